# Optimizing an MI355X kernel written in HIP

```python
import math
import jax, jax.numpy as jnp
from jax import lax
import numpy as np

D_MODEL = 2048
BATCH = 4
SEQ = 4096
DEPTH = 1

MIX_WIDTH = D_MODEL
ATT_WIDTH = MIX_WIDTH // 2
LRU_WIDTH = MIX_WIDTH - ATT_WIDTH
ATT_HEADS = 8
ATT_QK_DIM = ATT_WIDTH // (2 * ATT_HEADS)
ATT_V_DIM = ATT_WIDTH // ATT_HEADS
LRU_HEADS = 8
LRU_BLOCK = LRU_WIDTH // LRU_HEADS
CONV_WIDTH = 4
LRU_C = 8.0
Q_BLOCK = 128
IN_WIDTH = 3 * ATT_WIDTH + 2 * LRU_WIDTH
PEER_HEADS = 8
PEER_KEYS = 128
PEER_EXPERTS = PEER_KEYS * PEER_KEYS
PEER_QDIM = 256
PEER_HALF = PEER_QDIM // 2
PEER_TOPK = 16
PEER_CHUNK = 128
DN_ALPHA = (2.0 * DEPTH) ** 0.25
DN_BETA = (8.0 * DEPTH) ** -0.25
LN_EPS = 1e-5

kernel_name = 'hybrid_diffattn_rglru_peer'


def layer_norm(x, g, b):
    xf = x.astype(jnp.float32)
    mu = jnp.mean(xf, axis=-1, keepdims=True)
    var = jnp.mean(jnp.square(xf - mu), axis=-1, keepdims=True)
    return ((xf - mu) * lax.rsqrt(var + LN_EPS) * g + b).astype(x.dtype)


def rms_norm(x, g):
    xf = x.astype(jnp.float32)
    return xf * lax.rsqrt(jnp.mean(jnp.square(xf), axis=-1, keepdims=True) + LN_EPS) * g


def alibi_slopes():
    return jnp.exp2(-8.0 * jnp.arange(1, ATT_HEADS + 1, dtype=jnp.float32) / ATT_HEADS)


def diff_attention(q, k, v, lam, subln_g, lambda_init):
    B, S, _ = q.shape
    q = q.astype(jnp.float32).reshape(B, S, ATT_HEADS, 2, ATT_QK_DIM).transpose(0, 2, 3, 1, 4)
    k = k.astype(jnp.float32).reshape(B, S, ATT_HEADS, 2, ATT_QK_DIM).transpose(0, 2, 3, 1, 4)
    v = v.astype(jnp.float32).reshape(B, S, ATT_HEADS, ATT_V_DIM).transpose(0, 2, 1, 3)
    scale = ATT_QK_DIM ** -0.5
    slopes = alibi_slopes()
    key_pos = jnp.arange(S)

    def attend_block(i):
        start = i * Q_BLOCK
        qb = lax.dynamic_slice_in_dim(q, start, Q_BLOCK, axis=3)
        s = jnp.einsum('bhcqd,bhckd->bhcqk', qb, k) * scale
        dist = (start + jnp.arange(Q_BLOCK))[:, None] - key_pos[None, :]
        s = s - (slopes[:, None, None] * dist)[None, :, None]
        s = jnp.where(dist >= 0, s, -jnp.inf)
        p = jax.nn.softmax(s, axis=-1)
        pd = p[:, :, 0] - lam * p[:, :, 1]
        return jnp.einsum('bhqk,bhkd->bhqd', pd, v)

    o = lax.map(attend_block, jnp.arange(S // Q_BLOCK))
    o = o.transpose(1, 0, 3, 2, 4).reshape(B, S, ATT_HEADS, ATT_V_DIM)
    o = rms_norm(o, subln_g) * (1.0 - lambda_init)
    return o.reshape(B, S, ATT_WIDTH)


def causal_dwconv(x, w, b):
    S = x.shape[1]
    xp = jnp.pad(x, ((0, 0), (CONV_WIDTH - 1, 0), (0, 0)))
    y = xp[:, 0:S] * w[0]
    for j in range(1, CONV_WIDTH):
        y = y + xp[:, j:j + S] * w[j]
    return y + b


def rg_lru(xc, w_a, b_a, w_x, b_x, lam):
    B, S, _ = xc.shape
    xf = xc.astype(jnp.float32)
    xh = xf.reshape(B, S, LRU_HEADS, LRU_BLOCK)
    r = jax.nn.sigmoid(jnp.einsum('bshi,hij->bshj', xh, w_a.astype(jnp.float32)) + b_a).reshape(B, S, LRU_WIDTH)
    ig = jax.nn.sigmoid(jnp.einsum('bshi,hij->bshj', xh, w_x.astype(jnp.float32)) + b_x).reshape(B, S, LRU_WIDTH)
    log_a = -LRU_C * r * jax.nn.softplus(-lam.astype(jnp.float32))
    a = jnp.exp(log_a)
    bt = jnp.sqrt(-jnp.expm1(2.0 * log_a)) * (ig * xf)

    def combine(left, right):
        a_l, b_l = left
        a_r, b_r = right
        return a_l * a_r, a_r * b_l + b_r

    _, h = lax.associative_scan(combine, (a, bt), axis=1)
    return h.astype(xc.dtype)


def peer_ffn(x, wq, subkeys, u_tab, v_tab):
    B, S, D = x.shape
    xt = x.reshape((B * S) // PEER_CHUNK, PEER_CHUNK, D)
    K = PEER_TOPK

    def chunk(xc):
        C = xc.shape[0]
        q = (xc @ wq).astype(jnp.float32).reshape(C, PEER_HEADS, 2, PEER_HALF)
        sc = jnp.einsum('chpd,hpnd->chpn', q, subkeys.astype(jnp.float32))
        s_half, i_half = lax.top_k(sc, K)
        cand = s_half[:, :, 0, :, None] + s_half[:, :, 1, None, :]
        s_top, j = lax.top_k(cand.reshape(C, PEER_HEADS, K * K), K)
        ia = j // K
        ib = j % K
        e = (jnp.take_along_axis(i_half[:, :, 0], ia, axis=-1) * PEER_KEYS
             + jnp.take_along_axis(i_half[:, :, 1], ib, axis=-1))
        g = jax.nn.softmax(s_top, axis=-1)
        u = u_tab[e]
        hid = jax.nn.gelu(jnp.einsum('chkd,cd->chk', u, xc).astype(jnp.float32))
        w = (g * hid).astype(xc.dtype)
        return jnp.einsum('chk,chkd->cd', w, v_tab[e])

    return lax.map(chunk, xt).reshape(B, S, D)


def setup_inputs(seed: int = 0) -> dict:
    key = jax.random.key(seed)
    ks = jax.random.split(key, 24)
    f32 = jnp.float32
    nrm = lambda k, shape, s: jax.random.normal(k, shape, f32) * s
    x = nrm(ks[0], (BATCH, SEQ, D_MODEL), 1.0)
    col_scale = jnp.concatenate([jnp.ones((2 * ATT_WIDTH,), f32),
                                 jnp.full((ATT_WIDTH + 2 * LRU_WIDTH,), DN_BETA, f32)])
    w_in = nrm(ks[1], (DEPTH, D_MODEL, IN_WIDTH), D_MODEL ** -0.5) * col_scale
    conv_w = nrm(ks[2], (DEPTH, CONV_WIDTH, LRU_WIDTH), CONV_WIDTH ** -0.5)
    conv_b = nrm(ks[3], (DEPTH, LRU_WIDTH), 0.01)
    w_rg_a = nrm(ks[4], (DEPTH, LRU_HEADS, LRU_BLOCK, LRU_BLOCK), LRU_BLOCK ** -0.5)
    b_rg_a = nrm(ks[5], (DEPTH, LRU_HEADS, LRU_BLOCK), 0.01)
    w_rg_x = nrm(ks[6], (DEPTH, LRU_HEADS, LRU_BLOCK, LRU_BLOCK), LRU_BLOCK ** -0.5)
    b_rg_x = nrm(ks[7], (DEPTH, LRU_HEADS, LRU_BLOCK), 0.01)
    u = jax.random.uniform(ks[8], (DEPTH, LRU_WIDTH), f32, minval=0.9, maxval=0.999)
    p = u ** (1.0 / LRU_C)
    lru_lambda = jnp.log(p) - jnp.log1p(-p)
    lambda_q1 = nrm(ks[9], (DEPTH, ATT_QK_DIM), 0.1)
    lambda_k1 = nrm(ks[10], (DEPTH, ATT_QK_DIM), 0.1)
    lambda_q2 = nrm(ks[11], (DEPTH, ATT_QK_DIM), 0.1)
    lambda_k2 = nrm(ks[12], (DEPTH, ATT_QK_DIM), 0.1)
    subln_g = 1.0 + nrm(ks[13], (DEPTH, ATT_V_DIM), 0.01)
    w_out = nrm(ks[14], (DEPTH, MIX_WIDTH, D_MODEL), MIX_WIDTH ** -0.5 * DN_BETA)
    ln1_g = 1.0 + nrm(ks[15], (DEPTH, D_MODEL), 0.01)
    ln1_b = nrm(ks[16], (DEPTH, D_MODEL), 0.01)
    peer_wq = nrm(ks[17], (DEPTH, D_MODEL, PEER_HEADS * PEER_QDIM), D_MODEL ** -0.5)
    peer_subkeys = nrm(ks[18], (DEPTH, PEER_HEADS, 2, PEER_KEYS, PEER_HALF), PEER_HALF ** -0.5)
    peer_u = nrm(ks[19], (DEPTH, PEER_EXPERTS, D_MODEL), D_MODEL ** -0.5 * DN_BETA)
    peer_v = nrm(ks[20], (DEPTH, PEER_EXPERTS, D_MODEL), DN_BETA)
    ln2_g = 1.0 + nrm(ks[21], (DEPTH, D_MODEL), 0.01)
    ln2_b = nrm(ks[22], (DEPTH, D_MODEL), 0.01)
    return {'x': x, 'w_in': w_in, 'conv_w': conv_w, 'conv_b': conv_b,
            'w_rg_a': w_rg_a, 'b_rg_a': b_rg_a, 'w_rg_x': w_rg_x, 'b_rg_x': b_rg_x,
            'lru_lambda': lru_lambda, 'lambda_q1': lambda_q1, 'lambda_k1': lambda_k1,
            'lambda_q2': lambda_q2, 'lambda_k2': lambda_k2, 'subln_g': subln_g,
            'w_out': w_out, 'ln1_g': ln1_g, 'ln1_b': ln1_b, 'peer_wq': peer_wq,
            'peer_subkeys': peer_subkeys, 'peer_u': peer_u, 'peer_v': peer_v,
            'ln2_g': ln2_g, 'ln2_b': ln2_b}


def reference(x, w_in, conv_w, conv_b, w_rg_a, b_rg_a, w_rg_x, b_rg_x, lru_lambda,
              lambda_q1, lambda_k1, lambda_q2, lambda_k2, subln_g, w_out, ln1_g, ln1_b,
              peer_wq, peer_subkeys, peer_u, peer_v, ln2_g, ln2_b):
    h = x
    splits = [ATT_WIDTH, 2 * ATT_WIDTH, 3 * ATT_WIDTH, 3 * ATT_WIDTH + LRU_WIDTH]
    for l in range(DEPTH):
        proj = h @ w_in[l]
        q, k, v, xr, xg = jnp.split(proj, splits, axis=-1)
        lambda_init = 0.8 - 0.6 * math.exp(-0.3 * l)
        lam = (jnp.exp(jnp.sum(lambda_q1[l].astype(jnp.float32) * lambda_k1[l].astype(jnp.float32)))
               - jnp.exp(jnp.sum(lambda_q2[l].astype(jnp.float32) * lambda_k2[l].astype(jnp.float32)))
               + lambda_init)
        att = diff_attention(q, k, v, lam, subln_g[l], lambda_init).astype(h.dtype)
        xc = causal_dwconv(xr, conv_w[l], conv_b[l])
        lru = rg_lru(xc, w_rg_a[l], b_rg_a[l], w_rg_x[l], b_rg_x[l], lru_lambda[l]) * jax.nn.gelu(xg)
        mix = jnp.concatenate([att, lru], axis=-1) @ w_out[l]
        h = layer_norm(DN_ALPHA * h + mix, ln1_g[l], ln1_b[l])
        ffn = peer_ffn(h, peer_wq[l], peer_subkeys[l], peer_u[l], peer_v[l])
        h = layer_norm(DN_ALPHA * h + ffn, ln2_g[l], ln2_b[l])
    return h
```

```cpp
#include <hip/hip_runtime.h>
#include <cstdio>
#include <cstdint>
namespace pg8 {
#define PG8_LAS __attribute__((address_space(3)))
typedef unsigned short bf16_t;
typedef short bf16x8 __attribute__((ext_vector_type(8)));
typedef float f32x4 __attribute__((ext_vector_type(4)));
typedef unsigned u32x4 __attribute__((ext_vector_type(4)));
constexpr int BM = 256, BK = 64, HALF = 128, HTB = HALF * BK * 2  , STAGE_BYTES = 8 * HTB, NXCD = 8, WGM = 8;

__host__ __device__ __forceinline__ int lds_byte(int r, int c) { const int st = (r >> 4) * 2 + (c >> 5), rr = r & 15, cc = c & 31, ob = rr * 64 + cc * 2; return st * 1024 + (ob ^ (((ob >> 9) & 1) << 5)); }
__host__ __device__ __forceinline__ void stage_rc(int b, int& R, int& C) { const int st = b / 1024, sb = b % 1024, swz = sb ^ (((sb >> 9) & 1) << 5); R = (st >> 1) * 16 + swz / 64; C = (st & 1) * 32 + (swz % 64) / 2; }
__host__ __device__ __forceinline__ int perm32(int rho) { const int n = rho >> 4, i = rho & 15; return 8 * (i >> 2) + 4 * n + (i & 3); }

struct Unit { int pm, pn; };
struct Gemm { const bf16_t* A; const bf16_t* Bt; int M, N, K; };

struct StaticOrder {
    int nM, nN, nwg, G, c;
    __host__ __device__ void init(int M, int N, int G_, int c_) { nM = M / BM; nN = N / BM; nwg = nM * nN; G = G_; c = c_; }
    __host__ __device__ bool next(int i, Unit& u) const {
        const long L = (long)i * G + c; if (L >= nwg) return false;
        int wgid = (int)L; { const int q = nwg / NXCD, r = nwg % NXCD, xcd = wgid % NXCD, off = wgid / NXCD; wgid = (xcd < r ? xcd * (q + 1) : r * (q + 1) + (xcd - r) * q) + off; }
        const int nig = WGM * nN, gid = wgid / nig, fm = gid * WGM, gsz = (nM - fm) < WGM ? (nM - fm) : WGM;
        u.pm = fm + ((wgid % nig) % gsz); u.pn = (wgid % nig) / gsz; return true;
    }
    __device__ __forceinline__ void a_ready(const Unit&) const {}
    __device__ __forceinline__ void done(const Unit&) const {}
};

__device__ __forceinline__ unsigned cvt_pk_bf16(float lo, float hi) { unsigned r; asm volatile("v_cvt_pk_bf16_f32 %0, %1, %2" : "=v"(r) : "v"(lo), "v"(hi)); return r; }
typedef float f32x2 __attribute__((ext_vector_type(2)));
__device__ __forceinline__ f32x2 gelu_pk(f32x2 v) {
    const f32x2 av = __builtin_elementwise_abs(v), d = av * 0.2316418882f + 1.0f;
    f32x2 t; t.x = __builtin_amdgcn_rcpf(d.x); t.y = __builtin_amdgcn_rcpf(d.y);
    f32x2 q = t * 0.5307027145f + (-0.7265760135f); q = q * t + 0.7107068705f; q = q * t + (-0.142248368f); q = q * t + 0.127414796f; q = q * t;
    const f32x2 s = (v * v) * (-0.72134752044f);
    f32x2 e; e.x = __builtin_amdgcn_exp2f(s.x); e.y = __builtin_amdgcn_exp2f(s.y);
    const f32x2 m = v * (q * e), r = v - m;
    f32x2 o; o.x = v.x < 0.f ? m.x : r.x; o.y = v.y < 0.f ? m.y : r.y; return o;
}

template <int ACT  > struct EpiBf16 {
    static constexpr bool PERM = true, AFTER_DRAIN = false; static_assert(ACT == 0 || ACT == 1, "EpiBf16: ACT is 0 (none) or 1 (gelu_pk)");
    bf16_t* O; int ldc; const float* bias; int split_cols; size_t split_stride; float scale0;
    __device__ __forceinline__ void operator()(const f32x4 (&acc)[2][2][4][2], const Unit& u, int wr, int wc, int fr, int fq) const {
        const int row0 = u.pm * BM + wr * 64 + fr; int colt = u.pn * BM; bf16_t* base = O;
        float sc = 1.f; if (split_cols) { const int t = colt / split_cols; base += (size_t)t * split_stride; colt -= t * split_cols; if (t == 0) sc = scale0; }
        const int col0 = colt + wc * 32 + 8 * fq, bcol0 = u.pn * BM + wc * 32 + 8 * fq;
        f32x4 bv[2][2];
#pragma unroll
        for (int bj = 0; bj < 2; ++bj)
#pragma unroll
            for (int n = 0; n < 2; ++n) bv[bj][n] = bias ? *(const f32x4*)(bias + bcol0 + bj * HALF + 4 * n) : (f32x4){0.f, 0.f, 0.f, 0.f};
#pragma unroll
        for (int ai = 0; ai < 2; ++ai)
#pragma unroll
            for (int m = 0; m < 4; ++m) { bf16_t* rowp = base + (size_t)(row0 + ai * HALF + m * 16) * ldc + col0;
#pragma unroll
                for (int bj = 0; bj < 2; ++bj) { f32x4 v0 = acc[ai][bj][m][0] + bv[bj][0], v1 = acc[ai][bj][m][1] + bv[bj][1];
                    if (ACT == 1) { f32x2 a = gelu_pk((f32x2){v0[0], v0[1]}), b = gelu_pk((f32x2){v0[2], v0[3]}), c = gelu_pk((f32x2){v1[0], v1[1]}), d = gelu_pk((f32x2){v1[2], v1[3]});
                        v0 = (f32x4){a.x, a.y, b.x, b.y}; v1 = (f32x4){c.x, c.y, d.x, d.y}; }
                    v0 = v0 * sc; v1 = v1 * sc; u32x4 w; w.x = cvt_pk_bf16(v0[0], v0[1]); w.y = cvt_pk_bf16(v0[2], v0[3]); w.z = cvt_pk_bf16(v1[0], v1[1]); w.w = cvt_pk_bf16(v1[2], v1[3]);
                    *(u32x4*)(rowp + bj * HALF) = w; } }
    }
};

struct PanelStats {
    unsigned* xbuf;
    unsigned* cnt;
    unsigned* tmo;
    int ntn; float eps;
    unsigned code;
    __device__ __forceinline__ bool run(const f32x4 (&v)[2][2][4][2], const Unit& u, int wr, int wc, int fr, int fq, PG8_LAS unsigned char* lds, int wid, int lane) const {
        typedef float f32x2v __attribute__((ext_vector_type(2)));
        PG8_LAS f32x2v* P = (PG8_LAS f32x2v*)lds;
        PG8_LAS f32x2v* S = (PG8_LAS f32x2v*)(lds + 8192);
        PG8_LAS unsigned* flag = (PG8_LAS unsigned*)(lds + 8192 + 2048);
#pragma unroll
        for (int ai = 0; ai < 2; ++ai)
#pragma unroll
            for (int m = 0; m < 4; ++m) {
                float s = 0.f;
#pragma unroll
                for (int bj = 0; bj < 2; ++bj)
#pragma unroll
                    for (int n = 0; n < 2; ++n) { const f32x4 x = v[ai][bj][m][n]; s += (x[0] + x[1]) + (x[2] + x[3]); }
                s += __shfl_xor(s, 16); s += __shfl_xor(s, 32);
                const float mw = s * (1.0f / 64.0f); float q = 0.f;
#pragma unroll
                for (int bj = 0; bj < 2; ++bj)
#pragma unroll
                    for (int n = 0; n < 2; ++n) { const f32x4 d = v[ai][bj][m][n] - mw; q += (d[0] * d[0] + d[1] * d[1]) + (d[2] * d[2] + d[3] * d[3]); }
                q += __shfl_xor(q, 16); q += __shfl_xor(q, 32);
                if (fq == 0) P[(ai * HALF + wr * 64 + m * 16 + fr) * 4 + wc] = (f32x2v){mw, q};
            }
        asm volatile("s_waitcnt lgkmcnt(0)" ::: "memory"); __builtin_amdgcn_s_barrier(); asm volatile("" ::: "memory");
#if defined(BROKEN_EXCHANGE_NO_WAIT)
#warning BROKEN CONTROL BUILD: the row-statistics exchange does not wait; results are wrong by design
        if (blockIdx.x >= 64) { const long long t0_ = clock64(); while (clock64() - t0_ < 60000) __builtin_amdgcn_s_sleep(8); }
#endif
        const int row = wid * 32 + (lane & 31);
        if (lane < 32) {
            const f32x2v a = P[row * 4 + 0], b = P[row * 4 + 1], c = P[row * 4 + 2], d = P[row * 4 + 3];
            const float mt = (a.x + b.x + c.x + d.x) * 0.25f;
            const float da = a.x - mt, db = b.x - mt, dc = c.x - mt, dd = d.x - mt;
            const float m2 = (a.y + b.y) + (c.y + d.y) + 64.0f * ((da * da + db * db) + (dc * dc + dd * dd));
            unsigned long long* slot = (unsigned long long*)xbuf + ((size_t)(u.pm * BM + row) * 4 + u.pn);
            __hip_atomic_store(slot, ((unsigned long long)__float_as_uint(m2) << 32) | __float_as_uint(mt), __ATOMIC_RELAXED, __HIP_MEMORY_SCOPE_AGENT);
        }
        asm volatile("s_waitcnt vmcnt(0)" ::: "memory");
        if (lane == 0) __hip_atomic_fetch_add(cnt + 64 * u.pm, 1u, __ATOMIC_RELAXED, __HIP_MEMORY_SCOPE_AGENT);
        if (wid == 0) {
            bool dead = false; const unsigned long long t0 = __builtin_amdgcn_s_memrealtime(); const unsigned want = 8u * (unsigned)ntn;
            for (;;) {
#if defined(BROKEN_EXCHANGE_NO_WAIT)
                break;
#endif
                if ((unsigned)__builtin_amdgcn_readfirstlane(__hip_atomic_load(cnt + 64 * u.pm, __ATOMIC_RELAXED, __HIP_MEMORY_SCOPE_AGENT)) >= want) break;
                if (__builtin_amdgcn_s_memrealtime() - t0 > 2000000ull) {
                    if (lane == 0) { unsigned expect = 0u; __hip_atomic_compare_exchange_strong(tmo + 1, &expect, code | (unsigned)(u.pm & 0xff), __ATOMIC_RELAXED, __ATOMIC_RELAXED, __HIP_MEMORY_SCOPE_AGENT);
                                     __hip_atomic_store(tmo, 1u, __ATOMIC_RELAXED, __HIP_MEMORY_SCOPE_AGENT); }
                    dead = true; break; }
                __builtin_amdgcn_s_sleep(2);
            }
            __builtin_amdgcn_fence(__ATOMIC_ACQUIRE, "agent");
            if (lane == 0) flag[0] = dead ? 1u : 0u;
        }
        asm volatile("s_waitcnt vmcnt(0) lgkmcnt(0)" ::: "memory"); __builtin_amdgcn_s_barrier(); asm volatile("" ::: "memory");
        const bool bad = flag[0] != 0u;
        if (lane < 32) {
            const unsigned long long* slot = (const unsigned long long*)xbuf + (size_t)(u.pm * BM + row) * 4; float mt[4], m2[4]; float ms = 0.f;
#pragma unroll
            for (int t = 0; t < 4; ++t) { if (t < ntn) { const unsigned long long w = __hip_atomic_load(slot + t, __ATOMIC_RELAXED, __HIP_MEMORY_SCOPE_AGENT); mt[t] = __uint_as_float((unsigned)w); m2[t] = __uint_as_float((unsigned)(w >> 32)); } else { mt[t] = 0.f; m2[t] = 0.f; } ms += mt[t]; }
            const float mean = ms / (float)ntn; float q = 0.f;
#pragma unroll
            for (int t = 0; t < 4; ++t) if (t < ntn) { const float dm = mt[t] - mean; q += m2[t] + 256.0f * dm * dm; }
            S[row] = (f32x2v){mean, 1.0f / sqrtf(q / (256.0f * (float)ntn) + eps)};
        }
        asm volatile("s_waitcnt lgkmcnt(0)" ::: "memory"); __builtin_amdgcn_s_barrier(); asm volatile("" ::: "memory");
        return bad;
    }
};
struct EpiLnRes {
    static constexpr bool PERM = false, AFTER_DRAIN = true;
    const float* base; float* out; int ldc; const float* bias; PanelStats st; unsigned poison;
    __device__ __forceinline__ void fused(f32x4 (&acc)[2][2][4][2], const Unit& u, int wr, int wc, int fr, int fq, PG8_LAS unsigned char* lds, int wid, int lane) const {
        typedef float f32x2v __attribute__((ext_vector_type(2)));
        const PG8_LAS f32x2v* S = (const PG8_LAS f32x2v*)(lds + 8192);
        const int col0 = u.pn * BM + wc * 32 + 4 * fq;
#pragma unroll
        for (int bj = 0; bj < 2; ++bj)
#pragma unroll
            for (int n = 0; n < 2; ++n) { const f32x4 bv = bias ? *(const f32x4*)(bias + col0 + bj * HALF + n * 16) : (f32x4){0.f, 0.f, 0.f, 0.f};
#pragma unroll
                for (int ai = 0; ai < 2; ++ai)
#pragma unroll
                    for (int m = 0; m < 4; ++m) acc[ai][bj][m][n] += bv; }
        f32x4 pre[4][2][2];
#pragma unroll
        for (int m = 0; m < 4; ++m) { const size_t off = (size_t)(u.pm * BM + wr * 64 + m * 16 + fr) * ldc + col0;
#pragma unroll
            for (int bj = 0; bj < 2; ++bj)
#pragma unroll
                for (int n = 0; n < 2; ++n) pre[m][bj][n] = *(const f32x4*)(base + off + bj * HALF + n * 16); }
        const bool bad = st.run(acc, u, wr, wc, fr, fq, lds, wid, lane) || poison != 0u;
        const float qnan = __builtin_nanf("");
#pragma unroll
        for (int ai = 0; ai < 2; ++ai)
#pragma unroll
            for (int m = 0; m < 4; ++m) { const int r = ai * HALF + wr * 64 + m * 16 + fr; const f32x2v sr = S[r]; const size_t off = (size_t)(u.pm * BM + r) * ldc + col0;
#pragma unroll
                for (int bj = 0; bj < 2; ++bj)
#pragma unroll
                    for (int n = 0; n < 2; ++n) { const f32x4 bs = ai == 0 ? pre[m][bj][n] : *(const f32x4*)(base + off + bj * HALF + n * 16); f32x4 o = bs + (acc[ai][bj][m][n] - sr.x) * sr.y;
                        if (bad) o = (f32x4){qnan, qnan, qnan, qnan}; *(f32x4*)(out + off + bj * HALF + n * 16) = o; }
                if (m & 1) asm volatile("" ::: "memory"); }
    }
};
struct EpiLnResLn {
    static constexpr bool PERM = false, AFTER_DRAIN = true;
    const float* base; float* out; bf16_t* xn; int ldc; const float* bias; PanelStats st1, st2; unsigned poison;
    __device__ __forceinline__ void fused(f32x4 (&acc)[2][2][4][2], const Unit& u, int wr, int wc, int fr, int fq, PG8_LAS unsigned char* lds, int wid, int lane) const {
        typedef float f32x2v __attribute__((ext_vector_type(2))); typedef unsigned u32x2v __attribute__((ext_vector_type(2)));
        const PG8_LAS f32x2v* S = (const PG8_LAS f32x2v*)(lds + 8192);
        const int col0 = u.pn * BM + wc * 32 + 4 * fq;
#pragma unroll
        for (int bj = 0; bj < 2; ++bj)
#pragma unroll
            for (int n = 0; n < 2; ++n) { const f32x4 bv = bias ? *(const f32x4*)(bias + col0 + bj * HALF + n * 16) : (f32x4){0.f, 0.f, 0.f, 0.f};
#pragma unroll
                for (int ai = 0; ai < 2; ++ai)
#pragma unroll
                    for (int m = 0; m < 4; ++m) acc[ai][bj][m][n] += bv; }
        bool bad = st1.run(acc, u, wr, wc, fr, fq, lds, wid, lane) || poison != 0u;
        const float qnan = __builtin_nanf("");
#pragma unroll
        for (int ai = 0; ai < 2; ++ai)
#pragma unroll
            for (int m = 0; m < 4; ++m) { const int r = ai * HALF + wr * 64 + m * 16 + fr; const f32x2v sr = S[r]; const size_t off = (size_t)(u.pm * BM + r) * ldc + col0;
#pragma unroll
                for (int bj = 0; bj < 2; ++bj)
#pragma unroll
                    for (int n = 0; n < 2; ++n) { const f32x4 bs = *(const f32x4*)(base + off + bj * HALF + n * 16); acc[ai][bj][m][n] = bs + (acc[ai][bj][m][n] - sr.x) * sr.y; }
                asm volatile("" : "+v"(acc[ai][0][m][0]), "+v"(acc[ai][0][m][1]), "+v"(acc[ai][1][m][0]), "+v"(acc[ai][1][m][1]));
                if (m & 1) asm volatile("" ::: "memory"); }
        const bool bad1 = bad;
        bad = st2.run(acc, u, wr, wc, fr, fq, lds, wid, lane) || bad;
#pragma unroll
        for (int ai = 0; ai < 2; ++ai)
#pragma unroll
            for (int m = 0; m < 4; ++m) { const int r = ai * HALF + wr * 64 + m * 16 + fr; const f32x2v sr = S[r]; const size_t off = (size_t)(u.pm * BM + r) * ldc + col0;
#pragma unroll
                for (int bj = 0; bj < 2; ++bj)
#pragma unroll
                    for (int n = 0; n < 2; ++n) { const f32x4 x1 = acc[ai][bj][m][n]; *(f32x4*)(out + off + bj * HALF + n * 16) = bad1 ? (f32x4){qnan, qnan, qnan, qnan} : x1;
                        const f32x4 o = (x1 - sr.x) * sr.y; u32x2v w; w.x = cvt_pk_bf16(o[0], o[1]); w.y = cvt_pk_bf16(o[2], o[3]);
                        if (bad) { w.x = 0x7fc07fc0u; w.y = 0x7fc07fc0u; } *(u32x2v*)(xn + off + bj * HALF + n * 16) = w; }
                asm volatile("" ::: "memory"); }
    }
};

template <class Epi, class Sched, bool ALIGN_EPI = false, bool SP2 = false>
__device__ __forceinline__ void gemm_phase(PG8_LAS unsigned char* lds, const Gemm g, const Sched& S, const Epi& E) {
    const int tid = threadIdx.x, wid = __builtin_amdgcn_readfirstlane(tid >> 6), lane = tid & 63, wr = wid >> 2, wc = wid & 3, fr = lane & 15, fq = lane >> 4;
    const int K = g.K, nt = K / BK;
    unsigned voffA[2], voffB[2];
#pragma unroll
    for (int i = 0; i < 2; ++i) { int R, C; stage_rc(tid * 16 + i * 8192, R, C); const int Rb = Epi::PERM ? ((R & ~31) + perm32(R & 31)) : R;
        voffA[i] = (unsigned)(R * K + C) * 2u; voffB[i] = (unsigned)(Rb * K + C) * 2u; }
    const size_t kstep = (size_t)(BK * 2);
    const size_t hstep = (size_t)HALF * K * 2;
    const size_t tstep = 2 * hstep;
    const unsigned ldsw = (unsigned)wid * 1024u;
    const int aoff = lds_byte(wr * 64 + fr, fq * 8), boff = lds_byte(wc * 32 + fr, fq * 8);
#define PG8_SA(b, h) (((b) * 2 + (h)) * HTB)
#define PG8_SB(b, h) ((4 + (b) * 2 + (h)) * HTB)
#define PG8_STAGE(bufoff, gbase, voff) do { _Pragma("unroll") for (int _i = 0; _i < 2; ++_i) \
        __builtin_amdgcn_global_load_lds((const unsigned*)((const char*)(gbase) + (voff)[_i]), (PG8_LAS unsigned*)(lds + (bufoff) + ldsw + _i * 8192), 16, 0, 0); } while (0)
#define PG8_LDA(dst, b, h) do { _Pragma("unroll") for (int m = 0; m < 4; ++m) _Pragma("unroll") for (int k = 0; k < 2; ++k) dst[m][k] = *(const PG8_LAS bf16x8*)(lds + PG8_SA(b, h) + aoff + m * 2048 + k * 1024); } while (0)
#define PG8_LDB(dst, b, h) do { _Pragma("unroll") for (int n = 0; n < 2; ++n) _Pragma("unroll") for (int k = 0; k < 2; ++k) dst[n][k] = *(const PG8_LAS bf16x8*)(lds + PG8_SB(b, h) + boff + n * 2048 + k * 1024); } while (0)
#define PG8_MMA(ai, bj, At, Bt) do { __builtin_amdgcn_s_setprio(1); _Pragma("unroll") for (int m = 0; m < 4; ++m) _Pragma("unroll") for (int n = 0; n < 2; ++n) _Pragma("unroll") for (int k = 0; k < 2; ++k) \
        acc[ai][bj][m][n] = __builtin_amdgcn_mfma_f32_16x16x32_bf16(Bt[n][k], At[m][k], acc[ai][bj][m][n], 0, 0, 0); __builtin_amdgcn_s_setprio(0); } while (0)
#define PG8_WAIT_V(n) asm volatile("s_waitcnt vmcnt(" #n ")" ::: "memory")
#define PG8_WAIT_L(n) asm volatile("s_waitcnt lgkmcnt(" #n ")" ::: "memory")
#define PG8_BAR __builtin_amdgcn_s_barrier()
#define PG8_SCHED __builtin_amdgcn_sched_barrier(0)
    Unit cur, nxt; int ui = 0;
    if (!S.next(0, cur)) return;
    f32x4 acc[2][2][4][2];
#pragma unroll
    for (int a = 0; a < 2; ++a)
#pragma unroll
        for (int b = 0; b < 2; ++b)
#pragma unroll
            for (int m = 0; m < 4; ++m)
#pragma unroll
                for (int n = 0; n < 2; ++n) acc[a][b][m][n] = (f32x4){0.f, 0.f, 0.f, 0.f};
    bf16x8 At[4][2], B0[2][2], B1[2][2];
    const char* cA = (const char*)g.A + (size_t)cur.pm * tstep; const char* cB = (const char*)g.Bt + (size_t)cur.pn * tstep;
    S.a_ready(cur);
    if constexpr (SP2) {
        PG8_STAGE(PG8_SB(0, 0), cB, voffB); PG8_STAGE(PG8_SB(0, 1), cB + hstep, voffB); PG8_STAGE(PG8_SA(0, 0), cA, voffA); PG8_STAGE(PG8_SA(0, 1), cA + hstep, voffA);
        if (wr == 1) PG8_BAR;
        PG8_WAIT_V(2); PG8_BAR;
        PG8_STAGE(PG8_SB(1, 0), cB + kstep, voffB); PG8_STAGE(PG8_SA(1, 0), cA + kstep, voffA); PG8_STAGE(PG8_SB(1, 1), cB + hstep + kstep, voffB);
        PG8_WAIT_V(6); PG8_BAR;
    } else {
        PG8_STAGE(PG8_SB(0, 0), cB, voffB); PG8_STAGE(PG8_SA(0, 0), cA, voffA); PG8_STAGE(PG8_SB(0, 1), cB + hstep, voffB); PG8_STAGE(PG8_SA(0, 1), cA + hstep, voffA);
        if (wr == 1) PG8_BAR;
        PG8_WAIT_V(4); PG8_BAR;
        PG8_STAGE(PG8_SB(1, 0), cB + kstep, voffB); PG8_STAGE(PG8_SA(1, 0), cA + kstep, voffA); PG8_STAGE(PG8_SB(1, 1), cB + hstep + kstep, voffB);
        PG8_WAIT_V(6); PG8_BAR;
    }
    for (;;) {
        const bool has_next = S.next(ui + 1, nxt);
        const char* nA = has_next ? (const char*)g.A + (size_t)nxt.pm * tstep : cA; const char* nB = has_next ? (const char*)g.Bt + (size_t)nxt.pn * tstep : cB;
        for (int t = 0; t < nt; t += 2) {
            const bool last = (t == nt - 2);
            const char* a1 = cA + (size_t)(t + 1) * kstep;
            const char* a2 = last ? nA : cA + (size_t)(t + 2) * kstep; const char* b2 = last ? nB : cB + (size_t)(t + 2) * kstep;
            const char* a3 = a2 + kstep; const char* b3 = b2 + kstep;
            if (last && has_next) S.a_ready(nxt);
            if constexpr (SP2) {
            PG8_LDB(B0, 0, 0); PG8_LDB(B1, 0, 1); PG8_SCHED; PG8_LDA(At, 0, 0); PG8_STAGE(PG8_SA(1, 1), a1 + hstep, voffA);
            PG8_WAIT_V(8); PG8_WAIT_L(0); PG8_BAR; PG8_MMA(0, 0, At, B0); PG8_MMA(0, 1, At, B1); PG8_BAR; PG8_SCHED;
            PG8_LDA(At, 0, 1); PG8_STAGE(PG8_SB(0, 0), b2, voffB); PG8_STAGE(PG8_SB(0, 1), b2 + hstep, voffB); PG8_STAGE(PG8_SA(0, 0), a2, voffA);
            PG8_WAIT_V(8); PG8_WAIT_L(0); PG8_BAR; PG8_MMA(1, 0, At, B0); PG8_MMA(1, 1, At, B1); PG8_BAR; PG8_SCHED;
            PG8_LDB(B0, 1, 0); PG8_LDB(B1, 1, 1); PG8_SCHED; PG8_LDA(At, 1, 0); PG8_STAGE(PG8_SA(0, 1), a2 + hstep, voffA);
            PG8_WAIT_V(8); PG8_WAIT_L(0); PG8_BAR; PG8_MMA(0, 0, At, B0); PG8_MMA(0, 1, At, B1); PG8_BAR; PG8_SCHED;
            PG8_LDA(At, 1, 1); PG8_STAGE(PG8_SB(1, 0), b3, voffB); PG8_STAGE(PG8_SB(1, 1), b3 + hstep, voffB); PG8_STAGE(PG8_SA(1, 0), a3, voffA);
            PG8_WAIT_V(8); PG8_WAIT_L(0); PG8_BAR; PG8_MMA(1, 0, At, B0); PG8_MMA(1, 1, At, B1); PG8_BAR; PG8_SCHED;
            } else {
            PG8_LDB(B0, 0, 0); PG8_SCHED; PG8_LDA(At, 0, 0); PG8_STAGE(PG8_SA(1, 1), a1 + hstep, voffA);
            PG8_WAIT_L(8); PG8_BAR; PG8_WAIT_L(0); PG8_MMA(0, 0, At, B0); PG8_BAR; PG8_SCHED;
            PG8_LDB(B1, 0, 1); PG8_STAGE(PG8_SB(0, 0), b2, voffB);
            PG8_BAR; PG8_WAIT_L(0); PG8_MMA(0, 1, At, B1); PG8_BAR;
            PG8_LDA(At, 0, 1); PG8_STAGE(PG8_SA(0, 0), a2, voffA);
            PG8_BAR; PG8_WAIT_L(0); PG8_MMA(1, 0, At, B0); PG8_BAR; PG8_SCHED;
            PG8_STAGE(PG8_SB(0, 1), b2 + hstep, voffB);
            PG8_WAIT_V(6); PG8_BAR; PG8_MMA(1, 1, At, B1); PG8_BAR;
            PG8_LDB(B0, 1, 0); PG8_SCHED; PG8_LDA(At, 1, 0); PG8_STAGE(PG8_SA(0, 1), a2 + hstep, voffA);
            PG8_WAIT_L(8); PG8_BAR; PG8_WAIT_L(0); PG8_MMA(0, 0, At, B0); PG8_BAR; PG8_SCHED;
            PG8_LDB(B1, 1, 1); PG8_STAGE(PG8_SB(1, 0), b3, voffB);
            PG8_BAR; PG8_WAIT_L(0); PG8_MMA(0, 1, At, B1); PG8_BAR;
            PG8_LDA(At, 1, 1); PG8_STAGE(PG8_SA(1, 0), a3, voffA);
            PG8_BAR; PG8_WAIT_L(0); PG8_MMA(1, 0, At, B0); PG8_BAR; PG8_SCHED;
            PG8_STAGE(PG8_SB(1, 1), b3 + hstep, voffB);
            PG8_WAIT_V(6); PG8_BAR; PG8_MMA(1, 1, At, B1); PG8_BAR;
            }
        }
        if constexpr (ALIGN_EPI) { if (wr == 0) PG8_BAR; }
        if constexpr (!Epi::AFTER_DRAIN) { E(acc, cur, wr, wc, fr, fq); S.done(cur); }
        if (!has_next) break;
#pragma unroll
        for (int a = 0; a < 2; ++a)
#pragma unroll
            for (int b = 0; b < 2; ++b)
#pragma unroll
                for (int m = 0; m < 4; ++m)
#pragma unroll
                    for (int n = 0; n < 2; ++n) acc[a][b][m][n] = (f32x4){0.f, 0.f, 0.f, 0.f};
        cur = nxt; cA = nA; cB = nB; ++ui;
        if constexpr (ALIGN_EPI) { if (wr == 1) PG8_BAR; }
    }
    PG8_WAIT_V(0);
    if constexpr (!ALIGN_EPI) { if (wr == 0) PG8_BAR; }
    PG8_BAR;
    if constexpr (Epi::AFTER_DRAIN) { E.fused(acc, cur, wr, wc, fr, fq, lds, wid, lane); S.done(cur); }
#undef PG8_SA
#undef PG8_SB
#undef PG8_STAGE
#undef PG8_LDA
#undef PG8_LDB
#undef PG8_MMA
#undef PG8_WAIT_V
#undef PG8_WAIT_L
#undef PG8_BAR
#undef PG8_SCHED
}
}
#ifndef PG8_SP2
#define PG8_SP2 true
#endif
#ifndef PG8_ALIGN
#define PG8_ALIGN true
#endif
namespace pg8 {
struct EpiF32 {
    static constexpr bool PERM = false, AFTER_DRAIN = false;
    float* O; int ldc; const float* base; float alpha;
    __device__ __forceinline__ void operator()(const f32x4 (&acc)[2][2][4][2], const Unit& u, int wr, int wc, int fr, int fq) const {
        const int col0 = u.pn * BM + wc * 32 + 4 * fq;
#pragma unroll
        for (int ai = 0; ai < 2; ++ai)
#pragma unroll
            for (int m = 0; m < 4; ++m) { const size_t off = (size_t)(u.pm * BM + ai * HALF + wr * 64 + m * 16 + fr) * ldc + col0;
#pragma unroll
                for (int bj = 0; bj < 2; ++bj)
#pragma unroll
                    for (int n = 0; n < 2; ++n) { f32x4 v = acc[ai][bj][m][n];
                        if (base) { const f32x4 bs = *(const f32x4*)(base + off + bj * HALF + n * 16); v = v + bs * alpha; }
                        *(f32x4*)(O + off + bj * HALF + n * 16) = v; } }
    }
};
}

constexpr int NWAVES = 8;
constexpr int BATCH = 4, SEQ = 4096, D = 2048, M = BATCH * SEQ;
constexpr int AW = 1024, NIN = 5120;
constexpr float LN_EPS = 1e-5f;
constexpr float DN_ALPHA = 1.189207115002721f;
constexpr float C2 = 0.125f * 1.4426950408889634f;
constexpr float LOG2E = 1.4426950408889634f;

constexpr size_t MiB = 1u << 20;
constexpr size_t WS_CTL = 0, CTL_ZERO_BYTES = 1 * MiB;
constexpr size_t WS_WIN = 2 * MiB, WS_WOUT = 22 * MiB, WS_WQ = 30 * MiB, WS_PRM = 38 * MiB;
constexpr size_t WS_XB = 40 * MiB;
constexpr size_t WS_MIX = 40 * MiB;
constexpr size_t WS_Q = 104 * MiB, WS_K = 136 * MiB, WS_V = 168 * MiB, WS_XR = 200 * MiB, WS_XG = 232 * MiB;
constexpr size_t WS_H1 = 104 * MiB;
constexpr size_t WS_PQ = 168 * MiB;
constexpr size_t WS_Y1 = 328 * MiB;
constexpr size_t WS_LA = 328 * MiB, WS_LB = 392 * MiB;
constexpr size_t WS_E = 456 * MiB, WS_G = 464 * MiB, WS_END = 472 * MiB;
constexpr int CW_BAR = 4096;

constexpr int RING_OFF = 0, RING_BYTES = 131072;
constexpr int LDSCTL_OFF = RING_BYTES, MISC_OFF = LDSCTL_OFF + 320;
constexpr int LDS_BYTES = 147456;

#define GAS __attribute__((address_space(1)))
#define LAS __attribute__((address_space(3)))
typedef unsigned short bf16;
typedef unsigned v4u __attribute__((ext_vector_type(4)));
typedef float f32x4 __attribute__((ext_vector_type(4)));
typedef GAS unsigned gu32;
#define RLX_AGENT __ATOMIC_RELAXED, __HIP_MEMORY_SCOPE_AGENT
#define LDS_WAIT() asm volatile("s_waitcnt lgkmcnt(0)" ::: "memory")
#define VM_WAIT() asm volatile("s_waitcnt vmcnt(0)" ::: "memory")
__device__ __forceinline__ unsigned f2bf(float f) { unsigned u = __builtin_bit_cast(unsigned, f); return (u + 0x7fffu + ((u >> 16) & 1u)) >> 16; }
__device__ __forceinline__ unsigned pk2(float lo, float hi) { return f2bf(lo) | (f2bf(hi) << 16); }
__device__ __forceinline__ float bf2f(unsigned short u) { return __uint_as_float(((unsigned)u) << 16); }
__device__ __forceinline__ float gelu_tanh(float x) { const float u = 0.7978845608028654f * (x + 0.044715f * x * x * x); return 0.5f * x * (1.f + tanhf(u)); }

struct Frame {
    LAS unsigned char* lds;
    int tid, lane, wave;
    int vcu, G;
};

__device__ __forceinline__ void p0_transpose_item(const float* W, int K, int N, bf16* WT, int row_off, LAS float* scr, int item, int lane) {
    const int nblk = N / 32, kb = item / nblk, nb = item % nblk, k0 = 64 * kb, n0 = 32 * nb;
#pragma unroll 8
    for (int i = 0; i < 32; ++i) { const int kk = 2 * i + (lane >> 5); scr[kk * 33 + (lane & 31)] = W[(size_t)(k0 + kk) * N + n0 + (lane & 31)]; }
    LDS_WAIT(); asm volatile("" ::: "memory");
    const int c = lane & 7;
#pragma unroll
    for (int j = 0; j < 4; ++j) { const int n = (lane >> 3) + 8 * j; const LAS float* s = scr + (8 * c) * 33 + n;
        v4u o; o.x = pk2(s[0 * 33], s[1 * 33]); o.y = pk2(s[2 * 33], s[3 * 33]); o.z = pk2(s[4 * 33], s[5 * 33]); o.w = pk2(s[6 * 33], s[7 * 33]);
        *(GAS v4u*)(WT + (size_t)(row_off + n0 + n) * K + k0 + 8 * c) = o; }
    LDS_WAIT(); asm volatile("" ::: "memory");
}

struct Args { const float* in[23]; float* out; unsigned char* ws; int ph_lo, ph_hi; };

__global__ void __launch_bounds__(NWAVES * 64, 2) skel_fwd(Args args) {
    extern __shared__ __attribute__((aligned(16))) unsigned char lds[];
    Frame F;
    F.lds = (LAS unsigned char*)lds;
    F.tid = threadIdx.x; F.lane = F.tid & 63; F.wave = __builtin_amdgcn_readfirstlane(F.tid >> 6);
    F.G = gridDim.x; { const int bx = blockIdx.x; F.vcu = (F.G % 8 == 0) ? (bx % 8) * (F.G / 8) + bx / 8 : bx; }
    unsigned char* ws = args.ws;
    const float* x = args.in[0];
    bf16* WIN_T = (bf16*)(ws + WS_WIN); bf16* WOUT_T = (bf16*)(ws + WS_WOUT); bf16* WQ_T = (bf16*)(ws + WS_WQ);
    bf16* XB = (bf16*)(ws + WS_XB); bf16* MIX = (bf16*)(ws + WS_MIX); bf16* QB = (bf16*)(ws + WS_Q); bf16* H1 = (bf16*)(ws + WS_H1);
    float* Y1 = (float*)(ws + WS_Y1); float* PQ = (float*)(ws + WS_PQ);
    const int lo = args.ph_lo, hi = args.ph_hi;
#define IN(k) (lo <= (k) && (k) < hi)

    if (IN(0)) {
        LAS float* scr = (LAS float*)(F.lds + RING_OFF + F.wave * 16384);
        const int gw = F.vcu * NWAVES + F.wave, NGW = F.G * NWAVES;
        constexpr int I_IN = (D / 64) * (NIN / 32), I_SQ = (D / 64) * (D / 32);
        constexpr int NITEMS = I_IN + 2 * I_SQ;
        for (int it = gw; it < NITEMS; it += NGW) {
            int r = it;
            if (r < I_IN) { p0_transpose_item(args.in[1], D, NIN, WIN_T, 0, scr, r, F.lane); continue; } r -= I_IN;
            if (r < I_SQ) { p0_transpose_item(args.in[14], D, D, WOUT_T, 0, scr, r, F.lane); continue; } r -= I_SQ;
            p0_transpose_item(args.in[17], D, D, WQ_T, 0, scr, r, F.lane);
        }
        for (int m = gw; m < M; m += NGW) {
            const GAS f32x4* xr = (const GAS f32x4*)(x + (size_t)m * D) + F.lane;
            GAS unsigned long long* o8 = (GAS unsigned long long*)(XB + (size_t)m * D) + F.lane;
#pragma unroll
            for (int j = 0; j < 8; ++j) { const f32x4 v = xr[64 * j]; o8[64 * j] = (unsigned long long)pk2(v.x, v.y) | ((unsigned long long)pk2(v.z, v.w) << 32); }
        }
    }
    if (IN(1)) {
        pg8::Gemm g{XB, WIN_T, M, NIN, D}; pg8::StaticOrder S; S.init(M, NIN, F.G, (int)blockIdx.x);
        pg8::EpiBf16<0> E{QB, AW, nullptr, AW, (size_t)(WS_K - WS_Q) / 2, C2};
        pg8::gemm_phase<pg8::EpiBf16<0>, pg8::StaticOrder, PG8_ALIGN, PG8_SP2>(F.lds + RING_OFF, g, S, E);
    }
    if (IN(3)) {
        pg8::Gemm g{MIX, WOUT_T, M, D, D}; pg8::StaticOrder S; S.init(M, D, F.G, (int)blockIdx.x);
        pg8::EpiF32 E{Y1, D, x, DN_ALPHA};
        pg8::gemm_phase<pg8::EpiF32, pg8::StaticOrder, PG8_ALIGN, PG8_SP2>(F.lds + RING_OFF, g, S, E);
    }
    if (IN(5)) {
        pg8::Gemm g{H1, WQ_T, M, D, D}; pg8::StaticOrder S; S.init(M, D, F.G, (int)blockIdx.x);
        pg8::EpiF32 E{PQ, D, nullptr, 0.f};
        pg8::gemm_phase<pg8::EpiF32, pg8::StaticOrder, PG8_ALIGN, PG8_SP2>(F.lds + RING_OFF, g, S, E);
    }
#undef IN
}

__device__ __forceinline__ float wave_sum(float v) {
#pragma unroll
    for (int o = 1; o < 64; o <<= 1) v += __shfl_xor(v, o);
    return v;
}
__device__ __forceinline__ float wave_max(float v) {
#pragma unroll
    for (int o = 1; o < 64; o <<= 1) v = fmaxf(v, __shfl_xor(v, o));
    return v;
}
__device__ __forceinline__ float blk_sum(float v, float* red) {
    v = wave_sum(v); __syncthreads(); if ((threadIdx.x & 63) == 0) red[threadIdx.x >> 6] = v; __syncthreads();
    return (red[0] + red[1]) + (red[2] + red[3]);
}
__device__ __forceinline__ float blk_max(float v, float* red) {
    v = wave_max(v); __syncthreads(); if ((threadIdx.x & 63) == 0) red[threadIdx.x >> 6] = v; __syncthreads();
    return fmaxf(fmaxf(red[0], red[1]), fmaxf(red[2], red[3]));
}

__global__ void setup_params(const float* lq1, const float* lk1, const float* lq2, const float* lk2, float* prm) {
    const int l = threadIdx.x;
    float a = lq1[l] * lk1[l], b = lq2[l] * lk2[l];
    a = wave_sum(a); b = wave_sum(b);
    if (l == 0) prm[0] = expf(a) - expf(b) + 0.2f;
}

__device__ __forceinline__ float dot8(const v4u w, const float* q) {
    return bf2f((unsigned short)(w.x & 0xffff)) * q[0] + bf2f((unsigned short)(w.x >> 16)) * q[1] + bf2f((unsigned short)(w.y & 0xffff)) * q[2] + bf2f((unsigned short)(w.y >> 16)) * q[3]
         + bf2f((unsigned short)(w.z & 0xffff)) * q[4] + bf2f((unsigned short)(w.z >> 16)) * q[5] + bf2f((unsigned short)(w.w & 0xffff)) * q[6] + bf2f((unsigned short)(w.w >> 16)) * q[7];
}

__global__ void __launch_bounds__(256) naive_attn(const bf16* Q, const bf16* K, const bf16* V, bf16* MIX, const float* subln_g, const float* prm) {
    __shared__ float s0[SEQ], s1[SEQ]; __shared__ float qs[128]; __shared__ float red[4]; __shared__ float osum[256];
    const int blk = blockIdx.x, h = blk & 7, tok = blk >> 3, b = tok / SEQ, t = tok % SEQ, tid = threadIdx.x;
    if (tid < 128) qs[tid] = bf2f(Q[(size_t)tok * AW + h * 128 + tid]);
    __syncthreads();
    const float sl2 = exp2f(-(float)(h + 1)) * LOG2E;
    float m0 = -INFINITY, m1 = -INFINITY;
    for (int j = tid; j <= t; j += 256) {
        const bf16* kr = K + (size_t)(b * SEQ + j) * AW + h * 128;
        float d0 = 0.f, d1 = 0.f;
#pragma unroll
        for (int d = 0; d < 64; d += 8) { d0 += dot8(*(const v4u*)(kr + d), qs + d); d1 += dot8(*(const v4u*)(kr + 64 + d), qs + 64 + d); }
        const float bias = sl2 * (float)(t - j);
        d0 -= bias; d1 -= bias; s0[j] = d0; s1[j] = d1; m0 = fmaxf(m0, d0); m1 = fmaxf(m1, d1);
    }
    m0 = blk_max(m0, red); m1 = blk_max(m1, red);
    float l0 = 0.f, l1 = 0.f;
    for (int j = tid; j <= t; j += 256) { const float p0 = exp2f(s0[j] - m0), p1 = exp2f(s1[j] - m1); s0[j] = p0; s1[j] = p1; l0 += p0; l1 += p1; }
    l0 = blk_sum(l0, red); l1 = blk_sum(l1, red);
    const float lam = prm[0], i0 = 1.f / l0, i1 = lam / l1;
    for (int j = tid; j <= t; j += 256) s0[j] = s0[j] * i0 - s1[j] * i1;
    __syncthreads();
    const int half = tid >> 7, d = tid & 127;
    float acc = 0.f;
    const bf16* vb = V + (size_t)(b * SEQ) * AW + h * 128 + d;
    for (int j = half; j <= t; j += 2) acc += s0[j] * bf2f(vb[(size_t)j * AW]);
    osum[tid] = acc; __syncthreads();
    float o = 0.f; if (tid < 128) o = osum[tid] + osum[tid + 128];
    const float ss = blk_sum(o * o, red);
    const float r = rsqrtf(ss * (1.f / 128.f) + LN_EPS);
    if (tid < 128) MIX[(size_t)tok * D + h * 128 + d] = (bf16)f2bf(o * r * subln_g[d] * 0.8f);
}

__global__ void __launch_bounds__(256) naive_lru_gates(const bf16* XR, const float* conv_w, const float* conv_b, const float* w_a, const float* b_a, const float* w_x, const float* b_x,
                                                       const float* lru_lambda, float* A, float* BT) {
    __shared__ float xc[1024];
    const int tok = blockIdx.x, t = tok % SEQ, tid = threadIdx.x;
#pragma unroll
    for (int i = 0; i < 4; ++i) { const int ch = tid + 256 * i; float y = conv_b[ch];
#pragma unroll
        for (int j = 0; j < 4; ++j) { const int tt = t - 3 + j; if (tt >= 0) y += conv_w[j * 1024 + ch] * bf2f(XR[(size_t)(tok - 3 + j) * AW + ch]); }
        xc[ch] = y; }
    __syncthreads();
#pragma unroll
    for (int i = 0; i < 4; ++i) { const int ch = tid + 256 * i, hb = ch >> 7, jj = ch & 127;
        float ra = b_a[ch], rx = b_x[ch];
        for (int k = 0; k < 128; ++k) { const float xv = xc[hb * 128 + k]; ra += xv * w_a[(size_t)(hb * 128 + k) * 128 + jj]; rx += xv * w_x[(size_t)(hb * 128 + k) * 128 + jj]; }
        const float r = 1.f / (1.f + expf(-ra)), ig = 1.f / (1.f + expf(-rx));
        const float sp = log1pf(expf(-lru_lambda[ch]));
        const float log_a = -8.f * r * sp, a = expf(log_a), bt = sqrtf(-expm1f(2.f * log_a)) * ig * xc[ch];
        A[(size_t)tok * 1024 + ch] = a; BT[(size_t)tok * 1024 + ch] = bt; }
}
__global__ void __launch_bounds__(64) naive_lru_scan(const float* A, const float* BT, const bf16* XG, bf16* MIX) {
    const int idx = blockIdx.x * 64 + threadIdx.x, b = idx >> 10, ch = idx & 1023;
    float h = 0.f;
    for (int t0 = 0; t0 < SEQ; t0 += 8) {
        float a[8], bt[8], xg[8];
#pragma unroll
        for (int i = 0; i < 8; ++i) { const size_t o = (size_t)(b * SEQ + t0 + i) * 1024 + ch; a[i] = A[o]; bt[i] = BT[o]; xg[i] = bf2f(XG[o]); }
#pragma unroll
        for (int i = 0; i < 8; ++i) { h = a[i] * h + bt[i]; MIX[(size_t)(b * SEQ + t0 + i) * D + 1024 + ch] = (bf16)f2bf(h * gelu_tanh(xg[i])); }
    }
}
__global__ void __launch_bounds__(256) naive_ln(const float* Y1, const float* g, const float* bb, bf16* H1) {
    const int row = blockIdx.x * 4 + (threadIdx.x >> 6), lane = threadIdx.x & 63;
    const f32x4* y = (const f32x4*)(Y1 + (size_t)row * D);
    f32x4 v[8]; float s = 0.f;
#pragma unroll
    for (int j = 0; j < 8; ++j) { v[j] = y[lane + 64 * j]; s += (v[j].x + v[j].y) + (v[j].z + v[j].w); }
    const float mean = wave_sum(s) * (1.f / D); float s2 = 0.f;
#pragma unroll
    for (int j = 0; j < 8; ++j) { v[j] = v[j] - mean; s2 += (v[j].x * v[j].x + v[j].y * v[j].y) + (v[j].z * v[j].z + v[j].w * v[j].w); }
    const float rstd = rsqrtf(wave_sum(s2) * (1.f / D) + LN_EPS);
#pragma unroll
    for (int j = 0; j < 8; ++j) { const int c = (lane + 64 * j) * 4; const f32x4 gg = *(const f32x4*)(g + c), bv = *(const f32x4*)(bb + c);
        const f32x4 o = v[j] * rstd * gg + bv;
        *(unsigned long long*)(H1 + (size_t)row * D + c) = (unsigned long long)pk2(o.x, o.y) | ((unsigned long long)pk2(o.z, o.w) << 32); }
}
__global__ void __launch_bounds__(256) naive_route(const float* PQ, const float* subkeys, int* E, float* G) {
    __shared__ float qsh[4][256]; __shared__ float sh_s[4][2][16]; __shared__ int sh_i[4][2][16];
    const int w = threadIdx.x >> 6, lane = threadIdx.x & 63, id = blockIdx.x * 4 + w, tok = id >> 3, h = id & 7;
#pragma unroll
    for (int i = 0; i < 4; ++i) qsh[w][lane + 64 * i] = PQ[(size_t)tok * D + h * 256 + lane + 64 * i];
    __syncthreads();
#pragma unroll
    for (int p = 0; p < 2; ++p) {
        float v0 = 0.f, v1 = 0.f; const float* k0 = subkeys + (size_t)((h * 2 + p) * 128 + lane) * 128; const float* k1 = k0 + 64 * 128;
        for (int d = 0; d < 128; ++d) { const float q = qsh[w][p * 128 + d]; v0 += q * k0[d]; v1 += q * k1[d]; }
        for (int r = 0; r < 16; ++r) {
            float bv; int bi; if (v0 >= v1) { bv = v0; bi = lane; } else { bv = v1; bi = lane + 64; }
#pragma unroll
            for (int o = 1; o < 64; o <<= 1) { const float ov = __shfl_xor(bv, o); const int oi = __shfl_xor(bi, o); if (ov > bv || (ov == bv && oi < bi)) { bv = ov; bi = oi; } }
            if (bi == lane) v0 = -INFINITY; if (bi == lane + 64) v1 = -INFINITY;
            if (lane == 0) { sh_s[w][p][r] = bv; sh_i[w][p][r] = bi; }
        }
    }
    __syncthreads();
    float cv[4];
#pragma unroll
    for (int c = 0; c < 4; ++c) { const int f = lane + 64 * c; cv[c] = sh_s[w][0][f >> 4] + sh_s[w][1][f & 15]; }
    float mys = 0.f; int myf = 0;
    for (int r = 0; r < 16; ++r) {
        float bv = cv[0]; int bi = lane;
#pragma unroll
        for (int c = 1; c < 4; ++c) if (cv[c] > bv) { bv = cv[c]; bi = lane + 64 * c; }
#pragma unroll
        for (int o = 1; o < 64; o <<= 1) { const float ov = __shfl_xor(bv, o); const int oi = __shfl_xor(bi, o); if (ov > bv || (ov == bv && oi < bi)) { bv = ov; bi = oi; } }
#pragma unroll
        for (int c = 0; c < 4; ++c) if (bi == lane + 64 * c) cv[c] = -INFINITY;
        if (lane == r) { mys = bv; myf = bi; }
    }
    const float mx = __shfl(mys, 0);
    const float ex = lane < 16 ? expf(mys - mx) : 0.f;
    const float sum = wave_sum(ex);
    if (lane < 16) { E[(size_t)tok * 128 + h * 16 + lane] = sh_i[w][0][myf >> 4] * 128 + sh_i[w][1][myf & 15]; G[(size_t)tok * 128 + h * 16 + lane] = ex / sum; }
}
__global__ void __launch_bounds__(256) naive_peer(const bf16* H1, const int* E, const float* G, const float* u_tab, const float* v_tab, const float* g2, const float* b2, float* out) {
    __shared__ float hs[D]; __shared__ float wts[128]; __shared__ int es[128]; __shared__ float red[4];
    const int tok = blockIdx.x, tid = threadIdx.x, w = tid >> 6, lane = tid & 63;
#pragma unroll
    for (int i = 0; i < 8; ++i) hs[tid + 256 * i] = bf2f(H1[(size_t)tok * D + tid + 256 * i]);
    if (tid < 128) es[tid] = E[(size_t)tok * 128 + tid];
    __syncthreads();
    for (int k = w; k < 128; k += 4) {
        const f32x4* ur = (const f32x4*)(u_tab + (size_t)es[k] * D); float d = 0.f;
#pragma unroll
        for (int i = 0; i < 8; ++i) { const f32x4 uu = ur[lane + 64 * i]; const float* hp = hs + (lane + 64 * i) * 4; d += uu.x * hp[0] + uu.y * hp[1] + uu.z * hp[2] + uu.w * hp[3]; }
        d = wave_sum(d);
        if (lane == 0) wts[k] = G[(size_t)tok * 128 + k] * gelu_tanh(d);
    }
    __syncthreads();
    f32x4 a0 = {0.f, 0.f, 0.f, 0.f}, a1 = {0.f, 0.f, 0.f, 0.f};
    const int c0 = tid * 4, c1 = 1024 + tid * 4;
    for (int k = 0; k < 128; ++k) { const float* vr = v_tab + (size_t)es[k] * D; const float ww = wts[k]; a0 = a0 + *(const f32x4*)(vr + c0) * ww; a1 = a1 + *(const f32x4*)(vr + c1) * ww; }
    f32x4 y0, y1;
    y0.x = DN_ALPHA * hs[c0] + a0.x; y0.y = DN_ALPHA * hs[c0 + 1] + a0.y; y0.z = DN_ALPHA * hs[c0 + 2] + a0.z; y0.w = DN_ALPHA * hs[c0 + 3] + a0.w;
    y1.x = DN_ALPHA * hs[c1] + a1.x; y1.y = DN_ALPHA * hs[c1 + 1] + a1.y; y1.z = DN_ALPHA * hs[c1 + 2] + a1.z; y1.w = DN_ALPHA * hs[c1 + 3] + a1.w;
    const float mean = blk_sum((y0.x + y0.y) + (y0.z + y0.w) + (y1.x + y1.y) + (y1.z + y1.w), red) * (1.f / D);
    y0 = y0 - mean; y1 = y1 - mean;
    const float var = blk_sum((y0.x * y0.x + y0.y * y0.y) + (y0.z * y0.z + y0.w * y0.w) + (y1.x * y1.x + y1.y * y1.y) + (y1.z * y1.z + y1.w * y1.w), red) * (1.f / D);
    const float rstd = rsqrtf(var + LN_EPS);
    *(f32x4*)(out + (size_t)tok * D + c0) = y0 * rstd * *(const f32x4*)(g2 + c0) + *(const f32x4*)(b2 + c0);
    *(f32x4*)(out + (size_t)tok * D + c1) = y1 * rstd * *(const f32x4*)(g2 + c1) + *(const f32x4*)(b2 + c1);
}

extern "C" void kernel_launch(void* const* d_in, const int* in_sizes, int n_in, void* d_out, int out_size, void* d_ws, size_t ws_size, hipStream_t stream) {
    static int grid = 0;
    if (grid == 0) {
        if (n_in != 23 || in_sizes[0] != M * D || out_size != M * D || ws_size < WS_END) { fprintf(stderr, "kernel_launch: unexpected shapes n_in %d in0 %d out %d ws %zu\n", n_in, n_in > 0 ? in_sizes[0] : -1, out_size, ws_size); grid = -1; return; }
        int dev = 0, cus = 0;
        if (hipGetDevice(&dev) != hipSuccess || hipDeviceGetAttribute(&cus, hipDeviceAttributeMultiprocessorCount, dev) != hipSuccess) { grid = -1; return; }
        if (hipFuncSetAttribute((const void*)skel_fwd, hipFuncAttributeMaxDynamicSharedMemorySize, LDS_BYTES) != hipSuccess) { grid = -1; return; }
        grid = cus;
    }
    if (grid < 0) return;
    (void)hipMemsetAsync((char*)d_ws + WS_CTL, 0, CTL_ZERO_BYTES, stream);
    Args a{};
    for (int i = 0; i < 23; ++i) a.in[i] = (const float*)d_in[i];
    a.out = (float*)d_out; a.ws = (unsigned char*)d_ws;
    unsigned char* ws = (unsigned char*)d_ws;
    const float* const* in = (const float* const*)d_in;
    float* prm = (float*)(ws + WS_PRM);
    bf16 *Q = (bf16*)(ws + WS_Q), *K = (bf16*)(ws + WS_K), *V = (bf16*)(ws + WS_V), *XR = (bf16*)(ws + WS_XR), *XG = (bf16*)(ws + WS_XG), *MIX = (bf16*)(ws + WS_MIX), *H1 = (bf16*)(ws + WS_H1);
    float *LA = (float*)(ws + WS_LA), *LB = (float*)(ws + WS_LB), *Y1 = (float*)(ws + WS_Y1), *PQ = (float*)(ws + WS_PQ), *G = (float*)(ws + WS_G); int* E = (int*)(ws + WS_E);
    setup_params<<<1, 64, 0, stream>>>(in[9], in[10], in[11], in[12], prm);
    a.ph_lo = 0; a.ph_hi = 1; hipLaunchKernelGGL(skel_fwd, dim3(grid), dim3(NWAVES * 64), LDS_BYTES, stream, a);
    a.ph_lo = 1; a.ph_hi = 2; hipLaunchKernelGGL(skel_fwd, dim3(grid), dim3(NWAVES * 64), LDS_BYTES, stream, a);
    naive_attn<<<M * 8, 256, 0, stream>>>(Q, K, V, MIX, in[13], prm);
    naive_lru_gates<<<M, 256, 0, stream>>>(XR, in[2], in[3], in[4], in[5], in[6], in[7], in[8], LA, LB);
    naive_lru_scan<<<BATCH * 1024 / 64, 64, 0, stream>>>(LA, LB, XG, MIX);
    a.ph_lo = 3; a.ph_hi = 4; hipLaunchKernelGGL(skel_fwd, dim3(grid), dim3(NWAVES * 64), LDS_BYTES, stream, a);
    naive_ln<<<M / 4, 256, 0, stream>>>(Y1, in[15], in[16], H1);
    a.ph_lo = 5; a.ph_hi = 6; hipLaunchKernelGGL(skel_fwd, dim3(grid), dim3(NWAVES * 64), LDS_BYTES, stream, a);
    naive_route<<<M * 8 / 4, 256, 0, stream>>>(PQ, in[18], E, G);
    naive_peer<<<M, 256, 0, stream>>>(H1, E, G, in[19], in[20], in[21], in[22], (float*)d_out);
}
```

```cpp
#include <hip/hip_runtime.h>
#include <cstdio>
#include <cstdint>
namespace pg8 {
#define PG8_LAS __attribute__((address_space(3)))
typedef unsigned short bf16_t;
typedef short bf16x8 __attribute__((ext_vector_type(8)));
typedef float f32x4 __attribute__((ext_vector_type(4)));
typedef unsigned u32x4 __attribute__((ext_vector_type(4)));
constexpr int BM = 256, BK = 64, HALF = 128, HTB = HALF * BK * 2  , STAGE_BYTES = 8 * HTB, NXCD = 8, WGM = 8;

__host__ __device__ __forceinline__ int lds_byte(int r, int c) { const int st = (r >> 4) * 2 + (c >> 5), rr = r & 15, cc = c & 31, ob = rr * 64 + cc * 2; return st * 1024 + (ob ^ (((ob >> 9) & 1) << 5)); }
__host__ __device__ __forceinline__ void stage_rc(int b, int& R, int& C) { const int st = b / 1024, sb = b % 1024, swz = sb ^ (((sb >> 9) & 1) << 5); R = (st >> 1) * 16 + swz / 64; C = (st & 1) * 32 + (swz % 64) / 2; }
__host__ __device__ __forceinline__ int perm32(int rho) { const int n = rho >> 4, i = rho & 15; return 8 * (i >> 2) + 4 * n + (i & 3); }

struct Unit { int pm, pn; };
struct Gemm { const bf16_t* A; const bf16_t* Bt; int M, N, K; };

struct StaticOrder {
    int nM, nN, nwg, G, c;
    __host__ __device__ void init(int M, int N, int G_, int c_) { nM = M / BM; nN = N / BM; nwg = nM * nN; G = G_; c = c_; }
    __host__ __device__ bool next(int i, Unit& u) const {
        const long L = (long)i * G + c; if (L >= nwg) return false;
        int wgid = (int)L; { const int q = nwg / NXCD, r = nwg % NXCD, xcd = wgid % NXCD, off = wgid / NXCD; wgid = (xcd < r ? xcd * (q + 1) : r * (q + 1) + (xcd - r) * q) + off; }
        const int nig = WGM * nN, gid = wgid / nig, fm = gid * WGM, gsz = (nM - fm) < WGM ? (nM - fm) : WGM;
        u.pm = fm + ((wgid % nig) % gsz); u.pn = (wgid % nig) / gsz; return true;
    }
    __device__ __forceinline__ void a_ready(const Unit&) const {}
    __device__ __forceinline__ void done(const Unit&) const {}
};

__device__ __forceinline__ unsigned cvt_pk_bf16(float lo, float hi) { unsigned r; asm volatile("v_cvt_pk_bf16_f32 %0, %1, %2" : "=v"(r) : "v"(lo), "v"(hi)); return r; }
typedef float f32x2 __attribute__((ext_vector_type(2)));
__device__ __forceinline__ f32x2 gelu_pk(f32x2 v) {
    const f32x2 av = __builtin_elementwise_abs(v), d = av * 0.2316418882f + 1.0f;
    f32x2 t; t.x = __builtin_amdgcn_rcpf(d.x); t.y = __builtin_amdgcn_rcpf(d.y);
    f32x2 q = t * 0.5307027145f + (-0.7265760135f); q = q * t + 0.7107068705f; q = q * t + (-0.142248368f); q = q * t + 0.127414796f; q = q * t;
    const f32x2 s = (v * v) * (-0.72134752044f);
    f32x2 e; e.x = __builtin_amdgcn_exp2f(s.x); e.y = __builtin_amdgcn_exp2f(s.y);
    const f32x2 m = v * (q * e), r = v - m;
    f32x2 o; o.x = v.x < 0.f ? m.x : r.x; o.y = v.y < 0.f ? m.y : r.y; return o;
}

template <int ACT  > struct EpiBf16 {
    static constexpr bool PERM = true, AFTER_DRAIN = false; static_assert(ACT == 0 || ACT == 1, "EpiBf16: ACT is 0 (none) or 1 (gelu_pk)");
    bf16_t* O; int ldc; const float* bias; int split_cols; size_t split_stride; float scale0;
    __device__ __forceinline__ void operator()(const f32x4 (&acc)[2][2][4][2], const Unit& u, int wr, int wc, int fr, int fq) const {
        const int row0 = u.pm * BM + wr * 64 + fr; int colt = u.pn * BM; bf16_t* base = O;
        float sc = 1.f; if (split_cols) { const int t = colt / split_cols; base += (size_t)t * split_stride; colt -= t * split_cols; if (t == 0) sc = scale0; }
        const int col0 = colt + wc * 32 + 8 * fq, bcol0 = u.pn * BM + wc * 32 + 8 * fq;
        f32x4 bv[2][2];
#pragma unroll
        for (int bj = 0; bj < 2; ++bj)
#pragma unroll
            for (int n = 0; n < 2; ++n) bv[bj][n] = bias ? *(const f32x4*)(bias + bcol0 + bj * HALF + 4 * n) : (f32x4){0.f, 0.f, 0.f, 0.f};
#pragma unroll
        for (int ai = 0; ai < 2; ++ai)
#pragma unroll
            for (int m = 0; m < 4; ++m) { bf16_t* rowp = base + (size_t)(row0 + ai * HALF + m * 16) * ldc + col0;
#pragma unroll
                for (int bj = 0; bj < 2; ++bj) { f32x4 v0 = acc[ai][bj][m][0] + bv[bj][0], v1 = acc[ai][bj][m][1] + bv[bj][1];
                    if (ACT == 1) { f32x2 a = gelu_pk((f32x2){v0[0], v0[1]}), b = gelu_pk((f32x2){v0[2], v0[3]}), c = gelu_pk((f32x2){v1[0], v1[1]}), d = gelu_pk((f32x2){v1[2], v1[3]});
                        v0 = (f32x4){a.x, a.y, b.x, b.y}; v1 = (f32x4){c.x, c.y, d.x, d.y}; }
                    v0 = v0 * sc; v1 = v1 * sc; u32x4 w; w.x = cvt_pk_bf16(v0[0], v0[1]); w.y = cvt_pk_bf16(v0[2], v0[3]); w.z = cvt_pk_bf16(v1[0], v1[1]); w.w = cvt_pk_bf16(v1[2], v1[3]);
                    *(u32x4*)(rowp + bj * HALF) = w; } }
    }
};

struct PanelStats {
    unsigned* xbuf;
    unsigned* cnt;
    unsigned* tmo;
    int ntn; float eps;
    unsigned code;
    __device__ __forceinline__ bool run(const f32x4 (&v)[2][2][4][2], const Unit& u, int wr, int wc, int fr, int fq, PG8_LAS unsigned char* lds, int wid, int lane) const {
        typedef float f32x2v __attribute__((ext_vector_type(2)));
        PG8_LAS f32x2v* P = (PG8_LAS f32x2v*)lds;
        PG8_LAS f32x2v* S = (PG8_LAS f32x2v*)(lds + 8192);
        PG8_LAS unsigned* flag = (PG8_LAS unsigned*)(lds + 8192 + 2048);
#pragma unroll
        for (int ai = 0; ai < 2; ++ai)
#pragma unroll
            for (int m = 0; m < 4; ++m) {
                float s = 0.f;
#pragma unroll
                for (int bj = 0; bj < 2; ++bj)
#pragma unroll
                    for (int n = 0; n < 2; ++n) { const f32x4 x = v[ai][bj][m][n]; s += (x[0] + x[1]) + (x[2] + x[3]); }
                s += __shfl_xor(s, 16); s += __shfl_xor(s, 32);
                const float mw = s * (1.0f / 64.0f); float q = 0.f;
#pragma unroll
                for (int bj = 0; bj < 2; ++bj)
#pragma unroll
                    for (int n = 0; n < 2; ++n) { const f32x4 d = v[ai][bj][m][n] - mw; q += (d[0] * d[0] + d[1] * d[1]) + (d[2] * d[2] + d[3] * d[3]); }
                q += __shfl_xor(q, 16); q += __shfl_xor(q, 32);
                if (fq == 0) P[(ai * HALF + wr * 64 + m * 16 + fr) * 4 + wc] = (f32x2v){mw, q};
            }
        asm volatile("s_waitcnt lgkmcnt(0)" ::: "memory"); __builtin_amdgcn_s_barrier(); asm volatile("" ::: "memory");
#if defined(BROKEN_EXCHANGE_NO_WAIT)
#warning BROKEN CONTROL BUILD: the row-statistics exchange does not wait; results are wrong by design
        if (blockIdx.x >= 64) { const long long t0_ = clock64(); while (clock64() - t0_ < 60000) __builtin_amdgcn_s_sleep(8); }
#endif
        const int row = wid * 32 + (lane & 31);
        if (lane < 32) {
            const f32x2v a = P[row * 4 + 0], b = P[row * 4 + 1], c = P[row * 4 + 2], d = P[row * 4 + 3];
            const float mt = (a.x + b.x + c.x + d.x) * 0.25f;
            const float da = a.x - mt, db = b.x - mt, dc = c.x - mt, dd = d.x - mt;
            const float m2 = (a.y + b.y) + (c.y + d.y) + 64.0f * ((da * da + db * db) + (dc * dc + dd * dd));
            unsigned long long* slot = (unsigned long long*)xbuf + ((size_t)(u.pm * BM + row) * 4 + u.pn);
            __hip_atomic_store(slot, ((unsigned long long)__float_as_uint(m2) << 32) | __float_as_uint(mt), __ATOMIC_RELAXED, __HIP_MEMORY_SCOPE_AGENT);
        }
        asm volatile("s_waitcnt vmcnt(0)" ::: "memory");
        if (lane == 0) __hip_atomic_fetch_add(cnt + 64 * u.pm, 1u, __ATOMIC_RELAXED, __HIP_MEMORY_SCOPE_AGENT);
        if (wid == 0) {
            bool dead = false; const unsigned long long t0 = __builtin_amdgcn_s_memrealtime(); const unsigned want = 8u * (unsigned)ntn;
            for (;;) {
#if defined(BROKEN_EXCHANGE_NO_WAIT)
                break;
#endif
                if ((unsigned)__builtin_amdgcn_readfirstlane(__hip_atomic_load(cnt + 64 * u.pm, __ATOMIC_RELAXED, __HIP_MEMORY_SCOPE_AGENT)) >= want) break;
                if (__builtin_amdgcn_s_memrealtime() - t0 > 2000000ull) {
                    if (lane == 0) { unsigned expect = 0u; __hip_atomic_compare_exchange_strong(tmo + 1, &expect, code | (unsigned)(u.pm & 0xff), __ATOMIC_RELAXED, __ATOMIC_RELAXED, __HIP_MEMORY_SCOPE_AGENT);
                                     __hip_atomic_store(tmo, 1u, __ATOMIC_RELAXED, __HIP_MEMORY_SCOPE_AGENT); }
                    dead = true; break; }
                __builtin_amdgcn_s_sleep(2);
            }
            __builtin_amdgcn_fence(__ATOMIC_ACQUIRE, "agent");
            if (lane == 0) flag[0] = dead ? 1u : 0u;
        }
        asm volatile("s_waitcnt vmcnt(0) lgkmcnt(0)" ::: "memory"); __builtin_amdgcn_s_barrier(); asm volatile("" ::: "memory");
        const bool bad = flag[0] != 0u;
        if (lane < 32) {
            const unsigned long long* slot = (const unsigned long long*)xbuf + (size_t)(u.pm * BM + row) * 4; float mt[4], m2[4]; float ms = 0.f;
#pragma unroll
            for (int t = 0; t < 4; ++t) { if (t < ntn) { const unsigned long long w = __hip_atomic_load(slot + t, __ATOMIC_RELAXED, __HIP_MEMORY_SCOPE_AGENT); mt[t] = __uint_as_float((unsigned)w); m2[t] = __uint_as_float((unsigned)(w >> 32)); } else { mt[t] = 0.f; m2[t] = 0.f; } ms += mt[t]; }
            const float mean = ms / (float)ntn; float q = 0.f;
#pragma unroll
            for (int t = 0; t < 4; ++t) if (t < ntn) { const float dm = mt[t] - mean; q += m2[t] + 256.0f * dm * dm; }
            S[row] = (f32x2v){mean, 1.0f / sqrtf(q / (256.0f * (float)ntn) + eps)};
        }
        asm volatile("s_waitcnt lgkmcnt(0)" ::: "memory"); __builtin_amdgcn_s_barrier(); asm volatile("" ::: "memory");
        return bad;
    }
};
struct EpiLnRes {
    static constexpr bool PERM = false, AFTER_DRAIN = true;
    const float* base; float* out; int ldc; const float* bias; PanelStats st; unsigned poison;
    __device__ __forceinline__ void fused(f32x4 (&acc)[2][2][4][2], const Unit& u, int wr, int wc, int fr, int fq, PG8_LAS unsigned char* lds, int wid, int lane) const {
        typedef float f32x2v __attribute__((ext_vector_type(2)));
        const PG8_LAS f32x2v* S = (const PG8_LAS f32x2v*)(lds + 8192);
        const int col0 = u.pn * BM + wc * 32 + 4 * fq;
#pragma unroll
        for (int bj = 0; bj < 2; ++bj)
#pragma unroll
            for (int n = 0; n < 2; ++n) { const f32x4 bv = bias ? *(const f32x4*)(bias + col0 + bj * HALF + n * 16) : (f32x4){0.f, 0.f, 0.f, 0.f};
#pragma unroll
                for (int ai = 0; ai < 2; ++ai)
#pragma unroll
                    for (int m = 0; m < 4; ++m) acc[ai][bj][m][n] += bv; }
        f32x4 pre[4][2][2];
#pragma unroll
        for (int m = 0; m < 4; ++m) { const size_t off = (size_t)(u.pm * BM + wr * 64 + m * 16 + fr) * ldc + col0;
#pragma unroll
            for (int bj = 0; bj < 2; ++bj)
#pragma unroll
                for (int n = 0; n < 2; ++n) pre[m][bj][n] = *(const f32x4*)(base + off + bj * HALF + n * 16); }
        const bool bad = st.run(acc, u, wr, wc, fr, fq, lds, wid, lane) || poison != 0u;
        const float qnan = __builtin_nanf("");
#pragma unroll
        for (int ai = 0; ai < 2; ++ai)
#pragma unroll
            for (int m = 0; m < 4; ++m) { const int r = ai * HALF + wr * 64 + m * 16 + fr; const f32x2v sr = S[r]; const size_t off = (size_t)(u.pm * BM + r) * ldc + col0;
#pragma unroll
                for (int bj = 0; bj < 2; ++bj)
#pragma unroll
                    for (int n = 0; n < 2; ++n) { const f32x4 bs = ai == 0 ? pre[m][bj][n] : *(const f32x4*)(base + off + bj * HALF + n * 16); f32x4 o = bs + (acc[ai][bj][m][n] - sr.x) * sr.y;
                        if (bad) o = (f32x4){qnan, qnan, qnan, qnan}; *(f32x4*)(out + off + bj * HALF + n * 16) = o; }
                if (m & 1) asm volatile("" ::: "memory"); }
    }
};
struct EpiLnResLn {
    static constexpr bool PERM = false, AFTER_DRAIN = true;
    const float* base; float* out; bf16_t* xn; int ldc; const float* bias; PanelStats st1, st2; unsigned poison;
    __device__ __forceinline__ void fused(f32x4 (&acc)[2][2][4][2], const Unit& u, int wr, int wc, int fr, int fq, PG8_LAS unsigned char* lds, int wid, int lane) const {
        typedef float f32x2v __attribute__((ext_vector_type(2))); typedef unsigned u32x2v __attribute__((ext_vector_type(2)));
        const PG8_LAS f32x2v* S = (const PG8_LAS f32x2v*)(lds + 8192);
        const int col0 = u.pn * BM + wc * 32 + 4 * fq;
#pragma unroll
        for (int bj = 0; bj < 2; ++bj)
#pragma unroll
            for (int n = 0; n < 2; ++n) { const f32x4 bv = bias ? *(const f32x4*)(bias + col0 + bj * HALF + n * 16) : (f32x4){0.f, 0.f, 0.f, 0.f};
#pragma unroll
                for (int ai = 0; ai < 2; ++ai)
#pragma unroll
                    for (int m = 0; m < 4; ++m) acc[ai][bj][m][n] += bv; }
        bool bad = st1.run(acc, u, wr, wc, fr, fq, lds, wid, lane) || poison != 0u;
        const float qnan = __builtin_nanf("");
#pragma unroll
        for (int ai = 0; ai < 2; ++ai)
#pragma unroll
            for (int m = 0; m < 4; ++m) { const int r = ai * HALF + wr * 64 + m * 16 + fr; const f32x2v sr = S[r]; const size_t off = (size_t)(u.pm * BM + r) * ldc + col0;
#pragma unroll
                for (int bj = 0; bj < 2; ++bj)
#pragma unroll
                    for (int n = 0; n < 2; ++n) { const f32x4 bs = *(const f32x4*)(base + off + bj * HALF + n * 16); acc[ai][bj][m][n] = bs + (acc[ai][bj][m][n] - sr.x) * sr.y; }
                asm volatile("" : "+v"(acc[ai][0][m][0]), "+v"(acc[ai][0][m][1]), "+v"(acc[ai][1][m][0]), "+v"(acc[ai][1][m][1]));
                if (m & 1) asm volatile("" ::: "memory"); }
        const bool bad1 = bad;
        bad = st2.run(acc, u, wr, wc, fr, fq, lds, wid, lane) || bad;
#pragma unroll
        for (int ai = 0; ai < 2; ++ai)
#pragma unroll
            for (int m = 0; m < 4; ++m) { const int r = ai * HALF + wr * 64 + m * 16 + fr; const f32x2v sr = S[r]; const size_t off = (size_t)(u.pm * BM + r) * ldc + col0;
#pragma unroll
                for (int bj = 0; bj < 2; ++bj)
#pragma unroll
                    for (int n = 0; n < 2; ++n) { const f32x4 x1 = acc[ai][bj][m][n]; *(f32x4*)(out + off + bj * HALF + n * 16) = bad1 ? (f32x4){qnan, qnan, qnan, qnan} : x1;
                        const f32x4 o = (x1 - sr.x) * sr.y; u32x2v w; w.x = cvt_pk_bf16(o[0], o[1]); w.y = cvt_pk_bf16(o[2], o[3]);
                        if (bad) { w.x = 0x7fc07fc0u; w.y = 0x7fc07fc0u; } *(u32x2v*)(xn + off + bj * HALF + n * 16) = w; }
                asm volatile("" ::: "memory"); }
    }
};

template <class Epi, class Sched, bool ALIGN_EPI = false, bool SP2 = false>
__device__ __forceinline__ void gemm_phase(PG8_LAS unsigned char* lds, const Gemm g, const Sched& S, const Epi& E) {
    const int tid = threadIdx.x, wid = __builtin_amdgcn_readfirstlane(tid >> 6), lane = tid & 63, wr = wid >> 2, wc = wid & 3, fr = lane & 15, fq = lane >> 4;
    const int K = g.K, nt = K / BK;
    unsigned voffA[2], voffB[2];
#pragma unroll
    for (int i = 0; i < 2; ++i) { int R, C; stage_rc(tid * 16 + i * 8192, R, C); const int Rb = Epi::PERM ? ((R & ~31) + perm32(R & 31)) : R;
        voffA[i] = (unsigned)(R * K + C) * 2u; voffB[i] = (unsigned)(Rb * K + C) * 2u; }
    const size_t kstep = (size_t)(BK * 2);
    const size_t hstep = (size_t)HALF * K * 2;
    const size_t tstep = 2 * hstep;
    const unsigned ldsw = (unsigned)wid * 1024u;
    const int aoff = lds_byte(wr * 64 + fr, fq * 8), boff = lds_byte(wc * 32 + fr, fq * 8);
#define PG8_SA(b, h) (((b) * 2 + (h)) * HTB)
#define PG8_SB(b, h) ((4 + (b) * 2 + (h)) * HTB)
#define PG8_STAGE(bufoff, gbase, voff) do { _Pragma("unroll") for (int _i = 0; _i < 2; ++_i) \
        __builtin_amdgcn_global_load_lds((const unsigned*)((const char*)(gbase) + (voff)[_i]), (PG8_LAS unsigned*)(lds + (bufoff) + ldsw + _i * 8192), 16, 0, 0); } while (0)
#define PG8_LDA(dst, b, h) do { _Pragma("unroll") for (int m = 0; m < 4; ++m) _Pragma("unroll") for (int k = 0; k < 2; ++k) dst[m][k] = *(const PG8_LAS bf16x8*)(lds + PG8_SA(b, h) + aoff + m * 2048 + k * 1024); } while (0)
#define PG8_LDB(dst, b, h) do { _Pragma("unroll") for (int n = 0; n < 2; ++n) _Pragma("unroll") for (int k = 0; k < 2; ++k) dst[n][k] = *(const PG8_LAS bf16x8*)(lds + PG8_SB(b, h) + boff + n * 2048 + k * 1024); } while (0)
#define PG8_MMA(ai, bj, At, Bt) do { __builtin_amdgcn_s_setprio(1); _Pragma("unroll") for (int m = 0; m < 4; ++m) _Pragma("unroll") for (int n = 0; n < 2; ++n) _Pragma("unroll") for (int k = 0; k < 2; ++k) \
        acc[ai][bj][m][n] = __builtin_amdgcn_mfma_f32_16x16x32_bf16(Bt[n][k], At[m][k], acc[ai][bj][m][n], 0, 0, 0); __builtin_amdgcn_s_setprio(0); } while (0)
#define PG8_WAIT_V(n) asm volatile("s_waitcnt vmcnt(" #n ")" ::: "memory")
#define PG8_WAIT_L(n) asm volatile("s_waitcnt lgkmcnt(" #n ")" ::: "memory")
#define PG8_BAR __builtin_amdgcn_s_barrier()
#define PG8_SCHED __builtin_amdgcn_sched_barrier(0)
    Unit cur, nxt; int ui = 0;
    if (!S.next(0, cur)) return;
    f32x4 acc[2][2][4][2];
#pragma unroll
    for (int a = 0; a < 2; ++a)
#pragma unroll
        for (int b = 0; b < 2; ++b)
#pragma unroll
            for (int m = 0; m < 4; ++m)
#pragma unroll
                for (int n = 0; n < 2; ++n) acc[a][b][m][n] = (f32x4){0.f, 0.f, 0.f, 0.f};
    bf16x8 At[4][2], B0[2][2], B1[2][2];
    const char* cA = (const char*)g.A + (size_t)cur.pm * tstep; const char* cB = (const char*)g.Bt + (size_t)cur.pn * tstep;
    S.a_ready(cur);
    if constexpr (SP2) {
        PG8_STAGE(PG8_SB(0, 0), cB, voffB); PG8_STAGE(PG8_SB(0, 1), cB + hstep, voffB); PG8_STAGE(PG8_SA(0, 0), cA, voffA); PG8_STAGE(PG8_SA(0, 1), cA + hstep, voffA);
        if (wr == 1) PG8_BAR;
        PG8_WAIT_V(2); PG8_BAR;
        PG8_STAGE(PG8_SB(1, 0), cB + kstep, voffB); PG8_STAGE(PG8_SA(1, 0), cA + kstep, voffA); PG8_STAGE(PG8_SB(1, 1), cB + hstep + kstep, voffB);
        PG8_WAIT_V(6); PG8_BAR;
    } else {
        PG8_STAGE(PG8_SB(0, 0), cB, voffB); PG8_STAGE(PG8_SA(0, 0), cA, voffA); PG8_STAGE(PG8_SB(0, 1), cB + hstep, voffB); PG8_STAGE(PG8_SA(0, 1), cA + hstep, voffA);
        if (wr == 1) PG8_BAR;
        PG8_WAIT_V(4); PG8_BAR;
        PG8_STAGE(PG8_SB(1, 0), cB + kstep, voffB); PG8_STAGE(PG8_SA(1, 0), cA + kstep, voffA); PG8_STAGE(PG8_SB(1, 1), cB + hstep + kstep, voffB);
        PG8_WAIT_V(6); PG8_BAR;
    }
    for (;;) {
        const bool has_next = S.next(ui + 1, nxt);
        const char* nA = has_next ? (const char*)g.A + (size_t)nxt.pm * tstep : cA; const char* nB = has_next ? (const char*)g.Bt + (size_t)nxt.pn * tstep : cB;
        for (int t = 0; t < nt; t += 2) {
            const bool last = (t == nt - 2);
            const char* a1 = cA + (size_t)(t + 1) * kstep;
            const char* a2 = last ? nA : cA + (size_t)(t + 2) * kstep; const char* b2 = last ? nB : cB + (size_t)(t + 2) * kstep;
            const char* a3 = a2 + kstep; const char* b3 = b2 + kstep;
            if (last && has_next) S.a_ready(nxt);
            if constexpr (SP2) {
            PG8_LDB(B0, 0, 0); PG8_LDB(B1, 0, 1); PG8_SCHED; PG8_LDA(At, 0, 0); PG8_STAGE(PG8_SA(1, 1), a1 + hstep, voffA);
            PG8_WAIT_V(8); PG8_WAIT_L(0); PG8_BAR; PG8_MMA(0, 0, At, B0); PG8_MMA(0, 1, At, B1); PG8_BAR; PG8_SCHED;
            PG8_LDA(At, 0, 1); PG8_STAGE(PG8_SB(0, 0), b2, voffB); PG8_STAGE(PG8_SB(0, 1), b2 + hstep, voffB); PG8_STAGE(PG8_SA(0, 0), a2, voffA);
            PG8_WAIT_V(8); PG8_WAIT_L(0); PG8_BAR; PG8_MMA(1, 0, At, B0); PG8_MMA(1, 1, At, B1); PG8_BAR; PG8_SCHED;
            PG8_LDB(B0, 1, 0); PG8_LDB(B1, 1, 1); PG8_SCHED; PG8_LDA(At, 1, 0); PG8_STAGE(PG8_SA(0, 1), a2 + hstep, voffA);
            PG8_WAIT_V(8); PG8_WAIT_L(0); PG8_BAR; PG8_MMA(0, 0, At, B0); PG8_MMA(0, 1, At, B1); PG8_BAR; PG8_SCHED;
            PG8_LDA(At, 1, 1); PG8_STAGE(PG8_SB(1, 0), b3, voffB); PG8_STAGE(PG8_SB(1, 1), b3 + hstep, voffB); PG8_STAGE(PG8_SA(1, 0), a3, voffA);
            PG8_WAIT_V(8); PG8_WAIT_L(0); PG8_BAR; PG8_MMA(1, 0, At, B0); PG8_MMA(1, 1, At, B1); PG8_BAR; PG8_SCHED;
            } else {
            PG8_LDB(B0, 0, 0); PG8_SCHED; PG8_LDA(At, 0, 0); PG8_STAGE(PG8_SA(1, 1), a1 + hstep, voffA);
            PG8_WAIT_L(8); PG8_BAR; PG8_WAIT_L(0); PG8_MMA(0, 0, At, B0); PG8_BAR; PG8_SCHED;
            PG8_LDB(B1, 0, 1); PG8_STAGE(PG8_SB(0, 0), b2, voffB);
            PG8_BAR; PG8_WAIT_L(0); PG8_MMA(0, 1, At, B1); PG8_BAR;
            PG8_LDA(At, 0, 1); PG8_STAGE(PG8_SA(0, 0), a2, voffA);
            PG8_BAR; PG8_WAIT_L(0); PG8_MMA(1, 0, At, B0); PG8_BAR; PG8_SCHED;
            PG8_STAGE(PG8_SB(0, 1), b2 + hstep, voffB);
            PG8_WAIT_V(6); PG8_BAR; PG8_MMA(1, 1, At, B1); PG8_BAR;
            PG8_LDB(B0, 1, 0); PG8_SCHED; PG8_LDA(At, 1, 0); PG8_STAGE(PG8_SA(0, 1), a2 + hstep, voffA);
            PG8_WAIT_L(8); PG8_BAR; PG8_WAIT_L(0); PG8_MMA(0, 0, At, B0); PG8_BAR; PG8_SCHED;
            PG8_LDB(B1, 1, 1); PG8_STAGE(PG8_SB(1, 0), b3, voffB);
            PG8_BAR; PG8_WAIT_L(0); PG8_MMA(0, 1, At, B1); PG8_BAR;
            PG8_LDA(At, 1, 1); PG8_STAGE(PG8_SA(1, 0), a3, voffA);
            PG8_BAR; PG8_WAIT_L(0); PG8_MMA(1, 0, At, B0); PG8_BAR; PG8_SCHED;
            PG8_STAGE(PG8_SB(1, 1), b3 + hstep, voffB);
            PG8_WAIT_V(6); PG8_BAR; PG8_MMA(1, 1, At, B1); PG8_BAR;
            }
        }
        if constexpr (ALIGN_EPI) { if (wr == 0) PG8_BAR; }
        if constexpr (!Epi::AFTER_DRAIN) { E(acc, cur, wr, wc, fr, fq); S.done(cur); }
        if (!has_next) break;
#pragma unroll
        for (int a = 0; a < 2; ++a)
#pragma unroll
            for (int b = 0; b < 2; ++b)
#pragma unroll
                for (int m = 0; m < 4; ++m)
#pragma unroll
                    for (int n = 0; n < 2; ++n) acc[a][b][m][n] = (f32x4){0.f, 0.f, 0.f, 0.f};
        cur = nxt; cA = nA; cB = nB; ++ui;
        if constexpr (ALIGN_EPI) { if (wr == 1) PG8_BAR; }
    }
    PG8_WAIT_V(0);
    if constexpr (!ALIGN_EPI) { if (wr == 0) PG8_BAR; }
    PG8_BAR;
    if constexpr (Epi::AFTER_DRAIN) { E.fused(acc, cur, wr, wc, fr, fq, lds, wid, lane); S.done(cur); }
#undef PG8_SA
#undef PG8_SB
#undef PG8_STAGE
#undef PG8_LDA
#undef PG8_LDB
#undef PG8_MMA
#undef PG8_WAIT_V
#undef PG8_WAIT_L
#undef PG8_BAR
#undef PG8_SCHED
}
}
#ifndef PG8_SP2
#define PG8_SP2 true
#endif
#ifndef PG8_ALIGN
#define PG8_ALIGN true
#endif
namespace pg8 {
struct EpiF32 {
    static constexpr bool PERM = false, AFTER_DRAIN = false;
    float* O; int ldc; const float* base; float alpha;
    __device__ __forceinline__ void operator()(const f32x4 (&acc)[2][2][4][2], const Unit& u, int wr, int wc, int fr, int fq) const {
        const int col0 = u.pn * BM + wc * 32 + 4 * fq;
#pragma unroll
        for (int ai = 0; ai < 2; ++ai)
#pragma unroll
            for (int m = 0; m < 4; ++m) { const size_t off = (size_t)(u.pm * BM + ai * HALF + wr * 64 + m * 16 + fr) * ldc + col0;
#pragma unroll
                for (int bj = 0; bj < 2; ++bj)
#pragma unroll
                    for (int n = 0; n < 2; ++n) { f32x4 v = acc[ai][bj][m][n];
                        if (base) { const f32x4 bs = *(const f32x4*)(base + off + bj * HALF + n * 16); v = v + bs * alpha; }
                        *(f32x4*)(O + off + bj * HALF + n * 16) = v; } }
    }
};
}

#include <hip/hip_bf16.h>
#include <cmath>
namespace attn_body {
using bf16=__hip_bfloat16;
using bf16x8=__attribute__((ext_vector_type(8)))short;
using s16x4=__attribute__((ext_vector_type(4)))short;
using f32x16=__attribute__((ext_vector_type(16)))float;
using u32x4=__attribute__((ext_vector_type(4)))unsigned;
constexpr int BATCH=4,NHEAD=16,SEQ=4096,D=64,DM=NHEAD*D;
constexpr int NW=8,QBLK=32,QB=QBLK*NW,KVBLK=64,NQB=SEQ/QB;
constexpr int ATTN_PITCH=DM, ATTN_UNIT_ROWS=QB;
__device__ __forceinline__ int crow(int r,int hi){return (r&3)+8*(r>>2)+4*hi;}
#define SBAR() __builtin_amdgcn_sched_barrier(0)
__device__ __forceinline__ void cmask(f32x16&p0,f32x16&p1,int jb,int qrel,int hi){
  const float NEG=-INFINITY; int kb=64*jb+4*hi;
  #pragma unroll
  for(int r=0;r<16;++r){int kv=kb+(r&3)+8*(r>>2); if(kv>qrel)p0[r]=NEG; if(kv+32>qrel)p1[r]=NEG;}
}

constexpr int NSLOT=3, SLOTB=8192;
constexpr int LDS_K=0, LDS_V=NSLOT*SLOTB, LDS_WS=2*NSLOT*SLOTB, LDS_OST=LDS_WS+NW*64*4, LDS_BYTES=LDS_OST+NW*4096;
constexpr float C2=0.125f*1.4426950408889634f;
__device__ __forceinline__ void glds16(const void*gsrc,unsigned lds_dst){unsigned keep;
  asm volatile("s_mov_b32 %0, m0\n\ts_mov_b32 m0, %2\n\ts_nop 0\n\tglobal_load_lds_dwordx4 %1, off\n\ts_mov_b32 m0, %0":"=&s"(keep):"v"(gsrc),"s"(lds_dst):"memory");}
__device__ __forceinline__ float max3f(float a,float b,float c){float r;asm("v_max3_f32 %0, %1, %2, %3":"=v"(r):"v"(a),"v"(b),"v"(c));return r;}
__device__ __forceinline__ float max2f(float a,float b){float r;asm("v_max_f32_e32 %0, %1, %2":"=v"(r):"v"(a),"v"(b));return r;}
__device__ __forceinline__ float fadd_s(float a,float b){float r;asm("v_add_f32_e32 %0, %1, %2":"=v"(r):"v"(a),"v"(b));return r;}
__device__ __forceinline__ float fsub_s(float a,float b){float r;asm("v_sub_f32_e32 %0, %1, %2":"=v"(r):"v"(a),"v"(b));return r;}
typedef float f32x2_t __attribute__((ext_vector_type(2))); typedef __bf16 bf16x2_t __attribute__((ext_vector_type(2)));
__device__ __forceinline__ unsigned cvtpk_s(float lo,float hi){f32x2_t v={lo,hi};bf16x2_t b=__builtin_convertvector(v,bf16x2_t);return __builtin_bit_cast(unsigned,b);}
#define WAIT_BAR(N) asm volatile("s_waitcnt vmcnt(" #N ") lgkmcnt(0)\n\ts_barrier":::"memory")

__device__ __forceinline__ void qkt(f32x16&p0,f32x16&p1,const char*Kslot,const bf16x8*qr,const f32x16&negm,int r32,int hi){
  const char*kb=Kslot+hi*1024+r32*16;
  #pragma unroll
  for(int d0=0;d0<4;++d0){
    const bf16x8 b0=*reinterpret_cast<const bf16x8*>(kb+d0*2048);
    const bf16x8 b1=*reinterpret_cast<const bf16x8*>(kb+d0*2048+512);
    if(d0==0){p0=__builtin_amdgcn_mfma_f32_32x32x16_bf16(b0,qr[0],negm,0,0,0);p1=__builtin_amdgcn_mfma_f32_32x32x16_bf16(b1,qr[0],negm,0,0,0);}
    else{p0=__builtin_amdgcn_mfma_f32_32x32x16_bf16(b0,qr[d0],p0,0,0,0);p1=__builtin_amdgcn_mfma_f32_32x32x16_bf16(b1,qr[d0],p1,0,0,0);}}
}
typedef __attribute__((address_space(3))) const char* lds_cptr;
typedef short v4i16_t __attribute__((ext_vector_type(4)));
__device__ __forceinline__ void kload8(bf16x8*kf,lds_cptr kp){
  kf[0]=*(const __attribute__((address_space(3))) bf16x8*)(kp);      kf[1]=*(const __attribute__((address_space(3))) bf16x8*)(kp+512);
  kf[2]=*(const __attribute__((address_space(3))) bf16x8*)(kp+2048); kf[3]=*(const __attribute__((address_space(3))) bf16x8*)(kp+2560);
  kf[4]=*(const __attribute__((address_space(3))) bf16x8*)(kp+4096); kf[5]=*(const __attribute__((address_space(3))) bf16x8*)(kp+4608);
  kf[6]=*(const __attribute__((address_space(3))) bf16x8*)(kp+6144); kf[7]=*(const __attribute__((address_space(3))) bf16x8*)(kp+6656);
}
__device__ __forceinline__ void kload2(bf16x8*kf,lds_cptr kp,int j){ kf[2*j]=*(const __attribute__((address_space(3))) bf16x8*)(kp+j*2048); kf[2*j+1]=*(const __attribute__((address_space(3))) bf16x8*)(kp+j*2048+512); }
__device__ __forceinline__ s16x4 vtr(lds_cptr p){ return __builtin_bit_cast(s16x4,__builtin_amdgcn_ds_read_tr16_b64_v4i16((__attribute__((address_space(3))) v4i16_t*)p)); }
__device__ __forceinline__ float rowmax(const f32x16&p0,const f32x16&p1){
  float a=max3f(p0[0],p0[1],p1[0]),b=max3f(p0[2],p0[3],p1[1]);a=max3f(a,p1[2],p1[3]);
  #pragma unroll
  for(int r=4;r<16;r+=4){a=max3f(a,p0[r],p0[r+1]);b=max3f(b,p0[r+2],p0[r+3]);a=max3f(a,p1[r],p1[r+1]);b=max3f(b,p1[r+2],p1[r+3]);}
  const float m=max2f(a,b);
  auto rr=__builtin_amdgcn_permlane32_swap(__float_as_uint(m),__float_as_uint(m),false,false);
  return max2f(__uint_as_float(rr[0]),__uint_as_float(rr[1]));
}
__device__ __forceinline__ void pv(f32x16*o,int vb,bf16x8 pa0,bf16x8 pa1,bf16x8 pa2,bf16x8 pa3){
  #pragma unroll
  for(int d0=0;d0<2;++d0){s16x4 lo[4],hi[4];
    #pragma unroll
    for(int ks=0;ks<4;++ks){
      asm volatile("ds_read_b64_tr_b16 %0,%1 offset:%c2":"=&v"(lo[ks]):"v"(vb),"i"(d0*4096+ks*1024):"memory");
      asm volatile("ds_read_b64_tr_b16 %0,%1 offset:%c2":"=&v"(hi[ks]):"v"(vb),"i"(d0*4096+ks*1024+512):"memory");}
    asm volatile("s_waitcnt lgkmcnt(0)":::"memory");SBAR();
    #define PK(k) (bf16x8){lo[k][0],lo[k][1],lo[k][2],lo[k][3],hi[k][0],hi[k][1],hi[k][2],hi[k][3]}
    o[d0]=__builtin_amdgcn_mfma_f32_32x32x16_bf16(pa0,PK(0),o[d0],0,0,0);
    o[d0]=__builtin_amdgcn_mfma_f32_32x32x16_bf16(pa1,PK(1),o[d0],0,0,0);
    o[d0]=__builtin_amdgcn_mfma_f32_32x32x16_bf16(pa2,PK(2),o[d0],0,0,0);
    o[d0]=__builtin_amdgcn_mfma_f32_32x32x16_bf16(pa3,PK(3),o[d0],0,0,0);
    #undef PK
  }
}

#ifndef ATTN_STORE16
#define ATTN_STORE16(p,v) (*(u32x4*)(p)=(v))
#endif
template<int THRL> __device__ __forceinline__ void attn_unit(int b,int h,int hv,float sl2,int qb,const bf16*Q,const bf16*__restrict__ K,const bf16*__restrict__ V,bf16*O,char*shm){
  const int tid=threadIdx.x,lane=tid&63,r32=lane&31,hi=lane>>5; const int wid=__builtin_amdgcn_readfirstlane(tid>>6);
  const long rowbase=(long)b*SEQ; const int q0=qb*QB;
  const bf16*Qw=Q+(rowbase+q0+wid*QBLK)*DM+h*D;
  const bf16*Kh=K+rowbase*DM+h*D,*Vh=V+rowbase*DM+hv*D;
  const unsigned lds0=(unsigned)(uintptr_t)shm;
  float*wsf=(float*)(shm+LDS_WS)+wid*64;
  const bf16*ksrc=Kh+(long)lane*DM+wid*8;
  const bf16*vsrc=Vh+(long)(16*(wid&3)+(lane>>2))*DM+(wid>>2)*32+(lane&3)*8;
  const unsigned kdst=lds0+LDS_K+wid*1024, vdst=lds0+LDS_V+wid*1024;
  #define DMA_K(t,slot) glds16(ksrc+(long)(t)*KVBLK*DM,(unsigned)__builtin_amdgcn_readfirstlane(kdst+(slot)))
  #define DMA_V(t,slot) glds16(vsrc+(long)(t)*KVBLK*DM,(unsigned)__builtin_amdgcn_readfirstlane(vdst+(slot)))
  const int vb0=(int)(lds0+LDS_V)+((lane>>4)&1)*32+(lane&3)*8+(4*hi+((lane&15)>>2))*64;
  const char*Kbase=shm+LDS_K; bf16x8 kf[8];
  const lds_cptr shm3=(lds_cptr)shm; const lds_cptr kp0=shm3+LDS_K+hi*1024+r32*16; const lds_cptr vp0=shm3+LDS_V+((lane>>4)&1)*32+(lane&3)*8+(4*hi+((lane&15)>>2))*64;
  const int NT=(q0+QB)/KVBLK;
  DMA_K(0,0);DMA_V(0,0);DMA_K(1,SLOTB);
  bf16x8 qr[4];
  #pragma unroll
  for(int d0=0;d0<4;++d0)qr[d0]=*reinterpret_cast<const bf16x8*>(&Qw[(long)r32*DM+d0*16+hi*8]);
  float mhat=0.f,l_reg=0.f;f32x16 o[2];o[0]=f32x16{};o[1]=f32x16{};f32x16 negm; { const float nb0_=sl2*(float)(4*hi-q0); _Pragma("unroll") for(int r=0;r<16;++r)negm[r]=nb0_; } asm volatile("":"+v"(negm));
  #define NB(tt) __builtin_fmaf(sl2,(float)(64*(tt)-q0+4*hi),-mhat)
  #define ALIBI(P0,P1) do{ _Pragma("unroll") for(int r=0;r<16;++r){ P0[r]=__builtin_fmaf(sl2,(float)((r&3)+8*(r>>2)),P0[r]); P1[r]=__builtin_fmaf(sl2,(float)(32+(r&3)+8*(r>>2)),P1[r]); } }while(0)
  const int qrel=wid*QBLK+r32;
  #define CMASK(P0,P1,t) do{int jb_=(t)-(NT-4); if(jb_>=0)cmask(P0,P1,jb_,qrel,hi);}while(0)
  bool resc=false;
  #define START(P0,P1) do{ const float rm=rowmax(P0,P1); resc=false; \
    { const float dl=rm; mhat=fadd_s(mhat,dl); \
      _Pragma("unroll") for(int r=0;r<16;++r){P0[r]=fsub_s(P0[r],dl);P1[r]=fsub_s(P1[r],dl);} \
      { const float nb_=NB(1); _Pragma("unroll") for(int r=0;r<16;++r)negm[r]=nb_; } asm volatile("":"+v"(negm)); } \
    _Pragma("unroll") for(int r=0;r<16;++r)P0[r]=__builtin_amdgcn_exp2f(P0[r]); }while(0)
  #define RESC() do{ if(resc){ asm volatile("s_waitcnt lgkmcnt(0)":::"memory"); \
      _Pragma("unroll") for(int d_=0;d_<2;++d_) _Pragma("unroll") for(int r=0;r<16;++r)o[d_][r]*=wsf[crow(r,hi)]; } }while(0)
  f32x16 pA0,pA1,pB0,pB1;
  int sl_prev=0,sl_cur=0,sl_next=SLOTB;
  #define ROT() do{sl_prev=sl_cur;sl_cur=sl_next;sl_next=(sl_next==(NSLOT-1)*SLOTB)?0:sl_next+SLOTB;}while(0)
  DMA_K(2,2*SLOTB);
  WAIT_BAR(3);
  qkt(pA0,pA1,Kbase,qr,negm,r32,hi);asm volatile("s_nop 15\n\ts_nop 7":"+v"(pA0),"+v"(pA1));ALIBI(pA0,pA1);CMASK(pA0,pA1,0);
  START(pA0,pA1);
  _Pragma("unroll") for(int r=0;r<16;++r)pA1[r]=__builtin_amdgcn_exp2f(pA1[r]);
  WAIT_BAR(0);
  DMA_K(3,0);DMA_V(1,SLOTB);
  ROT();
  kload8(kf,kp0+sl_cur);
  WAIT_BAR(2);
  s16x4 vlo[8],vhi[8]; u32x4 pw0,pw1,pw2,pw3;
  #define PKW(P,B) cvtpk_s(P[B],P[B+1])
  #define PAF(k) __builtin_bit_cast(bf16x8,pw##k)
  #define VFR(i) (bf16x8){vlo[i][0],vlo[i][1],vlo[i][2],vlo[i][3],vhi[i][0],vhi[i][1],vhi[i][2],vhi[i][3]}
  #define PIN(x) asm volatile("":"+v"(x))
  #define MX3(a,b,c) __builtin_fmaxf(__builtin_fmaxf((a),(b)),(c))
  #define GAPA(MF,A0,A1,A2,A3,W0,W1,PW) do{ MF; sacc+=A0; sacc+=A1; sacc+=A2; sacc+=A3; PIN(sacc); W0; W1; PIN(PW); SBAR(); }while(0)
  #define EX(v) __builtin_amdgcn_exp2f(v)
  #define GAPB(MF,X,B) do{ MF; X[B]=EX(X[B]); X[B+1]=EX(X[B+1]); X[B+2]=EX(X[B+2]); X[B+3]=EX(X[B+3]); PIN(X); SBAR(); }while(0)
  #define VRD(i) do{ vlo[i]=vtr(vp_+(((i)>>2)*4096+((i)&3)*1024)); vhi[i]=vtr(vp_+(((i)>>2)*4096+((i)&3)*1024+512)); }while(0)
  #define KRD(G,j) do{ if(G){ kload2(kf,kp0+sl_next,j); SBAR(); } }while(0)
  #define STEP(C0,C1,P0,P1,t,GK,GV,GL) do{ SBAR(); \
    const lds_cptr vp_=vp0+sl_prev; \
    VRD(0); SBAR(); float sacc=(P0[0]+P0[1]); \
    GAPA(C0=__builtin_amdgcn_mfma_f32_32x32x16_bf16(kf[0],qr[0],negm,0,0,0), P0[2],P0[3],P0[4],P0[5],     pw0[0]=PKW(P0,0), pw0[1]=PKW(P0,2), pw0); \
    VRD(4); SBAR(); GAPA(C1=__builtin_amdgcn_mfma_f32_32x32x16_bf16(kf[1],qr[0],negm,0,0,0), P0[6],P0[7],P0[8],P0[9],     pw0[2]=PKW(P0,4), pw0[3]=PKW(P0,6), pw0); \
    VRD(1); SBAR(); GAPA(C0=__builtin_amdgcn_mfma_f32_32x32x16_bf16(kf[2],qr[1],C0,0,0,0),   P0[10],P0[11],P0[12],P0[13], pw1[0]=PKW(P0,8), pw1[1]=PKW(P0,10), pw1); \
    VRD(5); SBAR(); GAPA(C1=__builtin_amdgcn_mfma_f32_32x32x16_bf16(kf[3],qr[1],C1,0,0,0),   P0[14],P0[15],P1[0],P1[1],   pw1[2]=PKW(P0,12),pw1[3]=PKW(P0,14), pw1); \
    VRD(2); SBAR(); GAPA(C0=__builtin_amdgcn_mfma_f32_32x32x16_bf16(kf[4],qr[2],C0,0,0,0),   P1[2],P1[3],P1[4],P1[5],     pw2[0]=PKW(P1,0), pw2[1]=PKW(P1,2), pw2); \
    VRD(6); SBAR(); GAPA(C1=__builtin_amdgcn_mfma_f32_32x32x16_bf16(kf[5],qr[2],C1,0,0,0),   P1[6],P1[7],P1[8],P1[9],     pw2[2]=PKW(P1,4), pw2[3]=PKW(P1,6), pw2); \
    VRD(3); SBAR(); GAPA(C0=__builtin_amdgcn_mfma_f32_32x32x16_bf16(kf[6],qr[3],C0,0,0,0),   P1[10],P1[11],P1[12],P1[13], pw3[0]=PKW(P1,8), pw3[1]=PKW(P1,10), pw3); \
    VRD(7); SBAR(); GAPA(C1=__builtin_amdgcn_mfma_f32_32x32x16_bf16(kf[7],qr[3],C1,0,0,0),   P1[14],P1[15],0.f,0.f,       pw3[2]=PKW(P1,12),pw3[3]=PKW(P1,14), pw3); \
    l_reg+=sacc; \
    if(GK){DMA_K((t)+3,sl_cur);} if(GV){DMA_V((t)+1,sl_next);} \
    ALIBI(C0,C1); CMASK(C0,C1,t); \
    { float a=MX3(C0[0],C0[1],C1[0]),b=MX3(C0[2],C0[3],C1[1]); a=MX3(a,C1[2],C1[3]); \
      _Pragma("unroll") for(int r=4;r<16;r+=4){a=MX3(a,C0[r],C0[r+1]);b=MX3(b,C0[r+2],C0[r+3]);a=MX3(a,C1[r],C1[r+1]);b=MX3(b,C1[r+2],C1[r+3]);} \
      float rm=__builtin_fmaxf(a,b); { auto rr=__builtin_amdgcn_permlane32_swap(__float_as_uint(rm),__float_as_uint(rm),false,false); rm=__builtin_fmaxf(__uint_as_float(rr[0]),__uint_as_float(rr[1])); } \
      resc=false; \
      if(__builtin_expect(__any(rm>(float)THRL),0)){ const float dl=__builtin_fmaxf(rm,0.f); mhat+=dl; \
        _Pragma("unroll") for(int r=0;r<16;++r){C0[r]-=dl;C1[r]-=dl;} \
        const float f=__builtin_amdgcn_exp2f(-dl); l_reg*=f; if(hi==0)wsf[r32]=f; resc=true; } \
      { const float nb_=NB((t)+1); _Pragma("unroll") for(int r=0;r<16;++r)negm[r]=nb_; asm volatile("":"+v"(negm)); } } \
    SBAR(); \
    GAPB(o[0]=__builtin_amdgcn_mfma_f32_32x32x16_bf16(PAF(0),VFR(0),o[0],0,0,0), C0,0); \
    GAPB(o[1]=__builtin_amdgcn_mfma_f32_32x32x16_bf16(PAF(0),VFR(4),o[1],0,0,0), C0,4); \
    KRD(GL,0); GAPB(o[0]=__builtin_amdgcn_mfma_f32_32x32x16_bf16(PAF(1),VFR(1),o[0],0,0,0), C0,8); \
    KRD(GL,1); GAPB(o[1]=__builtin_amdgcn_mfma_f32_32x32x16_bf16(PAF(1),VFR(5),o[1],0,0,0), C0,12); \
    KRD(GL,2); GAPB(o[0]=__builtin_amdgcn_mfma_f32_32x32x16_bf16(PAF(2),VFR(2),o[0],0,0,0), C1,0); \
    KRD(GL,3); GAPB(o[1]=__builtin_amdgcn_mfma_f32_32x32x16_bf16(PAF(2),VFR(6),o[1],0,0,0), C1,4); \
    GAPB(o[0]=__builtin_amdgcn_mfma_f32_32x32x16_bf16(PAF(3),VFR(3),o[0],0,0,0), C1,8); \
    GAPB(o[1]=__builtin_amdgcn_mfma_f32_32x32x16_bf16(PAF(3),VFR(7),o[1],0,0,0), C1,12); \
    }while(0)
  int t=1;
  #undef CMASK
  #define CMASK(P0,P1,t) do{}while(0)
  for(;t+5<NT;t+=2){
    STEP(pB0,pB1,pA0,pA1,t,true,true,true);     WAIT_BAR(2); RESC(); ROT();
    STEP(pA0,pA1,pB0,pB1,t+1,true,true,true);   WAIT_BAR(2); RESC(); ROT();
  }
  #undef CMASK
  #define CMASK(P0,P1,t) do{int jb_=(t)-(NT-4); if(jb_>=0)cmask(P0,P1,jb_,qrel,hi);}while(0)
  #define ENDW(tt) do{ if((tt)+3<NT){WAIT_BAR(2);} else if((tt)+2<NT){WAIT_BAR(1);} else {WAIT_BAR(0);} }while(0)
  for(;t+1<NT;t+=2){
    STEP(pB0,pB1,pA0,pA1,t,(t+3<NT),(t+1<NT),(t+1<NT));       ENDW(t);   RESC(); ROT();
    STEP(pA0,pA1,pB0,pB1,t+1,(t+4<NT),(t+2<NT),(t+2<NT));     ENDW(t+1); RESC(); ROT();
  }
  STEP(pB0,pB1,pA0,pA1,NT-1,false,false,false); RESC();
  { float sacc=pB0[0]+pB0[1]; _Pragma("unroll") for(int r=2;r<16;++r)sacc+=pB0[r]; _Pragma("unroll") for(int r=0;r<16;++r)sacc+=pB1[r]; l_reg+=sacc;
    pw0=(u32x4){PKW(pB0,0),PKW(pB0,2),PKW(pB0,4),PKW(pB0,6)};pw1=(u32x4){PKW(pB0,8),PKW(pB0,10),PKW(pB0,12),PKW(pB0,14)};pw2=(u32x4){PKW(pB1,0),PKW(pB1,2),PKW(pB1,4),PKW(pB1,6)};pw3=(u32x4){PKW(pB1,8),PKW(pB1,10),PKW(pB1,12),PKW(pB1,14)};
    SBAR(); pv(o,vb0+sl_cur,PAF(0),PAF(1),PAF(2),PAF(3)); }
  #undef PKW
  #undef PAF
  #undef VFR
  #undef PIN
  #undef MX3
  #undef GAPA
  #undef GAPB
  #undef EX
  #undef VRD
  #undef KRD
  #undef STEP
  #undef ENDW
  {auto rr=__builtin_amdgcn_permlane32_swap(__float_as_uint(l_reg),__float_as_uint(l_reg),false,false);l_reg=__uint_as_float(rr[0])+__uint_as_float(rr[1]);}
  if(hi==0)wsf[32+r32]=l_reg;asm volatile("s_waitcnt lgkmcnt(0)":::"memory");
  float rli[16];
  #pragma unroll
  for(int r=0;r<16;++r)rli[r]=__builtin_amdgcn_rcpf(wsf[32+crow(r,hi)]);
  bf16*Ow=O+(rowbase+q0+wid*QBLK)*DM+hv*D;
  { bf16*stg=(bf16*)(shm+LDS_OST)+wid*2048;
    #pragma unroll
    for(int r=0;r<16;++r){const int orow=crow(r,hi);
      #pragma unroll
      for(int d0=0;d0<2;++d0)stg[orow*64+d0*32+r32]=__float2bfloat16(o[d0][r]*rli[r]);}
    asm volatile("s_waitcnt lgkmcnt(0)":::"memory");
    #pragma unroll
    for(int i=0;i<4;++i){const int row=i*8+(lane>>3),ch=lane&7; const u32x4 v=*(const u32x4*)(stg+row*64+ch*8); ATTN_STORE16(Ow+(long)row*DM+ch*8,v);} }
  asm volatile("s_waitcnt lgkmcnt(0)\n\ts_barrier":::"memory");
  #undef DMA_K
  #undef DMA_V
  #undef CMASK
  #undef START
  #undef RESC
  #undef ROT
  #undef NB
  #undef ALIBI
}
constexpr int ATTN_LDS_BYTES=LDS_BYTES;
struct AttnTensors { const bf16* Q; const bf16* K; const bf16* V; bf16* O0; bf16* O1; };
struct AttnUnit { int hu; int qb; };
struct StaticOrder {
  int vcu, G;
  __device__ __forceinline__ explicit StaticOrder(int grid,int block):vcu((grid%8==0)?(block%8)*(grid/8)+block/8:block),G(grid){}
  __device__ __forceinline__ bool next(int i,AttnUnit&u)const{
    const int p=(i>>1)*G+vcu; if(p>=128*8)return false; u.hu=p>>3; const int s=p&7; u.qb=(i&1)?15-s:s; return true; }
  __device__ __forceinline__ void a_ready(const AttnUnit&)const{}
  __device__ __forceinline__ void done(const AttnUnit&)const{}
};
template<class Sched,int THRL=8> __device__ __forceinline__ void attn_phase(char*lds,const AttnTensors&T,const Sched&S){
  AttnUnit u;
  for(int i=0;S.next(i,u);++i){ S.a_ready(u); { const int b_=u.hu>>5,h_=(u.hu>>2)&7,c_=(u.hu>>1)&1,j_=u.hu&1; const float sl2_=__builtin_amdgcn_exp2f(-(float)(h_+1))*1.4426950408889634f;
      attn_unit<THRL>(b_,2*h_+c_,2*h_+j_,sl2_,u.qb,T.Q,T.K,T.V,c_?T.O1:T.O0,lds); } S.done(u); }
}
#undef SBAR
#undef WAIT_BAR
}

constexpr int NWAVES = 8;
constexpr int BATCH = 4, SEQ = 4096, D = 2048, M = BATCH * SEQ;
constexpr int AW = 1024, NIN = 5120;
constexpr float LN_EPS = 1e-5f;
constexpr float DN_ALPHA = 1.189207115002721f;
constexpr float C2 = 0.125f * 1.4426950408889634f;
constexpr float LOG2E = 1.4426950408889634f;

constexpr size_t MiB = 1u << 20;
constexpr size_t WS_CTL = 0, CTL_ZERO_BYTES = 1 * MiB;
constexpr size_t WS_WIN = 2 * MiB, WS_WOUT = 22 * MiB, WS_WQ = 30 * MiB, WS_PRM = 38 * MiB;
constexpr size_t WS_XB = 40 * MiB;
constexpr size_t WS_MIX = 40 * MiB;
constexpr size_t WS_Q = 104 * MiB, WS_K = 136 * MiB, WS_V = 168 * MiB, WS_XR = 200 * MiB, WS_XG = 232 * MiB;
constexpr size_t WS_Y1 = 104 * MiB;
constexpr size_t WS_H1 = 232 * MiB;
constexpr size_t WS_H8 = 296 * MiB;
constexpr size_t WS_PQ = 104 * MiB;
constexpr size_t WS_U8 = 328 * MiB, WS_V8 = 360 * MiB;
constexpr size_t WS_LA = 328 * MiB, WS_LB = 392 * MiB;
constexpr size_t WS_O0 = 264 * MiB, WS_O1 = 296 * MiB;
constexpr size_t WS_E = 456 * MiB, WS_G = 464 * MiB, WS_TOTA = 472 * MiB, WS_TOTH = 473 * MiB, WS_SKH = 474 * MiB, WS_SKL = 475 * MiB, WS_END = 476 * MiB;
constexpr int CW_BAR = 4096;

constexpr int RING_OFF = 0, RING_BYTES = 131072;
constexpr int LDSCTL_OFF = RING_BYTES, MISC_OFF = LDSCTL_OFF + 320;
constexpr int LDS_BYTES = 147456;

#define GAS __attribute__((address_space(1)))
#define LAS __attribute__((address_space(3)))
typedef unsigned short bf16;
typedef unsigned v4u __attribute__((ext_vector_type(4)));
typedef float f32x4 __attribute__((ext_vector_type(4)));
typedef GAS unsigned gu32;
#define RLX_AGENT __ATOMIC_RELAXED, __HIP_MEMORY_SCOPE_AGENT
#define LDS_WAIT() asm volatile("s_waitcnt lgkmcnt(0)" ::: "memory")
#define VM_WAIT() asm volatile("s_waitcnt vmcnt(0)" ::: "memory")
__device__ __forceinline__ unsigned f2bf(float f) { unsigned u = __builtin_bit_cast(unsigned, f); return (u + 0x7fffu + ((u >> 16) & 1u)) >> 16; }
__device__ __forceinline__ unsigned pk2(float lo, float hi) { return f2bf(lo) | (f2bf(hi) << 16); }
__device__ __forceinline__ float bf2f(unsigned short u) { return __uint_as_float(((unsigned)u) << 16); }
__device__ __forceinline__ float gelu_tanh(float x) { const float u = 0.7978845608028654f * (x + 0.044715f * x * x * x); return 0.5f * x * (1.f + tanhf(u)); }

#define XB_TMO      128
#define XB_XCNT(j)  (256  + 64 * (j))
#define XB_XSUB(j)  (1280 + 64 * (j))
#define XB_XGEN(j)  (2304 + 64 * (j))
#define XB_TOP      3328
#define XB_TOPGEN   3392
#define XCD_BAR_WORDS 3456
#define XB_SPIN_CAP (1u << 18)

__device__ __forceinline__ unsigned xb_ld(unsigned* p)              { return __hip_atomic_load(p, __ATOMIC_RELAXED, __HIP_MEMORY_SCOPE_AGENT); }
__device__ __forceinline__ unsigned xb_add(unsigned* p, unsigned v) { return __hip_atomic_fetch_add(p, v, __ATOMIC_RELAXED, __HIP_MEMORY_SCOPE_AGENT); }
__device__ __forceinline__ unsigned xb_xcc_id() { return (unsigned)__builtin_amdgcn_s_getreg((3 << 11) | 20) & 0xFu; }
#define XB_SPIN(cond, bar) do { unsigned _sp = 0; while (cond) { __builtin_amdgcn_s_sleep(1); \
    if ((++_sp & 255u) == 0u) { if (xb_ld(&(bar)[XB_TMO])) break; if (_sp > XB_SPIN_CAP) { atomicAdd(&(bar)[XB_TMO], 1u); break; } } } } while (0)

struct XcdBarrier {
    unsigned* bar; unsigned x;
    volatile LAS unsigned* st;
};

__device__ __forceinline__ XcdBarrier xcd_barrier_post(unsigned* bar, volatile LAS unsigned* st) {
    XcdBarrier b; b.bar = bar; b.x = xb_xcc_id(); b.st = st;
    if (threadIdx.x == 0) (void)xb_add(&bar[XB_XCNT(b.x)], 1u);
    return b;
}
__device__ __forceinline__ void xcd_barrier_complete(unsigned* bar, unsigned x, unsigned& nloc, unsigned& nx) {
    const unsigned G = gridDim.x * gridDim.y * gridDim.z;
    unsigned sum, cnt, mine, sp = 0u;
    for (;;) {
        sum = 0u; cnt = 0u; mine = 0u;
#pragma unroll
        for (unsigned j = 0; j < 16; ++j) { const unsigned c = xb_ld(&bar[XB_XCNT(j)]); sum += c; cnt += (c > 0u) ? 1u : 0u; mine = (j == x) ? c : mine; }
        if (sum == G) break;
        __builtin_amdgcn_s_sleep(1);
        if ((++sp & 255u) == 0u) { if (xb_ld(&bar[XB_TMO])) break; if (sp > XB_SPIN_CAP) { atomicAdd(&bar[XB_TMO], 1u); break; } }
    }
    nloc = mine > 0u ? mine : 1u; nx = cnt > 0u ? cnt : 1u;
}

__device__ __forceinline__ void xcd_barrier(const XcdBarrier& b) {
    asm volatile("s_waitcnt vmcnt(0)" ::: "memory");
    __syncthreads();
    if (threadIdx.x == 0) {
        unsigned* bar = b.bar;
        __builtin_amdgcn_s_waitcnt(0);
        unsigned nloc = b.st[0], nx = b.st[1];
        if (nloc == 0u) { xcd_barrier_complete(bar, b.x, nloc, nx); b.st[0] = nloc; b.st[1] = nx; }
        const unsigned old = xb_add(&bar[XB_XSUB(b.x)], 1u);
        const unsigned gen = old / nloc;
        if (old + 1u == (gen + 1u) * nloc) {
            __builtin_amdgcn_fence(__ATOMIC_RELEASE, "agent");
            asm volatile("s_waitcnt vmcnt(0)" ::: "memory");
            const unsigned og = xb_add(&bar[XB_TOP], 1u);
            const unsigned tg = og / nx;
            if (og + 1u == (tg + 1u) * nx) xb_add(&bar[XB_TOPGEN], 1u);
            else XB_SPIN(xb_ld(&bar[XB_TOPGEN]) == tg, bar);
            __builtin_amdgcn_fence(__ATOMIC_ACQUIRE, "agent");
            xb_add(&bar[XB_XGEN(b.x)], 1u);
            asm volatile("s_waitcnt vmcnt(0)" ::: "memory");
        } else {
            XB_SPIN(xb_ld(&bar[XB_XGEN(b.x)]) == gen, bar);
            __builtin_amdgcn_fence(__ATOMIC_ACQUIRE, "agent");
            asm volatile("s_waitcnt vmcnt(0)" ::: "memory");
        }
    }
    __syncthreads();
}

struct Frame {
    LAS unsigned char* lds;
    int tid, lane, wave;
    int vcu, G;
};

__device__ __forceinline__ void p0_transpose_item(const float* W, int K, int N, bf16* WT, int row_off, LAS float* scr, int item, int lane) {
    const int nblk = N / 32, kb = item / nblk, nb = item % nblk, k0 = 64 * kb, n0 = 32 * nb;
#pragma unroll 8
    for (int i = 0; i < 32; ++i) { const int kk = 2 * i + (lane >> 5); scr[kk * 33 + (lane & 31)] = W[(size_t)(k0 + kk) * N + n0 + (lane & 31)]; }
    LDS_WAIT(); asm volatile("" ::: "memory");
    const int c = lane & 7;
#pragma unroll
    for (int j = 0; j < 4; ++j) { const int n = (lane >> 3) + 8 * j; const LAS float* s = scr + (8 * c) * 33 + n;
        v4u o; o.x = pk2(s[0 * 33], s[1 * 33]); o.y = pk2(s[2 * 33], s[3 * 33]); o.z = pk2(s[4 * 33], s[5 * 33]); o.w = pk2(s[6 * 33], s[7 * 33]);
        *(GAS v4u*)(WT + (size_t)(row_off + n0 + n) * K + k0 + 8 * c) = o; }
    LDS_WAIT(); asm volatile("" ::: "memory");
}

typedef short bf16x8 __attribute__((ext_vector_type(8)));
typedef float f32x16 __attribute__((ext_vector_type(16)));
typedef float f32x2_t __attribute__((ext_vector_type(2))); typedef __bf16 bf16x2_t __attribute__((ext_vector_type(2)));
__device__ __forceinline__ unsigned cvtpk(float lo, float hi) { f32x2_t v = {lo, hi}; bf16x2_t b = __builtin_convertvector(v, bf16x2_t); return __builtin_bit_cast(unsigned, b); }
__device__ __forceinline__ void split8(const f32x4 a, const f32x4 b, bf16x8& h, bf16x8& l) {
    v4u hh; hh.x = cvtpk(a.x, a.y); hh.y = cvtpk(a.z, a.w); hh.z = cvtpk(b.x, b.y); hh.w = cvtpk(b.z, b.w);
    v4u ll;
    ll.x = cvtpk(a.x - __uint_as_float(hh.x << 16), a.y - __uint_as_float(hh.x & 0xffff0000u));
    ll.y = cvtpk(a.z - __uint_as_float(hh.y << 16), a.w - __uint_as_float(hh.y & 0xffff0000u));
    ll.z = cvtpk(b.x - __uint_as_float(hh.z << 16), b.y - __uint_as_float(hh.z & 0xffff0000u));
    ll.w = cvtpk(b.z - __uint_as_float(hh.w << 16), b.w - __uint_as_float(hh.w & 0xffff0000u));
    h = __builtin_bit_cast(bf16x8, hh); l = __builtin_bit_cast(bf16x8, ll);
}
__device__ __forceinline__ float max3f_(float a, float b, float c) { return __builtin_fmaxf(__builtin_fmaxf(a, b), c); }
__device__ __forceinline__ float pair_max(float m) { auto rr = __builtin_amdgcn_permlane32_swap(__float_as_uint(m), __float_as_uint(m), false, false); return __builtin_fmaxf(__uint_as_float(rr[0]), __uint_as_float(rr[1])); }
__device__ __forceinline__ void route_half(const float* qp, const v4u* kh, const v4u* kl, int lane, int hi, float (&lst)[16]) {
    f32x16 sc[4];
#pragma unroll
    for (int kt = 0; kt < 4; ++kt) sc[kt] = f32x16{};
#pragma unroll 2
    for (int ds = 0; ds < 8; ++ds) { bf16x8 qh, ql; split8(*(const f32x4*)(qp + 16 * ds), *(const f32x4*)(qp + 16 * ds + 4), qh, ql);
#pragma unroll
        for (int kt = 0; kt < 4; ++kt) { const bf16x8 ah = __builtin_bit_cast(bf16x8, kh[(kt * 8 + ds) * 64 + lane]), al = __builtin_bit_cast(bf16x8, kl[(kt * 8 + ds) * 64 + lane]);
            sc[kt] = __builtin_amdgcn_mfma_f32_32x32x16_bf16(ah, qh, sc[kt], 0, 0, 0);
            sc[kt] = __builtin_amdgcn_mfma_f32_32x32x16_bf16(ah, ql, sc[kt], 0, 0, 0);
            sc[kt] = __builtin_amdgcn_mfma_f32_32x32x16_bf16(al, qh, sc[kt], 0, 0, 0); } }
#pragma unroll
    for (int kt = 0; kt < 4; ++kt)
#pragma unroll
        for (int r = 0; r < 16; ++r) { const unsigned key = (unsigned)(kt * 32 + (r & 3) + 8 * (r >> 2) + 4 * hi); sc[kt][r] = __uint_as_float((__float_as_uint(sc[kt][r]) & ~127u) | (127u - key)); }
#pragma unroll
    for (int rd = 0; rd < 16; ++rd) {
        float m = max3f_(sc[0][0], sc[0][1], sc[0][2]);
#pragma unroll
        for (int n = 3; n + 1 < 64; n += 2) m = max3f_(m, sc[n >> 4][n & 15], sc[(n + 1) >> 4][(n + 1) & 15]);
        m = __builtin_fmaxf(m, sc[3][15]);
        const float gm = pair_max(m); lst[rd] = gm;
#pragma unroll
        for (int kt = 0; kt < 4; ++kt)
#pragma unroll
            for (int r = 0; r < 16; ++r) sc[kt][r] = (__float_as_uint(sc[kt][r]) == __float_as_uint(gm)) ? -INFINITY : sc[kt][r];
    }
}
typedef float f32x2v __attribute__((ext_vector_type(2)));
__device__ __forceinline__ unsigned pk4_fp8(float a, float b, float c, float d) { int p = __builtin_amdgcn_cvt_pk_fp8_f32(a, b, 0, false); p = __builtin_amdgcn_cvt_pk_fp8_f32(c, d, p, true); return (unsigned)p; }
constexpr float U8_SCALE = 64.f;
struct Args { const float* in[23]; float* out; unsigned char* ws; int ph_lo, ph_hi; };

__global__ void __launch_bounds__(NWAVES * 64, 2) skel_fwd(Args args) {
    extern __shared__ __attribute__((aligned(16))) unsigned char lds[];
    Frame F;
    F.lds = (LAS unsigned char*)lds;
    F.tid = threadIdx.x; F.lane = F.tid & 63; F.wave = __builtin_amdgcn_readfirstlane(F.tid >> 6);
    F.G = gridDim.x; { const int bx = blockIdx.x; F.vcu = (F.G % 8 == 0) ? (bx % 8) * (F.G / 8) + bx / 8 : bx; }
    unsigned char* ws = args.ws;
    const float* x = args.in[0];
    bf16* WIN_T = (bf16*)(ws + WS_WIN); bf16* WOUT_T = (bf16*)(ws + WS_WOUT); bf16* WQ_T = (bf16*)(ws + WS_WQ);
    bf16* XB = (bf16*)(ws + WS_XB); bf16* MIX = (bf16*)(ws + WS_MIX); bf16* QB = (bf16*)(ws + WS_Q); bf16* H1 = (bf16*)(ws + WS_H1);
    float* Y1 = (float*)(ws + WS_Y1); float* PQ = (float*)(ws + WS_PQ);
    for (int u = F.tid; u < (LDS_BYTES - LDSCTL_OFF) / 4; u += NWAVES * 64) ((LAS unsigned*)(F.lds + LDSCTL_OFF))[u] = 0u;
    __syncthreads();
    XcdBarrier bar = xcd_barrier_post((unsigned*)(ws + WS_CTL) + CW_BAR, (volatile LAS unsigned*)(F.lds + MISC_OFF) + 8);
    const unsigned phmask = (unsigned)args.ph_lo;
    int slot_ = 0;
#define IN(k) (false)
#define RUN(slotbit) ((phmask >> (slotbit)) & 1u)
#define GRID_BAR() do { if (phmask == 0xffffffffu) xcd_barrier(bar); } while (0)

    if (RUN(0)) {
        if (blockIdx.x == 0 && F.wave == 0) {
            float a_ = args.in[9][F.lane] * args.in[10][F.lane], b_ = args.in[11][F.lane] * args.in[12][F.lane];
#pragma unroll
            for (int o = 1; o < 64; o <<= 1) { a_ += __shfl_xor(a_, o); b_ += __shfl_xor(b_, o); }
            if (F.lane == 0) ((float*)(ws + WS_PRM))[0] = expf(a_) - expf(b_) + 0.2f;
        }
        LAS float* scr = (LAS float*)(F.lds + RING_OFF + F.wave * 16384);
        const int gw = F.vcu * NWAVES + F.wave, NGW = F.G * NWAVES;
        constexpr int I_IN = (D / 64) * (NIN / 32), I_SQ = (D / 64) * (D / 32);
        constexpr int NITEMS = I_IN + 2 * I_SQ;
        for (int it = gw; it < NITEMS; it += NGW) {
            int r = it;
            if (r < I_IN) { p0_transpose_item(args.in[1], D, NIN, WIN_T, 0, scr, r, F.lane); continue; } r -= I_IN;
            if (r < I_SQ) { p0_transpose_item(args.in[14], D, D, WOUT_T, 0, scr, r, F.lane); continue; } r -= I_SQ;
            p0_transpose_item(args.in[17], D, D, WQ_T, 0, scr, r, F.lane);
        }
        {
            const float* sk = args.in[18]; v4u* SKH = (v4u*)(ws + WS_SKH); v4u* SKL = (v4u*)(ws + WS_SKL);
            for (int fi = gw; fi < 512; fi += NGW) { const int ds = fi & 7, kt = (fi >> 3) & 3, hp = fi >> 5;
                const float* src = sk + ((size_t)(hp * 128 + kt * 32 + (F.lane & 31)) * 128 + 16 * ds + 8 * (F.lane >> 5));
                bf16x8 h8, l8; split8(*(const f32x4*)src, *(const f32x4*)(src + 4), h8, l8);
                SKH[fi * 64 + F.lane] = __builtin_bit_cast(v4u, h8); SKL[fi * 64 + F.lane] = __builtin_bit_cast(v4u, l8); }
        }
        for (int m = gw; m < M; m += NGW) {
            const GAS f32x4* xr = (const GAS f32x4*)(x + (size_t)m * D) + F.lane;
            GAS unsigned long long* o8 = (GAS unsigned long long*)(XB + (size_t)m * D) + F.lane;
#pragma unroll
            for (int j = 0; j < 8; ++j) { const f32x4 v = xr[64 * j]; o8[64 * j] = (unsigned long long)pk2(v.x, v.y) | ((unsigned long long)pk2(v.z, v.w) << 32); }
        }
    }
    GRID_BAR();
    if (RUN(1)) {
        pg8::Gemm g{XB, WIN_T, M, NIN, D}; pg8::StaticOrder S; S.init(M, NIN, F.G, (int)blockIdx.x);
        pg8::EpiBf16<0> E{QB, AW, nullptr, AW, (size_t)(WS_K - WS_Q) / 2, C2};
        pg8::gemm_phase<pg8::EpiBf16<0>, pg8::StaticOrder, PG8_ALIGN, PG8_SP2>(F.lds + RING_OFF, g, S, E);
    }
    GRID_BAR();
    if (RUN(2)) {
        LAS float* xc = (LAS float*)(F.lds + RING_OFF);
        const bf16* XR = (const bf16*)(ws + WS_XR); float* LA = (float*)(ws + WS_LA); float* LB = (float*)(ws + WS_LB);
        const float* conv_w = args.in[2]; const float* conv_b = args.in[3]; const float* w_a = args.in[4]; const float* b_a = args.in[5]; const float* w_x = args.in[6]; const float* b_x = args.in[7]; const float* lru_lambda = args.in[8];
        for (int ti = F.vcu; ti < M / 16; ti += F.G) {
            const int tok0 = ti * 16, t0 = tok0 % SEQ;
            __syncthreads();
#pragma unroll
            for (int i = 0; i < 2; ++i) { const int ch = F.tid + 512 * i;
                const float cw0 = conv_w[ch], cw1 = conv_w[1024 + ch], cw2 = conv_w[2048 + ch], cw3 = conv_w[3072 + ch], cb = conv_b[ch];
                float xv[19];
#pragma unroll
                for (int r = 0; r < 19; ++r) xv[r] = (t0 + r - 3 >= 0) ? bf2f(XR[(size_t)(tok0 + r - 3) * AW + ch]) : 0.f;
#pragma unroll
                for (int q = 0; q < 4; ++q) { f32x4 o;
#pragma unroll
                    for (int e = 0; e < 4; ++e) { const int r = 4 * q + e; o[e] = cb + cw0 * xv[r] + cw1 * xv[r + 1] + cw2 * xv[r + 2] + cw3 * xv[r + 3]; }
                    *(LAS f32x4*)(xc + ch * 16 + 4 * q) = o; } }
            __syncthreads();
#pragma unroll 1
            for (int i = 0; i < 2; ++i) { const int ch = F.tid + 512 * i, hb = ch >> 7, jj = ch & 127;
                f32x4 aa[4], ax[4]; { const float ba = b_a[ch], bx = b_x[ch];
#pragma unroll
                    for (int q = 0; q < 4; ++q) { aa[q] = (f32x4){ba, ba, ba, ba}; ax[q] = (f32x4){bx, bx, bx, bx}; } }
                const float* wa = w_a + (size_t)hb * 128 * 128 + jj; const float* wx = w_x + (size_t)hb * 128 * 128 + jj; const LAS float* xk = xc + hb * 128 * 16;
#pragma unroll 4
                for (int k = 0; k < 128; ++k) { const float va = wa[k * 128], vx = wx[k * 128];
#pragma unroll
                    for (int q = 0; q < 4; ++q) { const f32x4 xq = *(const LAS f32x4*)(xk + k * 16 + 4 * q); aa[q] = aa[q] + xq * va; ax[q] = ax[q] + xq * vx; } }
                const float sp = log1pf(__expf(-lru_lambda[ch]));
#pragma unroll
                for (int q = 0; q < 4; ++q)
#pragma unroll
                    for (int e = 0; e < 4; ++e) { const int tt = 4 * q + e;
                        const float r = 1.f / (1.f + __expf(-aa[q][e])), ig = 1.f / (1.f + __expf(-ax[q][e]));
                        const float log_a = -8.f * r * sp, a = __expf(log_a), bt = sqrtf(fmaxf(1.f - a * a, 0.f)) * ig * xc[ch * 16 + tt];
                        LA[(size_t)(tok0 + tt) * 1024 + ch] = a; LB[(size_t)(tok0 + tt) * 1024 + ch] = bt; } }
        }
    }
    GRID_BAR();
    if (RUN(3)) {
        const float* LA = (const float*)(ws + WS_LA); const float* LB = (const float*)(ws + WS_LB); float* TA = (float*)(ws + WS_TOTA); float* TH = (float*)(ws + WS_TOTH);
        const bf16* XG = (const bf16*)(ws + WS_XG);
        const int T = F.vcu * 512 + F.tid;
        for (int it = T; it < 131072; it += F.G * 512) { const int ch = it & 1023, b = (it >> 10) & 3, cc = it >> 12;
#pragma unroll 1
            for (int half = 0; half < 2; ++half) { const int c = half ? 63 - cc : cc; const size_t base = (size_t)(b * SEQ + c * 64) * 1024 + ch;
                if (true) { float A = 1.f, H = 0.f;
#pragma unroll 8
                    for (int t = 0; t < 64; ++t) { const float a = LA[base + (size_t)t * 1024], bt = LB[base + (size_t)t * 1024]; H = a * H + bt; A *= a; }
                    TA[(b * 64 + c) * 1024 + ch] = A; TH[(b * 64 + c) * 1024 + ch] = H;
                } else { float h = 0.f;
                    for (int c2 = 0; c2 < c; ++c2) h = TA[(b * 64 + c2) * 1024 + ch] * h + TH[(b * 64 + c2) * 1024 + ch];
#pragma unroll 8
                    for (int t = 0; t < 64; ++t) { const float a = LA[base + (size_t)t * 1024], bt = LB[base + (size_t)t * 1024]; h = a * h + bt;
                        const float xg = bf2f(XG[base + (size_t)t * 1024]);
                        MIX[(size_t)(b * SEQ + c * 64 + t) * D + 1024 + ch] = (bf16)f2bf(h * gelu_tanh(xg)); } } } }
    }
    GRID_BAR();
    if (RUN(4)) {
        static_assert(attn_body::ATTN_LDS_BYTES <= RING_BYTES && attn_body::ATTN_PITCH == AW, "attention body geometry vs frame");
        const attn_body::AttnTensors AT{(const attn_body::bf16*)QB, (const attn_body::bf16*)(ws + WS_K), (const attn_body::bf16*)(ws + WS_V), (attn_body::bf16*)(ws + WS_O0), (attn_body::bf16*)(ws + WS_O1)};
        const attn_body::StaticOrder S((int)F.G, (int)blockIdx.x);
        attn_body::attn_phase<attn_body::StaticOrder>((char*)lds + RING_OFF, AT, S);
    }
    if (RUN(5)) {
        const float* LA = (const float*)(ws + WS_LA); const float* LB = (const float*)(ws + WS_LB); float* TA = (float*)(ws + WS_TOTA); float* TH = (float*)(ws + WS_TOTH);
        const bf16* XG = (const bf16*)(ws + WS_XG);
        const int T = F.vcu * 512 + F.tid;
        for (int it = T; it < 131072; it += F.G * 512) { const int ch = it & 1023, b = (it >> 10) & 3, cc = it >> 12;
#pragma unroll 1
            for (int half = 0; half < 2; ++half) { const int c = half ? 63 - cc : cc; const size_t base = (size_t)(b * SEQ + c * 64) * 1024 + ch;
                if (false) { float A = 1.f, H = 0.f;
#pragma unroll 8
                    for (int t = 0; t < 64; ++t) { const float a = LA[base + (size_t)t * 1024], bt = LB[base + (size_t)t * 1024]; H = a * H + bt; A *= a; }
                    TA[(b * 64 + c) * 1024 + ch] = A; TH[(b * 64 + c) * 1024 + ch] = H;
                } else { float h = 0.f;
                    for (int c2 = 0; c2 < c; ++c2) h = TA[(b * 64 + c2) * 1024 + ch] * h + TH[(b * 64 + c2) * 1024 + ch];
#pragma unroll 8
                    for (int t = 0; t < 64; ++t) { const float a = LA[base + (size_t)t * 1024], bt = LB[base + (size_t)t * 1024]; h = a * h + bt;
                        const float xg = bf2f(XG[base + (size_t)t * 1024]);
                        MIX[(size_t)(b * SEQ + c * 64 + t) * D + 1024 + ch] = (bf16)f2bf(h * gelu_tanh(xg)); } } } }
    }
    GRID_BAR();
    if (RUN(6)) {
        const int gw = F.vcu * NWAVES + F.wave, NGW = F.G * NWAVES;
        const float lam = ((const float*)(ws + WS_PRM))[0];
        const bf16* O0 = (const bf16*)(ws + WS_O0); const bf16* O1 = (const bf16*)(ws + WS_O1);
        const float g0 = args.in[13][2 * F.lane] * 0.8f, g1 = args.in[13][2 * F.lane + 1] * 0.8f;
        for (int it = gw; it < M * 8; it += NGW) { const int tok = it >> 3, h = it & 7;
            const unsigned a = *(const unsigned*)(O0 + (size_t)tok * AW + h * 128 + 2 * F.lane), b = *(const unsigned*)(O1 + (size_t)tok * AW + h * 128 + 2 * F.lane);
            const float d0 = bf2f((unsigned short)(a & 0xffff)) - lam * bf2f((unsigned short)(b & 0xffff)), d1 = bf2f((unsigned short)(a >> 16)) - lam * bf2f((unsigned short)(b >> 16));
            float ss = d0 * d0 + d1 * d1;
#pragma unroll
            for (int o = 1; o < 64; o <<= 1) ss += __shfl_xor(ss, o);
            const float r = rsqrtf(ss * (1.f / 128.f) + LN_EPS);
            *(unsigned*)(MIX + (size_t)tok * D + h * 128 + 2 * F.lane) = pk2(d0 * r * g0, d1 * r * g1); }
    }
    GRID_BAR();
    if (RUN(7)) {
        pg8::Gemm g{MIX, WOUT_T, M, D, D}; pg8::StaticOrder S; S.init(M, D, F.G, (int)blockIdx.x);
        pg8::EpiF32 E{Y1, D, x, DN_ALPHA};
        pg8::gemm_phase<pg8::EpiF32, pg8::StaticOrder, PG8_ALIGN, PG8_SP2>(F.lds + RING_OFF, g, S, E);
    }
    GRID_BAR();
    if (RUN(8)) {
        const int gw = F.vcu * NWAVES + F.wave, NGW = F.G * NWAVES; const float* g = args.in[15]; const float* bb = args.in[16];
        for (int row = gw; row < M; row += NGW) {
            const f32x4* y = (const f32x4*)(Y1 + (size_t)row * D);
            f32x4 v[8]; float s = 0.f;
#pragma unroll
            for (int j = 0; j < 8; ++j) { v[j] = y[F.lane + 64 * j]; s += (v[j].x + v[j].y) + (v[j].z + v[j].w); }
#pragma unroll
            for (int o = 1; o < 64; o <<= 1) s += __shfl_xor(s, o);
            const float mean = s * (1.f / D); float s2 = 0.f;
#pragma unroll
            for (int j = 0; j < 8; ++j) { v[j] = v[j] - mean; s2 += (v[j].x * v[j].x + v[j].y * v[j].y) + (v[j].z * v[j].z + v[j].w * v[j].w); }
#pragma unroll
            for (int o = 1; o < 64; o <<= 1) s2 += __shfl_xor(s2, o);
            const float rstd = rsqrtf(s2 * (1.f / D) + LN_EPS);
#pragma unroll
            for (int j = 0; j < 8; ++j) { const int c = (F.lane + 64 * j) * 4; const f32x4 gg = *(const f32x4*)(g + c), bv = *(const f32x4*)(bb + c);
                const f32x4 o = v[j] * rstd * gg + bv;
                *(unsigned long long*)(H1 + (size_t)row * D + c) = (unsigned long long)pk2(o.x, o.y) | ((unsigned long long)pk2(o.z, o.w) << 32);
                *(unsigned*)(ws + WS_H8 + (size_t)row * D + c) = pk4_fp8(o.x, o.y, o.z, o.w); }
        }
        {
            const f32x4* us = (const f32x4*)args.in[19]; const f32x4* vs = (const f32x4*)args.in[20]; v4u* U8 = (v4u*)(ws + WS_U8); v4u* V8 = (v4u*)(ws + WS_V8);
            for (size_t i = (size_t)F.vcu * 512 + F.tid; i < (size_t)16384 * 2048 / 16; i += (size_t)F.G * 512) {
                const f32x4 a0 = us[4 * i] * U8_SCALE, a1 = us[4 * i + 1] * U8_SCALE, a2 = us[4 * i + 2] * U8_SCALE, a3 = us[4 * i + 3] * U8_SCALE;
                U8[i] = (v4u){pk4_fp8(a0.x, a0.y, a0.z, a0.w), pk4_fp8(a1.x, a1.y, a1.z, a1.w), pk4_fp8(a2.x, a2.y, a2.z, a2.w), pk4_fp8(a3.x, a3.y, a3.z, a3.w)};
                const f32x4 b0 = vs[4 * i], b1 = vs[4 * i + 1], b2 = vs[4 * i + 2], b3 = vs[4 * i + 3];
                V8[i] = (v4u){pk4_fp8(b0.x, b0.y, b0.z, b0.w), pk4_fp8(b1.x, b1.y, b1.z, b1.w), pk4_fp8(b2.x, b2.y, b2.z, b2.w), pk4_fp8(b3.x, b3.y, b3.z, b3.w)}; }
        }
    }
    GRID_BAR();
    if (RUN(9)) {
        pg8::Gemm g{H1, WQ_T, M, D, D}; pg8::StaticOrder S; S.init(M, D, F.G, (int)blockIdx.x);
        pg8::EpiF32 E{PQ, D, nullptr, 0.f};
        pg8::gemm_phase<pg8::EpiF32, pg8::StaticOrder, PG8_ALIGN, PG8_SP2>(F.lds + RING_OFF, g, S, E);
    }
    GRID_BAR();
    if (RUN(10)) {
        const int gw = F.vcu * NWAVES + F.wave, NGW = F.G * NWAVES, tl = F.lane & 31, hi = F.lane >> 5;
        LAS unsigned char* scr = F.lds + RING_OFF + F.wave * 1024 + tl * 32;
        const v4u* SKH = (const v4u*)(ws + WS_SKH); const v4u* SKL = (const v4u*)(ws + WS_SKL);
        int* E = (int*)(ws + WS_E); float* G = (float*)(ws + WS_G);
        for (int it = gw; it < (M / 32) * 8; it += NGW) { const int h = it & 7, tok = (it >> 3) * 32 + tl;
            float sa[16], sb[16];
            route_half(PQ + (size_t)tok * D + h * 256 + 8 * hi, SKH + (size_t)(h * 2) * 32 * 64, SKL + (size_t)(h * 2) * 32 * 64, F.lane, hi, sa);
            route_half(PQ + (size_t)tok * D + h * 256 + 128 + 8 * hi, SKH + (size_t)(h * 2 + 1) * 32 * 64, SKL + (size_t)(h * 2 + 1) * 32 * 64, F.lane, hi, sb);
            { unsigned w[4];
#pragma unroll
              for (int q = 0; q < 4; ++q) { w[q] = 0u;
#pragma unroll
                  for (int e = 0; e < 4; ++e) { const unsigned ka = 127u - (__float_as_uint(sa[4 * q + e]) & 127u), kb = 127u - (__float_as_uint(sb[4 * q + e]) & 127u); w[q] |= (hi ? kb : ka) << (8 * e); } }
              *(LAS v4u*)(scr + 16 * hi) = (v4u){w[0], w[1], w[2], w[3]}; }
            float cd[25];
#define CV_(i, j) __uint_as_float((__float_as_uint(sa[i] + sb[j]) & ~255u) | (255u - (unsigned)(16 * (i) + (j))))
            cd[0] = hi ? CV_(0, 1) : CV_(0, 0);
            cd[1] = hi ? CV_(0, 3) : CV_(0, 2);
            cd[2] = hi ? CV_(0, 5) : CV_(0, 4);
            cd[3] = hi ? CV_(0, 7) : CV_(0, 6);
            cd[4] = hi ? CV_(0, 9) : CV_(0, 8);
            cd[5] = hi ? CV_(0, 11) : CV_(0, 10);
            cd[6] = hi ? CV_(0, 13) : CV_(0, 12);
            cd[7] = hi ? CV_(0, 15) : CV_(0, 14);
            cd[8] = hi ? CV_(1, 1) : CV_(1, 0);
            cd[9] = hi ? CV_(1, 3) : CV_(1, 2);
            cd[10] = hi ? CV_(1, 5) : CV_(1, 4);
            cd[11] = hi ? CV_(1, 7) : CV_(1, 6);
            cd[12] = hi ? CV_(2, 1) : CV_(2, 0);
            cd[13] = hi ? CV_(2, 3) : CV_(2, 2);
            cd[14] = hi ? CV_(3, 0) : CV_(2, 4);
            cd[15] = hi ? CV_(3, 2) : CV_(3, 1);
            cd[16] = hi ? CV_(4, 0) : CV_(3, 3);
            cd[17] = hi ? CV_(4, 2) : CV_(4, 1);
            cd[18] = hi ? CV_(5, 1) : CV_(5, 0);
            cd[19] = hi ? CV_(6, 1) : CV_(6, 0);
            cd[20] = hi ? CV_(7, 1) : CV_(7, 0);
            cd[21] = hi ? CV_(9, 0) : CV_(8, 0);
            cd[22] = hi ? CV_(11, 0) : CV_(10, 0);
            cd[23] = hi ? CV_(13, 0) : CV_(12, 0);
            cd[24] = hi ? CV_(15, 0) : CV_(14, 0);
#undef CV_
            float top[16];
#pragma unroll
            for (int rd = 0; rd < 16; ++rd) {
                float m = cd[0];
#pragma unroll
                for (int n = 1; n + 1 < 25; n += 2) m = max3f_(m, cd[n], cd[n + 1]);
                const float gm = pair_max(m); top[rd] = gm;
#pragma unroll
                for (int n = 0; n < 25; ++n) cd[n] = (__float_as_uint(cd[n]) == __float_as_uint(gm)) ? -INFINITY : cd[n];
            }
            float ex[16], sum = 0.f;
#pragma unroll
            for (int r = 0; r < 16; ++r) { ex[r] = __builtin_amdgcn_exp2f((top[r] - top[0]) * LOG2E); sum += ex[r]; }
            const float inv = 1.f / sum;
            asm volatile("s_waitcnt lgkmcnt(0)" ::: "memory");
            int eo[8]; float go[8];
#pragma unroll
            for (int rr = 0; rr < 8; ++rr) { float t0 = top[rr], t1 = top[rr + 8], e0 = ex[rr], e1 = ex[rr + 8]; asm volatile("" : "+v"(t0), "+v"(t1), "+v"(e0), "+v"(e1));
                const unsigned f = 255u - (__float_as_uint(hi ? t1 : t0) & 255u);
                const int ia = scr[f >> 4], ib = scr[16 + (f & 15)]; eo[rr] = ia * 128 + ib; go[rr] = (hi ? e1 : e0) * inv; }
            int* ep = E + (size_t)tok * 128 + h * 16 + 8 * hi; float* gp = G + (size_t)tok * 128 + h * 16 + 8 * hi;
            *(v4u*)ep = (v4u){(unsigned)eo[0], (unsigned)eo[1], (unsigned)eo[2], (unsigned)eo[3]}; *(v4u*)(ep + 4) = (v4u){(unsigned)eo[4], (unsigned)eo[5], (unsigned)eo[6], (unsigned)eo[7]};
            *(f32x4*)gp = (f32x4){go[0], go[1], go[2], go[3]}; *(f32x4*)(gp + 4) = (f32x4){go[4], go[5], go[6], go[7]};
            asm volatile("s_waitcnt lgkmcnt(0)" ::: "memory");
        }
    }
    GRID_BAR();
    if (RUN(11)) {
        const int gw = F.vcu * NWAVES + F.wave, NGW = F.G * NWAVES, lane = F.lane, lr = lane & 15, g4 = lane >> 4;
        LAS float* wsm = (LAS float*)(F.lds + RING_OFF + F.wave * 1024);
        LAS int* esm = (LAS int*)(F.lds + RING_OFF + F.wave * 1024 + 512);
        const unsigned char* U8 = ws + WS_U8; const unsigned char* V8 = ws + WS_V8; const unsigned char* H8 = ws + WS_H8;
        const int* E = (const int*)(ws + WS_E); const float* G = (const float*)(ws + WS_G);
        const float* g2 = args.in[21]; const float* b2 = args.in[22]; float* out = args.out;
        for (int tok = gw; tok < M; tok += NGW) {
            const unsigned char* up[8];
#pragma unroll
            for (int rg = 0; rg < 8; ++rg) { const int e = E[(size_t)tok * 128 + rg * 16 + lr]; up[rg] = U8 + (size_t)e * D + 32 * g4; if (g4 == 0) esm[rg * 16 + lr] = e; }
            const unsigned char* hp = H8 + (size_t)tok * D + 32 * g4;
            f32x4 acc[8];
#pragma unroll
            for (int rg = 0; rg < 8; ++rg) acc[rg] = (f32x4){0.f, 0.f, 0.f, 0.f};
#pragma unroll 2
            for (int cj = 0; cj < 16; ++cj) {
                const v4u b0 = *(const v4u*)(hp + 128 * cj), b1 = *(const v4u*)(hp + 128 * cj + 16);
                const long bb0 = (long)(((unsigned long long)b0.y << 32) | b0.x), bb1 = (long)(((unsigned long long)b0.w << 32) | b0.z), bb2 = (long)(((unsigned long long)b1.y << 32) | b1.x), bb3 = (long)(((unsigned long long)b1.w << 32) | b1.z);
#pragma unroll
                for (int rg = 0; rg < 8; ++rg) { const v4u a0 = *(const v4u*)(up[rg] + 128 * cj), a1 = *(const v4u*)(up[rg] + 128 * cj + 16);
                    acc[rg] = __builtin_amdgcn_mfma_f32_16x16x32_fp8_fp8((long)(((unsigned long long)a0.y << 32) | a0.x), bb0, acc[rg], 0, 0, 0);
                    acc[rg] = __builtin_amdgcn_mfma_f32_16x16x32_fp8_fp8((long)(((unsigned long long)a0.w << 32) | a0.z), bb1, acc[rg], 0, 0, 0);
                    acc[rg] = __builtin_amdgcn_mfma_f32_16x16x32_fp8_fp8((long)(((unsigned long long)a1.y << 32) | a1.x), bb2, acc[rg], 0, 0, 0);
                    acc[rg] = __builtin_amdgcn_mfma_f32_16x16x32_fp8_fp8((long)(((unsigned long long)a1.w << 32) | a1.z), bb3, acc[rg], 0, 0, 0); } }
#pragma unroll
            for (int rg = 0; rg < 8; ++rg) { const f32x4 gk = *(const f32x4*)(G + (size_t)tok * 128 + rg * 16 + 4 * g4); f32x4 w;
#pragma unroll
                for (int r = 0; r < 4; ++r) w[r] = gk[r] * gelu_tanh(acc[rg][r] * (1.f / U8_SCALE));
                if (lr == 0) *(LAS f32x4*)(wsm + rg * 16 + 4 * g4) = w; }
            asm volatile("s_waitcnt lgkmcnt(0)" ::: "memory");
            f32x2v av[16];
#pragma unroll
            for (int i = 0; i < 16; ++i) av[i] = (f32x2v){0.f, 0.f};
#pragma unroll 4
            for (int k = 0; k < 128; ++k) {
                const int e = __builtin_amdgcn_readfirstlane(esm[k]); const float w = __uint_as_float(__builtin_amdgcn_readfirstlane(__float_as_uint(wsm[k])));
                const v4u* vr = (const v4u*)(V8 + (size_t)e * D); const v4u d0 = vr[lane], d1 = vr[64 + lane];
                const f32x2v ww = (f32x2v){w, w};
#pragma unroll
                for (int q = 0; q < 4; ++q) { av[2 * q] = av[2 * q] + __builtin_amdgcn_cvt_pk_f32_fp8((int)d0[q], false) * ww; av[2 * q + 1] = av[2 * q + 1] + __builtin_amdgcn_cvt_pk_f32_fp8((int)d0[q], true) * ww;
                    av[8 + 2 * q] = av[8 + 2 * q] + __builtin_amdgcn_cvt_pk_f32_fp8((int)d1[q], false) * ww; av[8 + 2 * q + 1] = av[8 + 2 * q + 1] + __builtin_amdgcn_cvt_pk_f32_fp8((int)d1[q], true) * ww; }
            }
            float s = 0.f;
#pragma unroll
            for (int hh = 0; hh < 2; ++hh) { const v4u h0 = *(const v4u*)(H1 + (size_t)tok * D + hh * 1024 + 16 * lane), h1v = *(const v4u*)(H1 + (size_t)tok * D + hh * 1024 + 16 * lane + 8);
#pragma unroll
                for (int q = 0; q < 4; ++q) { av[8 * hh + q].x += DN_ALPHA * __uint_as_float(h0[q] << 16); av[8 * hh + q].y += DN_ALPHA * __uint_as_float(h0[q] & 0xffff0000u);
                    av[8 * hh + 4 + q].x += DN_ALPHA * __uint_as_float(h1v[q] << 16); av[8 * hh + 4 + q].y += DN_ALPHA * __uint_as_float(h1v[q] & 0xffff0000u); } }
#pragma unroll
            for (int i = 0; i < 16; ++i) s += av[i].x + av[i].y;
#pragma unroll
            for (int o = 1; o < 64; o <<= 1) s += __shfl_xor(s, o);
            const float mean = s * (1.f / D); float s2 = 0.f;
#pragma unroll
            for (int i = 0; i < 16; ++i) { av[i] = av[i] - mean; s2 += av[i].x * av[i].x + av[i].y * av[i].y; }
#pragma unroll
            for (int o = 1; o < 64; o <<= 1) s2 += __shfl_xor(s2, o);
            const float rstd = rsqrtf(s2 * (1.f / D) + LN_EPS);
#pragma unroll
            for (int hh = 0; hh < 2; ++hh)
#pragma unroll
                for (int q = 0; q < 4; ++q) { const int c = hh * 1024 + 16 * lane + 4 * q; const f32x4 gg = *(const f32x4*)(g2 + c), bv = *(const f32x4*)(b2 + c);
                    const f32x4 y = (f32x4){av[8 * hh + 2 * q].x, av[8 * hh + 2 * q].y, av[8 * hh + 2 * q + 1].x, av[8 * hh + 2 * q + 1].y};
                    *(f32x4*)(out + (size_t)tok * D + c) = y * rstd * gg + bv; }
            asm volatile("s_waitcnt lgkmcnt(0)" ::: "memory");
        }
    }
#undef IN
#undef RUN
#undef GRID_BAR
}

__device__ __forceinline__ float wave_sum(float v) {
#pragma unroll
    for (int o = 1; o < 64; o <<= 1) v += __shfl_xor(v, o);
    return v;
}
__device__ __forceinline__ float wave_max(float v) {
#pragma unroll
    for (int o = 1; o < 64; o <<= 1) v = fmaxf(v, __shfl_xor(v, o));
    return v;
}
__device__ __forceinline__ float blk_sum(float v, float* red) {
    v = wave_sum(v); __syncthreads(); if ((threadIdx.x & 63) == 0) red[threadIdx.x >> 6] = v; __syncthreads();
    return (red[0] + red[1]) + (red[2] + red[3]);
}
__device__ __forceinline__ float blk_max(float v, float* red) {
    v = wave_max(v); __syncthreads(); if ((threadIdx.x & 63) == 0) red[threadIdx.x >> 6] = v; __syncthreads();
    return fmaxf(fmaxf(red[0], red[1]), fmaxf(red[2], red[3]));
}

__global__ void setup_params(const float* lq1, const float* lk1, const float* lq2, const float* lk2, float* prm) {
    const int l = threadIdx.x;
    float a = lq1[l] * lk1[l], b = lq2[l] * lk2[l];
    a = wave_sum(a); b = wave_sum(b);
    if (l == 0) prm[0] = expf(a) - expf(b) + 0.2f;
}

__device__ __forceinline__ float dot8(const v4u w, const float* q) {
    return bf2f((unsigned short)(w.x & 0xffff)) * q[0] + bf2f((unsigned short)(w.x >> 16)) * q[1] + bf2f((unsigned short)(w.y & 0xffff)) * q[2] + bf2f((unsigned short)(w.y >> 16)) * q[3]
         + bf2f((unsigned short)(w.z & 0xffff)) * q[4] + bf2f((unsigned short)(w.z >> 16)) * q[5] + bf2f((unsigned short)(w.w & 0xffff)) * q[6] + bf2f((unsigned short)(w.w >> 16)) * q[7];
}

__global__ void __launch_bounds__(256) naive_attn(const bf16* Q, const bf16* K, const bf16* V, bf16* MIX, const float* subln_g, const float* prm) {
    __shared__ float s0[SEQ], s1[SEQ]; __shared__ float qs[128]; __shared__ float red[4]; __shared__ float osum[256];
    const int blk = blockIdx.x, h = blk & 7, tok = blk >> 3, b = tok / SEQ, t = tok % SEQ, tid = threadIdx.x;
    if (tid < 128) qs[tid] = bf2f(Q[(size_t)tok * AW + h * 128 + tid]);
    __syncthreads();
    const float sl2 = exp2f(-(float)(h + 1)) * LOG2E;
    float m0 = -INFINITY, m1 = -INFINITY;
    for (int j = tid; j <= t; j += 256) {
        const bf16* kr = K + (size_t)(b * SEQ + j) * AW + h * 128;
        float d0 = 0.f, d1 = 0.f;
#pragma unroll
        for (int d = 0; d < 64; d += 8) { d0 += dot8(*(const v4u*)(kr + d), qs + d); d1 += dot8(*(const v4u*)(kr + 64 + d), qs + 64 + d); }
        const float bias = sl2 * (float)(t - j);
        d0 -= bias; d1 -= bias; s0[j] = d0; s1[j] = d1; m0 = fmaxf(m0, d0); m1 = fmaxf(m1, d1);
    }
    m0 = blk_max(m0, red); m1 = blk_max(m1, red);
    float l0 = 0.f, l1 = 0.f;
    for (int j = tid; j <= t; j += 256) { const float p0 = exp2f(s0[j] - m0), p1 = exp2f(s1[j] - m1); s0[j] = p0; s1[j] = p1; l0 += p0; l1 += p1; }
    l0 = blk_sum(l0, red); l1 = blk_sum(l1, red);
    const float lam = prm[0], i0 = 1.f / l0, i1 = lam / l1;
    for (int j = tid; j <= t; j += 256) s0[j] = s0[j] * i0 - s1[j] * i1;
    __syncthreads();
    const int half = tid >> 7, d = tid & 127;
    float acc = 0.f;
    const bf16* vb = V + (size_t)(b * SEQ) * AW + h * 128 + d;
    for (int j = half; j <= t; j += 2) acc += s0[j] * bf2f(vb[(size_t)j * AW]);
    osum[tid] = acc; __syncthreads();
    float o = 0.f; if (tid < 128) o = osum[tid] + osum[tid + 128];
    const float ss = blk_sum(o * o, red);
    const float r = rsqrtf(ss * (1.f / 128.f) + LN_EPS);
    if (tid < 128) MIX[(size_t)tok * D + h * 128 + d] = (bf16)f2bf(o * r * subln_g[d] * 0.8f);
}

__global__ void __launch_bounds__(256) naive_lru_gates(const bf16* XR, const float* conv_w, const float* conv_b, const float* w_a, const float* b_a, const float* w_x, const float* b_x,
                                                       const float* lru_lambda, float* A, float* BT) {
    __shared__ float xc[1024];
    const int tok = blockIdx.x, t = tok % SEQ, tid = threadIdx.x;
#pragma unroll
    for (int i = 0; i < 4; ++i) { const int ch = tid + 256 * i; float y = conv_b[ch];
#pragma unroll
        for (int j = 0; j < 4; ++j) { const int tt = t - 3 + j; if (tt >= 0) y += conv_w[j * 1024 + ch] * bf2f(XR[(size_t)(tok - 3 + j) * AW + ch]); }
        xc[ch] = y; }
    __syncthreads();
#pragma unroll
    for (int i = 0; i < 4; ++i) { const int ch = tid + 256 * i, hb = ch >> 7, jj = ch & 127;
        float ra = b_a[ch], rx = b_x[ch];
        for (int k = 0; k < 128; ++k) { const float xv = xc[hb * 128 + k]; ra += xv * w_a[(size_t)(hb * 128 + k) * 128 + jj]; rx += xv * w_x[(size_t)(hb * 128 + k) * 128 + jj]; }
        const float r = 1.f / (1.f + expf(-ra)), ig = 1.f / (1.f + expf(-rx));
        const float sp = log1pf(expf(-lru_lambda[ch]));
        const float log_a = -8.f * r * sp, a = expf(log_a), bt = sqrtf(-expm1f(2.f * log_a)) * ig * xc[ch];
        A[(size_t)tok * 1024 + ch] = a; BT[(size_t)tok * 1024 + ch] = bt; }
}
__global__ void __launch_bounds__(64) naive_lru_scan(const float* A, const float* BT, const bf16* XG, bf16* MIX) {
    const int idx = blockIdx.x * 64 + threadIdx.x, b = idx >> 10, ch = idx & 1023;
    float h = 0.f;
    for (int t0 = 0; t0 < SEQ; t0 += 8) {
        float a[8], bt[8], xg[8];
#pragma unroll
        for (int i = 0; i < 8; ++i) { const size_t o = (size_t)(b * SEQ + t0 + i) * 1024 + ch; a[i] = A[o]; bt[i] = BT[o]; xg[i] = bf2f(XG[o]); }
#pragma unroll
        for (int i = 0; i < 8; ++i) { h = a[i] * h + bt[i]; MIX[(size_t)(b * SEQ + t0 + i) * D + 1024 + ch] = (bf16)f2bf(h * gelu_tanh(xg[i])); }
    }
}
__global__ void __launch_bounds__(256) naive_ln(const float* Y1, const float* g, const float* bb, bf16* H1) {
    const int row = blockIdx.x * 4 + (threadIdx.x >> 6), lane = threadIdx.x & 63;
    const f32x4* y = (const f32x4*)(Y1 + (size_t)row * D);
    f32x4 v[8]; float s = 0.f;
#pragma unroll
    for (int j = 0; j < 8; ++j) { v[j] = y[lane + 64 * j]; s += (v[j].x + v[j].y) + (v[j].z + v[j].w); }
    const float mean = wave_sum(s) * (1.f / D); float s2 = 0.f;
#pragma unroll
    for (int j = 0; j < 8; ++j) { v[j] = v[j] - mean; s2 += (v[j].x * v[j].x + v[j].y * v[j].y) + (v[j].z * v[j].z + v[j].w * v[j].w); }
    const float rstd = rsqrtf(wave_sum(s2) * (1.f / D) + LN_EPS);
#pragma unroll
    for (int j = 0; j < 8; ++j) { const int c = (lane + 64 * j) * 4; const f32x4 gg = *(const f32x4*)(g + c), bv = *(const f32x4*)(bb + c);
        const f32x4 o = v[j] * rstd * gg + bv;
        *(unsigned long long*)(H1 + (size_t)row * D + c) = (unsigned long long)pk2(o.x, o.y) | ((unsigned long long)pk2(o.z, o.w) << 32); }
}
__global__ void __launch_bounds__(256) naive_route(const float* PQ, const float* subkeys, int* E, float* G) {
    __shared__ float qsh[4][256]; __shared__ float sh_s[4][2][16]; __shared__ int sh_i[4][2][16];
    const int w = threadIdx.x >> 6, lane = threadIdx.x & 63, id = blockIdx.x * 4 + w, tok = id >> 3, h = id & 7;
#pragma unroll
    for (int i = 0; i < 4; ++i) qsh[w][lane + 64 * i] = PQ[(size_t)tok * D + h * 256 + lane + 64 * i];
    __syncthreads();
#pragma unroll
    for (int p = 0; p < 2; ++p) {
        float v0 = 0.f, v1 = 0.f; const float* k0 = subkeys + (size_t)((h * 2 + p) * 128 + lane) * 128; const float* k1 = k0 + 64 * 128;
        for (int d = 0; d < 128; ++d) { const float q = qsh[w][p * 128 + d]; v0 += q * k0[d]; v1 += q * k1[d]; }
        for (int r = 0; r < 16; ++r) {
            float bv; int bi; if (v0 >= v1) { bv = v0; bi = lane; } else { bv = v1; bi = lane + 64; }
#pragma unroll
            for (int o = 1; o < 64; o <<= 1) { const float ov = __shfl_xor(bv, o); const int oi = __shfl_xor(bi, o); if (ov > bv || (ov == bv && oi < bi)) { bv = ov; bi = oi; } }
            if (bi == lane) v0 = -INFINITY; if (bi == lane + 64) v1 = -INFINITY;
            if (lane == 0) { sh_s[w][p][r] = bv; sh_i[w][p][r] = bi; }
        }
    }
    __syncthreads();
    float cv[4];
#pragma unroll
    for (int c = 0; c < 4; ++c) { const int f = lane + 64 * c; cv[c] = sh_s[w][0][f >> 4] + sh_s[w][1][f & 15]; }
    float mys = 0.f; int myf = 0;
    for (int r = 0; r < 16; ++r) {
        float bv = cv[0]; int bi = lane;
#pragma unroll
        for (int c = 1; c < 4; ++c) if (cv[c] > bv) { bv = cv[c]; bi = lane + 64 * c; }
#pragma unroll
        for (int o = 1; o < 64; o <<= 1) { const float ov = __shfl_xor(bv, o); const int oi = __shfl_xor(bi, o); if (ov > bv || (ov == bv && oi < bi)) { bv = ov; bi = oi; } }
#pragma unroll
        for (int c = 0; c < 4; ++c) if (bi == lane + 64 * c) cv[c] = -INFINITY;
        if (lane == r) { mys = bv; myf = bi; }
    }
    const float mx = __shfl(mys, 0);
    const float ex = lane < 16 ? expf(mys - mx) : 0.f;
    const float sum = wave_sum(ex);
    if (lane < 16) { E[(size_t)tok * 128 + h * 16 + lane] = sh_i[w][0][myf >> 4] * 128 + sh_i[w][1][myf & 15]; G[(size_t)tok * 128 + h * 16 + lane] = ex / sum; }
}
__global__ void __launch_bounds__(256) naive_peer(const bf16* H1, const int* E, const float* G, const float* u_tab, const float* v_tab, const float* g2, const float* b2, float* out) {
    __shared__ float hs[D]; __shared__ float wts[128]; __shared__ int es[128]; __shared__ float red[4];
    const int tok = blockIdx.x, tid = threadIdx.x, w = tid >> 6, lane = tid & 63;
#pragma unroll
    for (int i = 0; i < 8; ++i) hs[tid + 256 * i] = bf2f(H1[(size_t)tok * D + tid + 256 * i]);
    if (tid < 128) es[tid] = E[(size_t)tok * 128 + tid];
    __syncthreads();
    for (int k = w; k < 128; k += 4) {
        const f32x4* ur = (const f32x4*)(u_tab + (size_t)es[k] * D); float d = 0.f;
#pragma unroll
        for (int i = 0; i < 8; ++i) { const f32x4 uu = ur[lane + 64 * i]; const float* hp = hs + (lane + 64 * i) * 4; d += uu.x * hp[0] + uu.y * hp[1] + uu.z * hp[2] + uu.w * hp[3]; }
        d = wave_sum(d);
        if (lane == 0) wts[k] = G[(size_t)tok * 128 + k] * gelu_tanh(d);
    }
    __syncthreads();
    f32x4 a0 = {0.f, 0.f, 0.f, 0.f}, a1 = {0.f, 0.f, 0.f, 0.f};
    const int c0 = tid * 4, c1 = 1024 + tid * 4;
    for (int k = 0; k < 128; ++k) { const float* vr = v_tab + (size_t)es[k] * D; const float ww = wts[k]; a0 = a0 + *(const f32x4*)(vr + c0) * ww; a1 = a1 + *(const f32x4*)(vr + c1) * ww; }
    f32x4 y0, y1;
    y0.x = DN_ALPHA * hs[c0] + a0.x; y0.y = DN_ALPHA * hs[c0 + 1] + a0.y; y0.z = DN_ALPHA * hs[c0 + 2] + a0.z; y0.w = DN_ALPHA * hs[c0 + 3] + a0.w;
    y1.x = DN_ALPHA * hs[c1] + a1.x; y1.y = DN_ALPHA * hs[c1 + 1] + a1.y; y1.z = DN_ALPHA * hs[c1 + 2] + a1.z; y1.w = DN_ALPHA * hs[c1 + 3] + a1.w;
    const float mean = blk_sum((y0.x + y0.y) + (y0.z + y0.w) + (y1.x + y1.y) + (y1.z + y1.w), red) * (1.f / D);
    y0 = y0 - mean; y1 = y1 - mean;
    const float var = blk_sum((y0.x * y0.x + y0.y * y0.y) + (y0.z * y0.z + y0.w * y0.w) + (y1.x * y1.x + y1.y * y1.y) + (y1.z * y1.z + y1.w * y1.w), red) * (1.f / D);
    const float rstd = rsqrtf(var + LN_EPS);
    *(f32x4*)(out + (size_t)tok * D + c0) = y0 * rstd * *(const f32x4*)(g2 + c0) + *(const f32x4*)(b2 + c0);
    *(f32x4*)(out + (size_t)tok * D + c1) = y1 * rstd * *(const f32x4*)(g2 + c1) + *(const f32x4*)(b2 + c1);
}

extern "C" void kernel_launch(void* const* d_in, const int* in_sizes, int n_in, void* d_out, int out_size, void* d_ws, size_t ws_size, hipStream_t stream) {
    static int grid = 0;
    if (grid == 0) {
        if (n_in != 23 || in_sizes[0] != M * D || out_size != M * D || ws_size < WS_END) { fprintf(stderr, "kernel_launch: unexpected shapes n_in %d in0 %d out %d ws %zu\n", n_in, n_in > 0 ? in_sizes[0] : -1, out_size, ws_size); grid = -1; return; }
        int dev = 0, cus = 0;
        if (hipGetDevice(&dev) != hipSuccess || hipDeviceGetAttribute(&cus, hipDeviceAttributeMultiprocessorCount, dev) != hipSuccess) { grid = -1; return; }
        if (hipFuncSetAttribute((const void*)skel_fwd, hipFuncAttributeMaxDynamicSharedMemorySize, LDS_BYTES) != hipSuccess) { grid = -1; return; }
        grid = cus;
    }
    if (grid < 0) return;
    (void)hipMemsetAsync((char*)d_ws + WS_CTL, 0, CTL_ZERO_BYTES, stream);
    Args a{};
    for (int i = 0; i < 23; ++i) a.in[i] = (const float*)d_in[i];
    a.out = (float*)d_out; a.ws = (unsigned char*)d_ws;
    unsigned char* ws = (unsigned char*)d_ws;
    const float* const* in = (const float* const*)d_in;
    float* prm = (float*)(ws + WS_PRM);
    bf16 *Q = (bf16*)(ws + WS_Q), *K = (bf16*)(ws + WS_K), *V = (bf16*)(ws + WS_V), *XR = (bf16*)(ws + WS_XR), *XG = (bf16*)(ws + WS_XG), *MIX = (bf16*)(ws + WS_MIX), *H1 = (bf16*)(ws + WS_H1);
    float *LA = (float*)(ws + WS_LA), *LB = (float*)(ws + WS_LB), *Y1 = (float*)(ws + WS_Y1), *PQ = (float*)(ws + WS_PQ), *G = (float*)(ws + WS_G); int* E = (int*)(ws + WS_E);
#ifndef MK_MULTI
    a.ph_lo = -1; a.ph_hi = 0; hipLaunchKernelGGL(skel_fwd, dim3(grid), dim3(NWAVES * 64), LDS_BYTES, stream, a);
#else
    for (int sl = 0; sl < 12; ++sl) { a.ph_lo = 1 << sl; a.ph_hi = 0; hipLaunchKernelGGL(skel_fwd, dim3(grid), dim3(NWAVES * 64), LDS_BYTES, stream, a); }
#endif
}
```

```cpp
#include <hip/hip_runtime.h>
#include <cstdio>
#include <cstdint>
namespace pg8 {
#define PG8_LAS __attribute__((address_space(3)))
typedef unsigned short bf16_t;
typedef short bf16x8 __attribute__((ext_vector_type(8)));
typedef float f32x4 __attribute__((ext_vector_type(4)));
typedef unsigned u32x4 __attribute__((ext_vector_type(4)));
constexpr int BM = 256, BK = 64, HALF = 128, HTB = HALF * BK * 2  , STAGE_BYTES = 8 * HTB, NXCD = 8, WGM = 8;

__host__ __device__ __forceinline__ int lds_byte(int r, int c) { const int st = (r >> 4) * 2 + (c >> 5), rr = r & 15, cc = c & 31, ob = rr * 64 + cc * 2; return st * 1024 + (ob ^ (((ob >> 9) & 1) << 5)); }
__host__ __device__ __forceinline__ void stage_rc(int b, int& R, int& C) { const int st = b / 1024, sb = b % 1024, swz = sb ^ (((sb >> 9) & 1) << 5); R = (st >> 1) * 16 + swz / 64; C = (st & 1) * 32 + (swz % 64) / 2; }
__host__ __device__ __forceinline__ int perm32(int rho) { const int n = rho >> 4, i = rho & 15; return 8 * (i >> 2) + 4 * n + (i & 3); }

struct Unit { int pm, pn; };
struct Gemm { const bf16_t* A; const bf16_t* Bt; int M, N, K; };

struct StaticOrder {
    int nM, nN, nwg, G, c;
    __host__ __device__ void init(int M, int N, int G_, int c_) { nM = M / BM; nN = N / BM; nwg = nM * nN; G = G_; c = c_; }
    __host__ __device__ bool next(int i, Unit& u) const {
        const long L = (long)i * G + c; if (L >= nwg) return false;
        int wgid = (int)L; { const int q = nwg / NXCD, r = nwg % NXCD, xcd = wgid % NXCD, off = wgid / NXCD; wgid = (xcd < r ? xcd * (q + 1) : r * (q + 1) + (xcd - r) * q) + off; }
        const int nig = WGM * nN, gid = wgid / nig, fm = gid * WGM, gsz = (nM - fm) < WGM ? (nM - fm) : WGM;
        u.pm = fm + ((wgid % nig) % gsz); u.pn = (wgid % nig) / gsz; return true;
    }
    __device__ __forceinline__ void a_ready(const Unit&) const {}
    __device__ __forceinline__ void done(const Unit&) const {}
};

__device__ __forceinline__ unsigned cvt_pk_bf16(float lo, float hi) { unsigned r; asm volatile("v_cvt_pk_bf16_f32 %0, %1, %2" : "=v"(r) : "v"(lo), "v"(hi)); return r; }
typedef float f32x2 __attribute__((ext_vector_type(2)));
__device__ __forceinline__ f32x2 gelu_pk(f32x2 v) {
    const f32x2 av = __builtin_elementwise_abs(v), d = av * 0.2316418882f + 1.0f;
    f32x2 t; t.x = __builtin_amdgcn_rcpf(d.x); t.y = __builtin_amdgcn_rcpf(d.y);
    f32x2 q = t * 0.5307027145f + (-0.7265760135f); q = q * t + 0.7107068705f; q = q * t + (-0.142248368f); q = q * t + 0.127414796f; q = q * t;
    const f32x2 s = (v * v) * (-0.72134752044f);
    f32x2 e; e.x = __builtin_amdgcn_exp2f(s.x); e.y = __builtin_amdgcn_exp2f(s.y);
    const f32x2 m = v * (q * e), r = v - m;
    f32x2 o; o.x = v.x < 0.f ? m.x : r.x; o.y = v.y < 0.f ? m.y : r.y; return o;
}

template <int ACT  > struct EpiBf16 {
    static constexpr bool PERM = true, AFTER_DRAIN = false; static_assert(ACT == 0 || ACT == 1, "EpiBf16: ACT is 0 (none) or 1 (gelu_pk)");
    bf16_t* O; int ldc; const float* bias; int split_cols; size_t split_stride; float scale0;
    __device__ __forceinline__ void operator()(const f32x4 (&acc)[2][2][4][2], const Unit& u, int wr, int wc, int fr, int fq) const {
        const int row0 = u.pm * BM + wr * 64 + fr; int colt = u.pn * BM; bf16_t* base = O;
        float sc = 1.f; if (split_cols) { const int t = colt / split_cols; base += (size_t)t * split_stride; colt -= t * split_cols; if (t == 0) sc = scale0; }
        const int col0 = colt + wc * 32 + 8 * fq, bcol0 = u.pn * BM + wc * 32 + 8 * fq;
        f32x4 bv[2][2];
#pragma unroll
        for (int bj = 0; bj < 2; ++bj)
#pragma unroll
            for (int n = 0; n < 2; ++n) bv[bj][n] = bias ? *(const f32x4*)(bias + bcol0 + bj * HALF + 4 * n) : (f32x4){0.f, 0.f, 0.f, 0.f};
#pragma unroll
        for (int ai = 0; ai < 2; ++ai)
#pragma unroll
            for (int m = 0; m < 4; ++m) { bf16_t* rowp = base + (size_t)(row0 + ai * HALF + m * 16) * ldc + col0;
#pragma unroll
                for (int bj = 0; bj < 2; ++bj) { f32x4 v0 = acc[ai][bj][m][0] + bv[bj][0], v1 = acc[ai][bj][m][1] + bv[bj][1];
                    if (ACT == 1) { f32x2 a = gelu_pk((f32x2){v0[0], v0[1]}), b = gelu_pk((f32x2){v0[2], v0[3]}), c = gelu_pk((f32x2){v1[0], v1[1]}), d = gelu_pk((f32x2){v1[2], v1[3]});
                        v0 = (f32x4){a.x, a.y, b.x, b.y}; v1 = (f32x4){c.x, c.y, d.x, d.y}; }
                    v0 = v0 * sc; v1 = v1 * sc; u32x4 w; w.x = cvt_pk_bf16(v0[0], v0[1]); w.y = cvt_pk_bf16(v0[2], v0[3]); w.z = cvt_pk_bf16(v1[0], v1[1]); w.w = cvt_pk_bf16(v1[2], v1[3]);
                    *(u32x4*)(rowp + bj * HALF) = w; } }
    }
};

struct PanelStats {
    unsigned* xbuf;
    unsigned* cnt;
    unsigned* tmo;
    int ntn; float eps;
    unsigned code;
    __device__ __forceinline__ bool run(const f32x4 (&v)[2][2][4][2], const Unit& u, int wr, int wc, int fr, int fq, PG8_LAS unsigned char* lds, int wid, int lane) const {
        typedef float f32x2v __attribute__((ext_vector_type(2)));
        PG8_LAS f32x2v* P = (PG8_LAS f32x2v*)lds;
        PG8_LAS f32x2v* S = (PG8_LAS f32x2v*)(lds + 8192);
        PG8_LAS unsigned* flag = (PG8_LAS unsigned*)(lds + 8192 + 2048);
#pragma unroll
        for (int ai = 0; ai < 2; ++ai)
#pragma unroll
            for (int m = 0; m < 4; ++m) {
                float s = 0.f;
#pragma unroll
                for (int bj = 0; bj < 2; ++bj)
#pragma unroll
                    for (int n = 0; n < 2; ++n) { const f32x4 x = v[ai][bj][m][n]; s += (x[0] + x[1]) + (x[2] + x[3]); }
                s += __shfl_xor(s, 16); s += __shfl_xor(s, 32);
                const float mw = s * (1.0f / 64.0f); float q = 0.f;
#pragma unroll
                for (int bj = 0; bj < 2; ++bj)
#pragma unroll
                    for (int n = 0; n < 2; ++n) { const f32x4 d = v[ai][bj][m][n] - mw; q += (d[0] * d[0] + d[1] * d[1]) + (d[2] * d[2] + d[3] * d[3]); }
                q += __shfl_xor(q, 16); q += __shfl_xor(q, 32);
                if (fq == 0) P[(ai * HALF + wr * 64 + m * 16 + fr) * 4 + wc] = (f32x2v){mw, q};
            }
        asm volatile("s_waitcnt lgkmcnt(0)" ::: "memory"); __builtin_amdgcn_s_barrier(); asm volatile("" ::: "memory");
#if defined(BROKEN_EXCHANGE_NO_WAIT)
#warning BROKEN CONTROL BUILD: the row-statistics exchange does not wait; results are wrong by design
        if (blockIdx.x >= 64) { const long long t0_ = clock64(); while (clock64() - t0_ < 60000) __builtin_amdgcn_s_sleep(8); }
#endif
        const int row = wid * 32 + (lane & 31);
        if (lane < 32) {
            const f32x2v a = P[row * 4 + 0], b = P[row * 4 + 1], c = P[row * 4 + 2], d = P[row * 4 + 3];
            const float mt = (a.x + b.x + c.x + d.x) * 0.25f;
            const float da = a.x - mt, db = b.x - mt, dc = c.x - mt, dd = d.x - mt;
            const float m2 = (a.y + b.y) + (c.y + d.y) + 64.0f * ((da * da + db * db) + (dc * dc + dd * dd));
            unsigned long long* slot = (unsigned long long*)xbuf + ((size_t)(u.pm * BM + row) * 4 + u.pn);
            __hip_atomic_store(slot, ((unsigned long long)__float_as_uint(m2) << 32) | __float_as_uint(mt), __ATOMIC_RELAXED, __HIP_MEMORY_SCOPE_AGENT);
        }
        asm volatile("s_waitcnt vmcnt(0)" ::: "memory");
        if (lane == 0) __hip_atomic_fetch_add(cnt + 64 * u.pm, 1u, __ATOMIC_RELAXED, __HIP_MEMORY_SCOPE_AGENT);
        if (wid == 0) {
            bool dead = false; const unsigned long long t0 = __builtin_amdgcn_s_memrealtime(); const unsigned want = 8u * (unsigned)ntn;
            for (;;) {
#if defined(BROKEN_EXCHANGE_NO_WAIT)
                break;
#endif
                if ((unsigned)__builtin_amdgcn_readfirstlane(__hip_atomic_load(cnt + 64 * u.pm, __ATOMIC_RELAXED, __HIP_MEMORY_SCOPE_AGENT)) >= want) break;
                if (__builtin_amdgcn_s_memrealtime() - t0 > 2000000ull) {
                    if (lane == 0) { unsigned expect = 0u; __hip_atomic_compare_exchange_strong(tmo + 1, &expect, code | (unsigned)(u.pm & 0xff), __ATOMIC_RELAXED, __ATOMIC_RELAXED, __HIP_MEMORY_SCOPE_AGENT);
                                     __hip_atomic_store(tmo, 1u, __ATOMIC_RELAXED, __HIP_MEMORY_SCOPE_AGENT); }
                    dead = true; break; }
                __builtin_amdgcn_s_sleep(2);
            }
            __builtin_amdgcn_fence(__ATOMIC_ACQUIRE, "agent");
            if (lane == 0) flag[0] = dead ? 1u : 0u;
        }
        asm volatile("s_waitcnt vmcnt(0) lgkmcnt(0)" ::: "memory"); __builtin_amdgcn_s_barrier(); asm volatile("" ::: "memory");
        const bool bad = flag[0] != 0u;
        if (lane < 32) {
            const unsigned long long* slot = (const unsigned long long*)xbuf + (size_t)(u.pm * BM + row) * 4; float mt[4], m2[4]; float ms = 0.f;
#pragma unroll
            for (int t = 0; t < 4; ++t) { if (t < ntn) { const unsigned long long w = __hip_atomic_load(slot + t, __ATOMIC_RELAXED, __HIP_MEMORY_SCOPE_AGENT); mt[t] = __uint_as_float((unsigned)w); m2[t] = __uint_as_float((unsigned)(w >> 32)); } else { mt[t] = 0.f; m2[t] = 0.f; } ms += mt[t]; }
            const float mean = ms / (float)ntn; float q = 0.f;
#pragma unroll
            for (int t = 0; t < 4; ++t) if (t < ntn) { const float dm = mt[t] - mean; q += m2[t] + 256.0f * dm * dm; }
            S[row] = (f32x2v){mean, 1.0f / sqrtf(q / (256.0f * (float)ntn) + eps)};
        }
        asm volatile("s_waitcnt lgkmcnt(0)" ::: "memory"); __builtin_amdgcn_s_barrier(); asm volatile("" ::: "memory");
        return bad;
    }
};
struct EpiLnRes {
    static constexpr bool PERM = false, AFTER_DRAIN = true;
    const float* base; float* out; int ldc; const float* bias; PanelStats st; unsigned poison;
    __device__ __forceinline__ void fused(f32x4 (&acc)[2][2][4][2], const Unit& u, int wr, int wc, int fr, int fq, PG8_LAS unsigned char* lds, int wid, int lane) const {
        typedef float f32x2v __attribute__((ext_vector_type(2)));
        const PG8_LAS f32x2v* S = (const PG8_LAS f32x2v*)(lds + 8192);
        const int col0 = u.pn * BM + wc * 32 + 4 * fq;
#pragma unroll
        for (int bj = 0; bj < 2; ++bj)
#pragma unroll
            for (int n = 0; n < 2; ++n) { const f32x4 bv = bias ? *(const f32x4*)(bias + col0 + bj * HALF + n * 16) : (f32x4){0.f, 0.f, 0.f, 0.f};
#pragma unroll
                for (int ai = 0; ai < 2; ++ai)
#pragma unroll
                    for (int m = 0; m < 4; ++m) acc[ai][bj][m][n] += bv; }
        f32x4 pre[4][2][2];
#pragma unroll
        for (int m = 0; m < 4; ++m) { const size_t off = (size_t)(u.pm * BM + wr * 64 + m * 16 + fr) * ldc + col0;
#pragma unroll
            for (int bj = 0; bj < 2; ++bj)
#pragma unroll
                for (int n = 0; n < 2; ++n) pre[m][bj][n] = *(const f32x4*)(base + off + bj * HALF + n * 16); }
        const bool bad = st.run(acc, u, wr, wc, fr, fq, lds, wid, lane) || poison != 0u;
        const float qnan = __builtin_nanf("");
#pragma unroll
        for (int ai = 0; ai < 2; ++ai)
#pragma unroll
            for (int m = 0; m < 4; ++m) { const int r = ai * HALF + wr * 64 + m * 16 + fr; const f32x2v sr = S[r]; const size_t off = (size_t)(u.pm * BM + r) * ldc + col0;
#pragma unroll
                for (int bj = 0; bj < 2; ++bj)
#pragma unroll
                    for (int n = 0; n < 2; ++n) { const f32x4 bs = ai == 0 ? pre[m][bj][n] : *(const f32x4*)(base + off + bj * HALF + n * 16); f32x4 o = bs + (acc[ai][bj][m][n] - sr.x) * sr.y;
                        if (bad) o = (f32x4){qnan, qnan, qnan, qnan}; *(f32x4*)(out + off + bj * HALF + n * 16) = o; }
                if (m & 1) asm volatile("" ::: "memory"); }
    }
};
struct EpiLnResLn {
    static constexpr bool PERM = false, AFTER_DRAIN = true;
    const float* base; float* out; bf16_t* xn; int ldc; const float* bias; PanelStats st1, st2; unsigned poison;
    __device__ __forceinline__ void fused(f32x4 (&acc)[2][2][4][2], const Unit& u, int wr, int wc, int fr, int fq, PG8_LAS unsigned char* lds, int wid, int lane) const {
        typedef float f32x2v __attribute__((ext_vector_type(2))); typedef unsigned u32x2v __attribute__((ext_vector_type(2)));
        const PG8_LAS f32x2v* S = (const PG8_LAS f32x2v*)(lds + 8192);
        const int col0 = u.pn * BM + wc * 32 + 4 * fq;
#pragma unroll
        for (int bj = 0; bj < 2; ++bj)
#pragma unroll
            for (int n = 0; n < 2; ++n) { const f32x4 bv = bias ? *(const f32x4*)(bias + col0 + bj * HALF + n * 16) : (f32x4){0.f, 0.f, 0.f, 0.f};
#pragma unroll
                for (int ai = 0; ai < 2; ++ai)
#pragma unroll
                    for (int m = 0; m < 4; ++m) acc[ai][bj][m][n] += bv; }
        bool bad = st1.run(acc, u, wr, wc, fr, fq, lds, wid, lane) || poison != 0u;
        const float qnan = __builtin_nanf("");
#pragma unroll
        for (int ai = 0; ai < 2; ++ai)
#pragma unroll
            for (int m = 0; m < 4; ++m) { const int r = ai * HALF + wr * 64 + m * 16 + fr; const f32x2v sr = S[r]; const size_t off = (size_t)(u.pm * BM + r) * ldc + col0;
#pragma unroll
                for (int bj = 0; bj < 2; ++bj)
#pragma unroll
                    for (int n = 0; n < 2; ++n) { const f32x4 bs = *(const f32x4*)(base + off + bj * HALF + n * 16); acc[ai][bj][m][n] = bs + (acc[ai][bj][m][n] - sr.x) * sr.y; }
                asm volatile("" : "+v"(acc[ai][0][m][0]), "+v"(acc[ai][0][m][1]), "+v"(acc[ai][1][m][0]), "+v"(acc[ai][1][m][1]));
                if (m & 1) asm volatile("" ::: "memory"); }
        const bool bad1 = bad;
        bad = st2.run(acc, u, wr, wc, fr, fq, lds, wid, lane) || bad;
#pragma unroll
        for (int ai = 0; ai < 2; ++ai)
#pragma unroll
            for (int m = 0; m < 4; ++m) { const int r = ai * HALF + wr * 64 + m * 16 + fr; const f32x2v sr = S[r]; const size_t off = (size_t)(u.pm * BM + r) * ldc + col0;
#pragma unroll
                for (int bj = 0; bj < 2; ++bj)
#pragma unroll
                    for (int n = 0; n < 2; ++n) { const f32x4 x1 = acc[ai][bj][m][n]; *(f32x4*)(out + off + bj * HALF + n * 16) = bad1 ? (f32x4){qnan, qnan, qnan, qnan} : x1;
                        const f32x4 o = (x1 - sr.x) * sr.y; u32x2v w; w.x = cvt_pk_bf16(o[0], o[1]); w.y = cvt_pk_bf16(o[2], o[3]);
                        if (bad) { w.x = 0x7fc07fc0u; w.y = 0x7fc07fc0u; } *(u32x2v*)(xn + off + bj * HALF + n * 16) = w; }
                asm volatile("" ::: "memory"); }
    }
};

template <class Epi, class Sched, bool ALIGN_EPI = false, bool SP2 = false>
__device__ __forceinline__ void gemm_phase(PG8_LAS unsigned char* lds, const Gemm g, const Sched& S, const Epi& E) {
    const int tid = threadIdx.x, wid = __builtin_amdgcn_readfirstlane(tid >> 6), lane = tid & 63, wr = wid >> 2, wc = wid & 3, fr = lane & 15, fq = lane >> 4;
    const int K = g.K, nt = K / BK;
    unsigned voffA[2], voffB[2];
#pragma unroll
    for (int i = 0; i < 2; ++i) { int R, C; stage_rc(tid * 16 + i * 8192, R, C); const int Rb = Epi::PERM ? ((R & ~31) + perm32(R & 31)) : R;
        voffA[i] = (unsigned)(R * K + C) * 2u; voffB[i] = (unsigned)(Rb * K + C) * 2u; }
    const size_t kstep = (size_t)(BK * 2);
    const size_t hstep = (size_t)HALF * K * 2;
    const size_t tstep = 2 * hstep;
    const unsigned ldsw = (unsigned)wid * 1024u;
    const int aoff = lds_byte(wr * 64 + fr, fq * 8), boff = lds_byte(wc * 32 + fr, fq * 8);
#define PG8_SA(b, h) (((b) * 2 + (h)) * HTB)
#define PG8_SB(b, h) ((4 + (b) * 2 + (h)) * HTB)
#define PG8_STAGE(bufoff, gbase, voff) do { _Pragma("unroll") for (int _i = 0; _i < 2; ++_i) \
        __builtin_amdgcn_global_load_lds((const unsigned*)((const char*)(gbase) + (voff)[_i]), (PG8_LAS unsigned*)(lds + (bufoff) + ldsw + _i * 8192), 16, 0, 0); } while (0)
#define PG8_LDA(dst, b, h) do { _Pragma("unroll") for (int m = 0; m < 4; ++m) _Pragma("unroll") for (int k = 0; k < 2; ++k) dst[m][k] = *(const PG8_LAS bf16x8*)(lds + PG8_SA(b, h) + aoff + m * 2048 + k * 1024); } while (0)
#define PG8_LDB(dst, b, h) do { _Pragma("unroll") for (int n = 0; n < 2; ++n) _Pragma("unroll") for (int k = 0; k < 2; ++k) dst[n][k] = *(const PG8_LAS bf16x8*)(lds + PG8_SB(b, h) + boff + n * 2048 + k * 1024); } while (0)
#define PG8_MMA(ai, bj, At, Bt) do { __builtin_amdgcn_s_setprio(1); _Pragma("unroll") for (int m = 0; m < 4; ++m) _Pragma("unroll") for (int n = 0; n < 2; ++n) _Pragma("unroll") for (int k = 0; k < 2; ++k) \
        acc[ai][bj][m][n] = __builtin_amdgcn_mfma_f32_16x16x32_bf16(Bt[n][k], At[m][k], acc[ai][bj][m][n], 0, 0, 0); __builtin_amdgcn_s_setprio(0); } while (0)
#define PG8_WAIT_V(n) asm volatile("s_waitcnt vmcnt(" #n ")" ::: "memory")
#define PG8_WAIT_L(n) asm volatile("s_waitcnt lgkmcnt(" #n ")" ::: "memory")
#define PG8_BAR __builtin_amdgcn_s_barrier()
#define PG8_SCHED __builtin_amdgcn_sched_barrier(0)
    Unit cur, nxt; int ui = 0;
    if (!S.next(0, cur)) return;
    f32x4 acc[2][2][4][2];
#pragma unroll
    for (int a = 0; a < 2; ++a)
#pragma unroll
        for (int b = 0; b < 2; ++b)
#pragma unroll
            for (int m = 0; m < 4; ++m)
#pragma unroll
                for (int n = 0; n < 2; ++n) acc[a][b][m][n] = (f32x4){0.f, 0.f, 0.f, 0.f};
    bf16x8 At[4][2], B0[2][2], B1[2][2];
    const char* cA = (const char*)g.A + (size_t)cur.pm * tstep; const char* cB = (const char*)g.Bt + (size_t)cur.pn * tstep;
    S.a_ready(cur);
    if constexpr (SP2) {
        PG8_STAGE(PG8_SB(0, 0), cB, voffB); PG8_STAGE(PG8_SB(0, 1), cB + hstep, voffB); PG8_STAGE(PG8_SA(0, 0), cA, voffA); PG8_STAGE(PG8_SA(0, 1), cA + hstep, voffA);
        if (wr == 1) PG8_BAR;
        PG8_WAIT_V(2); PG8_BAR;
        PG8_STAGE(PG8_SB(1, 0), cB + kstep, voffB); PG8_STAGE(PG8_SA(1, 0), cA + kstep, voffA); PG8_STAGE(PG8_SB(1, 1), cB + hstep + kstep, voffB);
        PG8_WAIT_V(6); PG8_BAR;
    } else {
        PG8_STAGE(PG8_SB(0, 0), cB, voffB); PG8_STAGE(PG8_SA(0, 0), cA, voffA); PG8_STAGE(PG8_SB(0, 1), cB + hstep, voffB); PG8_STAGE(PG8_SA(0, 1), cA + hstep, voffA);
        if (wr == 1) PG8_BAR;
        PG8_WAIT_V(4); PG8_BAR;
        PG8_STAGE(PG8_SB(1, 0), cB + kstep, voffB); PG8_STAGE(PG8_SA(1, 0), cA + kstep, voffA); PG8_STAGE(PG8_SB(1, 1), cB + hstep + kstep, voffB);
        PG8_WAIT_V(6); PG8_BAR;
    }
    for (;;) {
        const bool has_next = S.next(ui + 1, nxt);
        const char* nA = has_next ? (const char*)g.A + (size_t)nxt.pm * tstep : cA; const char* nB = has_next ? (const char*)g.Bt + (size_t)nxt.pn * tstep : cB;
        for (int t = 0; t < nt; t += 2) {
            const bool last = (t == nt - 2);
            const char* a1 = cA + (size_t)(t + 1) * kstep;
            const char* a2 = last ? nA : cA + (size_t)(t + 2) * kstep; const char* b2 = last ? nB : cB + (size_t)(t + 2) * kstep;
            const char* a3 = a2 + kstep; const char* b3 = b2 + kstep;
            if (last && has_next) S.a_ready(nxt);
            if constexpr (SP2) {
            PG8_LDB(B0, 0, 0); PG8_LDB(B1, 0, 1); PG8_SCHED; PG8_LDA(At, 0, 0); PG8_STAGE(PG8_SA(1, 1), a1 + hstep, voffA);
            PG8_WAIT_V(8); PG8_WAIT_L(0); PG8_BAR; PG8_MMA(0, 0, At, B0); PG8_MMA(0, 1, At, B1); PG8_BAR; PG8_SCHED;
            PG8_LDA(At, 0, 1); PG8_STAGE(PG8_SB(0, 0), b2, voffB); PG8_STAGE(PG8_SB(0, 1), b2 + hstep, voffB); PG8_STAGE(PG8_SA(0, 0), a2, voffA);
            PG8_WAIT_V(8); PG8_WAIT_L(0); PG8_BAR; PG8_MMA(1, 0, At, B0); PG8_MMA(1, 1, At, B1); PG8_BAR; PG8_SCHED;
            PG8_LDB(B0, 1, 0); PG8_LDB(B1, 1, 1); PG8_SCHED; PG8_LDA(At, 1, 0); PG8_STAGE(PG8_SA(0, 1), a2 + hstep, voffA);
            PG8_WAIT_V(8); PG8_WAIT_L(0); PG8_BAR; PG8_MMA(0, 0, At, B0); PG8_MMA(0, 1, At, B1); PG8_BAR; PG8_SCHED;
            PG8_LDA(At, 1, 1); PG8_STAGE(PG8_SB(1, 0), b3, voffB); PG8_STAGE(PG8_SB(1, 1), b3 + hstep, voffB); PG8_STAGE(PG8_SA(1, 0), a3, voffA);
            PG8_WAIT_V(8); PG8_WAIT_L(0); PG8_BAR; PG8_MMA(1, 0, At, B0); PG8_MMA(1, 1, At, B1); PG8_BAR; PG8_SCHED;
            } else {
            PG8_LDB(B0, 0, 0); PG8_SCHED; PG8_LDA(At, 0, 0); PG8_STAGE(PG8_SA(1, 1), a1 + hstep, voffA);
            PG8_WAIT_L(8); PG8_BAR; PG8_WAIT_L(0); PG8_MMA(0, 0, At, B0); PG8_BAR; PG8_SCHED;
            PG8_LDB(B1, 0, 1); PG8_STAGE(PG8_SB(0, 0), b2, voffB);
            PG8_BAR; PG8_WAIT_L(0); PG8_MMA(0, 1, At, B1); PG8_BAR;
            PG8_LDA(At, 0, 1); PG8_STAGE(PG8_SA(0, 0), a2, voffA);
            PG8_BAR; PG8_WAIT_L(0); PG8_MMA(1, 0, At, B0); PG8_BAR; PG8_SCHED;
            PG8_STAGE(PG8_SB(0, 1), b2 + hstep, voffB);
            PG8_WAIT_V(6); PG8_BAR; PG8_MMA(1, 1, At, B1); PG8_BAR;
            PG8_LDB(B0, 1, 0); PG8_SCHED; PG8_LDA(At, 1, 0); PG8_STAGE(PG8_SA(0, 1), a2 + hstep, voffA);
            PG8_WAIT_L(8); PG8_BAR; PG8_WAIT_L(0); PG8_MMA(0, 0, At, B0); PG8_BAR; PG8_SCHED;
            PG8_LDB(B1, 1, 1); PG8_STAGE(PG8_SB(1, 0), b3, voffB);
            PG8_BAR; PG8_WAIT_L(0); PG8_MMA(0, 1, At, B1); PG8_BAR;
            PG8_LDA(At, 1, 1); PG8_STAGE(PG8_SA(1, 0), a3, voffA);
            PG8_BAR; PG8_WAIT_L(0); PG8_MMA(1, 0, At, B0); PG8_BAR; PG8_SCHED;
            PG8_STAGE(PG8_SB(1, 1), b3 + hstep, voffB);
            PG8_WAIT_V(6); PG8_BAR; PG8_MMA(1, 1, At, B1); PG8_BAR;
            }
        }
        if constexpr (ALIGN_EPI) { if (wr == 0) PG8_BAR; }
        if constexpr (!Epi::AFTER_DRAIN) { E(acc, cur, wr, wc, fr, fq); S.done(cur); }
        if (!has_next) break;
#pragma unroll
        for (int a = 0; a < 2; ++a)
#pragma unroll
            for (int b = 0; b < 2; ++b)
#pragma unroll
                for (int m = 0; m < 4; ++m)
#pragma unroll
                    for (int n = 0; n < 2; ++n) acc[a][b][m][n] = (f32x4){0.f, 0.f, 0.f, 0.f};
        cur = nxt; cA = nA; cB = nB; ++ui;
        if constexpr (ALIGN_EPI) { if (wr == 1) PG8_BAR; }
    }
    PG8_WAIT_V(0);
    if constexpr (!ALIGN_EPI) { if (wr == 0) PG8_BAR; }
    PG8_BAR;
    if constexpr (Epi::AFTER_DRAIN) { E.fused(acc, cur, wr, wc, fr, fq, lds, wid, lane); S.done(cur); }
#undef PG8_SA
#undef PG8_SB
#undef PG8_STAGE
#undef PG8_LDA
#undef PG8_LDB
#undef PG8_MMA
#undef PG8_WAIT_V
#undef PG8_WAIT_L
#undef PG8_BAR
#undef PG8_SCHED
}
}
#ifndef PG8_SP2
#define PG8_SP2 true
#endif
#ifndef PG8_ALIGN
#define PG8_ALIGN true
#endif
namespace pg8 {
struct EpiF32 {
    static constexpr bool PERM = false, AFTER_DRAIN = false;
    float* O; int ldc; const float* base; float alpha;
    __device__ __forceinline__ void operator()(const f32x4 (&acc)[2][2][4][2], const Unit& u, int wr, int wc, int fr, int fq) const {
        const int col0 = u.pn * BM + wc * 32 + 4 * fq;
#pragma unroll
        for (int ai = 0; ai < 2; ++ai)
#pragma unroll
            for (int m = 0; m < 4; ++m) { const size_t off = (size_t)(u.pm * BM + ai * HALF + wr * 64 + m * 16 + fr) * ldc + col0;
#pragma unroll
                for (int bj = 0; bj < 2; ++bj)
#pragma unroll
                    for (int n = 0; n < 2; ++n) { f32x4 v = acc[ai][bj][m][n];
                        if (base) { const f32x4 bs = *(const f32x4*)(base + off + bj * HALF + n * 16); v = v + bs * alpha; }
                        *(f32x4*)(O + off + bj * HALF + n * 16) = v; } }
    }
};
}

#include <hip/hip_bf16.h>
#include <cmath>
namespace attn_body {
using bf16=__hip_bfloat16;
using bf16x8=__attribute__((ext_vector_type(8)))short;
using s16x4=__attribute__((ext_vector_type(4)))short;
using f32x16=__attribute__((ext_vector_type(16)))float;
using u32x4=__attribute__((ext_vector_type(4)))unsigned;
constexpr int BATCH=4,NHEAD=16,SEQ=4096,D=64,DM=NHEAD*D;
constexpr int NW=8,QBLK=32,QB=QBLK*NW,KVBLK=64,NQB=SEQ/QB;
constexpr int ATTN_PITCH=DM, ATTN_UNIT_ROWS=QB;
__device__ __forceinline__ int crow(int r,int hi){return (r&3)+8*(r>>2)+4*hi;}
#define SBAR() __builtin_amdgcn_sched_barrier(0)
__device__ __forceinline__ void cmask(f32x16&p0,f32x16&p1,int jb,int qrel,int hi){
  const float NEG=-INFINITY; int kb=64*jb+4*hi;
  #pragma unroll
  for(int r=0;r<16;++r){int kv=kb+(r&3)+8*(r>>2); if(kv>qrel)p0[r]=NEG; if(kv+32>qrel)p1[r]=NEG;}
}

constexpr int NSLOT=3, SLOTB=8192;
constexpr int LDS_K=0, LDS_V=NSLOT*SLOTB, LDS_WS=2*NSLOT*SLOTB, LDS_OST=LDS_WS+NW*64*4, LDS_BYTES=LDS_OST+NW*4096;
constexpr float C2=0.125f*1.4426950408889634f;
__device__ __forceinline__ void glds16(const void*gsrc,unsigned lds_dst){unsigned keep;
  asm volatile("s_mov_b32 %0, m0\n\ts_mov_b32 m0, %2\n\ts_nop 0\n\tglobal_load_lds_dwordx4 %1, off\n\ts_mov_b32 m0, %0":"=&s"(keep):"v"(gsrc),"s"(lds_dst):"memory");}
__device__ __forceinline__ float max3f(float a,float b,float c){float r;asm("v_max3_f32 %0, %1, %2, %3":"=v"(r):"v"(a),"v"(b),"v"(c));return r;}
__device__ __forceinline__ float max2f(float a,float b){float r;asm("v_max_f32_e32 %0, %1, %2":"=v"(r):"v"(a),"v"(b));return r;}
__device__ __forceinline__ float fadd_s(float a,float b){float r;asm("v_add_f32_e32 %0, %1, %2":"=v"(r):"v"(a),"v"(b));return r;}
__device__ __forceinline__ float fsub_s(float a,float b){float r;asm("v_sub_f32_e32 %0, %1, %2":"=v"(r):"v"(a),"v"(b));return r;}
typedef float f32x2_t __attribute__((ext_vector_type(2))); typedef __bf16 bf16x2_t __attribute__((ext_vector_type(2)));
__device__ __forceinline__ unsigned cvtpk_s(float lo,float hi){f32x2_t v={lo,hi};bf16x2_t b=__builtin_convertvector(v,bf16x2_t);return __builtin_bit_cast(unsigned,b);}
#define WAIT_BAR(N) asm volatile("s_waitcnt vmcnt(" #N ") lgkmcnt(0)\n\ts_barrier":::"memory")

__device__ __forceinline__ void qkt(f32x16&p0,f32x16&p1,const char*Kslot,const bf16x8*qr,const f32x16&negm,int r32,int hi){
  const char*kb=Kslot+hi*1024+r32*16;
  #pragma unroll
  for(int d0=0;d0<4;++d0){
    const bf16x8 b0=*reinterpret_cast<const bf16x8*>(kb+d0*2048);
    const bf16x8 b1=*reinterpret_cast<const bf16x8*>(kb+d0*2048+512);
    if(d0==0){p0=__builtin_amdgcn_mfma_f32_32x32x16_bf16(b0,qr[0],negm,0,0,0);p1=__builtin_amdgcn_mfma_f32_32x32x16_bf16(b1,qr[0],negm,0,0,0);}
    else{p0=__builtin_amdgcn_mfma_f32_32x32x16_bf16(b0,qr[d0],p0,0,0,0);p1=__builtin_amdgcn_mfma_f32_32x32x16_bf16(b1,qr[d0],p1,0,0,0);}}
}
typedef __attribute__((address_space(3))) const char* lds_cptr;
typedef short v4i16_t __attribute__((ext_vector_type(4)));
__device__ __forceinline__ void kload8(bf16x8*kf,lds_cptr kp){
  kf[0]=*(const __attribute__((address_space(3))) bf16x8*)(kp);      kf[1]=*(const __attribute__((address_space(3))) bf16x8*)(kp+512);
  kf[2]=*(const __attribute__((address_space(3))) bf16x8*)(kp+2048); kf[3]=*(const __attribute__((address_space(3))) bf16x8*)(kp+2560);
  kf[4]=*(const __attribute__((address_space(3))) bf16x8*)(kp+4096); kf[5]=*(const __attribute__((address_space(3))) bf16x8*)(kp+4608);
  kf[6]=*(const __attribute__((address_space(3))) bf16x8*)(kp+6144); kf[7]=*(const __attribute__((address_space(3))) bf16x8*)(kp+6656);
}
__device__ __forceinline__ void kload2(bf16x8*kf,lds_cptr kp,int j){ kf[2*j]=*(const __attribute__((address_space(3))) bf16x8*)(kp+j*2048); kf[2*j+1]=*(const __attribute__((address_space(3))) bf16x8*)(kp+j*2048+512); }
__device__ __forceinline__ s16x4 vtr(lds_cptr p){ return __builtin_bit_cast(s16x4,__builtin_amdgcn_ds_read_tr16_b64_v4i16((__attribute__((address_space(3))) v4i16_t*)p)); }
__device__ __forceinline__ float rowmax(const f32x16&p0,const f32x16&p1){
  float a=max3f(p0[0],p0[1],p1[0]),b=max3f(p0[2],p0[3],p1[1]);a=max3f(a,p1[2],p1[3]);
  #pragma unroll
  for(int r=4;r<16;r+=4){a=max3f(a,p0[r],p0[r+1]);b=max3f(b,p0[r+2],p0[r+3]);a=max3f(a,p1[r],p1[r+1]);b=max3f(b,p1[r+2],p1[r+3]);}
  const float m=max2f(a,b);
  auto rr=__builtin_amdgcn_permlane32_swap(__float_as_uint(m),__float_as_uint(m),false,false);
  return max2f(__uint_as_float(rr[0]),__uint_as_float(rr[1]));
}
__device__ __forceinline__ void pv(f32x16*o,int vb,bf16x8 pa0,bf16x8 pa1,bf16x8 pa2,bf16x8 pa3){
  #pragma unroll
  for(int d0=0;d0<2;++d0){s16x4 lo[4],hi[4];
    #pragma unroll
    for(int ks=0;ks<4;++ks){
      asm volatile("ds_read_b64_tr_b16 %0,%1 offset:%c2":"=&v"(lo[ks]):"v"(vb),"i"(d0*4096+ks*1024):"memory");
      asm volatile("ds_read_b64_tr_b16 %0,%1 offset:%c2":"=&v"(hi[ks]):"v"(vb),"i"(d0*4096+ks*1024+512):"memory");}
    asm volatile("s_waitcnt lgkmcnt(0)":::"memory");SBAR();
    #define PK(k) (bf16x8){lo[k][0],lo[k][1],lo[k][2],lo[k][3],hi[k][0],hi[k][1],hi[k][2],hi[k][3]}
    o[d0]=__builtin_amdgcn_mfma_f32_32x32x16_bf16(pa0,PK(0),o[d0],0,0,0);
    o[d0]=__builtin_amdgcn_mfma_f32_32x32x16_bf16(pa1,PK(1),o[d0],0,0,0);
    o[d0]=__builtin_amdgcn_mfma_f32_32x32x16_bf16(pa2,PK(2),o[d0],0,0,0);
    o[d0]=__builtin_amdgcn_mfma_f32_32x32x16_bf16(pa3,PK(3),o[d0],0,0,0);
    #undef PK
  }
}

#ifndef ATTN_STORE16
#define ATTN_STORE16(p,v) (*(u32x4*)(p)=(v))
#endif
template<int THRL> __device__ __forceinline__ void attn_unit(int b,int h,int hv,float sl2,int qb,const bf16*Q,const bf16*__restrict__ K,const bf16*__restrict__ V,bf16*O,char*shm){
  const int tid=threadIdx.x,lane=tid&63,r32=lane&31,hi=lane>>5; const int wid=__builtin_amdgcn_readfirstlane(tid>>6);
  const long rowbase=(long)b*SEQ; const int q0=qb*QB;
  const bf16*Qw=Q+(rowbase+q0+wid*QBLK)*DM+h*D;
  const bf16*Kh=K+rowbase*DM+h*D,*Vh=V+rowbase*DM+hv*D;
  const unsigned lds0=(unsigned)(uintptr_t)shm;
  float*wsf=(float*)(shm+LDS_WS)+wid*64;
  const bf16*ksrc=Kh+(long)lane*DM+wid*8;
  const bf16*vsrc=Vh+(long)(16*(wid&3)+(lane>>2))*DM+(wid>>2)*32+(lane&3)*8;
  const unsigned kdst=lds0+LDS_K+wid*1024, vdst=lds0+LDS_V+wid*1024;
  #define DMA_K(t,slot) glds16(ksrc+(long)(t)*KVBLK*DM,(unsigned)__builtin_amdgcn_readfirstlane(kdst+(slot)))
  #define DMA_V(t,slot) glds16(vsrc+(long)(t)*KVBLK*DM,(unsigned)__builtin_amdgcn_readfirstlane(vdst+(slot)))
  const int vb0=(int)(lds0+LDS_V)+((lane>>4)&1)*32+(lane&3)*8+(4*hi+((lane&15)>>2))*64;
  const char*Kbase=shm+LDS_K; bf16x8 kf[8];
  const lds_cptr shm3=(lds_cptr)shm; const lds_cptr kp0=shm3+LDS_K+hi*1024+r32*16; const lds_cptr vp0=shm3+LDS_V+((lane>>4)&1)*32+(lane&3)*8+(4*hi+((lane&15)>>2))*64;
  const int NT=(q0+QB)/KVBLK;
  DMA_K(0,0);DMA_V(0,0);DMA_K(1,SLOTB);
  bf16x8 qr[4];
  #pragma unroll
  for(int d0=0;d0<4;++d0)qr[d0]=*reinterpret_cast<const bf16x8*>(&Qw[(long)r32*DM+d0*16+hi*8]);
  float mhat=0.f,l_reg=0.f;f32x16 o[2];o[0]=f32x16{};o[1]=f32x16{};f32x16 negm; { const float nb0_=sl2*(float)(4*hi-q0); _Pragma("unroll") for(int r=0;r<16;++r)negm[r]=nb0_; } asm volatile("":"+v"(negm));
  #define NB(tt) __builtin_fmaf(sl2,(float)(64*(tt)-q0+4*hi),-mhat)
  #define ALIBI(P0,P1) do{ _Pragma("unroll") for(int r=0;r<16;++r){ P0[r]=__builtin_fmaf(sl2,(float)((r&3)+8*(r>>2)),P0[r]); P1[r]=__builtin_fmaf(sl2,(float)(32+(r&3)+8*(r>>2)),P1[r]); } }while(0)
  const int qrel=wid*QBLK+r32;
  #define CMASK(P0,P1,t) do{int jb_=(t)-(NT-4); if(jb_>=0)cmask(P0,P1,jb_,qrel,hi);}while(0)
  bool resc=false;
  #define START(P0,P1) do{ const float rm=rowmax(P0,P1); resc=false; \
    { const float dl=rm; mhat=fadd_s(mhat,dl); \
      _Pragma("unroll") for(int r=0;r<16;++r){P0[r]=fsub_s(P0[r],dl);P1[r]=fsub_s(P1[r],dl);} \
      { const float nb_=NB(1); _Pragma("unroll") for(int r=0;r<16;++r)negm[r]=nb_; } asm volatile("":"+v"(negm)); } \
    _Pragma("unroll") for(int r=0;r<16;++r)P0[r]=__builtin_amdgcn_exp2f(P0[r]); }while(0)
  #define RESC() do{ if(resc){ asm volatile("s_waitcnt lgkmcnt(0)":::"memory"); \
      _Pragma("unroll") for(int d_=0;d_<2;++d_) _Pragma("unroll") for(int r=0;r<16;++r)o[d_][r]*=wsf[crow(r,hi)]; } }while(0)
  f32x16 pA0,pA1,pB0,pB1;
  int sl_prev=0,sl_cur=0,sl_next=SLOTB;
  #define ROT() do{sl_prev=sl_cur;sl_cur=sl_next;sl_next=(sl_next==(NSLOT-1)*SLOTB)?0:sl_next+SLOTB;}while(0)
  DMA_K(2,2*SLOTB);
  WAIT_BAR(3);
  qkt(pA0,pA1,Kbase,qr,negm,r32,hi);asm volatile("s_nop 15\n\ts_nop 7":"+v"(pA0),"+v"(pA1));ALIBI(pA0,pA1);CMASK(pA0,pA1,0);
  START(pA0,pA1);
  _Pragma("unroll") for(int r=0;r<16;++r)pA1[r]=__builtin_amdgcn_exp2f(pA1[r]);
  WAIT_BAR(0);
  DMA_K(3,0);DMA_V(1,SLOTB);
  ROT();
  kload8(kf,kp0+sl_cur);
  WAIT_BAR(2);
  s16x4 vlo[8],vhi[8]; u32x4 pw0,pw1,pw2,pw3;
  #define PKW(P,B) cvtpk_s(P[B],P[B+1])
  #define PAF(k) __builtin_bit_cast(bf16x8,pw##k)
  #define VFR(i) (bf16x8){vlo[i][0],vlo[i][1],vlo[i][2],vlo[i][3],vhi[i][0],vhi[i][1],vhi[i][2],vhi[i][3]}
  #define PIN(x) asm volatile("":"+v"(x))
  #define MX3(a,b,c) __builtin_fmaxf(__builtin_fmaxf((a),(b)),(c))
  #define GAPA(MF,A0,A1,A2,A3,W0,W1,PW) do{ MF; sacc+=A0; sacc+=A1; sacc+=A2; sacc+=A3; PIN(sacc); W0; W1; PIN(PW); SBAR(); }while(0)
  #define EX(v) __builtin_amdgcn_exp2f(v)
  #define GAPB(MF,X,B) do{ MF; X[B]=EX(X[B]); X[B+1]=EX(X[B+1]); X[B+2]=EX(X[B+2]); X[B+3]=EX(X[B+3]); PIN(X); SBAR(); }while(0)
  #define VRD(i) do{ vlo[i]=vtr(vp_+(((i)>>2)*4096+((i)&3)*1024)); vhi[i]=vtr(vp_+(((i)>>2)*4096+((i)&3)*1024+512)); }while(0)
  #define KRD(G,j) do{ if(G){ kload2(kf,kp0+sl_next,j); SBAR(); } }while(0)
  #define STEP(C0,C1,P0,P1,t,GK,GV,GL) do{ SBAR(); \
    const lds_cptr vp_=vp0+sl_prev; \
    VRD(0); SBAR(); float sacc=(P0[0]+P0[1]); \
    GAPA(C0=__builtin_amdgcn_mfma_f32_32x32x16_bf16(kf[0],qr[0],negm,0,0,0), P0[2],P0[3],P0[4],P0[5],     pw0[0]=PKW(P0,0), pw0[1]=PKW(P0,2), pw0); \
    VRD(4); SBAR(); GAPA(C1=__builtin_amdgcn_mfma_f32_32x32x16_bf16(kf[1],qr[0],negm,0,0,0), P0[6],P0[7],P0[8],P0[9],     pw0[2]=PKW(P0,4), pw0[3]=PKW(P0,6), pw0); \
    VRD(1); SBAR(); GAPA(C0=__builtin_amdgcn_mfma_f32_32x32x16_bf16(kf[2],qr[1],C0,0,0,0),   P0[10],P0[11],P0[12],P0[13], pw1[0]=PKW(P0,8), pw1[1]=PKW(P0,10), pw1); \
    VRD(5); SBAR(); GAPA(C1=__builtin_amdgcn_mfma_f32_32x32x16_bf16(kf[3],qr[1],C1,0,0,0),   P0[14],P0[15],P1[0],P1[1],   pw1[2]=PKW(P0,12),pw1[3]=PKW(P0,14), pw1); \
    VRD(2); SBAR(); GAPA(C0=__builtin_amdgcn_mfma_f32_32x32x16_bf16(kf[4],qr[2],C0,0,0,0),   P1[2],P1[3],P1[4],P1[5],     pw2[0]=PKW(P1,0), pw2[1]=PKW(P1,2), pw2); \
    VRD(6); SBAR(); GAPA(C1=__builtin_amdgcn_mfma_f32_32x32x16_bf16(kf[5],qr[2],C1,0,0,0),   P1[6],P1[7],P1[8],P1[9],     pw2[2]=PKW(P1,4), pw2[3]=PKW(P1,6), pw2); \
    VRD(3); SBAR(); GAPA(C0=__builtin_amdgcn_mfma_f32_32x32x16_bf16(kf[6],qr[3],C0,0,0,0),   P1[10],P1[11],P1[12],P1[13], pw3[0]=PKW(P1,8), pw3[1]=PKW(P1,10), pw3); \
    VRD(7); SBAR(); GAPA(C1=__builtin_amdgcn_mfma_f32_32x32x16_bf16(kf[7],qr[3],C1,0,0,0),   P1[14],P1[15],0.f,0.f,       pw3[2]=PKW(P1,12),pw3[3]=PKW(P1,14), pw3); \
    l_reg+=sacc; \
    if(GK){DMA_K((t)+3,sl_cur);} if(GV){DMA_V((t)+1,sl_next);} \
    ALIBI(C0,C1); CMASK(C0,C1,t); \
    { float a=MX3(C0[0],C0[1],C1[0]),b=MX3(C0[2],C0[3],C1[1]); a=MX3(a,C1[2],C1[3]); \
      _Pragma("unroll") for(int r=4;r<16;r+=4){a=MX3(a,C0[r],C0[r+1]);b=MX3(b,C0[r+2],C0[r+3]);a=MX3(a,C1[r],C1[r+1]);b=MX3(b,C1[r+2],C1[r+3]);} \
      float rm=__builtin_fmaxf(a,b); { auto rr=__builtin_amdgcn_permlane32_swap(__float_as_uint(rm),__float_as_uint(rm),false,false); rm=__builtin_fmaxf(__uint_as_float(rr[0]),__uint_as_float(rr[1])); } \
      resc=false; \
      if(__builtin_expect(__any(rm>(float)THRL),0)){ const float dl=__builtin_fmaxf(rm,0.f); mhat+=dl; \
        _Pragma("unroll") for(int r=0;r<16;++r){C0[r]-=dl;C1[r]-=dl;} \
        const float f=__builtin_amdgcn_exp2f(-dl); l_reg*=f; if(hi==0)wsf[r32]=f; resc=true; } \
      { const float nb_=NB((t)+1); _Pragma("unroll") for(int r=0;r<16;++r)negm[r]=nb_; asm volatile("":"+v"(negm)); } } \
    SBAR(); \
    GAPB(o[0]=__builtin_amdgcn_mfma_f32_32x32x16_bf16(PAF(0),VFR(0),o[0],0,0,0), C0,0); \
    GAPB(o[1]=__builtin_amdgcn_mfma_f32_32x32x16_bf16(PAF(0),VFR(4),o[1],0,0,0), C0,4); \
    KRD(GL,0); GAPB(o[0]=__builtin_amdgcn_mfma_f32_32x32x16_bf16(PAF(1),VFR(1),o[0],0,0,0), C0,8); \
    KRD(GL,1); GAPB(o[1]=__builtin_amdgcn_mfma_f32_32x32x16_bf16(PAF(1),VFR(5),o[1],0,0,0), C0,12); \
    KRD(GL,2); GAPB(o[0]=__builtin_amdgcn_mfma_f32_32x32x16_bf16(PAF(2),VFR(2),o[0],0,0,0), C1,0); \
    KRD(GL,3); GAPB(o[1]=__builtin_amdgcn_mfma_f32_32x32x16_bf16(PAF(2),VFR(6),o[1],0,0,0), C1,4); \
    GAPB(o[0]=__builtin_amdgcn_mfma_f32_32x32x16_bf16(PAF(3),VFR(3),o[0],0,0,0), C1,8); \
    GAPB(o[1]=__builtin_amdgcn_mfma_f32_32x32x16_bf16(PAF(3),VFR(7),o[1],0,0,0), C1,12); \
    }while(0)
  int t=1;
  #undef CMASK
  #define CMASK(P0,P1,t) do{}while(0)
  for(;t+5<NT;t+=2){
    STEP(pB0,pB1,pA0,pA1,t,true,true,true);     WAIT_BAR(2); RESC(); ROT();
    STEP(pA0,pA1,pB0,pB1,t+1,true,true,true);   WAIT_BAR(2); RESC(); ROT();
  }
  #undef CMASK
  #define CMASK(P0,P1,t) do{int jb_=(t)-(NT-4); if(jb_>=0)cmask(P0,P1,jb_,qrel,hi);}while(0)
  #define ENDW(tt) do{ if((tt)+3<NT){WAIT_BAR(2);} else if((tt)+2<NT){WAIT_BAR(1);} else {WAIT_BAR(0);} }while(0)
  for(;t+1<NT;t+=2){
    STEP(pB0,pB1,pA0,pA1,t,(t+3<NT),(t+1<NT),(t+1<NT));       ENDW(t);   RESC(); ROT();
    STEP(pA0,pA1,pB0,pB1,t+1,(t+4<NT),(t+2<NT),(t+2<NT));     ENDW(t+1); RESC(); ROT();
  }
  STEP(pB0,pB1,pA0,pA1,NT-1,false,false,false); RESC();
  { float sacc=pB0[0]+pB0[1]; _Pragma("unroll") for(int r=2;r<16;++r)sacc+=pB0[r]; _Pragma("unroll") for(int r=0;r<16;++r)sacc+=pB1[r]; l_reg+=sacc;
    pw0=(u32x4){PKW(pB0,0),PKW(pB0,2),PKW(pB0,4),PKW(pB0,6)};pw1=(u32x4){PKW(pB0,8),PKW(pB0,10),PKW(pB0,12),PKW(pB0,14)};pw2=(u32x4){PKW(pB1,0),PKW(pB1,2),PKW(pB1,4),PKW(pB1,6)};pw3=(u32x4){PKW(pB1,8),PKW(pB1,10),PKW(pB1,12),PKW(pB1,14)};
    SBAR(); pv(o,vb0+sl_cur,PAF(0),PAF(1),PAF(2),PAF(3)); }
  #undef PKW
  #undef PAF
  #undef VFR
  #undef PIN
  #undef MX3
  #undef GAPA
  #undef GAPB
  #undef EX
  #undef VRD
  #undef KRD
  #undef STEP
  #undef ENDW
  {auto rr=__builtin_amdgcn_permlane32_swap(__float_as_uint(l_reg),__float_as_uint(l_reg),false,false);l_reg=__uint_as_float(rr[0])+__uint_as_float(rr[1]);}
  if(hi==0)wsf[32+r32]=l_reg;asm volatile("s_waitcnt lgkmcnt(0)":::"memory");
  float rli[16];
  #pragma unroll
  for(int r=0;r<16;++r)rli[r]=__builtin_amdgcn_rcpf(wsf[32+crow(r,hi)]);
  bf16*Ow=O+(rowbase+q0+wid*QBLK)*DM+hv*D;
  { bf16*stg=(bf16*)(shm+LDS_OST)+wid*2048;
    #pragma unroll
    for(int r=0;r<16;++r){const int orow=crow(r,hi);
      #pragma unroll
      for(int d0=0;d0<2;++d0)stg[orow*64+d0*32+r32]=__float2bfloat16(o[d0][r]*rli[r]);}
    asm volatile("s_waitcnt lgkmcnt(0)":::"memory");
    #pragma unroll
    for(int i=0;i<4;++i){const int row=i*8+(lane>>3),ch=lane&7; const u32x4 v=*(const u32x4*)(stg+row*64+ch*8); ATTN_STORE16(Ow+(long)row*DM+ch*8,v);} }
  asm volatile("s_waitcnt lgkmcnt(0)\n\ts_barrier":::"memory");
  #undef DMA_K
  #undef DMA_V
  #undef CMASK
  #undef START
  #undef RESC
  #undef ROT
  #undef NB
  #undef ALIBI
}
constexpr int ATTN_LDS_BYTES=LDS_BYTES;
struct AttnTensors { const bf16* Q; const bf16* K; const bf16* V; bf16* O0; bf16* O1; };
struct AttnUnit { int hu; int qb; };
struct StaticOrder {
  int vcu, G;
  __device__ __forceinline__ explicit StaticOrder(int grid,int block):vcu((grid%8==0)?(block%8)*(grid/8)+block/8:block),G(grid){}
  __device__ __forceinline__ bool next(int i,AttnUnit&u)const{
    const int p=(i>>1)*G+vcu; if(p>=128*8)return false; u.hu=p>>3; const int s=p&7; u.qb=(i&1)?15-s:s; return true; }
  __device__ __forceinline__ void a_ready(const AttnUnit&)const{}
  __device__ __forceinline__ void done(const AttnUnit&)const{}
};
template<class Sched,int THRL=8> __device__ __forceinline__ void attn_phase(char*lds,const AttnTensors&T,const Sched&S){
  AttnUnit u;
  for(int i=0;S.next(i,u);++i){ S.a_ready(u); { const int b_=u.hu>>5,h_=(u.hu>>2)&7,c_=(u.hu>>1)&1,j_=u.hu&1; const float sl2_=__builtin_amdgcn_exp2f(-(float)(h_+1))*1.4426950408889634f;
      attn_unit<THRL>(b_,2*h_+c_,2*h_+j_,sl2_,u.qb,T.Q,T.K,T.V,c_?T.O1:T.O0,lds); } S.done(u); }
}
#undef SBAR
#undef WAIT_BAR
}

constexpr int NWAVES = 8;
constexpr int BATCH = 4, SEQ = 4096, D = 2048, M = BATCH * SEQ;
constexpr int AW = 1024, NIN = 5120;
constexpr float LN_EPS = 1e-5f;
constexpr float DN_ALPHA = 1.189207115002721f;
constexpr float C2 = 0.125f * 1.4426950408889634f;
constexpr float LOG2E = 1.4426950408889634f;

constexpr size_t MiB = 1u << 20;
constexpr size_t WS_CTL = 0, CTL_ZERO_BYTES = 1 * MiB;
constexpr size_t WS_WIN = 2 * MiB, WS_WOUT = 22 * MiB, WS_WQ = 30 * MiB, WS_PRM = 38 * MiB;
constexpr size_t WS_XB = 40 * MiB;
constexpr size_t WS_MIX = 40 * MiB;
constexpr size_t WS_Q = 104 * MiB, WS_K = 136 * MiB, WS_V = 168 * MiB, WS_XR = 200 * MiB, WS_XG = 232 * MiB;
constexpr size_t WS_Y1 = 104 * MiB;
constexpr size_t WS_H1 = 232 * MiB;
constexpr size_t WS_H8 = 296 * MiB;
constexpr size_t WS_PQ = 104 * MiB;
constexpr size_t WS_SU = 38 * MiB + 65536, WS_SH = 38 * MiB + 131072;
constexpr size_t WS_PART = 104 * MiB;
constexpr size_t WS_FFN = 40 * MiB;
constexpr size_t WS_PK = 2 * MiB;
constexpr size_t WS_U8 = 328 * MiB, WS_V8 = 360 * MiB;
constexpr size_t WS_LA = 328 * MiB, WS_LB = 392 * MiB;
constexpr size_t WS_O0 = 264 * MiB, WS_O1 = 296 * MiB;
constexpr size_t WS_E = 456 * MiB, WS_G = 464 * MiB, WS_TOTA = 472 * MiB, WS_TOTH = 473 * MiB, WS_SKH = 474 * MiB, WS_SKL = 475 * MiB, WS_END = 476 * MiB;
constexpr int CW_BAR = 4096;

constexpr int RING_OFF = 0, RING_BYTES = 131072;
constexpr int LDSCTL_OFF = RING_BYTES, MISC_OFF = LDSCTL_OFF + 320;
constexpr int LDS_BYTES = 147456;

#define GAS __attribute__((address_space(1)))
#define LAS __attribute__((address_space(3)))
typedef unsigned short bf16;
typedef unsigned v4u __attribute__((ext_vector_type(4)));
typedef float f32x4 __attribute__((ext_vector_type(4)));
typedef GAS unsigned gu32;
#define RLX_AGENT __ATOMIC_RELAXED, __HIP_MEMORY_SCOPE_AGENT
#define LDS_WAIT() asm volatile("s_waitcnt lgkmcnt(0)" ::: "memory")
#define VM_WAIT() asm volatile("s_waitcnt vmcnt(0)" ::: "memory")
__device__ __forceinline__ unsigned f2bf(float f) { unsigned u = __builtin_bit_cast(unsigned, f); return (u + 0x7fffu + ((u >> 16) & 1u)) >> 16; }
__device__ __forceinline__ unsigned pk2(float lo, float hi) { return f2bf(lo) | (f2bf(hi) << 16); }
__device__ __forceinline__ float bf2f(unsigned short u) { return __uint_as_float(((unsigned)u) << 16); }
__device__ __forceinline__ float gelu_tanh(float x) { const float u = 0.7978845608028654f * (x + 0.044715f * x * x * x); return 0.5f * x * (1.f + tanhf(u)); }

#define XB_TMO      128
#define XB_XCNT(j)  (256  + 64 * (j))
#define XB_XSUB(j)  (1280 + 64 * (j))
#define XB_XGEN(j)  (2304 + 64 * (j))
#define XB_TOP      3328
#define XB_TOPGEN   3392
#define XCD_BAR_WORDS 3456
#define XB_SPIN_CAP (1u << 18)

__device__ __forceinline__ unsigned xb_ld(unsigned* p)              { return __hip_atomic_load(p, __ATOMIC_RELAXED, __HIP_MEMORY_SCOPE_AGENT); }
__device__ __forceinline__ unsigned xb_add(unsigned* p, unsigned v) { return __hip_atomic_fetch_add(p, v, __ATOMIC_RELAXED, __HIP_MEMORY_SCOPE_AGENT); }
__device__ __forceinline__ unsigned xb_xcc_id() { return (unsigned)__builtin_amdgcn_s_getreg((3 << 11) | 20) & 0xFu; }
#define XB_SPIN(cond, bar) do { unsigned _sp = 0; while (cond) { __builtin_amdgcn_s_sleep(1); \
    if ((++_sp & 255u) == 0u) { if (xb_ld(&(bar)[XB_TMO])) break; if (_sp > XB_SPIN_CAP) { atomicAdd(&(bar)[XB_TMO], 1u); break; } } } } while (0)

struct XcdBarrier {
    unsigned* bar; unsigned x;
    volatile LAS unsigned* st;
};

__device__ __forceinline__ XcdBarrier xcd_barrier_post(unsigned* bar, volatile LAS unsigned* st) {
    XcdBarrier b; b.bar = bar; b.x = xb_xcc_id(); b.st = st;
    if (threadIdx.x == 0) (void)xb_add(&bar[XB_XCNT(b.x)], 1u);
    return b;
}
__device__ __forceinline__ void xcd_barrier_complete(unsigned* bar, unsigned x, unsigned& nloc, unsigned& nx) {
    const unsigned G = gridDim.x * gridDim.y * gridDim.z;
    unsigned sum, cnt, mine, sp = 0u;
    for (;;) {
        sum = 0u; cnt = 0u; mine = 0u;
#pragma unroll
        for (unsigned j = 0; j < 16; ++j) { const unsigned c = xb_ld(&bar[XB_XCNT(j)]); sum += c; cnt += (c > 0u) ? 1u : 0u; mine = (j == x) ? c : mine; }
        if (sum == G) break;
        __builtin_amdgcn_s_sleep(1);
        if ((++sp & 255u) == 0u) { if (xb_ld(&bar[XB_TMO])) break; if (sp > XB_SPIN_CAP) { atomicAdd(&bar[XB_TMO], 1u); break; } }
    }
    nloc = mine > 0u ? mine : 1u; nx = cnt > 0u ? cnt : 1u;
}

__device__ __forceinline__ void xcd_barrier(const XcdBarrier& b) {
    asm volatile("s_waitcnt vmcnt(0)" ::: "memory");
    __syncthreads();
    if (threadIdx.x == 0) {
        unsigned* bar = b.bar;
        __builtin_amdgcn_s_waitcnt(0);
        unsigned nloc = b.st[0], nx = b.st[1];
        if (nloc == 0u) { xcd_barrier_complete(bar, b.x, nloc, nx); b.st[0] = nloc; b.st[1] = nx; }
        const unsigned old = xb_add(&bar[XB_XSUB(b.x)], 1u);
        const unsigned gen = old / nloc;
        if (old + 1u == (gen + 1u) * nloc) {
            __builtin_amdgcn_fence(__ATOMIC_RELEASE, "agent");
            asm volatile("s_waitcnt vmcnt(0)" ::: "memory");
            const unsigned og = xb_add(&bar[XB_TOP], 1u);
            const unsigned tg = og / nx;
            if (og + 1u == (tg + 1u) * nx) xb_add(&bar[XB_TOPGEN], 1u);
            else XB_SPIN(xb_ld(&bar[XB_TOPGEN]) == tg, bar);
            __builtin_amdgcn_fence(__ATOMIC_ACQUIRE, "agent");
            xb_add(&bar[XB_XGEN(b.x)], 1u);
            asm volatile("s_waitcnt vmcnt(0)" ::: "memory");
        } else {
            XB_SPIN(xb_ld(&bar[XB_XGEN(b.x)]) == gen, bar);
            __builtin_amdgcn_fence(__ATOMIC_ACQUIRE, "agent");
            asm volatile("s_waitcnt vmcnt(0)" ::: "memory");
        }
    }
    __syncthreads();
}

struct Frame {
    LAS unsigned char* lds;
    int tid, lane, wave;
    int vcu, G;
};

__device__ __forceinline__ void p0_transpose_item(const float* W, int K, int N, bf16* WT, int row_off, LAS float* scr, int item, int lane) {
    const int nblk = N / 32, kb = item / nblk, nb = item % nblk, k0 = 64 * kb, n0 = 32 * nb;
#pragma unroll 8
    for (int i = 0; i < 32; ++i) { const int kk = 2 * i + (lane >> 5); scr[kk * 33 + (lane & 31)] = W[(size_t)(k0 + kk) * N + n0 + (lane & 31)]; }
    LDS_WAIT(); asm volatile("" ::: "memory");
    const int c = lane & 7;
#pragma unroll
    for (int j = 0; j < 4; ++j) { const int n = (lane >> 3) + 8 * j; const LAS float* s = scr + (8 * c) * 33 + n;
        v4u o; o.x = pk2(s[0 * 33], s[1 * 33]); o.y = pk2(s[2 * 33], s[3 * 33]); o.z = pk2(s[4 * 33], s[5 * 33]); o.w = pk2(s[6 * 33], s[7 * 33]);
        *(GAS v4u*)(WT + (size_t)(row_off + n0 + n) * K + k0 + 8 * c) = o; }
    LDS_WAIT(); asm volatile("" ::: "memory");
}

typedef short bf16x8 __attribute__((ext_vector_type(8)));
typedef float f32x16 __attribute__((ext_vector_type(16)));
typedef float f32x2_t __attribute__((ext_vector_type(2))); typedef __bf16 bf16x2_t __attribute__((ext_vector_type(2)));
__device__ __forceinline__ unsigned cvtpk(float lo, float hi) { f32x2_t v = {lo, hi}; bf16x2_t b = __builtin_convertvector(v, bf16x2_t); return __builtin_bit_cast(unsigned, b); }
__device__ __forceinline__ void split8(const f32x4 a, const f32x4 b, bf16x8& h, bf16x8& l) {
    v4u hh; hh.x = cvtpk(a.x, a.y); hh.y = cvtpk(a.z, a.w); hh.z = cvtpk(b.x, b.y); hh.w = cvtpk(b.z, b.w);
    v4u ll;
    ll.x = cvtpk(a.x - __uint_as_float(hh.x << 16), a.y - __uint_as_float(hh.x & 0xffff0000u));
    ll.y = cvtpk(a.z - __uint_as_float(hh.y << 16), a.w - __uint_as_float(hh.y & 0xffff0000u));
    ll.z = cvtpk(b.x - __uint_as_float(hh.z << 16), b.y - __uint_as_float(hh.z & 0xffff0000u));
    ll.w = cvtpk(b.z - __uint_as_float(hh.w << 16), b.w - __uint_as_float(hh.w & 0xffff0000u));
    h = __builtin_bit_cast(bf16x8, hh); l = __builtin_bit_cast(bf16x8, ll);
}
__device__ __forceinline__ float max3f_(float a, float b, float c) { return __builtin_fmaxf(__builtin_fmaxf(a, b), c); }
__device__ __forceinline__ float pair_max(float m) { auto rr = __builtin_amdgcn_permlane32_swap(__float_as_uint(m), __float_as_uint(m), false, false); return __builtin_fmaxf(__uint_as_float(rr[0]), __uint_as_float(rr[1])); }
__device__ __forceinline__ void route_half(const float* qp, const v4u* kh, const v4u* kl, int lane, int hi, float (&lst)[16]) {
    f32x16 sc[4];
#pragma unroll
    for (int kt = 0; kt < 4; ++kt) sc[kt] = f32x16{};
#pragma unroll 2
    for (int ds = 0; ds < 8; ++ds) { bf16x8 qh, ql; split8(*(const f32x4*)(qp + 16 * ds), *(const f32x4*)(qp + 16 * ds + 4), qh, ql);
#pragma unroll
        for (int kt = 0; kt < 4; ++kt) { const bf16x8 ah = __builtin_bit_cast(bf16x8, kh[(kt * 8 + ds) * 64 + lane]), al = __builtin_bit_cast(bf16x8, kl[(kt * 8 + ds) * 64 + lane]);
            sc[kt] = __builtin_amdgcn_mfma_f32_32x32x16_bf16(ah, qh, sc[kt], 0, 0, 0);
            sc[kt] = __builtin_amdgcn_mfma_f32_32x32x16_bf16(ah, ql, sc[kt], 0, 0, 0);
            sc[kt] = __builtin_amdgcn_mfma_f32_32x32x16_bf16(al, qh, sc[kt], 0, 0, 0); } }
#pragma unroll
    for (int kt = 0; kt < 4; ++kt)
#pragma unroll
        for (int r = 0; r < 16; ++r) { const unsigned key = (unsigned)(kt * 32 + (r & 3) + 8 * (r >> 2) + 4 * hi); sc[kt][r] = __uint_as_float((__float_as_uint(sc[kt][r]) & ~127u) | (127u - key)); }
#pragma unroll
    for (int rd = 0; rd < 16; ++rd) {
        float m = max3f_(sc[0][0], sc[0][1], sc[0][2]);
#pragma unroll
        for (int n = 3; n + 1 < 64; n += 2) m = max3f_(m, sc[n >> 4][n & 15], sc[(n + 1) >> 4][(n + 1) & 15]);
        m = __builtin_fmaxf(m, sc[3][15]);
        const float gm = pair_max(m); lst[rd] = gm;
#pragma unroll
        for (int kt = 0; kt < 4; ++kt)
#pragma unroll
            for (int r = 0; r < 16; ++r) sc[kt][r] = (__float_as_uint(sc[kt][r]) == __float_as_uint(gm)) ? -INFINITY : sc[kt][r];
    }
}
typedef float f32x2v __attribute__((ext_vector_type(2)));
__device__ __forceinline__ unsigned pk4_fp8(float a, float b, float c, float d) { int p = __builtin_amdgcn_cvt_pk_fp8_f32(a, b, 0, false); p = __builtin_amdgcn_cvt_pk_fp8_f32(c, d, p, true); return (unsigned)p; }
constexpr float U8_SCALE = 64.f;
struct Args { const float* in[23]; float* out; unsigned char* ws; int ph_lo, ph_hi; };

__global__ void __launch_bounds__(NWAVES * 64, 2) skel_fwd(Args args) {
    extern __shared__ __attribute__((aligned(16))) unsigned char lds[];
    Frame F;
    F.lds = (LAS unsigned char*)lds;
    F.tid = threadIdx.x; F.lane = F.tid & 63; F.wave = __builtin_amdgcn_readfirstlane(F.tid >> 6);
    F.G = gridDim.x; { const int bx = blockIdx.x; F.vcu = (F.G % 8 == 0) ? (bx % 8) * (F.G / 8) + bx / 8 : bx; }
    unsigned char* ws = args.ws;
    const float* x = args.in[0];
    bf16* WIN_T = (bf16*)(ws + WS_WIN); bf16* WOUT_T = (bf16*)(ws + WS_WOUT); bf16* WQ_T = (bf16*)(ws + WS_WQ);
    bf16* XB = (bf16*)(ws + WS_XB); bf16* MIX = (bf16*)(ws + WS_MIX); bf16* QB = (bf16*)(ws + WS_Q); bf16* H1 = (bf16*)(ws + WS_H1);
    float* Y1 = (float*)(ws + WS_Y1); float* PQ = (float*)(ws + WS_PQ);
    for (int u = F.tid; u < (LDS_BYTES - LDSCTL_OFF) / 4; u += NWAVES * 64) ((LAS unsigned*)(F.lds + LDSCTL_OFF))[u] = 0u;
    __syncthreads();
    XcdBarrier bar = xcd_barrier_post((unsigned*)(ws + WS_CTL) + CW_BAR, (volatile LAS unsigned*)(F.lds + MISC_OFF) + 8);
    const unsigned phmask = (unsigned)args.ph_lo;
    int slot_ = 0;
#define IN(k) (false)
#define RUN(slotbit) ((phmask >> (slotbit)) & 1u)
#define GRID_BAR() do { if (phmask == 0xffffffffu) xcd_barrier(bar); } while (0)

    if (RUN(0)) {
        if (blockIdx.x == 0 && F.wave == 0) {
            float a_ = args.in[9][F.lane] * args.in[10][F.lane], b_ = args.in[11][F.lane] * args.in[12][F.lane];
#pragma unroll
            for (int o = 1; o < 64; o <<= 1) { a_ += __shfl_xor(a_, o); b_ += __shfl_xor(b_, o); }
            if (F.lane == 0) ((float*)(ws + WS_PRM))[0] = expf(a_) - expf(b_) + 0.2f;
        }
        LAS float* scr = (LAS float*)(F.lds + RING_OFF + F.wave * 16384);
        const int gw = F.vcu * NWAVES + F.wave, NGW = F.G * NWAVES;
        constexpr int I_IN = (D / 64) * (NIN / 32), I_SQ = (D / 64) * (D / 32);
        constexpr int NITEMS = I_IN + 2 * I_SQ;
        for (int it = gw; it < NITEMS; it += NGW) {
            int r = it;
            if (r < I_IN) { p0_transpose_item(args.in[1], D, NIN, WIN_T, 0, scr, r, F.lane); continue; } r -= I_IN;
            if (r < I_SQ) { p0_transpose_item(args.in[14], D, D, WOUT_T, 0, scr, r, F.lane); continue; } r -= I_SQ;
            p0_transpose_item(args.in[17], D, D, WQ_T, 0, scr, r, F.lane);
        }
        {
            const float* sk = args.in[18]; v4u* SKH = (v4u*)(ws + WS_SKH); v4u* SKL = (v4u*)(ws + WS_SKL);
            for (int fi = gw; fi < 512; fi += NGW) { const int ds = fi & 7, kt = (fi >> 3) & 3, hp = fi >> 5;
                const float* src = sk + ((size_t)(hp * 128 + kt * 32 + (F.lane & 31)) * 128 + 16 * ds + 8 * (F.lane >> 5));
                bf16x8 h8, l8; split8(*(const f32x4*)src, *(const f32x4*)(src + 4), h8, l8);
                SKH[fi * 64 + F.lane] = __builtin_bit_cast(v4u, h8); SKL[fi * 64 + F.lane] = __builtin_bit_cast(v4u, l8); }
        }
        for (int m = gw; m < M; m += NGW) {
            const GAS f32x4* xr = (const GAS f32x4*)(x + (size_t)m * D) + F.lane;
            GAS unsigned long long* o8 = (GAS unsigned long long*)(XB + (size_t)m * D) + F.lane;
#pragma unroll
            for (int j = 0; j < 8; ++j) { const f32x4 v = xr[64 * j]; o8[64 * j] = (unsigned long long)pk2(v.x, v.y) | ((unsigned long long)pk2(v.z, v.w) << 32); }
        }
    }
    GRID_BAR();
    if (RUN(1)) {
        pg8::Gemm g{XB, WIN_T, M, NIN, D}; pg8::StaticOrder S; S.init(M, NIN, F.G, (int)blockIdx.x);
        pg8::EpiBf16<0> E{QB, AW, nullptr, AW, (size_t)(WS_K - WS_Q) / 2, C2};
        pg8::gemm_phase<pg8::EpiBf16<0>, pg8::StaticOrder, PG8_ALIGN, PG8_SP2>(F.lds + RING_OFF, g, S, E);
    }
    GRID_BAR();
    if (RUN(2)) {
        LAS float* xc = (LAS float*)(F.lds + RING_OFF);
        const bf16* XR = (const bf16*)(ws + WS_XR); float* LA = (float*)(ws + WS_LA); float* LB = (float*)(ws + WS_LB);
        const float* conv_w = args.in[2]; const float* conv_b = args.in[3]; const float* w_a = args.in[4]; const float* b_a = args.in[5]; const float* w_x = args.in[6]; const float* b_x = args.in[7]; const float* lru_lambda = args.in[8];
        for (int ti = F.vcu; ti < M / 16; ti += F.G) {
            const int tok0 = ti * 16, t0 = tok0 % SEQ;
            __syncthreads();
#pragma unroll
            for (int i = 0; i < 2; ++i) { const int ch = F.tid + 512 * i;
                const float cw0 = conv_w[ch], cw1 = conv_w[1024 + ch], cw2 = conv_w[2048 + ch], cw3 = conv_w[3072 + ch], cb = conv_b[ch];
                float xv[19];
#pragma unroll
                for (int r = 0; r < 19; ++r) xv[r] = (t0 + r - 3 >= 0) ? bf2f(XR[(size_t)(tok0 + r - 3) * AW + ch]) : 0.f;
#pragma unroll
                for (int q = 0; q < 4; ++q) { f32x4 o;
#pragma unroll
                    for (int e = 0; e < 4; ++e) { const int r = 4 * q + e; o[e] = cb + cw0 * xv[r] + cw1 * xv[r + 1] + cw2 * xv[r + 2] + cw3 * xv[r + 3]; }
                    *(LAS f32x4*)(xc + ch * 16 + 4 * q) = o; } }
            __syncthreads();
#pragma unroll 1
            for (int i = 0; i < 2; ++i) { const int ch = F.tid + 512 * i, hb = ch >> 7, jj = ch & 127;
                f32x4 aa[4], ax[4]; { const float ba = b_a[ch], bx = b_x[ch];
#pragma unroll
                    for (int q = 0; q < 4; ++q) { aa[q] = (f32x4){ba, ba, ba, ba}; ax[q] = (f32x4){bx, bx, bx, bx}; } }
                const float* wa = w_a + (size_t)hb * 128 * 128 + jj; const float* wx = w_x + (size_t)hb * 128 * 128 + jj; const LAS float* xk = xc + hb * 128 * 16;
#pragma unroll 4
                for (int k = 0; k < 128; ++k) { const float va = wa[k * 128], vx = wx[k * 128];
#pragma unroll
                    for (int q = 0; q < 4; ++q) { const f32x4 xq = *(const LAS f32x4*)(xk + k * 16 + 4 * q); aa[q] = aa[q] + xq * va; ax[q] = ax[q] + xq * vx; } }
                const float sp = log1pf(__expf(-lru_lambda[ch]));
#pragma unroll
                for (int q = 0; q < 4; ++q)
#pragma unroll
                    for (int e = 0; e < 4; ++e) { const int tt = 4 * q + e;
                        const float r = 1.f / (1.f + __expf(-aa[q][e])), ig = 1.f / (1.f + __expf(-ax[q][e]));
                        const float log_a = -8.f * r * sp, a = __expf(log_a), bt = sqrtf(fmaxf(1.f - a * a, 0.f)) * ig * xc[ch * 16 + tt];
                        LA[(size_t)(tok0 + tt) * 1024 + ch] = a; LB[(size_t)(tok0 + tt) * 1024 + ch] = bt; } }
        }
    }
    GRID_BAR();
    if (RUN(3)) {
        const float* LA = (const float*)(ws + WS_LA); const float* LB = (const float*)(ws + WS_LB); float* TA = (float*)(ws + WS_TOTA); float* TH = (float*)(ws + WS_TOTH);
        const bf16* XG = (const bf16*)(ws + WS_XG);
        const int T = F.vcu * 512 + F.tid;
        for (int it = T; it < 131072; it += F.G * 512) { const int ch = it & 1023, b = (it >> 10) & 3, cc = it >> 12;
#pragma unroll 1
            for (int half = 0; half < 2; ++half) { const int c = half ? 63 - cc : cc; const size_t base = (size_t)(b * SEQ + c * 64) * 1024 + ch;
                if (true) { float A = 1.f, H = 0.f;
#pragma unroll 8
                    for (int t = 0; t < 64; ++t) { const float a = LA[base + (size_t)t * 1024], bt = LB[base + (size_t)t * 1024]; H = a * H + bt; A *= a; }
                    TA[(b * 64 + c) * 1024 + ch] = A; TH[(b * 64 + c) * 1024 + ch] = H;
                } else { float h = 0.f;
                    for (int c2 = 0; c2 < c; ++c2) h = TA[(b * 64 + c2) * 1024 + ch] * h + TH[(b * 64 + c2) * 1024 + ch];
#pragma unroll 8
                    for (int t = 0; t < 64; ++t) { const float a = LA[base + (size_t)t * 1024], bt = LB[base + (size_t)t * 1024]; h = a * h + bt;
                        const float xg = bf2f(XG[base + (size_t)t * 1024]);
                        MIX[(size_t)(b * SEQ + c * 64 + t) * D + 1024 + ch] = (bf16)f2bf(h * gelu_tanh(xg)); } } } }
    }
    GRID_BAR();
    if (RUN(4)) {
        static_assert(attn_body::ATTN_LDS_BYTES <= RING_BYTES && attn_body::ATTN_PITCH == AW, "attention body geometry vs frame");
        const attn_body::AttnTensors AT{(const attn_body::bf16*)QB, (const attn_body::bf16*)(ws + WS_K), (const attn_body::bf16*)(ws + WS_V), (attn_body::bf16*)(ws + WS_O0), (attn_body::bf16*)(ws + WS_O1)};
        const attn_body::StaticOrder S((int)F.G, (int)blockIdx.x);
        attn_body::attn_phase<attn_body::StaticOrder>((char*)lds + RING_OFF, AT, S);
    }
    if (RUN(5)) {
        const float* LA = (const float*)(ws + WS_LA); const float* LB = (const float*)(ws + WS_LB); float* TA = (float*)(ws + WS_TOTA); float* TH = (float*)(ws + WS_TOTH);
        const bf16* XG = (const bf16*)(ws + WS_XG);
        const int T = F.vcu * 512 + F.tid;
        for (int it = T; it < 131072; it += F.G * 512) { const int ch = it & 1023, b = (it >> 10) & 3, cc = it >> 12;
#pragma unroll 1
            for (int half = 0; half < 2; ++half) { const int c = half ? 63 - cc : cc; const size_t base = (size_t)(b * SEQ + c * 64) * 1024 + ch;
                if (false) { float A = 1.f, H = 0.f;
#pragma unroll 8
                    for (int t = 0; t < 64; ++t) { const float a = LA[base + (size_t)t * 1024], bt = LB[base + (size_t)t * 1024]; H = a * H + bt; A *= a; }
                    TA[(b * 64 + c) * 1024 + ch] = A; TH[(b * 64 + c) * 1024 + ch] = H;
                } else { float h = 0.f;
                    for (int c2 = 0; c2 < c; ++c2) h = TA[(b * 64 + c2) * 1024 + ch] * h + TH[(b * 64 + c2) * 1024 + ch];
#pragma unroll 8
                    for (int t = 0; t < 64; ++t) { const float a = LA[base + (size_t)t * 1024], bt = LB[base + (size_t)t * 1024]; h = a * h + bt;
                        const float xg = bf2f(XG[base + (size_t)t * 1024]);
                        MIX[(size_t)(b * SEQ + c * 64 + t) * D + 1024 + ch] = (bf16)f2bf(h * gelu_tanh(xg)); } } } }
    }
    GRID_BAR();
    if (RUN(6)) {
        const int gw = F.vcu * NWAVES + F.wave, NGW = F.G * NWAVES;
        const float lam = ((const float*)(ws + WS_PRM))[0];
        const bf16* O0 = (const bf16*)(ws + WS_O0); const bf16* O1 = (const bf16*)(ws + WS_O1);
        const float g0 = args.in[13][2 * F.lane] * 0.8f, g1 = args.in[13][2 * F.lane + 1] * 0.8f;
        for (int it = gw; it < M * 8; it += NGW) { const int tok = it >> 3, h = it & 7;
            const unsigned a = *(const unsigned*)(O0 + (size_t)tok * AW + h * 128 + 2 * F.lane), b = *(const unsigned*)(O1 + (size_t)tok * AW + h * 128 + 2 * F.lane);
            const float d0 = bf2f((unsigned short)(a & 0xffff)) - lam * bf2f((unsigned short)(b & 0xffff)), d1 = bf2f((unsigned short)(a >> 16)) - lam * bf2f((unsigned short)(b >> 16));
            float ss = d0 * d0 + d1 * d1;
#pragma unroll
            for (int o = 1; o < 64; o <<= 1) ss += __shfl_xor(ss, o);
            const float r = rsqrtf(ss * (1.f / 128.f) + LN_EPS);
            *(unsigned*)(MIX + (size_t)tok * D + h * 128 + 2 * F.lane) = pk2(d0 * r * g0, d1 * r * g1); }
    }
    GRID_BAR();
    if (RUN(7)) {
        pg8::Gemm g{MIX, WOUT_T, M, D, D}; pg8::StaticOrder S; S.init(M, D, F.G, (int)blockIdx.x);
        pg8::EpiF32 E{Y1, D, x, DN_ALPHA};
        pg8::gemm_phase<pg8::EpiF32, pg8::StaticOrder, PG8_ALIGN, PG8_SP2>(F.lds + RING_OFF, g, S, E);
    }
    GRID_BAR();
    if (RUN(8)) {
        const int gw = F.vcu * NWAVES + F.wave, NGW = F.G * NWAVES; const float* g = args.in[15]; const float* bb = args.in[16];
        for (int row = gw; row < M; row += NGW) {
            const f32x4* y = (const f32x4*)(Y1 + (size_t)row * D);
            f32x4 v[8]; float s = 0.f;
#pragma unroll
            for (int j = 0; j < 8; ++j) { v[j] = y[F.lane + 64 * j]; s += (v[j].x + v[j].y) + (v[j].z + v[j].w); }
#pragma unroll
            for (int o = 1; o < 64; o <<= 1) s += __shfl_xor(s, o);
            const float mean = s * (1.f / D); float s2 = 0.f;
#pragma unroll
            for (int j = 0; j < 8; ++j) { v[j] = v[j] - mean; s2 += (v[j].x * v[j].x + v[j].y * v[j].y) + (v[j].z * v[j].z + v[j].w * v[j].w); }
#pragma unroll
            for (int o = 1; o < 64; o <<= 1) s2 += __shfl_xor(s2, o);
            const float rstd = rsqrtf(s2 * (1.f / D) + LN_EPS);
#pragma unroll
            for (int j = 0; j < 8; ++j) { const int c = (F.lane + 64 * j) * 4; const f32x4 gg = *(const f32x4*)(g + c), bv = *(const f32x4*)(bb + c);
                const f32x4 o = v[j] * rstd * gg + bv;
                *(unsigned long long*)(H1 + (size_t)row * D + c) = (unsigned long long)pk2(o.x, o.y) | ((unsigned long long)pk2(o.z, o.w) << 32);
                v[j] = o; }
            float am = 0.f;
#pragma unroll
            for (int j = 0; j < 8; ++j) am = fmaxf(fmaxf(am, fmaxf(fabsf(v[j].x), fabsf(v[j].y))), fmaxf(fabsf(v[j].z), fabsf(v[j].w)));
#pragma unroll
            for (int o = 1; o < 64; o <<= 1) am = fmaxf(am, __shfl_xor(am, o));
            const float qs = am > 0.f ? 127.f / am : 0.f;
            if (F.lane == 0) ((float*)(ws + WS_SH))[row] = am * (1.f / 127.f);
#pragma unroll
            for (int j = 0; j < 8; ++j) { const int c = (F.lane + 64 * j) * 4;
                const unsigned q = ((unsigned)(int)rintf(v[j].x * qs) & 0xffu) | (((unsigned)(int)rintf(v[j].y * qs) & 0xffu) << 8) | (((unsigned)(int)rintf(v[j].z * qs) & 0xffu) << 16) | (((unsigned)(int)rintf(v[j].w * qs) & 0xffu) << 24);
                *(unsigned*)(ws + WS_H8 + ((size_t)(c >> 7) * M + row) * 128 + (c & 127)) = q; }
        }
        {
            const float* us = args.in[19]; float* SU = (float*)(ws + WS_SU);
            for (int e = gw; e < 16384; e += NGW) {
                const f32x4* ur = (const f32x4*)(us + (size_t)e * D); f32x4 uv[8]; float am = 0.f;
#pragma unroll
                for (int j = 0; j < 8; ++j) { uv[j] = ur[F.lane + 64 * j]; am = fmaxf(fmaxf(am, fmaxf(fabsf(uv[j].x), fabsf(uv[j].y))), fmaxf(fabsf(uv[j].z), fabsf(uv[j].w))); }
#pragma unroll
                for (int o = 1; o < 64; o <<= 1) am = fmaxf(am, __shfl_xor(am, o));
                const float qs = am > 0.f ? 127.f / am : 0.f;
                if (F.lane == 0) SU[e] = am * (1.f / 127.f);
#pragma unroll
                for (int j = 0; j < 8; ++j) { const int c = (F.lane + 64 * j) * 4;
                    const unsigned q = ((unsigned)(int)rintf(uv[j].x * qs) & 0xffu) | (((unsigned)(int)rintf(uv[j].y * qs) & 0xffu) << 8) | (((unsigned)(int)rintf(uv[j].z * qs) & 0xffu) << 16) | (((unsigned)(int)rintf(uv[j].w * qs) & 0xffu) << 24);
                    *(unsigned*)(ws + WS_U8 + ((size_t)(c >> 7) * 16384 + e) * 128 + (c & 127)) = q; }
            }
        }
        {
            const f32x4* vs = (const f32x4*)args.in[20]; v4u* V8 = (v4u*)(ws + WS_V8);
            for (size_t i = (size_t)F.vcu * 512 + F.tid; i < (size_t)16384 * 2048 / 16; i += (size_t)F.G * 512) {
                const size_t di = ((i & 127) >> 3) * (size_t)(16384 * 8) + (i >> 7) * 8 + (i & 7);
                const f32x4 b0 = vs[4 * i], b1 = vs[4 * i + 1], b2 = vs[4 * i + 2], b3 = vs[4 * i + 3];
                V8[di] = (v4u){pk4_fp8(b0.x, b0.y, b0.z, b0.w), pk4_fp8(b1.x, b1.y, b1.z, b1.w), pk4_fp8(b2.x, b2.y, b2.z, b2.w), pk4_fp8(b3.x, b3.y, b3.z, b3.w)}; }
        }
    }
    GRID_BAR();
    if (RUN(9)) {
        pg8::Gemm g{H1, WQ_T, M, D, D}; pg8::StaticOrder S; S.init(M, D, F.G, (int)blockIdx.x);
        pg8::EpiF32 E{PQ, D, nullptr, 0.f};
        pg8::gemm_phase<pg8::EpiF32, pg8::StaticOrder, PG8_ALIGN, PG8_SP2>(F.lds + RING_OFF, g, S, E);
    }
    GRID_BAR();
    if (RUN(10)) {
        const int gw = F.vcu * NWAVES + F.wave, NGW = F.G * NWAVES, tl = F.lane & 31, hi = F.lane >> 5;
        LAS unsigned char* scr = F.lds + RING_OFF + F.wave * 1024 + tl * 32;
        const v4u* SKH = (const v4u*)(ws + WS_SKH); const v4u* SKL = (const v4u*)(ws + WS_SKL);
        int* E = (int*)(ws + WS_E); float* G = (float*)(ws + WS_G);
        for (int it = gw; it < (M / 32) * 8; it += NGW) { const int h = it & 7, tok = (it >> 3) * 32 + tl;
            float sa[16], sb[16];
            route_half(PQ + (size_t)tok * D + h * 256 + 8 * hi, SKH + (size_t)(h * 2) * 32 * 64, SKL + (size_t)(h * 2) * 32 * 64, F.lane, hi, sa);
            route_half(PQ + (size_t)tok * D + h * 256 + 128 + 8 * hi, SKH + (size_t)(h * 2 + 1) * 32 * 64, SKL + (size_t)(h * 2 + 1) * 32 * 64, F.lane, hi, sb);
            { unsigned w[4];
#pragma unroll
              for (int q = 0; q < 4; ++q) { w[q] = 0u;
#pragma unroll
                  for (int e = 0; e < 4; ++e) { const unsigned ka = 127u - (__float_as_uint(sa[4 * q + e]) & 127u), kb = 127u - (__float_as_uint(sb[4 * q + e]) & 127u); w[q] |= (hi ? kb : ka) << (8 * e); } }
              *(LAS v4u*)(scr + 16 * hi) = (v4u){w[0], w[1], w[2], w[3]}; }
            float cd[25];
#define CV_(i, j) __uint_as_float((__float_as_uint(sa[i] + sb[j]) & ~255u) | (255u - (unsigned)(16 * (i) + (j))))
            cd[0] = hi ? CV_(0, 1) : CV_(0, 0);
            cd[1] = hi ? CV_(0, 3) : CV_(0, 2);
            cd[2] = hi ? CV_(0, 5) : CV_(0, 4);
            cd[3] = hi ? CV_(0, 7) : CV_(0, 6);
            cd[4] = hi ? CV_(0, 9) : CV_(0, 8);
            cd[5] = hi ? CV_(0, 11) : CV_(0, 10);
            cd[6] = hi ? CV_(0, 13) : CV_(0, 12);
            cd[7] = hi ? CV_(0, 15) : CV_(0, 14);
            cd[8] = hi ? CV_(1, 1) : CV_(1, 0);
            cd[9] = hi ? CV_(1, 3) : CV_(1, 2);
            cd[10] = hi ? CV_(1, 5) : CV_(1, 4);
            cd[11] = hi ? CV_(1, 7) : CV_(1, 6);
            cd[12] = hi ? CV_(2, 1) : CV_(2, 0);
            cd[13] = hi ? CV_(2, 3) : CV_(2, 2);
            cd[14] = hi ? CV_(3, 0) : CV_(2, 4);
            cd[15] = hi ? CV_(3, 2) : CV_(3, 1);
            cd[16] = hi ? CV_(4, 0) : CV_(3, 3);
            cd[17] = hi ? CV_(4, 2) : CV_(4, 1);
            cd[18] = hi ? CV_(5, 1) : CV_(5, 0);
            cd[19] = hi ? CV_(6, 1) : CV_(6, 0);
            cd[20] = hi ? CV_(7, 1) : CV_(7, 0);
            cd[21] = hi ? CV_(9, 0) : CV_(8, 0);
            cd[22] = hi ? CV_(11, 0) : CV_(10, 0);
            cd[23] = hi ? CV_(13, 0) : CV_(12, 0);
            cd[24] = hi ? CV_(15, 0) : CV_(14, 0);
#undef CV_
            float top[16];
#pragma unroll
            for (int rd = 0; rd < 16; ++rd) {
                float m = cd[0];
#pragma unroll
                for (int n = 1; n + 1 < 25; n += 2) m = max3f_(m, cd[n], cd[n + 1]);
                const float gm = pair_max(m); top[rd] = gm;
#pragma unroll
                for (int n = 0; n < 25; ++n) cd[n] = (__float_as_uint(cd[n]) == __float_as_uint(gm)) ? -INFINITY : cd[n];
            }
            float ex[16], sum = 0.f;
#pragma unroll
            for (int r = 0; r < 16; ++r) { ex[r] = __builtin_amdgcn_exp2f((top[r] - top[0]) * LOG2E); sum += ex[r]; }
            const float inv = 1.f / sum;
            asm volatile("s_waitcnt lgkmcnt(0)" ::: "memory");
            int eo[8]; float go[8];
#pragma unroll
            for (int rr = 0; rr < 8; ++rr) { float t0 = top[rr], t1 = top[rr + 8], e0 = ex[rr], e1 = ex[rr + 8]; asm volatile("" : "+v"(t0), "+v"(t1), "+v"(e0), "+v"(e1));
                const unsigned f = 255u - (__float_as_uint(hi ? t1 : t0) & 255u);
                const int ia = scr[f >> 4], ib = scr[16 + (f & 15)]; eo[rr] = ia * 128 + ib; go[rr] = (hi ? e1 : e0) * inv; }
            int* ep = E + (size_t)tok * 128 + h * 16 + 8 * hi; float* gp = G + (size_t)tok * 128 + h * 16 + 8 * hi;
            *(v4u*)ep = (v4u){(unsigned)eo[0], (unsigned)eo[1], (unsigned)eo[2], (unsigned)eo[3]}; *(v4u*)(ep + 4) = (v4u){(unsigned)eo[4], (unsigned)eo[5], (unsigned)eo[6], (unsigned)eo[7]};
            *(f32x4*)gp = (f32x4){go[0], go[1], go[2], go[3]}; *(f32x4*)(gp + 4) = (f32x4){go[4], go[5], go[6], go[7]};
            asm volatile("s_waitcnt lgkmcnt(0)" ::: "memory");
        }
    }
    GRID_BAR();
    if (RUN(11)) {
        const int nlab = F.G < 8 ? F.G : 8, label = (int)blockIdx.x % nlab, nblk = (F.G - label + nlab - 1) / nlab, wx = ((int)blockIdx.x / nlab) * NWAVES + F.wave, nwx = nblk * NWAVES;
        const int lane = F.lane, rr = lane >> 3, cc = lane & 7;
        const int* E = (const int*)(ws + WS_E);
        for (int sl = label; sl < 16; sl += nlab) {
            const unsigned char* Us = ws + WS_U8 + (size_t)sl * 16384 * 128 + 16 * cc;
            const unsigned char* Hs = ws + WS_H8 + (size_t)sl * M * 128 + 16 * cc;
            int* Ps = (int*)(ws + WS_PART) + (size_t)sl * M * 128;
            for (int item = wx; item < M / 8; item += nwx) { const int tok = item * 8 + rr;
                const v4u hq = *(const v4u*)(Hs + (size_t)tok * 128);
                const v4u* ep = (const v4u*)(E + (size_t)tok * 128);
                int res[16];
#pragma unroll
                for (int i = 0; i < 16; ++i) res[i] = 0;
#pragma unroll
                for (int i = 0; i < 16; ++i) {
                    const v4u e0 = ep[2 * i], e1 = ep[2 * i + 1];
#pragma unroll
                    for (int j = 0; j < 8; ++j) { const unsigned e = j < 4 ? e0[j & 3] : e1[j & 3];
                        const v4u a = *(const v4u*)(Us + (size_t)e * 128);
                        int d = __builtin_amdgcn_sdot4((int)a.x, (int)hq.x, 0, false); d = __builtin_amdgcn_sdot4((int)a.y, (int)hq.y, d, false); d = __builtin_amdgcn_sdot4((int)a.z, (int)hq.z, d, false); d = __builtin_amdgcn_sdot4((int)a.w, (int)hq.w, d, false);
                        d += __builtin_amdgcn_update_dpp(0, d, 0xB1, 0xf, 0xf, true); d += __builtin_amdgcn_update_dpp(0, d, 0x4E, 0xf, 0xf, true); d += __builtin_amdgcn_update_dpp(0, d, 0x141, 0xf, 0xf, true);
                        res[i] = (cc == j) ? d : res[i]; } }
                v4u* po = (v4u*)(Ps + (size_t)tok * 128 + cc * 16);
#pragma unroll
                for (int q = 0; q < 4; ++q) po[q] = (v4u){(unsigned)res[4 * q], (unsigned)res[4 * q + 1], (unsigned)res[4 * q + 2], (unsigned)res[4 * q + 3]};
            }
        }
    }
    GRID_BAR();
    if (RUN(12)) {
        const int* P = (const int*)(ws + WS_PART); const int* E = (const int*)(ws + WS_E); const float* G = (const float*)(ws + WS_G); unsigned* PK = (unsigned*)(ws + WS_PK);
        const float* SU = (const float*)(ws + WS_SU); const float* SH = (const float*)(ws + WS_SH);
        for (int idx = F.vcu * 512 + F.tid; idx < M * 128; idx += F.G * 512) { const int tok = idx >> 7, k = idx & 127; const size_t pi = (size_t)tok * 128 + (k & 7) * 16 + (k >> 3); int hsum = 0;
#pragma unroll
            for (int sl = 0; sl < 16; ++sl) hsum += P[(size_t)sl * M * 128 + pi];
            const int e = E[idx];
            const float w = G[idx] * gelu_tanh((float)hsum * SU[e] * SH[tok]);
            PK[idx] = (unsigned)e | (f2bf(w) << 16); }
    }
    GRID_BAR();
    if (RUN(13)) {
        const int nlab = F.G < 8 ? F.G : 8, label = (int)blockIdx.x % nlab, nblk = (F.G - label + nlab - 1) / nlab, wx = ((int)blockIdx.x / nlab) * NWAVES + F.wave, nwx = nblk * NWAVES;
        const int lane = F.lane, rr = lane >> 3, cc = lane & 7;
        const unsigned* PK = (const unsigned*)(ws + WS_PK); bf16* FFN = (bf16*)(ws + WS_FFN);
        for (int sl = label; sl < 16; sl += nlab) {
            const unsigned char* Vs = ws + WS_V8 + (size_t)sl * 16384 * 128 + 16 * cc;
            for (int item = wx; item < M / 8; item += nwx) { const int tok = item * 8 + rr;
                f32x2v av[8];
#pragma unroll
                for (int i = 0; i < 8; ++i) av[i] = (f32x2v){0.f, 0.f};
                const v4u* pk = (const v4u*)(PK + (size_t)tok * 128);
#pragma unroll 2
                for (int k4 = 0; k4 < 32; ++k4) { const v4u p = pk[k4];
#pragma unroll
                    for (int j = 0; j < 4; ++j) { const unsigned e = p[j] & 0xffffu; const float w = __uint_as_float(p[j] & 0xffff0000u); const f32x2v ww = (f32x2v){w, w};
                        const v4u d = *(const v4u*)(Vs + (size_t)e * 128);
#pragma unroll
                        for (int q = 0; q < 4; ++q) { av[2 * q] = av[2 * q] + __builtin_amdgcn_cvt_pk_f32_fp8((int)d[q], false) * ww; av[2 * q + 1] = av[2 * q + 1] + __builtin_amdgcn_cvt_pk_f32_fp8((int)d[q], true) * ww; } } }
                bf16* o = FFN + (size_t)tok * D + sl * 128 + 16 * cc;
                *(v4u*)o = (v4u){pk2(av[0].x, av[0].y), pk2(av[1].x, av[1].y), pk2(av[2].x, av[2].y), pk2(av[3].x, av[3].y)};
                *(v4u*)(o + 8) = (v4u){pk2(av[4].x, av[4].y), pk2(av[5].x, av[5].y), pk2(av[6].x, av[6].y), pk2(av[7].x, av[7].y)};
            }
        }
    }
    GRID_BAR();
    if (RUN(14)) {
        const int gw = F.vcu * NWAVES + F.wave, NGW = F.G * NWAVES, lane = F.lane; const float* g2 = args.in[21]; const float* b2 = args.in[22]; float* out = args.out; const bf16* FFN = (const bf16*)(ws + WS_FFN);
        for (int row = gw; row < M; row += NGW) {
            f32x4 v[8]; float sm = 0.f;
#pragma unroll
            for (int j = 0; j < 8; ++j) { const int c = (lane + 64 * j) * 4; const unsigned long long hq = *(const unsigned long long*)(H1 + (size_t)row * D + c), fq = *(const unsigned long long*)(FFN + (size_t)row * D + c);
                const unsigned h0 = (unsigned)hq, h1_ = (unsigned)(hq >> 32), f0 = (unsigned)fq, f1 = (unsigned)(fq >> 32);
                v[j].x = DN_ALPHA * __uint_as_float(h0 << 16) + __uint_as_float(f0 << 16); v[j].y = DN_ALPHA * __uint_as_float(h0 & 0xffff0000u) + __uint_as_float(f0 & 0xffff0000u);
                v[j].z = DN_ALPHA * __uint_as_float(h1_ << 16) + __uint_as_float(f1 << 16); v[j].w = DN_ALPHA * __uint_as_float(h1_ & 0xffff0000u) + __uint_as_float(f1 & 0xffff0000u);
                sm += (v[j].x + v[j].y) + (v[j].z + v[j].w); }
#pragma unroll
            for (int o = 1; o < 64; o <<= 1) sm += __shfl_xor(sm, o);
            const float mean = sm * (1.f / D); float s2 = 0.f;
#pragma unroll
            for (int j = 0; j < 8; ++j) { v[j] = v[j] - mean; s2 += (v[j].x * v[j].x + v[j].y * v[j].y) + (v[j].z * v[j].z + v[j].w * v[j].w); }
#pragma unroll
            for (int o = 1; o < 64; o <<= 1) s2 += __shfl_xor(s2, o);
            const float rstd = rsqrtf(s2 * (1.f / D) + LN_EPS);
#pragma unroll
            for (int j = 0; j < 8; ++j) { const int c = (lane + 64 * j) * 4; *(f32x4*)(out + (size_t)row * D + c) = v[j] * rstd * *(const f32x4*)(g2 + c) + *(const f32x4*)(b2 + c); }
        }
    }
#undef IN
#undef RUN
#undef GRID_BAR
}

extern "C" void kernel_launch(void* const* d_in, const int* in_sizes, int n_in, void* d_out, int out_size, void* d_ws, size_t ws_size, hipStream_t stream) {
    static int grid = 0;
    if (grid == 0) {
        if (n_in != 23 || in_sizes[0] != M * D || out_size != M * D || ws_size < WS_END) { fprintf(stderr, "kernel_launch: unexpected shapes n_in %d in0 %d out %d ws %zu\n", n_in, n_in > 0 ? in_sizes[0] : -1, out_size, ws_size); grid = -1; return; }
        int dev = 0, cus = 0;
        if (hipGetDevice(&dev) != hipSuccess || hipDeviceGetAttribute(&cus, hipDeviceAttributeMultiprocessorCount, dev) != hipSuccess) { grid = -1; return; }
        if (hipFuncSetAttribute((const void*)skel_fwd, hipFuncAttributeMaxDynamicSharedMemorySize, LDS_BYTES) != hipSuccess) { grid = -1; return; }
        grid = cus;
    }
    if (grid < 0) return;
    (void)hipMemsetAsync((char*)d_ws + WS_CTL, 0, CTL_ZERO_BYTES, stream);
    Args a{};
    for (int i = 0; i < 23; ++i) a.in[i] = (const float*)d_in[i];
    a.out = (float*)d_out; a.ws = (unsigned char*)d_ws;
    unsigned char* ws = (unsigned char*)d_ws;
    const float* const* in = (const float* const*)d_in;
    float* prm = (float*)(ws + WS_PRM);
    bf16 *Q = (bf16*)(ws + WS_Q), *K = (bf16*)(ws + WS_K), *V = (bf16*)(ws + WS_V), *XR = (bf16*)(ws + WS_XR), *XG = (bf16*)(ws + WS_XG), *MIX = (bf16*)(ws + WS_MIX), *H1 = (bf16*)(ws + WS_H1);
    float *LA = (float*)(ws + WS_LA), *LB = (float*)(ws + WS_LB), *Y1 = (float*)(ws + WS_Y1), *PQ = (float*)(ws + WS_PQ), *G = (float*)(ws + WS_G); int* E = (int*)(ws + WS_E);
#ifndef MK_MULTI
    a.ph_lo = -1; a.ph_hi = 0; hipLaunchKernelGGL(skel_fwd, dim3(grid), dim3(NWAVES * 64), LDS_BYTES, stream, a);
#else
    for (int sl = 0; sl < 15; ++sl) { a.ph_lo = 1 << sl; a.ph_hi = 0; hipLaunchKernelGGL(skel_fwd, dim3(grid), dim3(NWAVES * 64), LDS_BYTES, stream, a); }
#endif
}
```

```cpp
#include <hip/hip_runtime.h>
#include <cstdio>
#include <cstdint>
namespace pg8 {
#define PG8_LAS __attribute__((address_space(3)))
typedef unsigned short bf16_t;
typedef short bf16x8 __attribute__((ext_vector_type(8)));
typedef float f32x4 __attribute__((ext_vector_type(4)));
typedef unsigned u32x4 __attribute__((ext_vector_type(4)));
constexpr int BM = 256, BK = 64, HALF = 128, HTB = HALF * BK * 2  , STAGE_BYTES = 8 * HTB, NXCD = 8, WGM = 8;

__host__ __device__ __forceinline__ int lds_byte(int r, int c) { const int st = (r >> 4) * 2 + (c >> 5), rr = r & 15, cc = c & 31, ob = rr * 64 + cc * 2; return st * 1024 + (ob ^ (((ob >> 9) & 1) << 5)); }
__host__ __device__ __forceinline__ void stage_rc(int b, int& R, int& C) { const int st = b / 1024, sb = b % 1024, swz = sb ^ (((sb >> 9) & 1) << 5); R = (st >> 1) * 16 + swz / 64; C = (st & 1) * 32 + (swz % 64) / 2; }
__host__ __device__ __forceinline__ int perm32(int rho) { const int n = rho >> 4, i = rho & 15; return 8 * (i >> 2) + 4 * n + (i & 3); }

struct Unit { int pm, pn; };
struct Gemm { const bf16_t* A; const bf16_t* Bt; int M, N, K; };

struct StaticOrder {
    int nM, nN, nwg, G, c;
    __host__ __device__ void init(int M, int N, int G_, int c_) { nM = M / BM; nN = N / BM; nwg = nM * nN; G = G_; c = c_; }
    __host__ __device__ bool next(int i, Unit& u) const {
        const long L = (long)i * G + c; if (L >= nwg) return false;
        int wgid = (int)L; { const int q = nwg / NXCD, r = nwg % NXCD, xcd = wgid % NXCD, off = wgid / NXCD; wgid = (xcd < r ? xcd * (q + 1) : r * (q + 1) + (xcd - r) * q) + off; }
        const int nig = WGM * nN, gid = wgid / nig, fm = gid * WGM, gsz = (nM - fm) < WGM ? (nM - fm) : WGM;
        u.pm = fm + ((wgid % nig) % gsz); u.pn = (wgid % nig) / gsz; return true;
    }
    __device__ __forceinline__ void a_ready(const Unit&) const {}
    __device__ __forceinline__ void done(const Unit&) const {}
};

__device__ __forceinline__ unsigned cvt_pk_bf16(float lo, float hi) { unsigned r; asm volatile("v_cvt_pk_bf16_f32 %0, %1, %2" : "=v"(r) : "v"(lo), "v"(hi)); return r; }
typedef float f32x2 __attribute__((ext_vector_type(2)));
__device__ __forceinline__ f32x2 gelu_pk(f32x2 v) {
    const f32x2 av = __builtin_elementwise_abs(v), d = av * 0.2316418882f + 1.0f;
    f32x2 t; t.x = __builtin_amdgcn_rcpf(d.x); t.y = __builtin_amdgcn_rcpf(d.y);
    f32x2 q = t * 0.5307027145f + (-0.7265760135f); q = q * t + 0.7107068705f; q = q * t + (-0.142248368f); q = q * t + 0.127414796f; q = q * t;
    const f32x2 s = (v * v) * (-0.72134752044f);
    f32x2 e; e.x = __builtin_amdgcn_exp2f(s.x); e.y = __builtin_amdgcn_exp2f(s.y);
    const f32x2 m = v * (q * e), r = v - m;
    f32x2 o; o.x = v.x < 0.f ? m.x : r.x; o.y = v.y < 0.f ? m.y : r.y; return o;
}

template <int ACT  > struct EpiBf16 {
    static constexpr bool PERM = true, AFTER_DRAIN = false; static_assert(ACT == 0 || ACT == 1, "EpiBf16: ACT is 0 (none) or 1 (gelu_pk)");
    bf16_t* O; int ldc; const float* bias; int split_cols; size_t split_stride; float scale0;
    __device__ __forceinline__ void operator()(const f32x4 (&acc)[2][2][4][2], const Unit& u, int wr, int wc, int fr, int fq) const {
        const int row0 = u.pm * BM + wr * 64 + fr; int colt = u.pn * BM; bf16_t* base = O;
        float sc = 1.f; if (split_cols) { const int t = colt / split_cols; base += (size_t)t * split_stride; colt -= t * split_cols; if (t == 0) sc = scale0; }
        const int col0 = colt + wc * 32 + 8 * fq, bcol0 = u.pn * BM + wc * 32 + 8 * fq;
        f32x4 bv[2][2];
#pragma unroll
        for (int bj = 0; bj < 2; ++bj)
#pragma unroll
            for (int n = 0; n < 2; ++n) bv[bj][n] = bias ? *(const f32x4*)(bias + bcol0 + bj * HALF + 4 * n) : (f32x4){0.f, 0.f, 0.f, 0.f};
#pragma unroll
        for (int ai = 0; ai < 2; ++ai)
#pragma unroll
            for (int m = 0; m < 4; ++m) { bf16_t* rowp = base + (size_t)(row0 + ai * HALF + m * 16) * ldc + col0;
#pragma unroll
                for (int bj = 0; bj < 2; ++bj) { f32x4 v0 = acc[ai][bj][m][0] + bv[bj][0], v1 = acc[ai][bj][m][1] + bv[bj][1];
                    if (ACT == 1) { f32x2 a = gelu_pk((f32x2){v0[0], v0[1]}), b = gelu_pk((f32x2){v0[2], v0[3]}), c = gelu_pk((f32x2){v1[0], v1[1]}), d = gelu_pk((f32x2){v1[2], v1[3]});
                        v0 = (f32x4){a.x, a.y, b.x, b.y}; v1 = (f32x4){c.x, c.y, d.x, d.y}; }
                    v0 = v0 * sc; v1 = v1 * sc; u32x4 w; w.x = cvt_pk_bf16(v0[0], v0[1]); w.y = cvt_pk_bf16(v0[2], v0[3]); w.z = cvt_pk_bf16(v1[0], v1[1]); w.w = cvt_pk_bf16(v1[2], v1[3]);
                    *(u32x4*)(rowp + bj * HALF) = w; } }
    }
};

struct PanelStats {
    unsigned* xbuf;
    unsigned* cnt;
    unsigned* tmo;
    int ntn; float eps;
    unsigned code;
    __device__ __forceinline__ bool run(const f32x4 (&v)[2][2][4][2], const Unit& u, int wr, int wc, int fr, int fq, PG8_LAS unsigned char* lds, int wid, int lane) const {
        typedef float f32x2v __attribute__((ext_vector_type(2)));
        PG8_LAS f32x2v* P = (PG8_LAS f32x2v*)lds;
        PG8_LAS f32x2v* S = (PG8_LAS f32x2v*)(lds + 8192);
        PG8_LAS unsigned* flag = (PG8_LAS unsigned*)(lds + 8192 + 2048);
#pragma unroll
        for (int ai = 0; ai < 2; ++ai)
#pragma unroll
            for (int m = 0; m < 4; ++m) {
                float s = 0.f;
#pragma unroll
                for (int bj = 0; bj < 2; ++bj)
#pragma unroll
                    for (int n = 0; n < 2; ++n) { const f32x4 x = v[ai][bj][m][n]; s += (x[0] + x[1]) + (x[2] + x[3]); }
                s += __shfl_xor(s, 16); s += __shfl_xor(s, 32);
                const float mw = s * (1.0f / 64.0f); float q = 0.f;
#pragma unroll
                for (int bj = 0; bj < 2; ++bj)
#pragma unroll
                    for (int n = 0; n < 2; ++n) { const f32x4 d = v[ai][bj][m][n] - mw; q += (d[0] * d[0] + d[1] * d[1]) + (d[2] * d[2] + d[3] * d[3]); }
                q += __shfl_xor(q, 16); q += __shfl_xor(q, 32);
                if (fq == 0) P[(ai * HALF + wr * 64 + m * 16 + fr) * 4 + wc] = (f32x2v){mw, q};
            }
        asm volatile("s_waitcnt lgkmcnt(0)" ::: "memory"); __builtin_amdgcn_s_barrier(); asm volatile("" ::: "memory");
#if defined(BROKEN_EXCHANGE_NO_WAIT)
#warning BROKEN CONTROL BUILD: the row-statistics exchange does not wait; results are wrong by design
        if (blockIdx.x >= 64) { const long long t0_ = clock64(); while (clock64() - t0_ < 60000) __builtin_amdgcn_s_sleep(8); }
#endif
        const int row = wid * 32 + (lane & 31);
        if (lane < 32) {
            const f32x2v a = P[row * 4 + 0], b = P[row * 4 + 1], c = P[row * 4 + 2], d = P[row * 4 + 3];
            const float mt = (a.x + b.x + c.x + d.x) * 0.25f;
            const float da = a.x - mt, db = b.x - mt, dc = c.x - mt, dd = d.x - mt;
            const float m2 = (a.y + b.y) + (c.y + d.y) + 64.0f * ((da * da + db * db) + (dc * dc + dd * dd));
            unsigned long long* slot = (unsigned long long*)xbuf + ((size_t)(u.pm * BM + row) * 4 + u.pn);
            __hip_atomic_store(slot, ((unsigned long long)__float_as_uint(m2) << 32) | __float_as_uint(mt), __ATOMIC_RELAXED, __HIP_MEMORY_SCOPE_AGENT);
        }
        asm volatile("s_waitcnt vmcnt(0)" ::: "memory");
        if (lane == 0) __hip_atomic_fetch_add(cnt + 64 * u.pm, 1u, __ATOMIC_RELAXED, __HIP_MEMORY_SCOPE_AGENT);
        if (wid == 0) {
            bool dead = false; const unsigned long long t0 = __builtin_amdgcn_s_memrealtime(); const unsigned want = 8u * (unsigned)ntn;
            for (;;) {
#if defined(BROKEN_EXCHANGE_NO_WAIT)
                break;
#endif
                if ((unsigned)__builtin_amdgcn_readfirstlane(__hip_atomic_load(cnt + 64 * u.pm, __ATOMIC_RELAXED, __HIP_MEMORY_SCOPE_AGENT)) >= want) break;
                if (__builtin_amdgcn_s_memrealtime() - t0 > 2000000ull) {
                    if (lane == 0) { unsigned expect = 0u; __hip_atomic_compare_exchange_strong(tmo + 1, &expect, code | (unsigned)(u.pm & 0xff), __ATOMIC_RELAXED, __ATOMIC_RELAXED, __HIP_MEMORY_SCOPE_AGENT);
                                     __hip_atomic_store(tmo, 1u, __ATOMIC_RELAXED, __HIP_MEMORY_SCOPE_AGENT); }
                    dead = true; break; }
                __builtin_amdgcn_s_sleep(2);
            }
            __builtin_amdgcn_fence(__ATOMIC_ACQUIRE, "agent");
            if (lane == 0) flag[0] = dead ? 1u : 0u;
        }
        asm volatile("s_waitcnt vmcnt(0) lgkmcnt(0)" ::: "memory"); __builtin_amdgcn_s_barrier(); asm volatile("" ::: "memory");
        const bool bad = flag[0] != 0u;
        if (lane < 32) {
            const unsigned long long* slot = (const unsigned long long*)xbuf + (size_t)(u.pm * BM + row) * 4; float mt[4], m2[4]; float ms = 0.f;
#pragma unroll
            for (int t = 0; t < 4; ++t) { if (t < ntn) { const unsigned long long w = __hip_atomic_load(slot + t, __ATOMIC_RELAXED, __HIP_MEMORY_SCOPE_AGENT); mt[t] = __uint_as_float((unsigned)w); m2[t] = __uint_as_float((unsigned)(w >> 32)); } else { mt[t] = 0.f; m2[t] = 0.f; } ms += mt[t]; }
            const float mean = ms / (float)ntn; float q = 0.f;
#pragma unroll
            for (int t = 0; t < 4; ++t) if (t < ntn) { const float dm = mt[t] - mean; q += m2[t] + 256.0f * dm * dm; }
            S[row] = (f32x2v){mean, 1.0f / sqrtf(q / (256.0f * (float)ntn) + eps)};
        }
        asm volatile("s_waitcnt lgkmcnt(0)" ::: "memory"); __builtin_amdgcn_s_barrier(); asm volatile("" ::: "memory");
        return bad;
    }
};
struct EpiLnRes {
    static constexpr bool PERM = false, AFTER_DRAIN = true;
    const float* base; float* out; int ldc; const float* bias; PanelStats st; unsigned poison;
    __device__ __forceinline__ void fused(f32x4 (&acc)[2][2][4][2], const Unit& u, int wr, int wc, int fr, int fq, PG8_LAS unsigned char* lds, int wid, int lane) const {
        typedef float f32x2v __attribute__((ext_vector_type(2)));
        const PG8_LAS f32x2v* S = (const PG8_LAS f32x2v*)(lds + 8192);
        const int col0 = u.pn * BM + wc * 32 + 4 * fq;
#pragma unroll
        for (int bj = 0; bj < 2; ++bj)
#pragma unroll
            for (int n = 0; n < 2; ++n) { const f32x4 bv = bias ? *(const f32x4*)(bias + col0 + bj * HALF + n * 16) : (f32x4){0.f, 0.f, 0.f, 0.f};
#pragma unroll
                for (int ai = 0; ai < 2; ++ai)
#pragma unroll
                    for (int m = 0; m < 4; ++m) acc[ai][bj][m][n] += bv; }
        f32x4 pre[4][2][2];
#pragma unroll
        for (int m = 0; m < 4; ++m) { const size_t off = (size_t)(u.pm * BM + wr * 64 + m * 16 + fr) * ldc + col0;
#pragma unroll
            for (int bj = 0; bj < 2; ++bj)
#pragma unroll
                for (int n = 0; n < 2; ++n) pre[m][bj][n] = *(const f32x4*)(base + off + bj * HALF + n * 16); }
        const bool bad = st.run(acc, u, wr, wc, fr, fq, lds, wid, lane) || poison != 0u;
        const float qnan = __builtin_nanf("");
#pragma unroll
        for (int ai = 0; ai < 2; ++ai)
#pragma unroll
            for (int m = 0; m < 4; ++m) { const int r = ai * HALF + wr * 64 + m * 16 + fr; const f32x2v sr = S[r]; const size_t off = (size_t)(u.pm * BM + r) * ldc + col0;
#pragma unroll
                for (int bj = 0; bj < 2; ++bj)
#pragma unroll
                    for (int n = 0; n < 2; ++n) { const f32x4 bs = ai == 0 ? pre[m][bj][n] : *(const f32x4*)(base + off + bj * HALF + n * 16); f32x4 o = bs + (acc[ai][bj][m][n] - sr.x) * sr.y;
                        if (bad) o = (f32x4){qnan, qnan, qnan, qnan}; *(f32x4*)(out + off + bj * HALF + n * 16) = o; }
                if (m & 1) asm volatile("" ::: "memory"); }
    }
};
struct EpiLnResLn {
    static constexpr bool PERM = false, AFTER_DRAIN = true;
    const float* base; float* out; bf16_t* xn; int ldc; const float* bias; PanelStats st1, st2; unsigned poison;
    __device__ __forceinline__ void fused(f32x4 (&acc)[2][2][4][2], const Unit& u, int wr, int wc, int fr, int fq, PG8_LAS unsigned char* lds, int wid, int lane) const {
        typedef float f32x2v __attribute__((ext_vector_type(2))); typedef unsigned u32x2v __attribute__((ext_vector_type(2)));
        const PG8_LAS f32x2v* S = (const PG8_LAS f32x2v*)(lds + 8192);
        const int col0 = u.pn * BM + wc * 32 + 4 * fq;
#pragma unroll
        for (int bj = 0; bj < 2; ++bj)
#pragma unroll
            for (int n = 0; n < 2; ++n) { const f32x4 bv = bias ? *(const f32x4*)(bias + col0 + bj * HALF + n * 16) : (f32x4){0.f, 0.f, 0.f, 0.f};
#pragma unroll
                for (int ai = 0; ai < 2; ++ai)
#pragma unroll
                    for (int m = 0; m < 4; ++m) acc[ai][bj][m][n] += bv; }
        bool bad = st1.run(acc, u, wr, wc, fr, fq, lds, wid, lane) || poison != 0u;
        const float qnan = __builtin_nanf("");
#pragma unroll
        for (int ai = 0; ai < 2; ++ai)
#pragma unroll
            for (int m = 0; m < 4; ++m) { const int r = ai * HALF + wr * 64 + m * 16 + fr; const f32x2v sr = S[r]; const size_t off = (size_t)(u.pm * BM + r) * ldc + col0;
#pragma unroll
                for (int bj = 0; bj < 2; ++bj)
#pragma unroll
                    for (int n = 0; n < 2; ++n) { const f32x4 bs = *(const f32x4*)(base + off + bj * HALF + n * 16); acc[ai][bj][m][n] = bs + (acc[ai][bj][m][n] - sr.x) * sr.y; }
                asm volatile("" : "+v"(acc[ai][0][m][0]), "+v"(acc[ai][0][m][1]), "+v"(acc[ai][1][m][0]), "+v"(acc[ai][1][m][1]));
                if (m & 1) asm volatile("" ::: "memory"); }
        const bool bad1 = bad;
        bad = st2.run(acc, u, wr, wc, fr, fq, lds, wid, lane) || bad;
#pragma unroll
        for (int ai = 0; ai < 2; ++ai)
#pragma unroll
            for (int m = 0; m < 4; ++m) { const int r = ai * HALF + wr * 64 + m * 16 + fr; const f32x2v sr = S[r]; const size_t off = (size_t)(u.pm * BM + r) * ldc + col0;
#pragma unroll
                for (int bj = 0; bj < 2; ++bj)
#pragma unroll
                    for (int n = 0; n < 2; ++n) { const f32x4 x1 = acc[ai][bj][m][n]; *(f32x4*)(out + off + bj * HALF + n * 16) = bad1 ? (f32x4){qnan, qnan, qnan, qnan} : x1;
                        const f32x4 o = (x1 - sr.x) * sr.y; u32x2v w; w.x = cvt_pk_bf16(o[0], o[1]); w.y = cvt_pk_bf16(o[2], o[3]);
                        if (bad) { w.x = 0x7fc07fc0u; w.y = 0x7fc07fc0u; } *(u32x2v*)(xn + off + bj * HALF + n * 16) = w; }
                asm volatile("" ::: "memory"); }
    }
};

template <class Epi, class Sched, bool ALIGN_EPI = false, bool SP2 = false>
__device__ __forceinline__ void gemm_phase(PG8_LAS unsigned char* lds, const Gemm g, const Sched& S, const Epi& E) {
    const int tid = threadIdx.x, wid = __builtin_amdgcn_readfirstlane(tid >> 6), lane = tid & 63, wr = wid >> 2, wc = wid & 3, fr = lane & 15, fq = lane >> 4;
    const int K = g.K, nt = K / BK;
    unsigned voffA[2], voffB[2];
#pragma unroll
    for (int i = 0; i < 2; ++i) { int R, C; stage_rc(tid * 16 + i * 8192, R, C); const int Rb = Epi::PERM ? ((R & ~31) + perm32(R & 31)) : R;
        voffA[i] = (unsigned)(R * K + C) * 2u; voffB[i] = (unsigned)(Rb * K + C) * 2u; }
    const size_t kstep = (size_t)(BK * 2);
    const size_t hstep = (size_t)HALF * K * 2;
    const size_t tstep = 2 * hstep;
    const unsigned ldsw = (unsigned)wid * 1024u;
    const int aoff = lds_byte(wr * 64 + fr, fq * 8), boff = lds_byte(wc * 32 + fr, fq * 8);
#define PG8_SA(b, h) (((b) * 2 + (h)) * HTB)
#define PG8_SB(b, h) ((4 + (b) * 2 + (h)) * HTB)
#define PG8_STAGE(bufoff, gbase, voff) do { _Pragma("unroll") for (int _i = 0; _i < 2; ++_i) \
        __builtin_amdgcn_global_load_lds((const unsigned*)((const char*)(gbase) + (voff)[_i]), (PG8_LAS unsigned*)(lds + (bufoff) + ldsw + _i * 8192), 16, 0, 0); } while (0)
#define PG8_LDA(dst, b, h) do { _Pragma("unroll") for (int m = 0; m < 4; ++m) _Pragma("unroll") for (int k = 0; k < 2; ++k) dst[m][k] = *(const PG8_LAS bf16x8*)(lds + PG8_SA(b, h) + aoff + m * 2048 + k * 1024); } while (0)
#define PG8_LDB(dst, b, h) do { _Pragma("unroll") for (int n = 0; n < 2; ++n) _Pragma("unroll") for (int k = 0; k < 2; ++k) dst[n][k] = *(const PG8_LAS bf16x8*)(lds + PG8_SB(b, h) + boff + n * 2048 + k * 1024); } while (0)
#define PG8_MMA(ai, bj, At, Bt) do { __builtin_amdgcn_s_setprio(1); _Pragma("unroll") for (int m = 0; m < 4; ++m) _Pragma("unroll") for (int n = 0; n < 2; ++n) _Pragma("unroll") for (int k = 0; k < 2; ++k) \
        acc[ai][bj][m][n] = __builtin_amdgcn_mfma_f32_16x16x32_bf16(Bt[n][k], At[m][k], acc[ai][bj][m][n], 0, 0, 0); __builtin_amdgcn_s_setprio(0); } while (0)
#define PG8_WAIT_V(n) asm volatile("s_waitcnt vmcnt(" #n ")" ::: "memory")
#define PG8_WAIT_L(n) asm volatile("s_waitcnt lgkmcnt(" #n ")" ::: "memory")
#define PG8_BAR __builtin_amdgcn_s_barrier()
#define PG8_SCHED __builtin_amdgcn_sched_barrier(0)
    Unit cur, nxt; int ui = 0;
    if (!S.next(0, cur)) return;
    f32x4 acc[2][2][4][2];
#pragma unroll
    for (int a = 0; a < 2; ++a)
#pragma unroll
        for (int b = 0; b < 2; ++b)
#pragma unroll
            for (int m = 0; m < 4; ++m)
#pragma unroll
                for (int n = 0; n < 2; ++n) acc[a][b][m][n] = (f32x4){0.f, 0.f, 0.f, 0.f};
    bf16x8 At[4][2], B0[2][2], B1[2][2];
    const char* cA = (const char*)g.A + (size_t)cur.pm * tstep; const char* cB = (const char*)g.Bt + (size_t)cur.pn * tstep;
    S.a_ready(cur);
    if constexpr (SP2) {
        PG8_STAGE(PG8_SB(0, 0), cB, voffB); PG8_STAGE(PG8_SB(0, 1), cB + hstep, voffB); PG8_STAGE(PG8_SA(0, 0), cA, voffA); PG8_STAGE(PG8_SA(0, 1), cA + hstep, voffA);
        if (wr == 1) PG8_BAR;
        PG8_WAIT_V(2); PG8_BAR;
        PG8_STAGE(PG8_SB(1, 0), cB + kstep, voffB); PG8_STAGE(PG8_SA(1, 0), cA + kstep, voffA); PG8_STAGE(PG8_SB(1, 1), cB + hstep + kstep, voffB);
        PG8_WAIT_V(6); PG8_BAR;
    } else {
        PG8_STAGE(PG8_SB(0, 0), cB, voffB); PG8_STAGE(PG8_SA(0, 0), cA, voffA); PG8_STAGE(PG8_SB(0, 1), cB + hstep, voffB); PG8_STAGE(PG8_SA(0, 1), cA + hstep, voffA);
        if (wr == 1) PG8_BAR;
        PG8_WAIT_V(4); PG8_BAR;
        PG8_STAGE(PG8_SB(1, 0), cB + kstep, voffB); PG8_STAGE(PG8_SA(1, 0), cA + kstep, voffA); PG8_STAGE(PG8_SB(1, 1), cB + hstep + kstep, voffB);
        PG8_WAIT_V(6); PG8_BAR;
    }
    for (;;) {
        const bool has_next = S.next(ui + 1, nxt);
        const char* nA = has_next ? (const char*)g.A + (size_t)nxt.pm * tstep : cA; const char* nB = has_next ? (const char*)g.Bt + (size_t)nxt.pn * tstep : cB;
        for (int t = 0; t < nt; t += 2) {
            const bool last = (t == nt - 2);
            const char* a1 = cA + (size_t)(t + 1) * kstep;
            const char* a2 = last ? nA : cA + (size_t)(t + 2) * kstep; const char* b2 = last ? nB : cB + (size_t)(t + 2) * kstep;
            const char* a3 = a2 + kstep; const char* b3 = b2 + kstep;
            if (last && has_next) S.a_ready(nxt);
            if constexpr (SP2) {
            PG8_LDB(B0, 0, 0); PG8_LDB(B1, 0, 1); PG8_SCHED; PG8_LDA(At, 0, 0); PG8_STAGE(PG8_SA(1, 1), a1 + hstep, voffA);
            PG8_WAIT_V(8); PG8_WAIT_L(0); PG8_BAR; PG8_MMA(0, 0, At, B0); PG8_MMA(0, 1, At, B1); PG8_BAR; PG8_SCHED;
            PG8_LDA(At, 0, 1); PG8_STAGE(PG8_SB(0, 0), b2, voffB); PG8_STAGE(PG8_SB(0, 1), b2 + hstep, voffB); PG8_STAGE(PG8_SA(0, 0), a2, voffA);
            PG8_WAIT_V(8); PG8_WAIT_L(0); PG8_BAR; PG8_MMA(1, 0, At, B0); PG8_MMA(1, 1, At, B1); PG8_BAR; PG8_SCHED;
            PG8_LDB(B0, 1, 0); PG8_LDB(B1, 1, 1); PG8_SCHED; PG8_LDA(At, 1, 0); PG8_STAGE(PG8_SA(0, 1), a2 + hstep, voffA);
            PG8_WAIT_V(8); PG8_WAIT_L(0); PG8_BAR; PG8_MMA(0, 0, At, B0); PG8_MMA(0, 1, At, B1); PG8_BAR; PG8_SCHED;
            PG8_LDA(At, 1, 1); PG8_STAGE(PG8_SB(1, 0), b3, voffB); PG8_STAGE(PG8_SB(1, 1), b3 + hstep, voffB); PG8_STAGE(PG8_SA(1, 0), a3, voffA);
            PG8_WAIT_V(8); PG8_WAIT_L(0); PG8_BAR; PG8_MMA(1, 0, At, B0); PG8_MMA(1, 1, At, B1); PG8_BAR; PG8_SCHED;
            } else {
            PG8_LDB(B0, 0, 0); PG8_SCHED; PG8_LDA(At, 0, 0); PG8_STAGE(PG8_SA(1, 1), a1 + hstep, voffA);
            PG8_WAIT_L(8); PG8_BAR; PG8_WAIT_L(0); PG8_MMA(0, 0, At, B0); PG8_BAR; PG8_SCHED;
            PG8_LDB(B1, 0, 1); PG8_STAGE(PG8_SB(0, 0), b2, voffB);
            PG8_BAR; PG8_WAIT_L(0); PG8_MMA(0, 1, At, B1); PG8_BAR;
            PG8_LDA(At, 0, 1); PG8_STAGE(PG8_SA(0, 0), a2, voffA);
            PG8_BAR; PG8_WAIT_L(0); PG8_MMA(1, 0, At, B0); PG8_BAR; PG8_SCHED;
            PG8_STAGE(PG8_SB(0, 1), b2 + hstep, voffB);
            PG8_WAIT_V(6); PG8_BAR; PG8_MMA(1, 1, At, B1); PG8_BAR;
            PG8_LDB(B0, 1, 0); PG8_SCHED; PG8_LDA(At, 1, 0); PG8_STAGE(PG8_SA(0, 1), a2 + hstep, voffA);
            PG8_WAIT_L(8); PG8_BAR; PG8_WAIT_L(0); PG8_MMA(0, 0, At, B0); PG8_BAR; PG8_SCHED;
            PG8_LDB(B1, 1, 1); PG8_STAGE(PG8_SB(1, 0), b3, voffB);
            PG8_BAR; PG8_WAIT_L(0); PG8_MMA(0, 1, At, B1); PG8_BAR;
            PG8_LDA(At, 1, 1); PG8_STAGE(PG8_SA(1, 0), a3, voffA);
            PG8_BAR; PG8_WAIT_L(0); PG8_MMA(1, 0, At, B0); PG8_BAR; PG8_SCHED;
            PG8_STAGE(PG8_SB(1, 1), b3 + hstep, voffB);
            PG8_WAIT_V(6); PG8_BAR; PG8_MMA(1, 1, At, B1); PG8_BAR;
            }
        }
        if constexpr (ALIGN_EPI) { if (wr == 0) PG8_BAR; }
        if constexpr (!Epi::AFTER_DRAIN) { E(acc, cur, wr, wc, fr, fq); S.done(cur); }
        if (!has_next) break;
#pragma unroll
        for (int a = 0; a < 2; ++a)
#pragma unroll
            for (int b = 0; b < 2; ++b)
#pragma unroll
                for (int m = 0; m < 4; ++m)
#pragma unroll
                    for (int n = 0; n < 2; ++n) acc[a][b][m][n] = (f32x4){0.f, 0.f, 0.f, 0.f};
        cur = nxt; cA = nA; cB = nB; ++ui;
        if constexpr (ALIGN_EPI) { if (wr == 1) PG8_BAR; }
    }
    PG8_WAIT_V(0);
    if constexpr (!ALIGN_EPI) { if (wr == 0) PG8_BAR; }
    PG8_BAR;
    if constexpr (Epi::AFTER_DRAIN) { E.fused(acc, cur, wr, wc, fr, fq, lds, wid, lane); S.done(cur); }
#undef PG8_SA
#undef PG8_SB
#undef PG8_STAGE
#undef PG8_LDA
#undef PG8_LDB
#undef PG8_MMA
#undef PG8_WAIT_V
#undef PG8_WAIT_L
#undef PG8_BAR
#undef PG8_SCHED
}
}
#ifndef PG8_SP2
#define PG8_SP2 true
#endif
#ifndef PG8_ALIGN
#define PG8_ALIGN true
#endif
namespace pg8 {
struct EpiF32 {
    static constexpr bool PERM = false, AFTER_DRAIN = false;
    float* O; int ldc; const float* base; float alpha;
    __device__ __forceinline__ void operator()(const f32x4 (&acc)[2][2][4][2], const Unit& u, int wr, int wc, int fr, int fq) const {
        const int col0 = u.pn * BM + wc * 32 + 4 * fq;
#pragma unroll
        for (int ai = 0; ai < 2; ++ai)
#pragma unroll
            for (int m = 0; m < 4; ++m) { const size_t off = (size_t)(u.pm * BM + ai * HALF + wr * 64 + m * 16 + fr) * ldc + col0;
#pragma unroll
                for (int bj = 0; bj < 2; ++bj)
#pragma unroll
                    for (int n = 0; n < 2; ++n) { f32x4 v = acc[ai][bj][m][n];
                        if (base) { const f32x4 bs = *(const f32x4*)(base + off + bj * HALF + n * 16); v = v + bs * alpha; }
                        *(f32x4*)(O + off + bj * HALF + n * 16) = v; } }
    }
};
}

#include <hip/hip_bf16.h>
#include <cmath>
namespace attn_body {
using bf16=__hip_bfloat16;
using bf16x8=__attribute__((ext_vector_type(8)))short;
using s16x4=__attribute__((ext_vector_type(4)))short;
using f32x16=__attribute__((ext_vector_type(16)))float;
using u32x4=__attribute__((ext_vector_type(4)))unsigned;
constexpr int BATCH=4,NHEAD=16,SEQ=4096,D=64,DM=NHEAD*D;
constexpr int NW=8,QBLK=32,QB=QBLK*NW,KVBLK=64,NQB=SEQ/QB;
constexpr int ATTN_PITCH=DM, ATTN_UNIT_ROWS=QB;
__device__ __forceinline__ int crow(int r,int hi){return (r&3)+8*(r>>2)+4*hi;}
#define SBAR() __builtin_amdgcn_sched_barrier(0)
__device__ __forceinline__ void cmask(f32x16&p0,f32x16&p1,int jb,int qrel,int hi){
  const float NEG=-INFINITY; int kb=64*jb+4*hi;
  #pragma unroll
  for(int r=0;r<16;++r){int kv=kb+(r&3)+8*(r>>2); if(kv>qrel)p0[r]=NEG; if(kv+32>qrel)p1[r]=NEG;}
}

constexpr int NSLOT=3, SLOTB=8192;
constexpr int LDS_K=0, LDS_V=NSLOT*SLOTB, LDS_WS=2*NSLOT*SLOTB, LDS_OST=LDS_WS+NW*64*4, LDS_BYTES=LDS_OST+NW*4096;
constexpr float C2=0.125f*1.4426950408889634f;
__device__ __forceinline__ void glds16(const void*gsrc,unsigned lds_dst){unsigned keep;
  asm volatile("s_mov_b32 %0, m0\n\ts_mov_b32 m0, %2\n\ts_nop 0\n\tglobal_load_lds_dwordx4 %1, off\n\ts_mov_b32 m0, %0":"=&s"(keep):"v"(gsrc),"s"(lds_dst):"memory");}
__device__ __forceinline__ float max3f(float a,float b,float c){float r;asm("v_max3_f32 %0, %1, %2, %3":"=v"(r):"v"(a),"v"(b),"v"(c));return r;}
__device__ __forceinline__ float max2f(float a,float b){float r;asm("v_max_f32_e32 %0, %1, %2":"=v"(r):"v"(a),"v"(b));return r;}
__device__ __forceinline__ float fadd_s(float a,float b){float r;asm("v_add_f32_e32 %0, %1, %2":"=v"(r):"v"(a),"v"(b));return r;}
__device__ __forceinline__ float fsub_s(float a,float b){float r;asm("v_sub_f32_e32 %0, %1, %2":"=v"(r):"v"(a),"v"(b));return r;}
typedef float f32x2_t __attribute__((ext_vector_type(2))); typedef __bf16 bf16x2_t __attribute__((ext_vector_type(2)));
__device__ __forceinline__ unsigned cvtpk_s(float lo,float hi){f32x2_t v={lo,hi};bf16x2_t b=__builtin_convertvector(v,bf16x2_t);return __builtin_bit_cast(unsigned,b);}
#define WAIT_BAR(N) asm volatile("s_waitcnt vmcnt(" #N ") lgkmcnt(0)\n\ts_barrier":::"memory")

__device__ __forceinline__ void qkt(f32x16&p0,f32x16&p1,const char*Kslot,const bf16x8*qr,const f32x16&negm,int r32,int hi){
  const char*kb=Kslot+hi*1024+r32*16;
  #pragma unroll
  for(int d0=0;d0<4;++d0){
    const bf16x8 b0=*reinterpret_cast<const bf16x8*>(kb+d0*2048);
    const bf16x8 b1=*reinterpret_cast<const bf16x8*>(kb+d0*2048+512);
    if(d0==0){p0=__builtin_amdgcn_mfma_f32_32x32x16_bf16(b0,qr[0],negm,0,0,0);p1=__builtin_amdgcn_mfma_f32_32x32x16_bf16(b1,qr[0],negm,0,0,0);}
    else{p0=__builtin_amdgcn_mfma_f32_32x32x16_bf16(b0,qr[d0],p0,0,0,0);p1=__builtin_amdgcn_mfma_f32_32x32x16_bf16(b1,qr[d0],p1,0,0,0);}}
}
typedef __attribute__((address_space(3))) const char* lds_cptr;
typedef short v4i16_t __attribute__((ext_vector_type(4)));
__device__ __forceinline__ void kload8(bf16x8*kf,lds_cptr kp){
  kf[0]=*(const __attribute__((address_space(3))) bf16x8*)(kp);      kf[1]=*(const __attribute__((address_space(3))) bf16x8*)(kp+512);
  kf[2]=*(const __attribute__((address_space(3))) bf16x8*)(kp+2048); kf[3]=*(const __attribute__((address_space(3))) bf16x8*)(kp+2560);
  kf[4]=*(const __attribute__((address_space(3))) bf16x8*)(kp+4096); kf[5]=*(const __attribute__((address_space(3))) bf16x8*)(kp+4608);
  kf[6]=*(const __attribute__((address_space(3))) bf16x8*)(kp+6144); kf[7]=*(const __attribute__((address_space(3))) bf16x8*)(kp+6656);
}
__device__ __forceinline__ void kload2(bf16x8*kf,lds_cptr kp,int j){ kf[2*j]=*(const __attribute__((address_space(3))) bf16x8*)(kp+j*2048); kf[2*j+1]=*(const __attribute__((address_space(3))) bf16x8*)(kp+j*2048+512); }
__device__ __forceinline__ s16x4 vtr(lds_cptr p){ return __builtin_bit_cast(s16x4,__builtin_amdgcn_ds_read_tr16_b64_v4i16((__attribute__((address_space(3))) v4i16_t*)p)); }
__device__ __forceinline__ float rowmax(const f32x16&p0,const f32x16&p1){
  float a=max3f(p0[0],p0[1],p1[0]),b=max3f(p0[2],p0[3],p1[1]);a=max3f(a,p1[2],p1[3]);
  #pragma unroll
  for(int r=4;r<16;r+=4){a=max3f(a,p0[r],p0[r+1]);b=max3f(b,p0[r+2],p0[r+3]);a=max3f(a,p1[r],p1[r+1]);b=max3f(b,p1[r+2],p1[r+3]);}
  const float m=max2f(a,b);
  auto rr=__builtin_amdgcn_permlane32_swap(__float_as_uint(m),__float_as_uint(m),false,false);
  return max2f(__uint_as_float(rr[0]),__uint_as_float(rr[1]));
}
__device__ __forceinline__ void pv(f32x16*o,int vb,bf16x8 pa0,bf16x8 pa1,bf16x8 pa2,bf16x8 pa3){
  #pragma unroll
  for(int d0=0;d0<2;++d0){s16x4 lo[4],hi[4];
    #pragma unroll
    for(int ks=0;ks<4;++ks){
      asm volatile("ds_read_b64_tr_b16 %0,%1 offset:%c2":"=&v"(lo[ks]):"v"(vb),"i"(d0*4096+ks*1024):"memory");
      asm volatile("ds_read_b64_tr_b16 %0,%1 offset:%c2":"=&v"(hi[ks]):"v"(vb),"i"(d0*4096+ks*1024+512):"memory");}
    asm volatile("s_waitcnt lgkmcnt(0)":::"memory");SBAR();
    #define PK(k) (bf16x8){lo[k][0],lo[k][1],lo[k][2],lo[k][3],hi[k][0],hi[k][1],hi[k][2],hi[k][3]}
    o[d0]=__builtin_amdgcn_mfma_f32_32x32x16_bf16(pa0,PK(0),o[d0],0,0,0);
    o[d0]=__builtin_amdgcn_mfma_f32_32x32x16_bf16(pa1,PK(1),o[d0],0,0,0);
    o[d0]=__builtin_amdgcn_mfma_f32_32x32x16_bf16(pa2,PK(2),o[d0],0,0,0);
    o[d0]=__builtin_amdgcn_mfma_f32_32x32x16_bf16(pa3,PK(3),o[d0],0,0,0);
    #undef PK
  }
}

#ifndef ATTN_STORE16
#define ATTN_STORE16(p,v) (*(u32x4*)(p)=(v))
#endif
template<int THRL> __device__ __forceinline__ void attn_unit(int b,int h,int hv,float sl2,int qb,const bf16*Q,const bf16*__restrict__ K,const bf16*__restrict__ V,bf16*O,char*shm){
  const int tid=threadIdx.x,lane=tid&63,r32=lane&31,hi=lane>>5; const int wid=__builtin_amdgcn_readfirstlane(tid>>6);
  const long rowbase=(long)b*SEQ; const int q0=qb*QB;
  const bf16*Qw=Q+(rowbase+q0+wid*QBLK)*DM+h*D;
  const bf16*Kh=K+rowbase*DM+h*D,*Vh=V+rowbase*DM+hv*D;
  const unsigned lds0=(unsigned)(uintptr_t)shm;
  float*wsf=(float*)(shm+LDS_WS)+wid*64;
  const bf16*ksrc=Kh+(long)lane*DM+wid*8;
  const bf16*vsrc=Vh+(long)(16*(wid&3)+(lane>>2))*DM+(wid>>2)*32+(lane&3)*8;
  const unsigned kdst=lds0+LDS_K+wid*1024, vdst=lds0+LDS_V+wid*1024;
  #define DMA_K(t,slot) glds16(ksrc+(long)(t)*KVBLK*DM,(unsigned)__builtin_amdgcn_readfirstlane(kdst+(slot)))
  #define DMA_V(t,slot) glds16(vsrc+(long)(t)*KVBLK*DM,(unsigned)__builtin_amdgcn_readfirstlane(vdst+(slot)))
  const int vb0=(int)(lds0+LDS_V)+((lane>>4)&1)*32+(lane&3)*8+(4*hi+((lane&15)>>2))*64;
  const char*Kbase=shm+LDS_K; bf16x8 kf[8];
  const lds_cptr shm3=(lds_cptr)shm; const lds_cptr kp0=shm3+LDS_K+hi*1024+r32*16; const lds_cptr vp0=shm3+LDS_V+((lane>>4)&1)*32+(lane&3)*8+(4*hi+((lane&15)>>2))*64;
  const int NT=(q0+QB)/KVBLK;
  DMA_K(0,0);DMA_V(0,0);DMA_K(1,SLOTB);
  bf16x8 qr[4];
  #pragma unroll
  for(int d0=0;d0<4;++d0)qr[d0]=*reinterpret_cast<const bf16x8*>(&Qw[(long)r32*DM+d0*16+hi*8]);
  float mhat=0.f,l_reg=0.f;f32x16 o[2];o[0]=f32x16{};o[1]=f32x16{};f32x16 negm; { const float nb0_=sl2*(float)(4*hi-q0); _Pragma("unroll") for(int r=0;r<16;++r)negm[r]=nb0_; } asm volatile("":"+v"(negm));
  #define NB(tt) __builtin_fmaf(sl2,(float)(64*(tt)-q0+4*hi),-mhat)
  #define ALIBI(P0,P1) do{ _Pragma("unroll") for(int r=0;r<16;++r){ P0[r]=__builtin_fmaf(sl2,(float)((r&3)+8*(r>>2)),P0[r]); P1[r]=__builtin_fmaf(sl2,(float)(32+(r&3)+8*(r>>2)),P1[r]); } }while(0)
  const int qrel=wid*QBLK+r32;
  #define CMASK(P0,P1,t) do{int jb_=(t)-(NT-4); if(jb_>=0)cmask(P0,P1,jb_,qrel,hi);}while(0)
  bool resc=false;
  #define START(P0,P1) do{ const float rm=rowmax(P0,P1); resc=false; \
    { const float dl=rm; mhat=fadd_s(mhat,dl); \
      _Pragma("unroll") for(int r=0;r<16;++r){P0[r]=fsub_s(P0[r],dl);P1[r]=fsub_s(P1[r],dl);} \
      { const float nb_=NB(1); _Pragma("unroll") for(int r=0;r<16;++r)negm[r]=nb_; } asm volatile("":"+v"(negm)); } \
    _Pragma("unroll") for(int r=0;r<16;++r)P0[r]=__builtin_amdgcn_exp2f(P0[r]); }while(0)
  #define RESC() do{ if(resc){ asm volatile("s_waitcnt lgkmcnt(0)":::"memory"); \
      _Pragma("unroll") for(int d_=0;d_<2;++d_) _Pragma("unroll") for(int r=0;r<16;++r)o[d_][r]*=wsf[crow(r,hi)]; } }while(0)
  f32x16 pA0,pA1,pB0,pB1;
  int sl_prev=0,sl_cur=0,sl_next=SLOTB;
  #define ROT() do{sl_prev=sl_cur;sl_cur=sl_next;sl_next=(sl_next==(NSLOT-1)*SLOTB)?0:sl_next+SLOTB;}while(0)
  DMA_K(2,2*SLOTB);
  WAIT_BAR(3);
  qkt(pA0,pA1,Kbase,qr,negm,r32,hi);asm volatile("s_nop 15\n\ts_nop 7":"+v"(pA0),"+v"(pA1));ALIBI(pA0,pA1);CMASK(pA0,pA1,0);
  START(pA0,pA1);
  _Pragma("unroll") for(int r=0;r<16;++r)pA1[r]=__builtin_amdgcn_exp2f(pA1[r]);
  WAIT_BAR(0);
  DMA_K(3,0);DMA_V(1,SLOTB);
  ROT();
  kload8(kf,kp0+sl_cur);
  WAIT_BAR(2);
  s16x4 vlo[8],vhi[8]; u32x4 pw0,pw1,pw2,pw3;
  #define PKW(P,B) cvtpk_s(P[B],P[B+1])
  #define PAF(k) __builtin_bit_cast(bf16x8,pw##k)
  #define VFR(i) (bf16x8){vlo[i][0],vlo[i][1],vlo[i][2],vlo[i][3],vhi[i][0],vhi[i][1],vhi[i][2],vhi[i][3]}
  #define PIN(x) asm volatile("":"+v"(x))
  #define MX3(a,b,c) __builtin_fmaxf(__builtin_fmaxf((a),(b)),(c))
  #define GAPA(MF,A0,A1,A2,A3,W0,W1,PW) do{ MF; sacc+=A0; sacc+=A1; sacc+=A2; sacc+=A3; PIN(sacc); W0; W1; PIN(PW); SBAR(); }while(0)
  #define EX(v) __builtin_amdgcn_exp2f(v)
  #define GAPB(MF,X,B) do{ MF; X[B]=EX(X[B]); X[B+1]=EX(X[B+1]); X[B+2]=EX(X[B+2]); X[B+3]=EX(X[B+3]); PIN(X); SBAR(); }while(0)
  #define VRD(i) do{ vlo[i]=vtr(vp_+(((i)>>2)*4096+((i)&3)*1024)); vhi[i]=vtr(vp_+(((i)>>2)*4096+((i)&3)*1024+512)); }while(0)
  #define KRD(G,j) do{ if(G){ kload2(kf,kp0+sl_next,j); SBAR(); } }while(0)
  #define STEP(C0,C1,P0,P1,t,GK,GV,GL) do{ SBAR(); \
    const lds_cptr vp_=vp0+sl_prev; \
    VRD(0); SBAR(); float sacc=(P0[0]+P0[1]); \
    GAPA(C0=__builtin_amdgcn_mfma_f32_32x32x16_bf16(kf[0],qr[0],negm,0,0,0), P0[2],P0[3],P0[4],P0[5],     pw0[0]=PKW(P0,0), pw0[1]=PKW(P0,2), pw0); \
    VRD(4); SBAR(); GAPA(C1=__builtin_amdgcn_mfma_f32_32x32x16_bf16(kf[1],qr[0],negm,0,0,0), P0[6],P0[7],P0[8],P0[9],     pw0[2]=PKW(P0,4), pw0[3]=PKW(P0,6), pw0); \
    VRD(1); SBAR(); GAPA(C0=__builtin_amdgcn_mfma_f32_32x32x16_bf16(kf[2],qr[1],C0,0,0,0),   P0[10],P0[11],P0[12],P0[13], pw1[0]=PKW(P0,8), pw1[1]=PKW(P0,10), pw1); \
    VRD(5); SBAR(); GAPA(C1=__builtin_amdgcn_mfma_f32_32x32x16_bf16(kf[3],qr[1],C1,0,0,0),   P0[14],P0[15],P1[0],P1[1],   pw1[2]=PKW(P0,12),pw1[3]=PKW(P0,14), pw1); \
    VRD(2); SBAR(); GAPA(C0=__builtin_amdgcn_mfma_f32_32x32x16_bf16(kf[4],qr[2],C0,0,0,0),   P1[2],P1[3],P1[4],P1[5],     pw2[0]=PKW(P1,0), pw2[1]=PKW(P1,2), pw2); \
    VRD(6); SBAR(); GAPA(C1=__builtin_amdgcn_mfma_f32_32x32x16_bf16(kf[5],qr[2],C1,0,0,0),   P1[6],P1[7],P1[8],P1[9],     pw2[2]=PKW(P1,4), pw2[3]=PKW(P1,6), pw2); \
    VRD(3); SBAR(); GAPA(C0=__builtin_amdgcn_mfma_f32_32x32x16_bf16(kf[6],qr[3],C0,0,0,0),   P1[10],P1[11],P1[12],P1[13], pw3[0]=PKW(P1,8), pw3[1]=PKW(P1,10), pw3); \
    VRD(7); SBAR(); GAPA(C1=__builtin_amdgcn_mfma_f32_32x32x16_bf16(kf[7],qr[3],C1,0,0,0),   P1[14],P1[15],0.f,0.f,       pw3[2]=PKW(P1,12),pw3[3]=PKW(P1,14), pw3); \
    l_reg+=sacc; \
    if(GK){DMA_K((t)+3,sl_cur);} if(GV){DMA_V((t)+1,sl_next);} \
    ALIBI(C0,C1); CMASK(C0,C1,t); \
    { float a=MX3(C0[0],C0[1],C1[0]),b=MX3(C0[2],C0[3],C1[1]); a=MX3(a,C1[2],C1[3]); \
      _Pragma("unroll") for(int r=4;r<16;r+=4){a=MX3(a,C0[r],C0[r+1]);b=MX3(b,C0[r+2],C0[r+3]);a=MX3(a,C1[r],C1[r+1]);b=MX3(b,C1[r+2],C1[r+3]);} \
      float rm=__builtin_fmaxf(a,b); { auto rr=__builtin_amdgcn_permlane32_swap(__float_as_uint(rm),__float_as_uint(rm),false,false); rm=__builtin_fmaxf(__uint_as_float(rr[0]),__uint_as_float(rr[1])); } \
      resc=false; \
      if(__builtin_expect(__any(rm>(float)THRL),0)){ const float dl=__builtin_fmaxf(rm,0.f); mhat+=dl; \
        _Pragma("unroll") for(int r=0;r<16;++r){C0[r]-=dl;C1[r]-=dl;} \
        const float f=__builtin_amdgcn_exp2f(-dl); l_reg*=f; if(hi==0)wsf[r32]=f; resc=true; } \
      { const float nb_=NB((t)+1); _Pragma("unroll") for(int r=0;r<16;++r)negm[r]=nb_; asm volatile("":"+v"(negm)); } } \
    SBAR(); \
    GAPB(o[0]=__builtin_amdgcn_mfma_f32_32x32x16_bf16(PAF(0),VFR(0),o[0],0,0,0), C0,0); \
    GAPB(o[1]=__builtin_amdgcn_mfma_f32_32x32x16_bf16(PAF(0),VFR(4),o[1],0,0,0), C0,4); \
    KRD(GL,0); GAPB(o[0]=__builtin_amdgcn_mfma_f32_32x32x16_bf16(PAF(1),VFR(1),o[0],0,0,0), C0,8); \
    KRD(GL,1); GAPB(o[1]=__builtin_amdgcn_mfma_f32_32x32x16_bf16(PAF(1),VFR(5),o[1],0,0,0), C0,12); \
    KRD(GL,2); GAPB(o[0]=__builtin_amdgcn_mfma_f32_32x32x16_bf16(PAF(2),VFR(2),o[0],0,0,0), C1,0); \
    KRD(GL,3); GAPB(o[1]=__builtin_amdgcn_mfma_f32_32x32x16_bf16(PAF(2),VFR(6),o[1],0,0,0), C1,4); \
    GAPB(o[0]=__builtin_amdgcn_mfma_f32_32x32x16_bf16(PAF(3),VFR(3),o[0],0,0,0), C1,8); \
    GAPB(o[1]=__builtin_amdgcn_mfma_f32_32x32x16_bf16(PAF(3),VFR(7),o[1],0,0,0), C1,12); \
    }while(0)
  int t=1;
  #undef CMASK
  #define CMASK(P0,P1,t) do{}while(0)
  for(;t+5<NT;t+=2){
    STEP(pB0,pB1,pA0,pA1,t,true,true,true);     WAIT_BAR(2); RESC(); ROT();
    STEP(pA0,pA1,pB0,pB1,t+1,true,true,true);   WAIT_BAR(2); RESC(); ROT();
  }
  #undef CMASK
  #define CMASK(P0,P1,t) do{int jb_=(t)-(NT-4); if(jb_>=0)cmask(P0,P1,jb_,qrel,hi);}while(0)
  #define ENDW(tt) do{ if((tt)+3<NT){WAIT_BAR(2);} else if((tt)+2<NT){WAIT_BAR(1);} else {WAIT_BAR(0);} }while(0)
  for(;t+1<NT;t+=2){
    STEP(pB0,pB1,pA0,pA1,t,(t+3<NT),(t+1<NT),(t+1<NT));       ENDW(t);   RESC(); ROT();
    STEP(pA0,pA1,pB0,pB1,t+1,(t+4<NT),(t+2<NT),(t+2<NT));     ENDW(t+1); RESC(); ROT();
  }
  STEP(pB0,pB1,pA0,pA1,NT-1,false,false,false); RESC();
  { float sacc=pB0[0]+pB0[1]; _Pragma("unroll") for(int r=2;r<16;++r)sacc+=pB0[r]; _Pragma("unroll") for(int r=0;r<16;++r)sacc+=pB1[r]; l_reg+=sacc;
    pw0=(u32x4){PKW(pB0,0),PKW(pB0,2),PKW(pB0,4),PKW(pB0,6)};pw1=(u32x4){PKW(pB0,8),PKW(pB0,10),PKW(pB0,12),PKW(pB0,14)};pw2=(u32x4){PKW(pB1,0),PKW(pB1,2),PKW(pB1,4),PKW(pB1,6)};pw3=(u32x4){PKW(pB1,8),PKW(pB1,10),PKW(pB1,12),PKW(pB1,14)};
    SBAR(); pv(o,vb0+sl_cur,PAF(0),PAF(1),PAF(2),PAF(3)); }
  #undef PKW
  #undef PAF
  #undef VFR
  #undef PIN
  #undef MX3
  #undef GAPA
  #undef GAPB
  #undef EX
  #undef VRD
  #undef KRD
  #undef STEP
  #undef ENDW
  {auto rr=__builtin_amdgcn_permlane32_swap(__float_as_uint(l_reg),__float_as_uint(l_reg),false,false);l_reg=__uint_as_float(rr[0])+__uint_as_float(rr[1]);}
  if(hi==0)wsf[32+r32]=l_reg;asm volatile("s_waitcnt lgkmcnt(0)":::"memory");
  float rli[16];
  #pragma unroll
  for(int r=0;r<16;++r)rli[r]=__builtin_amdgcn_rcpf(wsf[32+crow(r,hi)]);
  bf16*Ow=O+(rowbase+q0+wid*QBLK)*DM+hv*D;
  { bf16*stg=(bf16*)(shm+LDS_OST)+wid*2048;
    #pragma unroll
    for(int r=0;r<16;++r){const int orow=crow(r,hi);
      #pragma unroll
      for(int d0=0;d0<2;++d0)stg[orow*64+d0*32+r32]=__float2bfloat16(o[d0][r]*rli[r]);}
    asm volatile("s_waitcnt lgkmcnt(0)":::"memory");
    #pragma unroll
    for(int i=0;i<4;++i){const int row=i*8+(lane>>3),ch=lane&7; const u32x4 v=*(const u32x4*)(stg+row*64+ch*8); ATTN_STORE16(Ow+(long)row*DM+ch*8,v);} }
  asm volatile("s_waitcnt lgkmcnt(0)\n\ts_barrier":::"memory");
  #undef DMA_K
  #undef DMA_V
  #undef CMASK
  #undef START
  #undef RESC
  #undef ROT
  #undef NB
  #undef ALIBI
}
constexpr int ATTN_LDS_BYTES=LDS_BYTES;
struct AttnTensors { const bf16* Q; const bf16* K; const bf16* V; bf16* O0; bf16* O1; };
struct AttnUnit { int hu; int qb; };
struct StaticOrder {
  int vcu, G;
  __device__ __forceinline__ explicit StaticOrder(int grid,int block):vcu((grid%8==0)?(block%8)*(grid/8)+block/8:block),G(grid){}
  __device__ __forceinline__ bool next(int i,AttnUnit&u)const{
    const int p=(i>>1)*G+vcu; if(p>=128*8)return false; u.hu=p>>3; const int s=p&7; u.qb=(i&1)?15-s:s; return true; }
  __device__ __forceinline__ void a_ready(const AttnUnit&)const{}
  __device__ __forceinline__ void done(const AttnUnit&)const{}
};
template<class Sched,int THRL=8> __device__ __forceinline__ void attn_phase(char*lds,const AttnTensors&T,const Sched&S){
  AttnUnit u;
  for(int i=0;S.next(i,u);++i){ S.a_ready(u); { const int b_=u.hu>>5,h_=(u.hu>>2)&7,c_=(u.hu>>1)&1,j_=u.hu&1; const float sl2_=__builtin_amdgcn_exp2f(-(float)(h_+1))*1.4426950408889634f;
      attn_unit<THRL>(b_,2*h_+c_,2*h_+j_,sl2_,u.qb,T.Q,T.K,T.V,c_?T.O1:T.O0,lds); } S.done(u); }
}
#undef SBAR
#undef WAIT_BAR
}

constexpr int NWAVES = 8;
constexpr int BATCH = 4, SEQ = 4096, D = 2048, M = BATCH * SEQ;
constexpr int AW = 1024, NIN = 5120;
constexpr float LN_EPS = 1e-5f;
constexpr float DN_ALPHA = 1.189207115002721f;
constexpr float C2 = 0.125f * 1.4426950408889634f;
constexpr float LOG2E = 1.4426950408889634f;

constexpr size_t MiB = 1u << 20;
constexpr size_t WS_CTL = 0, CTL_ZERO_BYTES = 1 * MiB;
constexpr size_t WS_WIN = 2 * MiB, WS_WOUT = 22 * MiB, WS_WQ = 30 * MiB, WS_PRM = 38 * MiB;
constexpr size_t WS_XB = 40 * MiB;
constexpr size_t WS_MIX = 40 * MiB;
constexpr size_t WS_Q = 104 * MiB, WS_K = 136 * MiB, WS_V = 168 * MiB, WS_XR = 200 * MiB, WS_XG = 232 * MiB;
constexpr size_t WS_Y1 = 104 * MiB;
constexpr size_t WS_H1 = 232 * MiB;
constexpr size_t WS_H8 = 296 * MiB;
constexpr size_t WS_PQ = 104 * MiB;
constexpr size_t WS_SU = 38 * MiB + 65536, WS_SH = 38 * MiB + 131072;
constexpr size_t WS_WG = 38 * MiB + 262144;
constexpr size_t WS_PART = 104 * MiB;
constexpr size_t WS_FFN = 40 * MiB;
constexpr size_t WS_PK = 2 * MiB;
constexpr size_t WS_U8 = 328 * MiB, WS_V8 = 360 * MiB;
constexpr size_t WS_LA = 328 * MiB, WS_LB = 392 * MiB;
constexpr size_t WS_O0 = 264 * MiB, WS_O1 = 296 * MiB;
constexpr size_t WS_E = 456 * MiB, WS_G = 464 * MiB, WS_TOTA = 472 * MiB, WS_TOTH = 473 * MiB, WS_SKH = 474 * MiB, WS_SKL = 475 * MiB, WS_END = 476 * MiB;
constexpr int CW_BAR = 4096;

constexpr int RING_OFF = 0, RING_BYTES = 131072;
constexpr int LDSCTL_OFF = RING_BYTES, MISC_OFF = LDSCTL_OFF + 320;
constexpr int LDS_BYTES = 147456;

#define GAS __attribute__((address_space(1)))
#define LAS __attribute__((address_space(3)))
typedef unsigned short bf16;
typedef unsigned v4u __attribute__((ext_vector_type(4)));
typedef float f32x4 __attribute__((ext_vector_type(4)));
typedef GAS unsigned gu32;
#define RLX_AGENT __ATOMIC_RELAXED, __HIP_MEMORY_SCOPE_AGENT
#define LDS_WAIT() asm volatile("s_waitcnt lgkmcnt(0)" ::: "memory")
#define VM_WAIT() asm volatile("s_waitcnt vmcnt(0)" ::: "memory")
__device__ __forceinline__ unsigned f2bf(float f) { unsigned u = __builtin_bit_cast(unsigned, f); return (u + 0x7fffu + ((u >> 16) & 1u)) >> 16; }
__device__ __forceinline__ unsigned pk2(float lo, float hi) { return f2bf(lo) | (f2bf(hi) << 16); }
__device__ __forceinline__ float bf2f(unsigned short u) { return __uint_as_float(((unsigned)u) << 16); }
__device__ __forceinline__ float gelu_tanh(float x) { const float u = 0.7978845608028654f * (x + 0.044715f * x * x * x); return 0.5f * x * (1.f + tanhf(u)); }

#define XB_TMO      128
#define XB_XCNT(j)  (256  + 64 * (j))
#define XB_XSUB(j)  (1280 + 64 * (j))
#define XB_XGEN(j)  (2304 + 64 * (j))
#define XB_TOP      3328
#define XB_TOPGEN   3392
#define XCD_BAR_WORDS 3456
#define XB_SPIN_CAP (1u << 18)

__device__ __forceinline__ unsigned xb_ld(unsigned* p)              { return __hip_atomic_load(p, __ATOMIC_RELAXED, __HIP_MEMORY_SCOPE_AGENT); }
__device__ __forceinline__ unsigned xb_add(unsigned* p, unsigned v) { return __hip_atomic_fetch_add(p, v, __ATOMIC_RELAXED, __HIP_MEMORY_SCOPE_AGENT); }
__device__ __forceinline__ unsigned xb_xcc_id() { return (unsigned)__builtin_amdgcn_s_getreg((3 << 11) | 20) & 0xFu; }
#define XB_SPIN(cond, bar) do { unsigned _sp = 0; while (cond) { __builtin_amdgcn_s_sleep(1); \
    if ((++_sp & 255u) == 0u) { if (xb_ld(&(bar)[XB_TMO])) break; if (_sp > XB_SPIN_CAP) { atomicAdd(&(bar)[XB_TMO], 1u); break; } } } } while (0)

struct XcdBarrier {
    unsigned* bar; unsigned x;
    volatile LAS unsigned* st;
};

__device__ __forceinline__ XcdBarrier xcd_barrier_post(unsigned* bar, volatile LAS unsigned* st) {
    XcdBarrier b; b.bar = bar; b.x = xb_xcc_id(); b.st = st;
    if (threadIdx.x == 0) (void)xb_add(&bar[XB_XCNT(b.x)], 1u);
    return b;
}
__device__ __forceinline__ void xcd_barrier_complete(unsigned* bar, unsigned x, unsigned& nloc, unsigned& nx) {
    const unsigned G = gridDim.x * gridDim.y * gridDim.z;
    unsigned sum, cnt, mine, sp = 0u;
    for (;;) {
        sum = 0u; cnt = 0u; mine = 0u;
#pragma unroll
        for (unsigned j = 0; j < 16; ++j) { const unsigned c = xb_ld(&bar[XB_XCNT(j)]); sum += c; cnt += (c > 0u) ? 1u : 0u; mine = (j == x) ? c : mine; }
        if (sum == G) break;
        __builtin_amdgcn_s_sleep(1);
        if ((++sp & 255u) == 0u) { if (xb_ld(&bar[XB_TMO])) break; if (sp > XB_SPIN_CAP) { atomicAdd(&bar[XB_TMO], 1u); break; } }
    }
    nloc = mine > 0u ? mine : 1u; nx = cnt > 0u ? cnt : 1u;
}

__device__ __forceinline__ void xcd_barrier(const XcdBarrier& b) {
    asm volatile("s_waitcnt vmcnt(0)" ::: "memory");
    __syncthreads();
    if (threadIdx.x == 0) {
        unsigned* bar = b.bar;
        __builtin_amdgcn_s_waitcnt(0);
        unsigned nloc = b.st[0], nx = b.st[1];
        if (nloc == 0u) { xcd_barrier_complete(bar, b.x, nloc, nx); b.st[0] = nloc; b.st[1] = nx; }
        const unsigned old = xb_add(&bar[XB_XSUB(b.x)], 1u);
        const unsigned gen = old / nloc;
        if (old + 1u == (gen + 1u) * nloc) {
            __builtin_amdgcn_fence(__ATOMIC_RELEASE, "agent");
            asm volatile("s_waitcnt vmcnt(0)" ::: "memory");
            const unsigned og = xb_add(&bar[XB_TOP], 1u);
            const unsigned tg = og / nx;
            if (og + 1u == (tg + 1u) * nx) xb_add(&bar[XB_TOPGEN], 1u);
            else XB_SPIN(xb_ld(&bar[XB_TOPGEN]) == tg, bar);
            __builtin_amdgcn_fence(__ATOMIC_ACQUIRE, "agent");
            xb_add(&bar[XB_XGEN(b.x)], 1u);
            asm volatile("s_waitcnt vmcnt(0)" ::: "memory");
        } else {
            XB_SPIN(xb_ld(&bar[XB_XGEN(b.x)]) == gen, bar);
            __builtin_amdgcn_fence(__ATOMIC_ACQUIRE, "agent");
            asm volatile("s_waitcnt vmcnt(0)" ::: "memory");
        }
    }
    __syncthreads();
}

struct Frame {
    LAS unsigned char* lds;
    int tid, lane, wave;
    int vcu, G;
};

__device__ __forceinline__ void p0_transpose_item(const float* W, int K, int N, bf16* WT, int row_off, LAS float* scr, int item, int lane) {
    const int nblk = N / 32, kb = item / nblk, nb = item % nblk, k0 = 64 * kb, n0 = 32 * nb;
#pragma unroll 8
    for (int i = 0; i < 32; ++i) { const int kk = 2 * i + (lane >> 5); scr[kk * 33 + (lane & 31)] = W[(size_t)(k0 + kk) * N + n0 + (lane & 31)]; }
    LDS_WAIT(); asm volatile("" ::: "memory");
    const int c = lane & 7;
#pragma unroll
    for (int j = 0; j < 4; ++j) { const int n = (lane >> 3) + 8 * j; const LAS float* s = scr + (8 * c) * 33 + n;
        v4u o; o.x = pk2(s[0 * 33], s[1 * 33]); o.y = pk2(s[2 * 33], s[3 * 33]); o.z = pk2(s[4 * 33], s[5 * 33]); o.w = pk2(s[6 * 33], s[7 * 33]);
        *(GAS v4u*)(WT + (size_t)(row_off + n0 + n) * K + k0 + 8 * c) = o; }
    LDS_WAIT(); asm volatile("" ::: "memory");
}

typedef short bf16x8 __attribute__((ext_vector_type(8)));
typedef float f32x16 __attribute__((ext_vector_type(16)));
typedef float f32x2_t __attribute__((ext_vector_type(2))); typedef __bf16 bf16x2_t __attribute__((ext_vector_type(2)));
__device__ __forceinline__ unsigned cvtpk(float lo, float hi) { f32x2_t v = {lo, hi}; bf16x2_t b = __builtin_convertvector(v, bf16x2_t); return __builtin_bit_cast(unsigned, b); }
__device__ __forceinline__ void split8(const f32x4 a, const f32x4 b, bf16x8& h, bf16x8& l) {
    v4u hh; hh.x = cvtpk(a.x, a.y); hh.y = cvtpk(a.z, a.w); hh.z = cvtpk(b.x, b.y); hh.w = cvtpk(b.z, b.w);
    v4u ll;
    ll.x = cvtpk(a.x - __uint_as_float(hh.x << 16), a.y - __uint_as_float(hh.x & 0xffff0000u));
    ll.y = cvtpk(a.z - __uint_as_float(hh.y << 16), a.w - __uint_as_float(hh.y & 0xffff0000u));
    ll.z = cvtpk(b.x - __uint_as_float(hh.z << 16), b.y - __uint_as_float(hh.z & 0xffff0000u));
    ll.w = cvtpk(b.z - __uint_as_float(hh.w << 16), b.w - __uint_as_float(hh.w & 0xffff0000u));
    h = __builtin_bit_cast(bf16x8, hh); l = __builtin_bit_cast(bf16x8, ll);
}
__device__ __forceinline__ float max3f_(float a, float b, float c) { return __builtin_fmaxf(__builtin_fmaxf(a, b), c); }
__device__ __forceinline__ float pair_max(float m) { auto rr = __builtin_amdgcn_permlane32_swap(__float_as_uint(m), __float_as_uint(m), false, false); return __builtin_fmaxf(__uint_as_float(rr[0]), __uint_as_float(rr[1])); }
__device__ __forceinline__ void route_half(const float* qp, const v4u* kh, const v4u* kl, int lane, int hi, float (&lst)[16]) {
    f32x16 sc[4];
#pragma unroll
    for (int kt = 0; kt < 4; ++kt) sc[kt] = f32x16{};
#pragma unroll 2
    for (int ds = 0; ds < 8; ++ds) { bf16x8 qh, ql; split8(*(const f32x4*)(qp + 16 * ds), *(const f32x4*)(qp + 16 * ds + 4), qh, ql);
#pragma unroll
        for (int kt = 0; kt < 4; ++kt) { const bf16x8 ah = __builtin_bit_cast(bf16x8, kh[(kt * 8 + ds) * 64 + lane]), al = __builtin_bit_cast(bf16x8, kl[(kt * 8 + ds) * 64 + lane]);
            sc[kt] = __builtin_amdgcn_mfma_f32_32x32x16_bf16(ah, qh, sc[kt], 0, 0, 0);
            sc[kt] = __builtin_amdgcn_mfma_f32_32x32x16_bf16(ah, ql, sc[kt], 0, 0, 0);
            sc[kt] = __builtin_amdgcn_mfma_f32_32x32x16_bf16(al, qh, sc[kt], 0, 0, 0); } }
#pragma unroll
    for (int kt = 0; kt < 4; ++kt)
#pragma unroll
        for (int r = 0; r < 16; ++r) { const unsigned key = (unsigned)(kt * 32 + (r & 3) + 8 * (r >> 2) + 4 * hi); sc[kt][r] = __uint_as_float((__float_as_uint(sc[kt][r]) & ~127u) | (127u - key)); }
#pragma unroll
    for (int rd = 0; rd < 16; ++rd) {
        float m = max3f_(sc[0][0], sc[0][1], sc[0][2]);
#pragma unroll
        for (int n = 3; n + 1 < 64; n += 2) m = max3f_(m, sc[n >> 4][n & 15], sc[(n + 1) >> 4][(n + 1) & 15]);
        m = __builtin_fmaxf(m, sc[3][15]);
        const float gm = pair_max(m); lst[rd] = gm;
#pragma unroll
        for (int kt = 0; kt < 4; ++kt)
#pragma unroll
            for (int r = 0; r < 16; ++r) sc[kt][r] = (__float_as_uint(sc[kt][r]) == __float_as_uint(gm)) ? -INFINITY : sc[kt][r];
    }
}
typedef float f32x2v __attribute__((ext_vector_type(2)));
__device__ __forceinline__ unsigned pk4_fp8(float a, float b, float c, float d) { int p = __builtin_amdgcn_cvt_pk_fp8_f32(a, b, 0, false); p = __builtin_amdgcn_cvt_pk_fp8_f32(c, d, p, true); return (unsigned)p; }
constexpr float U8_SCALE = 64.f;
typedef short bf16x8_l __attribute__((ext_vector_type(8)));
template <int PASS> __device__ __forceinline__ void lru_phase(const Frame& F, unsigned char* ws, const float* conv_w, const float* conv_b, const float* b_a, const float* b_x, const float* lru_lambda) {
    constexpr int XS = 272;
    LAS unsigned char* xs = F.lds + RING_OFF;
    const bf16* XR = (const bf16*)(ws + WS_XR); const bf16* XG = (const bf16*)(ws + WS_XG); bf16* MIX = (bf16*)(ws + WS_MIX); const bf16* WGT = (const bf16*)(ws + WS_WG);
    float* TA = (float*)(ws + WS_TOTA); float* TH = (float*)(ws + WS_TOTH);
    const int tid = F.tid, lane = F.lane, w = F.wave, l15 = lane & 15, g = lane >> 4;
    const int hb = F.vcu & 7;
    const int nun = 2048 / 8;
    const int gi = F.vcu >> 3, gn = (F.G + 7 - hb) >> 3;
    const int chc = tid & 127, tg = tid >> 7, colc = hb * 128 + chc;
    const float cw0 = conv_w[colc], cw1 = conv_w[1024 + colc], cw2 = conv_w[2048 + colc], cw3 = conv_w[3072 + colc], cb = conv_b[colc];
    const int chn = hb * 128 + 16 * w + l15;
    bf16x8_l Ba[4], Bx[4];
#pragma unroll
    for (int ks = 0; ks < 4; ++ks) { Ba[ks] = *(const bf16x8_l*)(WGT + ((size_t)(hb * 128 + 16 * w + l15)) * 128 + 32 * ks + 8 * g); Bx[ks] = *(const bf16x8_l*)(WGT + ((size_t)((8 + hb) * 128 + 16 * w + l15)) * 128 + 32 * ks + 8 * g); }
    const float ba = b_a[chn], bx = b_x[chn], sp8 = 8.f * log1pf(__expf(-lru_lambda[chn]));
    unsigned short xrn[19], xgn[16]; float tan_[16], thn_[16];
#define LRU_LOAD(uu) do { const int c_ = (uu) & 63, b_ = (uu) >> 6, tok0_ = b_ * SEQ + c_ * 64; \
        _Pragma("unroll") for (int r = 0; r < 19; ++r) xrn[r] = (c_ * 64 + tg * 16 + r - 3 >= 0) ? XR[(size_t)(tok0_ + tg * 16 + r - 3) * AW + colc] : (unsigned short)0; \
        if (PASS == 2) { _Pragma("unroll") for (int m = 0; m < 4; ++m) _Pragma("unroll") for (int r = 0; r < 4; ++r) xgn[4 * m + r] = XG[(size_t)(tok0_ + 16 * m + 4 * g + r) * AW + chn]; \
            _Pragma("unroll") for (int i = 0; i < 16; ++i) { const int c2 = 16 * g + i, cl = c2 < c_ ? c2 : 0; tan_[i] = TA[(b_ * 64 + cl) * 1024 + chn]; thn_[i] = TH[(b_ * 64 + cl) * 1024 + chn]; } } } while (0)
    if (gi < nun) LRU_LOAD(gi);
    for (int uu = gi; uu < nun; uu += gn) {
        const int c = uu & 63, b = uu >> 6, tok0 = b * SEQ + c * 64;
        {
            float xv[19];
#pragma unroll
            for (int r = 0; r < 19; ++r) xv[r] = bf2f(xrn[r]);
#pragma unroll
            for (int i = 0; i < 16; ++i) { const float y = cb + cw0 * xv[i] + cw1 * xv[i + 1] + cw2 * xv[i + 2] + cw3 * xv[i + 3];
                *(LAS unsigned short*)(xs + (tg * 16 + i) * XS + chc * 2) = (unsigned short)f2bf(y); }
        }
        unsigned short xgv[16]; float ta[16], th[16];
        if (PASS == 2) {
#pragma unroll
            for (int i = 0; i < 16; ++i) { xgv[i] = xgn[i]; const int c2 = 16 * g + i; ta[i] = c2 < c ? tan_[i] : 1.f; th[i] = c2 < c ? thn_[i] : 0.f; } }
        __syncthreads();
        if (uu + gn < nun) LRU_LOAD(uu + gn);
        f32x4 ca[4], cx[4];
#pragma unroll
        for (int m = 0; m < 4; ++m) { ca[m] = (f32x4){0.f, 0.f, 0.f, 0.f}; cx[m] = (f32x4){0.f, 0.f, 0.f, 0.f};
#pragma unroll
            for (int ks = 0; ks < 4; ++ks) { const bf16x8_l A = *(const LAS bf16x8_l*)(xs + (16 * m + l15) * XS + (32 * ks + 8 * g) * 2);
                ca[m] = __builtin_amdgcn_mfma_f32_16x16x32_bf16(A, Ba[ks], ca[m], 0, 0, 0); cx[m] = __builtin_amdgcn_mfma_f32_16x16x32_bf16(A, Bx[ks], cx[m], 0, 0, 0); } }
        float av[4][4], bv[4][4];
#pragma unroll
        for (int m = 0; m < 4; ++m)
#pragma unroll
            for (int r = 0; r < 4; ++r) { const int tt = 16 * m + 4 * g + r;
                const float rg = 1.f / (1.f + __expf(-(ca[m][r] + ba))), ig = 1.f / (1.f + __expf(-(cx[m][r] + bx)));
                const float a = __expf(-sp8 * rg), xcv = bf2f(*(const LAS unsigned short*)(xs + tt * XS + (16 * w + l15) * 2));
                av[m][r] = a; bv[m][r] = sqrtf(fmaxf(1.f - a * a, 0.f)) * ig * xcv; }
        float carry = 0.f, Ac = 1.f;
        if (PASS == 2) {
            float Ap = 1.f, Hp = 0.f;
#pragma unroll
            for (int i = 0; i < 16; ++i) { Hp = ta[i] * Hp + th[i]; Ap *= ta[i]; }
            { const float A1 = __shfl_up(Ap, 16), H1 = __shfl_up(Hp, 16); if (g >= 1) { Hp = Ap * H1 + Hp; Ap = Ap * A1; } }
            { const float A2 = __shfl_up(Ap, 32), H2 = __shfl_up(Hp, 32); if (g >= 2) { Hp = Ap * H2 + Hp; Ap = Ap * A2; } }
            carry = __shfl(Hp, 48 + l15);
        }
#pragma unroll
        for (int m = 0; m < 4; ++m) {
            float As = (av[m][0] * av[m][1]) * (av[m][2] * av[m][3]);
            float Hs = ((bv[m][0] * av[m][1] + bv[m][1]) * av[m][2] + bv[m][2]) * av[m][3] + bv[m][3];
            { const float A1 = __shfl_up(As, 16), H1 = __shfl_up(Hs, 16); if (g >= 1) { Hs = As * H1 + Hs; As = As * A1; } }
            { const float A2 = __shfl_up(As, 32), H2 = __shfl_up(Hs, 32); if (g >= 2) { Hs = As * H2 + Hs; As = As * A2; } }
            const float At = __shfl(As, 48 + l15), Ht = __shfl(Hs, 48 + l15);
            if (PASS == 2) {
                float Ae = __shfl_up(As, 16), He = __shfl_up(Hs, 16); if (g == 0) { Ae = 1.f; He = 0.f; }
                float h = Ae * carry + He;
#pragma unroll
                for (int r = 0; r < 4; ++r) { h = av[m][r] * h + bv[m][r]; const int tt = 16 * m + 4 * g + r;
                    MIX[(size_t)(tok0 + tt) * D + 1024 + chn] = (bf16)f2bf(h * gelu_tanh(bf2f(xgv[4 * m + r]))); }
            }
            carry = At * carry + Ht; Ac *= At;
        }
        if (PASS == 1 && g == 0) { TA[(b * 64 + c) * 1024 + chn] = Ac; TH[(b * 64 + c) * 1024 + chn] = carry; }
        __syncthreads();
    }
#undef LRU_LOAD
}
struct Args { const float* in[23]; float* out; unsigned char* ws; int ph_lo, ph_hi; };

__global__ void __launch_bounds__(NWAVES * 64, 2) skel_fwd(Args args) {
    extern __shared__ __attribute__((aligned(16))) unsigned char lds[];
    Frame F;
    F.lds = (LAS unsigned char*)lds;
    F.tid = threadIdx.x; F.lane = F.tid & 63; F.wave = __builtin_amdgcn_readfirstlane(F.tid >> 6);
    F.G = gridDim.x; { const int bx = blockIdx.x; F.vcu = (F.G % 8 == 0) ? (bx % 8) * (F.G / 8) + bx / 8 : bx; }
    unsigned char* ws = args.ws;
    const float* x = args.in[0];
    bf16* WIN_T = (bf16*)(ws + WS_WIN); bf16* WOUT_T = (bf16*)(ws + WS_WOUT); bf16* WQ_T = (bf16*)(ws + WS_WQ);
    bf16* XB = (bf16*)(ws + WS_XB); bf16* MIX = (bf16*)(ws + WS_MIX); bf16* QB = (bf16*)(ws + WS_Q); bf16* H1 = (bf16*)(ws + WS_H1);
    float* Y1 = (float*)(ws + WS_Y1); float* PQ = (float*)(ws + WS_PQ);
    for (int u = F.tid; u < (LDS_BYTES - LDSCTL_OFF) / 4; u += NWAVES * 64) ((LAS unsigned*)(F.lds + LDSCTL_OFF))[u] = 0u;
    __syncthreads();
    XcdBarrier bar = xcd_barrier_post((unsigned*)(ws + WS_CTL) + CW_BAR, (volatile LAS unsigned*)(F.lds + MISC_OFF) + 8);
    const unsigned phmask = (unsigned)args.ph_lo;
    int slot_ = 0;
#define IN(k) (false)
#define RUN(slotbit) ((phmask >> (slotbit)) & 1u)
#define GRID_BAR() do { if (phmask == 0xffffffffu) xcd_barrier(bar); } while (0)

    if (RUN(0)) {
        if (blockIdx.x == 0 && F.wave == 0) {
            float a_ = args.in[9][F.lane] * args.in[10][F.lane], b_ = args.in[11][F.lane] * args.in[12][F.lane];
#pragma unroll
            for (int o = 1; o < 64; o <<= 1) { a_ += __shfl_xor(a_, o); b_ += __shfl_xor(b_, o); }
            if (F.lane == 0) ((float*)(ws + WS_PRM))[0] = expf(a_) - expf(b_) + 0.2f;
        }
        LAS float* scr = (LAS float*)(F.lds + RING_OFF + F.wave * 16384);
        const int gw = F.vcu * NWAVES + F.wave, NGW = F.G * NWAVES;
        constexpr int I_IN = (D / 64) * (NIN / 32), I_SQ = (D / 64) * (D / 32);
        constexpr int NITEMS = I_IN + 2 * I_SQ;
        for (int it = gw; it < NITEMS; it += NGW) {
            int r = it;
            if (r < I_IN) { p0_transpose_item(args.in[1], D, NIN, WIN_T, 0, scr, r, F.lane); continue; } r -= I_IN;
            if (r < I_SQ) { p0_transpose_item(args.in[14], D, D, WOUT_T, 0, scr, r, F.lane); continue; } r -= I_SQ;
            p0_transpose_item(args.in[17], D, D, WQ_T, 0, scr, r, F.lane);
        }
        for (int it = gw; it < 128; it += NGW) { const int mt = it >> 3;
            p0_transpose_item(args.in[mt < 8 ? 4 : 6] + (size_t)(mt & 7) * 16384, 128, 128, (bf16*)(ws + WS_WG) + (size_t)mt * 16384, 0, scr, it & 7, F.lane); }
        {
            const float* sk = args.in[18]; v4u* SKH = (v4u*)(ws + WS_SKH); v4u* SKL = (v4u*)(ws + WS_SKL);
            for (int fi = gw; fi < 512; fi += NGW) { const int ds = fi & 7, kt = (fi >> 3) & 3, hp = fi >> 5;
                const float* src = sk + ((size_t)(hp * 128 + kt * 32 + (F.lane & 31)) * 128 + 16 * ds + 8 * (F.lane >> 5));
                bf16x8 h8, l8; split8(*(const f32x4*)src, *(const f32x4*)(src + 4), h8, l8);
                SKH[fi * 64 + F.lane] = __builtin_bit_cast(v4u, h8); SKL[fi * 64 + F.lane] = __builtin_bit_cast(v4u, l8); }
        }
        for (int m = gw; m < M; m += NGW) {
            const GAS f32x4* xr = (const GAS f32x4*)(x + (size_t)m * D) + F.lane;
            GAS unsigned long long* o8 = (GAS unsigned long long*)(XB + (size_t)m * D) + F.lane;
#pragma unroll
            for (int j = 0; j < 8; ++j) { const f32x4 v = xr[64 * j]; o8[64 * j] = (unsigned long long)pk2(v.x, v.y) | ((unsigned long long)pk2(v.z, v.w) << 32); }
        }
    }
    GRID_BAR();
    if (RUN(1)) {
        pg8::Gemm g{XB, WIN_T, M, NIN, D}; pg8::StaticOrder S; S.init(M, NIN, F.G, (int)blockIdx.x);
        pg8::EpiBf16<0> E{QB, AW, nullptr, AW, (size_t)(WS_K - WS_Q) / 2, C2};
        pg8::gemm_phase<pg8::EpiBf16<0>, pg8::StaticOrder, PG8_ALIGN, PG8_SP2>(F.lds + RING_OFF, g, S, E);
    }
    GRID_BAR();
    if (RUN(2)) lru_phase<1>(F, ws, args.in[2], args.in[3], args.in[5], args.in[7], args.in[8]);
    GRID_BAR();
    if (RUN(4)) {
        static_assert(attn_body::ATTN_LDS_BYTES <= RING_BYTES && attn_body::ATTN_PITCH == AW, "attention body geometry vs frame");
        const attn_body::AttnTensors AT{(const attn_body::bf16*)QB, (const attn_body::bf16*)(ws + WS_K), (const attn_body::bf16*)(ws + WS_V), (attn_body::bf16*)(ws + WS_O0), (attn_body::bf16*)(ws + WS_O1)};
        const attn_body::StaticOrder S((int)F.G, (int)blockIdx.x);
        attn_body::attn_phase<attn_body::StaticOrder>((char*)lds + RING_OFF, AT, S);
    }
    if (RUN(5)) lru_phase<2>(F, ws, args.in[2], args.in[3], args.in[5], args.in[7], args.in[8]);
    GRID_BAR();
    if (RUN(6)) {
        const int gw = F.vcu * NWAVES + F.wave, NGW = F.G * NWAVES;
        const float lam = ((const float*)(ws + WS_PRM))[0];
        const bf16* O0 = (const bf16*)(ws + WS_O0); const bf16* O1 = (const bf16*)(ws + WS_O1);
        const float g0 = args.in[13][2 * F.lane] * 0.8f, g1 = args.in[13][2 * F.lane + 1] * 0.8f;
        for (int it = gw; it < M * 8; it += NGW) { const int tok = it >> 3, h = it & 7;
            const unsigned a = *(const unsigned*)(O0 + (size_t)tok * AW + h * 128 + 2 * F.lane), b = *(const unsigned*)(O1 + (size_t)tok * AW + h * 128 + 2 * F.lane);
            const float d0 = bf2f((unsigned short)(a & 0xffff)) - lam * bf2f((unsigned short)(b & 0xffff)), d1 = bf2f((unsigned short)(a >> 16)) - lam * bf2f((unsigned short)(b >> 16));
            float ss = d0 * d0 + d1 * d1;
#pragma unroll
            for (int o = 1; o < 64; o <<= 1) ss += __shfl_xor(ss, o);
            const float r = rsqrtf(ss * (1.f / 128.f) + LN_EPS);
            *(unsigned*)(MIX + (size_t)tok * D + h * 128 + 2 * F.lane) = pk2(d0 * r * g0, d1 * r * g1); }
    }
    GRID_BAR();
    if (RUN(7)) {
        pg8::Gemm g{MIX, WOUT_T, M, D, D}; pg8::StaticOrder S; S.init(M, D, F.G, (int)blockIdx.x);
        pg8::EpiBf16<0> E{(bf16*)Y1, D, nullptr, 0, 0, 1.f};
        pg8::gemm_phase<pg8::EpiBf16<0>, pg8::StaticOrder, PG8_ALIGN, PG8_SP2>(F.lds + RING_OFF, g, S, E);
    }
    GRID_BAR();
    if (RUN(8)) {
        const int gw = F.vcu * NWAVES + F.wave, NGW = F.G * NWAVES; const float* g = args.in[15]; const float* bb = args.in[16];
        for (int row = gw; row < M; row += NGW) {
            const f32x4* xr_ = (const f32x4*)(x + (size_t)row * D); const unsigned long long* yb = (const unsigned long long*)((const bf16*)Y1 + (size_t)row * D);
            f32x4 v[8]; float s = 0.f;
#pragma unroll
            for (int j = 0; j < 8; ++j) { const f32x4 xv_ = xr_[F.lane + 64 * j]; const unsigned long long q_ = yb[F.lane + 64 * j]; const unsigned q0 = (unsigned)q_, q1 = (unsigned)(q_ >> 32);
                v[j].x = DN_ALPHA * xv_.x + __uint_as_float(q0 << 16); v[j].y = DN_ALPHA * xv_.y + __uint_as_float(q0 & 0xffff0000u); v[j].z = DN_ALPHA * xv_.z + __uint_as_float(q1 << 16); v[j].w = DN_ALPHA * xv_.w + __uint_as_float(q1 & 0xffff0000u);
                s += (v[j].x + v[j].y) + (v[j].z + v[j].w); }
#pragma unroll
            for (int o = 1; o < 64; o <<= 1) s += __shfl_xor(s, o);
            const float mean = s * (1.f / D); float s2 = 0.f;
#pragma unroll
            for (int j = 0; j < 8; ++j) { v[j] = v[j] - mean; s2 += (v[j].x * v[j].x + v[j].y * v[j].y) + (v[j].z * v[j].z + v[j].w * v[j].w); }
#pragma unroll
            for (int o = 1; o < 64; o <<= 1) s2 += __shfl_xor(s2, o);
            const float rstd = rsqrtf(s2 * (1.f / D) + LN_EPS);
#pragma unroll
            for (int j = 0; j < 8; ++j) { const int c = (F.lane + 64 * j) * 4; const f32x4 gg = *(const f32x4*)(g + c), bv = *(const f32x4*)(bb + c);
                const f32x4 o = v[j] * rstd * gg + bv;
                *(unsigned long long*)(H1 + (size_t)row * D + c) = (unsigned long long)pk2(o.x, o.y) | ((unsigned long long)pk2(o.z, o.w) << 32);
                v[j] = o; }
            float am = 0.f;
#pragma unroll
            for (int j = 0; j < 8; ++j) am = fmaxf(fmaxf(am, fmaxf(fabsf(v[j].x), fabsf(v[j].y))), fmaxf(fabsf(v[j].z), fabsf(v[j].w)));
#pragma unroll
            for (int o = 1; o < 64; o <<= 1) am = fmaxf(am, __shfl_xor(am, o));
            const float qs = am > 0.f ? 127.f / am : 0.f;
            if (F.lane == 0) ((float*)(ws + WS_SH))[row] = am * (1.f / 127.f);
#pragma unroll
            for (int j = 0; j < 8; ++j) { const int c = (F.lane + 64 * j) * 4;
                const unsigned q = ((unsigned)(int)rintf(v[j].x * qs) & 0xffu) | (((unsigned)(int)rintf(v[j].y * qs) & 0xffu) << 8) | (((unsigned)(int)rintf(v[j].z * qs) & 0xffu) << 16) | (((unsigned)(int)rintf(v[j].w * qs) & 0xffu) << 24);
                *(unsigned*)(ws + WS_H8 + ((size_t)(c >> 7) * M + row) * 128 + (c & 127)) = q; }
        }
        {
            const float* us = args.in[19]; float* SU = (float*)(ws + WS_SU);
            for (int e = gw; e < 16384; e += NGW) {
                const f32x4* ur = (const f32x4*)(us + (size_t)e * D); f32x4 uv[8]; float am = 0.f;
#pragma unroll
                for (int j = 0; j < 8; ++j) { uv[j] = ur[F.lane + 64 * j]; am = fmaxf(fmaxf(am, fmaxf(fabsf(uv[j].x), fabsf(uv[j].y))), fmaxf(fabsf(uv[j].z), fabsf(uv[j].w))); }
#pragma unroll
                for (int o = 1; o < 64; o <<= 1) am = fmaxf(am, __shfl_xor(am, o));
                const float qs = am > 0.f ? 127.f / am : 0.f;
                if (F.lane == 0) SU[e] = am * (1.f / 127.f);
#pragma unroll
                for (int j = 0; j < 8; ++j) { const int c = (F.lane + 64 * j) * 4;
                    const unsigned q = ((unsigned)(int)rintf(uv[j].x * qs) & 0xffu) | (((unsigned)(int)rintf(uv[j].y * qs) & 0xffu) << 8) | (((unsigned)(int)rintf(uv[j].z * qs) & 0xffu) << 16) | (((unsigned)(int)rintf(uv[j].w * qs) & 0xffu) << 24);
                    *(unsigned*)(ws + WS_U8 + ((size_t)(c >> 7) * 16384 + e) * 128 + (c & 127)) = q; }
            }
        }
        {
            const float* vs = args.in[20]; unsigned char* V8 = ws + WS_V8; LAS unsigned char* tl = F.lds + RING_OFF;
            for (int t = F.vcu; t < 256 * 8; t += F.G) { const int e0 = (t >> 3) * 64, c0 = (t & 7) * 256;
                __syncthreads();
#pragma unroll
                for (int j = 0; j < 8; ++j) { const int idx = F.tid + 512 * j, r = idx >> 6, c = 4 * (idx & 63);
                    const f32x4 v = *(const f32x4*)(vs + (size_t)(e0 + r) * D + c0 + c);
                    *(LAS unsigned*)(tl + (c >> 3) * 512 + r * 8 + (c & 7)) = pk4_fp8(v.x, v.y, v.z, v.w); }
                __syncthreads();
#pragma unroll
                for (int j = 0; j < 2; ++j) { const int cu = (F.tid >> 5) + 16 * j, pc = F.tid & 31;
                    *(v4u*)(V8 + ((size_t)((c0 >> 3) + cu) * 16384 + e0) * 8 + pc * 16) = *(const LAS v4u*)(tl + cu * 512 + pc * 16); }
            }
            __syncthreads();
        }
    }
    GRID_BAR();
    if (RUN(9)) {
        pg8::Gemm g{H1, WQ_T, M, D, D}; pg8::StaticOrder S; S.init(M, D, F.G, (int)blockIdx.x);
        pg8::EpiF32 E{PQ, D, nullptr, 0.f};
        pg8::gemm_phase<pg8::EpiF32, pg8::StaticOrder, PG8_ALIGN, PG8_SP2>(F.lds + RING_OFF, g, S, E);
    }
    GRID_BAR();
    if (RUN(10)) {
        const int gw = F.vcu * NWAVES + F.wave, NGW = F.G * NWAVES, tl = F.lane & 31, hi = F.lane >> 5;
        LAS unsigned char* scr = F.lds + RING_OFF + F.wave * 1024 + tl * 32;
        const v4u* SKH = (const v4u*)(ws + WS_SKH); const v4u* SKL = (const v4u*)(ws + WS_SKL);
        int* E = (int*)(ws + WS_E); float* G = (float*)(ws + WS_G);
        for (int it = gw; it < (M / 32) * 8; it += NGW) { const int h = it & 7, tok = (it >> 3) * 32 + tl;
            float sa[16], sb[16];
            route_half(PQ + (size_t)tok * D + h * 256 + 8 * hi, SKH + (size_t)(h * 2) * 32 * 64, SKL + (size_t)(h * 2) * 32 * 64, F.lane, hi, sa);
            route_half(PQ + (size_t)tok * D + h * 256 + 128 + 8 * hi, SKH + (size_t)(h * 2 + 1) * 32 * 64, SKL + (size_t)(h * 2 + 1) * 32 * 64, F.lane, hi, sb);
            { unsigned w[4];
#pragma unroll
              for (int q = 0; q < 4; ++q) { w[q] = 0u;
#pragma unroll
                  for (int e = 0; e < 4; ++e) { const unsigned ka = 127u - (__float_as_uint(sa[4 * q + e]) & 127u), kb = 127u - (__float_as_uint(sb[4 * q + e]) & 127u); w[q] |= (hi ? kb : ka) << (8 * e); } }
              *(LAS v4u*)(scr + 16 * hi) = (v4u){w[0], w[1], w[2], w[3]}; }
            float cd[25];
#define CV_(i, j) __uint_as_float((__float_as_uint(sa[i] + sb[j]) & ~255u) | (255u - (unsigned)(16 * (i) + (j))))
            cd[0] = hi ? CV_(0, 1) : CV_(0, 0);
            cd[1] = hi ? CV_(0, 3) : CV_(0, 2);
            cd[2] = hi ? CV_(0, 5) : CV_(0, 4);
            cd[3] = hi ? CV_(0, 7) : CV_(0, 6);
            cd[4] = hi ? CV_(0, 9) : CV_(0, 8);
            cd[5] = hi ? CV_(0, 11) : CV_(0, 10);
            cd[6] = hi ? CV_(0, 13) : CV_(0, 12);
            cd[7] = hi ? CV_(0, 15) : CV_(0, 14);
            cd[8] = hi ? CV_(1, 1) : CV_(1, 0);
            cd[9] = hi ? CV_(1, 3) : CV_(1, 2);
            cd[10] = hi ? CV_(1, 5) : CV_(1, 4);
            cd[11] = hi ? CV_(1, 7) : CV_(1, 6);
            cd[12] = hi ? CV_(2, 1) : CV_(2, 0);
            cd[13] = hi ? CV_(2, 3) : CV_(2, 2);
            cd[14] = hi ? CV_(3, 0) : CV_(2, 4);
            cd[15] = hi ? CV_(3, 2) : CV_(3, 1);
            cd[16] = hi ? CV_(4, 0) : CV_(3, 3);
            cd[17] = hi ? CV_(4, 2) : CV_(4, 1);
            cd[18] = hi ? CV_(5, 1) : CV_(5, 0);
            cd[19] = hi ? CV_(6, 1) : CV_(6, 0);
            cd[20] = hi ? CV_(7, 1) : CV_(7, 0);
            cd[21] = hi ? CV_(9, 0) : CV_(8, 0);
            cd[22] = hi ? CV_(11, 0) : CV_(10, 0);
            cd[23] = hi ? CV_(13, 0) : CV_(12, 0);
            cd[24] = hi ? CV_(15, 0) : CV_(14, 0);
#undef CV_
            float top[16];
#pragma unroll
            for (int rd = 0; rd < 16; ++rd) {
                float m = cd[0];
#pragma unroll
                for (int n = 1; n + 1 < 25; n += 2) m = max3f_(m, cd[n], cd[n + 1]);
                const float gm = pair_max(m); top[rd] = gm;
#pragma unroll
                for (int n = 0; n < 25; ++n) cd[n] = (__float_as_uint(cd[n]) == __float_as_uint(gm)) ? -INFINITY : cd[n];
            }
            float ex[16], sum = 0.f;
#pragma unroll
            for (int r = 0; r < 16; ++r) { ex[r] = __builtin_amdgcn_exp2f((top[r] - top[0]) * LOG2E); sum += ex[r]; }
            const float inv = 1.f / sum;
            asm volatile("s_waitcnt lgkmcnt(0)" ::: "memory");
            int eo[8]; float go[8];
#pragma unroll
            for (int rr = 0; rr < 8; ++rr) { float t0 = top[rr], t1 = top[rr + 8], e0 = ex[rr], e1 = ex[rr + 8]; asm volatile("" : "+v"(t0), "+v"(t1), "+v"(e0), "+v"(e1));
                const unsigned f = 255u - (__float_as_uint(hi ? t1 : t0) & 255u);
                const int ia = scr[f >> 4], ib = scr[16 + (f & 15)]; eo[rr] = ia * 128 + ib; go[rr] = (hi ? e1 : e0) * inv; }
            int* ep = E + (size_t)tok * 128 + h * 16 + 8 * hi; float* gp = G + (size_t)tok * 128 + h * 16 + 8 * hi;
            *(v4u*)ep = (v4u){(unsigned)eo[0], (unsigned)eo[1], (unsigned)eo[2], (unsigned)eo[3]}; *(v4u*)(ep + 4) = (v4u){(unsigned)eo[4], (unsigned)eo[5], (unsigned)eo[6], (unsigned)eo[7]};
            *(f32x4*)gp = (f32x4){go[0], go[1], go[2], go[3]}; *(f32x4*)(gp + 4) = (f32x4){go[4], go[5], go[6], go[7]};
            asm volatile("s_waitcnt lgkmcnt(0)" ::: "memory");
        }
    }
    GRID_BAR();
    if (RUN(11)) {
        const int nlab = F.G < 8 ? F.G : 8, label = (int)blockIdx.x % nlab, nblk = (F.G - label + nlab - 1) / nlab, wx = ((int)blockIdx.x / nlab) * NWAVES + F.wave, nwx = nblk * NWAVES;
        const int lane = F.lane, rr = lane >> 3, cc = lane & 7;
        const int* E = (const int*)(ws + WS_E);
        for (int sl = label; sl < 16; sl += nlab) {
            const unsigned char* Us = ws + WS_U8 + (size_t)sl * 16384 * 128 + 16 * cc;
            const unsigned char* Hs = ws + WS_H8 + (size_t)sl * M * 128 + 16 * cc;
            int* Ps = (int*)(ws + WS_PART) + (size_t)sl * M * 128;
            for (int item = wx; item < M / 8; item += nwx) { const int tok = item * 8 + rr;
                const v4u hq = *(const v4u*)(Hs + (size_t)tok * 128);
                const v4u* ep = (const v4u*)(E + (size_t)tok * 128);
                int res[16];
#pragma unroll
                for (int i = 0; i < 16; ++i) res[i] = 0;
#pragma unroll
                for (int i = 0; i < 16; ++i) {
                    const v4u e0 = ep[2 * i], e1 = ep[2 * i + 1];
#pragma unroll
                    for (int j = 0; j < 8; ++j) { const unsigned e = j < 4 ? e0[j & 3] : e1[j & 3];
                        const v4u a = *(const v4u*)(Us + (size_t)e * 128);
                        int d = __builtin_amdgcn_sdot4((int)a.x, (int)hq.x, 0, false); d = __builtin_amdgcn_sdot4((int)a.y, (int)hq.y, d, false); d = __builtin_amdgcn_sdot4((int)a.z, (int)hq.z, d, false); d = __builtin_amdgcn_sdot4((int)a.w, (int)hq.w, d, false);
                        d += __builtin_amdgcn_update_dpp(0, d, 0xB1, 0xf, 0xf, true); d += __builtin_amdgcn_update_dpp(0, d, 0x4E, 0xf, 0xf, true); d += __builtin_amdgcn_update_dpp(0, d, 0x141, 0xf, 0xf, true);
                        res[i] = (cc == j) ? d : res[i]; } }
                v4u* po = (v4u*)(Ps + (size_t)tok * 128 + cc * 16);
#pragma unroll
                for (int q = 0; q < 4; ++q) po[q] = (v4u){(unsigned)res[4 * q], (unsigned)res[4 * q + 1], (unsigned)res[4 * q + 2], (unsigned)res[4 * q + 3]};
            }
        }
    }
    GRID_BAR();
    if (RUN(12)) {
        const int* P = (const int*)(ws + WS_PART); const int* E = (const int*)(ws + WS_E); const float* G = (const float*)(ws + WS_G); unsigned* PK = (unsigned*)(ws + WS_PK);
        const float* SU = (const float*)(ws + WS_SU); const float* SH = (const float*)(ws + WS_SH);
        for (int idx = F.vcu * 512 + F.tid; idx < M * 128; idx += F.G * 512) { const int tok = idx >> 7, k = idx & 127; const size_t pi = (size_t)tok * 128 + (k & 7) * 16 + (k >> 3); int hsum = 0;
#pragma unroll
            for (int sl = 0; sl < 16; ++sl) hsum += P[(size_t)sl * M * 128 + pi];
            const int e = E[idx];
            const float w = G[idx] * gelu_tanh((float)hsum * SU[e] * SH[tok]);
            PK[(size_t)(tok >> 6) * 8192 + (k >> 2) * 256 + (tok & 63) * 4 + (k & 3)] = (unsigned)e | (f2bf(w) << 16); }
    }
    GRID_BAR();
    if (RUN(13)) {
        const unsigned* PK = (const unsigned*)(ws + WS_PK); bf16* FFN = (bf16*)(ws + WS_FFN);
        for (int c = F.vcu; c < 256; c += F.G) {
            __syncthreads();
            { const v4u* src = (const v4u*)(ws + WS_V8 + (size_t)c * 131072);
#pragma unroll 4
              for (int j = 0; j < 16; ++j) *(LAS v4u*)(F.lds + RING_OFF + (F.tid + 512 * j) * 16) = src[F.tid + 512 * j]; }
            __syncthreads();
            for (int tb = F.wave; tb < M / 64; tb += NWAVES) {
                const v4u* pk = (const v4u*)(PK + (size_t)tb * 8192) + F.lane;
                f32x2v av[4];
#pragma unroll
                for (int i = 0; i < 4; ++i) av[i] = (f32x2v){0.f, 0.f};
                v4u pb[32];
#pragma unroll
                for (int kq = 0; kq < 32; ++kq) pb[kq] = pk[kq * 64];
#pragma unroll
                for (int kq = 0; kq < 32; ++kq) { const v4u p4 = pb[kq];
#pragma unroll
                    for (int j = 0; j < 4; ++j) { const unsigned p = p4[j]; const float w = __uint_as_float(p & 0xffff0000u); const f32x2v ww = (f32x2v){w, w};
                        const unsigned long long d = *(const LAS unsigned long long*)(F.lds + RING_OFF + ((p & 0xffffu) << 3));
                        const int d0 = (int)(unsigned)d, d1 = (int)(unsigned)(d >> 32);
                        av[0] = av[0] + __builtin_amdgcn_cvt_pk_f32_fp8(d0, false) * ww; av[1] = av[1] + __builtin_amdgcn_cvt_pk_f32_fp8(d0, true) * ww;
                        av[2] = av[2] + __builtin_amdgcn_cvt_pk_f32_fp8(d1, false) * ww; av[3] = av[3] + __builtin_amdgcn_cvt_pk_f32_fp8(d1, true) * ww; } }
                *(v4u*)(FFN + (size_t)(tb * 64 + F.lane) * D + 8 * c) = (v4u){pk2(av[0].x, av[0].y), pk2(av[1].x, av[1].y), pk2(av[2].x, av[2].y), pk2(av[3].x, av[3].y)};
            }
        }
        __syncthreads();
    }
    GRID_BAR();
    if (RUN(14)) {
        const int gw = F.vcu * NWAVES + F.wave, NGW = F.G * NWAVES, lane = F.lane; const float* g2 = args.in[21]; const float* b2 = args.in[22]; float* out = args.out; const bf16* FFN = (const bf16*)(ws + WS_FFN);
        for (int row = gw; row < M; row += NGW) {
            f32x4 v[8]; float sm = 0.f;
#pragma unroll
            for (int j = 0; j < 8; ++j) { const int c = (lane + 64 * j) * 4; const unsigned long long hq = *(const unsigned long long*)(H1 + (size_t)row * D + c), fq = *(const unsigned long long*)(FFN + (size_t)row * D + c);
                const unsigned h0 = (unsigned)hq, h1_ = (unsigned)(hq >> 32), f0 = (unsigned)fq, f1 = (unsigned)(fq >> 32);
                v[j].x = DN_ALPHA * __uint_as_float(h0 << 16) + __uint_as_float(f0 << 16); v[j].y = DN_ALPHA * __uint_as_float(h0 & 0xffff0000u) + __uint_as_float(f0 & 0xffff0000u);
                v[j].z = DN_ALPHA * __uint_as_float(h1_ << 16) + __uint_as_float(f1 << 16); v[j].w = DN_ALPHA * __uint_as_float(h1_ & 0xffff0000u) + __uint_as_float(f1 & 0xffff0000u);
                sm += (v[j].x + v[j].y) + (v[j].z + v[j].w); }
#pragma unroll
            for (int o = 1; o < 64; o <<= 1) sm += __shfl_xor(sm, o);
            const float mean = sm * (1.f / D); float s2 = 0.f;
#pragma unroll
            for (int j = 0; j < 8; ++j) { v[j] = v[j] - mean; s2 += (v[j].x * v[j].x + v[j].y * v[j].y) + (v[j].z * v[j].z + v[j].w * v[j].w); }
#pragma unroll
            for (int o = 1; o < 64; o <<= 1) s2 += __shfl_xor(s2, o);
            const float rstd = rsqrtf(s2 * (1.f / D) + LN_EPS);
#pragma unroll
            for (int j = 0; j < 8; ++j) { const int c = (lane + 64 * j) * 4; *(f32x4*)(out + (size_t)row * D + c) = v[j] * rstd * *(const f32x4*)(g2 + c) + *(const f32x4*)(b2 + c); }
        }
    }
#undef IN
#undef RUN
#undef GRID_BAR
}

extern "C" void kernel_launch(void* const* d_in, const int* in_sizes, int n_in, void* d_out, int out_size, void* d_ws, size_t ws_size, hipStream_t stream) {
    static int grid = 0;
    if (grid == 0) {
        if (n_in != 23 || in_sizes[0] != M * D || out_size != M * D || ws_size < WS_END) { fprintf(stderr, "kernel_launch: unexpected shapes n_in %d in0 %d out %d ws %zu\n", n_in, n_in > 0 ? in_sizes[0] : -1, out_size, ws_size); grid = -1; return; }
        int dev = 0, cus = 0;
        if (hipGetDevice(&dev) != hipSuccess || hipDeviceGetAttribute(&cus, hipDeviceAttributeMultiprocessorCount, dev) != hipSuccess) { grid = -1; return; }
        if (hipFuncSetAttribute((const void*)skel_fwd, hipFuncAttributeMaxDynamicSharedMemorySize, LDS_BYTES) != hipSuccess) { grid = -1; return; }
        grid = cus;
    }
    if (grid < 0) return;
    (void)hipMemsetAsync((char*)d_ws + WS_CTL, 0, CTL_ZERO_BYTES, stream);
    Args a{};
    for (int i = 0; i < 23; ++i) a.in[i] = (const float*)d_in[i];
    a.out = (float*)d_out; a.ws = (unsigned char*)d_ws;
    unsigned char* ws = (unsigned char*)d_ws;
    const float* const* in = (const float* const*)d_in;
    float* prm = (float*)(ws + WS_PRM);
    bf16 *Q = (bf16*)(ws + WS_Q), *K = (bf16*)(ws + WS_K), *V = (bf16*)(ws + WS_V), *XR = (bf16*)(ws + WS_XR), *XG = (bf16*)(ws + WS_XG), *MIX = (bf16*)(ws + WS_MIX), *H1 = (bf16*)(ws + WS_H1);
    float *LA = (float*)(ws + WS_LA), *LB = (float*)(ws + WS_LB), *Y1 = (float*)(ws + WS_Y1), *PQ = (float*)(ws + WS_PQ), *G = (float*)(ws + WS_G); int* E = (int*)(ws + WS_E);
#ifndef MK_MULTI
    a.ph_lo = -1; a.ph_hi = 0; hipLaunchKernelGGL(skel_fwd, dim3(grid), dim3(NWAVES * 64), LDS_BYTES, stream, a);
#else
    for (int sl = 0; sl < 15; ++sl) { a.ph_lo = 1 << sl; a.ph_hi = 0; hipLaunchKernelGGL(skel_fwd, dim3(grid), dim3(NWAVES * 64), LDS_BYTES, stream, a); }
#endif
}
```

```cpp
#include <hip/hip_runtime.h>
#include <cstdio>
#include <cstdint>
namespace pg8 {
#define PG8_LAS __attribute__((address_space(3)))
typedef unsigned short bf16_t;
typedef short bf16x8 __attribute__((ext_vector_type(8)));
typedef float f32x4 __attribute__((ext_vector_type(4)));
typedef unsigned u32x4 __attribute__((ext_vector_type(4)));
constexpr int BM = 256, BK = 64, HALF = 128, HTB = HALF * BK * 2  , STAGE_BYTES = 8 * HTB, NXCD = 8, WGM = 8;

__host__ __device__ __forceinline__ int lds_byte(int r, int c) { const int st = (r >> 4) * 2 + (c >> 5), rr = r & 15, cc = c & 31, ob = rr * 64 + cc * 2; return st * 1024 + (ob ^ (((ob >> 9) & 1) << 5)); }
__host__ __device__ __forceinline__ void stage_rc(int b, int& R, int& C) { const int st = b / 1024, sb = b % 1024, swz = sb ^ (((sb >> 9) & 1) << 5); R = (st >> 1) * 16 + swz / 64; C = (st & 1) * 32 + (swz % 64) / 2; }
__host__ __device__ __forceinline__ int perm32(int rho) { const int n = rho >> 4, i = rho & 15; return 8 * (i >> 2) + 4 * n + (i & 3); }

struct Unit { int pm, pn; };
struct Gemm { const bf16_t* A; const bf16_t* Bt; int M, N, K; };

struct StaticOrder {
    int nM, nN, nwg, G, c;
    __host__ __device__ void init(int M, int N, int G_, int c_) { nM = M / BM; nN = N / BM; nwg = nM * nN; G = G_; c = c_; }
    __host__ __device__ bool next(int i, Unit& u) const {
        const long L = (long)i * G + c; if (L >= nwg) return false;
        int wgid = (int)L; { const int q = nwg / NXCD, r = nwg % NXCD, xcd = wgid % NXCD, off = wgid / NXCD; wgid = (xcd < r ? xcd * (q + 1) : r * (q + 1) + (xcd - r) * q) + off; }
        const int nig = WGM * nN, gid = wgid / nig, fm = gid * WGM, gsz = (nM - fm) < WGM ? (nM - fm) : WGM;
        u.pm = fm + ((wgid % nig) % gsz); u.pn = (wgid % nig) / gsz; return true;
    }
    __device__ __forceinline__ void a_ready(const Unit&) const {}
    __device__ __forceinline__ void done(const Unit&) const {}
};

__device__ __forceinline__ unsigned cvt_pk_bf16(float lo, float hi) { unsigned r; asm volatile("v_cvt_pk_bf16_f32 %0, %1, %2" : "=v"(r) : "v"(lo), "v"(hi)); return r; }
typedef float f32x2 __attribute__((ext_vector_type(2)));
__device__ __forceinline__ f32x2 gelu_pk(f32x2 v) {
    const f32x2 av = __builtin_elementwise_abs(v), d = av * 0.2316418882f + 1.0f;
    f32x2 t; t.x = __builtin_amdgcn_rcpf(d.x); t.y = __builtin_amdgcn_rcpf(d.y);
    f32x2 q = t * 0.5307027145f + (-0.7265760135f); q = q * t + 0.7107068705f; q = q * t + (-0.142248368f); q = q * t + 0.127414796f; q = q * t;
    const f32x2 s = (v * v) * (-0.72134752044f);
    f32x2 e; e.x = __builtin_amdgcn_exp2f(s.x); e.y = __builtin_amdgcn_exp2f(s.y);
    const f32x2 m = v * (q * e), r = v - m;
    f32x2 o; o.x = v.x < 0.f ? m.x : r.x; o.y = v.y < 0.f ? m.y : r.y; return o;
}

template <int ACT  > struct EpiBf16 {
    static constexpr bool PERM = true, AFTER_DRAIN = false; static_assert(ACT == 0 || ACT == 1, "EpiBf16: ACT is 0 (none) or 1 (gelu_pk)");
    bf16_t* O; int ldc; const float* bias; int split_cols; size_t split_stride; float scale0;
    __device__ __forceinline__ void operator()(const f32x4 (&acc)[2][2][4][2], const Unit& u, int wr, int wc, int fr, int fq) const {
        const int row0 = u.pm * BM + wr * 64 + fr; int colt = u.pn * BM; bf16_t* base = O;
        float sc = 1.f; if (split_cols) { const int t = colt / split_cols; base += (size_t)t * split_stride; colt -= t * split_cols; if (t == 0) sc = scale0; }
        const int col0 = colt + wc * 32 + 8 * fq, bcol0 = u.pn * BM + wc * 32 + 8 * fq;
        f32x4 bv[2][2];
#pragma unroll
        for (int bj = 0; bj < 2; ++bj)
#pragma unroll
            for (int n = 0; n < 2; ++n) bv[bj][n] = bias ? *(const f32x4*)(bias + bcol0 + bj * HALF + 4 * n) : (f32x4){0.f, 0.f, 0.f, 0.f};
#pragma unroll
        for (int ai = 0; ai < 2; ++ai)
#pragma unroll
            for (int m = 0; m < 4; ++m) { bf16_t* rowp = base + (size_t)(row0 + ai * HALF + m * 16) * ldc + col0;
#pragma unroll
                for (int bj = 0; bj < 2; ++bj) { f32x4 v0 = acc[ai][bj][m][0] + bv[bj][0], v1 = acc[ai][bj][m][1] + bv[bj][1];
                    if (ACT == 1) { f32x2 a = gelu_pk((f32x2){v0[0], v0[1]}), b = gelu_pk((f32x2){v0[2], v0[3]}), c = gelu_pk((f32x2){v1[0], v1[1]}), d = gelu_pk((f32x2){v1[2], v1[3]});
                        v0 = (f32x4){a.x, a.y, b.x, b.y}; v1 = (f32x4){c.x, c.y, d.x, d.y}; }
                    v0 = v0 * sc; v1 = v1 * sc; u32x4 w; w.x = cvt_pk_bf16(v0[0], v0[1]); w.y = cvt_pk_bf16(v0[2], v0[3]); w.z = cvt_pk_bf16(v1[0], v1[1]); w.w = cvt_pk_bf16(v1[2], v1[3]);
                    *(u32x4*)(rowp + bj * HALF) = w; } }
    }
};

struct PanelStats {
    unsigned* xbuf;
    unsigned* cnt;
    unsigned* tmo;
    int ntn; float eps;
    unsigned code;
    __device__ __forceinline__ bool run(const f32x4 (&v)[2][2][4][2], const Unit& u, int wr, int wc, int fr, int fq, PG8_LAS unsigned char* lds, int wid, int lane) const {
        typedef float f32x2v __attribute__((ext_vector_type(2)));
        PG8_LAS f32x2v* P = (PG8_LAS f32x2v*)lds;
        PG8_LAS f32x2v* S = (PG8_LAS f32x2v*)(lds + 8192);
        PG8_LAS unsigned* flag = (PG8_LAS unsigned*)(lds + 8192 + 2048);
#pragma unroll
        for (int ai = 0; ai < 2; ++ai)
#pragma unroll
            for (int m = 0; m < 4; ++m) {
                float s = 0.f;
#pragma unroll
                for (int bj = 0; bj < 2; ++bj)
#pragma unroll
                    for (int n = 0; n < 2; ++n) { const f32x4 x = v[ai][bj][m][n]; s += (x[0] + x[1]) + (x[2] + x[3]); }
                s += __shfl_xor(s, 16); s += __shfl_xor(s, 32);
                const float mw = s * (1.0f / 64.0f); float q = 0.f;
#pragma unroll
                for (int bj = 0; bj < 2; ++bj)
#pragma unroll
                    for (int n = 0; n < 2; ++n) { const f32x4 d = v[ai][bj][m][n] - mw; q += (d[0] * d[0] + d[1] * d[1]) + (d[2] * d[2] + d[3] * d[3]); }
                q += __shfl_xor(q, 16); q += __shfl_xor(q, 32);
                if (fq == 0) P[(ai * HALF + wr * 64 + m * 16 + fr) * 4 + wc] = (f32x2v){mw, q};
            }
        asm volatile("s_waitcnt lgkmcnt(0)" ::: "memory"); __builtin_amdgcn_s_barrier(); asm volatile("" ::: "memory");
#if defined(BROKEN_EXCHANGE_NO_WAIT)
#warning BROKEN CONTROL BUILD: the row-statistics exchange does not wait; results are wrong by design
        if (blockIdx.x >= 64) { const long long t0_ = clock64(); while (clock64() - t0_ < 60000) __builtin_amdgcn_s_sleep(8); }
#endif
        const int row = wid * 32 + (lane & 31);
        if (lane < 32) {
            const f32x2v a = P[row * 4 + 0], b = P[row * 4 + 1], c = P[row * 4 + 2], d = P[row * 4 + 3];
            const float mt = (a.x + b.x + c.x + d.x) * 0.25f;
            const float da = a.x - mt, db = b.x - mt, dc = c.x - mt, dd = d.x - mt;
            const float m2 = (a.y + b.y) + (c.y + d.y) + 64.0f * ((da * da + db * db) + (dc * dc + dd * dd));
            unsigned long long* slot = (unsigned long long*)xbuf + ((size_t)(u.pm * BM + row) * 4 + u.pn);
            __hip_atomic_store(slot, ((unsigned long long)__float_as_uint(m2) << 32) | __float_as_uint(mt), __ATOMIC_RELAXED, __HIP_MEMORY_SCOPE_AGENT);
        }
        asm volatile("s_waitcnt vmcnt(0)" ::: "memory");
        if (lane == 0) __hip_atomic_fetch_add(cnt + 64 * u.pm, 1u, __ATOMIC_RELAXED, __HIP_MEMORY_SCOPE_AGENT);
        if (wid == 0) {
            bool dead = false; const unsigned long long t0 = __builtin_amdgcn_s_memrealtime(); const unsigned want = 8u * (unsigned)ntn;
            for (;;) {
#if defined(BROKEN_EXCHANGE_NO_WAIT)
                break;
#endif
                if ((unsigned)__builtin_amdgcn_readfirstlane(__hip_atomic_load(cnt + 64 * u.pm, __ATOMIC_RELAXED, __HIP_MEMORY_SCOPE_AGENT)) >= want) break;
                if (__builtin_amdgcn_s_memrealtime() - t0 > 2000000ull) {
                    if (lane == 0) { unsigned expect = 0u; __hip_atomic_compare_exchange_strong(tmo + 1, &expect, code | (unsigned)(u.pm & 0xff), __ATOMIC_RELAXED, __ATOMIC_RELAXED, __HIP_MEMORY_SCOPE_AGENT);
                                     __hip_atomic_store(tmo, 1u, __ATOMIC_RELAXED, __HIP_MEMORY_SCOPE_AGENT); }
                    dead = true; break; }
                __builtin_amdgcn_s_sleep(2);
            }
            __builtin_amdgcn_fence(__ATOMIC_ACQUIRE, "agent");
            if (lane == 0) flag[0] = dead ? 1u : 0u;
        }
        asm volatile("s_waitcnt vmcnt(0) lgkmcnt(0)" ::: "memory"); __builtin_amdgcn_s_barrier(); asm volatile("" ::: "memory");
        const bool bad = flag[0] != 0u;
        if (lane < 32) {
            const unsigned long long* slot = (const unsigned long long*)xbuf + (size_t)(u.pm * BM + row) * 4; float mt[4], m2[4]; float ms = 0.f;
#pragma unroll
            for (int t = 0; t < 4; ++t) { if (t < ntn) { const unsigned long long w = __hip_atomic_load(slot + t, __ATOMIC_RELAXED, __HIP_MEMORY_SCOPE_AGENT); mt[t] = __uint_as_float((unsigned)w); m2[t] = __uint_as_float((unsigned)(w >> 32)); } else { mt[t] = 0.f; m2[t] = 0.f; } ms += mt[t]; }
            const float mean = ms / (float)ntn; float q = 0.f;
#pragma unroll
            for (int t = 0; t < 4; ++t) if (t < ntn) { const float dm = mt[t] - mean; q += m2[t] + 256.0f * dm * dm; }
            S[row] = (f32x2v){mean, 1.0f / sqrtf(q / (256.0f * (float)ntn) + eps)};
        }
        asm volatile("s_waitcnt lgkmcnt(0)" ::: "memory"); __builtin_amdgcn_s_barrier(); asm volatile("" ::: "memory");
        return bad;
    }
};
struct EpiLnRes {
    static constexpr bool PERM = false, AFTER_DRAIN = true;
    const float* base; float* out; int ldc; const float* bias; PanelStats st; unsigned poison;
    __device__ __forceinline__ void fused(f32x4 (&acc)[2][2][4][2], const Unit& u, int wr, int wc, int fr, int fq, PG8_LAS unsigned char* lds, int wid, int lane) const {
        typedef float f32x2v __attribute__((ext_vector_type(2)));
        const PG8_LAS f32x2v* S = (const PG8_LAS f32x2v*)(lds + 8192);
        const int col0 = u.pn * BM + wc * 32 + 4 * fq;
#pragma unroll
        for (int bj = 0; bj < 2; ++bj)
#pragma unroll
            for (int n = 0; n < 2; ++n) { const f32x4 bv = bias ? *(const f32x4*)(bias + col0 + bj * HALF + n * 16) : (f32x4){0.f, 0.f, 0.f, 0.f};
#pragma unroll
                for (int ai = 0; ai < 2; ++ai)
#pragma unroll
                    for (int m = 0; m < 4; ++m) acc[ai][bj][m][n] += bv; }
        f32x4 pre[4][2][2];
#pragma unroll
        for (int m = 0; m < 4; ++m) { const size_t off = (size_t)(u.pm * BM + wr * 64 + m * 16 + fr) * ldc + col0;
#pragma unroll
            for (int bj = 0; bj < 2; ++bj)
#pragma unroll
                for (int n = 0; n < 2; ++n) pre[m][bj][n] = *(const f32x4*)(base + off + bj * HALF + n * 16); }
        const bool bad = st.run(acc, u, wr, wc, fr, fq, lds, wid, lane) || poison != 0u;
        const float qnan = __builtin_nanf("");
#pragma unroll
        for (int ai = 0; ai < 2; ++ai)
#pragma unroll
            for (int m = 0; m < 4; ++m) { const int r = ai * HALF + wr * 64 + m * 16 + fr; const f32x2v sr = S[r]; const size_t off = (size_t)(u.pm * BM + r) * ldc + col0;
#pragma unroll
                for (int bj = 0; bj < 2; ++bj)
#pragma unroll
                    for (int n = 0; n < 2; ++n) { const f32x4 bs = ai == 0 ? pre[m][bj][n] : *(const f32x4*)(base + off + bj * HALF + n * 16); f32x4 o = bs + (acc[ai][bj][m][n] - sr.x) * sr.y;
                        if (bad) o = (f32x4){qnan, qnan, qnan, qnan}; *(f32x4*)(out + off + bj * HALF + n * 16) = o; }
                if (m & 1) asm volatile("" ::: "memory"); }
    }
};
struct EpiLnResLn {
    static constexpr bool PERM = false, AFTER_DRAIN = true;
    const float* base; float* out; bf16_t* xn; int ldc; const float* bias; PanelStats st1, st2; unsigned poison;
    __device__ __forceinline__ void fused(f32x4 (&acc)[2][2][4][2], const Unit& u, int wr, int wc, int fr, int fq, PG8_LAS unsigned char* lds, int wid, int lane) const {
        typedef float f32x2v __attribute__((ext_vector_type(2))); typedef unsigned u32x2v __attribute__((ext_vector_type(2)));
        const PG8_LAS f32x2v* S = (const PG8_LAS f32x2v*)(lds + 8192);
        const int col0 = u.pn * BM + wc * 32 + 4 * fq;
#pragma unroll
        for (int bj = 0; bj < 2; ++bj)
#pragma unroll
            for (int n = 0; n < 2; ++n) { const f32x4 bv = bias ? *(const f32x4*)(bias + col0 + bj * HALF + n * 16) : (f32x4){0.f, 0.f, 0.f, 0.f};
#pragma unroll
                for (int ai = 0; ai < 2; ++ai)
#pragma unroll
                    for (int m = 0; m < 4; ++m) acc[ai][bj][m][n] += bv; }
        bool bad = st1.run(acc, u, wr, wc, fr, fq, lds, wid, lane) || poison != 0u;
        const float qnan = __builtin_nanf("");
#pragma unroll
        for (int ai = 0; ai < 2; ++ai)
#pragma unroll
            for (int m = 0; m < 4; ++m) { const int r = ai * HALF + wr * 64 + m * 16 + fr; const f32x2v sr = S[r]; const size_t off = (size_t)(u.pm * BM + r) * ldc + col0;
#pragma unroll
                for (int bj = 0; bj < 2; ++bj)
#pragma unroll
                    for (int n = 0; n < 2; ++n) { const f32x4 bs = *(const f32x4*)(base + off + bj * HALF + n * 16); acc[ai][bj][m][n] = bs + (acc[ai][bj][m][n] - sr.x) * sr.y; }
                asm volatile("" : "+v"(acc[ai][0][m][0]), "+v"(acc[ai][0][m][1]), "+v"(acc[ai][1][m][0]), "+v"(acc[ai][1][m][1]));
                if (m & 1) asm volatile("" ::: "memory"); }
        const bool bad1 = bad;
        bad = st2.run(acc, u, wr, wc, fr, fq, lds, wid, lane) || bad;
#pragma unroll
        for (int ai = 0; ai < 2; ++ai)
#pragma unroll
            for (int m = 0; m < 4; ++m) { const int r = ai * HALF + wr * 64 + m * 16 + fr; const f32x2v sr = S[r]; const size_t off = (size_t)(u.pm * BM + r) * ldc + col0;
#pragma unroll
                for (int bj = 0; bj < 2; ++bj)
#pragma unroll
                    for (int n = 0; n < 2; ++n) { const f32x4 x1 = acc[ai][bj][m][n]; *(f32x4*)(out + off + bj * HALF + n * 16) = bad1 ? (f32x4){qnan, qnan, qnan, qnan} : x1;
                        const f32x4 o = (x1 - sr.x) * sr.y; u32x2v w; w.x = cvt_pk_bf16(o[0], o[1]); w.y = cvt_pk_bf16(o[2], o[3]);
                        if (bad) { w.x = 0x7fc07fc0u; w.y = 0x7fc07fc0u; } *(u32x2v*)(xn + off + bj * HALF + n * 16) = w; }
                asm volatile("" ::: "memory"); }
    }
};

template <class Epi, class Sched, bool ALIGN_EPI = false, bool SP2 = false>
__device__ __forceinline__ void gemm_phase(PG8_LAS unsigned char* lds, const Gemm g, const Sched& S, const Epi& E) {
    const int tid = threadIdx.x, wid = __builtin_amdgcn_readfirstlane(tid >> 6), lane = tid & 63, wr = wid >> 2, wc = wid & 3, fr = lane & 15, fq = lane >> 4;
    const int K = g.K, nt = K / BK;
    unsigned voffA[2], voffB[2];
#pragma unroll
    for (int i = 0; i < 2; ++i) { int R, C; stage_rc(tid * 16 + i * 8192, R, C); const int Rb = Epi::PERM ? ((R & ~31) + perm32(R & 31)) : R;
        voffA[i] = (unsigned)(R * K + C) * 2u; voffB[i] = (unsigned)(Rb * K + C) * 2u; }
    const size_t kstep = (size_t)(BK * 2);
    const size_t hstep = (size_t)HALF * K * 2;
    const size_t tstep = 2 * hstep;
    const unsigned ldsw = (unsigned)wid * 1024u;
    const int aoff = lds_byte(wr * 64 + fr, fq * 8), boff = lds_byte(wc * 32 + fr, fq * 8);
#define PG8_SA(b, h) (((b) * 2 + (h)) * HTB)
#define PG8_SB(b, h) ((4 + (b) * 2 + (h)) * HTB)
#define PG8_STAGE(bufoff, gbase, voff) do { _Pragma("unroll") for (int _i = 0; _i < 2; ++_i) \
        __builtin_amdgcn_global_load_lds((const unsigned*)((const char*)(gbase) + (voff)[_i]), (PG8_LAS unsigned*)(lds + (bufoff) + ldsw + _i * 8192), 16, 0, 0); } while (0)
#define PG8_LDA(dst, b, h) do { _Pragma("unroll") for (int m = 0; m < 4; ++m) _Pragma("unroll") for (int k = 0; k < 2; ++k) dst[m][k] = *(const PG8_LAS bf16x8*)(lds + PG8_SA(b, h) + aoff + m * 2048 + k * 1024); } while (0)
#define PG8_LDB(dst, b, h) do { _Pragma("unroll") for (int n = 0; n < 2; ++n) _Pragma("unroll") for (int k = 0; k < 2; ++k) dst[n][k] = *(const PG8_LAS bf16x8*)(lds + PG8_SB(b, h) + boff + n * 2048 + k * 1024); } while (0)
#define PG8_MMA(ai, bj, At, Bt) do { __builtin_amdgcn_s_setprio(1); _Pragma("unroll") for (int m = 0; m < 4; ++m) _Pragma("unroll") for (int n = 0; n < 2; ++n) _Pragma("unroll") for (int k = 0; k < 2; ++k) \
        acc[ai][bj][m][n] = __builtin_amdgcn_mfma_f32_16x16x32_bf16(Bt[n][k], At[m][k], acc[ai][bj][m][n], 0, 0, 0); __builtin_amdgcn_s_setprio(0); } while (0)
#define PG8_WAIT_V(n) asm volatile("s_waitcnt vmcnt(" #n ")" ::: "memory")
#define PG8_WAIT_L(n) asm volatile("s_waitcnt lgkmcnt(" #n ")" ::: "memory")
#define PG8_BAR __builtin_amdgcn_s_barrier()
#define PG8_SCHED __builtin_amdgcn_sched_barrier(0)
    Unit cur, nxt; int ui = 0;
    if (!S.next(0, cur)) return;
    f32x4 acc[2][2][4][2];
#pragma unroll
    for (int a = 0; a < 2; ++a)
#pragma unroll
        for (int b = 0; b < 2; ++b)
#pragma unroll
            for (int m = 0; m < 4; ++m)
#pragma unroll
                for (int n = 0; n < 2; ++n) acc[a][b][m][n] = (f32x4){0.f, 0.f, 0.f, 0.f};
    bf16x8 At[4][2], B0[2][2], B1[2][2];
    const char* cA = (const char*)g.A + (size_t)cur.pm * tstep; const char* cB = (const char*)g.Bt + (size_t)cur.pn * tstep;
    S.a_ready(cur);
    if constexpr (SP2) {
        PG8_STAGE(PG8_SB(0, 0), cB, voffB); PG8_STAGE(PG8_SB(0, 1), cB + hstep, voffB); PG8_STAGE(PG8_SA(0, 0), cA, voffA); PG8_STAGE(PG8_SA(0, 1), cA + hstep, voffA);
        if (wr == 1) PG8_BAR;
        PG8_WAIT_V(2); PG8_BAR;
        PG8_STAGE(PG8_SB(1, 0), cB + kstep, voffB); PG8_STAGE(PG8_SA(1, 0), cA + kstep, voffA); PG8_STAGE(PG8_SB(1, 1), cB + hstep + kstep, voffB);
        PG8_WAIT_V(6); PG8_BAR;
    } else {
        PG8_STAGE(PG8_SB(0, 0), cB, voffB); PG8_STAGE(PG8_SA(0, 0), cA, voffA); PG8_STAGE(PG8_SB(0, 1), cB + hstep, voffB); PG8_STAGE(PG8_SA(0, 1), cA + hstep, voffA);
        if (wr == 1) PG8_BAR;
        PG8_WAIT_V(4); PG8_BAR;
        PG8_STAGE(PG8_SB(1, 0), cB + kstep, voffB); PG8_STAGE(PG8_SA(1, 0), cA + kstep, voffA); PG8_STAGE(PG8_SB(1, 1), cB + hstep + kstep, voffB);
        PG8_WAIT_V(6); PG8_BAR;
    }
    for (;;) {
        const bool has_next = S.next(ui + 1, nxt);
        const char* nA = has_next ? (const char*)g.A + (size_t)nxt.pm * tstep : cA; const char* nB = has_next ? (const char*)g.Bt + (size_t)nxt.pn * tstep : cB;
        for (int t = 0; t < nt; t += 2) {
            const bool last = (t == nt - 2);
            const char* a1 = cA + (size_t)(t + 1) * kstep;
            const char* a2 = last ? nA : cA + (size_t)(t + 2) * kstep; const char* b2 = last ? nB : cB + (size_t)(t + 2) * kstep;
            const char* a3 = a2 + kstep; const char* b3 = b2 + kstep;
            if (last && has_next) S.a_ready(nxt);
            if constexpr (SP2) {
            PG8_LDB(B0, 0, 0); PG8_LDB(B1, 0, 1); PG8_SCHED; PG8_LDA(At, 0, 0); PG8_STAGE(PG8_SA(1, 1), a1 + hstep, voffA);
            PG8_WAIT_V(8); PG8_WAIT_L(0); PG8_BAR; PG8_MMA(0, 0, At, B0); PG8_MMA(0, 1, At, B1); PG8_BAR; PG8_SCHED;
            PG8_LDA(At, 0, 1); PG8_STAGE(PG8_SB(0, 0), b2, voffB); PG8_STAGE(PG8_SB(0, 1), b2 + hstep, voffB); PG8_STAGE(PG8_SA(0, 0), a2, voffA);
            PG8_WAIT_V(8); PG8_WAIT_L(0); PG8_BAR; PG8_MMA(1, 0, At, B0); PG8_MMA(1, 1, At, B1); PG8_BAR; PG8_SCHED;
            PG8_LDB(B0, 1, 0); PG8_LDB(B1, 1, 1); PG8_SCHED; PG8_LDA(At, 1, 0); PG8_STAGE(PG8_SA(0, 1), a2 + hstep, voffA);
            PG8_WAIT_V(8); PG8_WAIT_L(0); PG8_BAR; PG8_MMA(0, 0, At, B0); PG8_MMA(0, 1, At, B1); PG8_BAR; PG8_SCHED;
            PG8_LDA(At, 1, 1); PG8_STAGE(PG8_SB(1, 0), b3, voffB); PG8_STAGE(PG8_SB(1, 1), b3 + hstep, voffB); PG8_STAGE(PG8_SA(1, 0), a3, voffA);
            PG8_WAIT_V(8); PG8_WAIT_L(0); PG8_BAR; PG8_MMA(1, 0, At, B0); PG8_MMA(1, 1, At, B1); PG8_BAR; PG8_SCHED;
            } else {
            PG8_LDB(B0, 0, 0); PG8_SCHED; PG8_LDA(At, 0, 0); PG8_STAGE(PG8_SA(1, 1), a1 + hstep, voffA);
            PG8_WAIT_L(8); PG8_BAR; PG8_WAIT_L(0); PG8_MMA(0, 0, At, B0); PG8_BAR; PG8_SCHED;
            PG8_LDB(B1, 0, 1); PG8_STAGE(PG8_SB(0, 0), b2, voffB);
            PG8_BAR; PG8_WAIT_L(0); PG8_MMA(0, 1, At, B1); PG8_BAR;
            PG8_LDA(At, 0, 1); PG8_STAGE(PG8_SA(0, 0), a2, voffA);
            PG8_BAR; PG8_WAIT_L(0); PG8_MMA(1, 0, At, B0); PG8_BAR; PG8_SCHED;
            PG8_STAGE(PG8_SB(0, 1), b2 + hstep, voffB);
            PG8_WAIT_V(6); PG8_BAR; PG8_MMA(1, 1, At, B1); PG8_BAR;
            PG8_LDB(B0, 1, 0); PG8_SCHED; PG8_LDA(At, 1, 0); PG8_STAGE(PG8_SA(0, 1), a2 + hstep, voffA);
            PG8_WAIT_L(8); PG8_BAR; PG8_WAIT_L(0); PG8_MMA(0, 0, At, B0); PG8_BAR; PG8_SCHED;
            PG8_LDB(B1, 1, 1); PG8_STAGE(PG8_SB(1, 0), b3, voffB);
            PG8_BAR; PG8_WAIT_L(0); PG8_MMA(0, 1, At, B1); PG8_BAR;
            PG8_LDA(At, 1, 1); PG8_STAGE(PG8_SA(1, 0), a3, voffA);
            PG8_BAR; PG8_WAIT_L(0); PG8_MMA(1, 0, At, B0); PG8_BAR; PG8_SCHED;
            PG8_STAGE(PG8_SB(1, 1), b3 + hstep, voffB);
            PG8_WAIT_V(6); PG8_BAR; PG8_MMA(1, 1, At, B1); PG8_BAR;
            }
        }
        if constexpr (ALIGN_EPI) { if (wr == 0) PG8_BAR; }
        if constexpr (!Epi::AFTER_DRAIN) { E(acc, cur, wr, wc, fr, fq); S.done(cur); }
        if (!has_next) break;
#pragma unroll
        for (int a = 0; a < 2; ++a)
#pragma unroll
            for (int b = 0; b < 2; ++b)
#pragma unroll
                for (int m = 0; m < 4; ++m)
#pragma unroll
                    for (int n = 0; n < 2; ++n) acc[a][b][m][n] = (f32x4){0.f, 0.f, 0.f, 0.f};
        cur = nxt; cA = nA; cB = nB; ++ui;
        if constexpr (ALIGN_EPI) { if (wr == 1) PG8_BAR; }
    }
    PG8_WAIT_V(0);
    if constexpr (!ALIGN_EPI) { if (wr == 0) PG8_BAR; }
    PG8_BAR;
    if constexpr (Epi::AFTER_DRAIN) { E.fused(acc, cur, wr, wc, fr, fq, lds, wid, lane); S.done(cur); }
#undef PG8_SA
#undef PG8_SB
#undef PG8_STAGE
#undef PG8_LDA
#undef PG8_LDB
#undef PG8_MMA
#undef PG8_WAIT_V
#undef PG8_WAIT_L
#undef PG8_BAR
#undef PG8_SCHED
}
}
#ifndef PG8_SP2
#define PG8_SP2 true
#endif
#ifndef PG8_ALIGN
#define PG8_ALIGN true
#endif
namespace pg8 {
struct EpiF32 {
    static constexpr bool PERM = false, AFTER_DRAIN = false;
    float* O; int ldc; const float* base; float alpha;
    __device__ __forceinline__ void operator()(const f32x4 (&acc)[2][2][4][2], const Unit& u, int wr, int wc, int fr, int fq) const {
        const int col0 = u.pn * BM + wc * 32 + 4 * fq;
#pragma unroll
        for (int ai = 0; ai < 2; ++ai)
#pragma unroll
            for (int m = 0; m < 4; ++m) { const size_t off = (size_t)(u.pm * BM + ai * HALF + wr * 64 + m * 16 + fr) * ldc + col0;
#pragma unroll
                for (int bj = 0; bj < 2; ++bj)
#pragma unroll
                    for (int n = 0; n < 2; ++n) { f32x4 v = acc[ai][bj][m][n];
                        if (base) { const f32x4 bs = *(const f32x4*)(base + off + bj * HALF + n * 16); v = v + bs * alpha; }
                        *(f32x4*)(O + off + bj * HALF + n * 16) = v; } }
    }
};
}

#include <hip/hip_bf16.h>
#include <cmath>
namespace attn_body {
using bf16=__hip_bfloat16;
using bf16x8=__attribute__((ext_vector_type(8)))short;
using s16x4=__attribute__((ext_vector_type(4)))short;
using f32x16=__attribute__((ext_vector_type(16)))float;
using u32x4=__attribute__((ext_vector_type(4)))unsigned;
constexpr int BATCH=4,NHEAD=16,SEQ=4096,D=64,DM=NHEAD*D;
constexpr int NW=8,QBLK=32,QB=QBLK*NW,KVBLK=64,NQB=SEQ/QB;
constexpr int ATTN_PITCH=DM, ATTN_UNIT_ROWS=QB;
__device__ __forceinline__ int crow(int r,int hi){return (r&3)+8*(r>>2)+4*hi;}
#define SBAR() __builtin_amdgcn_sched_barrier(0)
__device__ __forceinline__ void cmask(f32x16&p0,f32x16&p1,int jb,int qrel,int hi){
  const float NEG=-INFINITY; int kb=64*jb+4*hi;
  #pragma unroll
  for(int r=0;r<16;++r){int kv=kb+(r&3)+8*(r>>2); if(kv>qrel)p0[r]=NEG; if(kv+32>qrel)p1[r]=NEG;}
}

constexpr int NSLOT=3, SLOTB=8192;
constexpr int LDS_K=0, LDS_V=NSLOT*SLOTB, LDS_WS=2*NSLOT*SLOTB, LDS_OST=LDS_WS+NW*64*4, LDS_BYTES=LDS_OST+NW*4096;
constexpr float C2=0.125f*1.4426950408889634f;
__device__ __forceinline__ void glds16s(const void*sbase,unsigned voff,unsigned lds_dst){unsigned keep;
  asm volatile("s_nop 4\n\ts_mov_b32 %0, m0\n\ts_mov_b32 m0, %3\n\ts_nop 0\n\tglobal_load_lds_dwordx4 %1, %2\n\ts_mov_b32 m0, %0":"=&s"(keep):"v"(voff),"s"(sbase),"s"(lds_dst):"memory");}
__device__ __forceinline__ void glds16(const void*gsrc,unsigned lds_dst){unsigned keep;
  asm volatile("s_mov_b32 %0, m0\n\ts_mov_b32 m0, %2\n\ts_nop 0\n\tglobal_load_lds_dwordx4 %1, off\n\ts_mov_b32 m0, %0":"=&s"(keep):"v"(gsrc),"s"(lds_dst):"memory");}
__device__ __forceinline__ float max3f(float a,float b,float c){float r;asm("v_max3_f32 %0, %1, %2, %3":"=v"(r):"v"(a),"v"(b),"v"(c));return r;}
__device__ __forceinline__ float max2f(float a,float b){float r;asm("v_max_f32_e32 %0, %1, %2":"=v"(r):"v"(a),"v"(b));return r;}
__device__ __forceinline__ float fadd_s(float a,float b){float r;asm("v_add_f32_e32 %0, %1, %2":"=v"(r):"v"(a),"v"(b));return r;}
__device__ __forceinline__ float fsub_s(float a,float b){float r;asm("v_sub_f32_e32 %0, %1, %2":"=v"(r):"v"(a),"v"(b));return r;}
typedef float f32x2_t __attribute__((ext_vector_type(2))); typedef __bf16 bf16x2_t __attribute__((ext_vector_type(2)));
__device__ __forceinline__ unsigned cvtpk_s(float lo,float hi){f32x2_t v={lo,hi};bf16x2_t b=__builtin_convertvector(v,bf16x2_t);return __builtin_bit_cast(unsigned,b);}
#define WAIT_BAR(N) asm volatile("s_waitcnt vmcnt(" #N ") lgkmcnt(0)\n\ts_barrier":::"memory")

__device__ __forceinline__ void qkt(f32x16&p0,f32x16&p1,const char*Kslot,const bf16x8*qr,const f32x16&negm,int r32,int hi){
  const char*kb=Kslot+hi*1024+r32*16;
  #pragma unroll
  for(int d0=0;d0<4;++d0){
    const bf16x8 b0=*reinterpret_cast<const bf16x8*>(kb+d0*2048);
    const bf16x8 b1=*reinterpret_cast<const bf16x8*>(kb+d0*2048+512);
    if(d0==0){p0=__builtin_amdgcn_mfma_f32_32x32x16_bf16(b0,qr[0],negm,0,0,0);p1=__builtin_amdgcn_mfma_f32_32x32x16_bf16(b1,qr[0],negm,0,0,0);}
    else{p0=__builtin_amdgcn_mfma_f32_32x32x16_bf16(b0,qr[d0],p0,0,0,0);p1=__builtin_amdgcn_mfma_f32_32x32x16_bf16(b1,qr[d0],p1,0,0,0);}}
}
typedef __attribute__((address_space(3))) const char* lds_cptr;
typedef short v4i16_t __attribute__((ext_vector_type(4)));
__device__ __forceinline__ void kload8(bf16x8*kf,lds_cptr kp){
  kf[0]=*(const __attribute__((address_space(3))) bf16x8*)(kp);      kf[1]=*(const __attribute__((address_space(3))) bf16x8*)(kp+512);
  kf[2]=*(const __attribute__((address_space(3))) bf16x8*)(kp+2048); kf[3]=*(const __attribute__((address_space(3))) bf16x8*)(kp+2560);
  kf[4]=*(const __attribute__((address_space(3))) bf16x8*)(kp+4096); kf[5]=*(const __attribute__((address_space(3))) bf16x8*)(kp+4608);
  kf[6]=*(const __attribute__((address_space(3))) bf16x8*)(kp+6144); kf[7]=*(const __attribute__((address_space(3))) bf16x8*)(kp+6656);
}
__device__ __forceinline__ void kload2(bf16x8*kf,lds_cptr kp,int j){ kf[2*j]=*(const __attribute__((address_space(3))) bf16x8*)(kp+j*2048); kf[2*j+1]=*(const __attribute__((address_space(3))) bf16x8*)(kp+j*2048+512); }
__device__ __forceinline__ s16x4 vtr(lds_cptr p){ return __builtin_bit_cast(s16x4,__builtin_amdgcn_ds_read_tr16_b64_v4i16((__attribute__((address_space(3))) v4i16_t*)p)); }
__device__ __forceinline__ float rowmax(const f32x16&p0,const f32x16&p1){
  float a=max3f(p0[0],p0[1],p1[0]),b=max3f(p0[2],p0[3],p1[1]);a=max3f(a,p1[2],p1[3]);
  #pragma unroll
  for(int r=4;r<16;r+=4){a=max3f(a,p0[r],p0[r+1]);b=max3f(b,p0[r+2],p0[r+3]);a=max3f(a,p1[r],p1[r+1]);b=max3f(b,p1[r+2],p1[r+3]);}
  const float m=max2f(a,b);
  auto rr=__builtin_amdgcn_permlane32_swap(__float_as_uint(m),__float_as_uint(m),false,false);
  return max2f(__uint_as_float(rr[0]),__uint_as_float(rr[1]));
}
__device__ __forceinline__ void pv(f32x16*o,int vb,bf16x8 pa0,bf16x8 pa1,bf16x8 pa2,bf16x8 pa3){
  #pragma unroll
  for(int d0=0;d0<2;++d0){s16x4 lo[4],hi[4];
    #pragma unroll
    for(int ks=0;ks<4;++ks){
      asm volatile("ds_read_b64_tr_b16 %0,%1 offset:%c2":"=&v"(lo[ks]):"v"(vb),"i"(d0*4096+ks*1024):"memory");
      asm volatile("ds_read_b64_tr_b16 %0,%1 offset:%c2":"=&v"(hi[ks]):"v"(vb),"i"(d0*4096+ks*1024+512):"memory");}
    asm volatile("s_waitcnt lgkmcnt(0)":::"memory");SBAR();
    #define PK(k) (bf16x8){lo[k][0],lo[k][1],lo[k][2],lo[k][3],hi[k][0],hi[k][1],hi[k][2],hi[k][3]}
    o[d0]=__builtin_amdgcn_mfma_f32_32x32x16_bf16(pa0,PK(0),o[d0],0,0,0);
    o[d0]=__builtin_amdgcn_mfma_f32_32x32x16_bf16(pa1,PK(1),o[d0],0,0,0);
    o[d0]=__builtin_amdgcn_mfma_f32_32x32x16_bf16(pa2,PK(2),o[d0],0,0,0);
    o[d0]=__builtin_amdgcn_mfma_f32_32x32x16_bf16(pa3,PK(3),o[d0],0,0,0);
    #undef PK
  }
}

#ifndef ATTN_STORE16
#define ATTN_STORE16(p,v) (*(u32x4*)(p)=(v))
#endif
template<int THRL> __device__ __forceinline__ void attn_unit(int b,int h,int hv,float sl2,int qb,const bf16*Q,const bf16*__restrict__ K,const bf16*__restrict__ V,bf16*O,char*shm){
  int tid_=threadIdx.x; asm volatile("":"+v"(tid_));
  const int tid=tid_,lane=tid&63,r32=lane&31,hi=lane>>5; const int wid=__builtin_amdgcn_readfirstlane(tid>>6);
  const long rowbase=(long)b*SEQ; const int q0=qb*QB;
  const bf16*Qw=Q+(rowbase+q0+wid*QBLK)*DM+h*D;
  const bf16*Kh=K+rowbase*DM+h*D,*Vh=V+rowbase*DM+hv*D;
  const unsigned lds0=(unsigned)(uintptr_t)shm;
  float*wsf=(float*)(shm+LDS_WS)+wid*64;
  const unsigned koff=(unsigned)((lane*DM+wid*8)*2);
  const unsigned voff=(unsigned)(((16*(wid&3)+(lane>>2))*DM+(wid>>2)*32+(lane&3)*8)*2);
  const unsigned kdst=lds0+LDS_K+wid*1024, vdst=lds0+LDS_V+wid*1024;
  #define DMA_K(t,slot) glds16s(Kh+(long)(t)*KVBLK*DM,koff,(unsigned)__builtin_amdgcn_readfirstlane(kdst+(slot)))
  #define DMA_V(t,slot) glds16s(Vh+(long)(t)*KVBLK*DM,voff,(unsigned)__builtin_amdgcn_readfirstlane(vdst+(slot)))
  const int vb0=(int)(lds0+LDS_V)+((lane>>4)&1)*32+(lane&3)*8+(4*hi+((lane&15)>>2))*64;
  const char*Kbase=shm+LDS_K; bf16x8 kf[8];
  const lds_cptr shm3=(lds_cptr)shm; const lds_cptr kp0=shm3+LDS_K+hi*1024+r32*16; const lds_cptr vp0=shm3+LDS_V+((lane>>4)&1)*32+(lane&3)*8+(4*hi+((lane&15)>>2))*64;
  const int NT=(q0+QB)/KVBLK;
  DMA_K(0,0);DMA_V(0,0);DMA_K(1,SLOTB);
  bf16x8 qr[4];
  #pragma unroll
  for(int d0=0;d0<4;++d0)qr[d0]=*reinterpret_cast<const bf16x8*>(&Qw[(long)r32*DM+d0*16+hi*8]);
  float mhat=sl2*(float)(wid*QBLK+r32)+4.0f,l_reg=0.f;
  f32x16 o[2];o[0]=f32x16{};o[1]=f32x16{};f32x16 negm; { const float nb0_=__builtin_fmaf(sl2,(float)(4*hi-q0),-mhat); _Pragma("unroll") for(int r=0;r<16;++r)negm[r]=nb0_; } asm volatile("":"+v"(negm));
  #define NB(tt) __builtin_fmaf(sl2,(float)(64*(tt)-q0+4*hi),-mhat)
  #define ALIBI(P0,P1) do{ _Pragma("unroll") for(int r=0;r<16;++r){ P0[r]=__builtin_fmaf(sl2,(float)((r&3)+8*(r>>2)),P0[r]); P1[r]=__builtin_fmaf(sl2,(float)(32+(r&3)+8*(r>>2)),P1[r]); } }while(0)
  const int qrel=wid*QBLK+r32;
  #define CMASK(P0,P1,t) do{int jb_=(t)-(NT-4); if(jb_>=0)cmask(P0,P1,jb_,qrel,hi);}while(0)
  bool resc=false;
  #define START(P0,P1) do{ const float rm=rowmax(P0,P1); resc=false; \
    { const float dl=__builtin_fmaxf(rm,0.f); mhat=fadd_s(mhat,dl); \
      _Pragma("unroll") for(int r=0;r<16;++r){P0[r]=fsub_s(P0[r],dl);P1[r]=fsub_s(P1[r],dl);} \
      { const float nb_=NB(1); _Pragma("unroll") for(int r=0;r<16;++r)negm[r]=nb_; } asm volatile("":"+v"(negm)); } \
    _Pragma("unroll") for(int r=0;r<16;++r)P0[r]=__builtin_amdgcn_exp2f(P0[r]); }while(0)
  #define RESC() do{ if(resc){ asm volatile("s_waitcnt lgkmcnt(0)":::"memory"); \
      _Pragma("unroll") for(int d_=0;d_<2;++d_) _Pragma("unroll") for(int r=0;r<16;++r)o[d_][r]*=wsf[crow(r,hi)]; } }while(0)
  f32x16 pA0,pA1,pB0,pB1;
  int sl_prev=0,sl_cur=0,sl_next=SLOTB;
  #define ROT() do{sl_prev=sl_cur;sl_cur=sl_next;sl_next=(sl_next==(NSLOT-1)*SLOTB)?0:sl_next+SLOTB;}while(0)
  DMA_K(2,2*SLOTB);
  WAIT_BAR(3);
  qkt(pA0,pA1,Kbase,qr,negm,r32,hi);asm volatile("s_nop 15\n\ts_nop 7":"+v"(pA0),"+v"(pA1));ALIBI(pA0,pA1);CMASK(pA0,pA1,0);
  START(pA0,pA1);
  _Pragma("unroll") for(int r=0;r<16;++r)pA1[r]=__builtin_amdgcn_exp2f(pA1[r]);
  WAIT_BAR(0);
  DMA_K(3,0);DMA_V(1,SLOTB);
  ROT();
  kload8(kf,kp0+sl_cur);
  WAIT_BAR(2);
  s16x4 vlo[8],vhi[8]; u32x4 pw0,pw1,pw2,pw3;
  #define PKW(P,B) cvtpk_s(P[B],P[B+1])
  #define PAF(k) __builtin_bit_cast(bf16x8,pw##k)
  #define VFR(i) (bf16x8){vlo[i][0],vlo[i][1],vlo[i][2],vlo[i][3],vhi[i][0],vhi[i][1],vhi[i][2],vhi[i][3]}
  #define PIN(x) asm volatile("":"+v"(x))
  #define MX3(a,b,c) __builtin_fmaxf(__builtin_fmaxf((a),(b)),(c))
  #define GAPA(MF,A0,A1,A2,A3,W0,W1,PW) do{ MF; sacc+=A0; sacc+=A1; sacc+=A2; sacc+=A3; PIN(sacc); W0; W1; PIN(PW); SBAR(); }while(0)
  #define EX(v) __builtin_amdgcn_exp2f(v)
  #define GAPB(MF,X,B) do{ MF; X[B]=EX(X[B]); X[B+1]=EX(X[B+1]); X[B+2]=EX(X[B+2]); X[B+3]=EX(X[B+3]); PIN(X); SBAR(); }while(0)
  #define VRD(i) do{ vlo[i]=vtr(vp_+(((i)>>2)*4096+((i)&3)*1024)); vhi[i]=vtr(vp_+(((i)>>2)*4096+((i)&3)*1024+512)); }while(0)
  #define KRD(G,j) do{ if(G){ kload2(kf,kp0+sl_next,j); SBAR(); } }while(0)
  #define STEP(C0,C1,P0,P1,t,GK,GV,GL) do{ SBAR(); \
    const lds_cptr vp_=vp0+sl_prev; \
    VRD(0); SBAR(); float sacc=(P0[0]+P0[1]); \
    GAPA(C0=__builtin_amdgcn_mfma_f32_32x32x16_bf16(kf[0],qr[0],negm,0,0,0), P0[2],P0[3],P0[4],P0[5],     pw0[0]=PKW(P0,0), pw0[1]=PKW(P0,2), pw0); \
    VRD(4); SBAR(); GAPA(C1=__builtin_amdgcn_mfma_f32_32x32x16_bf16(kf[1],qr[0],negm,0,0,0), P0[6],P0[7],P0[8],P0[9],     pw0[2]=PKW(P0,4), pw0[3]=PKW(P0,6), pw0); \
    VRD(1); SBAR(); GAPA(C0=__builtin_amdgcn_mfma_f32_32x32x16_bf16(kf[2],qr[1],C0,0,0,0),   P0[10],P0[11],P0[12],P0[13], pw1[0]=PKW(P0,8), pw1[1]=PKW(P0,10), pw1); \
    VRD(5); SBAR(); GAPA(C1=__builtin_amdgcn_mfma_f32_32x32x16_bf16(kf[3],qr[1],C1,0,0,0),   P0[14],P0[15],P1[0],P1[1],   pw1[2]=PKW(P0,12),pw1[3]=PKW(P0,14), pw1); \
    VRD(2); SBAR(); GAPA(C0=__builtin_amdgcn_mfma_f32_32x32x16_bf16(kf[4],qr[2],C0,0,0,0),   P1[2],P1[3],P1[4],P1[5],     pw2[0]=PKW(P1,0), pw2[1]=PKW(P1,2), pw2); \
    VRD(6); SBAR(); GAPA(C1=__builtin_amdgcn_mfma_f32_32x32x16_bf16(kf[5],qr[2],C1,0,0,0),   P1[6],P1[7],P1[8],P1[9],     pw2[2]=PKW(P1,4), pw2[3]=PKW(P1,6), pw2); \
    VRD(3); SBAR(); GAPA(C0=__builtin_amdgcn_mfma_f32_32x32x16_bf16(kf[6],qr[3],C0,0,0,0),   P1[10],P1[11],P1[12],P1[13], pw3[0]=PKW(P1,8), pw3[1]=PKW(P1,10), pw3); \
    VRD(7); SBAR(); GAPA(C1=__builtin_amdgcn_mfma_f32_32x32x16_bf16(kf[7],qr[3],C1,0,0,0),   P1[14],P1[15],0.f,0.f,       pw3[2]=PKW(P1,12),pw3[3]=PKW(P1,14), pw3); \
    l_reg+=sacc; \
    if(GK){DMA_K((t)+3,sl_cur);} if(GV){DMA_V((t)+1,sl_next);} \
    ALIBI(C0,C1); CMASK(C0,C1,t); \
    { float a=MX3(C0[0],C0[1],C1[0]),b=MX3(C0[2],C0[3],C1[1]); a=MX3(a,C1[2],C1[3]); \
      _Pragma("unroll") for(int r=4;r<16;r+=4){a=MX3(a,C0[r],C0[r+1]);b=MX3(b,C0[r+2],C0[r+3]);a=MX3(a,C1[r],C1[r+1]);b=MX3(b,C1[r+2],C1[r+3]);} \
      float rm=__builtin_fmaxf(a,b); { auto rr=__builtin_amdgcn_permlane32_swap(__float_as_uint(rm),__float_as_uint(rm),false,false); rm=__builtin_fmaxf(__uint_as_float(rr[0]),__uint_as_float(rr[1])); } \
      resc=false; \
      if(__builtin_expect(__any(rm>(float)THRL),0)){ const float dl=__builtin_fmaxf(rm,0.f); mhat+=dl; \
        _Pragma("unroll") for(int r=0;r<16;++r){C0[r]-=dl;C1[r]-=dl;} \
        const float f=__builtin_amdgcn_exp2f(-dl); l_reg*=f; if(hi==0)wsf[r32]=f; resc=true; } \
      { const float nb_=NB((t)+1); _Pragma("unroll") for(int r=0;r<16;++r)negm[r]=nb_; asm volatile("":"+v"(negm)); } } \
    SBAR(); \
    GAPB(o[0]=__builtin_amdgcn_mfma_f32_32x32x16_bf16(PAF(0),VFR(0),o[0],0,0,0), C0,0); \
    GAPB(o[1]=__builtin_amdgcn_mfma_f32_32x32x16_bf16(PAF(0),VFR(4),o[1],0,0,0), C0,4); \
    KRD(GL,0); GAPB(o[0]=__builtin_amdgcn_mfma_f32_32x32x16_bf16(PAF(1),VFR(1),o[0],0,0,0), C0,8); \
    KRD(GL,1); GAPB(o[1]=__builtin_amdgcn_mfma_f32_32x32x16_bf16(PAF(1),VFR(5),o[1],0,0,0), C0,12); \
    KRD(GL,2); GAPB(o[0]=__builtin_amdgcn_mfma_f32_32x32x16_bf16(PAF(2),VFR(2),o[0],0,0,0), C1,0); \
    KRD(GL,3); GAPB(o[1]=__builtin_amdgcn_mfma_f32_32x32x16_bf16(PAF(2),VFR(6),o[1],0,0,0), C1,4); \
    GAPB(o[0]=__builtin_amdgcn_mfma_f32_32x32x16_bf16(PAF(3),VFR(3),o[0],0,0,0), C1,8); \
    GAPB(o[1]=__builtin_amdgcn_mfma_f32_32x32x16_bf16(PAF(3),VFR(7),o[1],0,0,0), C1,12); \
    }while(0)
  int t=1;
  #undef CMASK
  #define CMASK(P0,P1,t) do{}while(0)
  for(;t+5<NT;t+=2){
    STEP(pB0,pB1,pA0,pA1,t,true,true,true);     WAIT_BAR(2); RESC(); ROT();
    STEP(pA0,pA1,pB0,pB1,t+1,true,true,true);   WAIT_BAR(2); RESC(); ROT();
  }
  #undef CMASK
  #define CMASK(P0,P1,t) do{int jb_=(t)-(NT-4); if(jb_>=0)cmask(P0,P1,jb_,qrel,hi);}while(0)
  #define ENDW(tt) do{ if((tt)+3<NT){WAIT_BAR(2);} else if((tt)+2<NT){WAIT_BAR(1);} else {WAIT_BAR(0);} }while(0)
  for(;t+1<NT;t+=2){
    STEP(pB0,pB1,pA0,pA1,t,(t+3<NT),(t+1<NT),(t+1<NT));       ENDW(t);   RESC(); ROT();
    STEP(pA0,pA1,pB0,pB1,t+1,(t+4<NT),(t+2<NT),(t+2<NT));     ENDW(t+1); RESC(); ROT();
  }
  STEP(pB0,pB1,pA0,pA1,NT-1,false,false,false); RESC();
  { float sacc=pB0[0]+pB0[1]; _Pragma("unroll") for(int r=2;r<16;++r)sacc+=pB0[r]; _Pragma("unroll") for(int r=0;r<16;++r)sacc+=pB1[r]; l_reg+=sacc;
    pw0=(u32x4){PKW(pB0,0),PKW(pB0,2),PKW(pB0,4),PKW(pB0,6)};pw1=(u32x4){PKW(pB0,8),PKW(pB0,10),PKW(pB0,12),PKW(pB0,14)};pw2=(u32x4){PKW(pB1,0),PKW(pB1,2),PKW(pB1,4),PKW(pB1,6)};pw3=(u32x4){PKW(pB1,8),PKW(pB1,10),PKW(pB1,12),PKW(pB1,14)};
    SBAR(); pv(o,vb0+sl_cur,PAF(0),PAF(1),PAF(2),PAF(3)); }
  #undef PKW
  #undef PAF
  #undef VFR
  #undef PIN
  #undef MX3
  #undef GAPA
  #undef GAPB
  #undef EX
  #undef VRD
  #undef KRD
  #undef STEP
  #undef ENDW
  {auto rr=__builtin_amdgcn_permlane32_swap(__float_as_uint(l_reg),__float_as_uint(l_reg),false,false);l_reg=__uint_as_float(rr[0])+__uint_as_float(rr[1]);}
  if(hi==0)wsf[32+r32]=l_reg;asm volatile("s_waitcnt lgkmcnt(0)":::"memory");
  float rli[16];
  #pragma unroll
  for(int r=0;r<16;++r)rli[r]=__builtin_amdgcn_rcpf(wsf[32+crow(r,hi)]);
  bf16*Ow=O+(rowbase+q0+wid*QBLK)*DM+hv*D;
  { bf16*stg=(bf16*)(shm+LDS_OST)+wid*2048;
    #pragma unroll
    for(int r=0;r<16;++r){const int orow=crow(r,hi);
      #pragma unroll
      for(int d0=0;d0<2;++d0)stg[orow*64+d0*32+r32]=__float2bfloat16(o[d0][r]*rli[r]);}
    asm volatile("s_waitcnt lgkmcnt(0)":::"memory");
    #pragma unroll
    for(int i=0;i<4;++i){const int row=i*8+(lane>>3),ch=lane&7; const u32x4 v=*(const u32x4*)(stg+row*64+ch*8); ATTN_STORE16(Ow+(long)row*DM+ch*8,v);} }
  asm volatile("s_waitcnt lgkmcnt(0)\n\ts_barrier":::"memory");
  #undef DMA_K
  #undef DMA_V
  #undef CMASK
  #undef START
  #undef RESC
  #undef ROT
  #undef NB
  #undef ALIBI
}
constexpr int ATTN_LDS_BYTES=LDS_BYTES;
struct AttnTensors { const bf16* Q; const bf16* K; const bf16* V; bf16* O0; bf16* O1; const unsigned* NQ; const unsigned* NK; };
struct AttnUnit { int hu; int qb; };
struct StaticOrder {
  int vcu, G;
  __device__ __forceinline__ explicit StaticOrder(int grid,int block):vcu((grid%8==0)?(block%8)*(grid/8)+block/8:block),G(grid){}
  __device__ __forceinline__ bool next(int i,AttnUnit&u)const{
    const int p=(i>>1)*G+vcu; if(p>=128*8)return false; u.hu=p>>3; const int s=p&7; u.qb=(i&1)?15-s:s; return true; }
  __device__ __forceinline__ void a_ready(const AttnUnit&)const{}
  __device__ __forceinline__ void done(const AttnUnit&)const{}
};
template<class Sched,int THRL=8> __device__ __forceinline__ void attn_phase(char*lds,const AttnTensors&T,const Sched&S){
  AttnUnit u;
  for(int i=0;S.next(i,u);++i){ S.a_ready(u); { const int b_=u.hu>>5,hh_=(u.hu>>2)&7,c_=(u.hu>>1)&1,j_=u.hu&1; const int h_=(((hh_&1)?0x7421:0x6530)>>(4*(((hh_>>1)+b_)&3)))&7;     const float sl2_=__builtin_amdgcn_exp2f(-(float)(h_+1))*1.4426950408889634f;
      int ts4_=0; { int lane_=threadIdx.x&63; asm volatile("":"+v"(lane_));
        const int hq_=2*h_+c_, nt_=4*u.qb+4; float qn_=0.f;
        _Pragma("unroll") for(int i_=0;i_<4;++i_) qn_=__builtin_fmaxf(qn_,__uint_as_float(T.NQ[((b_*64+4*u.qb+i_)*16)+hq_]));
        const float kn_=lane_<nt_?__uint_as_float(T.NK[((b_*64+lane_)*16)+hq_]):0.f;
        const float bound_=__builtin_sqrtf(qn_)*__builtin_sqrtf(kn_)*1.001f-sl2_*(float)(256*u.qb-64*lane_-63)-4.0f;
        const unsigned long long keep_=__ballot(lane_<nt_&&!(bound_<-152.0f));
        const int first_=keep_?(int)__builtin_ctzll(keep_):nt_; ts4_=first_>>2; if(ts4_>u.qb)ts4_=u.qb; ts4_=__builtin_amdgcn_readfirstlane(ts4_); }
      const long sh_=(long)ts4_*256*DM;
      attn_unit<THRL>(b_,2*h_+c_,2*h_+j_,sl2_,u.qb-ts4_,T.Q+sh_,T.K+sh_,T.V+sh_,(c_?T.O1:T.O0)+sh_,lds); } S.done(u); }
}
#undef SBAR
#undef WAIT_BAR
}

constexpr int NWAVES = 8;
constexpr int BATCH = 4, SEQ = 4096, D = 2048, M = BATCH * SEQ;
constexpr int AW = 1024, NIN = 5120;
constexpr float LN_EPS = 1e-5f;
constexpr float DN_ALPHA = 1.189207115002721f;
constexpr float C2 = 0.125f * 1.4426950408889634f;
constexpr float LOG2E = 1.4426950408889634f;

constexpr size_t MiB = 1u << 20;
constexpr size_t WS_CTL = 0, CTL_ZERO_BYTES = 1 * MiB;
constexpr size_t WS_WIN = 2 * MiB, WS_WOUT = 22 * MiB, WS_WQ = 30 * MiB, WS_PRM = 38 * MiB;
constexpr size_t WS_XB = 40 * MiB;
constexpr size_t WS_MIX = 40 * MiB;
constexpr size_t WS_Q = 104 * MiB, WS_K = 136 * MiB, WS_V = 168 * MiB, WS_XR = 200 * MiB, WS_XG = 232 * MiB;
constexpr size_t WS_Y1 = 104 * MiB;
constexpr size_t WS_H1 = 232 * MiB;
constexpr size_t WS_H8 = 296 * MiB;
constexpr size_t WS_PQ = 104 * MiB;
constexpr size_t WS_SU = 38 * MiB + 65536, WS_SH = 38 * MiB + 131072;
constexpr size_t WS_WG = 38 * MiB + 262144;
constexpr size_t WS_PART = 104 * MiB;
constexpr size_t WS_FFN = 40 * MiB;
constexpr size_t WS_PK = 2 * MiB;
constexpr size_t WS_U8 = 328 * MiB, WS_V8 = 360 * MiB;
constexpr size_t WS_LA = 328 * MiB, WS_LB = 392 * MiB;
constexpr size_t WS_O0 = 264 * MiB, WS_O1 = 296 * MiB;
constexpr size_t WS_E = 456 * MiB, WS_G = 464 * MiB, WS_TOTA = 472 * MiB, WS_TOTH = 473 * MiB, WS_SKH = 474 * MiB, WS_SKL = 475 * MiB, WS_END = 476 * MiB;
constexpr int CW_BAR = 4096;
constexpr int CW_NQ = 32768, CW_NK = 32768 + 4096;

constexpr int RING_OFF = 0, RING_BYTES = 131072;
constexpr int LDSCTL_OFF = RING_BYTES, MISC_OFF = LDSCTL_OFF + 320;
constexpr int LDS_BYTES = 147456;

#define GAS __attribute__((address_space(1)))
#define LAS __attribute__((address_space(3)))
typedef unsigned short bf16;
typedef unsigned v4u __attribute__((ext_vector_type(4)));
typedef float f32x4 __attribute__((ext_vector_type(4)));
typedef GAS unsigned gu32;
#define RLX_AGENT __ATOMIC_RELAXED, __HIP_MEMORY_SCOPE_AGENT
#define LDS_WAIT() asm volatile("s_waitcnt lgkmcnt(0)" ::: "memory")
#define VM_WAIT() asm volatile("s_waitcnt vmcnt(0)" ::: "memory")
__device__ __forceinline__ unsigned f2bf(float f) { unsigned u = __builtin_bit_cast(unsigned, f); return (u + 0x7fffu + ((u >> 16) & 1u)) >> 16; }
__device__ __forceinline__ unsigned pk2(float lo, float hi) { return f2bf(lo) | (f2bf(hi) << 16); }
__device__ __forceinline__ float bf2f(unsigned short u) { return __uint_as_float(((unsigned)u) << 16); }
__device__ __forceinline__ float gelu_tanh(float x) { const float u = 0.7978845608028654f * (x + 0.044715f * x * x * x); return 0.5f * x * (1.f + tanhf(u)); }

#define XB_TMO      128
#define XB_XCNT(j)  (256  + 64 * (j))
#define XB_XSUB(j)  (1280 + 64 * (j))
#define XB_XGEN(j)  (2304 + 64 * (j))
#define XB_TOP      3328
#define XB_TOPGEN   3392
#define XCD_BAR_WORDS 3456
#define XB_SPIN_CAP (1u << 18)

__device__ __forceinline__ unsigned xb_ld(unsigned* p)              { return __hip_atomic_load(p, __ATOMIC_RELAXED, __HIP_MEMORY_SCOPE_AGENT); }
__device__ __forceinline__ unsigned xb_add(unsigned* p, unsigned v) { return __hip_atomic_fetch_add(p, v, __ATOMIC_RELAXED, __HIP_MEMORY_SCOPE_AGENT); }
__device__ __forceinline__ unsigned xb_xcc_id() { return (unsigned)__builtin_amdgcn_s_getreg((3 << 11) | 20) & 0xFu; }
#define XB_SPIN(cond, bar) do { unsigned _sp = 0; while (cond) { __builtin_amdgcn_s_sleep(1); \
    if ((++_sp & 255u) == 0u) { if (xb_ld(&(bar)[XB_TMO])) break; if (_sp > XB_SPIN_CAP) { atomicAdd(&(bar)[XB_TMO], 1u); break; } } } } while (0)

struct XcdBarrier {
    unsigned* bar; unsigned x;
    volatile LAS unsigned* st;
};

__device__ __forceinline__ XcdBarrier xcd_barrier_post(unsigned* bar, volatile LAS unsigned* st) {
    XcdBarrier b; b.bar = bar; b.x = xb_xcc_id(); b.st = st;
    if (threadIdx.x == 0) (void)xb_add(&bar[XB_XCNT(b.x)], 1u);
    return b;
}
__device__ __forceinline__ void xcd_barrier_complete(unsigned* bar, unsigned x, unsigned& nloc, unsigned& nx) {
    const unsigned G = gridDim.x * gridDim.y * gridDim.z;
    unsigned sum, cnt, mine, sp = 0u;
    for (;;) {
        sum = 0u; cnt = 0u; mine = 0u;
#pragma unroll
        for (unsigned j = 0; j < 16; ++j) { const unsigned c = xb_ld(&bar[XB_XCNT(j)]); sum += c; cnt += (c > 0u) ? 1u : 0u; mine = (j == x) ? c : mine; }
        if (sum == G) break;
        __builtin_amdgcn_s_sleep(1);
        if ((++sp & 255u) == 0u) { if (xb_ld(&bar[XB_TMO])) break; if (sp > XB_SPIN_CAP) { atomicAdd(&bar[XB_TMO], 1u); break; } }
    }
    nloc = mine > 0u ? mine : 1u; nx = cnt > 0u ? cnt : 1u;
}

__device__ __forceinline__ void xcd_barrier(const XcdBarrier& b) {
    asm volatile("s_waitcnt vmcnt(0)" ::: "memory");
    __syncthreads();
    if (threadIdx.x == 0) {
        unsigned* bar = b.bar;
        __builtin_amdgcn_s_waitcnt(0);
        unsigned nloc = b.st[0], nx = b.st[1];
        if (nloc == 0u) { xcd_barrier_complete(bar, b.x, nloc, nx); b.st[0] = nloc; b.st[1] = nx; }
        const unsigned old = xb_add(&bar[XB_XSUB(b.x)], 1u);
        const unsigned gen = old / nloc;
        if (old + 1u == (gen + 1u) * nloc) {
            __builtin_amdgcn_fence(__ATOMIC_RELEASE, "agent");
            asm volatile("s_waitcnt vmcnt(0)" ::: "memory");
            const unsigned og = xb_add(&bar[XB_TOP], 1u);
            const unsigned tg = og / nx;
            if (og + 1u == (tg + 1u) * nx) xb_add(&bar[XB_TOPGEN], 1u);
            else XB_SPIN(xb_ld(&bar[XB_TOPGEN]) == tg, bar);
            __builtin_amdgcn_fence(__ATOMIC_ACQUIRE, "agent");
            xb_add(&bar[XB_XGEN(b.x)], 1u);
            asm volatile("s_waitcnt vmcnt(0)" ::: "memory");
        } else {
            XB_SPIN(xb_ld(&bar[XB_XGEN(b.x)]) == gen, bar);
            __builtin_amdgcn_fence(__ATOMIC_ACQUIRE, "agent");
            asm volatile("s_waitcnt vmcnt(0)" ::: "memory");
        }
    }
    __syncthreads();
}

struct Frame {
    LAS unsigned char* lds;
    int tid, lane, wave;
    int vcu, G;
};

__device__ __forceinline__ void p0_transpose_item(const float* W, int K, int N, bf16* WT, int row_off, LAS float* scr, int item, int lane) {
    const int nblk = N / 32, kb = item / nblk, nb = item % nblk, k0 = 64 * kb, n0 = 32 * nb;
#pragma unroll 8
    for (int i = 0; i < 32; ++i) { const int kk = 2 * i + (lane >> 5); scr[kk * 33 + (lane & 31)] = W[(size_t)(k0 + kk) * N + n0 + (lane & 31)]; }
    LDS_WAIT(); asm volatile("" ::: "memory");
    const int c = lane & 7;
#pragma unroll
    for (int j = 0; j < 4; ++j) { const int n = (lane >> 3) + 8 * j; const LAS float* s = scr + (8 * c) * 33 + n;
        v4u o; o.x = pk2(s[0 * 33], s[1 * 33]); o.y = pk2(s[2 * 33], s[3 * 33]); o.z = pk2(s[4 * 33], s[5 * 33]); o.w = pk2(s[6 * 33], s[7 * 33]);
        *(GAS v4u*)(WT + (size_t)(row_off + n0 + n) * K + k0 + 8 * c) = o; }
    LDS_WAIT(); asm volatile("" ::: "memory");
}

typedef short bf16x8 __attribute__((ext_vector_type(8)));
typedef float f32x16 __attribute__((ext_vector_type(16)));
typedef float f32x2_t __attribute__((ext_vector_type(2))); typedef __bf16 bf16x2_t __attribute__((ext_vector_type(2)));
__device__ __forceinline__ unsigned cvtpk(float lo, float hi) { f32x2_t v = {lo, hi}; bf16x2_t b = __builtin_convertvector(v, bf16x2_t); return __builtin_bit_cast(unsigned, b); }
__device__ __forceinline__ void split8(const f32x4 a, const f32x4 b, bf16x8& h, bf16x8& l) {
    v4u hh; hh.x = cvtpk(a.x, a.y); hh.y = cvtpk(a.z, a.w); hh.z = cvtpk(b.x, b.y); hh.w = cvtpk(b.z, b.w);
    v4u ll;
    ll.x = cvtpk(a.x - __uint_as_float(hh.x << 16), a.y - __uint_as_float(hh.x & 0xffff0000u));
    ll.y = cvtpk(a.z - __uint_as_float(hh.y << 16), a.w - __uint_as_float(hh.y & 0xffff0000u));
    ll.z = cvtpk(b.x - __uint_as_float(hh.z << 16), b.y - __uint_as_float(hh.z & 0xffff0000u));
    ll.w = cvtpk(b.z - __uint_as_float(hh.w << 16), b.w - __uint_as_float(hh.w & 0xffff0000u));
    h = __builtin_bit_cast(bf16x8, hh); l = __builtin_bit_cast(bf16x8, ll);
}
__device__ __forceinline__ float max3f_(float a, float b, float c) { return __builtin_fmaxf(__builtin_fmaxf(a, b), c); }
__device__ __forceinline__ float pair_max(float m) { auto rr = __builtin_amdgcn_permlane32_swap(__float_as_uint(m), __float_as_uint(m), false, false); return __builtin_fmaxf(__uint_as_float(rr[0]), __uint_as_float(rr[1])); }
__device__ __forceinline__ void route_half(const float* qp, const v4u* kh, const v4u* kl, int lane, int hi, float (&lst)[16]) {
    f32x16 sc[4];
#pragma unroll
    for (int kt = 0; kt < 4; ++kt) sc[kt] = f32x16{};
#pragma unroll 2
    for (int ds = 0; ds < 8; ++ds) { bf16x8 qh, ql; split8(*(const f32x4*)(qp + 16 * ds), *(const f32x4*)(qp + 16 * ds + 4), qh, ql);
#pragma unroll
        for (int kt = 0; kt < 4; ++kt) { const bf16x8 ah = __builtin_bit_cast(bf16x8, kh[(kt * 8 + ds) * 64 + lane]), al = __builtin_bit_cast(bf16x8, kl[(kt * 8 + ds) * 64 + lane]);
            sc[kt] = __builtin_amdgcn_mfma_f32_32x32x16_bf16(ah, qh, sc[kt], 0, 0, 0);
            sc[kt] = __builtin_amdgcn_mfma_f32_32x32x16_bf16(ah, ql, sc[kt], 0, 0, 0);
            sc[kt] = __builtin_amdgcn_mfma_f32_32x32x16_bf16(al, qh, sc[kt], 0, 0, 0); } }
#pragma unroll
    for (int kt = 0; kt < 4; ++kt)
#pragma unroll
        for (int r = 0; r < 16; ++r) { const unsigned key = (unsigned)(kt * 32 + (r & 3) + 8 * (r >> 2) + 4 * hi); sc[kt][r] = __uint_as_float((__float_as_uint(sc[kt][r]) & ~127u) | (127u - key)); }
#pragma unroll
    for (int rd = 0; rd < 16; ++rd) {
        float m = max3f_(sc[0][0], sc[0][1], sc[0][2]);
#pragma unroll
        for (int n = 3; n + 1 < 64; n += 2) m = max3f_(m, sc[n >> 4][n & 15], sc[(n + 1) >> 4][(n + 1) & 15]);
        m = __builtin_fmaxf(m, sc[3][15]);
        const float gm = pair_max(m); lst[rd] = gm;
#pragma unroll
        for (int kt = 0; kt < 4; ++kt)
#pragma unroll
            for (int r = 0; r < 16; ++r) sc[kt][r] = (__float_as_uint(sc[kt][r]) == __float_as_uint(gm)) ? -INFINITY : sc[kt][r];
    }
}
typedef float f32x2v __attribute__((ext_vector_type(2)));
__device__ __forceinline__ unsigned pk4_fp8(float a, float b, float c, float d) { int p = __builtin_amdgcn_cvt_pk_fp8_f32(a, b, 0, false); p = __builtin_amdgcn_cvt_pk_fp8_f32(c, d, p, true); return (unsigned)p; }
constexpr float U8_SCALE = 64.f;
typedef short bf16x8_l __attribute__((ext_vector_type(8)));
template <int PASS> __device__ __forceinline__ void lru_phase(const Frame& F, unsigned char* ws, const float* conv_w, const float* conv_b, const float* b_a, const float* b_x, const float* lru_lambda) {
    constexpr int XS = 272;
    LAS unsigned char* xs = F.lds + RING_OFF;
    const bf16* XR = (const bf16*)(ws + WS_XR); const bf16* XG = (const bf16*)(ws + WS_XG); bf16* MIX = (bf16*)(ws + WS_MIX); const bf16* WGT = (const bf16*)(ws + WS_WG);
    float* TA = (float*)(ws + WS_TOTA); float* TH = (float*)(ws + WS_TOTH);
    const int tid = F.tid, lane = F.lane, w = F.wave, l15 = lane & 15, g = lane >> 4;
    const int hb = F.vcu & 7;
    const int nun = 2048 / 8;
    const int gi = F.vcu >> 3, gn = (F.G + 7 - hb) >> 3;
    const int chc = tid & 127, tg = tid >> 7, colc = hb * 128 + chc;
    const float cw0 = conv_w[colc], cw1 = conv_w[1024 + colc], cw2 = conv_w[2048 + colc], cw3 = conv_w[3072 + colc], cb = conv_b[colc];
    const int chn = hb * 128 + 16 * w + l15;
    bf16x8_l Ba[4], Bx[4];
#pragma unroll
    for (int ks = 0; ks < 4; ++ks) { Ba[ks] = *(const bf16x8_l*)(WGT + ((size_t)(hb * 128 + 16 * w + l15)) * 128 + 32 * ks + 8 * g); Bx[ks] = *(const bf16x8_l*)(WGT + ((size_t)((8 + hb) * 128 + 16 * w + l15)) * 128 + 32 * ks + 8 * g); }
    const float ba = b_a[chn], bx = b_x[chn], sp8 = 8.f * log1pf(__expf(-lru_lambda[chn]));
    unsigned short xrn[19], xgn[16]; float tan_[16], thn_[16];
#define LRU_LOAD(uu) do { const int c_ = (uu) & 63, b_ = (uu) >> 6, tok0_ = b_ * SEQ + c_ * 64; \
        _Pragma("unroll") for (int r = 0; r < 19; ++r) xrn[r] = (c_ * 64 + tg * 16 + r - 3 >= 0) ? XR[(size_t)(tok0_ + tg * 16 + r - 3) * AW + colc] : (unsigned short)0; \
        if (PASS == 2) { _Pragma("unroll") for (int m = 0; m < 4; ++m) _Pragma("unroll") for (int r = 0; r < 4; ++r) xgn[4 * m + r] = XG[(size_t)(tok0_ + 16 * m + 4 * g + r) * AW + chn]; \
            _Pragma("unroll") for (int i = 0; i < 16; ++i) { const int c2 = 16 * g + i, cl = c2 < c_ ? c2 : 0; tan_[i] = TA[(b_ * 64 + cl) * 1024 + chn]; thn_[i] = TH[(b_ * 64 + cl) * 1024 + chn]; } } } while (0)
    if (gi < nun) LRU_LOAD(gi);
    for (int uu = gi; uu < nun; uu += gn) {
        const int c = uu & 63, b = uu >> 6, tok0 = b * SEQ + c * 64;
        {
            float xv[19];
#pragma unroll
            for (int r = 0; r < 19; ++r) xv[r] = bf2f(xrn[r]);
#pragma unroll
            for (int i = 0; i < 16; ++i) { const float y = cb + cw0 * xv[i] + cw1 * xv[i + 1] + cw2 * xv[i + 2] + cw3 * xv[i + 3];
                *(LAS unsigned short*)(xs + (tg * 16 + i) * XS + chc * 2) = (unsigned short)f2bf(y); }
        }
        unsigned short xgv[16]; float ta[16], th[16];
        if (PASS == 2) {
#pragma unroll
            for (int i = 0; i < 16; ++i) { xgv[i] = xgn[i]; const int c2 = 16 * g + i; ta[i] = c2 < c ? tan_[i] : 1.f; th[i] = c2 < c ? thn_[i] : 0.f; } }
        __syncthreads();
        if (uu + gn < nun) LRU_LOAD(uu + gn);
        f32x4 ca[4], cx[4];
#pragma unroll
        for (int m = 0; m < 4; ++m) { ca[m] = (f32x4){0.f, 0.f, 0.f, 0.f}; cx[m] = (f32x4){0.f, 0.f, 0.f, 0.f};
#pragma unroll
            for (int ks = 0; ks < 4; ++ks) { const bf16x8_l A = *(const LAS bf16x8_l*)(xs + (16 * m + l15) * XS + (32 * ks + 8 * g) * 2);
                ca[m] = __builtin_amdgcn_mfma_f32_16x16x32_bf16(A, Ba[ks], ca[m], 0, 0, 0); cx[m] = __builtin_amdgcn_mfma_f32_16x16x32_bf16(A, Bx[ks], cx[m], 0, 0, 0); } }
        float av[4][4], bv[4][4];
#pragma unroll
        for (int m = 0; m < 4; ++m)
#pragma unroll
            for (int r = 0; r < 4; ++r) { const int tt = 16 * m + 4 * g + r;
                const float rg = 1.f / (1.f + __expf(-(ca[m][r] + ba))), ig = 1.f / (1.f + __expf(-(cx[m][r] + bx)));
                const float a = __expf(-sp8 * rg), xcv = bf2f(*(const LAS unsigned short*)(xs + tt * XS + (16 * w + l15) * 2));
                av[m][r] = a; bv[m][r] = sqrtf(fmaxf(1.f - a * a, 0.f)) * ig * xcv; }
        float carry = 0.f, Ac = 1.f;
        if (PASS == 2) {
            float Ap = 1.f, Hp = 0.f;
#pragma unroll
            for (int i = 0; i < 16; ++i) { Hp = ta[i] * Hp + th[i]; Ap *= ta[i]; }
            { const float A1 = __shfl_up(Ap, 16), H1 = __shfl_up(Hp, 16); if (g >= 1) { Hp = Ap * H1 + Hp; Ap = Ap * A1; } }
            { const float A2 = __shfl_up(Ap, 32), H2 = __shfl_up(Hp, 32); if (g >= 2) { Hp = Ap * H2 + Hp; Ap = Ap * A2; } }
            carry = __shfl(Hp, 48 + l15);
        }
#pragma unroll
        for (int m = 0; m < 4; ++m) {
            float As = (av[m][0] * av[m][1]) * (av[m][2] * av[m][3]);
            float Hs = ((bv[m][0] * av[m][1] + bv[m][1]) * av[m][2] + bv[m][2]) * av[m][3] + bv[m][3];
            { const float A1 = __shfl_up(As, 16), H1 = __shfl_up(Hs, 16); if (g >= 1) { Hs = As * H1 + Hs; As = As * A1; } }
            { const float A2 = __shfl_up(As, 32), H2 = __shfl_up(Hs, 32); if (g >= 2) { Hs = As * H2 + Hs; As = As * A2; } }
            const float At = __shfl(As, 48 + l15), Ht = __shfl(Hs, 48 + l15);
            if (PASS == 2) {
                float Ae = __shfl_up(As, 16), He = __shfl_up(Hs, 16); if (g == 0) { Ae = 1.f; He = 0.f; }
                float h = Ae * carry + He;
#pragma unroll
                for (int r = 0; r < 4; ++r) { h = av[m][r] * h + bv[m][r]; const int tt = 16 * m + 4 * g + r;
                    MIX[(size_t)(tok0 + tt) * D + 1024 + chn] = (bf16)f2bf(h * gelu_tanh(bf2f(xgv[4 * m + r]))); }
            }
            carry = At * carry + Ht; Ac *= At;
        }
        if (PASS == 1 && g == 0) { TA[(b * 64 + c) * 1024 + chn] = Ac; TH[(b * 64 + c) * 1024 + chn] = carry; }
        __syncthreads();
    }
#undef LRU_LOAD
}
struct Args { const float* in[23]; float* out; unsigned char* ws; int ph_lo, ph_hi; };

__global__ void __launch_bounds__(NWAVES * 64, 2) skel_fwd(Args args) {
    extern __shared__ __attribute__((aligned(16))) unsigned char lds[];
    Frame F;
    F.lds = (LAS unsigned char*)lds;
    F.tid = threadIdx.x; F.lane = F.tid & 63; F.wave = __builtin_amdgcn_readfirstlane(F.tid >> 6);
    F.G = gridDim.x; { const int bx = blockIdx.x; F.vcu = (F.G % 8 == 0) ? (bx % 8) * (F.G / 8) + bx / 8 : bx; }
    unsigned char* ws = args.ws;
    const float* x = args.in[0];
    bf16* WIN_T = (bf16*)(ws + WS_WIN); bf16* WOUT_T = (bf16*)(ws + WS_WOUT); bf16* WQ_T = (bf16*)(ws + WS_WQ);
    bf16* XB = (bf16*)(ws + WS_XB); bf16* MIX = (bf16*)(ws + WS_MIX); bf16* QB = (bf16*)(ws + WS_Q); bf16* H1 = (bf16*)(ws + WS_H1);
    float* Y1 = (float*)(ws + WS_Y1); float* PQ = (float*)(ws + WS_PQ);
    for (int u = F.tid; u < (LDS_BYTES - LDSCTL_OFF) / 4; u += NWAVES * 64) ((LAS unsigned*)(F.lds + LDSCTL_OFF))[u] = 0u;
    __syncthreads();
    XcdBarrier bar = xcd_barrier_post((unsigned*)(ws + WS_CTL) + CW_BAR, (volatile LAS unsigned*)(F.lds + MISC_OFF) + 8);
    const unsigned phmask = (unsigned)args.ph_lo;
    int slot_ = 0;
#define IN(k) (false)
#define RUN(slotbit) ((phmask >> (slotbit)) & 1u)
#define GRID_BAR() do { if (phmask == 0xffffffffu) xcd_barrier(bar); } while (0)

    if (RUN(0)) {
        if (blockIdx.x == 0 && F.wave == 0) {
            float a_ = args.in[9][F.lane] * args.in[10][F.lane], b_ = args.in[11][F.lane] * args.in[12][F.lane];
#pragma unroll
            for (int o = 1; o < 64; o <<= 1) { a_ += __shfl_xor(a_, o); b_ += __shfl_xor(b_, o); }
            if (F.lane == 0) ((float*)(ws + WS_PRM))[0] = expf(a_) - expf(b_) + 0.2f;
        }
        LAS float* scr = (LAS float*)(F.lds + RING_OFF + F.wave * 16384);
        const int gw = F.vcu * NWAVES + F.wave, NGW = F.G * NWAVES;
        constexpr int I_IN = (D / 64) * (NIN / 32), I_SQ = (D / 64) * (D / 32);
        constexpr int NITEMS = I_IN + 2 * I_SQ;
        for (int it = gw; it < NITEMS; it += NGW) {
            int r = it;
            if (r < I_IN) { p0_transpose_item(args.in[1], D, NIN, WIN_T, 0, scr, r, F.lane); continue; } r -= I_IN;
            if (r < I_SQ) { p0_transpose_item(args.in[14], D, D, WOUT_T, 0, scr, r, F.lane); continue; } r -= I_SQ;
            p0_transpose_item(args.in[17], D, D, WQ_T, 0, scr, r, F.lane);
        }
        for (int it = gw; it < 128; it += NGW) { const int mt = it >> 3;
            p0_transpose_item(args.in[mt < 8 ? 4 : 6] + (size_t)(mt & 7) * 16384, 128, 128, (bf16*)(ws + WS_WG) + (size_t)mt * 16384, 0, scr, it & 7, F.lane); }
        {
            const float* sk = args.in[18]; v4u* SKH = (v4u*)(ws + WS_SKH); v4u* SKL = (v4u*)(ws + WS_SKL);
            for (int fi = gw; fi < 512; fi += NGW) { const int ds = fi & 7, kt = (fi >> 3) & 3, hp = fi >> 5;
                const float* src = sk + ((size_t)(hp * 128 + kt * 32 + (F.lane & 31)) * 128 + 16 * ds + 8 * (F.lane >> 5));
                bf16x8 h8, l8; split8(*(const f32x4*)src, *(const f32x4*)(src + 4), h8, l8);
                SKH[fi * 64 + F.lane] = __builtin_bit_cast(v4u, h8); SKL[fi * 64 + F.lane] = __builtin_bit_cast(v4u, l8); }
        }
        for (int m = gw; m < M; m += NGW) {
            const GAS f32x4* xr = (const GAS f32x4*)(x + (size_t)m * D) + F.lane;
            GAS unsigned long long* o8 = (GAS unsigned long long*)(XB + (size_t)m * D) + F.lane;
#pragma unroll
            for (int j = 0; j < 8; ++j) { const f32x4 v = xr[64 * j]; o8[64 * j] = (unsigned long long)pk2(v.x, v.y) | ((unsigned long long)pk2(v.z, v.w) << 32); }
        }
    }
    GRID_BAR();
    if (RUN(1)) {
        pg8::Gemm g{XB, WIN_T, M, NIN, D}; pg8::StaticOrder S; S.init(M, NIN, F.G, (int)blockIdx.x);
        pg8::EpiBf16<0> E{QB, AW, nullptr, AW, (size_t)(WS_K - WS_Q) / 2, C2};
        pg8::gemm_phase<pg8::EpiBf16<0>, pg8::StaticOrder, PG8_ALIGN, PG8_SP2>(F.lds + RING_OFF, g, S, E);
    }
    GRID_BAR();
    if (RUN(2)) { lru_phase<1>(F, ws, args.in[2], args.in[3], args.in[5], args.in[7], args.in[8]);
        {
            const int gw = F.vcu * NWAVES + F.wave, NGW = F.G * NWAVES, lane = F.lane; unsigned* ctlw = (unsigned*)(ws + WS_CTL);
            for (int it = gw; it < 2 * (M / 16); it += NGW) { const int z = it & 1, r16 = it >> 1; const bf16* src = (const bf16*)(ws + (z ? WS_K : WS_Q)) + (size_t)r16 * 16 * AW + 8 * lane;
                float mx0 = 0.f, mx1 = 0.f;
#pragma unroll 4
                for (int r = 0; r < 16; ++r) {
#pragma unroll
                    for (int hf = 0; hf < 2; ++hf) { const v4u q = *(const v4u*)(src + (size_t)r * AW + hf * 512); float ss = 0.f;
#pragma unroll
                        for (int e = 0; e < 4; ++e) { const float lo = __uint_as_float(q[e] << 16), hi = __uint_as_float(q[e] & 0xffff0000u); ss += lo * lo + hi * hi; }
                        ss += __builtin_bit_cast(float, __builtin_amdgcn_update_dpp(0, __builtin_bit_cast(int, ss), 0xB1, 0xf, 0xf, true)); ss += __builtin_bit_cast(float, __builtin_amdgcn_update_dpp(0, __builtin_bit_cast(int, ss), 0x4E, 0xf, 0xf, true));
                        ss += __builtin_bit_cast(float, __builtin_amdgcn_update_dpp(0, __builtin_bit_cast(int, ss), 0x141, 0xf, 0xf, true));
                        if (hf == 0) mx0 = fmaxf(mx0, ss); else mx1 = fmaxf(mx1, ss); } }
                if ((lane & 7) == 0) { unsigned* dst = ctlw + (z ? CW_NK : CW_NQ) + (r16 >> 2) * 16 + (lane >> 3); atomicMax(dst, __float_as_uint(mx0)); atomicMax(dst + 8, __float_as_uint(mx1)); }
            }
        }
    }
    GRID_BAR();
    if (RUN(4)) {
        static_assert(attn_body::ATTN_LDS_BYTES <= RING_BYTES && attn_body::ATTN_PITCH == AW, "attention body geometry vs frame");
        const attn_body::AttnTensors AT{(const attn_body::bf16*)QB, (const attn_body::bf16*)(ws + WS_K), (const attn_body::bf16*)(ws + WS_V), (attn_body::bf16*)(ws + WS_O0), (attn_body::bf16*)(ws + WS_O1), (const unsigned*)(ws + WS_CTL) + CW_NQ, (const unsigned*)(ws + WS_CTL) + CW_NK};
        const attn_body::StaticOrder S((int)F.G, (int)blockIdx.x);
        attn_body::attn_phase<attn_body::StaticOrder>((char*)lds + RING_OFF, AT, S);
    }
    if (RUN(5)) lru_phase<2>(F, ws, args.in[2], args.in[3], args.in[5], args.in[7], args.in[8]);
    GRID_BAR();
    if (RUN(6)) {
        const int gw = F.vcu * NWAVES + F.wave, NGW = F.G * NWAVES;
        const float lam = ((const float*)(ws + WS_PRM))[0];
        const bf16* O0 = (const bf16*)(ws + WS_O0); const bf16* O1 = (const bf16*)(ws + WS_O1);
        const float g0 = args.in[13][2 * F.lane] * 0.8f, g1 = args.in[13][2 * F.lane + 1] * 0.8f;
        for (int it = gw; it < M * 8; it += NGW) { const int tok = it >> 3, h = it & 7;
            const unsigned a = *(const unsigned*)(O0 + (size_t)tok * AW + h * 128 + 2 * F.lane), b = *(const unsigned*)(O1 + (size_t)tok * AW + h * 128 + 2 * F.lane);
            const float d0 = bf2f((unsigned short)(a & 0xffff)) - lam * bf2f((unsigned short)(b & 0xffff)), d1 = bf2f((unsigned short)(a >> 16)) - lam * bf2f((unsigned short)(b >> 16));
            float ss = d0 * d0 + d1 * d1;
#pragma unroll
            for (int o = 1; o < 64; o <<= 1) ss += __shfl_xor(ss, o);
            const float r = rsqrtf(ss * (1.f / 128.f) + LN_EPS);
            *(unsigned*)(MIX + (size_t)tok * D + h * 128 + 2 * F.lane) = pk2(d0 * r * g0, d1 * r * g1); }
    }
    GRID_BAR();
    if (RUN(7)) {
        pg8::Gemm g{MIX, WOUT_T, M, D, D}; pg8::StaticOrder S; S.init(M, D, F.G, (int)blockIdx.x);
        pg8::EpiBf16<0> E{(bf16*)Y1, D, nullptr, 0, 0, 1.f};
        pg8::gemm_phase<pg8::EpiBf16<0>, pg8::StaticOrder, PG8_ALIGN, PG8_SP2>(F.lds + RING_OFF, g, S, E);
    }
    GRID_BAR();
    if (RUN(8)) {
        const int gw = F.vcu * NWAVES + F.wave, NGW = F.G * NWAVES; const float* g = args.in[15]; const float* bb = args.in[16];
        for (int row = gw; row < M; row += NGW) {
            const f32x4* xr_ = (const f32x4*)(x + (size_t)row * D); const unsigned long long* yb = (const unsigned long long*)((const bf16*)Y1 + (size_t)row * D);
            f32x4 v[8]; float s = 0.f;
#pragma unroll
            for (int j = 0; j < 8; ++j) { const f32x4 xv_ = xr_[F.lane + 64 * j]; const unsigned long long q_ = yb[F.lane + 64 * j]; const unsigned q0 = (unsigned)q_, q1 = (unsigned)(q_ >> 32);
                v[j].x = DN_ALPHA * xv_.x + __uint_as_float(q0 << 16); v[j].y = DN_ALPHA * xv_.y + __uint_as_float(q0 & 0xffff0000u); v[j].z = DN_ALPHA * xv_.z + __uint_as_float(q1 << 16); v[j].w = DN_ALPHA * xv_.w + __uint_as_float(q1 & 0xffff0000u);
                s += (v[j].x + v[j].y) + (v[j].z + v[j].w); }
#pragma unroll
            for (int o = 1; o < 64; o <<= 1) s += __shfl_xor(s, o);
            const float mean = s * (1.f / D); float s2 = 0.f;
#pragma unroll
            for (int j = 0; j < 8; ++j) { v[j] = v[j] - mean; s2 += (v[j].x * v[j].x + v[j].y * v[j].y) + (v[j].z * v[j].z + v[j].w * v[j].w); }
#pragma unroll
            for (int o = 1; o < 64; o <<= 1) s2 += __shfl_xor(s2, o);
            const float rstd = rsqrtf(s2 * (1.f / D) + LN_EPS);
#pragma unroll
            for (int j = 0; j < 8; ++j) { const int c = (F.lane + 64 * j) * 4; const f32x4 gg = *(const f32x4*)(g + c), bv = *(const f32x4*)(bb + c);
                const f32x4 o = v[j] * rstd * gg + bv;
                *(unsigned long long*)(H1 + (size_t)row * D + c) = (unsigned long long)pk2(o.x, o.y) | ((unsigned long long)pk2(o.z, o.w) << 32);
                v[j] = o; }
            float am = 0.f;
#pragma unroll
            for (int j = 0; j < 8; ++j) am = fmaxf(fmaxf(am, fmaxf(fabsf(v[j].x), fabsf(v[j].y))), fmaxf(fabsf(v[j].z), fabsf(v[j].w)));
#pragma unroll
            for (int o = 1; o < 64; o <<= 1) am = fmaxf(am, __shfl_xor(am, o));
            const float qs = am > 0.f ? 127.f / am : 0.f;
            if (F.lane == 0) ((float*)(ws + WS_SH))[row] = am * (1.f / 127.f);
#pragma unroll
            for (int j = 0; j < 8; ++j) { const int c = (F.lane + 64 * j) * 4;
                const unsigned q = ((unsigned)(int)rintf(v[j].x * qs) & 0xffu) | (((unsigned)(int)rintf(v[j].y * qs) & 0xffu) << 8) | (((unsigned)(int)rintf(v[j].z * qs) & 0xffu) << 16) | (((unsigned)(int)rintf(v[j].w * qs) & 0xffu) << 24);
                *(unsigned*)(ws + WS_H8 + ((size_t)(c >> 7) * M + row) * 128 + (c & 127)) = q; }
        }
        {
            const float* us = args.in[19]; float* SU = (float*)(ws + WS_SU);
            for (int e = gw; e < 16384; e += NGW) {
                const f32x4* ur = (const f32x4*)(us + (size_t)e * D); f32x4 uv[8]; float am = 0.f;
#pragma unroll
                for (int j = 0; j < 8; ++j) { uv[j] = ur[F.lane + 64 * j]; am = fmaxf(fmaxf(am, fmaxf(fabsf(uv[j].x), fabsf(uv[j].y))), fmaxf(fabsf(uv[j].z), fabsf(uv[j].w))); }
#pragma unroll
                for (int o = 1; o < 64; o <<= 1) am = fmaxf(am, __shfl_xor(am, o));
                const float qs = am > 0.f ? 127.f / am : 0.f;
                if (F.lane == 0) SU[e] = am * (1.f / 127.f);
#pragma unroll
                for (int j = 0; j < 8; ++j) { const int c = (F.lane + 64 * j) * 4;
                    const unsigned q = ((unsigned)(int)rintf(uv[j].x * qs) & 0xffu) | (((unsigned)(int)rintf(uv[j].y * qs) & 0xffu) << 8) | (((unsigned)(int)rintf(uv[j].z * qs) & 0xffu) << 16) | (((unsigned)(int)rintf(uv[j].w * qs) & 0xffu) << 24);
                    *(unsigned*)(ws + WS_U8 + ((size_t)(c >> 7) * 16384 + e) * 128 + (c & 127)) = q; }
            }
        }
        {
            const float* vs = args.in[20]; unsigned char* V8 = ws + WS_V8; LAS unsigned char* tl = F.lds + RING_OFF;
            for (int t = F.vcu; t < 256 * 8; t += F.G) { const int e0 = (t >> 3) * 64, c0 = (t & 7) * 256;
                __syncthreads();
#pragma unroll
                for (int j = 0; j < 8; ++j) { const int idx = F.tid + 512 * j, r = idx >> 6, c = 4 * (idx & 63);
                    const f32x4 v = *(const f32x4*)(vs + (size_t)(e0 + r) * D + c0 + c);
                    *(LAS unsigned*)(tl + (c >> 3) * 512 + r * 8 + (c & 7)) = pk4_fp8(v.x, v.y, v.z, v.w); }
                __syncthreads();
#pragma unroll
                for (int j = 0; j < 2; ++j) { const int cu = (F.tid >> 5) + 16 * j, pc = F.tid & 31;
                    *(v4u*)(V8 + ((size_t)((c0 >> 3) + cu) * 16384 + e0) * 8 + pc * 16) = *(const LAS v4u*)(tl + cu * 512 + pc * 16); }
            }
            __syncthreads();
        }
    }
    GRID_BAR();
    if (RUN(9)) {
        pg8::Gemm g{H1, WQ_T, M, D, D}; pg8::StaticOrder S; S.init(M, D, F.G, (int)blockIdx.x);
        pg8::EpiF32 E{PQ, D, nullptr, 0.f};
        pg8::gemm_phase<pg8::EpiF32, pg8::StaticOrder, PG8_ALIGN, PG8_SP2>(F.lds + RING_OFF, g, S, E);
    }
    GRID_BAR();
    if (RUN(10)) {
        const int gw = F.vcu * NWAVES + F.wave, NGW = F.G * NWAVES, tl = F.lane & 31, hi = F.lane >> 5;
        LAS unsigned char* scr = F.lds + RING_OFF + F.wave * 1024 + tl * 32;
        const v4u* SKH = (const v4u*)(ws + WS_SKH); const v4u* SKL = (const v4u*)(ws + WS_SKL);
        int* E = (int*)(ws + WS_E); float* G = (float*)(ws + WS_G);
        for (int it = gw; it < (M / 32) * 8; it += NGW) { const int h = it & 7, tok = (it >> 3) * 32 + tl;
            float sa[16], sb[16];
            route_half(PQ + (size_t)tok * D + h * 256 + 8 * hi, SKH + (size_t)(h * 2) * 32 * 64, SKL + (size_t)(h * 2) * 32 * 64, F.lane, hi, sa);
            route_half(PQ + (size_t)tok * D + h * 256 + 128 + 8 * hi, SKH + (size_t)(h * 2 + 1) * 32 * 64, SKL + (size_t)(h * 2 + 1) * 32 * 64, F.lane, hi, sb);
            { unsigned w[4];
#pragma unroll
              for (int q = 0; q < 4; ++q) { w[q] = 0u;
#pragma unroll
                  for (int e = 0; e < 4; ++e) { const unsigned ka = 127u - (__float_as_uint(sa[4 * q + e]) & 127u), kb = 127u - (__float_as_uint(sb[4 * q + e]) & 127u); w[q] |= (hi ? kb : ka) << (8 * e); } }
              *(LAS v4u*)(scr + 16 * hi) = (v4u){w[0], w[1], w[2], w[3]}; }
            float cd[25];
#define CV_(i, j) __uint_as_float((__float_as_uint(sa[i] + sb[j]) & ~255u) | (255u - (unsigned)(16 * (i) + (j))))
            cd[0] = hi ? CV_(0, 1) : CV_(0, 0);
            cd[1] = hi ? CV_(0, 3) : CV_(0, 2);
            cd[2] = hi ? CV_(0, 5) : CV_(0, 4);
            cd[3] = hi ? CV_(0, 7) : CV_(0, 6);
            cd[4] = hi ? CV_(0, 9) : CV_(0, 8);
            cd[5] = hi ? CV_(0, 11) : CV_(0, 10);
            cd[6] = hi ? CV_(0, 13) : CV_(0, 12);
            cd[7] = hi ? CV_(0, 15) : CV_(0, 14);
            cd[8] = hi ? CV_(1, 1) : CV_(1, 0);
            cd[9] = hi ? CV_(1, 3) : CV_(1, 2);
            cd[10] = hi ? CV_(1, 5) : CV_(1, 4);
            cd[11] = hi ? CV_(1, 7) : CV_(1, 6);
            cd[12] = hi ? CV_(2, 1) : CV_(2, 0);
            cd[13] = hi ? CV_(2, 3) : CV_(2, 2);
            cd[14] = hi ? CV_(3, 0) : CV_(2, 4);
            cd[15] = hi ? CV_(3, 2) : CV_(3, 1);
            cd[16] = hi ? CV_(4, 0) : CV_(3, 3);
            cd[17] = hi ? CV_(4, 2) : CV_(4, 1);
            cd[18] = hi ? CV_(5, 1) : CV_(5, 0);
            cd[19] = hi ? CV_(6, 1) : CV_(6, 0);
            cd[20] = hi ? CV_(7, 1) : CV_(7, 0);
            cd[21] = hi ? CV_(9, 0) : CV_(8, 0);
            cd[22] = hi ? CV_(11, 0) : CV_(10, 0);
            cd[23] = hi ? CV_(13, 0) : CV_(12, 0);
            cd[24] = hi ? CV_(15, 0) : CV_(14, 0);
#undef CV_
            float top[16];
#pragma unroll
            for (int rd = 0; rd < 16; ++rd) {
                float m = cd[0];
#pragma unroll
                for (int n = 1; n + 1 < 25; n += 2) m = max3f_(m, cd[n], cd[n + 1]);
                const float gm = pair_max(m); top[rd] = gm;
#pragma unroll
                for (int n = 0; n < 25; ++n) cd[n] = (__float_as_uint(cd[n]) == __float_as_uint(gm)) ? -INFINITY : cd[n];
            }
            float ex[16], sum = 0.f;
#pragma unroll
            for (int r = 0; r < 16; ++r) { ex[r] = __builtin_amdgcn_exp2f((top[r] - top[0]) * LOG2E); sum += ex[r]; }
            const float inv = 1.f / sum;
            asm volatile("s_waitcnt lgkmcnt(0)" ::: "memory");
            int eo[8]; float go[8];
#pragma unroll
            for (int rr = 0; rr < 8; ++rr) { float t0 = top[rr], t1 = top[rr + 8], e0 = ex[rr], e1 = ex[rr + 8]; asm volatile("" : "+v"(t0), "+v"(t1), "+v"(e0), "+v"(e1));
                const unsigned f = 255u - (__float_as_uint(hi ? t1 : t0) & 255u);
                const int ia = scr[f >> 4], ib = scr[16 + (f & 15)]; eo[rr] = ia * 128 + ib; go[rr] = (hi ? e1 : e0) * inv; }
            int* ep = E + (size_t)tok * 128 + h * 16 + 8 * hi; float* gp = G + (size_t)tok * 128 + h * 16 + 8 * hi;
            *(v4u*)ep = (v4u){(unsigned)eo[0], (unsigned)eo[1], (unsigned)eo[2], (unsigned)eo[3]}; *(v4u*)(ep + 4) = (v4u){(unsigned)eo[4], (unsigned)eo[5], (unsigned)eo[6], (unsigned)eo[7]};
            *(f32x4*)gp = (f32x4){go[0], go[1], go[2], go[3]}; *(f32x4*)(gp + 4) = (f32x4){go[4], go[5], go[6], go[7]};
            asm volatile("s_waitcnt lgkmcnt(0)" ::: "memory");
        }
    }
    GRID_BAR();
    if (RUN(11)) {
        const int nlab = F.G < 8 ? F.G : 8, label = (int)blockIdx.x % nlab, nblk = (F.G - label + nlab - 1) / nlab, wx = ((int)blockIdx.x / nlab) * NWAVES + F.wave, nwx = nblk * NWAVES;
        const int lane = F.lane, rr = lane >> 3, cc = lane & 7;
        const int* E = (const int*)(ws + WS_E);
        for (int sl = label; sl < 16; sl += nlab) {
            const unsigned char* Us = ws + WS_U8 + (size_t)sl * 16384 * 128 + 16 * cc;
            const unsigned char* Hs = ws + WS_H8 + (size_t)sl * M * 128 + 16 * cc;
            int* Ps = (int*)(ws + WS_PART) + (size_t)sl * M * 128;
            for (int item = wx; item < M / 8; item += nwx) { const int tok = item * 8 + rr;
                const v4u hq = *(const v4u*)(Hs + (size_t)tok * 128);
                const v4u* ep = (const v4u*)(E + (size_t)tok * 128);
                int res[16];
#pragma unroll
                for (int i = 0; i < 16; ++i) res[i] = 0;
#pragma unroll
                for (int i = 0; i < 16; ++i) {
                    const v4u e0 = ep[2 * i], e1 = ep[2 * i + 1];
#pragma unroll
                    for (int j = 0; j < 8; ++j) { const unsigned e = j < 4 ? e0[j & 3] : e1[j & 3];
                        const v4u a = *(const v4u*)(Us + (size_t)e * 128);
                        int d = __builtin_amdgcn_sdot4((int)a.x, (int)hq.x, 0, false); d = __builtin_amdgcn_sdot4((int)a.y, (int)hq.y, d, false); d = __builtin_amdgcn_sdot4((int)a.z, (int)hq.z, d, false); d = __builtin_amdgcn_sdot4((int)a.w, (int)hq.w, d, false);
                        d += __builtin_amdgcn_update_dpp(0, d, 0xB1, 0xf, 0xf, true); d += __builtin_amdgcn_update_dpp(0, d, 0x4E, 0xf, 0xf, true); d += __builtin_amdgcn_update_dpp(0, d, 0x141, 0xf, 0xf, true);
                        res[i] = (cc == j) ? d : res[i]; } }
                v4u* po = (v4u*)(Ps + (size_t)tok * 128 + cc * 16);
#pragma unroll
                for (int q = 0; q < 4; ++q) po[q] = (v4u){(unsigned)res[4 * q], (unsigned)res[4 * q + 1], (unsigned)res[4 * q + 2], (unsigned)res[4 * q + 3]};
            }
        }
    }
    GRID_BAR();
    if (RUN(12)) {
        const int* P = (const int*)(ws + WS_PART); const int* E = (const int*)(ws + WS_E); const float* G = (const float*)(ws + WS_G); unsigned* PK = (unsigned*)(ws + WS_PK);
        const float* SU = (const float*)(ws + WS_SU); const float* SH = (const float*)(ws + WS_SH);
        for (int idx = F.vcu * 512 + F.tid; idx < M * 128; idx += F.G * 512) { const int tok = idx >> 7, k = idx & 127; const size_t pi = (size_t)tok * 128 + (k & 7) * 16 + (k >> 3); int hsum = 0;
#pragma unroll
            for (int sl = 0; sl < 16; ++sl) hsum += P[(size_t)sl * M * 128 + pi];
            const int e = E[idx];
            const float w = G[idx] * gelu_tanh((float)hsum * SU[e] * SH[tok]);
            PK[(size_t)(tok >> 6) * 8192 + (k >> 2) * 256 + (tok & 63) * 4 + (k & 3)] = (unsigned)e | (f2bf(w) << 16); }
    }
    GRID_BAR();
    if (RUN(13)) {
        const unsigned* PK = (const unsigned*)(ws + WS_PK); bf16* FFN = (bf16*)(ws + WS_FFN);
        for (int c = F.vcu; c < 256; c += F.G) {
            __syncthreads();
            { const v4u* src = (const v4u*)(ws + WS_V8 + (size_t)c * 131072);
#pragma unroll 4
              for (int j = 0; j < 16; ++j) *(LAS v4u*)(F.lds + RING_OFF + (F.tid + 512 * j) * 16) = src[F.tid + 512 * j]; }
            __syncthreads();
            for (int tb = F.wave; tb < M / 64; tb += NWAVES) {
                const v4u* pk = (const v4u*)(PK + (size_t)tb * 8192) + F.lane;
                f32x2v av[4];
#pragma unroll
                for (int i = 0; i < 4; ++i) av[i] = (f32x2v){0.f, 0.f};
                v4u pb[32];
#pragma unroll
                for (int kq = 0; kq < 32; ++kq) pb[kq] = pk[kq * 64];
#pragma unroll
                for (int kq = 0; kq < 32; ++kq) { const v4u p4 = pb[kq];
#pragma unroll
                    for (int j = 0; j < 4; ++j) { const unsigned p = p4[j]; const float w = __uint_as_float(p & 0xffff0000u); const f32x2v ww = (f32x2v){w, w};
                        const unsigned long long d = *(const LAS unsigned long long*)(F.lds + RING_OFF + ((p & 0xffffu) << 3));
                        const int d0 = (int)(unsigned)d, d1 = (int)(unsigned)(d >> 32);
                        av[0] = av[0] + __builtin_amdgcn_cvt_pk_f32_fp8(d0, false) * ww; av[1] = av[1] + __builtin_amdgcn_cvt_pk_f32_fp8(d0, true) * ww;
                        av[2] = av[2] + __builtin_amdgcn_cvt_pk_f32_fp8(d1, false) * ww; av[3] = av[3] + __builtin_amdgcn_cvt_pk_f32_fp8(d1, true) * ww; } }
                *(v4u*)(FFN + (size_t)(tb * 64 + F.lane) * D + 8 * c) = (v4u){pk2(av[0].x, av[0].y), pk2(av[1].x, av[1].y), pk2(av[2].x, av[2].y), pk2(av[3].x, av[3].y)};
            }
        }
        __syncthreads();
    }
    GRID_BAR();
    if (RUN(14)) {
        const int gw = F.vcu * NWAVES + F.wave, NGW = F.G * NWAVES, lane = F.lane; const float* g2 = args.in[21]; const float* b2 = args.in[22]; float* out = args.out; const bf16* FFN = (const bf16*)(ws + WS_FFN);
        for (int row = gw; row < M; row += NGW) {
            f32x4 v[8]; float sm = 0.f;
#pragma unroll
            for (int j = 0; j < 8; ++j) { const int c = (lane + 64 * j) * 4; const unsigned long long hq = *(const unsigned long long*)(H1 + (size_t)row * D + c), fq = *(const unsigned long long*)(FFN + (size_t)row * D + c);
                const unsigned h0 = (unsigned)hq, h1_ = (unsigned)(hq >> 32), f0 = (unsigned)fq, f1 = (unsigned)(fq >> 32);
                v[j].x = DN_ALPHA * __uint_as_float(h0 << 16) + __uint_as_float(f0 << 16); v[j].y = DN_ALPHA * __uint_as_float(h0 & 0xffff0000u) + __uint_as_float(f0 & 0xffff0000u);
                v[j].z = DN_ALPHA * __uint_as_float(h1_ << 16) + __uint_as_float(f1 << 16); v[j].w = DN_ALPHA * __uint_as_float(h1_ & 0xffff0000u) + __uint_as_float(f1 & 0xffff0000u);
                sm += (v[j].x + v[j].y) + (v[j].z + v[j].w); }
#pragma unroll
            for (int o = 1; o < 64; o <<= 1) sm += __shfl_xor(sm, o);
            const float mean = sm * (1.f / D); float s2 = 0.f;
#pragma unroll
            for (int j = 0; j < 8; ++j) { v[j] = v[j] - mean; s2 += (v[j].x * v[j].x + v[j].y * v[j].y) + (v[j].z * v[j].z + v[j].w * v[j].w); }
#pragma unroll
            for (int o = 1; o < 64; o <<= 1) s2 += __shfl_xor(s2, o);
            const float rstd = rsqrtf(s2 * (1.f / D) + LN_EPS);
#pragma unroll
            for (int j = 0; j < 8; ++j) { const int c = (lane + 64 * j) * 4; *(f32x4*)(out + (size_t)row * D + c) = v[j] * rstd * *(const f32x4*)(g2 + c) + *(const f32x4*)(b2 + c); }
        }
    }
#undef IN
#undef RUN
#undef GRID_BAR
}

extern "C" void kernel_launch(void* const* d_in, const int* in_sizes, int n_in, void* d_out, int out_size, void* d_ws, size_t ws_size, hipStream_t stream) {
    static int grid = 0;
    if (grid == 0) {
        if (n_in != 23 || in_sizes[0] != M * D || out_size != M * D || ws_size < WS_END) { fprintf(stderr, "kernel_launch: unexpected shapes n_in %d in0 %d out %d ws %zu\n", n_in, n_in > 0 ? in_sizes[0] : -1, out_size, ws_size); grid = -1; return; }
        int dev = 0, cus = 0;
        if (hipGetDevice(&dev) != hipSuccess || hipDeviceGetAttribute(&cus, hipDeviceAttributeMultiprocessorCount, dev) != hipSuccess) { grid = -1; return; }
        if (hipFuncSetAttribute((const void*)skel_fwd, hipFuncAttributeMaxDynamicSharedMemorySize, LDS_BYTES) != hipSuccess) { grid = -1; return; }
        grid = cus;
    }
    if (grid < 0) return;
    (void)hipMemsetAsync((char*)d_ws + WS_CTL, 0, CTL_ZERO_BYTES, stream);
    Args a{};
    for (int i = 0; i < 23; ++i) a.in[i] = (const float*)d_in[i];
    a.out = (float*)d_out; a.ws = (unsigned char*)d_ws;
    unsigned char* ws = (unsigned char*)d_ws;
    const float* const* in = (const float* const*)d_in;
    float* prm = (float*)(ws + WS_PRM);
    bf16 *Q = (bf16*)(ws + WS_Q), *K = (bf16*)(ws + WS_K), *V = (bf16*)(ws + WS_V), *XR = (bf16*)(ws + WS_XR), *XG = (bf16*)(ws + WS_XG), *MIX = (bf16*)(ws + WS_MIX), *H1 = (bf16*)(ws + WS_H1);
    float *LA = (float*)(ws + WS_LA), *LB = (float*)(ws + WS_LB), *Y1 = (float*)(ws + WS_Y1), *PQ = (float*)(ws + WS_PQ), *G = (float*)(ws + WS_G); int* E = (int*)(ws + WS_E);
#ifndef MK_MULTI
    a.ph_lo = -1; a.ph_hi = 0; hipLaunchKernelGGL(skel_fwd, dim3(grid), dim3(NWAVES * 64), LDS_BYTES, stream, a);
#else
    for (int sl = 0; sl < 15; ++sl) { a.ph_lo = 1 << sl; a.ph_hi = 0; hipLaunchKernelGGL(skel_fwd, dim3(grid), dim3(NWAVES * 64), LDS_BYTES, stream, a); }
#endif
}
```

```cpp
#include <hip/hip_runtime.h>
#include <cstdio>
#include <cstdint>
namespace pg8 {
#define PG8_LAS __attribute__((address_space(3)))
typedef unsigned short bf16_t;
typedef short bf16x8 __attribute__((ext_vector_type(8)));
typedef float f32x4 __attribute__((ext_vector_type(4)));
typedef unsigned u32x4 __attribute__((ext_vector_type(4)));
constexpr int BM = 256, BK = 64, HALF = 128, HTB = HALF * BK * 2  , STAGE_BYTES = 8 * HTB, NXCD = 8, WGM = 8;

__host__ __device__ __forceinline__ int lds_byte(int r, int c) { const int st = (r >> 4) * 2 + (c >> 5), rr = r & 15, cc = c & 31, ob = rr * 64 + cc * 2; return st * 1024 + (ob ^ (((ob >> 9) & 1) << 5)); }
__host__ __device__ __forceinline__ void stage_rc(int b, int& R, int& C) { const int st = b / 1024, sb = b % 1024, swz = sb ^ (((sb >> 9) & 1) << 5); R = (st >> 1) * 16 + swz / 64; C = (st & 1) * 32 + (swz % 64) / 2; }
__host__ __device__ __forceinline__ int perm32(int rho) { const int n = rho >> 4, i = rho & 15; return 8 * (i >> 2) + 4 * n + (i & 3); }

struct Unit { int pm, pn; };
struct Gemm { const bf16_t* A; const bf16_t* Bt; int M, N, K; };

struct StaticOrder {
    int nM, nN, nwg, G, c;
    __host__ __device__ void init(int M, int N, int G_, int c_) { nM = M / BM; nN = N / BM; nwg = nM * nN; G = G_; c = c_; }
    __host__ __device__ bool next(int i, Unit& u) const {
        const long L = (long)i * G + c; if (L >= nwg) return false;
        int wgid = (int)L; { const int q = nwg / NXCD, r = nwg % NXCD, xcd = wgid % NXCD, off = wgid / NXCD; wgid = (xcd < r ? xcd * (q + 1) : r * (q + 1) + (xcd - r) * q) + off; }
        const int nig = WGM * nN, gid = wgid / nig, fm = gid * WGM, gsz = (nM - fm) < WGM ? (nM - fm) : WGM;
        u.pm = fm + ((wgid % nig) % gsz); u.pn = (wgid % nig) / gsz; return true;
    }
    __device__ __forceinline__ void a_ready(const Unit&) const {}
    __device__ __forceinline__ void done(const Unit&) const {}
};

__device__ __forceinline__ unsigned cvt_pk_bf16(float lo, float hi) { unsigned r; asm volatile("v_cvt_pk_bf16_f32 %0, %1, %2" : "=v"(r) : "v"(lo), "v"(hi)); return r; }
typedef float f32x2 __attribute__((ext_vector_type(2)));
__device__ __forceinline__ f32x2 gelu_pk(f32x2 v) {
    const f32x2 av = __builtin_elementwise_abs(v), d = av * 0.2316418882f + 1.0f;
    f32x2 t; t.x = __builtin_amdgcn_rcpf(d.x); t.y = __builtin_amdgcn_rcpf(d.y);
    f32x2 q = t * 0.5307027145f + (-0.7265760135f); q = q * t + 0.7107068705f; q = q * t + (-0.142248368f); q = q * t + 0.127414796f; q = q * t;
    const f32x2 s = (v * v) * (-0.72134752044f);
    f32x2 e; e.x = __builtin_amdgcn_exp2f(s.x); e.y = __builtin_amdgcn_exp2f(s.y);
    const f32x2 m = v * (q * e), r = v - m;
    f32x2 o; o.x = v.x < 0.f ? m.x : r.x; o.y = v.y < 0.f ? m.y : r.y; return o;
}

template <int ACT  > struct EpiBf16 {
    static constexpr bool PERM = true, AFTER_DRAIN = false; static_assert(ACT == 0 || ACT == 1, "EpiBf16: ACT is 0 (none) or 1 (gelu_pk)");
    bf16_t* O; int ldc; const float* bias; int split_cols; size_t split_stride; float scale0;
    __device__ __forceinline__ void operator()(const f32x4 (&acc)[2][2][4][2], const Unit& u, int wr, int wc, int fr, int fq) const {
        const int row0 = u.pm * BM + wr * 64 + fr; int colt = u.pn * BM; bf16_t* base = O;
        float sc = 1.f; if (split_cols) { const int t = colt / split_cols; base += (size_t)t * split_stride; colt -= t * split_cols; if (t == 0) sc = scale0; }
        const int col0 = colt + wc * 32 + 8 * fq, bcol0 = u.pn * BM + wc * 32 + 8 * fq;
        f32x4 bv[2][2];
#pragma unroll
        for (int bj = 0; bj < 2; ++bj)
#pragma unroll
            for (int n = 0; n < 2; ++n) bv[bj][n] = bias ? *(const f32x4*)(bias + bcol0 + bj * HALF + 4 * n) : (f32x4){0.f, 0.f, 0.f, 0.f};
#pragma unroll
        for (int ai = 0; ai < 2; ++ai)
#pragma unroll
            for (int m = 0; m < 4; ++m) { bf16_t* rowp = base + (size_t)(row0 + ai * HALF + m * 16) * ldc + col0;
#pragma unroll
                for (int bj = 0; bj < 2; ++bj) { f32x4 v0 = acc[ai][bj][m][0] + bv[bj][0], v1 = acc[ai][bj][m][1] + bv[bj][1];
                    if (ACT == 1) { f32x2 a = gelu_pk((f32x2){v0[0], v0[1]}), b = gelu_pk((f32x2){v0[2], v0[3]}), c = gelu_pk((f32x2){v1[0], v1[1]}), d = gelu_pk((f32x2){v1[2], v1[3]});
                        v0 = (f32x4){a.x, a.y, b.x, b.y}; v1 = (f32x4){c.x, c.y, d.x, d.y}; }
                    v0 = v0 * sc; v1 = v1 * sc; u32x4 w; w.x = cvt_pk_bf16(v0[0], v0[1]); w.y = cvt_pk_bf16(v0[2], v0[3]); w.z = cvt_pk_bf16(v1[0], v1[1]); w.w = cvt_pk_bf16(v1[2], v1[3]);
                    *(u32x4*)(rowp + bj * HALF) = w; } }
    }
};

struct PanelStats {
    unsigned* xbuf;
    unsigned* cnt;
    unsigned* tmo;
    int ntn; float eps;
    unsigned code;
    __device__ __forceinline__ bool run(const f32x4 (&v)[2][2][4][2], const Unit& u, int wr, int wc, int fr, int fq, PG8_LAS unsigned char* lds, int wid, int lane) const {
        typedef float f32x2v __attribute__((ext_vector_type(2)));
        PG8_LAS f32x2v* P = (PG8_LAS f32x2v*)lds;
        PG8_LAS f32x2v* S = (PG8_LAS f32x2v*)(lds + 8192);
        PG8_LAS unsigned* flag = (PG8_LAS unsigned*)(lds + 8192 + 2048);
#pragma unroll
        for (int ai = 0; ai < 2; ++ai)
#pragma unroll
            for (int m = 0; m < 4; ++m) {
                float s = 0.f;
#pragma unroll
                for (int bj = 0; bj < 2; ++bj)
#pragma unroll
                    for (int n = 0; n < 2; ++n) { const f32x4 x = v[ai][bj][m][n]; s += (x[0] + x[1]) + (x[2] + x[3]); }
                s += __shfl_xor(s, 16); s += __shfl_xor(s, 32);
                const float mw = s * (1.0f / 64.0f); float q = 0.f;
#pragma unroll
                for (int bj = 0; bj < 2; ++bj)
#pragma unroll
                    for (int n = 0; n < 2; ++n) { const f32x4 d = v[ai][bj][m][n] - mw; q += (d[0] * d[0] + d[1] * d[1]) + (d[2] * d[2] + d[3] * d[3]); }
                q += __shfl_xor(q, 16); q += __shfl_xor(q, 32);
                if (fq == 0) P[(ai * HALF + wr * 64 + m * 16 + fr) * 4 + wc] = (f32x2v){mw, q};
            }
        asm volatile("s_waitcnt lgkmcnt(0)" ::: "memory"); __builtin_amdgcn_s_barrier(); asm volatile("" ::: "memory");
#if defined(BROKEN_EXCHANGE_NO_WAIT)
#warning BROKEN CONTROL BUILD: the row-statistics exchange does not wait; results are wrong by design
        if (blockIdx.x >= 64) { const long long t0_ = clock64(); while (clock64() - t0_ < 60000) __builtin_amdgcn_s_sleep(8); }
#endif
        const int row = wid * 32 + (lane & 31);
        if (lane < 32) {
            const f32x2v a = P[row * 4 + 0], b = P[row * 4 + 1], c = P[row * 4 + 2], d = P[row * 4 + 3];
            const float mt = (a.x + b.x + c.x + d.x) * 0.25f;
            const float da = a.x - mt, db = b.x - mt, dc = c.x - mt, dd = d.x - mt;
            const float m2 = (a.y + b.y) + (c.y + d.y) + 64.0f * ((da * da + db * db) + (dc * dc + dd * dd));
            unsigned long long* slot = (unsigned long long*)xbuf + ((size_t)(u.pm * BM + row) * 4 + u.pn);
            __hip_atomic_store(slot, ((unsigned long long)__float_as_uint(m2) << 32) | __float_as_uint(mt), __ATOMIC_RELAXED, __HIP_MEMORY_SCOPE_AGENT);
        }
        asm volatile("s_waitcnt vmcnt(0)" ::: "memory");
        if (lane == 0) __hip_atomic_fetch_add(cnt + 64 * u.pm, 1u, __ATOMIC_RELAXED, __HIP_MEMORY_SCOPE_AGENT);
        if (wid == 0) {
            bool dead = false; const unsigned long long t0 = __builtin_amdgcn_s_memrealtime(); const unsigned want = 8u * (unsigned)ntn;
            for (;;) {
#if defined(BROKEN_EXCHANGE_NO_WAIT)
                break;
#endif
                if ((unsigned)__builtin_amdgcn_readfirstlane(__hip_atomic_load(cnt + 64 * u.pm, __ATOMIC_RELAXED, __HIP_MEMORY_SCOPE_AGENT)) >= want) break;
                if (__builtin_amdgcn_s_memrealtime() - t0 > 2000000ull) {
                    if (lane == 0) { unsigned expect = 0u; __hip_atomic_compare_exchange_strong(tmo + 1, &expect, code | (unsigned)(u.pm & 0xff), __ATOMIC_RELAXED, __ATOMIC_RELAXED, __HIP_MEMORY_SCOPE_AGENT);
                                     __hip_atomic_store(tmo, 1u, __ATOMIC_RELAXED, __HIP_MEMORY_SCOPE_AGENT); }
                    dead = true; break; }
                __builtin_amdgcn_s_sleep(2);
            }
            __builtin_amdgcn_fence(__ATOMIC_ACQUIRE, "agent");
            if (lane == 0) flag[0] = dead ? 1u : 0u;
        }
        asm volatile("s_waitcnt vmcnt(0) lgkmcnt(0)" ::: "memory"); __builtin_amdgcn_s_barrier(); asm volatile("" ::: "memory");
        const bool bad = flag[0] != 0u;
        if (lane < 32) {
            const unsigned long long* slot = (const unsigned long long*)xbuf + (size_t)(u.pm * BM + row) * 4; float mt[4], m2[4]; float ms = 0.f;
#pragma unroll
            for (int t = 0; t < 4; ++t) { if (t < ntn) { const unsigned long long w = __hip_atomic_load(slot + t, __ATOMIC_RELAXED, __HIP_MEMORY_SCOPE_AGENT); mt[t] = __uint_as_float((unsigned)w); m2[t] = __uint_as_float((unsigned)(w >> 32)); } else { mt[t] = 0.f; m2[t] = 0.f; } ms += mt[t]; }
            const float mean = ms / (float)ntn; float q = 0.f;
#pragma unroll
            for (int t = 0; t < 4; ++t) if (t < ntn) { const float dm = mt[t] - mean; q += m2[t] + 256.0f * dm * dm; }
            S[row] = (f32x2v){mean, 1.0f / sqrtf(q / (256.0f * (float)ntn) + eps)};
        }
        asm volatile("s_waitcnt lgkmcnt(0)" ::: "memory"); __builtin_amdgcn_s_barrier(); asm volatile("" ::: "memory");
        return bad;
    }
};
struct EpiLnRes {
    static constexpr bool PERM = false, AFTER_DRAIN = true;
    const float* base; float* out; int ldc; const float* bias; PanelStats st; unsigned poison;
    __device__ __forceinline__ void fused(f32x4 (&acc)[2][2][4][2], const Unit& u, int wr, int wc, int fr, int fq, PG8_LAS unsigned char* lds, int wid, int lane) const {
        typedef float f32x2v __attribute__((ext_vector_type(2)));
        const PG8_LAS f32x2v* S = (const PG8_LAS f32x2v*)(lds + 8192);
        const int col0 = u.pn * BM + wc * 32 + 4 * fq;
#pragma unroll
        for (int bj = 0; bj < 2; ++bj)
#pragma unroll
            for (int n = 0; n < 2; ++n) { const f32x4 bv = bias ? *(const f32x4*)(bias + col0 + bj * HALF + n * 16) : (f32x4){0.f, 0.f, 0.f, 0.f};
#pragma unroll
                for (int ai = 0; ai < 2; ++ai)
#pragma unroll
                    for (int m = 0; m < 4; ++m) acc[ai][bj][m][n] += bv; }
        f32x4 pre[4][2][2];
#pragma unroll
        for (int m = 0; m < 4; ++m) { const size_t off = (size_t)(u.pm * BM + wr * 64 + m * 16 + fr) * ldc + col0;
#pragma unroll
            for (int bj = 0; bj < 2; ++bj)
#pragma unroll
                for (int n = 0; n < 2; ++n) pre[m][bj][n] = *(const f32x4*)(base + off + bj * HALF + n * 16); }
        const bool bad = st.run(acc, u, wr, wc, fr, fq, lds, wid, lane) || poison != 0u;
        const float qnan = __builtin_nanf("");
#pragma unroll
        for (int ai = 0; ai < 2; ++ai)
#pragma unroll
            for (int m = 0; m < 4; ++m) { const int r = ai * HALF + wr * 64 + m * 16 + fr; const f32x2v sr = S[r]; const size_t off = (size_t)(u.pm * BM + r) * ldc + col0;
#pragma unroll
                for (int bj = 0; bj < 2; ++bj)
#pragma unroll
                    for (int n = 0; n < 2; ++n) { const f32x4 bs = ai == 0 ? pre[m][bj][n] : *(const f32x4*)(base + off + bj * HALF + n * 16); f32x4 o = bs + (acc[ai][bj][m][n] - sr.x) * sr.y;
                        if (bad) o = (f32x4){qnan, qnan, qnan, qnan}; *(f32x4*)(out + off + bj * HALF + n * 16) = o; }
                if (m & 1) asm volatile("" ::: "memory"); }
    }
};
struct EpiLnResLn {
    static constexpr bool PERM = false, AFTER_DRAIN = true;
    const float* base; float* out; bf16_t* xn; int ldc; const float* bias; PanelStats st1, st2; unsigned poison;
    __device__ __forceinline__ void fused(f32x4 (&acc)[2][2][4][2], const Unit& u, int wr, int wc, int fr, int fq, PG8_LAS unsigned char* lds, int wid, int lane) const {
        typedef float f32x2v __attribute__((ext_vector_type(2))); typedef unsigned u32x2v __attribute__((ext_vector_type(2)));
        const PG8_LAS f32x2v* S = (const PG8_LAS f32x2v*)(lds + 8192);
        const int col0 = u.pn * BM + wc * 32 + 4 * fq;
#pragma unroll
        for (int bj = 0; bj < 2; ++bj)
#pragma unroll
            for (int n = 0; n < 2; ++n) { const f32x4 bv = bias ? *(const f32x4*)(bias + col0 + bj * HALF + n * 16) : (f32x4){0.f, 0.f, 0.f, 0.f};
#pragma unroll
                for (int ai = 0; ai < 2; ++ai)
#pragma unroll
                    for (int m = 0; m < 4; ++m) acc[ai][bj][m][n] += bv; }
        bool bad = st1.run(acc, u, wr, wc, fr, fq, lds, wid, lane) || poison != 0u;
        const float qnan = __builtin_nanf("");
#pragma unroll
        for (int ai = 0; ai < 2; ++ai)
#pragma unroll
            for (int m = 0; m < 4; ++m) { const int r = ai * HALF + wr * 64 + m * 16 + fr; const f32x2v sr = S[r]; const size_t off = (size_t)(u.pm * BM + r) * ldc + col0;
#pragma unroll
                for (int bj = 0; bj < 2; ++bj)
#pragma unroll
                    for (int n = 0; n < 2; ++n) { const f32x4 bs = *(const f32x4*)(base + off + bj * HALF + n * 16); acc[ai][bj][m][n] = bs + (acc[ai][bj][m][n] - sr.x) * sr.y; }
                asm volatile("" : "+v"(acc[ai][0][m][0]), "+v"(acc[ai][0][m][1]), "+v"(acc[ai][1][m][0]), "+v"(acc[ai][1][m][1]));
                if (m & 1) asm volatile("" ::: "memory"); }
        const bool bad1 = bad;
        bad = st2.run(acc, u, wr, wc, fr, fq, lds, wid, lane) || bad;
#pragma unroll
        for (int ai = 0; ai < 2; ++ai)
#pragma unroll
            for (int m = 0; m < 4; ++m) { const int r = ai * HALF + wr * 64 + m * 16 + fr; const f32x2v sr = S[r]; const size_t off = (size_t)(u.pm * BM + r) * ldc + col0;
#pragma unroll
                for (int bj = 0; bj < 2; ++bj)
#pragma unroll
                    for (int n = 0; n < 2; ++n) { const f32x4 x1 = acc[ai][bj][m][n]; *(f32x4*)(out + off + bj * HALF + n * 16) = bad1 ? (f32x4){qnan, qnan, qnan, qnan} : x1;
                        const f32x4 o = (x1 - sr.x) * sr.y; u32x2v w; w.x = cvt_pk_bf16(o[0], o[1]); w.y = cvt_pk_bf16(o[2], o[3]);
                        if (bad) { w.x = 0x7fc07fc0u; w.y = 0x7fc07fc0u; } *(u32x2v*)(xn + off + bj * HALF + n * 16) = w; }
                asm volatile("" ::: "memory"); }
    }
};

template <class Epi, class Sched, bool ALIGN_EPI = false, bool SP2 = false>
__device__ __forceinline__ void gemm_phase(PG8_LAS unsigned char* lds, const Gemm g, const Sched& S, const Epi& E) {
    const int tid = threadIdx.x, wid = __builtin_amdgcn_readfirstlane(tid >> 6), lane = tid & 63, wr = wid >> 2, wc = wid & 3, fr = lane & 15, fq = lane >> 4;
    const int K = g.K, nt = K / BK;
    unsigned voffA[2], voffB[2];
#pragma unroll
    for (int i = 0; i < 2; ++i) { int R, C; stage_rc(tid * 16 + i * 8192, R, C); const int Rb = Epi::PERM ? ((R & ~31) + perm32(R & 31)) : R;
        voffA[i] = (unsigned)(R * K + C) * 2u; voffB[i] = (unsigned)(Rb * K + C) * 2u; }
    const size_t kstep = (size_t)(BK * 2);
    const size_t hstep = (size_t)HALF * K * 2;
    const size_t tstep = 2 * hstep;
    const unsigned ldsw = (unsigned)wid * 1024u;
    const int aoff = lds_byte(wr * 64 + fr, fq * 8), boff = lds_byte(wc * 32 + fr, fq * 8);
#define PG8_SA(b, h) (((b) * 2 + (h)) * HTB)
#define PG8_SB(b, h) ((4 + (b) * 2 + (h)) * HTB)
#define PG8_STAGE(bufoff, gbase, voff) do { _Pragma("unroll") for (int _i = 0; _i < 2; ++_i) \
        __builtin_amdgcn_global_load_lds((const unsigned*)((const char*)(gbase) + (voff)[_i]), (PG8_LAS unsigned*)(lds + (bufoff) + ldsw + _i * 8192), 16, 0, 0); } while (0)
#define PG8_LDA(dst, b, h) do { _Pragma("unroll") for (int m = 0; m < 4; ++m) _Pragma("unroll") for (int k = 0; k < 2; ++k) dst[m][k] = *(const PG8_LAS bf16x8*)(lds + PG8_SA(b, h) + aoff + m * 2048 + k * 1024); } while (0)
#define PG8_LDB(dst, b, h) do { _Pragma("unroll") for (int n = 0; n < 2; ++n) _Pragma("unroll") for (int k = 0; k < 2; ++k) dst[n][k] = *(const PG8_LAS bf16x8*)(lds + PG8_SB(b, h) + boff + n * 2048 + k * 1024); } while (0)
#define PG8_MMA(ai, bj, At, Bt) do { __builtin_amdgcn_s_setprio(1); _Pragma("unroll") for (int m = 0; m < 4; ++m) _Pragma("unroll") for (int n = 0; n < 2; ++n) _Pragma("unroll") for (int k = 0; k < 2; ++k) \
        acc[ai][bj][m][n] = __builtin_amdgcn_mfma_f32_16x16x32_bf16(Bt[n][k], At[m][k], acc[ai][bj][m][n], 0, 0, 0); __builtin_amdgcn_s_setprio(0); } while (0)
#define PG8_WAIT_V(n) asm volatile("s_waitcnt vmcnt(" #n ")" ::: "memory")
#define PG8_WAIT_L(n) asm volatile("s_waitcnt lgkmcnt(" #n ")" ::: "memory")
#define PG8_BAR __builtin_amdgcn_s_barrier()
#define PG8_SCHED __builtin_amdgcn_sched_barrier(0)
    Unit cur, nxt; int ui = 0;
    if (!S.next(0, cur)) return;
    f32x4 acc[2][2][4][2];
#pragma unroll
    for (int a = 0; a < 2; ++a)
#pragma unroll
        for (int b = 0; b < 2; ++b)
#pragma unroll
            for (int m = 0; m < 4; ++m)
#pragma unroll
                for (int n = 0; n < 2; ++n) acc[a][b][m][n] = (f32x4){0.f, 0.f, 0.f, 0.f};
    bf16x8 At[4][2], B0[2][2], B1[2][2];
    const char* cA = (const char*)g.A + (size_t)cur.pm * tstep; const char* cB = (const char*)g.Bt + (size_t)cur.pn * tstep;
    S.a_ready(cur);
    if constexpr (SP2) {
        PG8_STAGE(PG8_SB(0, 0), cB, voffB); PG8_STAGE(PG8_SB(0, 1), cB + hstep, voffB); PG8_STAGE(PG8_SA(0, 0), cA, voffA); PG8_STAGE(PG8_SA(0, 1), cA + hstep, voffA);
        if (wr == 1) PG8_BAR;
        PG8_WAIT_V(2); PG8_BAR;
        PG8_STAGE(PG8_SB(1, 0), cB + kstep, voffB); PG8_STAGE(PG8_SA(1, 0), cA + kstep, voffA); PG8_STAGE(PG8_SB(1, 1), cB + hstep + kstep, voffB);
        PG8_WAIT_V(6); PG8_BAR;
    } else {
        PG8_STAGE(PG8_SB(0, 0), cB, voffB); PG8_STAGE(PG8_SA(0, 0), cA, voffA); PG8_STAGE(PG8_SB(0, 1), cB + hstep, voffB); PG8_STAGE(PG8_SA(0, 1), cA + hstep, voffA);
        if (wr == 1) PG8_BAR;
        PG8_WAIT_V(4); PG8_BAR;
        PG8_STAGE(PG8_SB(1, 0), cB + kstep, voffB); PG8_STAGE(PG8_SA(1, 0), cA + kstep, voffA); PG8_STAGE(PG8_SB(1, 1), cB + hstep + kstep, voffB);
        PG8_WAIT_V(6); PG8_BAR;
    }
    for (;;) {
        const bool has_next = S.next(ui + 1, nxt);
        const char* nA = has_next ? (const char*)g.A + (size_t)nxt.pm * tstep : cA; const char* nB = has_next ? (const char*)g.Bt + (size_t)nxt.pn * tstep : cB;
        for (int t = 0; t < nt; t += 2) {
            const bool last = (t == nt - 2);
            const char* a1 = cA + (size_t)(t + 1) * kstep;
            const char* a2 = last ? nA : cA + (size_t)(t + 2) * kstep; const char* b2 = last ? nB : cB + (size_t)(t + 2) * kstep;
            const char* a3 = a2 + kstep; const char* b3 = b2 + kstep;
            if (last && has_next) S.a_ready(nxt);
            if constexpr (SP2) {
            PG8_LDB(B0, 0, 0); PG8_LDB(B1, 0, 1); PG8_SCHED; PG8_LDA(At, 0, 0); PG8_STAGE(PG8_SA(1, 1), a1 + hstep, voffA);
            PG8_WAIT_V(8); PG8_WAIT_L(0); PG8_BAR; PG8_MMA(0, 0, At, B0); PG8_MMA(0, 1, At, B1); PG8_BAR; PG8_SCHED;
            PG8_LDA(At, 0, 1); PG8_STAGE(PG8_SB(0, 0), b2, voffB); PG8_STAGE(PG8_SB(0, 1), b2 + hstep, voffB); PG8_STAGE(PG8_SA(0, 0), a2, voffA);
            PG8_WAIT_V(8); PG8_WAIT_L(0); PG8_BAR; PG8_MMA(1, 0, At, B0); PG8_MMA(1, 1, At, B1); PG8_BAR; PG8_SCHED;
            PG8_LDB(B0, 1, 0); PG8_LDB(B1, 1, 1); PG8_SCHED; PG8_LDA(At, 1, 0); PG8_STAGE(PG8_SA(0, 1), a2 + hstep, voffA);
            PG8_WAIT_V(8); PG8_WAIT_L(0); PG8_BAR; PG8_MMA(0, 0, At, B0); PG8_MMA(0, 1, At, B1); PG8_BAR; PG8_SCHED;
            PG8_LDA(At, 1, 1); PG8_STAGE(PG8_SB(1, 0), b3, voffB); PG8_STAGE(PG8_SB(1, 1), b3 + hstep, voffB); PG8_STAGE(PG8_SA(1, 0), a3, voffA);
            PG8_WAIT_V(8); PG8_WAIT_L(0); PG8_BAR; PG8_MMA(1, 0, At, B0); PG8_MMA(1, 1, At, B1); PG8_BAR; PG8_SCHED;
            } else {
            PG8_LDB(B0, 0, 0); PG8_SCHED; PG8_LDA(At, 0, 0); PG8_STAGE(PG8_SA(1, 1), a1 + hstep, voffA);
            PG8_WAIT_L(8); PG8_BAR; PG8_WAIT_L(0); PG8_MMA(0, 0, At, B0); PG8_BAR; PG8_SCHED;
            PG8_LDB(B1, 0, 1); PG8_STAGE(PG8_SB(0, 0), b2, voffB);
            PG8_BAR; PG8_WAIT_L(0); PG8_MMA(0, 1, At, B1); PG8_BAR;
            PG8_LDA(At, 0, 1); PG8_STAGE(PG8_SA(0, 0), a2, voffA);
            PG8_BAR; PG8_WAIT_L(0); PG8_MMA(1, 0, At, B0); PG8_BAR; PG8_SCHED;
            PG8_STAGE(PG8_SB(0, 1), b2 + hstep, voffB);
            PG8_WAIT_V(6); PG8_BAR; PG8_MMA(1, 1, At, B1); PG8_BAR;
            PG8_LDB(B0, 1, 0); PG8_SCHED; PG8_LDA(At, 1, 0); PG8_STAGE(PG8_SA(0, 1), a2 + hstep, voffA);
            PG8_WAIT_L(8); PG8_BAR; PG8_WAIT_L(0); PG8_MMA(0, 0, At, B0); PG8_BAR; PG8_SCHED;
            PG8_LDB(B1, 1, 1); PG8_STAGE(PG8_SB(1, 0), b3, voffB);
            PG8_BAR; PG8_WAIT_L(0); PG8_MMA(0, 1, At, B1); PG8_BAR;
            PG8_LDA(At, 1, 1); PG8_STAGE(PG8_SA(1, 0), a3, voffA);
            PG8_BAR; PG8_WAIT_L(0); PG8_MMA(1, 0, At, B0); PG8_BAR; PG8_SCHED;
            PG8_STAGE(PG8_SB(1, 1), b3 + hstep, voffB);
            PG8_WAIT_V(6); PG8_BAR; PG8_MMA(1, 1, At, B1); PG8_BAR;
            }
        }
        if constexpr (ALIGN_EPI) { if (wr == 0) PG8_BAR; }
        if constexpr (!Epi::AFTER_DRAIN) { E(acc, cur, wr, wc, fr, fq); S.done(cur); }
        if (!has_next) break;
#pragma unroll
        for (int a = 0; a < 2; ++a)
#pragma unroll
            for (int b = 0; b < 2; ++b)
#pragma unroll
                for (int m = 0; m < 4; ++m)
#pragma unroll
                    for (int n = 0; n < 2; ++n) acc[a][b][m][n] = (f32x4){0.f, 0.f, 0.f, 0.f};
        cur = nxt; cA = nA; cB = nB; ++ui;
        if constexpr (ALIGN_EPI) { if (wr == 1) PG8_BAR; }
    }
    PG8_WAIT_V(0);
    if constexpr (!ALIGN_EPI) { if (wr == 0) PG8_BAR; }
    PG8_BAR;
    if constexpr (Epi::AFTER_DRAIN) { E.fused(acc, cur, wr, wc, fr, fq, lds, wid, lane); S.done(cur); }
#undef PG8_SA
#undef PG8_SB
#undef PG8_STAGE
#undef PG8_LDA
#undef PG8_LDB
#undef PG8_MMA
#undef PG8_WAIT_V
#undef PG8_WAIT_L
#undef PG8_BAR
#undef PG8_SCHED
}
}
#ifndef PG8_SP2
#define PG8_SP2 true
#endif
#ifndef PG8_ALIGN
#define PG8_ALIGN true
#endif
namespace pg8 {
struct EpiF32 {
    static constexpr bool PERM = false, AFTER_DRAIN = false;
    float* O; int ldc; const float* base; float alpha;
    __device__ __forceinline__ void operator()(const f32x4 (&acc)[2][2][4][2], const Unit& u, int wr, int wc, int fr, int fq) const {
        const int col0 = u.pn * BM + wc * 32 + 4 * fq;
#pragma unroll
        for (int ai = 0; ai < 2; ++ai)
#pragma unroll
            for (int m = 0; m < 4; ++m) { const size_t off = (size_t)(u.pm * BM + ai * HALF + wr * 64 + m * 16 + fr) * ldc + col0;
#pragma unroll
                for (int bj = 0; bj < 2; ++bj)
#pragma unroll
                    for (int n = 0; n < 2; ++n) { f32x4 v = acc[ai][bj][m][n];
                        if (base) { const f32x4 bs = *(const f32x4*)(base + off + bj * HALF + n * 16); v = v + bs * alpha; }
                        *(f32x4*)(O + off + bj * HALF + n * 16) = v; } }
    }
};
}

#include <hip/hip_bf16.h>
#include <cmath>
namespace datt {
using bf16 = __hip_bfloat16;
typedef short bf16x8 __attribute__((ext_vector_type(8)));
typedef short s16x4 __attribute__((ext_vector_type(4)));
typedef float f32x16 __attribute__((ext_vector_type(16)));
typedef float f32x4 __attribute__((ext_vector_type(4)));
typedef unsigned u32x4 __attribute__((ext_vector_type(4)));
constexpr int SEQ = 4096, DM = 1024, DQK = 64, DV = 128;
constexpr int NW = 8, QBLK = 32, KVBLK = 64, QB = NW * QBLK;
constexpr int SHM_V = KVBLK * DV * 2, SHM_K = KVBLK * DQK * 2;
constexpr int LDS_BYTES = 2 * SHM_V + 2 * SHM_K + NW * 64 * 4;
constexpr float THR = 8.f;
#define DKSWZ(row, colB) ((row) * 128 + ((colB) ^ (((row) & 7) << 4)))
#define DSBAR() __builtin_amdgcn_sched_barrier(0)
__device__ __forceinline__ int v_st(int k, int c) { const int kk = (k & ~0xC) | ((k & 4) << 1) | ((k & 8) >> 1); return ((kk >> 3) * 4 + (c >> 5)) * 512 + ((kk & 7) * 32 + (c & 31)) * 2; }
__device__ __forceinline__ int v_rd_base(int lane) { return ((lane & 3) << 3) | (((lane >> 2) & 3) << 6) | (((lane >> 4) & 1) << 5) | (((lane >> 5) & 1) << 8); }
constexpr int v_rd_off(int d0, int ks, int half) { return d0 * 512 + ks * 4096 + half * 2048; }
__device__ __forceinline__ int crow(int r, int hi) { return (r & 3) + 8 * (r >> 2) + 4 * hi; }
__device__ __forceinline__ unsigned cvtpk(float lo, float hi) { unsigned r; asm volatile("v_cvt_pk_bf16_f32 %0, %1, %2" : "=v"(r) : "v"(lo), "v"(hi)); return r; }
__device__ __forceinline__ bf16x8 load8(const bf16* p) { return *reinterpret_cast<const bf16x8*>(p); }
__device__ __forceinline__ void mask_tile(f32x16& p0, f32x16& p1, int dq) {
    const float NEG = -__builtin_inff();
#pragma unroll
    for (int r = 0; r < 16; ++r) { const int c = (r & 3) + 8 * (r >> 2); if (dq - c < 0) p0[r] = NEG; if (dq - c - 32 < 0) p1[r] = NEG; }
}
__device__ __forceinline__ void alibi_tile(f32x16& p0, f32x16& p1, float sl2) {
#pragma unroll
    for (int r = 0; r < 16; ++r) { const float c = (float)((r & 3) + 8 * (r >> 2)); p0[r] = __builtin_fmaf(sl2, c, p0[r]); p1[r] = __builtin_fmaf(sl2, c + 32.f, p1[r]); }
}
__device__ __forceinline__ void partialSM(f32x16& p0, f32x16& p1, float base, float& m_reg, float& alpha) {
    float pmax = p0[0];
#pragma unroll
    for (int r = 1; r < 16; ++r) pmax = fmaxf(pmax, p0[r]);
#pragma unroll
    for (int r = 0; r < 16; ++r) pmax = fmaxf(pmax, p1[r]);
    { auto rr = __builtin_amdgcn_permlane32_swap(__float_as_uint(pmax), __float_as_uint(pmax), false, false); pmax = fmaxf(__uint_as_float(rr[0]), __uint_as_float(rr[1])); }
    pmax += base;
    float mn;
    if (__builtin_expect(__all(pmax - m_reg <= THR), 1)) { mn = m_reg; alpha = 1.f; }
    else { mn = fmaxf(m_reg, pmax); alpha = __builtin_amdgcn_exp2f(m_reg - mn); m_reg = mn; }
    const float mnL = base - mn;
#pragma unroll
    for (int r = 0; r < 16; ++r) p0[r] += mnL;
#pragma unroll
    for (int r = 0; r < 16; ++r) p1[r] += mnL;
#pragma unroll
    for (int r = 0; r < 16; ++r) p0[r] = __builtin_amdgcn_exp2f(p0[r]);
}
__device__ __forceinline__ void finishSM(f32x16& p0, f32x16& p1, float alpha, float& l_reg, bf16x8& pa0, bf16x8& pa1, bf16x8& pa2, bf16x8& pa3) {
#pragma unroll
    for (int r = 0; r < 16; ++r) p1[r] = __builtin_amdgcn_exp2f(p1[r]);
    float ps = 0;
#pragma unroll
    for (int r = 0; r < 16; ++r) ps += p0[r];
#pragma unroll
    for (int r = 0; r < 16; ++r) ps += p1[r];
    { auto rr = __builtin_amdgcn_permlane32_swap(__float_as_uint(ps), __float_as_uint(ps), false, false); ps = __uint_as_float(rr[0]) + __uint_as_float(rr[1]); }
    l_reg = l_reg * alpha + ps;
#define DPK4(P, B_, OUT) do { unsigned a0 = cvtpk(P[B_+0], P[B_+1]), a1 = cvtpk(P[B_+2], P[B_+3]); unsigned b0 = cvtpk(P[B_+4], P[B_+5]), b1 = cvtpk(P[B_+6], P[B_+7]); \
        auto r0 = __builtin_amdgcn_permlane32_swap(a0, b0, false, false); auto r1 = __builtin_amdgcn_permlane32_swap(a1, b1, false, false); \
        u32x4 w = {r0[0], r1[0], r0[1], r1[1]}; OUT = *reinterpret_cast<bf16x8*>(&w); } while (0)
    DPK4(p0, 0, pa0); DPK4(p0, 8, pa1); DPK4(p1, 0, pa2); DPK4(p1, 8, pa3);
#undef DPK4
}
template <int KB>
__device__ __forceinline__ void qkt(f32x16& p0, f32x16& p1, const char* K_lds, int r32, int hi, const bf16x8* qr) {
    p0 = f32x16{}; p1 = f32x16{};
#pragma unroll
    for (int d0 = 0; d0 < 4; ++d0) { const char* a = K_lds + KB * SHM_K + DKSWZ(r32, (d0 * 16 + hi * 8) * 2);
        const bf16x8 b0 = *reinterpret_cast<const bf16x8*>(a);
        const bf16x8 b1 = *reinterpret_cast<const bf16x8*>(a + 32 * 128);
        p0 = __builtin_amdgcn_mfma_f32_32x32x16_bf16(b0, qr[d0], p0, 0, 0, 0);
        p1 = __builtin_amdgcn_mfma_f32_32x32x16_bf16(b1, qr[d0], p1, 0, 0, 0); }
}
template <int VB>
__device__ __forceinline__ void pv_tile(f32x16* o, int vb0, bf16x8 pa0, bf16x8 pa1, bf16x8 pa2, bf16x8 pa3) {
#define DTRRD(dst, off) asm volatile("ds_read_b64_tr_b16 %0, %1 offset:%2" : "=&v"(dst) : "v"(vb0), "i"(off) : "memory")
#define DPV_D0(d0) do { s16x4 l0, l1, l2, l3, h0, h1, h2, h3; constexpr int b_ = VB * SHM_V + v_rd_off(d0, 0, 0); \
        DTRRD(l0, b_); DTRRD(h0, b_ + 2048); DTRRD(l1, b_ + 4096); DTRRD(h1, b_ + 6144); DTRRD(l2, b_ + 8192); DTRRD(h2, b_ + 10240); DTRRD(l3, b_ + 12288); DTRRD(h3, b_ + 14336); \
        asm volatile("s_waitcnt lgkmcnt(0)" ::: "memory"); DSBAR(); \
        o[d0] = __builtin_amdgcn_mfma_f32_32x32x16_bf16(pa0, (bf16x8){l0[0], l0[1], l0[2], l0[3], h0[0], h0[1], h0[2], h0[3]}, o[d0], 0, 0, 0); \
        o[d0] = __builtin_amdgcn_mfma_f32_32x32x16_bf16(pa1, (bf16x8){l1[0], l1[1], l1[2], l1[3], h1[0], h1[1], h1[2], h1[3]}, o[d0], 0, 0, 0); \
        o[d0] = __builtin_amdgcn_mfma_f32_32x32x16_bf16(pa2, (bf16x8){l2[0], l2[1], l2[2], l2[3], h2[0], h2[1], h2[2], h2[3]}, o[d0], 0, 0, 0); \
        o[d0] = __builtin_amdgcn_mfma_f32_32x32x16_bf16(pa3, (bf16x8){l3[0], l3[1], l3[2], l3[3], h3[0], h3[1], h3[2], h3[3]}, o[d0], 0, 0, 0); } while (0)
    DPV_D0(0); DPV_D0(1); DPV_D0(2); DPV_D0(3);
#undef DPV_D0
#undef DTRRD
}
struct BlockRef { const bf16* Q; const bf16* K; const bf16* V; bf16* O; int P0; int jlo; float sl2; };
struct Seam { bf16x8 qr[4]; bf16x8 st_v0, st_v1, st_k0; };
#define DROWV(p, k0, rr) ((p) + (size_t)((k0) + (rr)) * DM + sc)
#define DROWK(p, k0) ((p) + (size_t)((k0) + kr) * DM + kc)
#define DVMW() asm volatile("s_waitcnt vmcnt(0)" ::: "memory")
#define DVMWN(n) asm volatile("s_waitcnt vmcnt(%0)" :: "i"(n) : "memory")
#define DSLOAD(Kp, Vp, k0) do { S.st_v0 = load8(DROWV(Vp, k0, sr)); S.st_v1 = load8(DROWV(Vp, k0, 32 + sr)); S.st_k0 = load8(DROWK(Kp, k0)); } while (0)
#define DSWRITE_K(bf) do { *(bf16x8*)(K_lds + (bf) * SHM_K + kws) = S.st_k0; } while (0)
#define DSWRITE_V(bf) do { *(bf16x8*)(V_lds + (bf) * SHM_V + vst0) = S.st_v0; *(bf16x8*)(V_lds + (bf) * SHM_V + vst1) = S.st_v1; } while (0)
__device__ __forceinline__ void datt_prime(const BlockRef& cur, char* lds, Seam& S) {
    const int tid = threadIdx.x, wid = __builtin_amdgcn_readfirstlane(tid >> 6), lane = tid & 63, r32 = lane & 31, hi = lane >> 5;
    const int sr = tid >> 4, sc = (tid & 15) * 8, kr = tid >> 3, kc = (tid & 7) * 8, kws = DKSWZ(kr, kc * 2); char* K_lds = lds + 2 * SHM_V;
    const int kb0 = cur.jlo * KVBLK;
#pragma unroll
    for (int d0 = 0; d0 < 4; ++d0) S.qr[d0] = load8(cur.Q + (size_t)(wid * QBLK + r32) * DM + d0 * 16 + hi * 8);
    DSLOAD(cur.K, cur.V, kb0); DVMW(); DSWRITE_K(0);
    __syncthreads();
}
__device__ __forceinline__ void datt_block(const BlockRef& cur, const BlockRef& nxt, char* lds, Seam& S) {
    const int tid = threadIdx.x, wid = __builtin_amdgcn_readfirstlane(tid >> 6), lane = tid & 63, r32 = lane & 31, hi = lane >> 5;
    const int j_lo = cur.jlo, j_hi = (cur.P0 + QB - 1) / KVBLK + 1, NT = j_hi - j_lo;
    const int kbn = nxt.jlo * KVBLK;
    const int qlo = cur.P0 + wid * QBLK, qm = qlo + r32 - 4 * hi;
    const float sl2 = cur.sl2;
    char* V_lds = lds; char* K_lds = lds + 2 * SHM_V;
    float* ws = (float*)(lds + 2 * SHM_V + 2 * SHM_K) + wid * 64; float* li_l = ws, * al_l = ws + 32;
    float m_reg = 4.0f, l_reg = 0; f32x16 o[4] = {};
    const int sr = tid >> 4, sc = (tid & 15) * 8, vst0 = v_st(sr, sc), vst1 = v_st(32 + sr, sc), kr = tid >> 3, kc = (tid & 7) * 8, kws = DKSWZ(kr, kc * 2);
    const int vb0 = (int)(uintptr_t)V_lds + v_rd_base(lane);
    const bf16* Kh = cur.K; const bf16* Vh = cur.V;
#define DRESC(a) do { if (__any((a) < 1.f)) { if (hi == 0) al_l[r32] = (a); asm volatile("s_waitcnt lgkmcnt(0)" ::: "memory"); \
                     _Pragma("unroll") for (int d_ = 0; d_ < 4; ++d_) _Pragma("unroll") for (int r = 0; r < 16; ++r) o[d_][r] *= al_l[crow(r, hi)]; } } while (0)
#define DKBASE(t) ((j_lo + (t)) * KVBLK)
#define DBIAS(t) (sl2 * (float)(DKBASE(t) - qm))
#define DMASKT(P0_, P1_, t) do { const int kb_ = DKBASE(t); alibi_tile(P0_, P1_, sl2); if (kb_ + KVBLK - 1 > qlo) mask_tile(P0_, P1_, qm - kb_); } while (0)
#define DSEAM_K0() do { DVMWN(4); DSWRITE_K(0); DSBAR(); } while (0)
    f32x16 pA0, pA1, pB0, pB1; float alA, alB; bf16x8 pa0, pa1, pa2, pa3;
    DSWRITE_V(0); DSBAR();
    if (NT > 1) DSLOAD(Kh, Vh, DKBASE(1));
    DSBAR(); qkt<0>(pA0, pA1, K_lds, r32, hi, S.qr);
    DMASKT(pA0, pA1, 0); partialSM(pA0, pA1, DBIAS(0), m_reg, alA);
    if (NT > 1) { DVMW(); DSWRITE_V(1); DSWRITE_K(1); }
    __syncthreads();
#define DHALF_STEP(PX0, PX1, alX, PY0, PY1, alY, t, KB, VB, SB) do { \
        DSBAR(); qkt<KB>(PX0, PX1, K_lds, r32, hi, S.qr); \
        finishSM(PY0, PY1, alY, l_reg, pa0, pa1, pa2, pa3); DSBAR(); \
        if ((t) + 1 < NT) { DSLOAD(Kh, Vh, DKBASE((t) + 1)); DSBAR(); } \
        pv_tile<VB>(o, vb0, pa0, pa1, pa2, pa3); DMASKT(PX0, PX1, (t)); partialSM(PX0, PX1, DBIAS(t), m_reg, alX); \
        __syncthreads(); \
        if ((t) + 1 < NT) { DVMW(); DSWRITE_V(SB); DSWRITE_K(SB); } \
        DRESC(alX); __syncthreads(); } while (0)
    for (int t = 1; t + 1 < NT; t += 2) {
        DHALF_STEP(pB0, pB1, alB, pA0, pA1, alA, t, 1, 0, 0);
        DHALF_STEP(pA0, pA1, alA, pB0, pB1, alB, t + 1, 0, 1, 1);
    }
    const bool even = (NT & 1) == 0;
    if (even) { DSBAR(); qkt<1>(pB0, pB1, K_lds, r32, hi, S.qr); DSBAR(); }
    DSLOAD(nxt.K, nxt.V, kbn); DSBAR();
#pragma unroll
    for (int d0 = 0; d0 < 4; ++d0) S.qr[d0] = load8(nxt.Q + (size_t)(wid * QBLK + r32) * DM + d0 * 16 + hi * 8);
    DSBAR();
    finishSM(pA0, pA1, alA, l_reg, pa0, pa1, pa2, pa3); DSBAR();
    pv_tile<0>(o, vb0, pa0, pa1, pa2, pa3);
    if (even) { DMASKT(pB0, pB1, NT - 1); partialSM(pB0, pB1, DBIAS(NT - 1), m_reg, alB); __syncthreads(); DRESC(alB);
        finishSM(pB0, pB1, alB, l_reg, pa0, pa1, pa2, pa3); DSBAR(); pv_tile<1>(o, vb0, pa0, pa1, pa2, pa3); }
    DSBAR(); DSEAM_K0();
    if (hi == 0) li_l[r32] = l_reg; asm volatile("s_waitcnt lgkmcnt(0)" ::: "memory");
    float rli[16];
#pragma unroll
    for (int r = 0; r < 16; ++r) rli[r] = __builtin_amdgcn_rcpf(li_l[crow(r, hi)]);
    bf16* Ow = cur.O + (size_t)(wid * QBLK) * DM;
#pragma unroll
    for (int r = 0; r < 16; ++r) { const int orow = crow(r, hi);
#pragma unroll
        for (int d0 = 0; d0 < 4; ++d0) { const float v = o[d0][r] * rli[r]; const float vn = __shfl_xor(v, 1);
            if ((r32 & 1) == 0) *(unsigned*)(Ow + (size_t)orow * DM + d0 * 32 + r32) = cvtpk(v, vn); } }
    __syncthreads();
#undef DRESC
#undef DKBASE
#undef DBIAS
#undef DMASKT
#undef DSEAM_K0
#undef DHALF_STEP
}
#undef DROWV
#undef DROWK
#undef DVMW
#undef DVMWN
#undef DSLOAD
#undef DSWRITE_K
#undef DSWRITE_V
struct Tensors { const bf16* Q; const bf16* K; const bf16* V; bf16* O0; bf16* O1; const unsigned* NQ; const unsigned* NK; unsigned* qhead; const unsigned short* order; };
__device__ __forceinline__ BlockRef make_ref(const Tensors& T, unsigned code) {
    const int qb = code & 15, h = (code >> 4) & 7, b = (code >> 7) & 3, c = (code >> 9) & 1, hq = 2 * h + c;
    BlockRef r; const size_t rowb = (size_t)b * SEQ;
    r.Q = T.Q + (rowb + (size_t)qb * QB) * DM + hq * DQK; r.K = T.K + rowb * DM + hq * DQK; r.V = T.V + rowb * DM + h * DV; r.O = (c ? T.O1 : T.O0) + (rowb + (size_t)qb * QB) * DM + h * DV;
    r.P0 = qb * QB; r.sl2 = __builtin_amdgcn_exp2f(-(float)(h + 1)) * 1.4426950408889634f;
    int lane_ = threadIdx.x & 63; asm volatile("" : "+v"(lane_));
    const int nt_ = 4 * qb + 4; float qn_ = 0.f;
#pragma unroll
    for (int i_ = 0; i_ < 4; ++i_) qn_ = fmaxf(qn_, __uint_as_float(T.NQ[((b * 64 + 4 * qb + i_) * 16) + hq]));
    const float kn_ = lane_ < nt_ ? __uint_as_float(T.NK[((b * 64 + lane_) * 16) + hq]) : 0.f;
    const float bound_ = sqrtf(qn_) * sqrtf(kn_) * 1.001f - r.sl2 * (float)(256 * qb - 64 * lane_ - 63) - 4.0f;
    const unsigned long long keep_ = __ballot(lane_ < nt_ && !(bound_ < -152.0f));
    int first_ = keep_ ? (int)__builtin_ctzll(keep_) : nt_ - 1; if (first_ > nt_ - 4) first_ = nt_ - 4;
    r.jlo = __builtin_amdgcn_readfirstlane(first_);
    return r;
}
__device__ __forceinline__ int draw(const Tensors& T, volatile __attribute__((address_space(3))) unsigned* qw) {
    __syncthreads();
    if (threadIdx.x == 0) *qw = __hip_atomic_fetch_add(T.qhead, 1u, __ATOMIC_RELAXED, __HIP_MEMORY_SCOPE_AGENT);
    __syncthreads();
    return (int)*qw;
}
__device__ __forceinline__ void datt_phase(char* lds, volatile __attribute__((address_space(3))) unsigned* qw, const Tensors& T) {
    int i = draw(T, qw); if (i >= 1024) return;
    BlockRef cur = make_ref(T, T.order[i]);
    Seam S;
    datt_prime(cur, lds, S);
    for (;;) {
        const int in = draw(T, qw); const bool last = in >= 1024;
        const BlockRef nxt = last ? cur : make_ref(T, T.order[in]);
        datt_block(cur, nxt, lds, S);
        if (last) break;
        cur = nxt;
    }
}
#undef DKSWZ
#undef DSBAR
}
__device__ const unsigned short datt_order[1024] = {79,95,111,127,207,223,239,255,335,351,367,383,463,479,495,511,591,607,623,639,719,735,751,767,847,863,879,895,975,991,1007,1023,78,94,110,126,206,222,238,254,334,350,366,382,462,478,494,510,590,606,622,638,718,734,750,766,846,862,878,894,974,990,1006,1022,77,93,109,125,205,221,237,253,333,349,365,381,461,477,493,509,589,605,621,637,717,733,749,765,845,861,877,893,973,989,1005,1021,76,92,108,124,204,220,236,252,332,348,364,380,460,476,492,508,588,604,620,636,716,732,748,764,844,860,876,892,972,988,1004,1020,75,91,107,123,203,219,235,251,331,347,363,379,459,475,491,507,587,603,619,635,715,731,747,763,843,859,875,891,971,987,1003,1019,74,90,106,122,202,218,234,250,330,346,362,378,458,474,490,506,586,602,618,634,714,730,746,762,842,858,874,890,970,986,1002,1018,73,89,105,121,201,217,233,249,329,345,361,377,457,473,489,505,585,601,617,633,713,729,745,761,841,857,873,889,969,985,1001,1017,56,57,58,59,60,61,62,63,72,88,104,120,184,185,186,187,188,189,190,191,200,216,232,248,312,313,314,315,316,317,318,319,328,344,360,376,440,441,442,443,444,445,446,447,456,472,488,504,568,569,570,571,572,573,574,575,584,600,616,632,696,697,698,699,700,701,702,703,712,728,744,760,824,825,826,827,828,829,830,831,840,856,872,888,952,953,954,955,956,957,958,959,968,984,1000,1016,55,71,87,103,119,183,199,215,231,247,311,327,343,359,375,439,455,471,487,503,567,583,599,615,631,695,711,727,743,759,823,839,855,871,887,951,967,983,999,1015,54,70,86,102,118,182,198,214,230,246,310,326,342,358,374,438,454,470,486,502,566,582,598,614,630,694,710,726,742,758,822,838,854,870,886,950,966,982,998,1014,53,69,85,101,117,181,197,213,229,245,309,325,341,357,373,437,453,469,485,501,565,581,597,613,629,693,709,725,741,757,821,837,853,869,885,949,965,981,997,1013,36,37,38,39,40,41,42,43,44,45,46,47,52,68,84,100,116,164,165,166,167,168,169,170,171,172,173,174,175,180,196,212,228,244,292,293,294,295,296,297,298,299,300,301,302,303,308,324,340,356,372,420,421,422,423,424,425,426,427,428,429,430,431,436,452,468,484,500,548,549,550,551,552,553,554,555,556,557,558,559,564,580,596,612,628,676,677,678,679,680,681,682,683,684,685,686,687,692,708,724,740,756,804,805,806,807,808,809,810,811,812,813,814,815,820,836,852,868,884,932,933,934,935,936,937,938,939,940,941,942,943,948,964,980,996,1012,35,51,67,83,99,115,163,179,195,211,227,243,291,307,323,339,355,371,419,435,451,467,483,499,547,563,579,595,611,627,675,691,707,723,739,755,803,819,835,851,867,883,931,947,963,979,995,1011,18,19,20,21,22,23,24,25,26,27,28,29,30,31,34,50,66,82,98,114,146,147,148,149,150,151,152,153,154,155,156,157,158,159,162,178,194,210,226,242,274,275,276,277,278,279,280,281,282,283,284,285,286,287,290,306,322,338,354,370,402,403,404,405,406,407,408,409,410,411,412,413,414,415,418,434,450,466,482,498,530,531,532,533,534,535,536,537,538,539,540,541,542,543,546,562,578,594,610,626,658,659,660,661,662,663,664,665,666,667,668,669,670,671,674,690,706,722,738,754,786,787,788,789,790,791,792,793,794,795,796,797,798,799,802,818,834,850,866,882,914,915,916,917,918,919,920,921,922,923,924,925,926,927,930,946,962,978,994,1010,1,2,3,4,5,6,7,8,9,10,11,12,13,14,15,17,33,49,65,81,97,113,129,130,131,132,133,134,135,136,137,138,139,140,141,142,143,145,161,177,193,209,225,241,257,258,259,260,261,262,263,264,265,266,267,268,269,270,271,273,289,305,321,337,353,369,385,386,387,388,389,390,391,392,393,394,395,396,397,398,399,401,417,433,449,465,481,497,513,514,515,516,517,518,519,520,521,522,523,524,525,526,527,529,545,561,577,593,609,625,641,642,643,644,645,646,647,648,649,650,651,652,653,654,655,657,673,689,705,721,737,753,769,770,771,772,773,774,775,776,777,778,779,780,781,782,783,785,801,817,833,849,865,881,897,898,899,900,901,902,903,904,905,906,907,908,909,910,911,913,929,945,961,977,993,1009,0,16,32,48,64,80,96,112,128,144,160,176,192,208,224,240,256,272,288,304,320,336,352,368,384,400,416,432,448,464,480,496,512,528,544,560,576,592,608,624,640,656,672,688,704,720,736,752,768,784,800,816,832,848,864,880,896,912,928,944,960,976,992,1008};

constexpr int NWAVES = 8;
constexpr int BATCH = 4, SEQ = 4096, D = 2048, M = BATCH * SEQ;
constexpr int AW = 1024, NIN = 5120;
constexpr float LN_EPS = 1e-5f;
constexpr float DN_ALPHA = 1.189207115002721f;
constexpr float C2 = 0.125f * 1.4426950408889634f;
constexpr float LOG2E = 1.4426950408889634f;

constexpr size_t MiB = 1u << 20;
constexpr size_t WS_CTL = 0, CTL_ZERO_BYTES = 1 * MiB;
constexpr size_t WS_WIN = 2 * MiB, WS_WOUT = 22 * MiB, WS_WQ = 30 * MiB, WS_PRM = 38 * MiB;
constexpr size_t WS_XB = 40 * MiB;
constexpr size_t WS_MIX = 40 * MiB;
constexpr size_t WS_Q = 104 * MiB, WS_K = 136 * MiB, WS_V = 168 * MiB, WS_XR = 200 * MiB, WS_XG = 232 * MiB;
constexpr size_t WS_Y1 = 104 * MiB;
constexpr size_t WS_H1 = 232 * MiB;
constexpr size_t WS_H8 = 296 * MiB;
constexpr size_t WS_PQ = 104 * MiB;
constexpr size_t WS_SU = 38 * MiB + 65536, WS_SH = 38 * MiB + 131072;
constexpr size_t WS_WG = 38 * MiB + 262144;
constexpr size_t WS_PART = 104 * MiB;
constexpr size_t WS_FFN = 40 * MiB;
constexpr size_t WS_PK = 2 * MiB;
constexpr size_t WS_U8 = 328 * MiB, WS_V8 = 360 * MiB;
constexpr size_t WS_LA = 328 * MiB, WS_LB = 392 * MiB;
constexpr size_t WS_O0 = 264 * MiB, WS_O1 = 296 * MiB;
constexpr size_t WS_E = 456 * MiB, WS_G = 464 * MiB, WS_TOTA = 472 * MiB, WS_TOTH = 473 * MiB, WS_SKH = 474 * MiB, WS_SKL = 475 * MiB, WS_END = 476 * MiB;
constexpr int CW_BAR = 4096;
constexpr int CW_NQ = 32768, CW_NK = 32768 + 4096, CW_AQ = 32768 + 8192;

constexpr int RING_OFF = 0, RING_BYTES = 131072;
constexpr int LDSCTL_OFF = RING_BYTES, MISC_OFF = LDSCTL_OFF + 320;
constexpr int LDS_BYTES = 147456;

#define GAS __attribute__((address_space(1)))
#define LAS __attribute__((address_space(3)))
typedef unsigned short bf16;
typedef unsigned v4u __attribute__((ext_vector_type(4)));
typedef float f32x4 __attribute__((ext_vector_type(4)));
typedef GAS unsigned gu32;
#define RLX_AGENT __ATOMIC_RELAXED, __HIP_MEMORY_SCOPE_AGENT
#define LDS_WAIT() asm volatile("s_waitcnt lgkmcnt(0)" ::: "memory")
#define VM_WAIT() asm volatile("s_waitcnt vmcnt(0)" ::: "memory")
__device__ __forceinline__ unsigned f2bf(float f) { unsigned u = __builtin_bit_cast(unsigned, f); return (u + 0x7fffu + ((u >> 16) & 1u)) >> 16; }
__device__ __forceinline__ unsigned pk2(float lo, float hi) { return f2bf(lo) | (f2bf(hi) << 16); }
__device__ __forceinline__ float bf2f(unsigned short u) { return __uint_as_float(((unsigned)u) << 16); }
__device__ __forceinline__ float gelu_tanh(float x) { const float u = 0.7978845608028654f * (x + 0.044715f * x * x * x); return 0.5f * x * (1.f + tanhf(u)); }

#define XB_TMO      128
#define XB_XCNT(j)  (256  + 64 * (j))
#define XB_XSUB(j)  (1280 + 64 * (j))
#define XB_XGEN(j)  (2304 + 64 * (j))
#define XB_TOP      3328
#define XB_TOPGEN   3392
#define XCD_BAR_WORDS 3456
#define XB_SPIN_CAP (1u << 18)

__device__ __forceinline__ unsigned xb_ld(unsigned* p)              { return __hip_atomic_load(p, __ATOMIC_RELAXED, __HIP_MEMORY_SCOPE_AGENT); }
__device__ __forceinline__ unsigned xb_add(unsigned* p, unsigned v) { return __hip_atomic_fetch_add(p, v, __ATOMIC_RELAXED, __HIP_MEMORY_SCOPE_AGENT); }
__device__ __forceinline__ unsigned xb_xcc_id() { return (unsigned)__builtin_amdgcn_s_getreg((3 << 11) | 20) & 0xFu; }
#define XB_SPIN(cond, bar) do { unsigned _sp = 0; while (cond) { __builtin_amdgcn_s_sleep(1); \
    if ((++_sp & 255u) == 0u) { if (xb_ld(&(bar)[XB_TMO])) break; if (_sp > XB_SPIN_CAP) { atomicAdd(&(bar)[XB_TMO], 1u); break; } } } } while (0)

struct XcdBarrier {
    unsigned* bar; unsigned x;
    volatile LAS unsigned* st;
};

__device__ __forceinline__ XcdBarrier xcd_barrier_post(unsigned* bar, volatile LAS unsigned* st) {
    XcdBarrier b; b.bar = bar; b.x = xb_xcc_id(); b.st = st;
    if (threadIdx.x == 0) (void)xb_add(&bar[XB_XCNT(b.x)], 1u);
    return b;
}
__device__ __forceinline__ void xcd_barrier_complete(unsigned* bar, unsigned x, unsigned& nloc, unsigned& nx) {
    const unsigned G = gridDim.x * gridDim.y * gridDim.z;
    unsigned sum, cnt, mine, sp = 0u;
    for (;;) {
        sum = 0u; cnt = 0u; mine = 0u;
#pragma unroll
        for (unsigned j = 0; j < 16; ++j) { const unsigned c = xb_ld(&bar[XB_XCNT(j)]); sum += c; cnt += (c > 0u) ? 1u : 0u; mine = (j == x) ? c : mine; }
        if (sum == G) break;
        __builtin_amdgcn_s_sleep(1);
        if ((++sp & 255u) == 0u) { if (xb_ld(&bar[XB_TMO])) break; if (sp > XB_SPIN_CAP) { atomicAdd(&bar[XB_TMO], 1u); break; } }
    }
    nloc = mine > 0u ? mine : 1u; nx = cnt > 0u ? cnt : 1u;
}

__device__ __forceinline__ void xcd_barrier(const XcdBarrier& b) {
    asm volatile("s_waitcnt vmcnt(0)" ::: "memory");
    __syncthreads();
    if (threadIdx.x == 0) {
        unsigned* bar = b.bar;
        __builtin_amdgcn_s_waitcnt(0);
        unsigned nloc = b.st[0], nx = b.st[1];
        if (nloc == 0u) { xcd_barrier_complete(bar, b.x, nloc, nx); b.st[0] = nloc; b.st[1] = nx; }
        const unsigned old = xb_add(&bar[XB_XSUB(b.x)], 1u);
        const unsigned gen = old / nloc;
        if (old + 1u == (gen + 1u) * nloc) {
            __builtin_amdgcn_fence(__ATOMIC_RELEASE, "agent");
            asm volatile("s_waitcnt vmcnt(0)" ::: "memory");
            const unsigned og = xb_add(&bar[XB_TOP], 1u);
            const unsigned tg = og / nx;
            if (og + 1u == (tg + 1u) * nx) xb_add(&bar[XB_TOPGEN], 1u);
            else XB_SPIN(xb_ld(&bar[XB_TOPGEN]) == tg, bar);
            __builtin_amdgcn_fence(__ATOMIC_ACQUIRE, "agent");
            xb_add(&bar[XB_XGEN(b.x)], 1u);
            asm volatile("s_waitcnt vmcnt(0)" ::: "memory");
        } else {
            XB_SPIN(xb_ld(&bar[XB_XGEN(b.x)]) == gen, bar);
            __builtin_amdgcn_fence(__ATOMIC_ACQUIRE, "agent");
            asm volatile("s_waitcnt vmcnt(0)" ::: "memory");
        }
    }
    __syncthreads();
}

struct Frame {
    LAS unsigned char* lds;
    int tid, lane, wave;
    int vcu, G;
};

__device__ __forceinline__ void p0_transpose_item(const float* W, int K, int N, bf16* WT, int row_off, LAS float* scr, int item, int lane) {
    const int nblk = N / 32, kb = item / nblk, nb = item % nblk, k0 = 64 * kb, n0 = 32 * nb;
#pragma unroll 8
    for (int i = 0; i < 32; ++i) { const int kk = 2 * i + (lane >> 5); scr[kk * 33 + (lane & 31)] = W[(size_t)(k0 + kk) * N + n0 + (lane & 31)]; }
    LDS_WAIT(); asm volatile("" ::: "memory");
    const int c = lane & 7;
#pragma unroll
    for (int j = 0; j < 4; ++j) { const int n = (lane >> 3) + 8 * j; const LAS float* s = scr + (8 * c) * 33 + n;
        v4u o; o.x = pk2(s[0 * 33], s[1 * 33]); o.y = pk2(s[2 * 33], s[3 * 33]); o.z = pk2(s[4 * 33], s[5 * 33]); o.w = pk2(s[6 * 33], s[7 * 33]);
        *(GAS v4u*)(WT + (size_t)(row_off + n0 + n) * K + k0 + 8 * c) = o; }
    LDS_WAIT(); asm volatile("" ::: "memory");
}

typedef short bf16x8 __attribute__((ext_vector_type(8)));
typedef float f32x16 __attribute__((ext_vector_type(16)));
typedef float f32x2_t __attribute__((ext_vector_type(2))); typedef __bf16 bf16x2_t __attribute__((ext_vector_type(2)));
__device__ __forceinline__ unsigned cvtpk(float lo, float hi) { f32x2_t v = {lo, hi}; bf16x2_t b = __builtin_convertvector(v, bf16x2_t); return __builtin_bit_cast(unsigned, b); }
__device__ __forceinline__ void split8(const f32x4 a, const f32x4 b, bf16x8& h, bf16x8& l) {
    v4u hh; hh.x = cvtpk(a.x, a.y); hh.y = cvtpk(a.z, a.w); hh.z = cvtpk(b.x, b.y); hh.w = cvtpk(b.z, b.w);
    v4u ll;
    ll.x = cvtpk(a.x - __uint_as_float(hh.x << 16), a.y - __uint_as_float(hh.x & 0xffff0000u));
    ll.y = cvtpk(a.z - __uint_as_float(hh.y << 16), a.w - __uint_as_float(hh.y & 0xffff0000u));
    ll.z = cvtpk(b.x - __uint_as_float(hh.z << 16), b.y - __uint_as_float(hh.z & 0xffff0000u));
    ll.w = cvtpk(b.z - __uint_as_float(hh.w << 16), b.w - __uint_as_float(hh.w & 0xffff0000u));
    h = __builtin_bit_cast(bf16x8, hh); l = __builtin_bit_cast(bf16x8, ll);
}
__device__ __forceinline__ float max3f_(float a, float b, float c) { return __builtin_fmaxf(__builtin_fmaxf(a, b), c); }
__device__ __forceinline__ float pair_max(float m) { auto rr = __builtin_amdgcn_permlane32_swap(__float_as_uint(m), __float_as_uint(m), false, false); return __builtin_fmaxf(__uint_as_float(rr[0]), __uint_as_float(rr[1])); }
__device__ __forceinline__ void route_half(const float* qp, const v4u* kh, const v4u* kl, int lane, int hi, float (&lst)[16]) {
    f32x16 sc[4];
#pragma unroll
    for (int kt = 0; kt < 4; ++kt) sc[kt] = f32x16{};
#pragma unroll 2
    for (int ds = 0; ds < 8; ++ds) { bf16x8 qh, ql; split8(*(const f32x4*)(qp + 16 * ds), *(const f32x4*)(qp + 16 * ds + 4), qh, ql);
#pragma unroll
        for (int kt = 0; kt < 4; ++kt) { const bf16x8 ah = __builtin_bit_cast(bf16x8, kh[(kt * 8 + ds) * 64 + lane]), al = __builtin_bit_cast(bf16x8, kl[(kt * 8 + ds) * 64 + lane]);
            sc[kt] = __builtin_amdgcn_mfma_f32_32x32x16_bf16(ah, qh, sc[kt], 0, 0, 0);
            sc[kt] = __builtin_amdgcn_mfma_f32_32x32x16_bf16(ah, ql, sc[kt], 0, 0, 0);
            sc[kt] = __builtin_amdgcn_mfma_f32_32x32x16_bf16(al, qh, sc[kt], 0, 0, 0); } }
#pragma unroll
    for (int kt = 0; kt < 4; ++kt)
#pragma unroll
        for (int r = 0; r < 16; ++r) { const unsigned key = (unsigned)(kt * 32 + (r & 3) + 8 * (r >> 2) + 4 * hi); sc[kt][r] = __uint_as_float((__float_as_uint(sc[kt][r]) & ~127u) | (127u - key)); }
#pragma unroll
    for (int rd = 0; rd < 16; ++rd) {
        float m = max3f_(sc[0][0], sc[0][1], sc[0][2]);
#pragma unroll
        for (int n = 3; n + 1 < 64; n += 2) m = max3f_(m, sc[n >> 4][n & 15], sc[(n + 1) >> 4][(n + 1) & 15]);
        m = __builtin_fmaxf(m, sc[3][15]);
        const float gm = pair_max(m); lst[rd] = gm;
#pragma unroll
        for (int kt = 0; kt < 4; ++kt)
#pragma unroll
            for (int r = 0; r < 16; ++r) sc[kt][r] = (__float_as_uint(sc[kt][r]) == __float_as_uint(gm)) ? -INFINITY : sc[kt][r];
    }
}
typedef float f32x2v __attribute__((ext_vector_type(2)));
__device__ __forceinline__ unsigned pk4_fp8(float a, float b, float c, float d) { int p = __builtin_amdgcn_cvt_pk_fp8_f32(a, b, 0, false); p = __builtin_amdgcn_cvt_pk_fp8_f32(c, d, p, true); return (unsigned)p; }
constexpr float U8_SCALE = 64.f;
typedef short bf16x8_l __attribute__((ext_vector_type(8)));
template <int PASS> __device__ __forceinline__ void lru_phase(const Frame& F, unsigned char* ws, const float* conv_w, const float* conv_b, const float* b_a, const float* b_x, const float* lru_lambda) {
    constexpr int XS = 272;
    LAS unsigned char* xs = F.lds + RING_OFF;
    const bf16* XR = (const bf16*)(ws + WS_XR); const bf16* XG = (const bf16*)(ws + WS_XG); bf16* MIX = (bf16*)(ws + WS_MIX); const bf16* WGT = (const bf16*)(ws + WS_WG);
    float* TA = (float*)(ws + WS_TOTA); float* TH = (float*)(ws + WS_TOTH);
    const int tid = F.tid, lane = F.lane, w = F.wave, l15 = lane & 15, g = lane >> 4;
    const int hb = F.vcu & 7;
    const int nun = 2048 / 8;
    const int gi = F.vcu >> 3, gn = (F.G + 7 - hb) >> 3;
    const int chc = tid & 127, tg = tid >> 7, colc = hb * 128 + chc;
    const float cw0 = conv_w[colc], cw1 = conv_w[1024 + colc], cw2 = conv_w[2048 + colc], cw3 = conv_w[3072 + colc], cb = conv_b[colc];
    const int chn = hb * 128 + 16 * w + l15;
    bf16x8_l Ba[4], Bx[4];
#pragma unroll
    for (int ks = 0; ks < 4; ++ks) { Ba[ks] = *(const bf16x8_l*)(WGT + ((size_t)(hb * 128 + 16 * w + l15)) * 128 + 32 * ks + 8 * g); Bx[ks] = *(const bf16x8_l*)(WGT + ((size_t)((8 + hb) * 128 + 16 * w + l15)) * 128 + 32 * ks + 8 * g); }
    const float ba = b_a[chn], bx = b_x[chn], sp8 = 8.f * log1pf(__expf(-lru_lambda[chn]));
    unsigned short xrn[19], xgn[16]; float tan_[16], thn_[16];
#define LRU_LOAD(uu) do { const int c_ = (uu) & 63, b_ = (uu) >> 6, tok0_ = b_ * SEQ + c_ * 64; \
        _Pragma("unroll") for (int r = 0; r < 19; ++r) xrn[r] = (c_ * 64 + tg * 16 + r - 3 >= 0) ? XR[(size_t)(tok0_ + tg * 16 + r - 3) * AW + colc] : (unsigned short)0; \
        if (PASS == 2) { _Pragma("unroll") for (int m = 0; m < 4; ++m) _Pragma("unroll") for (int r = 0; r < 4; ++r) xgn[4 * m + r] = XG[(size_t)(tok0_ + 16 * m + 4 * g + r) * AW + chn]; \
            _Pragma("unroll") for (int i = 0; i < 16; ++i) { const int c2 = 16 * g + i, cl = c2 < c_ ? c2 : 0; tan_[i] = TA[(b_ * 64 + cl) * 1024 + chn]; thn_[i] = TH[(b_ * 64 + cl) * 1024 + chn]; } } } while (0)
    if (gi < nun) LRU_LOAD(gi);
    for (int uu = gi; uu < nun; uu += gn) {
        const int c = uu & 63, b = uu >> 6, tok0 = b * SEQ + c * 64;
        {
            float xv[19];
#pragma unroll
            for (int r = 0; r < 19; ++r) xv[r] = bf2f(xrn[r]);
#pragma unroll
            for (int i = 0; i < 16; ++i) { const float y = cb + cw0 * xv[i] + cw1 * xv[i + 1] + cw2 * xv[i + 2] + cw3 * xv[i + 3];
                *(LAS unsigned short*)(xs + (tg * 16 + i) * XS + chc * 2) = (unsigned short)f2bf(y); }
        }
        unsigned short xgv[16]; float ta[16], th[16];
        if (PASS == 2) {
#pragma unroll
            for (int i = 0; i < 16; ++i) { xgv[i] = xgn[i]; const int c2 = 16 * g + i; ta[i] = c2 < c ? tan_[i] : 1.f; th[i] = c2 < c ? thn_[i] : 0.f; } }
        __syncthreads();
        if (uu + gn < nun) LRU_LOAD(uu + gn);
        f32x4 ca[4], cx[4];
#pragma unroll
        for (int m = 0; m < 4; ++m) { ca[m] = (f32x4){0.f, 0.f, 0.f, 0.f}; cx[m] = (f32x4){0.f, 0.f, 0.f, 0.f};
#pragma unroll
            for (int ks = 0; ks < 4; ++ks) { const bf16x8_l A = *(const LAS bf16x8_l*)(xs + (16 * m + l15) * XS + (32 * ks + 8 * g) * 2);
                ca[m] = __builtin_amdgcn_mfma_f32_16x16x32_bf16(A, Ba[ks], ca[m], 0, 0, 0); cx[m] = __builtin_amdgcn_mfma_f32_16x16x32_bf16(A, Bx[ks], cx[m], 0, 0, 0); } }
        float av[4][4], bv[4][4];
#pragma unroll
        for (int m = 0; m < 4; ++m)
#pragma unroll
            for (int r = 0; r < 4; ++r) { const int tt = 16 * m + 4 * g + r;
                const float rg = 1.f / (1.f + __expf(-(ca[m][r] + ba))), ig = 1.f / (1.f + __expf(-(cx[m][r] + bx)));
                const float a = __expf(-sp8 * rg), xcv = bf2f(*(const LAS unsigned short*)(xs + tt * XS + (16 * w + l15) * 2));
                av[m][r] = a; bv[m][r] = sqrtf(fmaxf(1.f - a * a, 0.f)) * ig * xcv; }
        float carry = 0.f, Ac = 1.f;
        if (PASS == 2) {
            float Ap = 1.f, Hp = 0.f;
#pragma unroll
            for (int i = 0; i < 16; ++i) { Hp = ta[i] * Hp + th[i]; Ap *= ta[i]; }
            { const float A1 = __shfl_up(Ap, 16), H1 = __shfl_up(Hp, 16); if (g >= 1) { Hp = Ap * H1 + Hp; Ap = Ap * A1; } }
            { const float A2 = __shfl_up(Ap, 32), H2 = __shfl_up(Hp, 32); if (g >= 2) { Hp = Ap * H2 + Hp; Ap = Ap * A2; } }
            carry = __shfl(Hp, 48 + l15);
        }
#pragma unroll
        for (int m = 0; m < 4; ++m) {
            float As = (av[m][0] * av[m][1]) * (av[m][2] * av[m][3]);
            float Hs = ((bv[m][0] * av[m][1] + bv[m][1]) * av[m][2] + bv[m][2]) * av[m][3] + bv[m][3];
            { const float A1 = __shfl_up(As, 16), H1 = __shfl_up(Hs, 16); if (g >= 1) { Hs = As * H1 + Hs; As = As * A1; } }
            { const float A2 = __shfl_up(As, 32), H2 = __shfl_up(Hs, 32); if (g >= 2) { Hs = As * H2 + Hs; As = As * A2; } }
            const float At = __shfl(As, 48 + l15), Ht = __shfl(Hs, 48 + l15);
            if (PASS == 2) {
                float Ae = __shfl_up(As, 16), He = __shfl_up(Hs, 16); if (g == 0) { Ae = 1.f; He = 0.f; }
                float h = Ae * carry + He;
#pragma unroll
                for (int r = 0; r < 4; ++r) { h = av[m][r] * h + bv[m][r]; const int tt = 16 * m + 4 * g + r;
                    MIX[(size_t)(tok0 + tt) * D + 1024 + chn] = (bf16)f2bf(h * gelu_tanh(bf2f(xgv[4 * m + r]))); }
            }
            carry = At * carry + Ht; Ac *= At;
        }
        if (PASS == 1 && g == 0) { TA[(b * 64 + c) * 1024 + chn] = Ac; TH[(b * 64 + c) * 1024 + chn] = carry; }
        __syncthreads();
    }
#undef LRU_LOAD
}
struct Args { const float* in[23]; float* out; unsigned char* ws; int ph_lo, ph_hi; };

__global__ void __launch_bounds__(NWAVES * 64, 2) skel_fwd(Args args) {
    extern __shared__ __attribute__((aligned(16))) unsigned char lds[];
    Frame F;
    F.lds = (LAS unsigned char*)lds;
    F.tid = threadIdx.x; F.lane = F.tid & 63; F.wave = __builtin_amdgcn_readfirstlane(F.tid >> 6);
    F.G = gridDim.x; { const int bx = blockIdx.x; F.vcu = (F.G % 8 == 0) ? (bx % 8) * (F.G / 8) + bx / 8 : bx; }
    unsigned char* ws = args.ws;
    const float* x = args.in[0];
    bf16* WIN_T = (bf16*)(ws + WS_WIN); bf16* WOUT_T = (bf16*)(ws + WS_WOUT); bf16* WQ_T = (bf16*)(ws + WS_WQ);
    bf16* XB = (bf16*)(ws + WS_XB); bf16* MIX = (bf16*)(ws + WS_MIX); bf16* QB = (bf16*)(ws + WS_Q); bf16* H1 = (bf16*)(ws + WS_H1);
    float* Y1 = (float*)(ws + WS_Y1); float* PQ = (float*)(ws + WS_PQ);
    for (int u = F.tid; u < (LDS_BYTES - LDSCTL_OFF) / 4; u += NWAVES * 64) ((LAS unsigned*)(F.lds + LDSCTL_OFF))[u] = 0u;
    __syncthreads();
    XcdBarrier bar = xcd_barrier_post((unsigned*)(ws + WS_CTL) + CW_BAR, (volatile LAS unsigned*)(F.lds + MISC_OFF) + 8);
    const unsigned phmask = (unsigned)args.ph_lo;
    int slot_ = 0;
#define IN(k) (false)
#define RUN(slotbit) ((phmask >> (slotbit)) & 1u)
#define GRID_BAR() do { if (phmask == 0xffffffffu) xcd_barrier(bar); } while (0)

    if (RUN(0)) {
        if (blockIdx.x == 0 && F.wave == 0) {
            float a_ = args.in[9][F.lane] * args.in[10][F.lane], b_ = args.in[11][F.lane] * args.in[12][F.lane];
#pragma unroll
            for (int o = 1; o < 64; o <<= 1) { a_ += __shfl_xor(a_, o); b_ += __shfl_xor(b_, o); }
            if (F.lane == 0) ((float*)(ws + WS_PRM))[0] = expf(a_) - expf(b_) + 0.2f;
        }
        LAS float* scr = (LAS float*)(F.lds + RING_OFF + F.wave * 16384);
        const int gw = F.vcu * NWAVES + F.wave, NGW = F.G * NWAVES;
        constexpr int I_IN = (D / 64) * (NIN / 32), I_SQ = (D / 64) * (D / 32);
        constexpr int NITEMS = I_IN + 2 * I_SQ;
        for (int it = gw; it < NITEMS; it += NGW) {
            int r = it;
            if (r < I_IN) { p0_transpose_item(args.in[1], D, NIN, WIN_T, 0, scr, r, F.lane); continue; } r -= I_IN;
            if (r < I_SQ) { p0_transpose_item(args.in[14], D, D, WOUT_T, 0, scr, r, F.lane); continue; } r -= I_SQ;
            p0_transpose_item(args.in[17], D, D, WQ_T, 0, scr, r, F.lane);
        }
        for (int it = gw; it < 128; it += NGW) { const int mt = it >> 3;
            p0_transpose_item(args.in[mt < 8 ? 4 : 6] + (size_t)(mt & 7) * 16384, 128, 128, (bf16*)(ws + WS_WG) + (size_t)mt * 16384, 0, scr, it & 7, F.lane); }
        {
            const float* sk = args.in[18]; v4u* SKH = (v4u*)(ws + WS_SKH); v4u* SKL = (v4u*)(ws + WS_SKL);
            for (int fi = gw; fi < 512; fi += NGW) { const int ds = fi & 7, kt = (fi >> 3) & 3, hp = fi >> 5;
                const float* src = sk + ((size_t)(hp * 128 + kt * 32 + (F.lane & 31)) * 128 + 16 * ds + 8 * (F.lane >> 5));
                bf16x8 h8, l8; split8(*(const f32x4*)src, *(const f32x4*)(src + 4), h8, l8);
                SKH[fi * 64 + F.lane] = __builtin_bit_cast(v4u, h8); SKL[fi * 64 + F.lane] = __builtin_bit_cast(v4u, l8); }
        }
        for (int m = gw; m < M; m += NGW) {
            const GAS f32x4* xr = (const GAS f32x4*)(x + (size_t)m * D) + F.lane;
            GAS unsigned long long* o8 = (GAS unsigned long long*)(XB + (size_t)m * D) + F.lane;
#pragma unroll
            for (int j = 0; j < 8; ++j) { const f32x4 v = xr[64 * j]; o8[64 * j] = (unsigned long long)pk2(v.x, v.y) | ((unsigned long long)pk2(v.z, v.w) << 32); }
        }
    }
    GRID_BAR();
    if (RUN(1)) {
        pg8::Gemm g{XB, WIN_T, M, NIN, D}; pg8::StaticOrder S; S.init(M, NIN, F.G, (int)blockIdx.x);
        pg8::EpiBf16<0> E{QB, AW, nullptr, AW, (size_t)(WS_K - WS_Q) / 2, C2};
        pg8::gemm_phase<pg8::EpiBf16<0>, pg8::StaticOrder, PG8_ALIGN, PG8_SP2>(F.lds + RING_OFF, g, S, E);
    }
    GRID_BAR();
    if (RUN(2)) { lru_phase<1>(F, ws, args.in[2], args.in[3], args.in[5], args.in[7], args.in[8]);
        {
            const int gw = F.vcu * NWAVES + F.wave, NGW = F.G * NWAVES, lane = F.lane; unsigned* ctlw = (unsigned*)(ws + WS_CTL);
            for (int it = gw; it < 2 * (M / 16); it += NGW) { const int z = it & 1, r16 = it >> 1; const bf16* src = (const bf16*)(ws + (z ? WS_K : WS_Q)) + (size_t)r16 * 16 * AW + 8 * lane;
                float mx0 = 0.f, mx1 = 0.f;
#pragma unroll 4
                for (int r = 0; r < 16; ++r) {
#pragma unroll
                    for (int hf = 0; hf < 2; ++hf) { const v4u q = *(const v4u*)(src + (size_t)r * AW + hf * 512); float ss = 0.f;
#pragma unroll
                        for (int e = 0; e < 4; ++e) { const float lo = __uint_as_float(q[e] << 16), hi = __uint_as_float(q[e] & 0xffff0000u); ss += lo * lo + hi * hi; }
                        ss += __builtin_bit_cast(float, __builtin_amdgcn_update_dpp(0, __builtin_bit_cast(int, ss), 0xB1, 0xf, 0xf, true)); ss += __builtin_bit_cast(float, __builtin_amdgcn_update_dpp(0, __builtin_bit_cast(int, ss), 0x4E, 0xf, 0xf, true));
                        ss += __builtin_bit_cast(float, __builtin_amdgcn_update_dpp(0, __builtin_bit_cast(int, ss), 0x141, 0xf, 0xf, true));
                        if (hf == 0) mx0 = fmaxf(mx0, ss); else mx1 = fmaxf(mx1, ss); } }
                if ((lane & 7) == 0) { unsigned* dst = ctlw + (z ? CW_NK : CW_NQ) + (r16 >> 2) * 16 + (lane >> 3); atomicMax(dst, __float_as_uint(mx0)); atomicMax(dst + 8, __float_as_uint(mx1)); }
            }
        }
    }
    GRID_BAR();
    if (RUN(4)) {
        static_assert(datt::LDS_BYTES <= RING_BYTES, "attention LDS vs ring");
        const datt::Tensors DT{(const datt::bf16*)QB, (const datt::bf16*)(ws + WS_K), (const datt::bf16*)(ws + WS_V), (datt::bf16*)(ws + WS_O0), (datt::bf16*)(ws + WS_O1),
                               (const unsigned*)(ws + WS_CTL) + CW_NQ, (const unsigned*)(ws + WS_CTL) + CW_NK, (unsigned*)(ws + WS_CTL) + CW_AQ, datt_order};
        datt::datt_phase((char*)lds + RING_OFF, (volatile LAS unsigned*)(F.lds + MISC_OFF) + 16, DT);
    }
    if (RUN(5)) lru_phase<2>(F, ws, args.in[2], args.in[3], args.in[5], args.in[7], args.in[8]);
    GRID_BAR();
    if (RUN(6)) {
        const int gw = F.vcu * NWAVES + F.wave, NGW = F.G * NWAVES;
        const float lam = ((const float*)(ws + WS_PRM))[0];
        const bf16* O0 = (const bf16*)(ws + WS_O0); const bf16* O1 = (const bf16*)(ws + WS_O1);
        const float g0 = args.in[13][2 * F.lane] * 0.8f, g1 = args.in[13][2 * F.lane + 1] * 0.8f;
        for (int it = gw; it < M * 8; it += NGW) { const int tok = it >> 3, h = it & 7;
            const unsigned a = *(const unsigned*)(O0 + (size_t)tok * AW + h * 128 + 2 * F.lane), b = *(const unsigned*)(O1 + (size_t)tok * AW + h * 128 + 2 * F.lane);
            const float d0 = bf2f((unsigned short)(a & 0xffff)) - lam * bf2f((unsigned short)(b & 0xffff)), d1 = bf2f((unsigned short)(a >> 16)) - lam * bf2f((unsigned short)(b >> 16));
            float ss = d0 * d0 + d1 * d1;
#pragma unroll
            for (int o = 1; o < 64; o <<= 1) ss += __shfl_xor(ss, o);
            const float r = rsqrtf(ss * (1.f / 128.f) + LN_EPS);
            *(unsigned*)(MIX + (size_t)tok * D + h * 128 + 2 * F.lane) = pk2(d0 * r * g0, d1 * r * g1); }
    }
    GRID_BAR();
    if (RUN(7)) {
        pg8::Gemm g{MIX, WOUT_T, M, D, D}; pg8::StaticOrder S; S.init(M, D, F.G, (int)blockIdx.x);
        pg8::EpiBf16<0> E{(bf16*)Y1, D, nullptr, 0, 0, 1.f};
        pg8::gemm_phase<pg8::EpiBf16<0>, pg8::StaticOrder, PG8_ALIGN, PG8_SP2>(F.lds + RING_OFF, g, S, E);
    }
    GRID_BAR();
    if (RUN(8)) {
        const int gw = F.vcu * NWAVES + F.wave, NGW = F.G * NWAVES; const float* g = args.in[15]; const float* bb = args.in[16];
        for (int row = gw; row < M; row += NGW) {
            const f32x4* xr_ = (const f32x4*)(x + (size_t)row * D); const unsigned long long* yb = (const unsigned long long*)((const bf16*)Y1 + (size_t)row * D);
            f32x4 v[8]; float s = 0.f;
#pragma unroll
            for (int j = 0; j < 8; ++j) { const f32x4 xv_ = xr_[F.lane + 64 * j]; const unsigned long long q_ = yb[F.lane + 64 * j]; const unsigned q0 = (unsigned)q_, q1 = (unsigned)(q_ >> 32);
                v[j].x = DN_ALPHA * xv_.x + __uint_as_float(q0 << 16); v[j].y = DN_ALPHA * xv_.y + __uint_as_float(q0 & 0xffff0000u); v[j].z = DN_ALPHA * xv_.z + __uint_as_float(q1 << 16); v[j].w = DN_ALPHA * xv_.w + __uint_as_float(q1 & 0xffff0000u);
                s += (v[j].x + v[j].y) + (v[j].z + v[j].w); }
#pragma unroll
            for (int o = 1; o < 64; o <<= 1) s += __shfl_xor(s, o);
            const float mean = s * (1.f / D); float s2 = 0.f;
#pragma unroll
            for (int j = 0; j < 8; ++j) { v[j] = v[j] - mean; s2 += (v[j].x * v[j].x + v[j].y * v[j].y) + (v[j].z * v[j].z + v[j].w * v[j].w); }
#pragma unroll
            for (int o = 1; o < 64; o <<= 1) s2 += __shfl_xor(s2, o);
            const float rstd = rsqrtf(s2 * (1.f / D) + LN_EPS);
#pragma unroll
            for (int j = 0; j < 8; ++j) { const int c = (F.lane + 64 * j) * 4; const f32x4 gg = *(const f32x4*)(g + c), bv = *(const f32x4*)(bb + c);
                const f32x4 o = v[j] * rstd * gg + bv;
                *(unsigned long long*)(H1 + (size_t)row * D + c) = (unsigned long long)pk2(o.x, o.y) | ((unsigned long long)pk2(o.z, o.w) << 32);
                v[j] = o; }
            float am = 0.f;
#pragma unroll
            for (int j = 0; j < 8; ++j) am = fmaxf(fmaxf(am, fmaxf(fabsf(v[j].x), fabsf(v[j].y))), fmaxf(fabsf(v[j].z), fabsf(v[j].w)));
#pragma unroll
            for (int o = 1; o < 64; o <<= 1) am = fmaxf(am, __shfl_xor(am, o));
            const float qs = am > 0.f ? 127.f / am : 0.f;
            if (F.lane == 0) ((float*)(ws + WS_SH))[row] = am * (1.f / 127.f);
#pragma unroll
            for (int j = 0; j < 8; ++j) { const int c = (F.lane + 64 * j) * 4;
                const unsigned q = ((unsigned)(int)rintf(v[j].x * qs) & 0xffu) | (((unsigned)(int)rintf(v[j].y * qs) & 0xffu) << 8) | (((unsigned)(int)rintf(v[j].z * qs) & 0xffu) << 16) | (((unsigned)(int)rintf(v[j].w * qs) & 0xffu) << 24);
                *(unsigned*)(ws + WS_H8 + ((size_t)(c >> 7) * M + row) * 128 + (c & 127)) = q; }
        }
        {
            const float* us = args.in[19]; float* SU = (float*)(ws + WS_SU);
            for (int e = gw; e < 16384; e += NGW) {
                const f32x4* ur = (const f32x4*)(us + (size_t)e * D); f32x4 uv[8]; float am = 0.f;
#pragma unroll
                for (int j = 0; j < 8; ++j) { uv[j] = ur[F.lane + 64 * j]; am = fmaxf(fmaxf(am, fmaxf(fabsf(uv[j].x), fabsf(uv[j].y))), fmaxf(fabsf(uv[j].z), fabsf(uv[j].w))); }
#pragma unroll
                for (int o = 1; o < 64; o <<= 1) am = fmaxf(am, __shfl_xor(am, o));
                const float qs = am > 0.f ? 127.f / am : 0.f;
                if (F.lane == 0) SU[e] = am * (1.f / 127.f);
#pragma unroll
                for (int j = 0; j < 8; ++j) { const int c = (F.lane + 64 * j) * 4;
                    const unsigned q = ((unsigned)(int)rintf(uv[j].x * qs) & 0xffu) | (((unsigned)(int)rintf(uv[j].y * qs) & 0xffu) << 8) | (((unsigned)(int)rintf(uv[j].z * qs) & 0xffu) << 16) | (((unsigned)(int)rintf(uv[j].w * qs) & 0xffu) << 24);
                    *(unsigned*)(ws + WS_U8 + ((size_t)(c >> 7) * 16384 + e) * 128 + (c & 127)) = q; }
            }
        }
        {
            const float* vs = args.in[20]; unsigned char* V8 = ws + WS_V8; LAS unsigned char* tl = F.lds + RING_OFF;
            for (int t = F.vcu; t < 256 * 8; t += F.G) { const int e0 = (t >> 3) * 64, c0 = (t & 7) * 256;
                __syncthreads();
#pragma unroll
                for (int j = 0; j < 8; ++j) { const int idx = F.tid + 512 * j, r = idx >> 6, c = 4 * (idx & 63);
                    const f32x4 v = *(const f32x4*)(vs + (size_t)(e0 + r) * D + c0 + c);
                    *(LAS unsigned*)(tl + (c >> 3) * 512 + r * 8 + (c & 7)) = pk4_fp8(v.x, v.y, v.z, v.w); }
                __syncthreads();
#pragma unroll
                for (int j = 0; j < 2; ++j) { const int cu = (F.tid >> 5) + 16 * j, pc = F.tid & 31;
                    *(v4u*)(V8 + ((size_t)((c0 >> 3) + cu) * 16384 + e0) * 8 + pc * 16) = *(const LAS v4u*)(tl + cu * 512 + pc * 16); }
            }
            __syncthreads();
        }
    }
    GRID_BAR();
    if (RUN(9)) {
        pg8::Gemm g{H1, WQ_T, M, D, D}; pg8::StaticOrder S; S.init(M, D, F.G, (int)blockIdx.x);
        pg8::EpiF32 E{PQ, D, nullptr, 0.f};
        pg8::gemm_phase<pg8::EpiF32, pg8::StaticOrder, PG8_ALIGN, PG8_SP2>(F.lds + RING_OFF, g, S, E);
    }
    GRID_BAR();
    if (RUN(10)) {
        const int nh = (F.G & 7) == 0 ? 8 : 1;
        int* E = (int*)(ws + WS_E); float* G = (float*)(ws + WS_G);
        for (int h = F.vcu % nh; h < 8; h += nh) {
            __syncthreads();
            {
                int tq = F.tid; asm volatile("" : "+v"(tq));
#pragma unroll 4
                for (int j = 0; j < 16; ++j) { const int i = tq + 512 * j, p = i >> 12, hl = (i >> 11) & 1, fl = i & 2047;
                    *(LAS v4u*)(F.lds + RING_OFF + (size_t)i * 16) = ((const v4u*)(ws + WS_SKH))[(size_t)hl * 65536 + (size_t)(h * 2 + p) * 2048 + fl]; }
            }
            __syncthreads();
            const int wv = (F.vcu / nh) * NWAVES + F.wave, nwv = ((F.G + nh - 1 - F.vcu % nh) / nh) * NWAVES;
            f32x4 qn[16];
#define ROUTE_LOADQ() do { _Pragma("unroll") for (int ds = 0; ds < 8; ++ds) { qn[2 * ds] = *(const f32x4*)(qptr + 16 * ds); qn[2 * ds + 1] = *(const f32x4*)(qptr + 16 * ds + 4); } } while (0)
            const float* qptr = PQ + (size_t)(wv * 32 + (F.lane & 31)) * D + h * 256 + 8 * (F.lane >> 5);
            if (wv < M / 32) ROUTE_LOADQ();
            for (int tg = wv; tg < M / 32; tg += nwv) { int ln_ = F.lane; asm volatile("" : "+v"(ln_));
                const int tl = ln_ & 31, hi = ln_ >> 5, tok = tg * 32 + tl;
                LAS unsigned char* scr = F.lds + RING_BYTES + 1024 + F.wave * 1024 + tl * 32;
                float sa[16], sb[16];
#pragma unroll
                for (int p = 0; p < 2; ++p) {
                    f32x16 sc[4];
#pragma unroll
                    for (int kt = 0; kt < 4; ++kt) sc[kt] = f32x16{};
#pragma unroll
                    for (int ds = 0; ds < 8; ++ds) { bf16x8 qh, ql; split8(qn[2 * ds], qn[2 * ds + 1], qh, ql);
#pragma unroll
                        for (int kt = 0; kt < 4; ++kt) { const bf16x8 ah = *(const LAS bf16x8*)(F.lds + RING_OFF + ((p * 2 + 0) * 32 + kt * 8 + ds) * 1024 + F.lane * 16), al = *(const LAS bf16x8*)(F.lds + RING_OFF + ((p * 2 + 1) * 32 + kt * 8 + ds) * 1024 + F.lane * 16);
                            sc[kt] = __builtin_amdgcn_mfma_f32_32x32x16_bf16(ah, qh, sc[kt], 0, 0, 0);
                            sc[kt] = __builtin_amdgcn_mfma_f32_32x32x16_bf16(ah, ql, sc[kt], 0, 0, 0);
                            sc[kt] = __builtin_amdgcn_mfma_f32_32x32x16_bf16(al, qh, sc[kt], 0, 0, 0); } }
                    if (p == 0) { qptr += 128; ROUTE_LOADQ(); } else if (tg + nwv < M / 32) { qptr += (size_t)nwv * 32 * D - 128; ROUTE_LOADQ(); }
#pragma unroll
                    for (int kt = 0; kt < 4; ++kt)
#pragma unroll
                        for (int r = 0; r < 16; ++r) { const unsigned key = (unsigned)(kt * 32 + (r & 3) + 8 * (r >> 2) + 4 * hi); sc[kt][r] = __uint_as_float((__float_as_uint(sc[kt][r]) & ~127u) | (127u - key)); }
#define CE_(x, y) do { const float h_ = __builtin_fmaxf(x, y), l_ = __builtin_fminf(x, y); x = h_; y = l_; } while (0)
                    CE_(sc[0][0], sc[0][1]); CE_(sc[0][2], sc[0][3]); CE_(sc[0][0], sc[0][2]); CE_(sc[0][1], sc[0][3]); CE_(sc[0][1], sc[0][2]); CE_(sc[0][4], sc[0][5]); CE_(sc[0][6], sc[0][7]); CE_(sc[0][4], sc[0][6]); CE_(sc[0][5], sc[0][7]); CE_(sc[0][5], sc[0][6]); CE_(sc[0][0], sc[0][4]); CE_(sc[0][2], sc[0][6]); CE_(sc[0][2], sc[0][4]); CE_(sc[0][1], sc[0][5]); CE_(sc[0][3], sc[0][7]); CE_(sc[0][3], sc[0][5]); CE_(sc[0][1], sc[0][2]); CE_(sc[0][3], sc[0][4]); CE_(sc[0][5], sc[0][6]); CE_(sc[0][8], sc[0][9]); CE_(sc[0][10], sc[0][11]); CE_(sc[0][8], sc[0][10]); CE_(sc[0][9], sc[0][11]); CE_(sc[0][9], sc[0][10]); CE_(sc[0][12], sc[0][13]); CE_(sc[0][14], sc[0][15]); CE_(sc[0][12], sc[0][14]); CE_(sc[0][13], sc[0][15]); CE_(sc[0][13], sc[0][14]); CE_(sc[0][8], sc[0][12]); CE_(sc[0][10], sc[0][14]); CE_(sc[0][10], sc[0][12]); CE_(sc[0][9], sc[0][13]); CE_(sc[0][11], sc[0][15]); CE_(sc[0][11], sc[0][13]); CE_(sc[0][9], sc[0][10]); CE_(sc[0][11], sc[0][12]); CE_(sc[0][13], sc[0][14]); CE_(sc[0][0], sc[0][8]); CE_(sc[0][4], sc[0][12]); CE_(sc[0][4], sc[0][8]); CE_(sc[0][2], sc[0][10]); CE_(sc[0][6], sc[0][14]); CE_(sc[0][6], sc[0][10]); CE_(sc[0][2], sc[0][4]); CE_(sc[0][6], sc[0][8]); CE_(sc[0][10], sc[0][12]); CE_(sc[0][1], sc[0][9]); CE_(sc[0][5], sc[0][13]); CE_(sc[0][5], sc[0][9]); CE_(sc[0][3], sc[0][11]); CE_(sc[0][7], sc[0][15]); CE_(sc[0][7], sc[0][11]); CE_(sc[0][3], sc[0][5]); CE_(sc[0][7], sc[0][9]); CE_(sc[0][11], sc[0][13]); CE_(sc[0][1], sc[0][2]); CE_(sc[0][3], sc[0][4]); CE_(sc[0][5], sc[0][6]); CE_(sc[0][7], sc[0][8]); CE_(sc[0][9], sc[0][10]); CE_(sc[0][11], sc[0][12]); CE_(sc[0][13], sc[0][14]);
                    CE_(sc[1][0], sc[1][1]); CE_(sc[1][2], sc[1][3]); CE_(sc[1][0], sc[1][2]); CE_(sc[1][1], sc[1][3]); CE_(sc[1][1], sc[1][2]); CE_(sc[1][4], sc[1][5]); CE_(sc[1][6], sc[1][7]); CE_(sc[1][4], sc[1][6]); CE_(sc[1][5], sc[1][7]); CE_(sc[1][5], sc[1][6]); CE_(sc[1][0], sc[1][4]); CE_(sc[1][2], sc[1][6]); CE_(sc[1][2], sc[1][4]); CE_(sc[1][1], sc[1][5]); CE_(sc[1][3], sc[1][7]); CE_(sc[1][3], sc[1][5]); CE_(sc[1][1], sc[1][2]); CE_(sc[1][3], sc[1][4]); CE_(sc[1][5], sc[1][6]); CE_(sc[1][8], sc[1][9]); CE_(sc[1][10], sc[1][11]); CE_(sc[1][8], sc[1][10]); CE_(sc[1][9], sc[1][11]); CE_(sc[1][9], sc[1][10]); CE_(sc[1][12], sc[1][13]); CE_(sc[1][14], sc[1][15]); CE_(sc[1][12], sc[1][14]); CE_(sc[1][13], sc[1][15]); CE_(sc[1][13], sc[1][14]); CE_(sc[1][8], sc[1][12]); CE_(sc[1][10], sc[1][14]); CE_(sc[1][10], sc[1][12]); CE_(sc[1][9], sc[1][13]); CE_(sc[1][11], sc[1][15]); CE_(sc[1][11], sc[1][13]); CE_(sc[1][9], sc[1][10]); CE_(sc[1][11], sc[1][12]); CE_(sc[1][13], sc[1][14]); CE_(sc[1][0], sc[1][8]); CE_(sc[1][4], sc[1][12]); CE_(sc[1][4], sc[1][8]); CE_(sc[1][2], sc[1][10]); CE_(sc[1][6], sc[1][14]); CE_(sc[1][6], sc[1][10]); CE_(sc[1][2], sc[1][4]); CE_(sc[1][6], sc[1][8]); CE_(sc[1][10], sc[1][12]); CE_(sc[1][1], sc[1][9]); CE_(sc[1][5], sc[1][13]); CE_(sc[1][5], sc[1][9]); CE_(sc[1][3], sc[1][11]); CE_(sc[1][7], sc[1][15]); CE_(sc[1][7], sc[1][11]); CE_(sc[1][3], sc[1][5]); CE_(sc[1][7], sc[1][9]); CE_(sc[1][11], sc[1][13]); CE_(sc[1][1], sc[1][2]); CE_(sc[1][3], sc[1][4]); CE_(sc[1][5], sc[1][6]); CE_(sc[1][7], sc[1][8]); CE_(sc[1][9], sc[1][10]); CE_(sc[1][11], sc[1][12]); CE_(sc[1][13], sc[1][14]);
                    CE_(sc[2][0], sc[2][1]); CE_(sc[2][2], sc[2][3]); CE_(sc[2][0], sc[2][2]); CE_(sc[2][1], sc[2][3]); CE_(sc[2][1], sc[2][2]); CE_(sc[2][4], sc[2][5]); CE_(sc[2][6], sc[2][7]); CE_(sc[2][4], sc[2][6]); CE_(sc[2][5], sc[2][7]); CE_(sc[2][5], sc[2][6]); CE_(sc[2][0], sc[2][4]); CE_(sc[2][2], sc[2][6]); CE_(sc[2][2], sc[2][4]); CE_(sc[2][1], sc[2][5]); CE_(sc[2][3], sc[2][7]); CE_(sc[2][3], sc[2][5]); CE_(sc[2][1], sc[2][2]); CE_(sc[2][3], sc[2][4]); CE_(sc[2][5], sc[2][6]); CE_(sc[2][8], sc[2][9]); CE_(sc[2][10], sc[2][11]); CE_(sc[2][8], sc[2][10]); CE_(sc[2][9], sc[2][11]); CE_(sc[2][9], sc[2][10]); CE_(sc[2][12], sc[2][13]); CE_(sc[2][14], sc[2][15]); CE_(sc[2][12], sc[2][14]); CE_(sc[2][13], sc[2][15]); CE_(sc[2][13], sc[2][14]); CE_(sc[2][8], sc[2][12]); CE_(sc[2][10], sc[2][14]); CE_(sc[2][10], sc[2][12]); CE_(sc[2][9], sc[2][13]); CE_(sc[2][11], sc[2][15]); CE_(sc[2][11], sc[2][13]); CE_(sc[2][9], sc[2][10]); CE_(sc[2][11], sc[2][12]); CE_(sc[2][13], sc[2][14]); CE_(sc[2][0], sc[2][8]); CE_(sc[2][4], sc[2][12]); CE_(sc[2][4], sc[2][8]); CE_(sc[2][2], sc[2][10]); CE_(sc[2][6], sc[2][14]); CE_(sc[2][6], sc[2][10]); CE_(sc[2][2], sc[2][4]); CE_(sc[2][6], sc[2][8]); CE_(sc[2][10], sc[2][12]); CE_(sc[2][1], sc[2][9]); CE_(sc[2][5], sc[2][13]); CE_(sc[2][5], sc[2][9]); CE_(sc[2][3], sc[2][11]); CE_(sc[2][7], sc[2][15]); CE_(sc[2][7], sc[2][11]); CE_(sc[2][3], sc[2][5]); CE_(sc[2][7], sc[2][9]); CE_(sc[2][11], sc[2][13]); CE_(sc[2][1], sc[2][2]); CE_(sc[2][3], sc[2][4]); CE_(sc[2][5], sc[2][6]); CE_(sc[2][7], sc[2][8]); CE_(sc[2][9], sc[2][10]); CE_(sc[2][11], sc[2][12]); CE_(sc[2][13], sc[2][14]);
                    CE_(sc[3][0], sc[3][1]); CE_(sc[3][2], sc[3][3]); CE_(sc[3][0], sc[3][2]); CE_(sc[3][1], sc[3][3]); CE_(sc[3][1], sc[3][2]); CE_(sc[3][4], sc[3][5]); CE_(sc[3][6], sc[3][7]); CE_(sc[3][4], sc[3][6]); CE_(sc[3][5], sc[3][7]); CE_(sc[3][5], sc[3][6]); CE_(sc[3][0], sc[3][4]); CE_(sc[3][2], sc[3][6]); CE_(sc[3][2], sc[3][4]); CE_(sc[3][1], sc[3][5]); CE_(sc[3][3], sc[3][7]); CE_(sc[3][3], sc[3][5]); CE_(sc[3][1], sc[3][2]); CE_(sc[3][3], sc[3][4]); CE_(sc[3][5], sc[3][6]); CE_(sc[3][8], sc[3][9]); CE_(sc[3][10], sc[3][11]); CE_(sc[3][8], sc[3][10]); CE_(sc[3][9], sc[3][11]); CE_(sc[3][9], sc[3][10]); CE_(sc[3][12], sc[3][13]); CE_(sc[3][14], sc[3][15]); CE_(sc[3][12], sc[3][14]); CE_(sc[3][13], sc[3][15]); CE_(sc[3][13], sc[3][14]); CE_(sc[3][8], sc[3][12]); CE_(sc[3][10], sc[3][14]); CE_(sc[3][10], sc[3][12]); CE_(sc[3][9], sc[3][13]); CE_(sc[3][11], sc[3][15]); CE_(sc[3][11], sc[3][13]); CE_(sc[3][9], sc[3][10]); CE_(sc[3][11], sc[3][12]); CE_(sc[3][13], sc[3][14]); CE_(sc[3][0], sc[3][8]); CE_(sc[3][4], sc[3][12]); CE_(sc[3][4], sc[3][8]); CE_(sc[3][2], sc[3][10]); CE_(sc[3][6], sc[3][14]); CE_(sc[3][6], sc[3][10]); CE_(sc[3][2], sc[3][4]); CE_(sc[3][6], sc[3][8]); CE_(sc[3][10], sc[3][12]); CE_(sc[3][1], sc[3][9]); CE_(sc[3][5], sc[3][13]); CE_(sc[3][5], sc[3][9]); CE_(sc[3][3], sc[3][11]); CE_(sc[3][7], sc[3][15]); CE_(sc[3][7], sc[3][11]); CE_(sc[3][3], sc[3][5]); CE_(sc[3][7], sc[3][9]); CE_(sc[3][11], sc[3][13]); CE_(sc[3][1], sc[3][2]); CE_(sc[3][3], sc[3][4]); CE_(sc[3][5], sc[3][6]); CE_(sc[3][7], sc[3][8]); CE_(sc[3][9], sc[3][10]); CE_(sc[3][11], sc[3][12]); CE_(sc[3][13], sc[3][14]);
                    sc[0][0] = __builtin_fmaxf(sc[0][0], sc[1][15]); sc[0][1] = __builtin_fmaxf(sc[0][1], sc[1][14]); sc[0][2] = __builtin_fmaxf(sc[0][2], sc[1][13]); sc[0][3] = __builtin_fmaxf(sc[0][3], sc[1][12]); sc[0][4] = __builtin_fmaxf(sc[0][4], sc[1][11]); sc[0][5] = __builtin_fmaxf(sc[0][5], sc[1][10]); sc[0][6] = __builtin_fmaxf(sc[0][6], sc[1][9]); sc[0][7] = __builtin_fmaxf(sc[0][7], sc[1][8]); sc[0][8] = __builtin_fmaxf(sc[0][8], sc[1][7]); sc[0][9] = __builtin_fmaxf(sc[0][9], sc[1][6]); sc[0][10] = __builtin_fmaxf(sc[0][10], sc[1][5]); sc[0][11] = __builtin_fmaxf(sc[0][11], sc[1][4]); sc[0][12] = __builtin_fmaxf(sc[0][12], sc[1][3]); sc[0][13] = __builtin_fmaxf(sc[0][13], sc[1][2]); sc[0][14] = __builtin_fmaxf(sc[0][14], sc[1][1]); sc[0][15] = __builtin_fmaxf(sc[0][15], sc[1][0]);
                    CE_(sc[0][0], sc[0][8]); CE_(sc[0][1], sc[0][9]); CE_(sc[0][2], sc[0][10]); CE_(sc[0][3], sc[0][11]); CE_(sc[0][4], sc[0][12]); CE_(sc[0][5], sc[0][13]); CE_(sc[0][6], sc[0][14]); CE_(sc[0][7], sc[0][15]); CE_(sc[0][0], sc[0][4]); CE_(sc[0][1], sc[0][5]); CE_(sc[0][2], sc[0][6]); CE_(sc[0][3], sc[0][7]); CE_(sc[0][8], sc[0][12]); CE_(sc[0][9], sc[0][13]); CE_(sc[0][10], sc[0][14]); CE_(sc[0][11], sc[0][15]); CE_(sc[0][0], sc[0][2]); CE_(sc[0][1], sc[0][3]); CE_(sc[0][4], sc[0][6]); CE_(sc[0][5], sc[0][7]); CE_(sc[0][8], sc[0][10]); CE_(sc[0][9], sc[0][11]); CE_(sc[0][12], sc[0][14]); CE_(sc[0][13], sc[0][15]); CE_(sc[0][0], sc[0][1]); CE_(sc[0][2], sc[0][3]); CE_(sc[0][4], sc[0][5]); CE_(sc[0][6], sc[0][7]); CE_(sc[0][8], sc[0][9]); CE_(sc[0][10], sc[0][11]); CE_(sc[0][12], sc[0][13]); CE_(sc[0][14], sc[0][15]);
                    sc[2][0] = __builtin_fmaxf(sc[2][0], sc[3][15]); sc[2][1] = __builtin_fmaxf(sc[2][1], sc[3][14]); sc[2][2] = __builtin_fmaxf(sc[2][2], sc[3][13]); sc[2][3] = __builtin_fmaxf(sc[2][3], sc[3][12]); sc[2][4] = __builtin_fmaxf(sc[2][4], sc[3][11]); sc[2][5] = __builtin_fmaxf(sc[2][5], sc[3][10]); sc[2][6] = __builtin_fmaxf(sc[2][6], sc[3][9]); sc[2][7] = __builtin_fmaxf(sc[2][7], sc[3][8]); sc[2][8] = __builtin_fmaxf(sc[2][8], sc[3][7]); sc[2][9] = __builtin_fmaxf(sc[2][9], sc[3][6]); sc[2][10] = __builtin_fmaxf(sc[2][10], sc[3][5]); sc[2][11] = __builtin_fmaxf(sc[2][11], sc[3][4]); sc[2][12] = __builtin_fmaxf(sc[2][12], sc[3][3]); sc[2][13] = __builtin_fmaxf(sc[2][13], sc[3][2]); sc[2][14] = __builtin_fmaxf(sc[2][14], sc[3][1]); sc[2][15] = __builtin_fmaxf(sc[2][15], sc[3][0]);
                    CE_(sc[2][0], sc[2][8]); CE_(sc[2][1], sc[2][9]); CE_(sc[2][2], sc[2][10]); CE_(sc[2][3], sc[2][11]); CE_(sc[2][4], sc[2][12]); CE_(sc[2][5], sc[2][13]); CE_(sc[2][6], sc[2][14]); CE_(sc[2][7], sc[2][15]); CE_(sc[2][0], sc[2][4]); CE_(sc[2][1], sc[2][5]); CE_(sc[2][2], sc[2][6]); CE_(sc[2][3], sc[2][7]); CE_(sc[2][8], sc[2][12]); CE_(sc[2][9], sc[2][13]); CE_(sc[2][10], sc[2][14]); CE_(sc[2][11], sc[2][15]); CE_(sc[2][0], sc[2][2]); CE_(sc[2][1], sc[2][3]); CE_(sc[2][4], sc[2][6]); CE_(sc[2][5], sc[2][7]); CE_(sc[2][8], sc[2][10]); CE_(sc[2][9], sc[2][11]); CE_(sc[2][12], sc[2][14]); CE_(sc[2][13], sc[2][15]); CE_(sc[2][0], sc[2][1]); CE_(sc[2][2], sc[2][3]); CE_(sc[2][4], sc[2][5]); CE_(sc[2][6], sc[2][7]); CE_(sc[2][8], sc[2][9]); CE_(sc[2][10], sc[2][11]); CE_(sc[2][12], sc[2][13]); CE_(sc[2][14], sc[2][15]);
                    sc[0][0] = __builtin_fmaxf(sc[0][0], sc[2][15]); sc[0][1] = __builtin_fmaxf(sc[0][1], sc[2][14]); sc[0][2] = __builtin_fmaxf(sc[0][2], sc[2][13]); sc[0][3] = __builtin_fmaxf(sc[0][3], sc[2][12]); sc[0][4] = __builtin_fmaxf(sc[0][4], sc[2][11]); sc[0][5] = __builtin_fmaxf(sc[0][5], sc[2][10]); sc[0][6] = __builtin_fmaxf(sc[0][6], sc[2][9]); sc[0][7] = __builtin_fmaxf(sc[0][7], sc[2][8]); sc[0][8] = __builtin_fmaxf(sc[0][8], sc[2][7]); sc[0][9] = __builtin_fmaxf(sc[0][9], sc[2][6]); sc[0][10] = __builtin_fmaxf(sc[0][10], sc[2][5]); sc[0][11] = __builtin_fmaxf(sc[0][11], sc[2][4]); sc[0][12] = __builtin_fmaxf(sc[0][12], sc[2][3]); sc[0][13] = __builtin_fmaxf(sc[0][13], sc[2][2]); sc[0][14] = __builtin_fmaxf(sc[0][14], sc[2][1]); sc[0][15] = __builtin_fmaxf(sc[0][15], sc[2][0]);
                    CE_(sc[0][0], sc[0][8]); CE_(sc[0][1], sc[0][9]); CE_(sc[0][2], sc[0][10]); CE_(sc[0][3], sc[0][11]); CE_(sc[0][4], sc[0][12]); CE_(sc[0][5], sc[0][13]); CE_(sc[0][6], sc[0][14]); CE_(sc[0][7], sc[0][15]); CE_(sc[0][0], sc[0][4]); CE_(sc[0][1], sc[0][5]); CE_(sc[0][2], sc[0][6]); CE_(sc[0][3], sc[0][7]); CE_(sc[0][8], sc[0][12]); CE_(sc[0][9], sc[0][13]); CE_(sc[0][10], sc[0][14]); CE_(sc[0][11], sc[0][15]); CE_(sc[0][0], sc[0][2]); CE_(sc[0][1], sc[0][3]); CE_(sc[0][4], sc[0][6]); CE_(sc[0][5], sc[0][7]); CE_(sc[0][8], sc[0][10]); CE_(sc[0][9], sc[0][11]); CE_(sc[0][12], sc[0][14]); CE_(sc[0][13], sc[0][15]); CE_(sc[0][0], sc[0][1]); CE_(sc[0][2], sc[0][3]); CE_(sc[0][4], sc[0][5]); CE_(sc[0][6], sc[0][7]); CE_(sc[0][8], sc[0][9]); CE_(sc[0][10], sc[0][11]); CE_(sc[0][12], sc[0][13]); CE_(sc[0][14], sc[0][15]);
                    { float la[16], lb[16];
#pragma unroll
                      for (int i = 0; i < 16; ++i) { auto rr = __builtin_amdgcn_permlane32_swap(__float_as_uint(sc[0][i]), __float_as_uint(sc[0][i]), false, false); la[i] = __uint_as_float(rr[0]); lb[i] = __uint_as_float(rr[1]); }
#pragma unroll
                      for (int i = 0; i < 16; ++i) la[i] = __builtin_fmaxf(la[i], lb[15 - i]);
                      CE_(la[0], la[8]); CE_(la[1], la[9]); CE_(la[2], la[10]); CE_(la[3], la[11]); CE_(la[4], la[12]); CE_(la[5], la[13]); CE_(la[6], la[14]); CE_(la[7], la[15]); CE_(la[0], la[4]); CE_(la[1], la[5]); CE_(la[2], la[6]); CE_(la[3], la[7]); CE_(la[8], la[12]); CE_(la[9], la[13]); CE_(la[10], la[14]); CE_(la[11], la[15]); CE_(la[0], la[2]); CE_(la[1], la[3]); CE_(la[4], la[6]); CE_(la[5], la[7]); CE_(la[8], la[10]); CE_(la[9], la[11]); CE_(la[12], la[14]); CE_(la[13], la[15]); CE_(la[0], la[1]); CE_(la[2], la[3]); CE_(la[4], la[5]); CE_(la[6], la[7]); CE_(la[8], la[9]); CE_(la[10], la[11]); CE_(la[12], la[13]); CE_(la[14], la[15]);
#pragma unroll
                      for (int i = 0; i < 16; ++i) { if (p == 0) sa[i] = la[i]; else sb[i] = la[i]; } }
#undef CE_
                }
                { unsigned w[4];
    #pragma unroll
                  for (int q = 0; q < 4; ++q) { w[q] = 0u;
    #pragma unroll
                      for (int e = 0; e < 4; ++e) { const unsigned ka = 127u - (__float_as_uint(sa[4 * q + e]) & 127u), kb = 127u - (__float_as_uint(sb[4 * q + e]) & 127u); w[q] |= (hi ? kb : ka) << (8 * e); } }
                  *(LAS v4u*)(scr + 16 * hi) = (v4u){w[0], w[1], w[2], w[3]}; }
                float cd[25];
    #define CV_(i, j) __uint_as_float((__float_as_uint(sa[i] + sb[j]) & ~255u) | (255u - (unsigned)(16 * (i) + (j))))
                cd[0] = hi ? CV_(0, 1) : CV_(0, 0);
                cd[1] = hi ? CV_(0, 3) : CV_(0, 2);
                cd[2] = hi ? CV_(0, 5) : CV_(0, 4);
                cd[3] = hi ? CV_(0, 7) : CV_(0, 6);
                cd[4] = hi ? CV_(0, 9) : CV_(0, 8);
                cd[5] = hi ? CV_(0, 11) : CV_(0, 10);
                cd[6] = hi ? CV_(0, 13) : CV_(0, 12);
                cd[7] = hi ? CV_(0, 15) : CV_(0, 14);
                cd[8] = hi ? CV_(1, 1) : CV_(1, 0);
                cd[9] = hi ? CV_(1, 3) : CV_(1, 2);
                cd[10] = hi ? CV_(1, 5) : CV_(1, 4);
                cd[11] = hi ? CV_(1, 7) : CV_(1, 6);
                cd[12] = hi ? CV_(2, 1) : CV_(2, 0);
                cd[13] = hi ? CV_(2, 3) : CV_(2, 2);
                cd[14] = hi ? CV_(3, 0) : CV_(2, 4);
                cd[15] = hi ? CV_(3, 2) : CV_(3, 1);
                cd[16] = hi ? CV_(4, 0) : CV_(3, 3);
                cd[17] = hi ? CV_(4, 2) : CV_(4, 1);
                cd[18] = hi ? CV_(5, 1) : CV_(5, 0);
                cd[19] = hi ? CV_(6, 1) : CV_(6, 0);
                cd[20] = hi ? CV_(7, 1) : CV_(7, 0);
                cd[21] = hi ? CV_(9, 0) : CV_(8, 0);
                cd[22] = hi ? CV_(11, 0) : CV_(10, 0);
                cd[23] = hi ? CV_(13, 0) : CV_(12, 0);
                cd[24] = hi ? CV_(15, 0) : CV_(14, 0);
    #undef CV_
                float top[16];
    #pragma unroll
                for (int rd = 0; rd < 16; ++rd) {
                    float m = cd[0];
    #pragma unroll
                    for (int n = 1; n + 1 < 25; n += 2) m = max3f_(m, cd[n], cd[n + 1]);
                    const float gm = pair_max(m); top[rd] = gm;
    #pragma unroll
                    for (int n = 0; n < 25; ++n) cd[n] = (__float_as_uint(cd[n]) == __float_as_uint(gm)) ? -INFINITY : cd[n];
                }
                float ex[16], sum = 0.f;
    #pragma unroll
                for (int r = 0; r < 16; ++r) { ex[r] = __builtin_amdgcn_exp2f((top[r] - top[0]) * LOG2E); sum += ex[r]; }
                const float inv = 1.f / sum;
                asm volatile("s_waitcnt lgkmcnt(0)" ::: "memory");
                int eo[8]; float go[8];
    #pragma unroll
                for (int rr = 0; rr < 8; ++rr) { float t0 = top[rr], t1 = top[rr + 8], e0 = ex[rr], e1 = ex[rr + 8]; asm volatile("" : "+v"(t0), "+v"(t1), "+v"(e0), "+v"(e1));
                    const unsigned f = 255u - (__float_as_uint(hi ? t1 : t0) & 255u);
                    const int ia = scr[f >> 4], ib = scr[16 + (f & 15)]; eo[rr] = ia * 128 + ib; go[rr] = (hi ? e1 : e0) * inv; }
                int* ep = E + (size_t)tok * 128 + h * 16 + 8 * hi; float* gp = G + (size_t)tok * 128 + h * 16 + 8 * hi;
                *(v4u*)ep = (v4u){(unsigned)eo[0], (unsigned)eo[1], (unsigned)eo[2], (unsigned)eo[3]}; *(v4u*)(ep + 4) = (v4u){(unsigned)eo[4], (unsigned)eo[5], (unsigned)eo[6], (unsigned)eo[7]};
                *(f32x4*)gp = (f32x4){go[0], go[1], go[2], go[3]}; *(f32x4*)(gp + 4) = (f32x4){go[4], go[5], go[6], go[7]};
                asm volatile("s_waitcnt lgkmcnt(0)" ::: "memory");
            }
        }
#undef ROUTE_LOADQ
    }
    GRID_BAR();
    if (RUN(11)) {
        const int nlab = F.G < 8 ? F.G : 8, label = (int)blockIdx.x % nlab, nblk = (F.G - label + nlab - 1) / nlab, wx = ((int)blockIdx.x / nlab) * NWAVES + F.wave, nwx = nblk * NWAVES;
        const int lane = F.lane, rr = lane >> 3, cc = lane & 7;
        const int* E = (const int*)(ws + WS_E);
        for (int sl = label; sl < 16; sl += nlab) {
            const unsigned char* Us = ws + WS_U8 + (size_t)sl * 16384 * 128 + 16 * cc;
            const unsigned char* Hs = ws + WS_H8 + (size_t)sl * M * 128 + 16 * cc;
            int* Ps = (int*)(ws + WS_PART) + (size_t)sl * M * 128;
            for (int item = wx; item < M / 8; item += nwx) { const int tok = item * 8 + rr;
                const v4u hq = *(const v4u*)(Hs + (size_t)tok * 128);
                const v4u* ep = (const v4u*)(E + (size_t)tok * 128);
                int res[16];
#pragma unroll
                for (int i = 0; i < 16; ++i) res[i] = 0;
#pragma unroll
                for (int i = 0; i < 16; ++i) {
                    const v4u e0 = ep[2 * i], e1 = ep[2 * i + 1];
#pragma unroll
                    for (int j = 0; j < 8; ++j) { const unsigned e = j < 4 ? e0[j & 3] : e1[j & 3];
                        const v4u a = *(const v4u*)(Us + (size_t)e * 128);
                        int d = __builtin_amdgcn_sdot4((int)a.x, (int)hq.x, 0, false); d = __builtin_amdgcn_sdot4((int)a.y, (int)hq.y, d, false); d = __builtin_amdgcn_sdot4((int)a.z, (int)hq.z, d, false); d = __builtin_amdgcn_sdot4((int)a.w, (int)hq.w, d, false);
                        d += __builtin_amdgcn_update_dpp(0, d, 0xB1, 0xf, 0xf, true); d += __builtin_amdgcn_update_dpp(0, d, 0x4E, 0xf, 0xf, true); d += __builtin_amdgcn_update_dpp(0, d, 0x141, 0xf, 0xf, true);
                        res[i] = (cc == j) ? d : res[i]; } }
                v4u* po = (v4u*)(Ps + (size_t)tok * 128 + cc * 16);
#pragma unroll
                for (int q = 0; q < 4; ++q) po[q] = (v4u){(unsigned)res[4 * q], (unsigned)res[4 * q + 1], (unsigned)res[4 * q + 2], (unsigned)res[4 * q + 3]};
            }
        }
    }
    GRID_BAR();
    if (RUN(12)) {
        const int* P = (const int*)(ws + WS_PART); const int* E = (const int*)(ws + WS_E); const float* G = (const float*)(ws + WS_G); unsigned* PK = (unsigned*)(ws + WS_PK);
        const float* SU = (const float*)(ws + WS_SU); const float* SH = (const float*)(ws + WS_SH);
        for (int idx = F.vcu * 512 + F.tid; idx < M * 128; idx += F.G * 512) { const int tok = idx >> 7, k = idx & 127; const size_t pi = (size_t)tok * 128 + (k & 7) * 16 + (k >> 3); int hsum = 0;
#pragma unroll
            for (int sl = 0; sl < 16; ++sl) hsum += P[(size_t)sl * M * 128 + pi];
            const int e = E[idx];
            const float w = G[idx] * gelu_tanh((float)hsum * SU[e] * SH[tok]);
            PK[(size_t)(tok >> 6) * 8192 + (k >> 2) * 256 + (tok & 63) * 4 + (k & 3)] = (unsigned)e | (f2bf(w) << 16); }
    }
    GRID_BAR();
    if (RUN(13)) {
        const unsigned* PK = (const unsigned*)(ws + WS_PK); bf16* FFN = (bf16*)(ws + WS_FFN);
        for (int c = F.vcu; c < 256; c += F.G) {
            __syncthreads();
            { const v4u* src = (const v4u*)(ws + WS_V8 + (size_t)c * 131072);
#pragma unroll 4
              for (int j = 0; j < 16; ++j) *(LAS v4u*)(F.lds + RING_OFF + (F.tid + 512 * j) * 16) = src[F.tid + 512 * j]; }
            __syncthreads();
            for (int tb = F.wave; tb < M / 64; tb += NWAVES) { int ln_ = F.lane; asm volatile("" : "+v"(ln_));
                const v4u* pk = (const v4u*)(PK + (size_t)tb * 8192) + ln_;
                f32x2v av[4];
#pragma unroll
                for (int i = 0; i < 4; ++i) av[i] = (f32x2v){0.f, 0.f};
                v4u pb[32];
#pragma unroll
                for (int kq = 0; kq < 32; ++kq) pb[kq] = pk[kq * 64];
#pragma unroll
                for (int kq = 0; kq < 32; ++kq) { const v4u p4 = pb[kq];
#pragma unroll
                    for (int j = 0; j < 4; ++j) { const unsigned p = p4[j]; const float w = __uint_as_float(p & 0xffff0000u); const f32x2v ww = (f32x2v){w, w};
                        const unsigned long long d = *(const LAS unsigned long long*)(F.lds + RING_OFF + ((p & 0xffffu) << 3));
                        const int d0 = (int)(unsigned)d, d1 = (int)(unsigned)(d >> 32);
                        av[0] = av[0] + __builtin_amdgcn_cvt_pk_f32_fp8(d0, false) * ww; av[1] = av[1] + __builtin_amdgcn_cvt_pk_f32_fp8(d0, true) * ww;
                        av[2] = av[2] + __builtin_amdgcn_cvt_pk_f32_fp8(d1, false) * ww; av[3] = av[3] + __builtin_amdgcn_cvt_pk_f32_fp8(d1, true) * ww; } }
                *(v4u*)(FFN + (size_t)(tb * 64 + ln_) * D + 8 * c) = (v4u){pk2(av[0].x, av[0].y), pk2(av[1].x, av[1].y), pk2(av[2].x, av[2].y), pk2(av[3].x, av[3].y)};
            }
        }
        __syncthreads();
    }
    GRID_BAR();
    if (RUN(14)) {
        const int gw = F.vcu * NWAVES + F.wave, NGW = F.G * NWAVES, lane = F.lane; const float* g2 = args.in[21]; const float* b2 = args.in[22]; float* out = args.out; const bf16* FFN = (const bf16*)(ws + WS_FFN);
        for (int row = gw; row < M; row += NGW) {
            f32x4 v[8]; float sm = 0.f;
#pragma unroll
            for (int j = 0; j < 8; ++j) { const int c = (lane + 64 * j) * 4; const unsigned long long hq = *(const unsigned long long*)(H1 + (size_t)row * D + c), fq = *(const unsigned long long*)(FFN + (size_t)row * D + c);
                const unsigned h0 = (unsigned)hq, h1_ = (unsigned)(hq >> 32), f0 = (unsigned)fq, f1 = (unsigned)(fq >> 32);
                v[j].x = DN_ALPHA * __uint_as_float(h0 << 16) + __uint_as_float(f0 << 16); v[j].y = DN_ALPHA * __uint_as_float(h0 & 0xffff0000u) + __uint_as_float(f0 & 0xffff0000u);
                v[j].z = DN_ALPHA * __uint_as_float(h1_ << 16) + __uint_as_float(f1 << 16); v[j].w = DN_ALPHA * __uint_as_float(h1_ & 0xffff0000u) + __uint_as_float(f1 & 0xffff0000u);
                sm += (v[j].x + v[j].y) + (v[j].z + v[j].w); }
#pragma unroll
            for (int o = 1; o < 64; o <<= 1) sm += __shfl_xor(sm, o);
            const float mean = sm * (1.f / D); float s2 = 0.f;
#pragma unroll
            for (int j = 0; j < 8; ++j) { v[j] = v[j] - mean; s2 += (v[j].x * v[j].x + v[j].y * v[j].y) + (v[j].z * v[j].z + v[j].w * v[j].w); }
#pragma unroll
            for (int o = 1; o < 64; o <<= 1) s2 += __shfl_xor(s2, o);
            const float rstd = rsqrtf(s2 * (1.f / D) + LN_EPS);
#pragma unroll
            for (int j = 0; j < 8; ++j) { const int c = (lane + 64 * j) * 4; *(f32x4*)(out + (size_t)row * D + c) = v[j] * rstd * *(const f32x4*)(g2 + c) + *(const f32x4*)(b2 + c); }
        }
    }
#undef IN
#undef RUN
#undef GRID_BAR
}

extern "C" void kernel_launch(void* const* d_in, const int* in_sizes, int n_in, void* d_out, int out_size, void* d_ws, size_t ws_size, hipStream_t stream) {
    static int grid = 0;
    if (grid == 0) {
        if (n_in != 23 || in_sizes[0] != M * D || out_size != M * D || ws_size < WS_END) { fprintf(stderr, "kernel_launch: unexpected shapes n_in %d in0 %d out %d ws %zu\n", n_in, n_in > 0 ? in_sizes[0] : -1, out_size, ws_size); grid = -1; return; }
        int dev = 0, cus = 0;
        if (hipGetDevice(&dev) != hipSuccess || hipDeviceGetAttribute(&cus, hipDeviceAttributeMultiprocessorCount, dev) != hipSuccess) { grid = -1; return; }
        if (hipFuncSetAttribute((const void*)skel_fwd, hipFuncAttributeMaxDynamicSharedMemorySize, LDS_BYTES) != hipSuccess) { grid = -1; return; }
        grid = cus;
    }
    if (grid < 0) return;
    (void)hipMemsetAsync((char*)d_ws + WS_CTL, 0, CTL_ZERO_BYTES, stream);
    Args a{};
    for (int i = 0; i < 23; ++i) a.in[i] = (const float*)d_in[i];
    a.out = (float*)d_out; a.ws = (unsigned char*)d_ws;
    unsigned char* ws = (unsigned char*)d_ws;
    const float* const* in = (const float* const*)d_in;
    float* prm = (float*)(ws + WS_PRM);
    bf16 *Q = (bf16*)(ws + WS_Q), *K = (bf16*)(ws + WS_K), *V = (bf16*)(ws + WS_V), *XR = (bf16*)(ws + WS_XR), *XG = (bf16*)(ws + WS_XG), *MIX = (bf16*)(ws + WS_MIX), *H1 = (bf16*)(ws + WS_H1);
    float *LA = (float*)(ws + WS_LA), *LB = (float*)(ws + WS_LB), *Y1 = (float*)(ws + WS_Y1), *PQ = (float*)(ws + WS_PQ), *G = (float*)(ws + WS_G); int* E = (int*)(ws + WS_E);
#ifndef MK_MULTI
    a.ph_lo = -1; a.ph_hi = 0; hipLaunchKernelGGL(skel_fwd, dim3(grid), dim3(NWAVES * 64), LDS_BYTES, stream, a);
#else
    for (int sl = 0; sl < 15; ++sl) { a.ph_lo = 1 << sl; a.ph_hi = 0; hipLaunchKernelGGL(skel_fwd, dim3(grid), dim3(NWAVES * 64), LDS_BYTES, stream, a); }
#endif
}
```

```cpp
#include <hip/hip_runtime.h>
#include <cstdio>
#include <cstdint>
namespace pg8 {
#define PG8_LAS __attribute__((address_space(3)))
typedef unsigned short bf16_t;
typedef short bf16x8 __attribute__((ext_vector_type(8)));
typedef float f32x4 __attribute__((ext_vector_type(4)));
typedef unsigned u32x4 __attribute__((ext_vector_type(4)));
constexpr int BM = 256, BK = 64, HALF = 128, HTB = HALF * BK * 2  , STAGE_BYTES = 8 * HTB, NXCD = 8, WGM = 8;

__host__ __device__ __forceinline__ int lds_byte(int r, int c) { const int st = (r >> 4) * 2 + (c >> 5), rr = r & 15, cc = c & 31, ob = rr * 64 + cc * 2; return st * 1024 + (ob ^ (((ob >> 9) & 1) << 5)); }
__host__ __device__ __forceinline__ void stage_rc(int b, int& R, int& C) { const int st = b / 1024, sb = b % 1024, swz = sb ^ (((sb >> 9) & 1) << 5); R = (st >> 1) * 16 + swz / 64; C = (st & 1) * 32 + (swz % 64) / 2; }
__host__ __device__ __forceinline__ int perm32(int rho) { const int n = rho >> 4, i = rho & 15; return 8 * (i >> 2) + 4 * n + (i & 3); }

struct Unit { int pm, pn; };
struct Gemm { const bf16_t* A; const bf16_t* Bt; int M, N, K; };

struct StaticOrder {
    int nM, nN, nwg, G, c;
    __host__ __device__ void init(int M, int N, int G_, int c_) { nM = M / BM; nN = N / BM; nwg = nM * nN; G = G_; c = c_; }
    __host__ __device__ bool next(int i, Unit& u) const {
        const long L = (long)i * G + c; if (L >= nwg) return false;
        int wgid = (int)L; { const int q = nwg / NXCD, r = nwg % NXCD, xcd = wgid % NXCD, off = wgid / NXCD; wgid = (xcd < r ? xcd * (q + 1) : r * (q + 1) + (xcd - r) * q) + off; }
        const int nig = WGM * nN, gid = wgid / nig, fm = gid * WGM, gsz = (nM - fm) < WGM ? (nM - fm) : WGM;
        u.pm = fm + ((wgid % nig) % gsz); u.pn = (wgid % nig) / gsz; return true;
    }
    __device__ __forceinline__ void a_ready(const Unit&) const {}
    __device__ __forceinline__ void done(const Unit&) const {}
};

__device__ __forceinline__ unsigned cvt_pk_bf16(float lo, float hi) { unsigned r; asm volatile("v_cvt_pk_bf16_f32 %0, %1, %2" : "=v"(r) : "v"(lo), "v"(hi)); return r; }
typedef float f32x2 __attribute__((ext_vector_type(2)));
__device__ __forceinline__ f32x2 gelu_pk(f32x2 v) {
    const f32x2 av = __builtin_elementwise_abs(v), d = av * 0.2316418882f + 1.0f;
    f32x2 t; t.x = __builtin_amdgcn_rcpf(d.x); t.y = __builtin_amdgcn_rcpf(d.y);
    f32x2 q = t * 0.5307027145f + (-0.7265760135f); q = q * t + 0.7107068705f; q = q * t + (-0.142248368f); q = q * t + 0.127414796f; q = q * t;
    const f32x2 s = (v * v) * (-0.72134752044f);
    f32x2 e; e.x = __builtin_amdgcn_exp2f(s.x); e.y = __builtin_amdgcn_exp2f(s.y);
    const f32x2 m = v * (q * e), r = v - m;
    f32x2 o; o.x = v.x < 0.f ? m.x : r.x; o.y = v.y < 0.f ? m.y : r.y; return o;
}

template <int ACT  > struct EpiBf16 {
    static constexpr bool PERM = true, AFTER_DRAIN = false; static_assert(ACT == 0 || ACT == 1, "EpiBf16: ACT is 0 (none) or 1 (gelu_pk)");
    bf16_t* O; int ldc; const float* bias; int split_cols; size_t split_stride; float scale0;
    __device__ __forceinline__ void operator()(const f32x4 (&acc)[2][2][4][2], const Unit& u, int wr, int wc, int fr, int fq) const {
        const int row0 = u.pm * BM + wr * 64 + fr; int colt = u.pn * BM; bf16_t* base = O;
        float sc = 1.f; if (split_cols) { const int t = colt / split_cols; base += (size_t)t * split_stride; colt -= t * split_cols; if (t == 0) sc = scale0; }
        const int col0 = colt + wc * 32 + 8 * fq, bcol0 = u.pn * BM + wc * 32 + 8 * fq;
        f32x4 bv[2][2];
#pragma unroll
        for (int bj = 0; bj < 2; ++bj)
#pragma unroll
            for (int n = 0; n < 2; ++n) bv[bj][n] = bias ? *(const f32x4*)(bias + bcol0 + bj * HALF + 4 * n) : (f32x4){0.f, 0.f, 0.f, 0.f};
#pragma unroll
        for (int ai = 0; ai < 2; ++ai)
#pragma unroll
            for (int m = 0; m < 4; ++m) { bf16_t* rowp = base + (size_t)(row0 + ai * HALF + m * 16) * ldc + col0;
#pragma unroll
                for (int bj = 0; bj < 2; ++bj) { f32x4 v0 = acc[ai][bj][m][0] + bv[bj][0], v1 = acc[ai][bj][m][1] + bv[bj][1];
                    if (ACT == 1) { f32x2 a = gelu_pk((f32x2){v0[0], v0[1]}), b = gelu_pk((f32x2){v0[2], v0[3]}), c = gelu_pk((f32x2){v1[0], v1[1]}), d = gelu_pk((f32x2){v1[2], v1[3]});
                        v0 = (f32x4){a.x, a.y, b.x, b.y}; v1 = (f32x4){c.x, c.y, d.x, d.y}; }
                    v0 = v0 * sc; v1 = v1 * sc; u32x4 w; w.x = cvt_pk_bf16(v0[0], v0[1]); w.y = cvt_pk_bf16(v0[2], v0[3]); w.z = cvt_pk_bf16(v1[0], v1[1]); w.w = cvt_pk_bf16(v1[2], v1[3]);
                    *(u32x4*)(rowp + bj * HALF) = w; } }
    }
};

struct PanelStats {
    unsigned* xbuf;
    unsigned* cnt;
    unsigned* tmo;
    int ntn; float eps;
    unsigned code;
    __device__ __forceinline__ bool run(const f32x4 (&v)[2][2][4][2], const Unit& u, int wr, int wc, int fr, int fq, PG8_LAS unsigned char* lds, int wid, int lane) const {
        typedef float f32x2v __attribute__((ext_vector_type(2)));
        PG8_LAS f32x2v* P = (PG8_LAS f32x2v*)lds;
        PG8_LAS f32x2v* S = (PG8_LAS f32x2v*)(lds + 8192);
        PG8_LAS unsigned* flag = (PG8_LAS unsigned*)(lds + 8192 + 2048);
#pragma unroll
        for (int ai = 0; ai < 2; ++ai)
#pragma unroll
            for (int m = 0; m < 4; ++m) {
                float s = 0.f;
#pragma unroll
                for (int bj = 0; bj < 2; ++bj)
#pragma unroll
                    for (int n = 0; n < 2; ++n) { const f32x4 x = v[ai][bj][m][n]; s += (x[0] + x[1]) + (x[2] + x[3]); }
                s += __shfl_xor(s, 16); s += __shfl_xor(s, 32);
                const float mw = s * (1.0f / 64.0f); float q = 0.f;
#pragma unroll
                for (int bj = 0; bj < 2; ++bj)
#pragma unroll
                    for (int n = 0; n < 2; ++n) { const f32x4 d = v[ai][bj][m][n] - mw; q += (d[0] * d[0] + d[1] * d[1]) + (d[2] * d[2] + d[3] * d[3]); }
                q += __shfl_xor(q, 16); q += __shfl_xor(q, 32);
                if (fq == 0) P[(ai * HALF + wr * 64 + m * 16 + fr) * 4 + wc] = (f32x2v){mw, q};
            }
        asm volatile("s_waitcnt lgkmcnt(0)" ::: "memory"); __builtin_amdgcn_s_barrier(); asm volatile("" ::: "memory");
#if defined(BROKEN_EXCHANGE_NO_WAIT)
#warning BROKEN CONTROL BUILD: the row-statistics exchange does not wait; results are wrong by design
        if (blockIdx.x >= 64) { const long long t0_ = clock64(); while (clock64() - t0_ < 60000) __builtin_amdgcn_s_sleep(8); }
#endif
        const int row = wid * 32 + (lane & 31);
        if (lane < 32) {
            const f32x2v a = P[row * 4 + 0], b = P[row * 4 + 1], c = P[row * 4 + 2], d = P[row * 4 + 3];
            const float mt = (a.x + b.x + c.x + d.x) * 0.25f;
            const float da = a.x - mt, db = b.x - mt, dc = c.x - mt, dd = d.x - mt;
            const float m2 = (a.y + b.y) + (c.y + d.y) + 64.0f * ((da * da + db * db) + (dc * dc + dd * dd));
            unsigned long long* slot = (unsigned long long*)xbuf + ((size_t)(u.pm * BM + row) * 4 + u.pn);
            __hip_atomic_store(slot, ((unsigned long long)__float_as_uint(m2) << 32) | __float_as_uint(mt), __ATOMIC_RELAXED, __HIP_MEMORY_SCOPE_AGENT);
        }
        asm volatile("s_waitcnt vmcnt(0)" ::: "memory");
        if (lane == 0) __hip_atomic_fetch_add(cnt + 64 * u.pm, 1u, __ATOMIC_RELAXED, __HIP_MEMORY_SCOPE_AGENT);
        if (wid == 0) {
            bool dead = false; const unsigned long long t0 = __builtin_amdgcn_s_memrealtime(); const unsigned want = 8u * (unsigned)ntn;
            for (;;) {
#if defined(BROKEN_EXCHANGE_NO_WAIT)
                break;
#endif
                if ((unsigned)__builtin_amdgcn_readfirstlane(__hip_atomic_load(cnt + 64 * u.pm, __ATOMIC_RELAXED, __HIP_MEMORY_SCOPE_AGENT)) >= want) break;
                if (__builtin_amdgcn_s_memrealtime() - t0 > 2000000ull) {
                    if (lane == 0) { unsigned expect = 0u; __hip_atomic_compare_exchange_strong(tmo + 1, &expect, code | (unsigned)(u.pm & 0xff), __ATOMIC_RELAXED, __ATOMIC_RELAXED, __HIP_MEMORY_SCOPE_AGENT);
                                     __hip_atomic_store(tmo, 1u, __ATOMIC_RELAXED, __HIP_MEMORY_SCOPE_AGENT); }
                    dead = true; break; }
                __builtin_amdgcn_s_sleep(2);
            }
            __builtin_amdgcn_fence(__ATOMIC_ACQUIRE, "agent");
            if (lane == 0) flag[0] = dead ? 1u : 0u;
        }
        asm volatile("s_waitcnt vmcnt(0) lgkmcnt(0)" ::: "memory"); __builtin_amdgcn_s_barrier(); asm volatile("" ::: "memory");
        const bool bad = flag[0] != 0u;
        if (lane < 32) {
            const unsigned long long* slot = (const unsigned long long*)xbuf + (size_t)(u.pm * BM + row) * 4; float mt[4], m2[4]; float ms = 0.f;
#pragma unroll
            for (int t = 0; t < 4; ++t) { if (t < ntn) { const unsigned long long w = __hip_atomic_load(slot + t, __ATOMIC_RELAXED, __HIP_MEMORY_SCOPE_AGENT); mt[t] = __uint_as_float((unsigned)w); m2[t] = __uint_as_float((unsigned)(w >> 32)); } else { mt[t] = 0.f; m2[t] = 0.f; } ms += mt[t]; }
            const float mean = ms / (float)ntn; float q = 0.f;
#pragma unroll
            for (int t = 0; t < 4; ++t) if (t < ntn) { const float dm = mt[t] - mean; q += m2[t] + 256.0f * dm * dm; }
            S[row] = (f32x2v){mean, 1.0f / sqrtf(q / (256.0f * (float)ntn) + eps)};
        }
        asm volatile("s_waitcnt lgkmcnt(0)" ::: "memory"); __builtin_amdgcn_s_barrier(); asm volatile("" ::: "memory");
        return bad;
    }
};
struct EpiLnRes {
    static constexpr bool PERM = false, AFTER_DRAIN = true;
    const float* base; float* out; int ldc; const float* bias; PanelStats st; unsigned poison;
    __device__ __forceinline__ void fused(f32x4 (&acc)[2][2][4][2], const Unit& u, int wr, int wc, int fr, int fq, PG8_LAS unsigned char* lds, int wid, int lane) const {
        typedef float f32x2v __attribute__((ext_vector_type(2)));
        const PG8_LAS f32x2v* S = (const PG8_LAS f32x2v*)(lds + 8192);
        const int col0 = u.pn * BM + wc * 32 + 4 * fq;
#pragma unroll
        for (int bj = 0; bj < 2; ++bj)
#pragma unroll
            for (int n = 0; n < 2; ++n) { const f32x4 bv = bias ? *(const f32x4*)(bias + col0 + bj * HALF + n * 16) : (f32x4){0.f, 0.f, 0.f, 0.f};
#pragma unroll
                for (int ai = 0; ai < 2; ++ai)
#pragma unroll
                    for (int m = 0; m < 4; ++m) acc[ai][bj][m][n] += bv; }
        f32x4 pre[4][2][2];
#pragma unroll
        for (int m = 0; m < 4; ++m) { const size_t off = (size_t)(u.pm * BM + wr * 64 + m * 16 + fr) * ldc + col0;
#pragma unroll
            for (int bj = 0; bj < 2; ++bj)
#pragma unroll
                for (int n = 0; n < 2; ++n) pre[m][bj][n] = *(const f32x4*)(base + off + bj * HALF + n * 16); }
        const bool bad = st.run(acc, u, wr, wc, fr, fq, lds, wid, lane) || poison != 0u;
        const float qnan = __builtin_nanf("");
#pragma unroll
        for (int ai = 0; ai < 2; ++ai)
#pragma unroll
            for (int m = 0; m < 4; ++m) { const int r = ai * HALF + wr * 64 + m * 16 + fr; const f32x2v sr = S[r]; const size_t off = (size_t)(u.pm * BM + r) * ldc + col0;
#pragma unroll
                for (int bj = 0; bj < 2; ++bj)
#pragma unroll
                    for (int n = 0; n < 2; ++n) { const f32x4 bs = ai == 0 ? pre[m][bj][n] : *(const f32x4*)(base + off + bj * HALF + n * 16); f32x4 o = bs + (acc[ai][bj][m][n] - sr.x) * sr.y;
                        if (bad) o = (f32x4){qnan, qnan, qnan, qnan}; *(f32x4*)(out + off + bj * HALF + n * 16) = o; }
                if (m & 1) asm volatile("" ::: "memory"); }
    }
};
struct EpiLnResLn {
    static constexpr bool PERM = false, AFTER_DRAIN = true;
    const float* base; float* out; bf16_t* xn; int ldc; const float* bias; PanelStats st1, st2; unsigned poison;
    __device__ __forceinline__ void fused(f32x4 (&acc)[2][2][4][2], const Unit& u, int wr, int wc, int fr, int fq, PG8_LAS unsigned char* lds, int wid, int lane) const {
        typedef float f32x2v __attribute__((ext_vector_type(2))); typedef unsigned u32x2v __attribute__((ext_vector_type(2)));
        const PG8_LAS f32x2v* S = (const PG8_LAS f32x2v*)(lds + 8192);
        const int col0 = u.pn * BM + wc * 32 + 4 * fq;
#pragma unroll
        for (int bj = 0; bj < 2; ++bj)
#pragma unroll
            for (int n = 0; n < 2; ++n) { const f32x4 bv = bias ? *(const f32x4*)(bias + col0 + bj * HALF + n * 16) : (f32x4){0.f, 0.f, 0.f, 0.f};
#pragma unroll
                for (int ai = 0; ai < 2; ++ai)
#pragma unroll
                    for (int m = 0; m < 4; ++m) acc[ai][bj][m][n] += bv; }
        bool bad = st1.run(acc, u, wr, wc, fr, fq, lds, wid, lane) || poison != 0u;
        const float qnan = __builtin_nanf("");
#pragma unroll
        for (int ai = 0; ai < 2; ++ai)
#pragma unroll
            for (int m = 0; m < 4; ++m) { const int r = ai * HALF + wr * 64 + m * 16 + fr; const f32x2v sr = S[r]; const size_t off = (size_t)(u.pm * BM + r) * ldc + col0;
#pragma unroll
                for (int bj = 0; bj < 2; ++bj)
#pragma unroll
                    for (int n = 0; n < 2; ++n) { const f32x4 bs = *(const f32x4*)(base + off + bj * HALF + n * 16); acc[ai][bj][m][n] = bs + (acc[ai][bj][m][n] - sr.x) * sr.y; }
                asm volatile("" : "+v"(acc[ai][0][m][0]), "+v"(acc[ai][0][m][1]), "+v"(acc[ai][1][m][0]), "+v"(acc[ai][1][m][1]));
                if (m & 1) asm volatile("" ::: "memory"); }
        const bool bad1 = bad;
        bad = st2.run(acc, u, wr, wc, fr, fq, lds, wid, lane) || bad;
#pragma unroll
        for (int ai = 0; ai < 2; ++ai)
#pragma unroll
            for (int m = 0; m < 4; ++m) { const int r = ai * HALF + wr * 64 + m * 16 + fr; const f32x2v sr = S[r]; const size_t off = (size_t)(u.pm * BM + r) * ldc + col0;
#pragma unroll
                for (int bj = 0; bj < 2; ++bj)
#pragma unroll
                    for (int n = 0; n < 2; ++n) { const f32x4 x1 = acc[ai][bj][m][n]; *(f32x4*)(out + off + bj * HALF + n * 16) = bad1 ? (f32x4){qnan, qnan, qnan, qnan} : x1;
                        const f32x4 o = (x1 - sr.x) * sr.y; u32x2v w; w.x = cvt_pk_bf16(o[0], o[1]); w.y = cvt_pk_bf16(o[2], o[3]);
                        if (bad) { w.x = 0x7fc07fc0u; w.y = 0x7fc07fc0u; } *(u32x2v*)(xn + off + bj * HALF + n * 16) = w; }
                asm volatile("" ::: "memory"); }
    }
};

template <class Epi, class Sched, bool ALIGN_EPI = false, bool SP2 = false>
__device__ __forceinline__ void gemm_phase(PG8_LAS unsigned char* lds, const Gemm g, const Sched& S, const Epi& E) {
    const int tid = threadIdx.x, wid = __builtin_amdgcn_readfirstlane(tid >> 6), lane = tid & 63, wr = wid >> 2, wc = wid & 3, fr = lane & 15, fq = lane >> 4;
    const int K = g.K, nt = K / BK;
    unsigned voffA[2], voffB[2];
#pragma unroll
    for (int i = 0; i < 2; ++i) { int R, C; stage_rc(tid * 16 + i * 8192, R, C); const int Rb = Epi::PERM ? ((R & ~31) + perm32(R & 31)) : R;
        voffA[i] = (unsigned)(R * K + C) * 2u; voffB[i] = (unsigned)(Rb * K + C) * 2u; }
    const size_t kstep = (size_t)(BK * 2);
    const size_t hstep = (size_t)HALF * K * 2;
    const size_t tstep = 2 * hstep;
    const unsigned ldsw = (unsigned)wid * 1024u;
    const int aoff = lds_byte(wr * 64 + fr, fq * 8), boff = lds_byte(wc * 32 + fr, fq * 8);
#define PG8_SA(b, h) (((b) * 2 + (h)) * HTB)
#define PG8_SB(b, h) ((4 + (b) * 2 + (h)) * HTB)
#define PG8_STAGE(bufoff, gbase, voff) do { _Pragma("unroll") for (int _i = 0; _i < 2; ++_i) \
        __builtin_amdgcn_global_load_lds((const unsigned*)((const char*)(gbase) + (voff)[_i]), (PG8_LAS unsigned*)(lds + (bufoff) + ldsw + _i * 8192), 16, 0, 0); } while (0)
#define PG8_LDA(dst, b, h) do { _Pragma("unroll") for (int m = 0; m < 4; ++m) _Pragma("unroll") for (int k = 0; k < 2; ++k) dst[m][k] = *(const PG8_LAS bf16x8*)(lds + PG8_SA(b, h) + aoff + m * 2048 + k * 1024); } while (0)
#define PG8_LDB(dst, b, h) do { _Pragma("unroll") for (int n = 0; n < 2; ++n) _Pragma("unroll") for (int k = 0; k < 2; ++k) dst[n][k] = *(const PG8_LAS bf16x8*)(lds + PG8_SB(b, h) + boff + n * 2048 + k * 1024); } while (0)
#define PG8_MMA(ai, bj, At, Bt) do { __builtin_amdgcn_s_setprio(1); _Pragma("unroll") for (int m = 0; m < 4; ++m) _Pragma("unroll") for (int n = 0; n < 2; ++n) _Pragma("unroll") for (int k = 0; k < 2; ++k) \
        acc[ai][bj][m][n] = __builtin_amdgcn_mfma_f32_16x16x32_bf16(Bt[n][k], At[m][k], acc[ai][bj][m][n], 0, 0, 0); __builtin_amdgcn_s_setprio(0); } while (0)
#define PG8_WAIT_V(n) asm volatile("s_waitcnt vmcnt(" #n ")" ::: "memory")
#define PG8_WAIT_L(n) asm volatile("s_waitcnt lgkmcnt(" #n ")" ::: "memory")
#define PG8_BAR __builtin_amdgcn_s_barrier()
#define PG8_SCHED __builtin_amdgcn_sched_barrier(0)
    Unit cur, nxt; int ui = 0;
    if (!S.next(0, cur)) return;
    f32x4 acc[2][2][4][2];
#pragma unroll
    for (int a = 0; a < 2; ++a)
#pragma unroll
        for (int b = 0; b < 2; ++b)
#pragma unroll
            for (int m = 0; m < 4; ++m)
#pragma unroll
                for (int n = 0; n < 2; ++n) acc[a][b][m][n] = (f32x4){0.f, 0.f, 0.f, 0.f};
    bf16x8 At[4][2], B0[2][2], B1[2][2];
    const char* cA = (const char*)g.A + (size_t)cur.pm * tstep; const char* cB = (const char*)g.Bt + (size_t)cur.pn * tstep;
    S.a_ready(cur);
    if constexpr (SP2) {
        PG8_STAGE(PG8_SB(0, 0), cB, voffB); PG8_STAGE(PG8_SB(0, 1), cB + hstep, voffB); PG8_STAGE(PG8_SA(0, 0), cA, voffA); PG8_STAGE(PG8_SA(0, 1), cA + hstep, voffA);
        if (wr == 1) PG8_BAR;
        PG8_WAIT_V(2); PG8_BAR;
        PG8_STAGE(PG8_SB(1, 0), cB + kstep, voffB); PG8_STAGE(PG8_SA(1, 0), cA + kstep, voffA); PG8_STAGE(PG8_SB(1, 1), cB + hstep + kstep, voffB);
        PG8_WAIT_V(6); PG8_BAR;
    } else {
        PG8_STAGE(PG8_SB(0, 0), cB, voffB); PG8_STAGE(PG8_SA(0, 0), cA, voffA); PG8_STAGE(PG8_SB(0, 1), cB + hstep, voffB); PG8_STAGE(PG8_SA(0, 1), cA + hstep, voffA);
        if (wr == 1) PG8_BAR;
        PG8_WAIT_V(4); PG8_BAR;
        PG8_STAGE(PG8_SB(1, 0), cB + kstep, voffB); PG8_STAGE(PG8_SA(1, 0), cA + kstep, voffA); PG8_STAGE(PG8_SB(1, 1), cB + hstep + kstep, voffB);
        PG8_WAIT_V(6); PG8_BAR;
    }
    for (;;) {
        const bool has_next = S.next(ui + 1, nxt);
        const char* nA = has_next ? (const char*)g.A + (size_t)nxt.pm * tstep : cA; const char* nB = has_next ? (const char*)g.Bt + (size_t)nxt.pn * tstep : cB;
        for (int t = 0; t < nt; t += 2) {
            const bool last = (t == nt - 2);
            const char* a1 = cA + (size_t)(t + 1) * kstep;
            const char* a2 = last ? nA : cA + (size_t)(t + 2) * kstep; const char* b2 = last ? nB : cB + (size_t)(t + 2) * kstep;
            const char* a3 = a2 + kstep; const char* b3 = b2 + kstep;
            if (last && has_next) S.a_ready(nxt);
            if constexpr (SP2) {
            PG8_LDB(B0, 0, 0); PG8_LDB(B1, 0, 1); PG8_SCHED; PG8_LDA(At, 0, 0); PG8_STAGE(PG8_SA(1, 1), a1 + hstep, voffA);
            PG8_WAIT_V(8); PG8_WAIT_L(0); PG8_BAR; PG8_MMA(0, 0, At, B0); PG8_MMA(0, 1, At, B1); PG8_BAR; PG8_SCHED;
            PG8_LDA(At, 0, 1); PG8_STAGE(PG8_SB(0, 0), b2, voffB); PG8_STAGE(PG8_SB(0, 1), b2 + hstep, voffB); PG8_STAGE(PG8_SA(0, 0), a2, voffA);
            PG8_WAIT_V(8); PG8_WAIT_L(0); PG8_BAR; PG8_MMA(1, 0, At, B0); PG8_MMA(1, 1, At, B1); PG8_BAR; PG8_SCHED;
            PG8_LDB(B0, 1, 0); PG8_LDB(B1, 1, 1); PG8_SCHED; PG8_LDA(At, 1, 0); PG8_STAGE(PG8_SA(0, 1), a2 + hstep, voffA);
            PG8_WAIT_V(8); PG8_WAIT_L(0); PG8_BAR; PG8_MMA(0, 0, At, B0); PG8_MMA(0, 1, At, B1); PG8_BAR; PG8_SCHED;
            PG8_LDA(At, 1, 1); PG8_STAGE(PG8_SB(1, 0), b3, voffB); PG8_STAGE(PG8_SB(1, 1), b3 + hstep, voffB); PG8_STAGE(PG8_SA(1, 0), a3, voffA);
            PG8_WAIT_V(8); PG8_WAIT_L(0); PG8_BAR; PG8_MMA(1, 0, At, B0); PG8_MMA(1, 1, At, B1); PG8_BAR; PG8_SCHED;
            } else {
            PG8_LDB(B0, 0, 0); PG8_SCHED; PG8_LDA(At, 0, 0); PG8_STAGE(PG8_SA(1, 1), a1 + hstep, voffA);
            PG8_WAIT_L(8); PG8_BAR; PG8_WAIT_L(0); PG8_MMA(0, 0, At, B0); PG8_BAR; PG8_SCHED;
            PG8_LDB(B1, 0, 1); PG8_STAGE(PG8_SB(0, 0), b2, voffB);
            PG8_BAR; PG8_WAIT_L(0); PG8_MMA(0, 1, At, B1); PG8_BAR;
            PG8_LDA(At, 0, 1); PG8_STAGE(PG8_SA(0, 0), a2, voffA);
            PG8_BAR; PG8_WAIT_L(0); PG8_MMA(1, 0, At, B0); PG8_BAR; PG8_SCHED;
            PG8_STAGE(PG8_SB(0, 1), b2 + hstep, voffB);
            PG8_WAIT_V(6); PG8_BAR; PG8_MMA(1, 1, At, B1); PG8_BAR;
            PG8_LDB(B0, 1, 0); PG8_SCHED; PG8_LDA(At, 1, 0); PG8_STAGE(PG8_SA(0, 1), a2 + hstep, voffA);
            PG8_WAIT_L(8); PG8_BAR; PG8_WAIT_L(0); PG8_MMA(0, 0, At, B0); PG8_BAR; PG8_SCHED;
            PG8_LDB(B1, 1, 1); PG8_STAGE(PG8_SB(1, 0), b3, voffB);
            PG8_BAR; PG8_WAIT_L(0); PG8_MMA(0, 1, At, B1); PG8_BAR;
            PG8_LDA(At, 1, 1); PG8_STAGE(PG8_SA(1, 0), a3, voffA);
            PG8_BAR; PG8_WAIT_L(0); PG8_MMA(1, 0, At, B0); PG8_BAR; PG8_SCHED;
            PG8_STAGE(PG8_SB(1, 1), b3 + hstep, voffB);
            PG8_WAIT_V(6); PG8_BAR; PG8_MMA(1, 1, At, B1); PG8_BAR;
            }
        }
        if constexpr (ALIGN_EPI) { if (wr == 0) PG8_BAR; }
        if constexpr (!Epi::AFTER_DRAIN) { E(acc, cur, wr, wc, fr, fq); S.done(cur); }
        if (!has_next) break;
#pragma unroll
        for (int a = 0; a < 2; ++a)
#pragma unroll
            for (int b = 0; b < 2; ++b)
#pragma unroll
                for (int m = 0; m < 4; ++m)
#pragma unroll
                    for (int n = 0; n < 2; ++n) acc[a][b][m][n] = (f32x4){0.f, 0.f, 0.f, 0.f};
        cur = nxt; cA = nA; cB = nB; ++ui;
        if constexpr (ALIGN_EPI) { if (wr == 1) PG8_BAR; }
    }
    PG8_WAIT_V(0);
    if constexpr (!ALIGN_EPI) { if (wr == 0) PG8_BAR; }
    PG8_BAR;
    if constexpr (Epi::AFTER_DRAIN) { E.fused(acc, cur, wr, wc, fr, fq, lds, wid, lane); S.done(cur); }
#undef PG8_SA
#undef PG8_SB
#undef PG8_STAGE
#undef PG8_LDA
#undef PG8_LDB
#undef PG8_MMA
#undef PG8_WAIT_V
#undef PG8_WAIT_L
#undef PG8_BAR
#undef PG8_SCHED
}
}
#ifndef PG8_SP2
#define PG8_SP2 true
#endif
#ifndef PG8_ALIGN
#define PG8_ALIGN true
#endif
namespace pg8 {
struct EpiF32 {
    static constexpr bool PERM = false, AFTER_DRAIN = false;
    float* O; int ldc; const float* base; float alpha;
    __device__ __forceinline__ void operator()(const f32x4 (&acc)[2][2][4][2], const Unit& u, int wr, int wc, int fr, int fq) const {
        const int col0 = u.pn * BM + wc * 32 + 4 * fq;
#pragma unroll
        for (int ai = 0; ai < 2; ++ai)
#pragma unroll
            for (int m = 0; m < 4; ++m) { const size_t off = (size_t)(u.pm * BM + ai * HALF + wr * 64 + m * 16 + fr) * ldc + col0;
#pragma unroll
                for (int bj = 0; bj < 2; ++bj)
#pragma unroll
                    for (int n = 0; n < 2; ++n) { f32x4 v = acc[ai][bj][m][n];
                        if (base) { const f32x4 bs = *(const f32x4*)(base + off + bj * HALF + n * 16); v = v + bs * alpha; }
                        *(f32x4*)(O + off + bj * HALF + n * 16) = v; } }
    }
};
}

#include <hip/hip_bf16.h>
#include <cmath>
namespace datt {
using bf16 = __hip_bfloat16;
typedef short bf16x8 __attribute__((ext_vector_type(8)));
typedef short s16x4 __attribute__((ext_vector_type(4)));
typedef float f32x16 __attribute__((ext_vector_type(16)));
typedef float f32x4 __attribute__((ext_vector_type(4)));
typedef unsigned u32x4 __attribute__((ext_vector_type(4)));
constexpr int SEQ = 4096, DM = 1024, DQK = 64, DV = 128;
constexpr int NW = 8, QBLK = 32, KVBLK = 64, QB = NW * QBLK;
constexpr int SHM_V = KVBLK * DV * 2, SHM_K = KVBLK * DQK * 2;
constexpr int NSLOT = 3;
constexpr int LDS_BYTES = NSLOT * SHM_V + NSLOT * SHM_K + NW * 64 * 4;
constexpr float THR = 8.f;
#define DKSWZ(row, colB) ((row) * 128 + ((colB) ^ (((row) & 7) << 4)))
#define DSBAR() __builtin_amdgcn_sched_barrier(0)
__device__ __forceinline__ int v_st(int k, int c) { const int kk = (k & ~0xC) | ((k & 4) << 1) | ((k & 8) >> 1); return ((kk >> 3) * 4 + (c >> 5)) * 512 + ((kk & 7) * 32 + (c & 31)) * 2; }
__device__ __forceinline__ int v_rd_base(int lane) { return ((lane & 3) << 3) | (((lane >> 2) & 3) << 6) | (((lane >> 4) & 1) << 5) | (((lane >> 5) & 1) << 8); }
constexpr int v_rd_off(int d0, int ks, int half) { return d0 * 512 + ks * 4096 + half * 2048; }
__device__ __forceinline__ int crow(int r, int hi) { return (r & 3) + 8 * (r >> 2) + 4 * hi; }
__device__ __forceinline__ unsigned cvtpk(float lo, float hi) { unsigned r; asm volatile("v_cvt_pk_bf16_f32 %0, %1, %2" : "=v"(r) : "v"(lo), "v"(hi)); return r; }
__device__ __forceinline__ bf16x8 load8(const bf16* p) { return *reinterpret_cast<const bf16x8*>(p); }
__device__ __forceinline__ void mask_tile(f32x16& p0, f32x16& p1, int dq) {
    const float NEG = -__builtin_inff();
#pragma unroll
    for (int r = 0; r < 16; ++r) { const int c = (r & 3) + 8 * (r >> 2); if (dq - c < 0) p0[r] = NEG; if (dq - c - 32 < 0) p1[r] = NEG; }
}
__device__ __forceinline__ void alibi_tile(f32x16& p0, f32x16& p1, float sl2) {
#pragma unroll
    for (int r = 0; r < 16; ++r) { const float c = (float)((r & 3) + 8 * (r >> 2)); p0[r] = __builtin_fmaf(sl2, c, p0[r]); p1[r] = __builtin_fmaf(sl2, c + 32.f, p1[r]); }
}
__device__ __forceinline__ void partialSM(f32x16& p0, f32x16& p1, float base, float& m_reg, float& alpha) {
    float pmax = p0[0];
#pragma unroll
    for (int r = 1; r < 16; ++r) pmax = fmaxf(pmax, p0[r]);
#pragma unroll
    for (int r = 0; r < 16; ++r) pmax = fmaxf(pmax, p1[r]);
    { auto rr = __builtin_amdgcn_permlane32_swap(__float_as_uint(pmax), __float_as_uint(pmax), false, false); pmax = fmaxf(__uint_as_float(rr[0]), __uint_as_float(rr[1])); }
    pmax += base;
    float mn;
    if (__builtin_expect(__all(pmax - m_reg <= THR), 1)) { mn = m_reg; alpha = 1.f; }
    else { mn = fmaxf(m_reg, pmax); alpha = __builtin_amdgcn_exp2f(m_reg - mn); m_reg = mn; }
    const float mnL = base - mn;
#pragma unroll
    for (int r = 0; r < 16; ++r) p0[r] += mnL;
#pragma unroll
    for (int r = 0; r < 16; ++r) p1[r] += mnL;
#pragma unroll
    for (int r = 0; r < 16; ++r) p0[r] = __builtin_amdgcn_exp2f(p0[r]);
}
__device__ __forceinline__ void finishSM(f32x16& p0, f32x16& p1, float alpha, float& l_reg, bf16x8& pa0, bf16x8& pa1, bf16x8& pa2, bf16x8& pa3) {
#pragma unroll
    for (int r = 0; r < 16; ++r) p1[r] = __builtin_amdgcn_exp2f(p1[r]);
    float ps = 0;
#pragma unroll
    for (int r = 0; r < 16; ++r) ps += p0[r];
#pragma unroll
    for (int r = 0; r < 16; ++r) ps += p1[r];
    { auto rr = __builtin_amdgcn_permlane32_swap(__float_as_uint(ps), __float_as_uint(ps), false, false); ps = __uint_as_float(rr[0]) + __uint_as_float(rr[1]); }
    l_reg = l_reg * alpha + ps;
#define DPK4(P, B_, OUT) do { unsigned a0 = cvtpk(P[B_+0], P[B_+1]), a1 = cvtpk(P[B_+2], P[B_+3]); unsigned b0 = cvtpk(P[B_+4], P[B_+5]), b1 = cvtpk(P[B_+6], P[B_+7]); \
        auto r0 = __builtin_amdgcn_permlane32_swap(a0, b0, false, false); auto r1 = __builtin_amdgcn_permlane32_swap(a1, b1, false, false); \
        u32x4 w = {r0[0], r1[0], r0[1], r1[1]}; OUT = *reinterpret_cast<bf16x8*>(&w); } while (0)
    DPK4(p0, 0, pa0); DPK4(p0, 8, pa1); DPK4(p1, 0, pa2); DPK4(p1, 8, pa3);
#undef DPK4
}
__device__ __forceinline__ void qkt(f32x16& p0, f32x16& p1, const char* Kslot, int r32, int hi, const bf16x8* qr) {
    p0 = f32x16{}; p1 = f32x16{};
#pragma unroll
    for (int d0 = 0; d0 < 4; ++d0) { const char* a = Kslot + DKSWZ(r32, (d0 * 16 + hi * 8) * 2);
        const bf16x8 b0 = *reinterpret_cast<const bf16x8*>(a);
        const bf16x8 b1 = *reinterpret_cast<const bf16x8*>(a + 32 * 128);
        p0 = __builtin_amdgcn_mfma_f32_32x32x16_bf16(b0, qr[d0], p0, 0, 0, 0);
        p1 = __builtin_amdgcn_mfma_f32_32x32x16_bf16(b1, qr[d0], p1, 0, 0, 0); }
}
__device__ __forceinline__ void pv_tile(f32x16* o, int vb0, bf16x8 pa0, bf16x8 pa1, bf16x8 pa2, bf16x8 pa3) {
#define DTRRD(dst, off) asm volatile("ds_read_b64_tr_b16 %0, %1 offset:%2" : "=&v"(dst) : "v"(vb0), "i"(off) : "memory")
#define DPV_D0(d0) do { s16x4 l0, l1, l2, l3, h0, h1, h2, h3; constexpr int b_ = v_rd_off(d0, 0, 0); \
        DTRRD(l0, b_); DTRRD(h0, b_ + 2048); DTRRD(l1, b_ + 4096); DTRRD(h1, b_ + 6144); DTRRD(l2, b_ + 8192); DTRRD(h2, b_ + 10240); DTRRD(l3, b_ + 12288); DTRRD(h3, b_ + 14336); \
        asm volatile("s_waitcnt lgkmcnt(0)" ::: "memory"); DSBAR(); \
        o[d0] = __builtin_amdgcn_mfma_f32_32x32x16_bf16(pa0, (bf16x8){l0[0], l0[1], l0[2], l0[3], h0[0], h0[1], h0[2], h0[3]}, o[d0], 0, 0, 0); \
        o[d0] = __builtin_amdgcn_mfma_f32_32x32x16_bf16(pa1, (bf16x8){l1[0], l1[1], l1[2], l1[3], h1[0], h1[1], h1[2], h1[3]}, o[d0], 0, 0, 0); \
        o[d0] = __builtin_amdgcn_mfma_f32_32x32x16_bf16(pa2, (bf16x8){l2[0], l2[1], l2[2], l2[3], h2[0], h2[1], h2[2], h2[3]}, o[d0], 0, 0, 0); \
        o[d0] = __builtin_amdgcn_mfma_f32_32x32x16_bf16(pa3, (bf16x8){l3[0], l3[1], l3[2], l3[3], h3[0], h3[1], h3[2], h3[3]}, o[d0], 0, 0, 0); } while (0)
    DPV_D0(0); DPV_D0(1); DPV_D0(2); DPV_D0(3);
#undef DPV_D0
#undef DTRRD
}
struct BlockRef { const bf16* Q; const bf16* K; const bf16* V; bf16* O; int P0; int jlo; float sl2; };
struct Seam { bf16x8 qr[4]; bf16x8 st_v0, st_v1, st_k0; };
#define DROWV(p, k0, rr) ((p) + (size_t)((k0) + (rr)) * DM + sc)
#define DROWK(p, k0) ((p) + (size_t)((k0) + kr) * DM + kc)
#define DVMW() asm volatile("s_waitcnt vmcnt(0)" ::: "memory")
#define DVMWN(n) asm volatile("s_waitcnt vmcnt(%0)" :: "i"(n) : "memory")
#define DSLOAD(Kp, Vp, k0) do { S.st_v0 = load8(DROWV(Vp, k0, sr)); S.st_v1 = load8(DROWV(Vp, k0, 32 + sr)); S.st_k0 = load8(DROWK(Kp, k0)); } while (0)
#define DSWRITE_K(so) do { *(bf16x8*)(K_lds + (so) * SHM_K + kws) = S.st_k0; } while (0)
#define DSWRITE_V(so) do { *(bf16x8*)(V_lds + (so) * SHM_V + vst0) = S.st_v0; *(bf16x8*)(V_lds + (so) * SHM_V + vst1) = S.st_v1; } while (0)
__device__ __forceinline__ void datt_prime(const BlockRef& cur, char* lds, Seam& S) {
    const int tid = threadIdx.x, wid = __builtin_amdgcn_readfirstlane(tid >> 6), lane = tid & 63, r32 = lane & 31, hi = lane >> 5;
    const int sr = tid >> 4, sc = (tid & 15) * 8, kr = tid >> 3, kc = (tid & 7) * 8, kws = DKSWZ(kr, kc * 2); char* K_lds = lds + NSLOT * SHM_V;
    const int kb0 = cur.jlo * KVBLK;
#pragma unroll
    for (int d0 = 0; d0 < 4; ++d0) S.qr[d0] = load8(cur.Q + (size_t)(wid * QBLK + r32) * DM + d0 * 16 + hi * 8);
    DSLOAD(cur.K, cur.V, kb0); DVMW(); DSWRITE_K(0);
    __syncthreads();
}
__device__ __forceinline__ void datt_block(const BlockRef& cur, const BlockRef& nxt, char* lds, Seam& S) {
    const int tid = threadIdx.x, wid = __builtin_amdgcn_readfirstlane(tid >> 6), lane = tid & 63, r32 = lane & 31, hi = lane >> 5;
    const int j_lo = cur.jlo, j_hi = (cur.P0 + QB - 1) / KVBLK + 1, NT = j_hi - j_lo;
    const int kbn = nxt.jlo * KVBLK;
    const int qlo = cur.P0 + wid * QBLK, qm = qlo + r32 - 4 * hi;
    const float sl2 = cur.sl2;
    char* V_lds = lds; char* K_lds = lds + NSLOT * SHM_V;
    float* ws = (float*)(lds + NSLOT * SHM_V + NSLOT * SHM_K) + wid * 64; float* li_l = ws, * al_l = ws + 32;
    float m_reg = 4.0f, l_reg = 0; f32x16 o[4] = {};
    const int sr = tid >> 4, sc = (tid & 15) * 8, vst0 = v_st(sr, sc), vst1 = v_st(32 + sr, sc), kr = tid >> 3, kc = (tid & 7) * 8, kws = DKSWZ(kr, kc * 2);
    const int vb0 = (int)(uintptr_t)V_lds + v_rd_base(lane);
    const bf16* Kh = cur.K; const bf16* Vh = cur.V;
#define DRESC(a) do { if (__any((a) < 1.f)) { if (hi == 0) al_l[r32] = (a); asm volatile("s_waitcnt lgkmcnt(0)" ::: "memory"); \
                     _Pragma("unroll") for (int d_ = 0; d_ < 4; ++d_) _Pragma("unroll") for (int r = 0; r < 16; ++r) o[d_][r] *= al_l[crow(r, hi)]; } } while (0)
#define DKBASE(t) ((j_lo + (t)) * KVBLK)
#define DBIAS(t) (sl2 * (float)(DKBASE(t) - qm))
#define DMASKT(P0_, P1_, t) do { const int kb_ = DKBASE(t); alibi_tile(P0_, P1_, sl2); if (kb_ + KVBLK - 1 > qlo) mask_tile(P0_, P1_, qm - kb_); } while (0)
#define DSEAM_K0() do { DVMWN(4); DSWRITE_K(0); DSBAR(); } while (0)
    int s_p = 2, s_c = 0, s_n = 1;
#define DROT() do { const int t_ = s_p; s_p = s_c; s_c = s_n; s_n = t_; } while (0)
    f32x16 pA0, pA1, pB0, pB1; float alA, alB; bf16x8 pa0, pa1, pa2, pa3;
    DSWRITE_V(0); DSBAR();
    if (NT > 1) DSLOAD(Kh, Vh, DKBASE(1));
    DSBAR(); qkt(pA0, pA1, K_lds, r32, hi, S.qr);
    DMASKT(pA0, pA1, 0); partialSM(pA0, pA1, DBIAS(0), m_reg, alA);
    if (NT > 1) { DVMW(); DSWRITE_V(1); DSWRITE_K(1); }
    __syncthreads();
#define DHALF_STEP(PX0, PX1, alX, PY0, PY1, alY, t) do { DROT(); \
        DSBAR(); qkt(PX0, PX1, K_lds + s_c * SHM_K, r32, hi, S.qr); \
        finishSM(PY0, PY1, alY, l_reg, pa0, pa1, pa2, pa3); DSBAR(); \
        if ((t) + 1 < NT) { DSLOAD(Kh, Vh, DKBASE((t) + 1)); DSBAR(); } \
        pv_tile(o, vb0 + s_p * SHM_V, pa0, pa1, pa2, pa3); DMASKT(PX0, PX1, (t)); partialSM(PX0, PX1, DBIAS(t), m_reg, alX); \
        if ((t) + 1 < NT) { DVMW(); DSWRITE_V(s_n); DSWRITE_K(s_n); } \
        DRESC(alX); __syncthreads(); } while (0)
    for (int t = 1; t + 1 < NT; t += 2) {
        DHALF_STEP(pB0, pB1, alB, pA0, pA1, alA, t);
        DHALF_STEP(pA0, pA1, alA, pB0, pB1, alB, t + 1);
    }
    const bool even = (NT & 1) == 0;
    if (even) { DSBAR(); qkt(pB0, pB1, K_lds + s_n * SHM_K, r32, hi, S.qr); DSBAR(); }
    DSLOAD(nxt.K, nxt.V, kbn); DSBAR();
#pragma unroll
    for (int d0 = 0; d0 < 4; ++d0) S.qr[d0] = load8(nxt.Q + (size_t)(wid * QBLK + r32) * DM + d0 * 16 + hi * 8);
    DSBAR();
    finishSM(pA0, pA1, alA, l_reg, pa0, pa1, pa2, pa3); DSBAR();
    pv_tile(o, vb0 + s_c * SHM_V, pa0, pa1, pa2, pa3);
    if (even) { DMASKT(pB0, pB1, NT - 1); partialSM(pB0, pB1, DBIAS(NT - 1), m_reg, alB); __syncthreads(); DRESC(alB);
        finishSM(pB0, pB1, alB, l_reg, pa0, pa1, pa2, pa3); DSBAR(); pv_tile(o, vb0 + s_n * SHM_V, pa0, pa1, pa2, pa3); }
    else { __syncthreads(); }
    DSBAR(); DSEAM_K0();
    if (hi == 0) li_l[r32] = l_reg; asm volatile("s_waitcnt lgkmcnt(0)" ::: "memory");
    float rli[16];
#pragma unroll
    for (int r = 0; r < 16; ++r) rli[r] = __builtin_amdgcn_rcpf(li_l[crow(r, hi)]);
    bf16* Ow = cur.O + (size_t)(wid * QBLK) * DM;
#pragma unroll
    for (int r = 0; r < 16; ++r) { const int orow = crow(r, hi);
#pragma unroll
        for (int d0 = 0; d0 < 4; ++d0) { const float v = o[d0][r] * rli[r]; const float vn = __shfl_xor(v, 1);
            if ((r32 & 1) == 0) *(unsigned*)(Ow + (size_t)orow * DM + d0 * 32 + r32) = cvtpk(v, vn); } }
    __syncthreads();
#undef DRESC
#undef DKBASE
#undef DBIAS
#undef DMASKT
#undef DSEAM_K0
#undef DHALF_STEP
#undef DROT
}
#undef DROWV
#undef DROWK
#undef DVMW
#undef DVMWN
#undef DSLOAD
#undef DSWRITE_K
#undef DSWRITE_V
struct Tensors { const bf16* Q; const bf16* K; const bf16* V; bf16* O0; bf16* O1; const unsigned* NQ; const unsigned* NK; unsigned* qhead; const unsigned short* order; };
__device__ __forceinline__ BlockRef make_ref(const Tensors& T, unsigned code) {
    const int qb = code & 15, h = (code >> 4) & 7, b = (code >> 7) & 3, c = (code >> 9) & 1, hq = 2 * h + c;
    BlockRef r; const size_t rowb = (size_t)b * SEQ;
    r.Q = T.Q + (rowb + (size_t)qb * QB) * DM + hq * DQK; r.K = T.K + rowb * DM + hq * DQK; r.V = T.V + rowb * DM + h * DV; r.O = (c ? T.O1 : T.O0) + (rowb + (size_t)qb * QB) * DM + h * DV;
    r.P0 = qb * QB; r.sl2 = __builtin_amdgcn_exp2f(-(float)(h + 1)) * 1.4426950408889634f;
    int lane_ = threadIdx.x & 63; asm volatile("" : "+v"(lane_));
    const int nt_ = 4 * qb + 4; float qn_ = 0.f;
#pragma unroll
    for (int i_ = 0; i_ < 4; ++i_) qn_ = fmaxf(qn_, __uint_as_float(T.NQ[((b * 64 + 4 * qb + i_) * 16) + hq]));
    const float kn_ = lane_ < nt_ ? __uint_as_float(T.NK[((b * 64 + lane_) * 16) + hq]) : 0.f;
    const float bound_ = sqrtf(qn_) * sqrtf(kn_) * 1.001f - r.sl2 * (float)(256 * qb - 64 * lane_ - 63) - 4.0f;
    const unsigned long long keep_ = __ballot(lane_ < nt_ && !(bound_ < -152.0f));
    int first_ = keep_ ? (int)__builtin_ctzll(keep_) : nt_ - 1; if (first_ > nt_ - 4) first_ = nt_ - 4;
    r.jlo = __builtin_amdgcn_readfirstlane(first_);
    return r;
}
__device__ __forceinline__ int draw(const Tensors& T, volatile __attribute__((address_space(3))) unsigned* qw) {
    __syncthreads();
    if (threadIdx.x == 0) *qw = __hip_atomic_fetch_add(T.qhead, 1u, __ATOMIC_RELAXED, __HIP_MEMORY_SCOPE_AGENT);
    __syncthreads();
    return (int)*qw;
}
__device__ __forceinline__ void datt_phase(char* lds, volatile __attribute__((address_space(3))) unsigned* qw, const Tensors& T) {
    int i = draw(T, qw); if (i >= 1024) return;
    BlockRef cur = make_ref(T, T.order[i]);
    Seam S;
    datt_prime(cur, lds, S);
    for (;;) {
        const int in = draw(T, qw); const bool last = in >= 1024;
        const BlockRef nxt = last ? cur : make_ref(T, T.order[in]);
        datt_block(cur, nxt, lds, S);
        if (last) break;
        cur = nxt;
    }
}
#undef DKSWZ
#undef DSBAR
}
__device__ const unsigned short datt_order[1024] = {79,95,111,127,207,223,239,255,335,351,367,383,463,479,495,511,591,607,623,639,719,735,751,767,847,863,879,895,975,991,1007,1023,78,94,110,126,206,222,238,254,334,350,366,382,462,478,494,510,590,606,622,638,718,734,750,766,846,862,878,894,974,990,1006,1022,77,93,109,125,205,221,237,253,333,349,365,381,461,477,493,509,589,605,621,637,717,733,749,765,845,861,877,893,973,989,1005,1021,76,92,108,124,204,220,236,252,332,348,364,380,460,476,492,508,588,604,620,636,716,732,748,764,844,860,876,892,972,988,1004,1020,75,91,107,123,203,219,235,251,331,347,363,379,459,475,491,507,587,603,619,635,715,731,747,763,843,859,875,891,971,987,1003,1019,74,90,106,122,202,218,234,250,330,346,362,378,458,474,490,506,586,602,618,634,714,730,746,762,842,858,874,890,970,986,1002,1018,73,89,105,121,201,217,233,249,329,345,361,377,457,473,489,505,585,601,617,633,713,729,745,761,841,857,873,889,969,985,1001,1017,56,57,58,59,60,61,62,63,72,88,104,120,184,185,186,187,188,189,190,191,200,216,232,248,312,313,314,315,316,317,318,319,328,344,360,376,440,441,442,443,444,445,446,447,456,472,488,504,568,569,570,571,572,573,574,575,584,600,616,632,696,697,698,699,700,701,702,703,712,728,744,760,824,825,826,827,828,829,830,831,840,856,872,888,952,953,954,955,956,957,958,959,968,984,1000,1016,55,71,87,103,119,183,199,215,231,247,311,327,343,359,375,439,455,471,487,503,567,583,599,615,631,695,711,727,743,759,823,839,855,871,887,951,967,983,999,1015,54,70,86,102,118,182,198,214,230,246,310,326,342,358,374,438,454,470,486,502,566,582,598,614,630,694,710,726,742,758,822,838,854,870,886,950,966,982,998,1014,53,69,85,101,117,181,197,213,229,245,309,325,341,357,373,437,453,469,485,501,565,581,597,613,629,693,709,725,741,757,821,837,853,869,885,949,965,981,997,1013,36,37,38,39,40,41,42,43,44,45,46,47,52,68,84,100,116,164,165,166,167,168,169,170,171,172,173,174,175,180,196,212,228,244,292,293,294,295,296,297,298,299,300,301,302,303,308,324,340,356,372,420,421,422,423,424,425,426,427,428,429,430,431,436,452,468,484,500,548,549,550,551,552,553,554,555,556,557,558,559,564,580,596,612,628,676,677,678,679,680,681,682,683,684,685,686,687,692,708,724,740,756,804,805,806,807,808,809,810,811,812,813,814,815,820,836,852,868,884,932,933,934,935,936,937,938,939,940,941,942,943,948,964,980,996,1012,35,51,67,83,99,115,163,179,195,211,227,243,291,307,323,339,355,371,419,435,451,467,483,499,547,563,579,595,611,627,675,691,707,723,739,755,803,819,835,851,867,883,931,947,963,979,995,1011,18,19,20,21,22,23,24,25,26,27,28,29,30,31,34,50,66,82,98,114,146,147,148,149,150,151,152,153,154,155,156,157,158,159,162,178,194,210,226,242,274,275,276,277,278,279,280,281,282,283,284,285,286,287,290,306,322,338,354,370,402,403,404,405,406,407,408,409,410,411,412,413,414,415,418,434,450,466,482,498,530,531,532,533,534,535,536,537,538,539,540,541,542,543,546,562,578,594,610,626,658,659,660,661,662,663,664,665,666,667,668,669,670,671,674,690,706,722,738,754,786,787,788,789,790,791,792,793,794,795,796,797,798,799,802,818,834,850,866,882,914,915,916,917,918,919,920,921,922,923,924,925,926,927,930,946,962,978,994,1010,1,2,3,4,5,6,7,8,9,10,11,12,13,14,15,17,33,49,65,81,97,113,129,130,131,132,133,134,135,136,137,138,139,140,141,142,143,145,161,177,193,209,225,241,257,258,259,260,261,262,263,264,265,266,267,268,269,270,271,273,289,305,321,337,353,369,385,386,387,388,389,390,391,392,393,394,395,396,397,398,399,401,417,433,449,465,481,497,513,514,515,516,517,518,519,520,521,522,523,524,525,526,527,529,545,561,577,593,609,625,641,642,643,644,645,646,647,648,649,650,651,652,653,654,655,657,673,689,705,721,737,753,769,770,771,772,773,774,775,776,777,778,779,780,781,782,783,785,801,817,833,849,865,881,897,898,899,900,901,902,903,904,905,906,907,908,909,910,911,913,929,945,961,977,993,1009,0,16,32,48,64,80,96,112,128,144,160,176,192,208,224,240,256,272,288,304,320,336,352,368,384,400,416,432,448,464,480,496,512,528,544,560,576,592,608,624,640,656,672,688,704,720,736,752,768,784,800,816,832,848,864,880,896,912,928,944,960,976,992,1008};

constexpr int NWAVES = 8;
constexpr int BATCH = 4, SEQ = 4096, D = 2048, M = BATCH * SEQ;
constexpr int AW = 1024, NIN = 5120;
constexpr float LN_EPS = 1e-5f;
constexpr float DN_ALPHA = 1.189207115002721f;
constexpr float C2 = 0.125f * 1.4426950408889634f;
constexpr float LOG2E = 1.4426950408889634f;

constexpr size_t MiB = 1u << 20;
constexpr size_t WS_CTL = 0, CTL_ZERO_BYTES = 1 * MiB;
constexpr size_t WS_WIN = 2 * MiB, WS_WOUT = 22 * MiB, WS_WQ = 30 * MiB, WS_PRM = 38 * MiB;
constexpr size_t WS_XB = 392 * MiB;
constexpr size_t WS_MIX = 40 * MiB;
constexpr size_t WS_Q = 104 * MiB, WS_K = 136 * MiB, WS_V = 168 * MiB, WS_XR = 200 * MiB, WS_XG = 232 * MiB;
constexpr size_t WS_Y1 = 104 * MiB;
constexpr size_t WS_H1 = 232 * MiB;
constexpr size_t WS_H8 = 296 * MiB;
constexpr size_t WS_PQ = 104 * MiB;
constexpr size_t WS_SU = 38 * MiB + 65536, WS_SH = 38 * MiB + 131072;
constexpr size_t WS_WG = 38 * MiB + 262144;
constexpr size_t WS_PART = 104 * MiB;
constexpr size_t WS_FFN = 40 * MiB;
constexpr size_t WS_PK = 2 * MiB;
constexpr size_t WS_U8 = 328 * MiB, WS_V8 = 360 * MiB;
constexpr size_t WS_LA = 328 * MiB, WS_LB = 392 * MiB;
constexpr size_t WS_O0 = 264 * MiB, WS_O1 = 296 * MiB;
constexpr size_t WS_E = 456 * MiB, WS_G = 464 * MiB, WS_TOTA = 472 * MiB, WS_TOTH = 473 * MiB, WS_SKH = 474 * MiB, WS_SKL = 475 * MiB, WS_END = 476 * MiB;
constexpr int CW_BAR = 4096;
constexpr int CW_NQ = 32768, CW_NK = 32768 + 4096, CW_AQ = 32768 + 8192;

constexpr int RING_OFF = 0, RING_BYTES = 131072;
constexpr int LDSCTL_OFF = RING_BYTES, MISC_OFF = LDSCTL_OFF + 320;
constexpr int LDS_BYTES = 147456;

#define GAS __attribute__((address_space(1)))
#define LAS __attribute__((address_space(3)))
typedef unsigned short bf16;
typedef unsigned v4u __attribute__((ext_vector_type(4)));
typedef float f32x4 __attribute__((ext_vector_type(4)));
typedef GAS unsigned gu32;
#define RLX_AGENT __ATOMIC_RELAXED, __HIP_MEMORY_SCOPE_AGENT
#define LDS_WAIT() asm volatile("s_waitcnt lgkmcnt(0)" ::: "memory")
#define VM_WAIT() asm volatile("s_waitcnt vmcnt(0)" ::: "memory")
__device__ __forceinline__ unsigned f2bf(float f) { unsigned u = __builtin_bit_cast(unsigned, f); return (u + 0x7fffu + ((u >> 16) & 1u)) >> 16; }
__device__ __forceinline__ unsigned pk2(float lo, float hi) { return f2bf(lo) | (f2bf(hi) << 16); }
__device__ __forceinline__ float bf2f(unsigned short u) { return __uint_as_float(((unsigned)u) << 16); }
__device__ __forceinline__ float gelu_tanh(float x) { const float u = 0.7978845608028654f * (x + 0.044715f * x * x * x); return 0.5f * x * (1.f + tanhf(u)); }

#define XB_TMO      128
#define XB_XCNT(j)  (256  + 64 * (j))
#define XB_XSUB(j)  (1280 + 64 * (j))
#define XB_XGEN(j)  (2304 + 64 * (j))
#define XB_TOP      3328
#define XB_TOPGEN   3392
#define XCD_BAR_WORDS 3456
#define XB_SPIN_CAP (1u << 18)

__device__ __forceinline__ unsigned xb_ld(unsigned* p)              { return __hip_atomic_load(p, __ATOMIC_RELAXED, __HIP_MEMORY_SCOPE_AGENT); }
__device__ __forceinline__ unsigned xb_add(unsigned* p, unsigned v) { return __hip_atomic_fetch_add(p, v, __ATOMIC_RELAXED, __HIP_MEMORY_SCOPE_AGENT); }
__device__ __forceinline__ unsigned xb_xcc_id() { return (unsigned)__builtin_amdgcn_s_getreg((3 << 11) | 20) & 0xFu; }
#define XB_SPIN(cond, bar) do { unsigned _sp = 0; while (cond) { __builtin_amdgcn_s_sleep(1); \
    if ((++_sp & 255u) == 0u) { if (xb_ld(&(bar)[XB_TMO])) break; if (_sp > XB_SPIN_CAP) { atomicAdd(&(bar)[XB_TMO], 1u); break; } } } } while (0)

struct XcdBarrier {
    unsigned* bar; unsigned x;
    volatile LAS unsigned* st;
};

__device__ __forceinline__ XcdBarrier xcd_barrier_post(unsigned* bar, volatile LAS unsigned* st) {
    XcdBarrier b; b.bar = bar; b.x = xb_xcc_id(); b.st = st;
    if (threadIdx.x == 0) (void)xb_add(&bar[XB_XCNT(b.x)], 1u);
    return b;
}
__device__ __forceinline__ void xcd_barrier_complete(unsigned* bar, unsigned x, unsigned& nloc, unsigned& nx) {
    const unsigned G = gridDim.x * gridDim.y * gridDim.z;
    unsigned sum, cnt, mine, sp = 0u;
    for (;;) {
        sum = 0u; cnt = 0u; mine = 0u;
#pragma unroll
        for (unsigned j = 0; j < 16; ++j) { const unsigned c = xb_ld(&bar[XB_XCNT(j)]); sum += c; cnt += (c > 0u) ? 1u : 0u; mine = (j == x) ? c : mine; }
        if (sum == G) break;
        __builtin_amdgcn_s_sleep(1);
        if ((++sp & 255u) == 0u) { if (xb_ld(&bar[XB_TMO])) break; if (sp > XB_SPIN_CAP) { atomicAdd(&bar[XB_TMO], 1u); break; } }
    }
    nloc = mine > 0u ? mine : 1u; nx = cnt > 0u ? cnt : 1u;
}

__device__ __forceinline__ void xcd_barrier(const XcdBarrier& b) {
    asm volatile("s_waitcnt vmcnt(0)" ::: "memory");
    __syncthreads();
    if (threadIdx.x == 0) {
        unsigned* bar = b.bar;
        __builtin_amdgcn_s_waitcnt(0);
        unsigned nloc = b.st[0], nx = b.st[1];
        if (nloc == 0u) { xcd_barrier_complete(bar, b.x, nloc, nx); b.st[0] = nloc; b.st[1] = nx; }
        const unsigned old = xb_add(&bar[XB_XSUB(b.x)], 1u);
        const unsigned gen = old / nloc;
        if (old + 1u == (gen + 1u) * nloc) {
            __builtin_amdgcn_fence(__ATOMIC_RELEASE, "agent");
            asm volatile("s_waitcnt vmcnt(0)" ::: "memory");
            const unsigned og = xb_add(&bar[XB_TOP], 1u);
            const unsigned tg = og / nx;
            if (og + 1u == (tg + 1u) * nx) xb_add(&bar[XB_TOPGEN], 1u);
            else XB_SPIN(xb_ld(&bar[XB_TOPGEN]) == tg, bar);
            __builtin_amdgcn_fence(__ATOMIC_ACQUIRE, "agent");
            xb_add(&bar[XB_XGEN(b.x)], 1u);
            asm volatile("s_waitcnt vmcnt(0)" ::: "memory");
        } else {
            XB_SPIN(xb_ld(&bar[XB_XGEN(b.x)]) == gen, bar);
            __builtin_amdgcn_fence(__ATOMIC_ACQUIRE, "agent");
            asm volatile("s_waitcnt vmcnt(0)" ::: "memory");
        }
    }
    __syncthreads();
}

struct Frame {
    LAS unsigned char* lds;
    int tid, lane, wave;
    int vcu, G;
};

__device__ __forceinline__ void p0_transpose_item(const float* W, int K, int N, bf16* WT, int row_off, LAS float* scr, int item, int lane) {
    const int nblk = N / 32, kb = item / nblk, nb = item % nblk, k0 = 64 * kb, n0 = 32 * nb;
#pragma unroll 8
    for (int i = 0; i < 32; ++i) { const int kk = 2 * i + (lane >> 5); scr[kk * 33 + (lane & 31)] = W[(size_t)(k0 + kk) * N + n0 + (lane & 31)]; }
    LDS_WAIT(); asm volatile("" ::: "memory");
    const int c = lane & 7;
#pragma unroll
    for (int j = 0; j < 4; ++j) { const int n = (lane >> 3) + 8 * j; const LAS float* s = scr + (8 * c) * 33 + n;
        v4u o; o.x = pk2(s[0 * 33], s[1 * 33]); o.y = pk2(s[2 * 33], s[3 * 33]); o.z = pk2(s[4 * 33], s[5 * 33]); o.w = pk2(s[6 * 33], s[7 * 33]);
        *(GAS v4u*)(WT + (size_t)(row_off + n0 + n) * K + k0 + 8 * c) = o; }
    LDS_WAIT(); asm volatile("" ::: "memory");
}

typedef short bf16x8 __attribute__((ext_vector_type(8)));
typedef float f32x16 __attribute__((ext_vector_type(16)));
typedef float f32x2_t __attribute__((ext_vector_type(2))); typedef __bf16 bf16x2_t __attribute__((ext_vector_type(2)));
__device__ __forceinline__ unsigned cvtpk(float lo, float hi) { f32x2_t v = {lo, hi}; bf16x2_t b = __builtin_convertvector(v, bf16x2_t); return __builtin_bit_cast(unsigned, b); }
__device__ __forceinline__ void split8(const f32x4 a, const f32x4 b, bf16x8& h, bf16x8& l) {
    v4u hh; hh.x = cvtpk(a.x, a.y); hh.y = cvtpk(a.z, a.w); hh.z = cvtpk(b.x, b.y); hh.w = cvtpk(b.z, b.w);
    v4u ll;
    ll.x = cvtpk(a.x - __uint_as_float(hh.x << 16), a.y - __uint_as_float(hh.x & 0xffff0000u));
    ll.y = cvtpk(a.z - __uint_as_float(hh.y << 16), a.w - __uint_as_float(hh.y & 0xffff0000u));
    ll.z = cvtpk(b.x - __uint_as_float(hh.z << 16), b.y - __uint_as_float(hh.z & 0xffff0000u));
    ll.w = cvtpk(b.z - __uint_as_float(hh.w << 16), b.w - __uint_as_float(hh.w & 0xffff0000u));
    h = __builtin_bit_cast(bf16x8, hh); l = __builtin_bit_cast(bf16x8, ll);
}
__device__ __forceinline__ float max3f_(float a, float b, float c) { return __builtin_fmaxf(__builtin_fmaxf(a, b), c); }
__device__ __forceinline__ float pair_max(float m) { auto rr = __builtin_amdgcn_permlane32_swap(__float_as_uint(m), __float_as_uint(m), false, false); return __builtin_fmaxf(__uint_as_float(rr[0]), __uint_as_float(rr[1])); }
__device__ __forceinline__ void route_half(const float* qp, const v4u* kh, const v4u* kl, int lane, int hi, float (&lst)[16]) {
    f32x16 sc[4];
#pragma unroll
    for (int kt = 0; kt < 4; ++kt) sc[kt] = f32x16{};
#pragma unroll 2
    for (int ds = 0; ds < 8; ++ds) { bf16x8 qh, ql; split8(*(const f32x4*)(qp + 16 * ds), *(const f32x4*)(qp + 16 * ds + 4), qh, ql);
#pragma unroll
        for (int kt = 0; kt < 4; ++kt) { const bf16x8 ah = __builtin_bit_cast(bf16x8, kh[(kt * 8 + ds) * 64 + lane]), al = __builtin_bit_cast(bf16x8, kl[(kt * 8 + ds) * 64 + lane]);
            sc[kt] = __builtin_amdgcn_mfma_f32_32x32x16_bf16(ah, qh, sc[kt], 0, 0, 0);
            sc[kt] = __builtin_amdgcn_mfma_f32_32x32x16_bf16(ah, ql, sc[kt], 0, 0, 0);
            sc[kt] = __builtin_amdgcn_mfma_f32_32x32x16_bf16(al, qh, sc[kt], 0, 0, 0); } }
#pragma unroll
    for (int kt = 0; kt < 4; ++kt)
#pragma unroll
        for (int r = 0; r < 16; ++r) { const unsigned key = (unsigned)(kt * 32 + (r & 3) + 8 * (r >> 2) + 4 * hi); sc[kt][r] = __uint_as_float((__float_as_uint(sc[kt][r]) & ~127u) | (127u - key)); }
#pragma unroll
    for (int rd = 0; rd < 16; ++rd) {
        float m = max3f_(sc[0][0], sc[0][1], sc[0][2]);
#pragma unroll
        for (int n = 3; n + 1 < 64; n += 2) m = max3f_(m, sc[n >> 4][n & 15], sc[(n + 1) >> 4][(n + 1) & 15]);
        m = __builtin_fmaxf(m, sc[3][15]);
        const float gm = pair_max(m); lst[rd] = gm;
#pragma unroll
        for (int kt = 0; kt < 4; ++kt)
#pragma unroll
            for (int r = 0; r < 16; ++r) sc[kt][r] = (__float_as_uint(sc[kt][r]) == __float_as_uint(gm)) ? -INFINITY : sc[kt][r];
    }
}
typedef float f32x2v __attribute__((ext_vector_type(2)));
__device__ __forceinline__ unsigned pk4_fp8(float a, float b, float c, float d) { int p = __builtin_amdgcn_cvt_pk_fp8_f32(a, b, 0, false); p = __builtin_amdgcn_cvt_pk_fp8_f32(c, d, p, true); return (unsigned)p; }
constexpr float U8_SCALE = 64.f;
typedef short bf16x8_l __attribute__((ext_vector_type(8)));
template <int PASS> __device__ __forceinline__ void lru_phase(const Frame& F, unsigned char* ws, const float* conv_w, const float* conv_b, const float* b_a, const float* b_x, const float* lru_lambda) {
    constexpr int XS = 272;
    LAS unsigned char* xs = F.lds + RING_OFF;
    const bf16* XR = (const bf16*)(ws + WS_XR); const bf16* XG = (const bf16*)(ws + WS_XG); bf16* MIX = (bf16*)(ws + WS_MIX); const bf16* WGT = (const bf16*)(ws + WS_WG);
    float* TA = (float*)(ws + WS_TOTA); float* TH = (float*)(ws + WS_TOTH);
    const int tid = F.tid, lane = F.lane, w = F.wave, l15 = lane & 15, g = lane >> 4;
    const int hb = F.vcu & 7;
    const int nun = 2048 / 8;
    const int gi = F.vcu >> 3, gn = (F.G + 7 - hb) >> 3;
    const int chc = tid & 127, tg = tid >> 7, colc = hb * 128 + chc;
    const float cw0 = conv_w[colc], cw1 = conv_w[1024 + colc], cw2 = conv_w[2048 + colc], cw3 = conv_w[3072 + colc], cb = conv_b[colc];
    const int chn = hb * 128 + 16 * w + l15;
    bf16x8_l Ba[4], Bx[4];
#pragma unroll
    for (int ks = 0; ks < 4; ++ks) { Ba[ks] = *(const bf16x8_l*)(WGT + ((size_t)(hb * 128 + 16 * w + l15)) * 128 + 32 * ks + 8 * g); Bx[ks] = *(const bf16x8_l*)(WGT + ((size_t)((8 + hb) * 128 + 16 * w + l15)) * 128 + 32 * ks + 8 * g); }
    const float ba = b_a[chn], bx = b_x[chn], sp8 = 8.f * log1pf(__expf(-lru_lambda[chn]));
    unsigned short xrn[19], xgn[16]; float tan_[16], thn_[16];
#define LRU_LOAD(uu) do { const int c_ = (uu) & 63, b_ = (uu) >> 6, tok0_ = b_ * SEQ + c_ * 64; \
        _Pragma("unroll") for (int r = 0; r < 19; ++r) xrn[r] = (c_ * 64 + tg * 16 + r - 3 >= 0) ? XR[(size_t)(tok0_ + tg * 16 + r - 3) * AW + colc] : (unsigned short)0; \
        if (PASS == 2) { _Pragma("unroll") for (int m = 0; m < 4; ++m) _Pragma("unroll") for (int r = 0; r < 4; ++r) xgn[4 * m + r] = XG[(size_t)(tok0_ + 16 * m + 4 * g + r) * AW + chn]; \
            _Pragma("unroll") for (int i = 0; i < 16; ++i) { const int c2 = 16 * g + i, cl = c2 < c_ ? c2 : 0; tan_[i] = TA[(b_ * 64 + cl) * 1024 + chn]; thn_[i] = TH[(b_ * 64 + cl) * 1024 + chn]; } } } while (0)
    if (gi < nun) LRU_LOAD(gi);
    for (int uu = gi; uu < nun; uu += gn) {
        const int c = uu & 63, b = uu >> 6, tok0 = b * SEQ + c * 64;
        {
            float xv[19];
#pragma unroll
            for (int r = 0; r < 19; ++r) xv[r] = bf2f(xrn[r]);
#pragma unroll
            for (int i = 0; i < 16; ++i) { const float y = cb + cw0 * xv[i] + cw1 * xv[i + 1] + cw2 * xv[i + 2] + cw3 * xv[i + 3];
                *(LAS unsigned short*)(xs + (tg * 16 + i) * XS + chc * 2) = (unsigned short)f2bf(y); }
        }
        unsigned short xgv[16]; float ta[16], th[16];
        if (PASS == 2) {
#pragma unroll
            for (int i = 0; i < 16; ++i) { xgv[i] = xgn[i]; const int c2 = 16 * g + i; ta[i] = c2 < c ? tan_[i] : 1.f; th[i] = c2 < c ? thn_[i] : 0.f; } }
        __syncthreads();
        if (uu + gn < nun) LRU_LOAD(uu + gn);
        f32x4 ca[4], cx[4];
#pragma unroll
        for (int m = 0; m < 4; ++m) { ca[m] = (f32x4){0.f, 0.f, 0.f, 0.f}; cx[m] = (f32x4){0.f, 0.f, 0.f, 0.f};
#pragma unroll
            for (int ks = 0; ks < 4; ++ks) { const bf16x8_l A = *(const LAS bf16x8_l*)(xs + (16 * m + l15) * XS + (32 * ks + 8 * g) * 2);
                ca[m] = __builtin_amdgcn_mfma_f32_16x16x32_bf16(A, Ba[ks], ca[m], 0, 0, 0); cx[m] = __builtin_amdgcn_mfma_f32_16x16x32_bf16(A, Bx[ks], cx[m], 0, 0, 0); } }
        float av[4][4], bv[4][4];
#pragma unroll
        for (int m = 0; m < 4; ++m)
#pragma unroll
            for (int r = 0; r < 4; ++r) { const int tt = 16 * m + 4 * g + r;
                const float rg = 1.f / (1.f + __expf(-(ca[m][r] + ba))), ig = 1.f / (1.f + __expf(-(cx[m][r] + bx)));
                const float a = __expf(-sp8 * rg), xcv = bf2f(*(const LAS unsigned short*)(xs + tt * XS + (16 * w + l15) * 2));
                av[m][r] = a; bv[m][r] = sqrtf(fmaxf(1.f - a * a, 0.f)) * ig * xcv; }
        float carry = 0.f, Ac = 1.f;
        if (PASS == 2) {
            float Ap = 1.f, Hp = 0.f;
#pragma unroll
            for (int i = 0; i < 16; ++i) { Hp = ta[i] * Hp + th[i]; Ap *= ta[i]; }
            { const float A1 = __shfl_up(Ap, 16), H1 = __shfl_up(Hp, 16); if (g >= 1) { Hp = Ap * H1 + Hp; Ap = Ap * A1; } }
            { const float A2 = __shfl_up(Ap, 32), H2 = __shfl_up(Hp, 32); if (g >= 2) { Hp = Ap * H2 + Hp; Ap = Ap * A2; } }
            carry = __shfl(Hp, 48 + l15);
        }
#pragma unroll
        for (int m = 0; m < 4; ++m) {
            float As = (av[m][0] * av[m][1]) * (av[m][2] * av[m][3]);
            float Hs = ((bv[m][0] * av[m][1] + bv[m][1]) * av[m][2] + bv[m][2]) * av[m][3] + bv[m][3];
            { const float A1 = __shfl_up(As, 16), H1 = __shfl_up(Hs, 16); if (g >= 1) { Hs = As * H1 + Hs; As = As * A1; } }
            { const float A2 = __shfl_up(As, 32), H2 = __shfl_up(Hs, 32); if (g >= 2) { Hs = As * H2 + Hs; As = As * A2; } }
            const float At = __shfl(As, 48 + l15), Ht = __shfl(Hs, 48 + l15);
            if (PASS == 2) {
                float Ae = __shfl_up(As, 16), He = __shfl_up(Hs, 16); if (g == 0) { Ae = 1.f; He = 0.f; }
                float h = Ae * carry + He;
#pragma unroll
                for (int r = 0; r < 4; ++r) { h = av[m][r] * h + bv[m][r]; const int tt = 16 * m + 4 * g + r;
                    MIX[(size_t)(tok0 + tt) * D + 1024 + chn] = (bf16)f2bf(h * gelu_tanh(bf2f(xgv[4 * m + r]))); }
            }
            carry = At * carry + Ht; Ac *= At;
        }
        if (PASS == 1 && g == 0) { TA[(b * 64 + c) * 1024 + chn] = Ac; TH[(b * 64 + c) * 1024 + chn] = carry; }
        __syncthreads();
    }
#undef LRU_LOAD
}
struct Args { const float* in[23]; float* out; unsigned char* ws; int ph_lo, ph_hi; };

__global__ void __launch_bounds__(NWAVES * 64, 2) skel_fwd(Args args) {
    extern __shared__ __attribute__((aligned(16))) unsigned char lds[];
    Frame F;
    F.lds = (LAS unsigned char*)lds;
    F.tid = threadIdx.x; F.lane = F.tid & 63; F.wave = __builtin_amdgcn_readfirstlane(F.tid >> 6);
    F.G = gridDim.x; { const int bx = blockIdx.x; F.vcu = (F.G % 8 == 0) ? (bx % 8) * (F.G / 8) + bx / 8 : bx; }
    unsigned char* ws = args.ws;
    const float* x = args.in[0];
    bf16* WIN_T = (bf16*)(ws + WS_WIN); bf16* WOUT_T = (bf16*)(ws + WS_WOUT); bf16* WQ_T = (bf16*)(ws + WS_WQ);
    bf16* XB = (bf16*)(ws + WS_XB); bf16* MIX = (bf16*)(ws + WS_MIX); bf16* QB = (bf16*)(ws + WS_Q); bf16* H1 = (bf16*)(ws + WS_H1);
    float* Y1 = (float*)(ws + WS_Y1); float* PQ = (float*)(ws + WS_PQ);
    for (int u = F.tid; u < (LDS_BYTES - LDSCTL_OFF) / 4; u += NWAVES * 64) ((LAS unsigned*)(F.lds + LDSCTL_OFF))[u] = 0u;
    __syncthreads();
    XcdBarrier bar = xcd_barrier_post((unsigned*)(ws + WS_CTL) + CW_BAR, (volatile LAS unsigned*)(F.lds + MISC_OFF) + 8);
    const unsigned phmask = (unsigned)args.ph_lo;
    int slot_ = 0;
#define IN(k) (false)
#define RUN(slotbit) ((phmask >> (slotbit)) & 1u)
#define GRID_BAR() do { if (phmask == 0xffffffffu) xcd_barrier(bar); } while (0)

    if (RUN(0)) {
        if (blockIdx.x == 0 && F.wave == 0) {
            float a_ = args.in[9][F.lane] * args.in[10][F.lane], b_ = args.in[11][F.lane] * args.in[12][F.lane];
#pragma unroll
            for (int o = 1; o < 64; o <<= 1) { a_ += __shfl_xor(a_, o); b_ += __shfl_xor(b_, o); }
            if (F.lane == 0) ((float*)(ws + WS_PRM))[0] = expf(a_) - expf(b_) + 0.2f;
        }
        LAS float* scr = (LAS float*)(F.lds + RING_OFF + F.wave * 16384);
        const int gw = F.vcu * NWAVES + F.wave, NGW = F.G * NWAVES;
        constexpr int I_IN = (D / 64) * (NIN / 32), I_SQ = (D / 64) * (D / 32);
        constexpr int NITEMS = I_IN + 2 * I_SQ;
        for (int it = gw; it < NITEMS; it += NGW) {
            int r = it;
            if (r < I_IN) { p0_transpose_item(args.in[1], D, NIN, WIN_T, 0, scr, r, F.lane); continue; } r -= I_IN;
            if (r < I_SQ) { p0_transpose_item(args.in[14], D, D, WOUT_T, 0, scr, r, F.lane); continue; } r -= I_SQ;
            p0_transpose_item(args.in[17], D, D, WQ_T, 0, scr, r, F.lane);
        }
        for (int it = gw; it < 128; it += NGW) { const int mt = it >> 3;
            p0_transpose_item(args.in[mt < 8 ? 4 : 6] + (size_t)(mt & 7) * 16384, 128, 128, (bf16*)(ws + WS_WG) + (size_t)mt * 16384, 0, scr, it & 7, F.lane); }
        {
            const float* sk = args.in[18]; v4u* SKH = (v4u*)(ws + WS_SKH); v4u* SKL = (v4u*)(ws + WS_SKL);
            for (int fi = gw; fi < 512; fi += NGW) { const int ds = fi & 7, kt = (fi >> 3) & 3, hp = fi >> 5;
                const float* src = sk + ((size_t)(hp * 128 + kt * 32 + (F.lane & 31)) * 128 + 16 * ds + 8 * (F.lane >> 5));
                bf16x8 h8, l8; split8(*(const f32x4*)src, *(const f32x4*)(src + 4), h8, l8);
                SKH[fi * 64 + F.lane] = __builtin_bit_cast(v4u, h8); SKL[fi * 64 + F.lane] = __builtin_bit_cast(v4u, l8); }
        }
        for (int m = gw; m < M; m += NGW) {
            const GAS f32x4* xr = (const GAS f32x4*)(x + (size_t)m * D) + F.lane;
            GAS unsigned long long* o8 = (GAS unsigned long long*)(XB + (size_t)m * D) + F.lane;
#pragma unroll
            for (int j = 0; j < 8; ++j) { const f32x4 v = xr[64 * j]; o8[64 * j] = (unsigned long long)pk2(v.x, v.y) | ((unsigned long long)pk2(v.z, v.w) << 32); }
        }
    }
    GRID_BAR();
    if (RUN(1)) {
        pg8::Gemm g{XB, WIN_T, M, NIN, D}; pg8::StaticOrder S; S.init(M, NIN, F.G, (int)blockIdx.x);
        pg8::EpiBf16<0> E{QB, AW, nullptr, AW, (size_t)(WS_K - WS_Q) / 2, C2};
        pg8::gemm_phase<pg8::EpiBf16<0>, pg8::StaticOrder, PG8_ALIGN, PG8_SP2>(F.lds + RING_OFF, g, S, E);
    }
    GRID_BAR();
    if (RUN(2)) { lru_phase<1>(F, ws, args.in[2], args.in[3], args.in[5], args.in[7], args.in[8]);
        {
            const int gw = F.vcu * NWAVES + F.wave, NGW = F.G * NWAVES, lane = F.lane; unsigned* ctlw = (unsigned*)(ws + WS_CTL);
            for (int it = gw; it < 2 * (M / 16); it += NGW) { const int z = it & 1, r16 = it >> 1; const bf16* src = (const bf16*)(ws + (z ? WS_K : WS_Q)) + (size_t)r16 * 16 * AW + 8 * lane;
                float mx0 = 0.f, mx1 = 0.f;
#pragma unroll 4
                for (int r = 0; r < 16; ++r) {
#pragma unroll
                    for (int hf = 0; hf < 2; ++hf) { const v4u q = *(const v4u*)(src + (size_t)r * AW + hf * 512); float ss = 0.f;
#pragma unroll
                        for (int e = 0; e < 4; ++e) { const float lo = __uint_as_float(q[e] << 16), hi = __uint_as_float(q[e] & 0xffff0000u); ss += lo * lo + hi * hi; }
                        ss += __builtin_bit_cast(float, __builtin_amdgcn_update_dpp(0, __builtin_bit_cast(int, ss), 0xB1, 0xf, 0xf, true)); ss += __builtin_bit_cast(float, __builtin_amdgcn_update_dpp(0, __builtin_bit_cast(int, ss), 0x4E, 0xf, 0xf, true));
                        ss += __builtin_bit_cast(float, __builtin_amdgcn_update_dpp(0, __builtin_bit_cast(int, ss), 0x141, 0xf, 0xf, true));
                        if (hf == 0) mx0 = fmaxf(mx0, ss); else mx1 = fmaxf(mx1, ss); } }
                if ((lane & 7) == 0) { unsigned* dst = ctlw + (z ? CW_NK : CW_NQ) + (r16 >> 2) * 16 + (lane >> 3); atomicMax(dst, __float_as_uint(mx0)); atomicMax(dst + 8, __float_as_uint(mx1)); }
            }
        }
    }
    GRID_BAR();
    if (RUN(4)) {
        static_assert(datt::LDS_BYTES <= RING_BYTES, "attention LDS vs ring");
        const datt::Tensors DT{(const datt::bf16*)QB, (const datt::bf16*)(ws + WS_K), (const datt::bf16*)(ws + WS_V), (datt::bf16*)(ws + WS_O0), (datt::bf16*)(ws + WS_O1),
                               (const unsigned*)(ws + WS_CTL) + CW_NQ, (const unsigned*)(ws + WS_CTL) + CW_NK, (unsigned*)(ws + WS_CTL) + CW_AQ, datt_order};
        datt::datt_phase((char*)lds + RING_OFF, (volatile LAS unsigned*)(F.lds + MISC_OFF) + 16, DT);
    }
    if (RUN(5)) lru_phase<2>(F, ws, args.in[2], args.in[3], args.in[5], args.in[7], args.in[8]);
    GRID_BAR();
    if (RUN(6)) {
        const int gw = F.vcu * NWAVES + F.wave, NGW = F.G * NWAVES, sub = F.lane >> 4, l16 = F.lane & 15;
        const float lam = ((const float*)(ws + WS_PRM))[0];
        const bf16* O0 = (const bf16*)(ws + WS_O0); const bf16* O1 = (const bf16*)(ws + WS_O1);
        float gs[8];
#pragma unroll
        for (int e = 0; e < 8; ++e) gs[e] = args.in[13][l16 * 8 + e] * 0.8f;
        for (int it = gw; it < M * 2; it += NGW) { const int item = it * 4 + sub, tok = item >> 3, h = item & 7;
            const v4u a = *(const v4u*)(O0 + (size_t)tok * AW + h * 128 + l16 * 8), b = *(const v4u*)(O1 + (size_t)tok * AW + h * 128 + l16 * 8);
            float d[8]; float ss = 0.f;
#pragma unroll
            for (int e = 0; e < 4; ++e) { d[2 * e] = __uint_as_float(a[e] << 16) - lam * __uint_as_float(b[e] << 16); d[2 * e + 1] = __uint_as_float(a[e] & 0xffff0000u) - lam * __uint_as_float(b[e] & 0xffff0000u); ss += d[2 * e] * d[2 * e] + d[2 * e + 1] * d[2 * e + 1]; }
            ss += __builtin_bit_cast(float, __builtin_amdgcn_update_dpp(0, __builtin_bit_cast(int, ss), 0xB1, 0xf, 0xf, true)); ss += __builtin_bit_cast(float, __builtin_amdgcn_update_dpp(0, __builtin_bit_cast(int, ss), 0x4E, 0xf, 0xf, true));
            ss += __builtin_bit_cast(float, __builtin_amdgcn_update_dpp(0, __builtin_bit_cast(int, ss), 0x141, 0xf, 0xf, true)); ss += __builtin_bit_cast(float, __builtin_amdgcn_update_dpp(0, __builtin_bit_cast(int, ss), 0x140, 0xf, 0xf, true));
            const float r = rsqrtf(ss * (1.f / 128.f) + LN_EPS);
            *(v4u*)(MIX + (size_t)tok * D + h * 128 + l16 * 8) = (v4u){pk2(d[0] * r * gs[0], d[1] * r * gs[1]), pk2(d[2] * r * gs[2], d[3] * r * gs[3]), pk2(d[4] * r * gs[4], d[5] * r * gs[5]), pk2(d[6] * r * gs[6], d[7] * r * gs[7])}; }
    }
    GRID_BAR();
    if (RUN(7)) {
        pg8::Gemm g{MIX, WOUT_T, M, D, D}; pg8::StaticOrder S; S.init(M, D, F.G, (int)blockIdx.x);
        pg8::EpiBf16<0> E{(bf16*)Y1, D, nullptr, 0, 0, 1.f};
        pg8::gemm_phase<pg8::EpiBf16<0>, pg8::StaticOrder, PG8_ALIGN, PG8_SP2>(F.lds + RING_OFF, g, S, E);
    }
    GRID_BAR();
    if (RUN(8)) {
        const int gw = F.vcu * NWAVES + F.wave, NGW = F.G * NWAVES; const float* g = args.in[15]; const float* bb = args.in[16];
        for (int row = gw; row < M; row += NGW) {
            const unsigned long long* xr_ = (const unsigned long long*)(XB + (size_t)row * D); const unsigned long long* yb = (const unsigned long long*)((const bf16*)Y1 + (size_t)row * D);
            f32x4 v[8]; float s = 0.f;
#pragma unroll
            for (int j = 0; j < 8; ++j) { const unsigned long long x_ = xr_[F.lane + 64 * j]; const unsigned x0 = (unsigned)x_, x1 = (unsigned)(x_ >> 32); const f32x4 xv_ = (f32x4){__uint_as_float(x0 << 16), __uint_as_float(x0 & 0xffff0000u), __uint_as_float(x1 << 16), __uint_as_float(x1 & 0xffff0000u)};
                const unsigned long long q_ = yb[F.lane + 64 * j]; const unsigned q0 = (unsigned)q_, q1 = (unsigned)(q_ >> 32);
                v[j].x = DN_ALPHA * xv_.x + __uint_as_float(q0 << 16); v[j].y = DN_ALPHA * xv_.y + __uint_as_float(q0 & 0xffff0000u); v[j].z = DN_ALPHA * xv_.z + __uint_as_float(q1 << 16); v[j].w = DN_ALPHA * xv_.w + __uint_as_float(q1 & 0xffff0000u);
                s += (v[j].x + v[j].y) + (v[j].z + v[j].w); }
#pragma unroll
            for (int o = 1; o < 64; o <<= 1) s += __shfl_xor(s, o);
            const float mean = s * (1.f / D); float s2 = 0.f;
#pragma unroll
            for (int j = 0; j < 8; ++j) { v[j] = v[j] - mean; s2 += (v[j].x * v[j].x + v[j].y * v[j].y) + (v[j].z * v[j].z + v[j].w * v[j].w); }
#pragma unroll
            for (int o = 1; o < 64; o <<= 1) s2 += __shfl_xor(s2, o);
            const float rstd = rsqrtf(s2 * (1.f / D) + LN_EPS);
#pragma unroll
            for (int j = 0; j < 8; ++j) { const int c = (F.lane + 64 * j) * 4; const f32x4 gg = *(const f32x4*)(g + c), bv = *(const f32x4*)(bb + c);
                const f32x4 o = v[j] * rstd * gg + bv;
                *(unsigned long long*)(H1 + (size_t)row * D + c) = (unsigned long long)pk2(o.x, o.y) | ((unsigned long long)pk2(o.z, o.w) << 32);
                v[j] = o; }
            float am = 0.f;
#pragma unroll
            for (int j = 0; j < 8; ++j) am = fmaxf(fmaxf(am, fmaxf(fabsf(v[j].x), fabsf(v[j].y))), fmaxf(fabsf(v[j].z), fabsf(v[j].w)));
#pragma unroll
            for (int o = 1; o < 64; o <<= 1) am = fmaxf(am, __shfl_xor(am, o));
            const float qs = am > 0.f ? 127.f / am : 0.f;
            if (F.lane == 0) ((float*)(ws + WS_SH))[row] = am * (1.f / 127.f);
#pragma unroll
            for (int j = 0; j < 8; ++j) { const int c = (F.lane + 64 * j) * 4;
                const unsigned q = ((unsigned)(int)rintf(v[j].x * qs) & 0xffu) | (((unsigned)(int)rintf(v[j].y * qs) & 0xffu) << 8) | (((unsigned)(int)rintf(v[j].z * qs) & 0xffu) << 16) | (((unsigned)(int)rintf(v[j].w * qs) & 0xffu) << 24);
                *(unsigned*)(ws + WS_H8 + ((size_t)(c >> 7) * M + row) * 128 + (c & 127)) = q; }
        }
        {
            const float* us = args.in[19]; float* SU = (float*)(ws + WS_SU);
            for (int e = gw; e < 16384; e += NGW) {
                const f32x4* ur = (const f32x4*)(us + (size_t)e * D); f32x4 uv[8]; float am = 0.f;
#pragma unroll
                for (int j = 0; j < 8; ++j) { uv[j] = ur[F.lane + 64 * j]; am = fmaxf(fmaxf(am, fmaxf(fabsf(uv[j].x), fabsf(uv[j].y))), fmaxf(fabsf(uv[j].z), fabsf(uv[j].w))); }
#pragma unroll
                for (int o = 1; o < 64; o <<= 1) am = fmaxf(am, __shfl_xor(am, o));
                const float qs = am > 0.f ? 127.f / am : 0.f;
                if (F.lane == 0) SU[e] = am * (1.f / 127.f);
#pragma unroll
                for (int j = 0; j < 8; ++j) { const int c = (F.lane + 64 * j) * 4;
                    const unsigned q = ((unsigned)(int)rintf(uv[j].x * qs) & 0xffu) | (((unsigned)(int)rintf(uv[j].y * qs) & 0xffu) << 8) | (((unsigned)(int)rintf(uv[j].z * qs) & 0xffu) << 16) | (((unsigned)(int)rintf(uv[j].w * qs) & 0xffu) << 24);
                    *(unsigned*)(ws + WS_U8 + ((size_t)(c >> 7) * 16384 + e) * 128 + (c & 127)) = q; }
            }
        }
        {
            const float* vs = args.in[20]; unsigned char* V8 = ws + WS_V8; LAS unsigned char* tl = F.lds + RING_OFF;
            for (int t = F.vcu; t < 256 * 8; t += F.G) { const int e0 = (t >> 3) * 64, c0 = (t & 7) * 256;
                __syncthreads();
#pragma unroll
                for (int j = 0; j < 8; ++j) { const int idx = F.tid + 512 * j, r = idx >> 6, c = 4 * (idx & 63);
                    const f32x4 v = *(const f32x4*)(vs + (size_t)(e0 + r) * D + c0 + c);
                    *(LAS unsigned*)(tl + (c >> 3) * 512 + r * 8 + (c & 7)) = pk4_fp8(v.x, v.y, v.z, v.w); }
                __syncthreads();
#pragma unroll
                for (int j = 0; j < 2; ++j) { const int cu = (F.tid >> 5) + 16 * j, pc = F.tid & 31;
                    *(v4u*)(V8 + ((size_t)((c0 >> 3) + cu) * 16384 + e0) * 8 + pc * 16) = *(const LAS v4u*)(tl + cu * 512 + pc * 16); }
            }
            __syncthreads();
        }
    }
    GRID_BAR();
    if (RUN(9)) {
        pg8::Gemm g{H1, WQ_T, M, D, D}; pg8::StaticOrder S; S.init(M, D, F.G, (int)blockIdx.x);
        pg8::EpiF32 E{PQ, D, nullptr, 0.f};
        pg8::gemm_phase<pg8::EpiF32, pg8::StaticOrder, PG8_ALIGN, PG8_SP2>(F.lds + RING_OFF, g, S, E);
    }
    GRID_BAR();
    if (RUN(10)) {
        const int nh = (F.G & 7) == 0 ? 8 : 1;
        int* E = (int*)(ws + WS_E); float* G = (float*)(ws + WS_G);
        for (int h = F.vcu % nh; h < 8; h += nh) {
            __syncthreads();
            {
                int tq = F.tid; asm volatile("" : "+v"(tq));
#pragma unroll 4
                for (int j = 0; j < 16; ++j) { const int i = tq + 512 * j, p = i >> 12, hl = (i >> 11) & 1, fl = i & 2047;
                    *(LAS v4u*)(F.lds + RING_OFF + (size_t)i * 16) = ((const v4u*)(ws + WS_SKH))[(size_t)hl * 65536 + (size_t)(h * 2 + p) * 2048 + fl]; }
            }
            __syncthreads();
            const int wv = (F.vcu / nh) * NWAVES + F.wave, nwv = ((F.G + nh - 1 - F.vcu % nh) / nh) * NWAVES;
            f32x4 qn[16];
#define ROUTE_LOADQ() do { _Pragma("unroll") for (int ds = 0; ds < 8; ++ds) { qn[2 * ds] = *(const f32x4*)(qptr + 16 * ds); qn[2 * ds + 1] = *(const f32x4*)(qptr + 16 * ds + 4); } } while (0)
            const float* qptr = PQ + (size_t)(wv * 32 + (F.lane & 31)) * D + h * 256 + 8 * (F.lane >> 5);
            if (wv < M / 32) ROUTE_LOADQ();
            for (int tg = wv; tg < M / 32; tg += nwv) { int ln_ = F.lane; asm volatile("" : "+v"(ln_));
                const int tl = ln_ & 31, hi = ln_ >> 5, tok = tg * 32 + tl;
                LAS unsigned char* scr = F.lds + RING_BYTES + 1024 + F.wave * 1024 + tl * 32;
                float sa[16], sb[16];
#pragma unroll
                for (int p = 0; p < 2; ++p) {
                    f32x16 sc[4];
#pragma unroll
                    for (int kt = 0; kt < 4; ++kt) sc[kt] = f32x16{};
#pragma unroll
                    for (int ds = 0; ds < 8; ++ds) { bf16x8 qh, ql; split8(qn[2 * ds], qn[2 * ds + 1], qh, ql);
#pragma unroll
                        for (int kt = 0; kt < 4; ++kt) { const bf16x8 ah = *(const LAS bf16x8*)(F.lds + RING_OFF + ((p * 2 + 0) * 32 + kt * 8 + ds) * 1024 + F.lane * 16), al = *(const LAS bf16x8*)(F.lds + RING_OFF + ((p * 2 + 1) * 32 + kt * 8 + ds) * 1024 + F.lane * 16);
                            sc[kt] = __builtin_amdgcn_mfma_f32_32x32x16_bf16(ah, qh, sc[kt], 0, 0, 0);
                            sc[kt] = __builtin_amdgcn_mfma_f32_32x32x16_bf16(ah, ql, sc[kt], 0, 0, 0);
                            sc[kt] = __builtin_amdgcn_mfma_f32_32x32x16_bf16(al, qh, sc[kt], 0, 0, 0); } }
                    if (p == 0) { qptr += 128; ROUTE_LOADQ(); } else if (tg + nwv < M / 32) { qptr += (size_t)nwv * 32 * D - 128; ROUTE_LOADQ(); }
#pragma unroll
                    for (int kt = 0; kt < 4; ++kt)
#pragma unroll
                        for (int r = 0; r < 16; ++r) { const unsigned key = (unsigned)(kt * 32 + (r & 3) + 8 * (r >> 2) + 4 * hi); sc[kt][r] = __uint_as_float((__float_as_uint(sc[kt][r]) & ~127u) | (127u - key)); }
#define CE_(x, y) do { const float h_ = __builtin_fmaxf(x, y), l_ = __builtin_fminf(x, y); x = h_; y = l_; } while (0)
                    CE_(sc[0][0], sc[0][1]); CE_(sc[0][2], sc[0][3]); CE_(sc[0][0], sc[0][2]); CE_(sc[0][1], sc[0][3]); CE_(sc[0][1], sc[0][2]); CE_(sc[0][4], sc[0][5]); CE_(sc[0][6], sc[0][7]); CE_(sc[0][4], sc[0][6]); CE_(sc[0][5], sc[0][7]); CE_(sc[0][5], sc[0][6]); CE_(sc[0][0], sc[0][4]); CE_(sc[0][2], sc[0][6]); CE_(sc[0][2], sc[0][4]); CE_(sc[0][1], sc[0][5]); CE_(sc[0][3], sc[0][7]); CE_(sc[0][3], sc[0][5]); CE_(sc[0][1], sc[0][2]); CE_(sc[0][3], sc[0][4]); CE_(sc[0][5], sc[0][6]); CE_(sc[0][8], sc[0][9]); CE_(sc[0][10], sc[0][11]); CE_(sc[0][8], sc[0][10]); CE_(sc[0][9], sc[0][11]); CE_(sc[0][9], sc[0][10]); CE_(sc[0][12], sc[0][13]); CE_(sc[0][14], sc[0][15]); CE_(sc[0][12], sc[0][14]); CE_(sc[0][13], sc[0][15]); CE_(sc[0][13], sc[0][14]); CE_(sc[0][8], sc[0][12]); CE_(sc[0][10], sc[0][14]); CE_(sc[0][10], sc[0][12]); CE_(sc[0][9], sc[0][13]); CE_(sc[0][11], sc[0][15]); CE_(sc[0][11], sc[0][13]); CE_(sc[0][9], sc[0][10]); CE_(sc[0][11], sc[0][12]); CE_(sc[0][13], sc[0][14]); CE_(sc[0][0], sc[0][8]); CE_(sc[0][4], sc[0][12]); CE_(sc[0][4], sc[0][8]); CE_(sc[0][2], sc[0][10]); CE_(sc[0][6], sc[0][14]); CE_(sc[0][6], sc[0][10]); CE_(sc[0][2], sc[0][4]); CE_(sc[0][6], sc[0][8]); CE_(sc[0][10], sc[0][12]); CE_(sc[0][1], sc[0][9]); CE_(sc[0][5], sc[0][13]); CE_(sc[0][5], sc[0][9]); CE_(sc[0][3], sc[0][11]); CE_(sc[0][7], sc[0][15]); CE_(sc[0][7], sc[0][11]); CE_(sc[0][3], sc[0][5]); CE_(sc[0][7], sc[0][9]); CE_(sc[0][11], sc[0][13]); CE_(sc[0][1], sc[0][2]); CE_(sc[0][3], sc[0][4]); CE_(sc[0][5], sc[0][6]); CE_(sc[0][7], sc[0][8]); CE_(sc[0][9], sc[0][10]); CE_(sc[0][11], sc[0][12]); CE_(sc[0][13], sc[0][14]);
                    CE_(sc[1][0], sc[1][1]); CE_(sc[1][2], sc[1][3]); CE_(sc[1][0], sc[1][2]); CE_(sc[1][1], sc[1][3]); CE_(sc[1][1], sc[1][2]); CE_(sc[1][4], sc[1][5]); CE_(sc[1][6], sc[1][7]); CE_(sc[1][4], sc[1][6]); CE_(sc[1][5], sc[1][7]); CE_(sc[1][5], sc[1][6]); CE_(sc[1][0], sc[1][4]); CE_(sc[1][2], sc[1][6]); CE_(sc[1][2], sc[1][4]); CE_(sc[1][1], sc[1][5]); CE_(sc[1][3], sc[1][7]); CE_(sc[1][3], sc[1][5]); CE_(sc[1][1], sc[1][2]); CE_(sc[1][3], sc[1][4]); CE_(sc[1][5], sc[1][6]); CE_(sc[1][8], sc[1][9]); CE_(sc[1][10], sc[1][11]); CE_(sc[1][8], sc[1][10]); CE_(sc[1][9], sc[1][11]); CE_(sc[1][9], sc[1][10]); CE_(sc[1][12], sc[1][13]); CE_(sc[1][14], sc[1][15]); CE_(sc[1][12], sc[1][14]); CE_(sc[1][13], sc[1][15]); CE_(sc[1][13], sc[1][14]); CE_(sc[1][8], sc[1][12]); CE_(sc[1][10], sc[1][14]); CE_(sc[1][10], sc[1][12]); CE_(sc[1][9], sc[1][13]); CE_(sc[1][11], sc[1][15]); CE_(sc[1][11], sc[1][13]); CE_(sc[1][9], sc[1][10]); CE_(sc[1][11], sc[1][12]); CE_(sc[1][13], sc[1][14]); CE_(sc[1][0], sc[1][8]); CE_(sc[1][4], sc[1][12]); CE_(sc[1][4], sc[1][8]); CE_(sc[1][2], sc[1][10]); CE_(sc[1][6], sc[1][14]); CE_(sc[1][6], sc[1][10]); CE_(sc[1][2], sc[1][4]); CE_(sc[1][6], sc[1][8]); CE_(sc[1][10], sc[1][12]); CE_(sc[1][1], sc[1][9]); CE_(sc[1][5], sc[1][13]); CE_(sc[1][5], sc[1][9]); CE_(sc[1][3], sc[1][11]); CE_(sc[1][7], sc[1][15]); CE_(sc[1][7], sc[1][11]); CE_(sc[1][3], sc[1][5]); CE_(sc[1][7], sc[1][9]); CE_(sc[1][11], sc[1][13]); CE_(sc[1][1], sc[1][2]); CE_(sc[1][3], sc[1][4]); CE_(sc[1][5], sc[1][6]); CE_(sc[1][7], sc[1][8]); CE_(sc[1][9], sc[1][10]); CE_(sc[1][11], sc[1][12]); CE_(sc[1][13], sc[1][14]);
                    CE_(sc[2][0], sc[2][1]); CE_(sc[2][2], sc[2][3]); CE_(sc[2][0], sc[2][2]); CE_(sc[2][1], sc[2][3]); CE_(sc[2][1], sc[2][2]); CE_(sc[2][4], sc[2][5]); CE_(sc[2][6], sc[2][7]); CE_(sc[2][4], sc[2][6]); CE_(sc[2][5], sc[2][7]); CE_(sc[2][5], sc[2][6]); CE_(sc[2][0], sc[2][4]); CE_(sc[2][2], sc[2][6]); CE_(sc[2][2], sc[2][4]); CE_(sc[2][1], sc[2][5]); CE_(sc[2][3], sc[2][7]); CE_(sc[2][3], sc[2][5]); CE_(sc[2][1], sc[2][2]); CE_(sc[2][3], sc[2][4]); CE_(sc[2][5], sc[2][6]); CE_(sc[2][8], sc[2][9]); CE_(sc[2][10], sc[2][11]); CE_(sc[2][8], sc[2][10]); CE_(sc[2][9], sc[2][11]); CE_(sc[2][9], sc[2][10]); CE_(sc[2][12], sc[2][13]); CE_(sc[2][14], sc[2][15]); CE_(sc[2][12], sc[2][14]); CE_(sc[2][13], sc[2][15]); CE_(sc[2][13], sc[2][14]); CE_(sc[2][8], sc[2][12]); CE_(sc[2][10], sc[2][14]); CE_(sc[2][10], sc[2][12]); CE_(sc[2][9], sc[2][13]); CE_(sc[2][11], sc[2][15]); CE_(sc[2][11], sc[2][13]); CE_(sc[2][9], sc[2][10]); CE_(sc[2][11], sc[2][12]); CE_(sc[2][13], sc[2][14]); CE_(sc[2][0], sc[2][8]); CE_(sc[2][4], sc[2][12]); CE_(sc[2][4], sc[2][8]); CE_(sc[2][2], sc[2][10]); CE_(sc[2][6], sc[2][14]); CE_(sc[2][6], sc[2][10]); CE_(sc[2][2], sc[2][4]); CE_(sc[2][6], sc[2][8]); CE_(sc[2][10], sc[2][12]); CE_(sc[2][1], sc[2][9]); CE_(sc[2][5], sc[2][13]); CE_(sc[2][5], sc[2][9]); CE_(sc[2][3], sc[2][11]); CE_(sc[2][7], sc[2][15]); CE_(sc[2][7], sc[2][11]); CE_(sc[2][3], sc[2][5]); CE_(sc[2][7], sc[2][9]); CE_(sc[2][11], sc[2][13]); CE_(sc[2][1], sc[2][2]); CE_(sc[2][3], sc[2][4]); CE_(sc[2][5], sc[2][6]); CE_(sc[2][7], sc[2][8]); CE_(sc[2][9], sc[2][10]); CE_(sc[2][11], sc[2][12]); CE_(sc[2][13], sc[2][14]);
                    CE_(sc[3][0], sc[3][1]); CE_(sc[3][2], sc[3][3]); CE_(sc[3][0], sc[3][2]); CE_(sc[3][1], sc[3][3]); CE_(sc[3][1], sc[3][2]); CE_(sc[3][4], sc[3][5]); CE_(sc[3][6], sc[3][7]); CE_(sc[3][4], sc[3][6]); CE_(sc[3][5], sc[3][7]); CE_(sc[3][5], sc[3][6]); CE_(sc[3][0], sc[3][4]); CE_(sc[3][2], sc[3][6]); CE_(sc[3][2], sc[3][4]); CE_(sc[3][1], sc[3][5]); CE_(sc[3][3], sc[3][7]); CE_(sc[3][3], sc[3][5]); CE_(sc[3][1], sc[3][2]); CE_(sc[3][3], sc[3][4]); CE_(sc[3][5], sc[3][6]); CE_(sc[3][8], sc[3][9]); CE_(sc[3][10], sc[3][11]); CE_(sc[3][8], sc[3][10]); CE_(sc[3][9], sc[3][11]); CE_(sc[3][9], sc[3][10]); CE_(sc[3][12], sc[3][13]); CE_(sc[3][14], sc[3][15]); CE_(sc[3][12], sc[3][14]); CE_(sc[3][13], sc[3][15]); CE_(sc[3][13], sc[3][14]); CE_(sc[3][8], sc[3][12]); CE_(sc[3][10], sc[3][14]); CE_(sc[3][10], sc[3][12]); CE_(sc[3][9], sc[3][13]); CE_(sc[3][11], sc[3][15]); CE_(sc[3][11], sc[3][13]); CE_(sc[3][9], sc[3][10]); CE_(sc[3][11], sc[3][12]); CE_(sc[3][13], sc[3][14]); CE_(sc[3][0], sc[3][8]); CE_(sc[3][4], sc[3][12]); CE_(sc[3][4], sc[3][8]); CE_(sc[3][2], sc[3][10]); CE_(sc[3][6], sc[3][14]); CE_(sc[3][6], sc[3][10]); CE_(sc[3][2], sc[3][4]); CE_(sc[3][6], sc[3][8]); CE_(sc[3][10], sc[3][12]); CE_(sc[3][1], sc[3][9]); CE_(sc[3][5], sc[3][13]); CE_(sc[3][5], sc[3][9]); CE_(sc[3][3], sc[3][11]); CE_(sc[3][7], sc[3][15]); CE_(sc[3][7], sc[3][11]); CE_(sc[3][3], sc[3][5]); CE_(sc[3][7], sc[3][9]); CE_(sc[3][11], sc[3][13]); CE_(sc[3][1], sc[3][2]); CE_(sc[3][3], sc[3][4]); CE_(sc[3][5], sc[3][6]); CE_(sc[3][7], sc[3][8]); CE_(sc[3][9], sc[3][10]); CE_(sc[3][11], sc[3][12]); CE_(sc[3][13], sc[3][14]);
                    sc[0][0] = __builtin_fmaxf(sc[0][0], sc[1][15]); sc[0][1] = __builtin_fmaxf(sc[0][1], sc[1][14]); sc[0][2] = __builtin_fmaxf(sc[0][2], sc[1][13]); sc[0][3] = __builtin_fmaxf(sc[0][3], sc[1][12]); sc[0][4] = __builtin_fmaxf(sc[0][4], sc[1][11]); sc[0][5] = __builtin_fmaxf(sc[0][5], sc[1][10]); sc[0][6] = __builtin_fmaxf(sc[0][6], sc[1][9]); sc[0][7] = __builtin_fmaxf(sc[0][7], sc[1][8]); sc[0][8] = __builtin_fmaxf(sc[0][8], sc[1][7]); sc[0][9] = __builtin_fmaxf(sc[0][9], sc[1][6]); sc[0][10] = __builtin_fmaxf(sc[0][10], sc[1][5]); sc[0][11] = __builtin_fmaxf(sc[0][11], sc[1][4]); sc[0][12] = __builtin_fmaxf(sc[0][12], sc[1][3]); sc[0][13] = __builtin_fmaxf(sc[0][13], sc[1][2]); sc[0][14] = __builtin_fmaxf(sc[0][14], sc[1][1]); sc[0][15] = __builtin_fmaxf(sc[0][15], sc[1][0]);
                    CE_(sc[0][0], sc[0][8]); CE_(sc[0][1], sc[0][9]); CE_(sc[0][2], sc[0][10]); CE_(sc[0][3], sc[0][11]); CE_(sc[0][4], sc[0][12]); CE_(sc[0][5], sc[0][13]); CE_(sc[0][6], sc[0][14]); CE_(sc[0][7], sc[0][15]); CE_(sc[0][0], sc[0][4]); CE_(sc[0][1], sc[0][5]); CE_(sc[0][2], sc[0][6]); CE_(sc[0][3], sc[0][7]); CE_(sc[0][8], sc[0][12]); CE_(sc[0][9], sc[0][13]); CE_(sc[0][10], sc[0][14]); CE_(sc[0][11], sc[0][15]); CE_(sc[0][0], sc[0][2]); CE_(sc[0][1], sc[0][3]); CE_(sc[0][4], sc[0][6]); CE_(sc[0][5], sc[0][7]); CE_(sc[0][8], sc[0][10]); CE_(sc[0][9], sc[0][11]); CE_(sc[0][12], sc[0][14]); CE_(sc[0][13], sc[0][15]); CE_(sc[0][0], sc[0][1]); CE_(sc[0][2], sc[0][3]); CE_(sc[0][4], sc[0][5]); CE_(sc[0][6], sc[0][7]); CE_(sc[0][8], sc[0][9]); CE_(sc[0][10], sc[0][11]); CE_(sc[0][12], sc[0][13]); CE_(sc[0][14], sc[0][15]);
                    sc[2][0] = __builtin_fmaxf(sc[2][0], sc[3][15]); sc[2][1] = __builtin_fmaxf(sc[2][1], sc[3][14]); sc[2][2] = __builtin_fmaxf(sc[2][2], sc[3][13]); sc[2][3] = __builtin_fmaxf(sc[2][3], sc[3][12]); sc[2][4] = __builtin_fmaxf(sc[2][4], sc[3][11]); sc[2][5] = __builtin_fmaxf(sc[2][5], sc[3][10]); sc[2][6] = __builtin_fmaxf(sc[2][6], sc[3][9]); sc[2][7] = __builtin_fmaxf(sc[2][7], sc[3][8]); sc[2][8] = __builtin_fmaxf(sc[2][8], sc[3][7]); sc[2][9] = __builtin_fmaxf(sc[2][9], sc[3][6]); sc[2][10] = __builtin_fmaxf(sc[2][10], sc[3][5]); sc[2][11] = __builtin_fmaxf(sc[2][11], sc[3][4]); sc[2][12] = __builtin_fmaxf(sc[2][12], sc[3][3]); sc[2][13] = __builtin_fmaxf(sc[2][13], sc[3][2]); sc[2][14] = __builtin_fmaxf(sc[2][14], sc[3][1]); sc[2][15] = __builtin_fmaxf(sc[2][15], sc[3][0]);
                    CE_(sc[2][0], sc[2][8]); CE_(sc[2][1], sc[2][9]); CE_(sc[2][2], sc[2][10]); CE_(sc[2][3], sc[2][11]); CE_(sc[2][4], sc[2][12]); CE_(sc[2][5], sc[2][13]); CE_(sc[2][6], sc[2][14]); CE_(sc[2][7], sc[2][15]); CE_(sc[2][0], sc[2][4]); CE_(sc[2][1], sc[2][5]); CE_(sc[2][2], sc[2][6]); CE_(sc[2][3], sc[2][7]); CE_(sc[2][8], sc[2][12]); CE_(sc[2][9], sc[2][13]); CE_(sc[2][10], sc[2][14]); CE_(sc[2][11], sc[2][15]); CE_(sc[2][0], sc[2][2]); CE_(sc[2][1], sc[2][3]); CE_(sc[2][4], sc[2][6]); CE_(sc[2][5], sc[2][7]); CE_(sc[2][8], sc[2][10]); CE_(sc[2][9], sc[2][11]); CE_(sc[2][12], sc[2][14]); CE_(sc[2][13], sc[2][15]); CE_(sc[2][0], sc[2][1]); CE_(sc[2][2], sc[2][3]); CE_(sc[2][4], sc[2][5]); CE_(sc[2][6], sc[2][7]); CE_(sc[2][8], sc[2][9]); CE_(sc[2][10], sc[2][11]); CE_(sc[2][12], sc[2][13]); CE_(sc[2][14], sc[2][15]);
                    sc[0][0] = __builtin_fmaxf(sc[0][0], sc[2][15]); sc[0][1] = __builtin_fmaxf(sc[0][1], sc[2][14]); sc[0][2] = __builtin_fmaxf(sc[0][2], sc[2][13]); sc[0][3] = __builtin_fmaxf(sc[0][3], sc[2][12]); sc[0][4] = __builtin_fmaxf(sc[0][4], sc[2][11]); sc[0][5] = __builtin_fmaxf(sc[0][5], sc[2][10]); sc[0][6] = __builtin_fmaxf(sc[0][6], sc[2][9]); sc[0][7] = __builtin_fmaxf(sc[0][7], sc[2][8]); sc[0][8] = __builtin_fmaxf(sc[0][8], sc[2][7]); sc[0][9] = __builtin_fmaxf(sc[0][9], sc[2][6]); sc[0][10] = __builtin_fmaxf(sc[0][10], sc[2][5]); sc[0][11] = __builtin_fmaxf(sc[0][11], sc[2][4]); sc[0][12] = __builtin_fmaxf(sc[0][12], sc[2][3]); sc[0][13] = __builtin_fmaxf(sc[0][13], sc[2][2]); sc[0][14] = __builtin_fmaxf(sc[0][14], sc[2][1]); sc[0][15] = __builtin_fmaxf(sc[0][15], sc[2][0]);
                    CE_(sc[0][0], sc[0][8]); CE_(sc[0][1], sc[0][9]); CE_(sc[0][2], sc[0][10]); CE_(sc[0][3], sc[0][11]); CE_(sc[0][4], sc[0][12]); CE_(sc[0][5], sc[0][13]); CE_(sc[0][6], sc[0][14]); CE_(sc[0][7], sc[0][15]); CE_(sc[0][0], sc[0][4]); CE_(sc[0][1], sc[0][5]); CE_(sc[0][2], sc[0][6]); CE_(sc[0][3], sc[0][7]); CE_(sc[0][8], sc[0][12]); CE_(sc[0][9], sc[0][13]); CE_(sc[0][10], sc[0][14]); CE_(sc[0][11], sc[0][15]); CE_(sc[0][0], sc[0][2]); CE_(sc[0][1], sc[0][3]); CE_(sc[0][4], sc[0][6]); CE_(sc[0][5], sc[0][7]); CE_(sc[0][8], sc[0][10]); CE_(sc[0][9], sc[0][11]); CE_(sc[0][12], sc[0][14]); CE_(sc[0][13], sc[0][15]); CE_(sc[0][0], sc[0][1]); CE_(sc[0][2], sc[0][3]); CE_(sc[0][4], sc[0][5]); CE_(sc[0][6], sc[0][7]); CE_(sc[0][8], sc[0][9]); CE_(sc[0][10], sc[0][11]); CE_(sc[0][12], sc[0][13]); CE_(sc[0][14], sc[0][15]);
                    { float la[16], lb[16];
#pragma unroll
                      for (int i = 0; i < 16; ++i) { auto rr = __builtin_amdgcn_permlane32_swap(__float_as_uint(sc[0][i]), __float_as_uint(sc[0][i]), false, false); la[i] = __uint_as_float(rr[0]); lb[i] = __uint_as_float(rr[1]); }
#pragma unroll
                      for (int i = 0; i < 16; ++i) la[i] = __builtin_fmaxf(la[i], lb[15 - i]);
                      CE_(la[0], la[8]); CE_(la[1], la[9]); CE_(la[2], la[10]); CE_(la[3], la[11]); CE_(la[4], la[12]); CE_(la[5], la[13]); CE_(la[6], la[14]); CE_(la[7], la[15]); CE_(la[0], la[4]); CE_(la[1], la[5]); CE_(la[2], la[6]); CE_(la[3], la[7]); CE_(la[8], la[12]); CE_(la[9], la[13]); CE_(la[10], la[14]); CE_(la[11], la[15]); CE_(la[0], la[2]); CE_(la[1], la[3]); CE_(la[4], la[6]); CE_(la[5], la[7]); CE_(la[8], la[10]); CE_(la[9], la[11]); CE_(la[12], la[14]); CE_(la[13], la[15]); CE_(la[0], la[1]); CE_(la[2], la[3]); CE_(la[4], la[5]); CE_(la[6], la[7]); CE_(la[8], la[9]); CE_(la[10], la[11]); CE_(la[12], la[13]); CE_(la[14], la[15]);
#pragma unroll
                      for (int i = 0; i < 16; ++i) { if (p == 0) sa[i] = la[i]; else sb[i] = la[i]; } }
#undef CE_
                }
                { unsigned w[4];
    #pragma unroll
                  for (int q = 0; q < 4; ++q) { w[q] = 0u;
    #pragma unroll
                      for (int e = 0; e < 4; ++e) { const unsigned ka = 127u - (__float_as_uint(sa[4 * q + e]) & 127u), kb = 127u - (__float_as_uint(sb[4 * q + e]) & 127u); w[q] |= (hi ? kb : ka) << (8 * e); } }
                  *(LAS v4u*)(scr + 16 * hi) = (v4u){w[0], w[1], w[2], w[3]}; }
                float cd[25];
    #define CV_(i, j) __uint_as_float((__float_as_uint(sa[i] + sb[j]) & ~255u) | (255u - (unsigned)(16 * (i) + (j))))
                cd[0] = hi ? CV_(0, 1) : CV_(0, 0);
                cd[1] = hi ? CV_(0, 3) : CV_(0, 2);
                cd[2] = hi ? CV_(0, 5) : CV_(0, 4);
                cd[3] = hi ? CV_(0, 7) : CV_(0, 6);
                cd[4] = hi ? CV_(0, 9) : CV_(0, 8);
                cd[5] = hi ? CV_(0, 11) : CV_(0, 10);
                cd[6] = hi ? CV_(0, 13) : CV_(0, 12);
                cd[7] = hi ? CV_(0, 15) : CV_(0, 14);
                cd[8] = hi ? CV_(1, 1) : CV_(1, 0);
                cd[9] = hi ? CV_(1, 3) : CV_(1, 2);
                cd[10] = hi ? CV_(1, 5) : CV_(1, 4);
                cd[11] = hi ? CV_(1, 7) : CV_(1, 6);
                cd[12] = hi ? CV_(2, 1) : CV_(2, 0);
                cd[13] = hi ? CV_(2, 3) : CV_(2, 2);
                cd[14] = hi ? CV_(3, 0) : CV_(2, 4);
                cd[15] = hi ? CV_(3, 2) : CV_(3, 1);
                cd[16] = hi ? CV_(4, 0) : CV_(3, 3);
                cd[17] = hi ? CV_(4, 2) : CV_(4, 1);
                cd[18] = hi ? CV_(5, 1) : CV_(5, 0);
                cd[19] = hi ? CV_(6, 1) : CV_(6, 0);
                cd[20] = hi ? CV_(7, 1) : CV_(7, 0);
                cd[21] = hi ? CV_(9, 0) : CV_(8, 0);
                cd[22] = hi ? CV_(11, 0) : CV_(10, 0);
                cd[23] = hi ? CV_(13, 0) : CV_(12, 0);
                cd[24] = hi ? CV_(15, 0) : CV_(14, 0);
    #undef CV_
                float top[16];
    #pragma unroll
                for (int rd = 0; rd < 16; ++rd) {
                    float m = cd[0];
    #pragma unroll
                    for (int n = 1; n + 1 < 25; n += 2) m = max3f_(m, cd[n], cd[n + 1]);
                    const float gm = pair_max(m); top[rd] = gm;
    #pragma unroll
                    for (int n = 0; n < 25; ++n) cd[n] = (__float_as_uint(cd[n]) == __float_as_uint(gm)) ? -INFINITY : cd[n];
                }
                float ex[16], sum = 0.f;
    #pragma unroll
                for (int r = 0; r < 16; ++r) { ex[r] = __builtin_amdgcn_exp2f((top[r] - top[0]) * LOG2E); sum += ex[r]; }
                const float inv = 1.f / sum;
                asm volatile("s_waitcnt lgkmcnt(0)" ::: "memory");
                int eo[8]; float go[8];
    #pragma unroll
                for (int rr = 0; rr < 8; ++rr) { float t0 = top[rr], t1 = top[rr + 8], e0 = ex[rr], e1 = ex[rr + 8]; asm volatile("" : "+v"(t0), "+v"(t1), "+v"(e0), "+v"(e1));
                    const unsigned f = 255u - (__float_as_uint(hi ? t1 : t0) & 255u);
                    const int ia = scr[f >> 4], ib = scr[16 + (f & 15)]; eo[rr] = ia * 128 + ib; go[rr] = (hi ? e1 : e0) * inv; }
                int* ep = E + (size_t)tok * 128 + h * 16 + 8 * hi; float* gp = G + (size_t)tok * 128 + h * 16 + 8 * hi;
                *(v4u*)ep = (v4u){(unsigned)eo[0], (unsigned)eo[1], (unsigned)eo[2], (unsigned)eo[3]}; *(v4u*)(ep + 4) = (v4u){(unsigned)eo[4], (unsigned)eo[5], (unsigned)eo[6], (unsigned)eo[7]};
                *(f32x4*)gp = (f32x4){go[0], go[1], go[2], go[3]}; *(f32x4*)(gp + 4) = (f32x4){go[4], go[5], go[6], go[7]};
                asm volatile("s_waitcnt lgkmcnt(0)" ::: "memory");
            }
        }
#undef ROUTE_LOADQ
    }
    GRID_BAR();
    if (RUN(11)) {
        const int nlab = F.G < 8 ? F.G : 8, label = (int)blockIdx.x % nlab, nblk = (F.G - label + nlab - 1) / nlab, wx = ((int)blockIdx.x / nlab) * NWAVES + F.wave, nwx = nblk * NWAVES;
        const int lane = F.lane, rr = lane >> 3, cc = lane & 7;
        const int* E = (const int*)(ws + WS_E);
        for (int sl = label; sl < 16; sl += nlab) {
            const unsigned char* Us = ws + WS_U8 + (size_t)sl * 16384 * 128 + 16 * cc;
            const unsigned char* Hs = ws + WS_H8 + (size_t)sl * M * 128 + 16 * cc;
            for (int item = wx; item < M / 8; item += nwx) { const int tok = item * 8 + rr;
                const v4u hq = *(const v4u*)(Hs + (size_t)tok * 128);
                const v4u* ep = (const v4u*)(E + (size_t)tok * 128);
                int res[16];
#pragma unroll
                for (int i = 0; i < 16; ++i) res[i] = 0;
#pragma unroll
                for (int i = 0; i < 16; ++i) {
                    const v4u e0 = ep[2 * i], e1 = ep[2 * i + 1];
#pragma unroll
                    for (int j = 0; j < 8; ++j) { const unsigned e = j < 4 ? e0[j & 3] : e1[j & 3];
                        const v4u a = *(const v4u*)(Us + (size_t)e * 128);
                        int d = __builtin_amdgcn_sdot4((int)a.x, (int)hq.x, 0, false); d = __builtin_amdgcn_sdot4((int)a.y, (int)hq.y, d, false); d = __builtin_amdgcn_sdot4((int)a.z, (int)hq.z, d, false); d = __builtin_amdgcn_sdot4((int)a.w, (int)hq.w, d, false);
                        d += __builtin_amdgcn_update_dpp(0, d, 0xB1, 0xf, 0xf, true); d += __builtin_amdgcn_update_dpp(0, d, 0x4E, 0xf, 0xf, true); d += __builtin_amdgcn_update_dpp(0, d, 0x141, 0xf, 0xf, true);
                        res[i] = (cc == j) ? d : res[i]; } }
                v4u* po = (v4u*)((short*)(ws + WS_PART) + (size_t)sl * M * 128 + (size_t)tok * 128 + cc * 16);
                unsigned pw[8];
#pragma unroll
                for (int q = 0; q < 8; ++q) pw[q] = ((unsigned)((res[2 * q] + 32) >> 6) & 0xffffu) | ((unsigned)((res[2 * q + 1] + 32) >> 6) << 16);
                po[0] = (v4u){pw[0], pw[1], pw[2], pw[3]}; po[1] = (v4u){pw[4], pw[5], pw[6], pw[7]};
            }
        }
    }
    GRID_BAR();
    if (RUN(12)) {
        const short* P = (const short*)(ws + WS_PART); const int* E = (const int*)(ws + WS_E); const float* G = (const float*)(ws + WS_G); unsigned* PK = (unsigned*)(ws + WS_PK);
        const float* SU = (const float*)(ws + WS_SU); const float* SH = (const float*)(ws + WS_SH);
        for (int idx = F.vcu * 512 + F.tid; idx < M * 128; idx += F.G * 512) { const int tok = idx >> 7, k = idx & 127; const size_t pi = (size_t)tok * 128 + (k & 7) * 16 + (k >> 3); int hsum = 0;
#pragma unroll
            for (int sl = 0; sl < 16; ++sl) hsum += (int)P[(size_t)sl * M * 128 + pi];
            const int e = E[idx];
            const float w = G[idx] * gelu_tanh((float)hsum * 64.f * SU[e] * SH[tok]);
            PK[(size_t)(tok >> 6) * 8192 + (k >> 2) * 256 + (tok & 63) * 4 + (k & 3)] = (unsigned)e | (f2bf(w) << 16); }
    }
    GRID_BAR();
    if (RUN(13)) {
        const unsigned* PK = (const unsigned*)(ws + WS_PK); bf16* FFN = (bf16*)(ws + WS_FFN);
        for (int c = F.vcu; c < 256; c += F.G) {
            __syncthreads();
            { int tq = F.tid; asm volatile("" : "+v"(tq)); const v4u* src = (const v4u*)(ws + WS_V8 + (size_t)c * 131072) + tq;
#pragma unroll 4
              for (int j = 0; j < 16; ++j) *(LAS v4u*)(F.lds + RING_OFF + (tq + 512 * j) * 16) = src[512 * j]; }
            __syncthreads();
            for (int tb = F.wave; tb < M / 64; tb += NWAVES) { int ln_ = F.lane; asm volatile("" : "+v"(ln_));
                const v4u* pk = (const v4u*)(PK + (size_t)tb * 8192) + ln_;
                f32x2v av[4];
#pragma unroll
                for (int i = 0; i < 4; ++i) av[i] = (f32x2v){0.f, 0.f};
                v4u pb[32];
#pragma unroll
                for (int kq = 0; kq < 32; ++kq) pb[kq] = pk[kq * 64];
#pragma unroll
                for (int kq = 0; kq < 32; ++kq) { const v4u p4 = pb[kq];
#pragma unroll
                    for (int j = 0; j < 4; ++j) { const unsigned p = p4[j]; const float w = __uint_as_float(p & 0xffff0000u); const f32x2v ww = (f32x2v){w, w};
                        const unsigned long long d = *(const LAS unsigned long long*)(F.lds + RING_OFF + ((p & 0xffffu) << 3));
                        const int d0 = (int)(unsigned)d, d1 = (int)(unsigned)(d >> 32);
                        av[0] = av[0] + __builtin_amdgcn_cvt_pk_f32_fp8(d0, false) * ww; av[1] = av[1] + __builtin_amdgcn_cvt_pk_f32_fp8(d0, true) * ww;
                        av[2] = av[2] + __builtin_amdgcn_cvt_pk_f32_fp8(d1, false) * ww; av[3] = av[3] + __builtin_amdgcn_cvt_pk_f32_fp8(d1, true) * ww; } }
                *(v4u*)(FFN + (size_t)(tb * 64 + ln_) * D + 8 * c) = (v4u){pk2(av[0].x, av[0].y), pk2(av[1].x, av[1].y), pk2(av[2].x, av[2].y), pk2(av[3].x, av[3].y)};
            }
        }
        __syncthreads();
    }
    GRID_BAR();
    if (RUN(14)) {
        const int gw = F.vcu * NWAVES + F.wave, NGW = F.G * NWAVES, lane = F.lane; const float* g2 = args.in[21]; const float* b2 = args.in[22]; float* out = args.out; const bf16* FFN = (const bf16*)(ws + WS_FFN);
        for (int row = gw; row < M; row += NGW) {
            f32x4 v[8]; float sm = 0.f;
#pragma unroll
            for (int j = 0; j < 8; ++j) { const int c = (lane + 64 * j) * 4; const unsigned long long hq = *(const unsigned long long*)(H1 + (size_t)row * D + c), fq = *(const unsigned long long*)(FFN + (size_t)row * D + c);
                const unsigned h0 = (unsigned)hq, h1_ = (unsigned)(hq >> 32), f0 = (unsigned)fq, f1 = (unsigned)(fq >> 32);
                v[j].x = DN_ALPHA * __uint_as_float(h0 << 16) + __uint_as_float(f0 << 16); v[j].y = DN_ALPHA * __uint_as_float(h0 & 0xffff0000u) + __uint_as_float(f0 & 0xffff0000u);
                v[j].z = DN_ALPHA * __uint_as_float(h1_ << 16) + __uint_as_float(f1 << 16); v[j].w = DN_ALPHA * __uint_as_float(h1_ & 0xffff0000u) + __uint_as_float(f1 & 0xffff0000u);
                sm += (v[j].x + v[j].y) + (v[j].z + v[j].w); }
#pragma unroll
            for (int o = 1; o < 64; o <<= 1) sm += __shfl_xor(sm, o);
            const float mean = sm * (1.f / D); float s2 = 0.f;
#pragma unroll
            for (int j = 0; j < 8; ++j) { v[j] = v[j] - mean; s2 += (v[j].x * v[j].x + v[j].y * v[j].y) + (v[j].z * v[j].z + v[j].w * v[j].w); }
#pragma unroll
            for (int o = 1; o < 64; o <<= 1) s2 += __shfl_xor(s2, o);
            const float rstd = rsqrtf(s2 * (1.f / D) + LN_EPS);
#pragma unroll
            for (int j = 0; j < 8; ++j) { const int c = (lane + 64 * j) * 4; *(f32x4*)(out + (size_t)row * D + c) = v[j] * rstd * *(const f32x4*)(g2 + c) + *(const f32x4*)(b2 + c); }
        }
    }
#undef IN
#undef RUN
#undef GRID_BAR
}

extern "C" void kernel_launch(void* const* d_in, const int* in_sizes, int n_in, void* d_out, int out_size, void* d_ws, size_t ws_size, hipStream_t stream) {
    static int grid = 0;
    if (grid == 0) {
        if (n_in != 23 || in_sizes[0] != M * D || out_size != M * D || ws_size < WS_END) { fprintf(stderr, "kernel_launch: unexpected shapes n_in %d in0 %d out %d ws %zu\n", n_in, n_in > 0 ? in_sizes[0] : -1, out_size, ws_size); grid = -1; return; }
        int dev = 0, cus = 0;
        if (hipGetDevice(&dev) != hipSuccess || hipDeviceGetAttribute(&cus, hipDeviceAttributeMultiprocessorCount, dev) != hipSuccess) { grid = -1; return; }
        if (hipFuncSetAttribute((const void*)skel_fwd, hipFuncAttributeMaxDynamicSharedMemorySize, LDS_BYTES) != hipSuccess) { grid = -1; return; }
        grid = cus;
    }
    if (grid < 0) return;
    (void)hipMemsetAsync((char*)d_ws + WS_CTL, 0, CTL_ZERO_BYTES, stream);
    Args a{};
    for (int i = 0; i < 23; ++i) a.in[i] = (const float*)d_in[i];
    a.out = (float*)d_out; a.ws = (unsigned char*)d_ws;
    unsigned char* ws = (unsigned char*)d_ws;
    const float* const* in = (const float* const*)d_in;
    float* prm = (float*)(ws + WS_PRM);
    bf16 *Q = (bf16*)(ws + WS_Q), *K = (bf16*)(ws + WS_K), *V = (bf16*)(ws + WS_V), *XR = (bf16*)(ws + WS_XR), *XG = (bf16*)(ws + WS_XG), *MIX = (bf16*)(ws + WS_MIX), *H1 = (bf16*)(ws + WS_H1);
    float *LA = (float*)(ws + WS_LA), *LB = (float*)(ws + WS_LB), *Y1 = (float*)(ws + WS_Y1), *PQ = (float*)(ws + WS_PQ), *G = (float*)(ws + WS_G); int* E = (int*)(ws + WS_E);
#ifndef MK_MULTI
    a.ph_lo = -1; a.ph_hi = 0; hipLaunchKernelGGL(skel_fwd, dim3(grid), dim3(NWAVES * 64), LDS_BYTES, stream, a);
#else
    for (int sl = 0; sl < 15; ++sl) { a.ph_lo = 1 << sl; a.ph_hi = 0; hipLaunchKernelGGL(skel_fwd, dim3(grid), dim3(NWAVES * 64), LDS_BYTES, stream, a); }
#endif
}
```

```cpp
#include <hip/hip_runtime.h>
#include <cstdio>
#include <cstdint>
namespace pg8 {
#define PG8_LAS __attribute__((address_space(3)))
typedef unsigned short bf16_t;
typedef short bf16x8 __attribute__((ext_vector_type(8)));
typedef float f32x4 __attribute__((ext_vector_type(4)));
typedef unsigned u32x4 __attribute__((ext_vector_type(4)));
constexpr int BM = 256, BK = 64, HALF = 128, HTB = HALF * BK * 2  , STAGE_BYTES = 8 * HTB, NXCD = 8, WGM = 8;

__host__ __device__ __forceinline__ int lds_byte(int r, int c) { const int st = (r >> 4) * 2 + (c >> 5), rr = r & 15, cc = c & 31, ob = rr * 64 + cc * 2; return st * 1024 + (ob ^ (((ob >> 9) & 1) << 5)); }
__host__ __device__ __forceinline__ void stage_rc(int b, int& R, int& C) { const int st = b / 1024, sb = b % 1024, swz = sb ^ (((sb >> 9) & 1) << 5); R = (st >> 1) * 16 + swz / 64; C = (st & 1) * 32 + (swz % 64) / 2; }
__host__ __device__ __forceinline__ int perm32(int rho) { const int n = rho >> 4, i = rho & 15; return 8 * (i >> 2) + 4 * n + (i & 3); }

struct Unit { int pm, pn; };
struct Gemm { const bf16_t* A; const bf16_t* Bt; int M, N, K; };

struct StaticOrder {
    int nM, nN, nwg, G, c;
    __host__ __device__ void init(int M, int N, int G_, int c_) { nM = M / BM; nN = N / BM; nwg = nM * nN; G = G_; c = c_; }
    __host__ __device__ bool next(int i, Unit& u) const {
        const long L = (long)i * G + c; if (L >= nwg) return false;
        int wgid = (int)L; { const int q = nwg / NXCD, r = nwg % NXCD, xcd = wgid % NXCD, off = wgid / NXCD; wgid = (xcd < r ? xcd * (q + 1) : r * (q + 1) + (xcd - r) * q) + off; }
        const int nig = WGM * nN, gid = wgid / nig, fm = gid * WGM, gsz = (nM - fm) < WGM ? (nM - fm) : WGM;
        u.pm = fm + ((wgid % nig) % gsz); u.pn = (wgid % nig) / gsz; return true;
    }
    __device__ __forceinline__ void a_ready(const Unit&) const {}
    __device__ __forceinline__ void done(const Unit&) const {}
};

__device__ __forceinline__ unsigned cvt_pk_bf16(float lo, float hi) { unsigned r; asm volatile("v_cvt_pk_bf16_f32 %0, %1, %2" : "=v"(r) : "v"(lo), "v"(hi)); return r; }
typedef float f32x2 __attribute__((ext_vector_type(2)));
__device__ __forceinline__ f32x2 gelu_pk(f32x2 v) {
    const f32x2 av = __builtin_elementwise_abs(v), d = av * 0.2316418882f + 1.0f;
    f32x2 t; t.x = __builtin_amdgcn_rcpf(d.x); t.y = __builtin_amdgcn_rcpf(d.y);
    f32x2 q = t * 0.5307027145f + (-0.7265760135f); q = q * t + 0.7107068705f; q = q * t + (-0.142248368f); q = q * t + 0.127414796f; q = q * t;
    const f32x2 s = (v * v) * (-0.72134752044f);
    f32x2 e; e.x = __builtin_amdgcn_exp2f(s.x); e.y = __builtin_amdgcn_exp2f(s.y);
    const f32x2 m = v * (q * e), r = v - m;
    f32x2 o; o.x = v.x < 0.f ? m.x : r.x; o.y = v.y < 0.f ? m.y : r.y; return o;
}

template <int ACT  > struct EpiBf16 {
    static constexpr bool PERM = true, AFTER_DRAIN = false; static_assert(ACT == 0 || ACT == 1, "EpiBf16: ACT is 0 (none) or 1 (gelu_pk)");
    bf16_t* O; int ldc; const float* bias; int split_cols; size_t split_stride; float scale0;
    __device__ __forceinline__ void operator()(const f32x4 (&acc)[2][2][4][2], const Unit& u, int wr, int wc, int fr, int fq) const {
        const int row0 = u.pm * BM + wr * 64 + fr; int colt = u.pn * BM; bf16_t* base = O;
        float sc = 1.f; if (split_cols) { const int t = colt / split_cols; base += (size_t)t * split_stride; colt -= t * split_cols; if (t == 0) sc = scale0; }
        const int col0 = colt + wc * 32 + 8 * fq, bcol0 = u.pn * BM + wc * 32 + 8 * fq;
        f32x4 bv[2][2];
#pragma unroll
        for (int bj = 0; bj < 2; ++bj)
#pragma unroll
            for (int n = 0; n < 2; ++n) bv[bj][n] = bias ? *(const f32x4*)(bias + bcol0 + bj * HALF + 4 * n) : (f32x4){0.f, 0.f, 0.f, 0.f};
#pragma unroll
        for (int ai = 0; ai < 2; ++ai)
#pragma unroll
            for (int m = 0; m < 4; ++m) { bf16_t* rowp = base + (size_t)(row0 + ai * HALF + m * 16) * ldc + col0;
#pragma unroll
                for (int bj = 0; bj < 2; ++bj) { f32x4 v0 = acc[ai][bj][m][0] + bv[bj][0], v1 = acc[ai][bj][m][1] + bv[bj][1];
                    if (ACT == 1) { f32x2 a = gelu_pk((f32x2){v0[0], v0[1]}), b = gelu_pk((f32x2){v0[2], v0[3]}), c = gelu_pk((f32x2){v1[0], v1[1]}), d = gelu_pk((f32x2){v1[2], v1[3]});
                        v0 = (f32x4){a.x, a.y, b.x, b.y}; v1 = (f32x4){c.x, c.y, d.x, d.y}; }
                    v0 = v0 * sc; v1 = v1 * sc; u32x4 w; w.x = cvt_pk_bf16(v0[0], v0[1]); w.y = cvt_pk_bf16(v0[2], v0[3]); w.z = cvt_pk_bf16(v1[0], v1[1]); w.w = cvt_pk_bf16(v1[2], v1[3]);
                    *(u32x4*)(rowp + bj * HALF) = w; } }
    }
};

struct PanelStats {
    unsigned* xbuf;
    unsigned* cnt;
    unsigned* tmo;
    int ntn; float eps;
    unsigned code;
    __device__ __forceinline__ bool run(const f32x4 (&v)[2][2][4][2], const Unit& u, int wr, int wc, int fr, int fq, PG8_LAS unsigned char* lds, int wid, int lane) const {
        typedef float f32x2v __attribute__((ext_vector_type(2)));
        PG8_LAS f32x2v* P = (PG8_LAS f32x2v*)lds;
        PG8_LAS f32x2v* S = (PG8_LAS f32x2v*)(lds + 8192);
        PG8_LAS unsigned* flag = (PG8_LAS unsigned*)(lds + 8192 + 2048);
#pragma unroll
        for (int ai = 0; ai < 2; ++ai)
#pragma unroll
            for (int m = 0; m < 4; ++m) {
                float s = 0.f;
#pragma unroll
                for (int bj = 0; bj < 2; ++bj)
#pragma unroll
                    for (int n = 0; n < 2; ++n) { const f32x4 x = v[ai][bj][m][n]; s += (x[0] + x[1]) + (x[2] + x[3]); }
                s += __shfl_xor(s, 16); s += __shfl_xor(s, 32);
                const float mw = s * (1.0f / 64.0f); float q = 0.f;
#pragma unroll
                for (int bj = 0; bj < 2; ++bj)
#pragma unroll
                    for (int n = 0; n < 2; ++n) { const f32x4 d = v[ai][bj][m][n] - mw; q += (d[0] * d[0] + d[1] * d[1]) + (d[2] * d[2] + d[3] * d[3]); }
                q += __shfl_xor(q, 16); q += __shfl_xor(q, 32);
                if (fq == 0) P[(ai * HALF + wr * 64 + m * 16 + fr) * 4 + wc] = (f32x2v){mw, q};
            }
        asm volatile("s_waitcnt lgkmcnt(0)" ::: "memory"); __builtin_amdgcn_s_barrier(); asm volatile("" ::: "memory");
#if defined(BROKEN_EXCHANGE_NO_WAIT)
#warning BROKEN CONTROL BUILD: the row-statistics exchange does not wait; results are wrong by design
        if (blockIdx.x >= 64) { const long long t0_ = clock64(); while (clock64() - t0_ < 60000) __builtin_amdgcn_s_sleep(8); }
#endif
        const int row = wid * 32 + (lane & 31);
        if (lane < 32) {
            const f32x2v a = P[row * 4 + 0], b = P[row * 4 + 1], c = P[row * 4 + 2], d = P[row * 4 + 3];
            const float mt = (a.x + b.x + c.x + d.x) * 0.25f;
            const float da = a.x - mt, db = b.x - mt, dc = c.x - mt, dd = d.x - mt;
            const float m2 = (a.y + b.y) + (c.y + d.y) + 64.0f * ((da * da + db * db) + (dc * dc + dd * dd));
            unsigned long long* slot = (unsigned long long*)xbuf + ((size_t)(u.pm * BM + row) * 4 + u.pn);
            __hip_atomic_store(slot, ((unsigned long long)__float_as_uint(m2) << 32) | __float_as_uint(mt), __ATOMIC_RELAXED, __HIP_MEMORY_SCOPE_AGENT);
        }
        asm volatile("s_waitcnt vmcnt(0)" ::: "memory");
        if (lane == 0) __hip_atomic_fetch_add(cnt + 64 * u.pm, 1u, __ATOMIC_RELAXED, __HIP_MEMORY_SCOPE_AGENT);
        if (wid == 0) {
            bool dead = false; const unsigned long long t0 = __builtin_amdgcn_s_memrealtime(); const unsigned want = 8u * (unsigned)ntn;
            for (;;) {
#if defined(BROKEN_EXCHANGE_NO_WAIT)
                break;
#endif
                if ((unsigned)__builtin_amdgcn_readfirstlane(__hip_atomic_load(cnt + 64 * u.pm, __ATOMIC_RELAXED, __HIP_MEMORY_SCOPE_AGENT)) >= want) break;
                if (__builtin_amdgcn_s_memrealtime() - t0 > 2000000ull) {
                    if (lane == 0) { unsigned expect = 0u; __hip_atomic_compare_exchange_strong(tmo + 1, &expect, code | (unsigned)(u.pm & 0xff), __ATOMIC_RELAXED, __ATOMIC_RELAXED, __HIP_MEMORY_SCOPE_AGENT);
                                     __hip_atomic_store(tmo, 1u, __ATOMIC_RELAXED, __HIP_MEMORY_SCOPE_AGENT); }
                    dead = true; break; }
                __builtin_amdgcn_s_sleep(2);
            }
            __builtin_amdgcn_fence(__ATOMIC_ACQUIRE, "agent");
            if (lane == 0) flag[0] = dead ? 1u : 0u;
        }
        asm volatile("s_waitcnt vmcnt(0) lgkmcnt(0)" ::: "memory"); __builtin_amdgcn_s_barrier(); asm volatile("" ::: "memory");
        const bool bad = flag[0] != 0u;
        if (lane < 32) {
            const unsigned long long* slot = (const unsigned long long*)xbuf + (size_t)(u.pm * BM + row) * 4; float mt[4], m2[4]; float ms = 0.f;
#pragma unroll
            for (int t = 0; t < 4; ++t) { if (t < ntn) { const unsigned long long w = __hip_atomic_load(slot + t, __ATOMIC_RELAXED, __HIP_MEMORY_SCOPE_AGENT); mt[t] = __uint_as_float((unsigned)w); m2[t] = __uint_as_float((unsigned)(w >> 32)); } else { mt[t] = 0.f; m2[t] = 0.f; } ms += mt[t]; }
            const float mean = ms / (float)ntn; float q = 0.f;
#pragma unroll
            for (int t = 0; t < 4; ++t) if (t < ntn) { const float dm = mt[t] - mean; q += m2[t] + 256.0f * dm * dm; }
            S[row] = (f32x2v){mean, 1.0f / sqrtf(q / (256.0f * (float)ntn) + eps)};
        }
        asm volatile("s_waitcnt lgkmcnt(0)" ::: "memory"); __builtin_amdgcn_s_barrier(); asm volatile("" ::: "memory");
        return bad;
    }
};
struct EpiLnRes {
    static constexpr bool PERM = false, AFTER_DRAIN = true;
    const float* base; float* out; int ldc; const float* bias; PanelStats st; unsigned poison;
    __device__ __forceinline__ void fused(f32x4 (&acc)[2][2][4][2], const Unit& u, int wr, int wc, int fr, int fq, PG8_LAS unsigned char* lds, int wid, int lane) const {
        typedef float f32x2v __attribute__((ext_vector_type(2)));
        const PG8_LAS f32x2v* S = (const PG8_LAS f32x2v*)(lds + 8192);
        const int col0 = u.pn * BM + wc * 32 + 4 * fq;
#pragma unroll
        for (int bj = 0; bj < 2; ++bj)
#pragma unroll
            for (int n = 0; n < 2; ++n) { const f32x4 bv = bias ? *(const f32x4*)(bias + col0 + bj * HALF + n * 16) : (f32x4){0.f, 0.f, 0.f, 0.f};
#pragma unroll
                for (int ai = 0; ai < 2; ++ai)
#pragma unroll
                    for (int m = 0; m < 4; ++m) acc[ai][bj][m][n] += bv; }
        f32x4 pre[4][2][2];
#pragma unroll
        for (int m = 0; m < 4; ++m) { const size_t off = (size_t)(u.pm * BM + wr * 64 + m * 16 + fr) * ldc + col0;
#pragma unroll
            for (int bj = 0; bj < 2; ++bj)
#pragma unroll
                for (int n = 0; n < 2; ++n) pre[m][bj][n] = *(const f32x4*)(base + off + bj * HALF + n * 16); }
        const bool bad = st.run(acc, u, wr, wc, fr, fq, lds, wid, lane) || poison != 0u;
        const float qnan = __builtin_nanf("");
#pragma unroll
        for (int ai = 0; ai < 2; ++ai)
#pragma unroll
            for (int m = 0; m < 4; ++m) { const int r = ai * HALF + wr * 64 + m * 16 + fr; const f32x2v sr = S[r]; const size_t off = (size_t)(u.pm * BM + r) * ldc + col0;
#pragma unroll
                for (int bj = 0; bj < 2; ++bj)
#pragma unroll
                    for (int n = 0; n < 2; ++n) { const f32x4 bs = ai == 0 ? pre[m][bj][n] : *(const f32x4*)(base + off + bj * HALF + n * 16); f32x4 o = bs + (acc[ai][bj][m][n] - sr.x) * sr.y;
                        if (bad) o = (f32x4){qnan, qnan, qnan, qnan}; *(f32x4*)(out + off + bj * HALF + n * 16) = o; }
                if (m & 1) asm volatile("" ::: "memory"); }
    }
};
struct EpiLnResLn {
    static constexpr bool PERM = false, AFTER_DRAIN = true;
    const float* base; float* out; bf16_t* xn; int ldc; const float* bias; PanelStats st1, st2; unsigned poison;
    __device__ __forceinline__ void fused(f32x4 (&acc)[2][2][4][2], const Unit& u, int wr, int wc, int fr, int fq, PG8_LAS unsigned char* lds, int wid, int lane) const {
        typedef float f32x2v __attribute__((ext_vector_type(2))); typedef unsigned u32x2v __attribute__((ext_vector_type(2)));
        const PG8_LAS f32x2v* S = (const PG8_LAS f32x2v*)(lds + 8192);
        const int col0 = u.pn * BM + wc * 32 + 4 * fq;
#pragma unroll
        for (int bj = 0; bj < 2; ++bj)
#pragma unroll
            for (int n = 0; n < 2; ++n) { const f32x4 bv = bias ? *(const f32x4*)(bias + col0 + bj * HALF + n * 16) : (f32x4){0.f, 0.f, 0.f, 0.f};
#pragma unroll
                for (int ai = 0; ai < 2; ++ai)
#pragma unroll
                    for (int m = 0; m < 4; ++m) acc[ai][bj][m][n] += bv; }
        bool bad = st1.run(acc, u, wr, wc, fr, fq, lds, wid, lane) || poison != 0u;
        const float qnan = __builtin_nanf("");
#pragma unroll
        for (int ai = 0; ai < 2; ++ai)
#pragma unroll
            for (int m = 0; m < 4; ++m) { const int r = ai * HALF + wr * 64 + m * 16 + fr; const f32x2v sr = S[r]; const size_t off = (size_t)(u.pm * BM + r) * ldc + col0;
#pragma unroll
                for (int bj = 0; bj < 2; ++bj)
#pragma unroll
                    for (int n = 0; n < 2; ++n) { const f32x4 bs = *(const f32x4*)(base + off + bj * HALF + n * 16); acc[ai][bj][m][n] = bs + (acc[ai][bj][m][n] - sr.x) * sr.y; }
                asm volatile("" : "+v"(acc[ai][0][m][0]), "+v"(acc[ai][0][m][1]), "+v"(acc[ai][1][m][0]), "+v"(acc[ai][1][m][1]));
                if (m & 1) asm volatile("" ::: "memory"); }
        const bool bad1 = bad;
        bad = st2.run(acc, u, wr, wc, fr, fq, lds, wid, lane) || bad;
#pragma unroll
        for (int ai = 0; ai < 2; ++ai)
#pragma unroll
            for (int m = 0; m < 4; ++m) { const int r = ai * HALF + wr * 64 + m * 16 + fr; const f32x2v sr = S[r]; const size_t off = (size_t)(u.pm * BM + r) * ldc + col0;
#pragma unroll
                for (int bj = 0; bj < 2; ++bj)
#pragma unroll
                    for (int n = 0; n < 2; ++n) { const f32x4 x1 = acc[ai][bj][m][n]; *(f32x4*)(out + off + bj * HALF + n * 16) = bad1 ? (f32x4){qnan, qnan, qnan, qnan} : x1;
                        const f32x4 o = (x1 - sr.x) * sr.y; u32x2v w; w.x = cvt_pk_bf16(o[0], o[1]); w.y = cvt_pk_bf16(o[2], o[3]);
                        if (bad) { w.x = 0x7fc07fc0u; w.y = 0x7fc07fc0u; } *(u32x2v*)(xn + off + bj * HALF + n * 16) = w; }
                asm volatile("" ::: "memory"); }
    }
};

template <class Epi, class Sched, bool ALIGN_EPI = false, bool SP2 = false>
__device__ __forceinline__ void gemm_phase(PG8_LAS unsigned char* lds, const Gemm g, const Sched& S, const Epi& E) {
    const int tid = threadIdx.x, wid = __builtin_amdgcn_readfirstlane(tid >> 6), lane = tid & 63, wr = wid >> 2, wc = wid & 3, fr = lane & 15, fq = lane >> 4;
    const int K = g.K, nt = K / BK;
    unsigned voffA[2], voffB[2];
#pragma unroll
    for (int i = 0; i < 2; ++i) { int R, C; stage_rc(tid * 16 + i * 8192, R, C); const int Rb = Epi::PERM ? ((R & ~31) + perm32(R & 31)) : R;
        voffA[i] = (unsigned)(R * K + C) * 2u; voffB[i] = (unsigned)(Rb * K + C) * 2u; }
    const size_t kstep = (size_t)(BK * 2);
    const size_t hstep = (size_t)HALF * K * 2;
    const size_t tstep = 2 * hstep;
    const unsigned ldsw = (unsigned)wid * 1024u;
    const int aoff = lds_byte(wr * 64 + fr, fq * 8), boff = lds_byte(wc * 32 + fr, fq * 8);
#define PG8_SA(b, h) (((b) * 2 + (h)) * HTB)
#define PG8_SB(b, h) ((4 + (b) * 2 + (h)) * HTB)
#define PG8_STAGE(bufoff, gbase, voff) do { _Pragma("unroll") for (int _i = 0; _i < 2; ++_i) \
        __builtin_amdgcn_global_load_lds((const unsigned*)((const char*)(gbase) + (voff)[_i]), (PG8_LAS unsigned*)(lds + (bufoff) + ldsw + _i * 8192), 16, 0, 0); } while (0)
#define PG8_LDA(dst, b, h) do { _Pragma("unroll") for (int m = 0; m < 4; ++m) _Pragma("unroll") for (int k = 0; k < 2; ++k) dst[m][k] = *(const PG8_LAS bf16x8*)(lds + PG8_SA(b, h) + aoff + m * 2048 + k * 1024); } while (0)
#define PG8_LDB(dst, b, h) do { _Pragma("unroll") for (int n = 0; n < 2; ++n) _Pragma("unroll") for (int k = 0; k < 2; ++k) dst[n][k] = *(const PG8_LAS bf16x8*)(lds + PG8_SB(b, h) + boff + n * 2048 + k * 1024); } while (0)
#define PG8_MMA(ai, bj, At, Bt) do { __builtin_amdgcn_s_setprio(1); _Pragma("unroll") for (int m = 0; m < 4; ++m) _Pragma("unroll") for (int n = 0; n < 2; ++n) _Pragma("unroll") for (int k = 0; k < 2; ++k) \
        acc[ai][bj][m][n] = __builtin_amdgcn_mfma_f32_16x16x32_bf16(Bt[n][k], At[m][k], acc[ai][bj][m][n], 0, 0, 0); __builtin_amdgcn_s_setprio(0); } while (0)
#define PG8_WAIT_V(n) asm volatile("s_waitcnt vmcnt(" #n ")" ::: "memory")
#define PG8_WAIT_L(n) asm volatile("s_waitcnt lgkmcnt(" #n ")" ::: "memory")
#define PG8_BAR __builtin_amdgcn_s_barrier()
#define PG8_SCHED __builtin_amdgcn_sched_barrier(0)
    Unit cur, nxt; int ui = 0;
    if (!S.next(0, cur)) return;
    f32x4 acc[2][2][4][2];
#pragma unroll
    for (int a = 0; a < 2; ++a)
#pragma unroll
        for (int b = 0; b < 2; ++b)
#pragma unroll
            for (int m = 0; m < 4; ++m)
#pragma unroll
                for (int n = 0; n < 2; ++n) acc[a][b][m][n] = (f32x4){0.f, 0.f, 0.f, 0.f};
    bf16x8 At[4][2], B0[2][2], B1[2][2];
    const char* cA = (const char*)g.A + (size_t)cur.pm * tstep; const char* cB = (const char*)g.Bt + (size_t)cur.pn * tstep;
    S.a_ready(cur);
    if constexpr (SP2) {
        PG8_STAGE(PG8_SB(0, 0), cB, voffB); PG8_STAGE(PG8_SB(0, 1), cB + hstep, voffB); PG8_STAGE(PG8_SA(0, 0), cA, voffA); PG8_STAGE(PG8_SA(0, 1), cA + hstep, voffA);
        if (wr == 1) PG8_BAR;
        PG8_WAIT_V(2); PG8_BAR;
        PG8_STAGE(PG8_SB(1, 0), cB + kstep, voffB); PG8_STAGE(PG8_SA(1, 0), cA + kstep, voffA); PG8_STAGE(PG8_SB(1, 1), cB + hstep + kstep, voffB);
        PG8_WAIT_V(6); PG8_BAR;
    } else {
        PG8_STAGE(PG8_SB(0, 0), cB, voffB); PG8_STAGE(PG8_SA(0, 0), cA, voffA); PG8_STAGE(PG8_SB(0, 1), cB + hstep, voffB); PG8_STAGE(PG8_SA(0, 1), cA + hstep, voffA);
        if (wr == 1) PG8_BAR;
        PG8_WAIT_V(4); PG8_BAR;
        PG8_STAGE(PG8_SB(1, 0), cB + kstep, voffB); PG8_STAGE(PG8_SA(1, 0), cA + kstep, voffA); PG8_STAGE(PG8_SB(1, 1), cB + hstep + kstep, voffB);
        PG8_WAIT_V(6); PG8_BAR;
    }
    for (;;) {
        const bool has_next = S.next(ui + 1, nxt);
        const char* nA = has_next ? (const char*)g.A + (size_t)nxt.pm * tstep : cA; const char* nB = has_next ? (const char*)g.Bt + (size_t)nxt.pn * tstep : cB;
        for (int t = 0; t < nt; t += 2) {
            const bool last = (t == nt - 2);
            const char* a1 = cA + (size_t)(t + 1) * kstep;
            const char* a2 = last ? nA : cA + (size_t)(t + 2) * kstep; const char* b2 = last ? nB : cB + (size_t)(t + 2) * kstep;
            const char* a3 = a2 + kstep; const char* b3 = b2 + kstep;
            if (last && has_next) S.a_ready(nxt);
            if constexpr (SP2) {
            PG8_LDB(B0, 0, 0); PG8_LDB(B1, 0, 1); PG8_SCHED; PG8_LDA(At, 0, 0); PG8_STAGE(PG8_SA(1, 1), a1 + hstep, voffA);
            PG8_WAIT_V(8); PG8_WAIT_L(0); PG8_BAR; PG8_MMA(0, 0, At, B0); PG8_MMA(0, 1, At, B1); PG8_BAR; PG8_SCHED;
            PG8_LDA(At, 0, 1); PG8_STAGE(PG8_SB(0, 0), b2, voffB); PG8_STAGE(PG8_SB(0, 1), b2 + hstep, voffB); PG8_STAGE(PG8_SA(0, 0), a2, voffA);
            PG8_WAIT_V(8); PG8_WAIT_L(0); PG8_BAR; PG8_MMA(1, 0, At, B0); PG8_MMA(1, 1, At, B1); PG8_BAR; PG8_SCHED;
            PG8_LDB(B0, 1, 0); PG8_LDB(B1, 1, 1); PG8_SCHED; PG8_LDA(At, 1, 0); PG8_STAGE(PG8_SA(0, 1), a2 + hstep, voffA);
            PG8_WAIT_V(8); PG8_WAIT_L(0); PG8_BAR; PG8_MMA(0, 0, At, B0); PG8_MMA(0, 1, At, B1); PG8_BAR; PG8_SCHED;
            PG8_LDA(At, 1, 1); PG8_STAGE(PG8_SB(1, 0), b3, voffB); PG8_STAGE(PG8_SB(1, 1), b3 + hstep, voffB); PG8_STAGE(PG8_SA(1, 0), a3, voffA);
            PG8_WAIT_V(8); PG8_WAIT_L(0); PG8_BAR; PG8_MMA(1, 0, At, B0); PG8_MMA(1, 1, At, B1); PG8_BAR; PG8_SCHED;
            } else {
            PG8_LDB(B0, 0, 0); PG8_SCHED; PG8_LDA(At, 0, 0); PG8_STAGE(PG8_SA(1, 1), a1 + hstep, voffA);
            PG8_WAIT_L(8); PG8_BAR; PG8_WAIT_L(0); PG8_MMA(0, 0, At, B0); PG8_BAR; PG8_SCHED;
            PG8_LDB(B1, 0, 1); PG8_STAGE(PG8_SB(0, 0), b2, voffB);
            PG8_BAR; PG8_WAIT_L(0); PG8_MMA(0, 1, At, B1); PG8_BAR;
            PG8_LDA(At, 0, 1); PG8_STAGE(PG8_SA(0, 0), a2, voffA);
            PG8_BAR; PG8_WAIT_L(0); PG8_MMA(1, 0, At, B0); PG8_BAR; PG8_SCHED;
            PG8_STAGE(PG8_SB(0, 1), b2 + hstep, voffB);
            PG8_WAIT_V(6); PG8_BAR; PG8_MMA(1, 1, At, B1); PG8_BAR;
            PG8_LDB(B0, 1, 0); PG8_SCHED; PG8_LDA(At, 1, 0); PG8_STAGE(PG8_SA(0, 1), a2 + hstep, voffA);
            PG8_WAIT_L(8); PG8_BAR; PG8_WAIT_L(0); PG8_MMA(0, 0, At, B0); PG8_BAR; PG8_SCHED;
            PG8_LDB(B1, 1, 1); PG8_STAGE(PG8_SB(1, 0), b3, voffB);
            PG8_BAR; PG8_WAIT_L(0); PG8_MMA(0, 1, At, B1); PG8_BAR;
            PG8_LDA(At, 1, 1); PG8_STAGE(PG8_SA(1, 0), a3, voffA);
            PG8_BAR; PG8_WAIT_L(0); PG8_MMA(1, 0, At, B0); PG8_BAR; PG8_SCHED;
            PG8_STAGE(PG8_SB(1, 1), b3 + hstep, voffB);
            PG8_WAIT_V(6); PG8_BAR; PG8_MMA(1, 1, At, B1); PG8_BAR;
            }
        }
        if constexpr (ALIGN_EPI) { if (wr == 0) PG8_BAR; }
        if constexpr (!Epi::AFTER_DRAIN) { E(acc, cur, wr, wc, fr, fq); S.done(cur); }
        if (!has_next) break;
#pragma unroll
        for (int a = 0; a < 2; ++a)
#pragma unroll
            for (int b = 0; b < 2; ++b)
#pragma unroll
                for (int m = 0; m < 4; ++m)
#pragma unroll
                    for (int n = 0; n < 2; ++n) acc[a][b][m][n] = (f32x4){0.f, 0.f, 0.f, 0.f};
        cur = nxt; cA = nA; cB = nB; ++ui;
        if constexpr (ALIGN_EPI) { if (wr == 1) PG8_BAR; }
    }
    PG8_WAIT_V(0);
    if constexpr (!ALIGN_EPI) { if (wr == 0) PG8_BAR; }
    PG8_BAR;
    if constexpr (Epi::AFTER_DRAIN) { E.fused(acc, cur, wr, wc, fr, fq, lds, wid, lane); S.done(cur); }
#undef PG8_SA
#undef PG8_SB
#undef PG8_STAGE
#undef PG8_LDA
#undef PG8_LDB
#undef PG8_MMA
#undef PG8_WAIT_V
#undef PG8_WAIT_L
#undef PG8_BAR
#undef PG8_SCHED
}
}
#ifndef PG8_SP2
#define PG8_SP2 true
#endif
#ifndef PG8_ALIGN
#define PG8_ALIGN true
#endif
namespace pg8 {
struct EpiF32 {
    static constexpr bool PERM = false, AFTER_DRAIN = false;
    float* O; int ldc; const float* base; float alpha;
    __device__ __forceinline__ void operator()(const f32x4 (&acc)[2][2][4][2], const Unit& u, int wr, int wc, int fr, int fq) const {
        const int col0 = u.pn * BM + wc * 32 + 4 * fq;
#pragma unroll
        for (int ai = 0; ai < 2; ++ai)
#pragma unroll
            for (int m = 0; m < 4; ++m) { const size_t off = (size_t)(u.pm * BM + ai * HALF + wr * 64 + m * 16 + fr) * ldc + col0;
#pragma unroll
                for (int bj = 0; bj < 2; ++bj)
#pragma unroll
                    for (int n = 0; n < 2; ++n) { f32x4 v = acc[ai][bj][m][n];
                        if (base) { const f32x4 bs = *(const f32x4*)(base + off + bj * HALF + n * 16); v = v + bs * alpha; }
                        *(f32x4*)(O + off + bj * HALF + n * 16) = v; } }
    }
};
}

#include <hip/hip_bf16.h>
#include <cmath>
namespace datt {
using bf16 = __hip_bfloat16;
typedef short bf16x8 __attribute__((ext_vector_type(8)));
typedef short s16x4 __attribute__((ext_vector_type(4)));
typedef float f32x16 __attribute__((ext_vector_type(16)));
typedef float f32x4 __attribute__((ext_vector_type(4)));
typedef unsigned u32x4 __attribute__((ext_vector_type(4)));
constexpr int SEQ = 4096, DM = 1024, DQK = 64, DV = 128;
constexpr int NW = 8, QBLK = 32, KVBLK = 64, QB = NW * QBLK;
constexpr int SHM_V = KVBLK * DV * 2, SHM_K = KVBLK * DQK * 2;
constexpr int NSLOT = 3;
constexpr int LDS_BYTES = NSLOT * SHM_V + NSLOT * SHM_K + NW * 64 * 4;
constexpr float THR = 8.f;
#define DKSWZ(row, colB) ((row) * 128 + ((colB) ^ (((row) & 7) << 4)))
#define DSBAR() __builtin_amdgcn_sched_barrier(0)
__device__ __forceinline__ int v_st(int k, int c) { const int kk = (k & ~0xC) | ((k & 4) << 1) | ((k & 8) >> 1); return ((kk >> 3) * 4 + (c >> 5)) * 512 + ((kk & 7) * 32 + (c & 31)) * 2; }
__device__ __forceinline__ int v_rd_base(int lane) { return ((lane & 3) << 3) | (((lane >> 2) & 3) << 6) | (((lane >> 4) & 1) << 5) | (((lane >> 5) & 1) << 8); }
constexpr int v_rd_off(int d0, int ks, int half) { return d0 * 512 + ks * 4096 + half * 2048; }
__device__ __forceinline__ int crow(int r, int hi) { return (r & 3) + 8 * (r >> 2) + 4 * hi; }
__device__ __forceinline__ unsigned cvtpk(float lo, float hi) { unsigned r; asm volatile("v_cvt_pk_bf16_f32 %0, %1, %2" : "=v"(r) : "v"(lo), "v"(hi)); return r; }
__device__ __forceinline__ bf16x8 load8(const bf16* p) { return *reinterpret_cast<const bf16x8*>(p); }
__device__ __forceinline__ void mask_tile(f32x16& p0, f32x16& p1, int dq) {
    const float NEG = -__builtin_inff();
#pragma unroll
    for (int r = 0; r < 16; ++r) { const int c = (r & 3) + 8 * (r >> 2); if (dq - c < 0) p0[r] = NEG; if (dq - c - 32 < 0) p1[r] = NEG; }
}
__device__ __forceinline__ void alibi_tile(f32x16& p0, f32x16& p1, float sl2) {
#pragma unroll
    for (int r = 0; r < 16; ++r) { const float c = (float)((r & 3) + 8 * (r >> 2)); p0[r] = __builtin_fmaf(sl2, c, p0[r]); p1[r] = __builtin_fmaf(sl2, c + 32.f, p1[r]); }
}
__device__ __forceinline__ void partialSM(f32x16& p0, f32x16& p1, float base, float& m_reg, float& alpha) {
    float pmax = p0[0];
#pragma unroll
    for (int r = 1; r < 16; ++r) pmax = fmaxf(pmax, p0[r]);
#pragma unroll
    for (int r = 0; r < 16; ++r) pmax = fmaxf(pmax, p1[r]);
    { auto rr = __builtin_amdgcn_permlane32_swap(__float_as_uint(pmax), __float_as_uint(pmax), false, false); pmax = fmaxf(__uint_as_float(rr[0]), __uint_as_float(rr[1])); }
    pmax += base;
    float mn;
    if (__builtin_expect(__all(pmax - m_reg <= THR), 1)) { mn = m_reg; alpha = 1.f; }
    else { mn = fmaxf(m_reg, pmax); alpha = __builtin_amdgcn_exp2f(m_reg - mn); m_reg = mn; }
    const float mnL = base - mn;
#pragma unroll
    for (int r = 0; r < 16; ++r) p0[r] += mnL;
#pragma unroll
    for (int r = 0; r < 16; ++r) p1[r] += mnL;
#pragma unroll
    for (int r = 0; r < 16; ++r) p0[r] = __builtin_amdgcn_exp2f(p0[r]);
}
__device__ __forceinline__ void finishSM(f32x16& p0, f32x16& p1, float alpha, float& l_reg, bf16x8& pa0, bf16x8& pa1, bf16x8& pa2, bf16x8& pa3) {
#pragma unroll
    for (int r = 0; r < 16; ++r) p1[r] = __builtin_amdgcn_exp2f(p1[r]);
    float ps = 0;
#pragma unroll
    for (int r = 0; r < 16; ++r) ps += p0[r];
#pragma unroll
    for (int r = 0; r < 16; ++r) ps += p1[r];
    { auto rr = __builtin_amdgcn_permlane32_swap(__float_as_uint(ps), __float_as_uint(ps), false, false); ps = __uint_as_float(rr[0]) + __uint_as_float(rr[1]); }
    l_reg = l_reg * alpha + ps;
#define DPK4(P, B_, OUT) do { unsigned a0 = cvtpk(P[B_+0], P[B_+1]), a1 = cvtpk(P[B_+2], P[B_+3]); unsigned b0 = cvtpk(P[B_+4], P[B_+5]), b1 = cvtpk(P[B_+6], P[B_+7]); \
        auto r0 = __builtin_amdgcn_permlane32_swap(a0, b0, false, false); auto r1 = __builtin_amdgcn_permlane32_swap(a1, b1, false, false); \
        u32x4 w = {r0[0], r1[0], r0[1], r1[1]}; OUT = *reinterpret_cast<bf16x8*>(&w); } while (0)
    DPK4(p0, 0, pa0); DPK4(p0, 8, pa1); DPK4(p1, 0, pa2); DPK4(p1, 8, pa3);
#undef DPK4
}
__device__ __forceinline__ void qkt(f32x16& p0, f32x16& p1, const char* Kslot, int r32, int hi, const bf16x8* qr) {
    p0 = f32x16{}; p1 = f32x16{};
#pragma unroll
    for (int d0 = 0; d0 < 4; ++d0) { const char* a = Kslot + DKSWZ(r32, (d0 * 16 + hi * 8) * 2);
        const bf16x8 b0 = *reinterpret_cast<const bf16x8*>(a);
        const bf16x8 b1 = *reinterpret_cast<const bf16x8*>(a + 32 * 128);
        p0 = __builtin_amdgcn_mfma_f32_32x32x16_bf16(b0, qr[d0], p0, 0, 0, 0);
        p1 = __builtin_amdgcn_mfma_f32_32x32x16_bf16(b1, qr[d0], p1, 0, 0, 0); }
}
__device__ __forceinline__ void pv_tile(f32x16* o, int vb0, bf16x8 pa0, bf16x8 pa1, bf16x8 pa2, bf16x8 pa3) {
#define DTRRD(dst, off) asm volatile("ds_read_b64_tr_b16 %0, %1 offset:%2" : "=&v"(dst) : "v"(vb0), "i"(off) : "memory")
#define DPV_D0(d0) do { s16x4 l0, l1, l2, l3, h0, h1, h2, h3; constexpr int b_ = v_rd_off(d0, 0, 0); \
        DTRRD(l0, b_); DTRRD(h0, b_ + 2048); DTRRD(l1, b_ + 4096); DTRRD(h1, b_ + 6144); DTRRD(l2, b_ + 8192); DTRRD(h2, b_ + 10240); DTRRD(l3, b_ + 12288); DTRRD(h3, b_ + 14336); \
        asm volatile("s_waitcnt lgkmcnt(0)" ::: "memory"); DSBAR(); \
        o[d0] = __builtin_amdgcn_mfma_f32_32x32x16_bf16(pa0, (bf16x8){l0[0], l0[1], l0[2], l0[3], h0[0], h0[1], h0[2], h0[3]}, o[d0], 0, 0, 0); \
        o[d0] = __builtin_amdgcn_mfma_f32_32x32x16_bf16(pa1, (bf16x8){l1[0], l1[1], l1[2], l1[3], h1[0], h1[1], h1[2], h1[3]}, o[d0], 0, 0, 0); \
        o[d0] = __builtin_amdgcn_mfma_f32_32x32x16_bf16(pa2, (bf16x8){l2[0], l2[1], l2[2], l2[3], h2[0], h2[1], h2[2], h2[3]}, o[d0], 0, 0, 0); \
        o[d0] = __builtin_amdgcn_mfma_f32_32x32x16_bf16(pa3, (bf16x8){l3[0], l3[1], l3[2], l3[3], h3[0], h3[1], h3[2], h3[3]}, o[d0], 0, 0, 0); } while (0)
    DPV_D0(0); DPV_D0(1); DPV_D0(2); DPV_D0(3);
#undef DPV_D0
#undef DTRRD
}
struct BlockRef { const bf16* Q; const bf16* K; const bf16* V; bf16* O; int P0; int jlo; float sl2; };
struct Seam { bf16x8 qr[4]; bf16x8 st_v0, st_v1, st_k0; };
#define DROWV(p, k0, rr) ((p) + (size_t)((k0) + (rr)) * DM + sc)
#define DROWK(p, k0) ((p) + (size_t)((k0) + kr) * DM + kc)
#define DVMW() asm volatile("s_waitcnt vmcnt(0)" ::: "memory")
#define DVMWN(n) asm volatile("s_waitcnt vmcnt(%0)" :: "i"(n) : "memory")
#define DSLOAD(Kp, Vp, k0) do { S.st_v0 = load8(DROWV(Vp, k0, sr)); S.st_v1 = load8(DROWV(Vp, k0, 32 + sr)); S.st_k0 = load8(DROWK(Kp, k0)); } while (0)
#define DSWRITE_K(so) do { *(bf16x8*)(K_lds + (so) * SHM_K + kws) = S.st_k0; } while (0)
#define DSWRITE_V(so) do { *(bf16x8*)(V_lds + (so) * SHM_V + vst0) = S.st_v0; *(bf16x8*)(V_lds + (so) * SHM_V + vst1) = S.st_v1; } while (0)
__device__ __forceinline__ void datt_prime(const BlockRef& cur, char* lds, Seam& S) {
    const int tid = threadIdx.x, wid = __builtin_amdgcn_readfirstlane(tid >> 6), lane = tid & 63, r32 = lane & 31, hi = lane >> 5;
    const int sr = tid >> 4, sc = (tid & 15) * 8, kr = tid >> 3, kc = (tid & 7) * 8, kws = DKSWZ(kr, kc * 2); char* K_lds = lds + NSLOT * SHM_V;
    const int kb0 = cur.jlo * KVBLK;
#pragma unroll
    for (int d0 = 0; d0 < 4; ++d0) S.qr[d0] = load8(cur.Q + (size_t)(wid * QBLK + r32) * DM + d0 * 16 + hi * 8);
    DSLOAD(cur.K, cur.V, kb0); DVMW(); DSWRITE_K(0);
    __syncthreads();
}
__device__ __forceinline__ void datt_block(const BlockRef& cur, const BlockRef& nxt, char* lds, Seam& S) {
    const int tid = threadIdx.x, wid = __builtin_amdgcn_readfirstlane(tid >> 6), lane = tid & 63, r32 = lane & 31, hi = lane >> 5;
    const int j_lo = cur.jlo, j_hi = (cur.P0 + QB - 1) / KVBLK + 1, NT = j_hi - j_lo;
    const int kbn = nxt.jlo * KVBLK;
    const int qlo = cur.P0 + wid * QBLK, qm = qlo + r32 - 4 * hi;
    const float sl2 = cur.sl2;
    char* V_lds = lds; char* K_lds = lds + NSLOT * SHM_V;
    float* ws = (float*)(lds + NSLOT * SHM_V + NSLOT * SHM_K) + wid * 64; float* li_l = ws, * al_l = ws + 32;
    float m_reg = 4.0f, l_reg = 0; f32x16 o[4] = {};
    const int sr = tid >> 4, sc = (tid & 15) * 8, vst0 = v_st(sr, sc), vst1 = v_st(32 + sr, sc), kr = tid >> 3, kc = (tid & 7) * 8, kws = DKSWZ(kr, kc * 2);
    const int vb0 = (int)(uintptr_t)V_lds + v_rd_base(lane);
    const bf16* Kh = cur.K; const bf16* Vh = cur.V;
#define DRESC(a) do { if (__any((a) < 1.f)) { if (hi == 0) al_l[r32] = (a); asm volatile("s_waitcnt lgkmcnt(0)" ::: "memory"); \
                     _Pragma("unroll") for (int d_ = 0; d_ < 4; ++d_) _Pragma("unroll") for (int r = 0; r < 16; ++r) o[d_][r] *= al_l[crow(r, hi)]; } } while (0)
#define DKBASE(t) ((j_lo + (t)) * KVBLK)
#define DBIAS(t) (sl2 * (float)(DKBASE(t) - qm))
#define DMASKT(P0_, P1_, t) do { const int kb_ = DKBASE(t); alibi_tile(P0_, P1_, sl2); if (kb_ + KVBLK - 1 > qlo) mask_tile(P0_, P1_, qm - kb_); } while (0)
#define DSEAM_K0() do { DVMWN(4); DSWRITE_K(0); DSBAR(); } while (0)
    int s_p = 2, s_c = 0, s_n = 1;
#define DROT() do { const int t_ = s_p; s_p = s_c; s_c = s_n; s_n = t_; } while (0)
    f32x16 pA0, pA1, pB0, pB1; float alA, alB; bf16x8 pa0, pa1, pa2, pa3;
    DSWRITE_V(0); DSBAR();
    if (NT > 1) DSLOAD(Kh, Vh, DKBASE(1));
    DSBAR(); qkt(pA0, pA1, K_lds, r32, hi, S.qr);
    DMASKT(pA0, pA1, 0); partialSM(pA0, pA1, DBIAS(0), m_reg, alA);
    if (NT > 1) { DVMW(); DSWRITE_V(1); DSWRITE_K(1); }
    __syncthreads();
#define DHALF_STEP(PX0, PX1, alX, PY0, PY1, alY, t) do { DROT(); \
        DSBAR(); qkt(PX0, PX1, K_lds + s_c * SHM_K, r32, hi, S.qr); \
        finishSM(PY0, PY1, alY, l_reg, pa0, pa1, pa2, pa3); DSBAR(); \
        if ((t) + 1 < NT) { DSLOAD(Kh, Vh, DKBASE((t) + 1)); DSBAR(); } \
        pv_tile(o, vb0 + s_p * SHM_V, pa0, pa1, pa2, pa3); DMASKT(PX0, PX1, (t)); partialSM(PX0, PX1, DBIAS(t), m_reg, alX); \
        if ((t) + 1 < NT) { DVMW(); DSWRITE_V(s_n); DSWRITE_K(s_n); } \
        DRESC(alX); __syncthreads(); } while (0)
    for (int t = 1; t + 1 < NT; t += 2) {
        DHALF_STEP(pB0, pB1, alB, pA0, pA1, alA, t);
        DHALF_STEP(pA0, pA1, alA, pB0, pB1, alB, t + 1);
    }
    const bool even = (NT & 1) == 0;
    if (even) { DSBAR(); qkt(pB0, pB1, K_lds + s_n * SHM_K, r32, hi, S.qr); DSBAR(); }
    DSLOAD(nxt.K, nxt.V, kbn); DSBAR();
#pragma unroll
    for (int d0 = 0; d0 < 4; ++d0) S.qr[d0] = load8(nxt.Q + (size_t)(wid * QBLK + r32) * DM + d0 * 16 + hi * 8);
    DSBAR();
    finishSM(pA0, pA1, alA, l_reg, pa0, pa1, pa2, pa3); DSBAR();
    pv_tile(o, vb0 + s_c * SHM_V, pa0, pa1, pa2, pa3);
    if (even) { DMASKT(pB0, pB1, NT - 1); partialSM(pB0, pB1, DBIAS(NT - 1), m_reg, alB); __syncthreads(); DRESC(alB);
        finishSM(pB0, pB1, alB, l_reg, pa0, pa1, pa2, pa3); DSBAR(); pv_tile(o, vb0 + s_n * SHM_V, pa0, pa1, pa2, pa3); }
    else { __syncthreads(); }
    DSBAR(); DSEAM_K0();
    if (hi == 0) li_l[r32] = l_reg; asm volatile("s_waitcnt lgkmcnt(0)" ::: "memory");
    float rli[16];
#pragma unroll
    for (int r = 0; r < 16; ++r) rli[r] = __builtin_amdgcn_rcpf(li_l[crow(r, hi)]);
    bf16* Ow = cur.O + (size_t)(wid * QBLK) * DM;
#pragma unroll
    for (int r = 0; r < 16; ++r) { const int orow = crow(r, hi);
#pragma unroll
        for (int d0 = 0; d0 < 4; ++d0) { const float v = o[d0][r] * rli[r]; const float vn = __shfl_xor(v, 1);
            if ((r32 & 1) == 0) *(unsigned*)(Ow + (size_t)orow * DM + d0 * 32 + r32) = cvtpk(v, vn); } }
    __syncthreads();
#undef DRESC
#undef DKBASE
#undef DBIAS
#undef DMASKT
#undef DSEAM_K0
#undef DHALF_STEP
#undef DROT
}
#undef DROWV
#undef DROWK
#undef DVMW
#undef DVMWN
#undef DSLOAD
#undef DSWRITE_K
#undef DSWRITE_V
struct Tensors { const bf16* Q; const bf16* K; const bf16* V; bf16* O0; bf16* O1; const unsigned* NQ; const unsigned* NK; unsigned* qhead; const unsigned short* order; };
__device__ __forceinline__ BlockRef make_ref(const Tensors& T, unsigned code) {
    const int qb = code & 15, h = (code >> 4) & 7, b = (code >> 7) & 3, c = (code >> 9) & 1, hq = 2 * h + c;
    BlockRef r; const size_t rowb = (size_t)b * SEQ;
    r.Q = T.Q + (rowb + (size_t)qb * QB) * DM + hq * DQK; r.K = T.K + rowb * DM + hq * DQK; r.V = T.V + rowb * DM + h * DV; r.O = (c ? T.O1 : T.O0) + (rowb + (size_t)qb * QB) * DM + h * DV;
    r.P0 = qb * QB; r.sl2 = __builtin_amdgcn_exp2f(-(float)(h + 1)) * 1.4426950408889634f;
    int lane_ = threadIdx.x & 63; asm volatile("" : "+v"(lane_));
    const int nt_ = 4 * qb + 4; float qn_ = 0.f;
#pragma unroll
    for (int i_ = 0; i_ < 4; ++i_) qn_ = fmaxf(qn_, __uint_as_float(T.NQ[((b * 64 + 4 * qb + i_) * 16) + hq]));
    const float kn_ = lane_ < nt_ ? __uint_as_float(T.NK[((b * 64 + lane_) * 16) + hq]) : 0.f;
    const float bound_ = sqrtf(qn_) * sqrtf(kn_) * 1.001f - r.sl2 * (float)(256 * qb - 64 * lane_ - 63) - 4.0f;
    const unsigned long long keep_ = __ballot(lane_ < nt_ && !(bound_ < -152.0f));
    int first_ = keep_ ? (int)__builtin_ctzll(keep_) : nt_ - 1; if (first_ > nt_ - 4) first_ = nt_ - 4;
    r.jlo = __builtin_amdgcn_readfirstlane(first_);
    return r;
}
__device__ __forceinline__ int draw(const Tensors& T, volatile __attribute__((address_space(3))) unsigned* qw) {
    __syncthreads();
    if (threadIdx.x == 0) *qw = __hip_atomic_fetch_add(T.qhead, 1u, __ATOMIC_RELAXED, __HIP_MEMORY_SCOPE_AGENT);
    __syncthreads();
    return (int)*qw;
}
__device__ __forceinline__ void datt_phase(char* lds, volatile __attribute__((address_space(3))) unsigned* qw, const Tensors& T) {
    int i = draw(T, qw); if (i >= 1024) return;
    BlockRef cur = make_ref(T, T.order[i]);
    Seam S;
    datt_prime(cur, lds, S);
    for (;;) {
        const int in = draw(T, qw); const bool last = in >= 1024;
        const BlockRef nxt = last ? cur : make_ref(T, T.order[in]);
        datt_block(cur, nxt, lds, S);
        if (last) break;
        cur = nxt;
    }
}
#undef DKSWZ
#undef DSBAR
}
__device__ const unsigned short datt_order[1024] = {79,95,111,127,207,223,239,255,335,351,367,383,463,479,495,511,591,607,623,639,719,735,751,767,847,863,879,895,975,991,1007,1023,78,94,110,126,206,222,238,254,334,350,366,382,462,478,494,510,590,606,622,638,718,734,750,766,846,862,878,894,974,990,1006,1022,77,93,109,125,205,221,237,253,333,349,365,381,461,477,493,509,589,605,621,637,717,733,749,765,845,861,877,893,973,989,1005,1021,76,92,108,124,204,220,236,252,332,348,364,380,460,476,492,508,588,604,620,636,716,732,748,764,844,860,876,892,972,988,1004,1020,75,91,107,123,203,219,235,251,331,347,363,379,459,475,491,507,587,603,619,635,715,731,747,763,843,859,875,891,971,987,1003,1019,74,90,106,122,202,218,234,250,330,346,362,378,458,474,490,506,586,602,618,634,714,730,746,762,842,858,874,890,970,986,1002,1018,73,89,105,121,201,217,233,249,329,345,361,377,457,473,489,505,585,601,617,633,713,729,745,761,841,857,873,889,969,985,1001,1017,56,57,58,59,60,61,62,63,72,88,104,120,184,185,186,187,188,189,190,191,200,216,232,248,312,313,314,315,316,317,318,319,328,344,360,376,440,441,442,443,444,445,446,447,456,472,488,504,568,569,570,571,572,573,574,575,584,600,616,632,696,697,698,699,700,701,702,703,712,728,744,760,824,825,826,827,828,829,830,831,840,856,872,888,952,953,954,955,956,957,958,959,968,984,1000,1016,55,71,87,103,119,183,199,215,231,247,311,327,343,359,375,439,455,471,487,503,567,583,599,615,631,695,711,727,743,759,823,839,855,871,887,951,967,983,999,1015,54,70,86,102,118,182,198,214,230,246,310,326,342,358,374,438,454,470,486,502,566,582,598,614,630,694,710,726,742,758,822,838,854,870,886,950,966,982,998,1014,53,69,85,101,117,181,197,213,229,245,309,325,341,357,373,437,453,469,485,501,565,581,597,613,629,693,709,725,741,757,821,837,853,869,885,949,965,981,997,1013,36,37,38,39,40,41,42,43,44,45,46,47,52,68,84,100,116,164,165,166,167,168,169,170,171,172,173,174,175,180,196,212,228,244,292,293,294,295,296,297,298,299,300,301,302,303,308,324,340,356,372,420,421,422,423,424,425,426,427,428,429,430,431,436,452,468,484,500,548,549,550,551,552,553,554,555,556,557,558,559,564,580,596,612,628,676,677,678,679,680,681,682,683,684,685,686,687,692,708,724,740,756,804,805,806,807,808,809,810,811,812,813,814,815,820,836,852,868,884,932,933,934,935,936,937,938,939,940,941,942,943,948,964,980,996,1012,35,51,67,83,99,115,163,179,195,211,227,243,291,307,323,339,355,371,419,435,451,467,483,499,547,563,579,595,611,627,675,691,707,723,739,755,803,819,835,851,867,883,931,947,963,979,995,1011,18,19,20,21,22,23,24,25,26,27,28,29,30,31,34,50,66,82,98,114,146,147,148,149,150,151,152,153,154,155,156,157,158,159,162,178,194,210,226,242,274,275,276,277,278,279,280,281,282,283,284,285,286,287,290,306,322,338,354,370,402,403,404,405,406,407,408,409,410,411,412,413,414,415,418,434,450,466,482,498,530,531,532,533,534,535,536,537,538,539,540,541,542,543,546,562,578,594,610,626,658,659,660,661,662,663,664,665,666,667,668,669,670,671,674,690,706,722,738,754,786,787,788,789,790,791,792,793,794,795,796,797,798,799,802,818,834,850,866,882,914,915,916,917,918,919,920,921,922,923,924,925,926,927,930,946,962,978,994,1010,1,2,3,4,5,6,7,8,9,10,11,12,13,14,15,17,33,49,65,81,97,113,129,130,131,132,133,134,135,136,137,138,139,140,141,142,143,145,161,177,193,209,225,241,257,258,259,260,261,262,263,264,265,266,267,268,269,270,271,273,289,305,321,337,353,369,385,386,387,388,389,390,391,392,393,394,395,396,397,398,399,401,417,433,449,465,481,497,513,514,515,516,517,518,519,520,521,522,523,524,525,526,527,529,545,561,577,593,609,625,641,642,643,644,645,646,647,648,649,650,651,652,653,654,655,657,673,689,705,721,737,753,769,770,771,772,773,774,775,776,777,778,779,780,781,782,783,785,801,817,833,849,865,881,897,898,899,900,901,902,903,904,905,906,907,908,909,910,911,913,929,945,961,977,993,1009,0,16,32,48,64,80,96,112,128,144,160,176,192,208,224,240,256,272,288,304,320,336,352,368,384,400,416,432,448,464,480,496,512,528,544,560,576,592,608,624,640,656,672,688,704,720,736,752,768,784,800,816,832,848,864,880,896,912,928,944,960,976,992,1008};

constexpr int NWAVES = 8;
constexpr int BATCH = 4, SEQ = 4096, D = 2048, M = BATCH * SEQ;
constexpr int AW = 1024, NIN = 5120;
constexpr float LN_EPS = 1e-5f;
constexpr float DN_ALPHA = 1.189207115002721f;
constexpr float C2 = 0.125f * 1.4426950408889634f;
constexpr float LOG2E = 1.4426950408889634f;

constexpr size_t MiB = 1u << 20;
constexpr size_t WS_CTL = 0, CTL_ZERO_BYTES = 1 * MiB;
constexpr size_t WS_WIN = 2 * MiB, WS_WOUT = 22 * MiB, WS_WQ = 30 * MiB, WS_PRM = 38 * MiB;
constexpr size_t WS_XB = 392 * MiB;
constexpr size_t WS_MIX = 40 * MiB;
constexpr size_t WS_Q = 104 * MiB, WS_K = 136 * MiB, WS_V = 168 * MiB, WS_XR = 200 * MiB, WS_XG = 232 * MiB;
constexpr size_t WS_Y1 = 104 * MiB;
constexpr size_t WS_H1 = 232 * MiB;
constexpr size_t WS_H8 = 296 * MiB;
constexpr size_t WS_PQ = 104 * MiB;
constexpr size_t WS_SU = 38 * MiB + 65536, WS_SH = 38 * MiB + 131072;
constexpr size_t WS_WG = 38 * MiB + 262144;
constexpr size_t WS_PART = 104 * MiB;
constexpr size_t WS_FFN = 40 * MiB;
constexpr size_t WS_PK = 2 * MiB;
constexpr size_t WS_U8 = 328 * MiB, WS_V8 = 360 * MiB;
constexpr size_t WS_LA = 328 * MiB, WS_LB = 392 * MiB;
constexpr size_t WS_O0 = 264 * MiB, WS_O1 = 296 * MiB;
constexpr size_t WS_E = 456 * MiB, WS_G = 464 * MiB, WS_TOTA = 472 * MiB, WS_TOTH = 473 * MiB, WS_SKH = 474 * MiB, WS_SKL = 475 * MiB, WS_END = 476 * MiB;
constexpr int CW_BAR = 4096;
constexpr int CW_NQ = 32768, CW_NK = 32768 + 4096, CW_AQ = 32768 + 8192, CW_CQ = 32768 + 8192 + 128;

constexpr int RING_OFF = 0, RING_BYTES = 131072;
constexpr int LDSCTL_OFF = RING_BYTES, MISC_OFF = LDSCTL_OFF + 320;
constexpr int LDS_BYTES = 147456;

#define GAS __attribute__((address_space(1)))
#define LAS __attribute__((address_space(3)))
typedef unsigned short bf16;
typedef unsigned v4u __attribute__((ext_vector_type(4)));
typedef float f32x4 __attribute__((ext_vector_type(4)));
typedef GAS unsigned gu32;
#define RLX_AGENT __ATOMIC_RELAXED, __HIP_MEMORY_SCOPE_AGENT
#define LDS_WAIT() asm volatile("s_waitcnt lgkmcnt(0)" ::: "memory")
#define VM_WAIT() asm volatile("s_waitcnt vmcnt(0)" ::: "memory")
__device__ __forceinline__ unsigned f2bf(float f) { unsigned u = __builtin_bit_cast(unsigned, f); return (u + 0x7fffu + ((u >> 16) & 1u)) >> 16; }
__device__ __forceinline__ unsigned pk2(float lo, float hi) { return f2bf(lo) | (f2bf(hi) << 16); }
__device__ __forceinline__ float bf2f(unsigned short u) { return __uint_as_float(((unsigned)u) << 16); }
__device__ __forceinline__ float gelu_tanh(float x) { const float u = 0.7978845608028654f * (x + 0.044715f * x * x * x); return 0.5f * x * (1.f + tanhf(u)); }

#define XB_TMO      128
#define XB_XCNT(j)  (256  + 64 * (j))
#define XB_XSUB(j)  (1280 + 64 * (j))
#define XB_XGEN(j)  (2304 + 64 * (j))
#define XB_TOP      3328
#define XB_TOPGEN   3392
#define XCD_BAR_WORDS 3456
#define XB_SPIN_CAP (1u << 18)

__device__ __forceinline__ unsigned xb_ld(unsigned* p)              { return __hip_atomic_load(p, __ATOMIC_RELAXED, __HIP_MEMORY_SCOPE_AGENT); }
__device__ __forceinline__ unsigned xb_add(unsigned* p, unsigned v) { return __hip_atomic_fetch_add(p, v, __ATOMIC_RELAXED, __HIP_MEMORY_SCOPE_AGENT); }
__device__ __forceinline__ unsigned xb_xcc_id() { return (unsigned)__builtin_amdgcn_s_getreg((3 << 11) | 20) & 0xFu; }
#define XB_SPIN(cond, bar) do { unsigned _sp = 0; while (cond) { __builtin_amdgcn_s_sleep(1); \
    if ((++_sp & 255u) == 0u) { if (xb_ld(&(bar)[XB_TMO])) break; if (_sp > XB_SPIN_CAP) { atomicAdd(&(bar)[XB_TMO], 1u); break; } } } } while (0)

struct XcdBarrier {
    unsigned* bar; unsigned x;
    volatile LAS unsigned* st;
};

__device__ __forceinline__ XcdBarrier xcd_barrier_post(unsigned* bar, volatile LAS unsigned* st) {
    XcdBarrier b; b.bar = bar; b.x = xb_xcc_id(); b.st = st;
    if (threadIdx.x == 0) (void)xb_add(&bar[XB_XCNT(b.x)], 1u);
    return b;
}
__device__ __forceinline__ void xcd_barrier_complete(unsigned* bar, unsigned x, unsigned& nloc, unsigned& nx) {
    const unsigned G = gridDim.x * gridDim.y * gridDim.z;
    unsigned sum, cnt, mine, sp = 0u;
    for (;;) {
        sum = 0u; cnt = 0u; mine = 0u;
#pragma unroll
        for (unsigned j = 0; j < 16; ++j) { const unsigned c = xb_ld(&bar[XB_XCNT(j)]); sum += c; cnt += (c > 0u) ? 1u : 0u; mine = (j == x) ? c : mine; }
        if (sum == G) break;
        __builtin_amdgcn_s_sleep(1);
        if ((++sp & 255u) == 0u) { if (xb_ld(&bar[XB_TMO])) break; if (sp > XB_SPIN_CAP) { atomicAdd(&bar[XB_TMO], 1u); break; } }
    }
    nloc = mine > 0u ? mine : 1u; nx = cnt > 0u ? cnt : 1u;
}

__device__ __forceinline__ void xcd_barrier(const XcdBarrier& b) {
    asm volatile("s_waitcnt vmcnt(0)" ::: "memory");
    __syncthreads();
    if (threadIdx.x == 0) {
        unsigned* bar = b.bar;
        __builtin_amdgcn_s_waitcnt(0);
        unsigned nloc = b.st[0], nx = b.st[1];
        if (nloc == 0u) { xcd_barrier_complete(bar, b.x, nloc, nx); b.st[0] = nloc; b.st[1] = nx; }
        const unsigned old = xb_add(&bar[XB_XSUB(b.x)], 1u);
        const unsigned gen = old / nloc;
        if (old + 1u == (gen + 1u) * nloc) {
            __builtin_amdgcn_fence(__ATOMIC_RELEASE, "agent");
            asm volatile("s_waitcnt vmcnt(0)" ::: "memory");
            const unsigned og = xb_add(&bar[XB_TOP], 1u);
            const unsigned tg = og / nx;
            if (og + 1u == (tg + 1u) * nx) xb_add(&bar[XB_TOPGEN], 1u);
            else XB_SPIN(xb_ld(&bar[XB_TOPGEN]) == tg, bar);
            __builtin_amdgcn_fence(__ATOMIC_ACQUIRE, "agent");
            xb_add(&bar[XB_XGEN(b.x)], 1u);
            asm volatile("s_waitcnt vmcnt(0)" ::: "memory");
        } else {
            XB_SPIN(xb_ld(&bar[XB_XGEN(b.x)]) == gen, bar);
            __builtin_amdgcn_fence(__ATOMIC_ACQUIRE, "agent");
            asm volatile("s_waitcnt vmcnt(0)" ::: "memory");
        }
    }
    __syncthreads();
}

struct Frame {
    LAS unsigned char* lds;
    int tid, lane, wave;
    int vcu, G;
};

__device__ __forceinline__ void p0_transpose_item(const float* W, int K, int N, bf16* WT, int row_off, LAS float* scr, int item, int lane) {
    const int nblk = N / 32, kb = item / nblk, nb = item % nblk, k0 = 64 * kb, n0 = 32 * nb;
#pragma unroll 8
    for (int i = 0; i < 32; ++i) { const int kk = 2 * i + (lane >> 5); scr[kk * 33 + (lane & 31)] = W[(size_t)(k0 + kk) * N + n0 + (lane & 31)]; }
    LDS_WAIT(); asm volatile("" ::: "memory");
    const int c = lane & 7;
#pragma unroll
    for (int j = 0; j < 4; ++j) { const int n = (lane >> 3) + 8 * j; const LAS float* s = scr + (8 * c) * 33 + n;
        v4u o; o.x = pk2(s[0 * 33], s[1 * 33]); o.y = pk2(s[2 * 33], s[3 * 33]); o.z = pk2(s[4 * 33], s[5 * 33]); o.w = pk2(s[6 * 33], s[7 * 33]);
        *(GAS v4u*)(WT + (size_t)(row_off + n0 + n) * K + k0 + 8 * c) = o; }
    LDS_WAIT(); asm volatile("" ::: "memory");
}

typedef short bf16x8 __attribute__((ext_vector_type(8)));
typedef float f32x16 __attribute__((ext_vector_type(16)));
typedef float f32x2_t __attribute__((ext_vector_type(2))); typedef __bf16 bf16x2_t __attribute__((ext_vector_type(2)));
__device__ __forceinline__ unsigned cvtpk(float lo, float hi) { f32x2_t v = {lo, hi}; bf16x2_t b = __builtin_convertvector(v, bf16x2_t); return __builtin_bit_cast(unsigned, b); }
__device__ __forceinline__ void split8(const f32x4 a, const f32x4 b, bf16x8& h, bf16x8& l) {
    v4u hh; hh.x = cvtpk(a.x, a.y); hh.y = cvtpk(a.z, a.w); hh.z = cvtpk(b.x, b.y); hh.w = cvtpk(b.z, b.w);
    v4u ll;
    ll.x = cvtpk(a.x - __uint_as_float(hh.x << 16), a.y - __uint_as_float(hh.x & 0xffff0000u));
    ll.y = cvtpk(a.z - __uint_as_float(hh.y << 16), a.w - __uint_as_float(hh.y & 0xffff0000u));
    ll.z = cvtpk(b.x - __uint_as_float(hh.z << 16), b.y - __uint_as_float(hh.z & 0xffff0000u));
    ll.w = cvtpk(b.z - __uint_as_float(hh.w << 16), b.w - __uint_as_float(hh.w & 0xffff0000u));
    h = __builtin_bit_cast(bf16x8, hh); l = __builtin_bit_cast(bf16x8, ll);
}
__device__ __forceinline__ float max3f_(float a, float b, float c) { return __builtin_fmaxf(__builtin_fmaxf(a, b), c); }
__device__ __forceinline__ float pair_max(float m) { auto rr = __builtin_amdgcn_permlane32_swap(__float_as_uint(m), __float_as_uint(m), false, false); return __builtin_fmaxf(__uint_as_float(rr[0]), __uint_as_float(rr[1])); }
__device__ __forceinline__ void route_half(const float* qp, const v4u* kh, const v4u* kl, int lane, int hi, float (&lst)[16]) {
    f32x16 sc[4];
#pragma unroll
    for (int kt = 0; kt < 4; ++kt) sc[kt] = f32x16{};
#pragma unroll 2
    for (int ds = 0; ds < 8; ++ds) { bf16x8 qh, ql; split8(*(const f32x4*)(qp + 16 * ds), *(const f32x4*)(qp + 16 * ds + 4), qh, ql);
#pragma unroll
        for (int kt = 0; kt < 4; ++kt) { const bf16x8 ah = __builtin_bit_cast(bf16x8, kh[(kt * 8 + ds) * 64 + lane]), al = __builtin_bit_cast(bf16x8, kl[(kt * 8 + ds) * 64 + lane]);
            sc[kt] = __builtin_amdgcn_mfma_f32_32x32x16_bf16(ah, qh, sc[kt], 0, 0, 0);
            sc[kt] = __builtin_amdgcn_mfma_f32_32x32x16_bf16(ah, ql, sc[kt], 0, 0, 0);
            sc[kt] = __builtin_amdgcn_mfma_f32_32x32x16_bf16(al, qh, sc[kt], 0, 0, 0); } }
#pragma unroll
    for (int kt = 0; kt < 4; ++kt)
#pragma unroll
        for (int r = 0; r < 16; ++r) { const unsigned key = (unsigned)(kt * 32 + (r & 3) + 8 * (r >> 2) + 4 * hi); sc[kt][r] = __uint_as_float((__float_as_uint(sc[kt][r]) & ~127u) | (127u - key)); }
#pragma unroll
    for (int rd = 0; rd < 16; ++rd) {
        float m = max3f_(sc[0][0], sc[0][1], sc[0][2]);
#pragma unroll
        for (int n = 3; n + 1 < 64; n += 2) m = max3f_(m, sc[n >> 4][n & 15], sc[(n + 1) >> 4][(n + 1) & 15]);
        m = __builtin_fmaxf(m, sc[3][15]);
        const float gm = pair_max(m); lst[rd] = gm;
#pragma unroll
        for (int kt = 0; kt < 4; ++kt)
#pragma unroll
            for (int r = 0; r < 16; ++r) sc[kt][r] = (__float_as_uint(sc[kt][r]) == __float_as_uint(gm)) ? -INFINITY : sc[kt][r];
    }
}
typedef float f32x2v __attribute__((ext_vector_type(2)));
__device__ __forceinline__ unsigned pk4_fp8(float a, float b, float c, float d) { int p = __builtin_amdgcn_cvt_pk_fp8_f32(a, b, 0, false); p = __builtin_amdgcn_cvt_pk_fp8_f32(c, d, p, true); return (unsigned)p; }
constexpr float U8_SCALE = 64.f;
typedef short bf16x8_l __attribute__((ext_vector_type(8)));
template <int PASS> __device__ __forceinline__ void lru_phase(const Frame& F, unsigned char* ws, const float* conv_w, const float* conv_b, const float* b_a, const float* b_x, const float* lru_lambda) {
    constexpr int XS = 272;
    LAS unsigned char* xs = F.lds + RING_OFF;
    const bf16* XR = (const bf16*)(ws + WS_XR); const bf16* XG = (const bf16*)(ws + WS_XG); bf16* MIX = (bf16*)(ws + WS_MIX); const bf16* WGT = (const bf16*)(ws + WS_WG);
    float* TA = (float*)(ws + WS_TOTA); float* TH = (float*)(ws + WS_TOTH);
    const int tid = F.tid, lane = F.lane, w = F.wave, l15 = lane & 15, g = lane >> 4;
    const int hb = F.vcu & 7;
    const int nun = 2048 / 8;
    const int gi = F.vcu >> 3, gn = (F.G + 7 - hb) >> 3;
    const int chc = tid & 127, tg = tid >> 7, colc = hb * 128 + chc;
    const float cw0 = conv_w[colc], cw1 = conv_w[1024 + colc], cw2 = conv_w[2048 + colc], cw3 = conv_w[3072 + colc], cb = conv_b[colc];
    const int chn = hb * 128 + 16 * w + l15;
    bf16x8_l Ba[4], Bx[4];
#pragma unroll
    for (int ks = 0; ks < 4; ++ks) { Ba[ks] = *(const bf16x8_l*)(WGT + ((size_t)(hb * 128 + 16 * w + l15)) * 128 + 32 * ks + 8 * g); Bx[ks] = *(const bf16x8_l*)(WGT + ((size_t)((8 + hb) * 128 + 16 * w + l15)) * 128 + 32 * ks + 8 * g); }
    const float ba = b_a[chn], bx = b_x[chn], sp8 = 8.f * log1pf(__expf(-lru_lambda[chn]));
    unsigned short xrn[19], xgn[16]; float tan_[16], thn_[16];
#define LRU_LOAD(uu) do { const int c_ = (uu) & 63, b_ = (uu) >> 6, tok0_ = b_ * SEQ + c_ * 64; \
        _Pragma("unroll") for (int r = 0; r < 19; ++r) xrn[r] = (c_ * 64 + tg * 16 + r - 3 >= 0) ? XR[(size_t)(tok0_ + tg * 16 + r - 3) * AW + colc] : (unsigned short)0; \
        if (PASS == 2) { _Pragma("unroll") for (int m = 0; m < 4; ++m) _Pragma("unroll") for (int r = 0; r < 4; ++r) xgn[4 * m + r] = XG[(size_t)(tok0_ + 16 * m + 4 * g + r) * AW + chn]; \
            _Pragma("unroll") for (int i = 0; i < 16; ++i) { const int c2 = 16 * g + i, cl = c2 < c_ ? c2 : 0; tan_[i] = TA[(b_ * 64 + cl) * 1024 + chn]; thn_[i] = TH[(b_ * 64 + cl) * 1024 + chn]; } } } while (0)
    if (gi < nun) LRU_LOAD(gi);
    for (int uu = gi; uu < nun; uu += gn) {
        const int c = uu & 63, b = uu >> 6, tok0 = b * SEQ + c * 64;
        {
            float xv[19];
#pragma unroll
            for (int r = 0; r < 19; ++r) xv[r] = bf2f(xrn[r]);
#pragma unroll
            for (int i = 0; i < 16; ++i) { const float y = cb + cw0 * xv[i] + cw1 * xv[i + 1] + cw2 * xv[i + 2] + cw3 * xv[i + 3];
                *(LAS unsigned short*)(xs + (tg * 16 + i) * XS + chc * 2) = (unsigned short)f2bf(y); }
        }
        unsigned short xgv[16]; float ta[16], th[16];
        if (PASS == 2) {
#pragma unroll
            for (int i = 0; i < 16; ++i) { xgv[i] = xgn[i]; const int c2 = 16 * g + i; ta[i] = c2 < c ? tan_[i] : 1.f; th[i] = c2 < c ? thn_[i] : 0.f; } }
        __syncthreads();
        if (uu + gn < nun) LRU_LOAD(uu + gn);
        f32x4 ca[4], cx[4];
#pragma unroll
        for (int m = 0; m < 4; ++m) { ca[m] = (f32x4){0.f, 0.f, 0.f, 0.f}; cx[m] = (f32x4){0.f, 0.f, 0.f, 0.f};
#pragma unroll
            for (int ks = 0; ks < 4; ++ks) { const bf16x8_l A = *(const LAS bf16x8_l*)(xs + (16 * m + l15) * XS + (32 * ks + 8 * g) * 2);
                ca[m] = __builtin_amdgcn_mfma_f32_16x16x32_bf16(A, Ba[ks], ca[m], 0, 0, 0); cx[m] = __builtin_amdgcn_mfma_f32_16x16x32_bf16(A, Bx[ks], cx[m], 0, 0, 0); } }
        float av[4][4], bv[4][4];
#pragma unroll
        for (int m = 0; m < 4; ++m)
#pragma unroll
            for (int r = 0; r < 4; ++r) { const int tt = 16 * m + 4 * g + r;
                const float rg = 1.f / (1.f + __expf(-(ca[m][r] + ba))), ig = 1.f / (1.f + __expf(-(cx[m][r] + bx)));
                const float a = __expf(-sp8 * rg), xcv = bf2f(*(const LAS unsigned short*)(xs + tt * XS + (16 * w + l15) * 2));
                av[m][r] = a; bv[m][r] = sqrtf(fmaxf(1.f - a * a, 0.f)) * ig * xcv; }
        float carry = 0.f, Ac = 1.f;
        if (PASS == 2) {
            float Ap = 1.f, Hp = 0.f;
#pragma unroll
            for (int i = 0; i < 16; ++i) { Hp = ta[i] * Hp + th[i]; Ap *= ta[i]; }
            { const float A1 = __shfl_up(Ap, 16), H1 = __shfl_up(Hp, 16); if (g >= 1) { Hp = Ap * H1 + Hp; Ap = Ap * A1; } }
            { const float A2 = __shfl_up(Ap, 32), H2 = __shfl_up(Hp, 32); if (g >= 2) { Hp = Ap * H2 + Hp; Ap = Ap * A2; } }
            carry = __shfl(Hp, 48 + l15);
        }
#pragma unroll
        for (int m = 0; m < 4; ++m) {
            float As = (av[m][0] * av[m][1]) * (av[m][2] * av[m][3]);
            float Hs = ((bv[m][0] * av[m][1] + bv[m][1]) * av[m][2] + bv[m][2]) * av[m][3] + bv[m][3];
            { const float A1 = __shfl_up(As, 16), H1 = __shfl_up(Hs, 16); if (g >= 1) { Hs = As * H1 + Hs; As = As * A1; } }
            { const float A2 = __shfl_up(As, 32), H2 = __shfl_up(Hs, 32); if (g >= 2) { Hs = As * H2 + Hs; As = As * A2; } }
            const float At = __shfl(As, 48 + l15), Ht = __shfl(Hs, 48 + l15);
            if (PASS == 2) {
                float Ae = __shfl_up(As, 16), He = __shfl_up(Hs, 16); if (g == 0) { Ae = 1.f; He = 0.f; }
                float h = Ae * carry + He;
#pragma unroll
                for (int r = 0; r < 4; ++r) { h = av[m][r] * h + bv[m][r]; const int tt = 16 * m + 4 * g + r;
                    MIX[(size_t)(tok0 + tt) * D + 1024 + chn] = (bf16)f2bf(h * gelu_tanh(bf2f(xgv[4 * m + r]))); }
            }
            carry = At * carry + Ht; Ac *= At;
        }
        if (PASS == 1 && g == 0) { TA[(b * 64 + c) * 1024 + chn] = Ac; TH[(b * 64 + c) * 1024 + chn] = carry; }
        __syncthreads();
    }
#undef LRU_LOAD
}
struct Args { const float* in[23]; float* out; unsigned char* ws; int ph_lo, ph_hi; };

__global__ void __launch_bounds__(NWAVES * 64, 2) skel_fwd(Args args) {
    extern __shared__ __attribute__((aligned(16))) unsigned char lds[];
    Frame F;
    F.lds = (LAS unsigned char*)lds;
    F.tid = threadIdx.x; F.lane = F.tid & 63; F.wave = __builtin_amdgcn_readfirstlane(F.tid >> 6);
    F.G = gridDim.x; { const int bx = blockIdx.x; F.vcu = (F.G % 8 == 0) ? (bx % 8) * (F.G / 8) + bx / 8 : bx; }
    unsigned char* ws = args.ws;
    const float* x = args.in[0];
    bf16* WIN_T = (bf16*)(ws + WS_WIN); bf16* WOUT_T = (bf16*)(ws + WS_WOUT); bf16* WQ_T = (bf16*)(ws + WS_WQ);
    bf16* XB = (bf16*)(ws + WS_XB); bf16* MIX = (bf16*)(ws + WS_MIX); bf16* QB = (bf16*)(ws + WS_Q); bf16* H1 = (bf16*)(ws + WS_H1);
    float* Y1 = (float*)(ws + WS_Y1); float* PQ = (float*)(ws + WS_PQ);
    for (int u = F.tid; u < (LDS_BYTES - LDSCTL_OFF) / 4; u += NWAVES * 64) ((LAS unsigned*)(F.lds + LDSCTL_OFF))[u] = 0u;
    __syncthreads();
    XcdBarrier bar = xcd_barrier_post((unsigned*)(ws + WS_CTL) + CW_BAR, (volatile LAS unsigned*)(F.lds + MISC_OFF) + 8);
    const unsigned phmask = (unsigned)args.ph_lo;
    int slot_ = 0;
#define IN(k) (false)
#define RUN(slotbit) ((phmask >> (slotbit)) & 1u)
#define GRID_BAR() do { if (phmask == 0xffffffffu) xcd_barrier(bar); } while (0)

    if (RUN(0)) {
        if (blockIdx.x == 0 && F.wave == 0) {
            float a_ = args.in[9][F.lane] * args.in[10][F.lane], b_ = args.in[11][F.lane] * args.in[12][F.lane];
#pragma unroll
            for (int o = 1; o < 64; o <<= 1) { a_ += __shfl_xor(a_, o); b_ += __shfl_xor(b_, o); }
            if (F.lane == 0) ((float*)(ws + WS_PRM))[0] = expf(a_) - expf(b_) + 0.2f;
        }
        LAS float* scr = (LAS float*)(F.lds + RING_OFF + F.wave * 16384);
        const int gw = F.vcu * NWAVES + F.wave, NGW = F.G * NWAVES;
        constexpr int I_IN = (D / 64) * (NIN / 32), I_SQ = (D / 64) * (D / 32);
        constexpr int NITEMS = I_IN + 2 * I_SQ;
        for (int it = gw; it < NITEMS; it += NGW) {
            int r = it;
            if (r < I_IN) { p0_transpose_item(args.in[1], D, NIN, WIN_T, 0, scr, r, F.lane); continue; } r -= I_IN;
            if (r < I_SQ) { p0_transpose_item(args.in[14], D, D, WOUT_T, 0, scr, r, F.lane); continue; } r -= I_SQ;
            p0_transpose_item(args.in[17], D, D, WQ_T, 0, scr, r, F.lane);
        }
        for (int it = gw; it < 128; it += NGW) { const int mt = it >> 3;
            p0_transpose_item(args.in[mt < 8 ? 4 : 6] + (size_t)(mt & 7) * 16384, 128, 128, (bf16*)(ws + WS_WG) + (size_t)mt * 16384, 0, scr, it & 7, F.lane); }
        {
            const float* sk = args.in[18]; v4u* SKH = (v4u*)(ws + WS_SKH); v4u* SKL = (v4u*)(ws + WS_SKL);
            for (int fi = gw; fi < 512; fi += NGW) { const int ds = fi & 7, kt = (fi >> 3) & 3, hp = fi >> 5;
                const float* src = sk + ((size_t)(hp * 128 + kt * 32 + (F.lane & 31)) * 128 + 16 * ds + 8 * (F.lane >> 5));
                bf16x8 h8, l8; split8(*(const f32x4*)src, *(const f32x4*)(src + 4), h8, l8);
                SKH[fi * 64 + F.lane] = __builtin_bit_cast(v4u, h8); SKL[fi * 64 + F.lane] = __builtin_bit_cast(v4u, l8); }
        }
        for (int m = gw; m < M; m += NGW) {
            const GAS f32x4* xr = (const GAS f32x4*)(x + (size_t)m * D) + F.lane;
            GAS unsigned long long* o8 = (GAS unsigned long long*)(XB + (size_t)m * D) + F.lane;
#pragma unroll
            for (int j = 0; j < 8; ++j) { const f32x4 v = xr[64 * j]; o8[64 * j] = (unsigned long long)pk2(v.x, v.y) | ((unsigned long long)pk2(v.z, v.w) << 32); }
        }
    }
    GRID_BAR();
    if (RUN(1)) {
        pg8::Gemm g{XB, WIN_T, M, NIN, D}; pg8::StaticOrder S; S.init(M, NIN, F.G, (int)blockIdx.x);
        pg8::EpiBf16<0> E{QB, AW, nullptr, AW, (size_t)(WS_K - WS_Q) / 2, C2};
        pg8::gemm_phase<pg8::EpiBf16<0>, pg8::StaticOrder, PG8_ALIGN, PG8_SP2>(F.lds + RING_OFF, g, S, E);
    }
    GRID_BAR();
    if (RUN(2)) {
#pragma unroll 1
        for (int step = 0; step < 2; ++step) {
            if (((step ^ F.vcu) & 1) == 0) {
                lru_phase<1>(F, ws, args.in[2], args.in[3], args.in[5], args.in[7], args.in[8]);
                {
                    const int gw = F.vcu * NWAVES + F.wave, NGW = F.G * NWAVES, lane = F.lane; unsigned* ctlw = (unsigned*)(ws + WS_CTL);
                    for (int it = gw; it < 2 * (M / 16); it += NGW) { const int z = it & 1, r16 = it >> 1; const bf16* src = (const bf16*)(ws + (z ? WS_K : WS_Q)) + (size_t)r16 * 16 * AW + 8 * lane;
                        float mx0 = 0.f, mx1 = 0.f;
#pragma unroll 4
                        for (int r = 0; r < 16; ++r) {
#pragma unroll
                            for (int hf = 0; hf < 2; ++hf) { const v4u q = *(const v4u*)(src + (size_t)r * AW + hf * 512); float ss = 0.f;
#pragma unroll
                                for (int e = 0; e < 4; ++e) { const float lo = __uint_as_float(q[e] << 16), hi = __uint_as_float(q[e] & 0xffff0000u); ss += lo * lo + hi * hi; }
                                ss += __builtin_bit_cast(float, __builtin_amdgcn_update_dpp(0, __builtin_bit_cast(int, ss), 0xB1, 0xf, 0xf, true)); ss += __builtin_bit_cast(float, __builtin_amdgcn_update_dpp(0, __builtin_bit_cast(int, ss), 0x4E, 0xf, 0xf, true));
                                ss += __builtin_bit_cast(float, __builtin_amdgcn_update_dpp(0, __builtin_bit_cast(int, ss), 0x141, 0xf, 0xf, true));
                                if (hf == 0) mx0 = fmaxf(mx0, ss); else mx1 = fmaxf(mx1, ss); } }
                        if ((lane & 7) == 0) { unsigned* dst = ctlw + (z ? CW_NK : CW_NQ) + (r16 >> 2) * 16 + (lane >> 3); atomicMax(dst, __float_as_uint(mx0)); atomicMax(dst + 8, __float_as_uint(mx1)); }
                    }
                }
            } else {
                for (int item = F.vcu; item < 512; item += F.G) {
                    if (item < 256) {
                        const float* us = args.in[19]; float* SU = (float*)(ws + WS_SU);
                        f32x4 uv[8];
                        { const f32x4* ur = (const f32x4*)(us + (size_t)(item * 64 + F.wave) * D);
#pragma unroll
                          for (int j = 0; j < 8; ++j) uv[j] = ur[F.lane + 64 * j]; }
                        for (int e = item * 64 + F.wave; e < item * 64 + 64; e += NWAVES) {
                            f32x4 un[8]; { const int en = e + NWAVES < item * 64 + 64 ? e + NWAVES : e; const f32x4* ur = (const f32x4*)(us + (size_t)en * D);
#pragma unroll
                              for (int j = 0; j < 8; ++j) un[j] = ur[F.lane + 64 * j]; }
                            float am = 0.f;
#pragma unroll
                            for (int j = 0; j < 8; ++j) am = fmaxf(fmaxf(am, fmaxf(fabsf(uv[j].x), fabsf(uv[j].y))), fmaxf(fabsf(uv[j].z), fabsf(uv[j].w)));
#pragma unroll
                            for (int o = 1; o < 64; o <<= 1) am = fmaxf(am, __shfl_xor(am, o));
                            const float qs = am > 0.f ? 127.f / am : 0.f;
                            if (F.lane == 0) SU[e] = am * (1.f / 127.f);
#pragma unroll
                            for (int j = 0; j < 8; ++j) { const int c = (F.lane + 64 * j) * 4;
                                const unsigned q = ((unsigned)(int)rintf(uv[j].x * qs) & 0xffu) | (((unsigned)(int)rintf(uv[j].y * qs) & 0xffu) << 8) | (((unsigned)(int)rintf(uv[j].z * qs) & 0xffu) << 16) | (((unsigned)(int)rintf(uv[j].w * qs) & 0xffu) << 24);
                                *(unsigned*)(ws + WS_U8 + ((size_t)(c >> 7) * 16384 + e) * 128 + (c & 127)) = q; }
#pragma unroll
                            for (int j = 0; j < 8; ++j) uv[j] = un[j];
                        }
                    } else {
                        const float* vs = args.in[20]; unsigned char* V8 = ws + WS_V8; LAS unsigned char* tl = F.lds + RING_OFF;
                        f32x4 vv[8];
                        { const int t = (item - 256) * 8, e0 = (t >> 3) * 64, c0 = (t & 7) * 256;
#pragma unroll
                          for (int j = 0; j < 8; ++j) { const int idx = F.tid + 512 * j, r = idx >> 6, c = 4 * (idx & 63); vv[j] = *(const f32x4*)(vs + (size_t)(e0 + r) * D + c0 + c); } }
                        for (int t = (item - 256) * 8; t < (item - 256) * 8 + 8; ++t) { const int e0 = (t >> 3) * 64, c0 = (t & 7) * 256;
                            f32x4 vn[8]; { const int tn = t + 1 < (item - 256) * 8 + 8 ? t + 1 : t, e1 = (tn >> 3) * 64, c1 = (tn & 7) * 256;
#pragma unroll
                              for (int j = 0; j < 8; ++j) { const int idx = F.tid + 512 * j, r = idx >> 6, c = 4 * (idx & 63); vn[j] = *(const f32x4*)(vs + (size_t)(e1 + r) * D + c1 + c); } }
                            __syncthreads();
#pragma unroll
                            for (int j = 0; j < 8; ++j) { const int idx = F.tid + 512 * j, r = idx >> 6, c = 4 * (idx & 63);
                                *(LAS unsigned*)(tl + (c >> 3) * 512 + r * 8 + (c & 7)) = pk4_fp8(vv[j].x, vv[j].y, vv[j].z, vv[j].w); }
                            __syncthreads();
#pragma unroll
                            for (int j = 0; j < 2; ++j) { const int cu = (F.tid >> 5) + 16 * j, pc = F.tid & 31;
                                *(v4u*)(V8 + ((size_t)((c0 >> 3) + cu) * 16384 + e0) * 8 + pc * 16) = *(const LAS v4u*)(tl + cu * 512 + pc * 16); }
#pragma unroll
                            for (int j = 0; j < 8; ++j) vv[j] = vn[j];
                        }
                    }
                }
                __syncthreads();
            }
        }
    }
    GRID_BAR();
    if (RUN(4)) {
        static_assert(datt::LDS_BYTES <= RING_BYTES, "attention LDS vs ring");
        const datt::Tensors DT{(const datt::bf16*)QB, (const datt::bf16*)(ws + WS_K), (const datt::bf16*)(ws + WS_V), (datt::bf16*)(ws + WS_O0), (datt::bf16*)(ws + WS_O1),
                               (const unsigned*)(ws + WS_CTL) + CW_NQ, (const unsigned*)(ws + WS_CTL) + CW_NK, (unsigned*)(ws + WS_CTL) + CW_AQ, datt_order};
        datt::datt_phase((char*)lds + RING_OFF, (volatile LAS unsigned*)(F.lds + MISC_OFF) + 16, DT);
    }
    if (RUN(5)) lru_phase<2>(F, ws, args.in[2], args.in[3], args.in[5], args.in[7], args.in[8]);
    GRID_BAR();
    if (RUN(6)) {
        const int gw = F.vcu * NWAVES + F.wave, NGW = F.G * NWAVES, sub = F.lane >> 4, l16 = F.lane & 15;
        const float lam = ((const float*)(ws + WS_PRM))[0];
        const bf16* O0 = (const bf16*)(ws + WS_O0); const bf16* O1 = (const bf16*)(ws + WS_O1);
        float gs[8];
#pragma unroll
        for (int e = 0; e < 8; ++e) gs[e] = args.in[13][l16 * 8 + e] * 0.8f;
        for (int it = gw; it < M * 2; it += NGW) { const int item = it * 4 + sub, tok = item >> 3, h = item & 7;
            const v4u a = *(const v4u*)(O0 + (size_t)tok * AW + h * 128 + l16 * 8), b = *(const v4u*)(O1 + (size_t)tok * AW + h * 128 + l16 * 8);
            float d[8]; float ss = 0.f;
#pragma unroll
            for (int e = 0; e < 4; ++e) { d[2 * e] = __uint_as_float(a[e] << 16) - lam * __uint_as_float(b[e] << 16); d[2 * e + 1] = __uint_as_float(a[e] & 0xffff0000u) - lam * __uint_as_float(b[e] & 0xffff0000u); ss += d[2 * e] * d[2 * e] + d[2 * e + 1] * d[2 * e + 1]; }
            ss += __builtin_bit_cast(float, __builtin_amdgcn_update_dpp(0, __builtin_bit_cast(int, ss), 0xB1, 0xf, 0xf, true)); ss += __builtin_bit_cast(float, __builtin_amdgcn_update_dpp(0, __builtin_bit_cast(int, ss), 0x4E, 0xf, 0xf, true));
            ss += __builtin_bit_cast(float, __builtin_amdgcn_update_dpp(0, __builtin_bit_cast(int, ss), 0x141, 0xf, 0xf, true)); ss += __builtin_bit_cast(float, __builtin_amdgcn_update_dpp(0, __builtin_bit_cast(int, ss), 0x140, 0xf, 0xf, true));
            const float r = rsqrtf(ss * (1.f / 128.f) + LN_EPS);
            *(v4u*)(MIX + (size_t)tok * D + h * 128 + l16 * 8) = (v4u){pk2(d[0] * r * gs[0], d[1] * r * gs[1]), pk2(d[2] * r * gs[2], d[3] * r * gs[3]), pk2(d[4] * r * gs[4], d[5] * r * gs[5]), pk2(d[6] * r * gs[6], d[7] * r * gs[7])}; }
    }
    GRID_BAR();
    if (RUN(7)) {
        pg8::Gemm g{MIX, WOUT_T, M, D, D}; pg8::StaticOrder S; S.init(M, D, F.G, (int)blockIdx.x);
        pg8::EpiBf16<0> E{(bf16*)Y1, D, nullptr, 0, 0, 1.f};
        pg8::gemm_phase<pg8::EpiBf16<0>, pg8::StaticOrder, PG8_ALIGN, PG8_SP2>(F.lds + RING_OFF, g, S, E);
    }
    GRID_BAR();
    if (RUN(8)) {
        const int gw = F.vcu * NWAVES + F.wave, NGW = F.G * NWAVES; const float* g = args.in[15]; const float* bb = args.in[16];
        for (int row = gw; row < M; row += NGW) {
            const unsigned long long* xr_ = (const unsigned long long*)(XB + (size_t)row * D); const unsigned long long* yb = (const unsigned long long*)((const bf16*)Y1 + (size_t)row * D);
            f32x4 v[8]; float s = 0.f;
#pragma unroll
            for (int j = 0; j < 8; ++j) { const unsigned long long x_ = xr_[F.lane + 64 * j]; const unsigned x0 = (unsigned)x_, x1 = (unsigned)(x_ >> 32); const f32x4 xv_ = (f32x4){__uint_as_float(x0 << 16), __uint_as_float(x0 & 0xffff0000u), __uint_as_float(x1 << 16), __uint_as_float(x1 & 0xffff0000u)};
                const unsigned long long q_ = yb[F.lane + 64 * j]; const unsigned q0 = (unsigned)q_, q1 = (unsigned)(q_ >> 32);
                v[j].x = DN_ALPHA * xv_.x + __uint_as_float(q0 << 16); v[j].y = DN_ALPHA * xv_.y + __uint_as_float(q0 & 0xffff0000u); v[j].z = DN_ALPHA * xv_.z + __uint_as_float(q1 << 16); v[j].w = DN_ALPHA * xv_.w + __uint_as_float(q1 & 0xffff0000u);
                s += (v[j].x + v[j].y) + (v[j].z + v[j].w); }
#pragma unroll
            for (int o = 1; o < 64; o <<= 1) s += __shfl_xor(s, o);
            const float mean = s * (1.f / D); float s2 = 0.f;
#pragma unroll
            for (int j = 0; j < 8; ++j) { v[j] = v[j] - mean; s2 += (v[j].x * v[j].x + v[j].y * v[j].y) + (v[j].z * v[j].z + v[j].w * v[j].w); }
#pragma unroll
            for (int o = 1; o < 64; o <<= 1) s2 += __shfl_xor(s2, o);
            const float rstd = rsqrtf(s2 * (1.f / D) + LN_EPS);
#pragma unroll
            for (int j = 0; j < 8; ++j) { const int c = (F.lane + 64 * j) * 4; const f32x4 gg = *(const f32x4*)(g + c), bv = *(const f32x4*)(bb + c);
                const f32x4 o = v[j] * rstd * gg + bv;
                *(unsigned long long*)(H1 + (size_t)row * D + c) = (unsigned long long)pk2(o.x, o.y) | ((unsigned long long)pk2(o.z, o.w) << 32);
                v[j] = o; }
            float am = 0.f;
#pragma unroll
            for (int j = 0; j < 8; ++j) am = fmaxf(fmaxf(am, fmaxf(fabsf(v[j].x), fabsf(v[j].y))), fmaxf(fabsf(v[j].z), fabsf(v[j].w)));
#pragma unroll
            for (int o = 1; o < 64; o <<= 1) am = fmaxf(am, __shfl_xor(am, o));
            const float qs = am > 0.f ? 127.f / am : 0.f;
            if (F.lane == 0) ((float*)(ws + WS_SH))[row] = am * (1.f / 127.f);
#pragma unroll
            for (int j = 0; j < 8; ++j) { const int c = (F.lane + 64 * j) * 4;
                const unsigned q = ((unsigned)(int)rintf(v[j].x * qs) & 0xffu) | (((unsigned)(int)rintf(v[j].y * qs) & 0xffu) << 8) | (((unsigned)(int)rintf(v[j].z * qs) & 0xffu) << 16) | (((unsigned)(int)rintf(v[j].w * qs) & 0xffu) << 24);
                *(unsigned*)(ws + WS_H8 + ((size_t)(c >> 7) * M + row) * 128 + (c & 127)) = q; }
        }
    }
    GRID_BAR();
    if (RUN(9)) {
        pg8::Gemm g{H1, WQ_T, M, D, D}; pg8::StaticOrder S; S.init(M, D, F.G, (int)blockIdx.x);
        pg8::EpiBf16<0> E{(bf16*)PQ, D, nullptr, 0, 0, 1.f};
        pg8::gemm_phase<pg8::EpiBf16<0>, pg8::StaticOrder, PG8_ALIGN, PG8_SP2>(F.lds + RING_OFF, g, S, E);
    }
    GRID_BAR();
    if (RUN(10)) {
        const int nh = (F.G & 7) == 0 ? 8 : 1;
        int* E = (int*)(ws + WS_E); float* G = (float*)(ws + WS_G);
        for (int h = F.vcu % nh; h < 8; h += nh) {
            __syncthreads();
            {
                int tq = F.tid; asm volatile("" : "+v"(tq));
#pragma unroll 4
                for (int j = 0; j < 16; ++j) { const int i = tq + 512 * j, p = i >> 12, hl = (i >> 11) & 1, fl = i & 2047;
                    *(LAS v4u*)(F.lds + RING_OFF + (size_t)i * 16) = ((const v4u*)(ws + WS_SKH))[(size_t)hl * 65536 + (size_t)(h * 2 + p) * 2048 + fl]; }
            }
            __syncthreads();
            const int wv = (F.vcu / nh) * NWAVES + F.wave, nwv = ((F.G + nh - 1 - F.vcu % nh) / nh) * NWAVES;
            v4u qn[8];
#define ROUTE_LOADQ() do { _Pragma("unroll") for (int ds = 0; ds < 8; ++ds) qn[ds] = *(const v4u*)(qptr + 16 * ds); } while (0)
            const bf16* qptr = (const bf16*)PQ + (size_t)(wv * 32 + (F.lane & 31)) * D + h * 256 + 8 * (F.lane >> 5);
            if (wv < M / 32) ROUTE_LOADQ();
            for (int tg = wv; tg < M / 32; tg += nwv) { int ln_ = F.lane; asm volatile("" : "+v"(ln_));
                const int tl = ln_ & 31, hi = ln_ >> 5, tok = tg * 32 + tl;
                LAS unsigned char* scr = F.lds + RING_BYTES + 1024 + F.wave * 1024 + tl * 32;
                float sa[16], sb[16];
#pragma unroll
                for (int p = 0; p < 2; ++p) {
                    f32x16 sc[4];
#pragma unroll
                    for (int kt = 0; kt < 4; ++kt) sc[kt] = f32x16{};
#pragma unroll
                    for (int ds = 0; ds < 8; ++ds) { const bf16x8 qh = __builtin_bit_cast(bf16x8, qn[ds]);
#pragma unroll
                        for (int kt = 0; kt < 4; ++kt) { const bf16x8 ah = *(const LAS bf16x8*)(F.lds + RING_OFF + ((p * 2 + 0) * 32 + kt * 8 + ds) * 1024 + F.lane * 16), al = *(const LAS bf16x8*)(F.lds + RING_OFF + ((p * 2 + 1) * 32 + kt * 8 + ds) * 1024 + F.lane * 16);
                            sc[kt] = __builtin_amdgcn_mfma_f32_32x32x16_bf16(ah, qh, sc[kt], 0, 0, 0);
                            sc[kt] = __builtin_amdgcn_mfma_f32_32x32x16_bf16(al, qh, sc[kt], 0, 0, 0); } }
                    if (p == 0) { qptr += 128; ROUTE_LOADQ(); } else if (tg + nwv < M / 32) { qptr += (size_t)nwv * 32 * D - 128; ROUTE_LOADQ(); }
#pragma unroll
                    for (int kt = 0; kt < 4; ++kt)
#pragma unroll
                        for (int r = 0; r < 16; ++r) { const unsigned key = (unsigned)(kt * 32 + (r & 3) + 8 * (r >> 2) + 4 * hi); sc[kt][r] = __uint_as_float((__float_as_uint(sc[kt][r]) & ~127u) | (127u - key)); }
#define CE_(x, y) do { const float h_ = __builtin_fmaxf(x, y), l_ = __builtin_fminf(x, y); x = h_; y = l_; } while (0)
                    CE_(sc[0][0], sc[0][1]); CE_(sc[0][2], sc[0][3]); CE_(sc[0][0], sc[0][2]); CE_(sc[0][1], sc[0][3]); CE_(sc[0][1], sc[0][2]); CE_(sc[0][4], sc[0][5]); CE_(sc[0][6], sc[0][7]); CE_(sc[0][4], sc[0][6]); CE_(sc[0][5], sc[0][7]); CE_(sc[0][5], sc[0][6]); CE_(sc[0][0], sc[0][4]); CE_(sc[0][2], sc[0][6]); CE_(sc[0][2], sc[0][4]); CE_(sc[0][1], sc[0][5]); CE_(sc[0][3], sc[0][7]); CE_(sc[0][3], sc[0][5]); CE_(sc[0][1], sc[0][2]); CE_(sc[0][3], sc[0][4]); CE_(sc[0][5], sc[0][6]); CE_(sc[0][8], sc[0][9]); CE_(sc[0][10], sc[0][11]); CE_(sc[0][8], sc[0][10]); CE_(sc[0][9], sc[0][11]); CE_(sc[0][9], sc[0][10]); CE_(sc[0][12], sc[0][13]); CE_(sc[0][14], sc[0][15]); CE_(sc[0][12], sc[0][14]); CE_(sc[0][13], sc[0][15]); CE_(sc[0][13], sc[0][14]); CE_(sc[0][8], sc[0][12]); CE_(sc[0][10], sc[0][14]); CE_(sc[0][10], sc[0][12]); CE_(sc[0][9], sc[0][13]); CE_(sc[0][11], sc[0][15]); CE_(sc[0][11], sc[0][13]); CE_(sc[0][9], sc[0][10]); CE_(sc[0][11], sc[0][12]); CE_(sc[0][13], sc[0][14]); CE_(sc[0][0], sc[0][8]); CE_(sc[0][4], sc[0][12]); CE_(sc[0][4], sc[0][8]); CE_(sc[0][2], sc[0][10]); CE_(sc[0][6], sc[0][14]); CE_(sc[0][6], sc[0][10]); CE_(sc[0][2], sc[0][4]); CE_(sc[0][6], sc[0][8]); CE_(sc[0][10], sc[0][12]); CE_(sc[0][1], sc[0][9]); CE_(sc[0][5], sc[0][13]); CE_(sc[0][5], sc[0][9]); CE_(sc[0][3], sc[0][11]); CE_(sc[0][7], sc[0][15]); CE_(sc[0][7], sc[0][11]); CE_(sc[0][3], sc[0][5]); CE_(sc[0][7], sc[0][9]); CE_(sc[0][11], sc[0][13]); CE_(sc[0][1], sc[0][2]); CE_(sc[0][3], sc[0][4]); CE_(sc[0][5], sc[0][6]); CE_(sc[0][7], sc[0][8]); CE_(sc[0][9], sc[0][10]); CE_(sc[0][11], sc[0][12]); CE_(sc[0][13], sc[0][14]);
                    CE_(sc[1][0], sc[1][1]); CE_(sc[1][2], sc[1][3]); CE_(sc[1][0], sc[1][2]); CE_(sc[1][1], sc[1][3]); CE_(sc[1][1], sc[1][2]); CE_(sc[1][4], sc[1][5]); CE_(sc[1][6], sc[1][7]); CE_(sc[1][4], sc[1][6]); CE_(sc[1][5], sc[1][7]); CE_(sc[1][5], sc[1][6]); CE_(sc[1][0], sc[1][4]); CE_(sc[1][2], sc[1][6]); CE_(sc[1][2], sc[1][4]); CE_(sc[1][1], sc[1][5]); CE_(sc[1][3], sc[1][7]); CE_(sc[1][3], sc[1][5]); CE_(sc[1][1], sc[1][2]); CE_(sc[1][3], sc[1][4]); CE_(sc[1][5], sc[1][6]); CE_(sc[1][8], sc[1][9]); CE_(sc[1][10], sc[1][11]); CE_(sc[1][8], sc[1][10]); CE_(sc[1][9], sc[1][11]); CE_(sc[1][9], sc[1][10]); CE_(sc[1][12], sc[1][13]); CE_(sc[1][14], sc[1][15]); CE_(sc[1][12], sc[1][14]); CE_(sc[1][13], sc[1][15]); CE_(sc[1][13], sc[1][14]); CE_(sc[1][8], sc[1][12]); CE_(sc[1][10], sc[1][14]); CE_(sc[1][10], sc[1][12]); CE_(sc[1][9], sc[1][13]); CE_(sc[1][11], sc[1][15]); CE_(sc[1][11], sc[1][13]); CE_(sc[1][9], sc[1][10]); CE_(sc[1][11], sc[1][12]); CE_(sc[1][13], sc[1][14]); CE_(sc[1][0], sc[1][8]); CE_(sc[1][4], sc[1][12]); CE_(sc[1][4], sc[1][8]); CE_(sc[1][2], sc[1][10]); CE_(sc[1][6], sc[1][14]); CE_(sc[1][6], sc[1][10]); CE_(sc[1][2], sc[1][4]); CE_(sc[1][6], sc[1][8]); CE_(sc[1][10], sc[1][12]); CE_(sc[1][1], sc[1][9]); CE_(sc[1][5], sc[1][13]); CE_(sc[1][5], sc[1][9]); CE_(sc[1][3], sc[1][11]); CE_(sc[1][7], sc[1][15]); CE_(sc[1][7], sc[1][11]); CE_(sc[1][3], sc[1][5]); CE_(sc[1][7], sc[1][9]); CE_(sc[1][11], sc[1][13]); CE_(sc[1][1], sc[1][2]); CE_(sc[1][3], sc[1][4]); CE_(sc[1][5], sc[1][6]); CE_(sc[1][7], sc[1][8]); CE_(sc[1][9], sc[1][10]); CE_(sc[1][11], sc[1][12]); CE_(sc[1][13], sc[1][14]);
                    CE_(sc[2][0], sc[2][1]); CE_(sc[2][2], sc[2][3]); CE_(sc[2][0], sc[2][2]); CE_(sc[2][1], sc[2][3]); CE_(sc[2][1], sc[2][2]); CE_(sc[2][4], sc[2][5]); CE_(sc[2][6], sc[2][7]); CE_(sc[2][4], sc[2][6]); CE_(sc[2][5], sc[2][7]); CE_(sc[2][5], sc[2][6]); CE_(sc[2][0], sc[2][4]); CE_(sc[2][2], sc[2][6]); CE_(sc[2][2], sc[2][4]); CE_(sc[2][1], sc[2][5]); CE_(sc[2][3], sc[2][7]); CE_(sc[2][3], sc[2][5]); CE_(sc[2][1], sc[2][2]); CE_(sc[2][3], sc[2][4]); CE_(sc[2][5], sc[2][6]); CE_(sc[2][8], sc[2][9]); CE_(sc[2][10], sc[2][11]); CE_(sc[2][8], sc[2][10]); CE_(sc[2][9], sc[2][11]); CE_(sc[2][9], sc[2][10]); CE_(sc[2][12], sc[2][13]); CE_(sc[2][14], sc[2][15]); CE_(sc[2][12], sc[2][14]); CE_(sc[2][13], sc[2][15]); CE_(sc[2][13], sc[2][14]); CE_(sc[2][8], sc[2][12]); CE_(sc[2][10], sc[2][14]); CE_(sc[2][10], sc[2][12]); CE_(sc[2][9], sc[2][13]); CE_(sc[2][11], sc[2][15]); CE_(sc[2][11], sc[2][13]); CE_(sc[2][9], sc[2][10]); CE_(sc[2][11], sc[2][12]); CE_(sc[2][13], sc[2][14]); CE_(sc[2][0], sc[2][8]); CE_(sc[2][4], sc[2][12]); CE_(sc[2][4], sc[2][8]); CE_(sc[2][2], sc[2][10]); CE_(sc[2][6], sc[2][14]); CE_(sc[2][6], sc[2][10]); CE_(sc[2][2], sc[2][4]); CE_(sc[2][6], sc[2][8]); CE_(sc[2][10], sc[2][12]); CE_(sc[2][1], sc[2][9]); CE_(sc[2][5], sc[2][13]); CE_(sc[2][5], sc[2][9]); CE_(sc[2][3], sc[2][11]); CE_(sc[2][7], sc[2][15]); CE_(sc[2][7], sc[2][11]); CE_(sc[2][3], sc[2][5]); CE_(sc[2][7], sc[2][9]); CE_(sc[2][11], sc[2][13]); CE_(sc[2][1], sc[2][2]); CE_(sc[2][3], sc[2][4]); CE_(sc[2][5], sc[2][6]); CE_(sc[2][7], sc[2][8]); CE_(sc[2][9], sc[2][10]); CE_(sc[2][11], sc[2][12]); CE_(sc[2][13], sc[2][14]);
                    CE_(sc[3][0], sc[3][1]); CE_(sc[3][2], sc[3][3]); CE_(sc[3][0], sc[3][2]); CE_(sc[3][1], sc[3][3]); CE_(sc[3][1], sc[3][2]); CE_(sc[3][4], sc[3][5]); CE_(sc[3][6], sc[3][7]); CE_(sc[3][4], sc[3][6]); CE_(sc[3][5], sc[3][7]); CE_(sc[3][5], sc[3][6]); CE_(sc[3][0], sc[3][4]); CE_(sc[3][2], sc[3][6]); CE_(sc[3][2], sc[3][4]); CE_(sc[3][1], sc[3][5]); CE_(sc[3][3], sc[3][7]); CE_(sc[3][3], sc[3][5]); CE_(sc[3][1], sc[3][2]); CE_(sc[3][3], sc[3][4]); CE_(sc[3][5], sc[3][6]); CE_(sc[3][8], sc[3][9]); CE_(sc[3][10], sc[3][11]); CE_(sc[3][8], sc[3][10]); CE_(sc[3][9], sc[3][11]); CE_(sc[3][9], sc[3][10]); CE_(sc[3][12], sc[3][13]); CE_(sc[3][14], sc[3][15]); CE_(sc[3][12], sc[3][14]); CE_(sc[3][13], sc[3][15]); CE_(sc[3][13], sc[3][14]); CE_(sc[3][8], sc[3][12]); CE_(sc[3][10], sc[3][14]); CE_(sc[3][10], sc[3][12]); CE_(sc[3][9], sc[3][13]); CE_(sc[3][11], sc[3][15]); CE_(sc[3][11], sc[3][13]); CE_(sc[3][9], sc[3][10]); CE_(sc[3][11], sc[3][12]); CE_(sc[3][13], sc[3][14]); CE_(sc[3][0], sc[3][8]); CE_(sc[3][4], sc[3][12]); CE_(sc[3][4], sc[3][8]); CE_(sc[3][2], sc[3][10]); CE_(sc[3][6], sc[3][14]); CE_(sc[3][6], sc[3][10]); CE_(sc[3][2], sc[3][4]); CE_(sc[3][6], sc[3][8]); CE_(sc[3][10], sc[3][12]); CE_(sc[3][1], sc[3][9]); CE_(sc[3][5], sc[3][13]); CE_(sc[3][5], sc[3][9]); CE_(sc[3][3], sc[3][11]); CE_(sc[3][7], sc[3][15]); CE_(sc[3][7], sc[3][11]); CE_(sc[3][3], sc[3][5]); CE_(sc[3][7], sc[3][9]); CE_(sc[3][11], sc[3][13]); CE_(sc[3][1], sc[3][2]); CE_(sc[3][3], sc[3][4]); CE_(sc[3][5], sc[3][6]); CE_(sc[3][7], sc[3][8]); CE_(sc[3][9], sc[3][10]); CE_(sc[3][11], sc[3][12]); CE_(sc[3][13], sc[3][14]);
                    sc[0][0] = __builtin_fmaxf(sc[0][0], sc[1][15]); sc[0][1] = __builtin_fmaxf(sc[0][1], sc[1][14]); sc[0][2] = __builtin_fmaxf(sc[0][2], sc[1][13]); sc[0][3] = __builtin_fmaxf(sc[0][3], sc[1][12]); sc[0][4] = __builtin_fmaxf(sc[0][4], sc[1][11]); sc[0][5] = __builtin_fmaxf(sc[0][5], sc[1][10]); sc[0][6] = __builtin_fmaxf(sc[0][6], sc[1][9]); sc[0][7] = __builtin_fmaxf(sc[0][7], sc[1][8]); sc[0][8] = __builtin_fmaxf(sc[0][8], sc[1][7]); sc[0][9] = __builtin_fmaxf(sc[0][9], sc[1][6]); sc[0][10] = __builtin_fmaxf(sc[0][10], sc[1][5]); sc[0][11] = __builtin_fmaxf(sc[0][11], sc[1][4]); sc[0][12] = __builtin_fmaxf(sc[0][12], sc[1][3]); sc[0][13] = __builtin_fmaxf(sc[0][13], sc[1][2]); sc[0][14] = __builtin_fmaxf(sc[0][14], sc[1][1]); sc[0][15] = __builtin_fmaxf(sc[0][15], sc[1][0]);
                    CE_(sc[0][0], sc[0][8]); CE_(sc[0][1], sc[0][9]); CE_(sc[0][2], sc[0][10]); CE_(sc[0][3], sc[0][11]); CE_(sc[0][4], sc[0][12]); CE_(sc[0][5], sc[0][13]); CE_(sc[0][6], sc[0][14]); CE_(sc[0][7], sc[0][15]); CE_(sc[0][0], sc[0][4]); CE_(sc[0][1], sc[0][5]); CE_(sc[0][2], sc[0][6]); CE_(sc[0][3], sc[0][7]); CE_(sc[0][8], sc[0][12]); CE_(sc[0][9], sc[0][13]); CE_(sc[0][10], sc[0][14]); CE_(sc[0][11], sc[0][15]); CE_(sc[0][0], sc[0][2]); CE_(sc[0][1], sc[0][3]); CE_(sc[0][4], sc[0][6]); CE_(sc[0][5], sc[0][7]); CE_(sc[0][8], sc[0][10]); CE_(sc[0][9], sc[0][11]); CE_(sc[0][12], sc[0][14]); CE_(sc[0][13], sc[0][15]); CE_(sc[0][0], sc[0][1]); CE_(sc[0][2], sc[0][3]); CE_(sc[0][4], sc[0][5]); CE_(sc[0][6], sc[0][7]); CE_(sc[0][8], sc[0][9]); CE_(sc[0][10], sc[0][11]); CE_(sc[0][12], sc[0][13]); CE_(sc[0][14], sc[0][15]);
                    sc[2][0] = __builtin_fmaxf(sc[2][0], sc[3][15]); sc[2][1] = __builtin_fmaxf(sc[2][1], sc[3][14]); sc[2][2] = __builtin_fmaxf(sc[2][2], sc[3][13]); sc[2][3] = __builtin_fmaxf(sc[2][3], sc[3][12]); sc[2][4] = __builtin_fmaxf(sc[2][4], sc[3][11]); sc[2][5] = __builtin_fmaxf(sc[2][5], sc[3][10]); sc[2][6] = __builtin_fmaxf(sc[2][6], sc[3][9]); sc[2][7] = __builtin_fmaxf(sc[2][7], sc[3][8]); sc[2][8] = __builtin_fmaxf(sc[2][8], sc[3][7]); sc[2][9] = __builtin_fmaxf(sc[2][9], sc[3][6]); sc[2][10] = __builtin_fmaxf(sc[2][10], sc[3][5]); sc[2][11] = __builtin_fmaxf(sc[2][11], sc[3][4]); sc[2][12] = __builtin_fmaxf(sc[2][12], sc[3][3]); sc[2][13] = __builtin_fmaxf(sc[2][13], sc[3][2]); sc[2][14] = __builtin_fmaxf(sc[2][14], sc[3][1]); sc[2][15] = __builtin_fmaxf(sc[2][15], sc[3][0]);
                    CE_(sc[2][0], sc[2][8]); CE_(sc[2][1], sc[2][9]); CE_(sc[2][2], sc[2][10]); CE_(sc[2][3], sc[2][11]); CE_(sc[2][4], sc[2][12]); CE_(sc[2][5], sc[2][13]); CE_(sc[2][6], sc[2][14]); CE_(sc[2][7], sc[2][15]); CE_(sc[2][0], sc[2][4]); CE_(sc[2][1], sc[2][5]); CE_(sc[2][2], sc[2][6]); CE_(sc[2][3], sc[2][7]); CE_(sc[2][8], sc[2][12]); CE_(sc[2][9], sc[2][13]); CE_(sc[2][10], sc[2][14]); CE_(sc[2][11], sc[2][15]); CE_(sc[2][0], sc[2][2]); CE_(sc[2][1], sc[2][3]); CE_(sc[2][4], sc[2][6]); CE_(sc[2][5], sc[2][7]); CE_(sc[2][8], sc[2][10]); CE_(sc[2][9], sc[2][11]); CE_(sc[2][12], sc[2][14]); CE_(sc[2][13], sc[2][15]); CE_(sc[2][0], sc[2][1]); CE_(sc[2][2], sc[2][3]); CE_(sc[2][4], sc[2][5]); CE_(sc[2][6], sc[2][7]); CE_(sc[2][8], sc[2][9]); CE_(sc[2][10], sc[2][11]); CE_(sc[2][12], sc[2][13]); CE_(sc[2][14], sc[2][15]);
                    sc[0][0] = __builtin_fmaxf(sc[0][0], sc[2][15]); sc[0][1] = __builtin_fmaxf(sc[0][1], sc[2][14]); sc[0][2] = __builtin_fmaxf(sc[0][2], sc[2][13]); sc[0][3] = __builtin_fmaxf(sc[0][3], sc[2][12]); sc[0][4] = __builtin_fmaxf(sc[0][4], sc[2][11]); sc[0][5] = __builtin_fmaxf(sc[0][5], sc[2][10]); sc[0][6] = __builtin_fmaxf(sc[0][6], sc[2][9]); sc[0][7] = __builtin_fmaxf(sc[0][7], sc[2][8]); sc[0][8] = __builtin_fmaxf(sc[0][8], sc[2][7]); sc[0][9] = __builtin_fmaxf(sc[0][9], sc[2][6]); sc[0][10] = __builtin_fmaxf(sc[0][10], sc[2][5]); sc[0][11] = __builtin_fmaxf(sc[0][11], sc[2][4]); sc[0][12] = __builtin_fmaxf(sc[0][12], sc[2][3]); sc[0][13] = __builtin_fmaxf(sc[0][13], sc[2][2]); sc[0][14] = __builtin_fmaxf(sc[0][14], sc[2][1]); sc[0][15] = __builtin_fmaxf(sc[0][15], sc[2][0]);
                    CE_(sc[0][0], sc[0][8]); CE_(sc[0][1], sc[0][9]); CE_(sc[0][2], sc[0][10]); CE_(sc[0][3], sc[0][11]); CE_(sc[0][4], sc[0][12]); CE_(sc[0][5], sc[0][13]); CE_(sc[0][6], sc[0][14]); CE_(sc[0][7], sc[0][15]); CE_(sc[0][0], sc[0][4]); CE_(sc[0][1], sc[0][5]); CE_(sc[0][2], sc[0][6]); CE_(sc[0][3], sc[0][7]); CE_(sc[0][8], sc[0][12]); CE_(sc[0][9], sc[0][13]); CE_(sc[0][10], sc[0][14]); CE_(sc[0][11], sc[0][15]); CE_(sc[0][0], sc[0][2]); CE_(sc[0][1], sc[0][3]); CE_(sc[0][4], sc[0][6]); CE_(sc[0][5], sc[0][7]); CE_(sc[0][8], sc[0][10]); CE_(sc[0][9], sc[0][11]); CE_(sc[0][12], sc[0][14]); CE_(sc[0][13], sc[0][15]); CE_(sc[0][0], sc[0][1]); CE_(sc[0][2], sc[0][3]); CE_(sc[0][4], sc[0][5]); CE_(sc[0][6], sc[0][7]); CE_(sc[0][8], sc[0][9]); CE_(sc[0][10], sc[0][11]); CE_(sc[0][12], sc[0][13]); CE_(sc[0][14], sc[0][15]);
                    { float la[16], lb[16];
#pragma unroll
                      for (int i = 0; i < 16; ++i) { auto rr = __builtin_amdgcn_permlane32_swap(__float_as_uint(sc[0][i]), __float_as_uint(sc[0][i]), false, false); la[i] = __uint_as_float(rr[0]); lb[i] = __uint_as_float(rr[1]); }
#pragma unroll
                      for (int i = 0; i < 16; ++i) la[i] = __builtin_fmaxf(la[i], lb[15 - i]);
                      CE_(la[0], la[8]); CE_(la[1], la[9]); CE_(la[2], la[10]); CE_(la[3], la[11]); CE_(la[4], la[12]); CE_(la[5], la[13]); CE_(la[6], la[14]); CE_(la[7], la[15]); CE_(la[0], la[4]); CE_(la[1], la[5]); CE_(la[2], la[6]); CE_(la[3], la[7]); CE_(la[8], la[12]); CE_(la[9], la[13]); CE_(la[10], la[14]); CE_(la[11], la[15]); CE_(la[0], la[2]); CE_(la[1], la[3]); CE_(la[4], la[6]); CE_(la[5], la[7]); CE_(la[8], la[10]); CE_(la[9], la[11]); CE_(la[12], la[14]); CE_(la[13], la[15]); CE_(la[0], la[1]); CE_(la[2], la[3]); CE_(la[4], la[5]); CE_(la[6], la[7]); CE_(la[8], la[9]); CE_(la[10], la[11]); CE_(la[12], la[13]); CE_(la[14], la[15]);
#pragma unroll
                      for (int i = 0; i < 16; ++i) { if (p == 0) sa[i] = la[i]; else sb[i] = la[i]; } }
#undef CE_
                }
                { unsigned w[4];
    #pragma unroll
                  for (int q = 0; q < 4; ++q) { w[q] = 0u;
    #pragma unroll
                      for (int e = 0; e < 4; ++e) { const unsigned ka = 127u - (__float_as_uint(sa[4 * q + e]) & 127u), kb = 127u - (__float_as_uint(sb[4 * q + e]) & 127u); w[q] |= (hi ? kb : ka) << (8 * e); } }
                  *(LAS v4u*)(scr + 16 * hi) = (v4u){w[0], w[1], w[2], w[3]}; }
                float cd[25];
    #define CV_(i, j) __uint_as_float((__float_as_uint(sa[i] + sb[j]) & ~255u) | (255u - (unsigned)(16 * (i) + (j))))
                cd[0] = hi ? CV_(0, 1) : CV_(0, 0);
                cd[1] = hi ? CV_(0, 3) : CV_(0, 2);
                cd[2] = hi ? CV_(0, 5) : CV_(0, 4);
                cd[3] = hi ? CV_(0, 7) : CV_(0, 6);
                cd[4] = hi ? CV_(0, 9) : CV_(0, 8);
                cd[5] = hi ? CV_(0, 11) : CV_(0, 10);
                cd[6] = hi ? CV_(0, 13) : CV_(0, 12);
                cd[7] = hi ? CV_(0, 15) : CV_(0, 14);
                cd[8] = hi ? CV_(1, 1) : CV_(1, 0);
                cd[9] = hi ? CV_(1, 3) : CV_(1, 2);
                cd[10] = hi ? CV_(1, 5) : CV_(1, 4);
                cd[11] = hi ? CV_(1, 7) : CV_(1, 6);
                cd[12] = hi ? CV_(2, 1) : CV_(2, 0);
                cd[13] = hi ? CV_(2, 3) : CV_(2, 2);
                cd[14] = hi ? CV_(3, 0) : CV_(2, 4);
                cd[15] = hi ? CV_(3, 2) : CV_(3, 1);
                cd[16] = hi ? CV_(4, 0) : CV_(3, 3);
                cd[17] = hi ? CV_(4, 2) : CV_(4, 1);
                cd[18] = hi ? CV_(5, 1) : CV_(5, 0);
                cd[19] = hi ? CV_(6, 1) : CV_(6, 0);
                cd[20] = hi ? CV_(7, 1) : CV_(7, 0);
                cd[21] = hi ? CV_(9, 0) : CV_(8, 0);
                cd[22] = hi ? CV_(11, 0) : CV_(10, 0);
                cd[23] = hi ? CV_(13, 0) : CV_(12, 0);
                cd[24] = hi ? CV_(15, 0) : CV_(14, 0);
    #undef CV_
                float top[16];
    #pragma unroll
                for (int rd = 0; rd < 16; ++rd) {
                    float m = cd[0];
    #pragma unroll
                    for (int n = 1; n + 1 < 25; n += 2) m = max3f_(m, cd[n], cd[n + 1]);
                    const float gm = pair_max(m); top[rd] = gm;
    #pragma unroll
                    for (int n = 0; n < 25; ++n) cd[n] = (__float_as_uint(cd[n]) == __float_as_uint(gm)) ? -INFINITY : cd[n];
                }
                float ex[16], sum = 0.f;
    #pragma unroll
                for (int r = 0; r < 16; ++r) { ex[r] = __builtin_amdgcn_exp2f((top[r] - top[0]) * LOG2E); sum += ex[r]; }
                const float inv = 1.f / sum;
                asm volatile("s_waitcnt lgkmcnt(0)" ::: "memory");
                int eo[8]; float go[8];
    #pragma unroll
                for (int rr = 0; rr < 8; ++rr) { float t0 = top[rr], t1 = top[rr + 8], e0 = ex[rr], e1 = ex[rr + 8]; asm volatile("" : "+v"(t0), "+v"(t1), "+v"(e0), "+v"(e1));
                    const unsigned f = 255u - (__float_as_uint(hi ? t1 : t0) & 255u);
                    const int ia = scr[f >> 4], ib = scr[16 + (f & 15)]; eo[rr] = ia * 128 + ib; go[rr] = (hi ? e1 : e0) * inv; }
                int* ep = E + (size_t)tok * 128 + h * 16 + 8 * hi; float* gp = G + (size_t)tok * 128 + h * 16 + 8 * hi;
                *(v4u*)ep = (v4u){(unsigned)eo[0], (unsigned)eo[1], (unsigned)eo[2], (unsigned)eo[3]}; *(v4u*)(ep + 4) = (v4u){(unsigned)eo[4], (unsigned)eo[5], (unsigned)eo[6], (unsigned)eo[7]};
                *(f32x4*)gp = (f32x4){go[0], go[1], go[2], go[3]}; *(f32x4*)(gp + 4) = (f32x4){go[4], go[5], go[6], go[7]};
                asm volatile("s_waitcnt lgkmcnt(0)" ::: "memory");
            }
        }
#undef ROUTE_LOADQ
    }
    GRID_BAR();
    if (RUN(11)) {
        const int nlab = F.G < 8 ? F.G : 8, label = (int)blockIdx.x % nlab, nblk = (F.G - label + nlab - 1) / nlab, wx = ((int)blockIdx.x / nlab) * NWAVES + F.wave, nwx = nblk * NWAVES;
        const int lane = F.lane, rr = lane >> 3, cc = lane & 7;
        const int* E = (const int*)(ws + WS_E);
        for (int sl = label; sl < 16; sl += nlab) {
            const unsigned char* Us = ws + WS_U8 + (size_t)sl * 16384 * 128 + 16 * cc;
            const unsigned char* Hs = ws + WS_H8 + (size_t)sl * M * 128 + 16 * cc;
            for (int item = wx; item < M / 8; item += nwx) { const int tok = item * 8 + rr;
                const v4u hq = *(const v4u*)(Hs + (size_t)tok * 128);
                const v4u* ep = (const v4u*)(E + (size_t)tok * 128);
                int res[16];
#pragma unroll
                for (int i = 0; i < 16; ++i) res[i] = 0;
#pragma unroll
                for (int i = 0; i < 16; ++i) {
                    const v4u e0 = ep[2 * i], e1 = ep[2 * i + 1];
#pragma unroll
                    for (int j = 0; j < 8; ++j) { const unsigned e = j < 4 ? e0[j & 3] : e1[j & 3];
                        const v4u a = *(const v4u*)(Us + (size_t)e * 128);
                        int d = __builtin_amdgcn_sdot4((int)a.x, (int)hq.x, 0, false); d = __builtin_amdgcn_sdot4((int)a.y, (int)hq.y, d, false); d = __builtin_amdgcn_sdot4((int)a.z, (int)hq.z, d, false); d = __builtin_amdgcn_sdot4((int)a.w, (int)hq.w, d, false);
                        d += __builtin_amdgcn_update_dpp(0, d, 0xB1, 0xf, 0xf, true); d += __builtin_amdgcn_update_dpp(0, d, 0x4E, 0xf, 0xf, true); d += __builtin_amdgcn_update_dpp(0, d, 0x141, 0xf, 0xf, true);
                        res[i] = (cc == j) ? d : res[i]; } }
                v4u* po = (v4u*)((short*)(ws + WS_PART) + (size_t)sl * M * 128 + (size_t)tok * 128 + cc * 16);
                unsigned pw[8];
#pragma unroll
                for (int q = 0; q < 8; ++q) pw[q] = ((unsigned)((res[2 * q] + 32) >> 6) & 0xffffu) | ((unsigned)((res[2 * q + 1] + 32) >> 6) << 16);
                po[0] = (v4u){pw[0], pw[1], pw[2], pw[3]}; po[1] = (v4u){pw[4], pw[5], pw[6], pw[7]};
            }
        }
    }
    GRID_BAR();
    if (RUN(12)) {
        const short* P = (const short*)(ws + WS_PART); const int* E = (const int*)(ws + WS_E); const float* G = (const float*)(ws + WS_G); unsigned* PK = (unsigned*)(ws + WS_PK);
        const float* SU = (const float*)(ws + WS_SU); const float* SH = (const float*)(ws + WS_SH);
        for (int idx = F.vcu * 512 + F.tid; idx < M * 128; idx += F.G * 512) { const int tok = idx >> 7, k = idx & 127; const size_t pi = (size_t)tok * 128 + (k & 7) * 16 + (k >> 3); int hsum = 0;
#pragma unroll
            for (int sl = 0; sl < 16; ++sl) hsum += (int)P[(size_t)sl * M * 128 + pi];
            const int e = E[idx];
            const float w = G[idx] * gelu_tanh((float)hsum * 64.f * SU[e] * SH[tok]);
            PK[(size_t)(tok >> 6) * 8192 + (k >> 2) * 256 + (tok & 63) * 4 + (k & 3)] = (unsigned)e | (f2bf(w) << 16); }
    }
    GRID_BAR();
    if (RUN(13)) {
        const unsigned* PK = (const unsigned*)(ws + WS_PK); bf16* FFN = (bf16*)(ws + WS_FFN);
        for (int c = F.vcu; c < 256; c += F.G) {
            __syncthreads();
            { int tq = F.tid; asm volatile("" : "+v"(tq)); const v4u* src = (const v4u*)(ws + WS_V8 + (size_t)c * 131072) + tq;
#pragma unroll 4
              for (int j = 0; j < 16; ++j) *(LAS v4u*)(F.lds + RING_OFF + (tq + 512 * j) * 16) = src[512 * j]; }
            __syncthreads();
            for (int tb = F.wave; tb < M / 64; tb += NWAVES) { int ln_ = F.lane; asm volatile("" : "+v"(ln_));
                const v4u* pk = (const v4u*)(PK + (size_t)tb * 8192) + ln_;
                f32x2v av[4];
#pragma unroll
                for (int i = 0; i < 4; ++i) av[i] = (f32x2v){0.f, 0.f};
                v4u pb[32];
#pragma unroll
                for (int kq = 0; kq < 32; ++kq) pb[kq] = pk[kq * 64];
#pragma unroll
                for (int kq = 0; kq < 32; ++kq) { const v4u p4 = pb[kq];
#pragma unroll
                    for (int j = 0; j < 4; ++j) { const unsigned p = p4[j]; const float w = __uint_as_float(p & 0xffff0000u); const f32x2v ww = (f32x2v){w, w};
                        const unsigned long long d = *(const LAS unsigned long long*)(F.lds + RING_OFF + ((p & 0xffffu) << 3));
                        const int d0 = (int)(unsigned)d, d1 = (int)(unsigned)(d >> 32);
                        av[0] = av[0] + __builtin_amdgcn_cvt_pk_f32_fp8(d0, false) * ww; av[1] = av[1] + __builtin_amdgcn_cvt_pk_f32_fp8(d0, true) * ww;
                        av[2] = av[2] + __builtin_amdgcn_cvt_pk_f32_fp8(d1, false) * ww; av[3] = av[3] + __builtin_amdgcn_cvt_pk_f32_fp8(d1, true) * ww; } }
                *(v4u*)(FFN + (size_t)(tb * 64 + ln_) * D + 8 * c) = (v4u){pk2(av[0].x, av[0].y), pk2(av[1].x, av[1].y), pk2(av[2].x, av[2].y), pk2(av[3].x, av[3].y)};
            }
        }
        __syncthreads();
    }
    GRID_BAR();
    if (RUN(14)) {
        const int gw = F.vcu * NWAVES + F.wave, NGW = F.G * NWAVES, lane = F.lane; const float* g2 = args.in[21]; const float* b2 = args.in[22]; float* out = args.out; const bf16* FFN = (const bf16*)(ws + WS_FFN);
        for (int row = gw; row < M; row += NGW) {
            f32x4 v[8]; float sm = 0.f;
#pragma unroll
            for (int j = 0; j < 8; ++j) { const int c = (lane + 64 * j) * 4; const unsigned long long hq = *(const unsigned long long*)(H1 + (size_t)row * D + c), fq = *(const unsigned long long*)(FFN + (size_t)row * D + c);
                const unsigned h0 = (unsigned)hq, h1_ = (unsigned)(hq >> 32), f0 = (unsigned)fq, f1 = (unsigned)(fq >> 32);
                v[j].x = DN_ALPHA * __uint_as_float(h0 << 16) + __uint_as_float(f0 << 16); v[j].y = DN_ALPHA * __uint_as_float(h0 & 0xffff0000u) + __uint_as_float(f0 & 0xffff0000u);
                v[j].z = DN_ALPHA * __uint_as_float(h1_ << 16) + __uint_as_float(f1 << 16); v[j].w = DN_ALPHA * __uint_as_float(h1_ & 0xffff0000u) + __uint_as_float(f1 & 0xffff0000u);
                sm += (v[j].x + v[j].y) + (v[j].z + v[j].w); }
#pragma unroll
            for (int o = 1; o < 64; o <<= 1) sm += __shfl_xor(sm, o);
            const float mean = sm * (1.f / D); float s2 = 0.f;
#pragma unroll
            for (int j = 0; j < 8; ++j) { v[j] = v[j] - mean; s2 += (v[j].x * v[j].x + v[j].y * v[j].y) + (v[j].z * v[j].z + v[j].w * v[j].w); }
#pragma unroll
            for (int o = 1; o < 64; o <<= 1) s2 += __shfl_xor(s2, o);
            const float rstd = rsqrtf(s2 * (1.f / D) + LN_EPS);
#pragma unroll
            for (int j = 0; j < 8; ++j) { const int c = (lane + 64 * j) * 4; *(f32x4*)(out + (size_t)row * D + c) = v[j] * rstd * *(const f32x4*)(g2 + c) + *(const f32x4*)(b2 + c); }
        }
    }
#undef IN
#undef RUN
#undef GRID_BAR
}

extern "C" void kernel_launch(void* const* d_in, const int* in_sizes, int n_in, void* d_out, int out_size, void* d_ws, size_t ws_size, hipStream_t stream) {
    static int grid = 0;
    if (grid == 0) {
        if (n_in != 23 || in_sizes[0] != M * D || out_size != M * D || ws_size < WS_END) { fprintf(stderr, "kernel_launch: unexpected shapes n_in %d in0 %d out %d ws %zu\n", n_in, n_in > 0 ? in_sizes[0] : -1, out_size, ws_size); grid = -1; return; }
        int dev = 0, cus = 0;
        if (hipGetDevice(&dev) != hipSuccess || hipDeviceGetAttribute(&cus, hipDeviceAttributeMultiprocessorCount, dev) != hipSuccess) { grid = -1; return; }
        if (hipFuncSetAttribute((const void*)skel_fwd, hipFuncAttributeMaxDynamicSharedMemorySize, LDS_BYTES) != hipSuccess) { grid = -1; return; }
        grid = cus;
    }
    if (grid < 0) return;
    (void)hipMemsetAsync((char*)d_ws + WS_CTL, 0, CTL_ZERO_BYTES, stream);
    Args a{};
    for (int i = 0; i < 23; ++i) a.in[i] = (const float*)d_in[i];
    a.out = (float*)d_out; a.ws = (unsigned char*)d_ws;
    unsigned char* ws = (unsigned char*)d_ws;
    const float* const* in = (const float* const*)d_in;
    float* prm = (float*)(ws + WS_PRM);
    bf16 *Q = (bf16*)(ws + WS_Q), *K = (bf16*)(ws + WS_K), *V = (bf16*)(ws + WS_V), *XR = (bf16*)(ws + WS_XR), *XG = (bf16*)(ws + WS_XG), *MIX = (bf16*)(ws + WS_MIX), *H1 = (bf16*)(ws + WS_H1);
    float *LA = (float*)(ws + WS_LA), *LB = (float*)(ws + WS_LB), *Y1 = (float*)(ws + WS_Y1), *PQ = (float*)(ws + WS_PQ), *G = (float*)(ws + WS_G); int* E = (int*)(ws + WS_E);
#ifndef MK_MULTI
    a.ph_lo = -1; a.ph_hi = 0; hipLaunchKernelGGL(skel_fwd, dim3(grid), dim3(NWAVES * 64), LDS_BYTES, stream, a);
#else
    for (int sl = 0; sl < 15; ++sl) { a.ph_lo = 1 << sl; a.ph_hi = 0; hipLaunchKernelGGL(skel_fwd, dim3(grid), dim3(NWAVES * 64), LDS_BYTES, stream, a); }
#endif
}
```

```cpp
#include <hip/hip_runtime.h>
#include <cstdio>
#include <cstdint>
namespace pg8 {
#define PG8_LAS __attribute__((address_space(3)))
typedef unsigned short bf16_t;
typedef short bf16x8 __attribute__((ext_vector_type(8)));
typedef float f32x4 __attribute__((ext_vector_type(4)));
typedef unsigned u32x4 __attribute__((ext_vector_type(4)));
constexpr int BM = 256, BK = 64, HALF = 128, HTB = HALF * BK * 2  , STAGE_BYTES = 8 * HTB, NXCD = 8, WGM = 8;

__host__ __device__ __forceinline__ int lds_byte(int r, int c) { const int st = (r >> 4) * 2 + (c >> 5), rr = r & 15, cc = c & 31, ob = rr * 64 + cc * 2; return st * 1024 + (ob ^ (((ob >> 9) & 1) << 5)); }
__host__ __device__ __forceinline__ void stage_rc(int b, int& R, int& C) { const int st = b / 1024, sb = b % 1024, swz = sb ^ (((sb >> 9) & 1) << 5); R = (st >> 1) * 16 + swz / 64; C = (st & 1) * 32 + (swz % 64) / 2; }
__host__ __device__ __forceinline__ int perm32(int rho) { const int n = rho >> 4, i = rho & 15; return 8 * (i >> 2) + 4 * n + (i & 3); }

struct Unit { int pm, pn; };
struct Gemm { const bf16_t* A; const bf16_t* Bt; int M, N, K; };

struct StaticOrder {
    int nM, nN, nwg, G, c;
    __host__ __device__ void init(int M, int N, int G_, int c_) { nM = M / BM; nN = N / BM; nwg = nM * nN; G = G_; c = c_; }
    __host__ __device__ bool next(int i, Unit& u) const {
        const long L = (long)i * G + c; if (L >= nwg) return false;
        int wgid = (int)L; { const int q = nwg / NXCD, r = nwg % NXCD, xcd = wgid % NXCD, off = wgid / NXCD; wgid = (xcd < r ? xcd * (q + 1) : r * (q + 1) + (xcd - r) * q) + off; }
        const int nig = WGM * nN, gid = wgid / nig, fm = gid * WGM, gsz = (nM - fm) < WGM ? (nM - fm) : WGM;
        u.pm = fm + ((wgid % nig) % gsz); u.pn = (wgid % nig) / gsz; return true;
    }
    __device__ __forceinline__ void a_ready(const Unit&) const {}
    __device__ __forceinline__ void done(const Unit&) const {}
};

__device__ __forceinline__ unsigned cvt_pk_bf16(float lo, float hi) { unsigned r; asm volatile("v_cvt_pk_bf16_f32 %0, %1, %2" : "=v"(r) : "v"(lo), "v"(hi)); return r; }
typedef float f32x2 __attribute__((ext_vector_type(2)));
__device__ __forceinline__ f32x2 gelu_pk(f32x2 v) {
    const f32x2 av = __builtin_elementwise_abs(v), d = av * 0.2316418882f + 1.0f;
    f32x2 t; t.x = __builtin_amdgcn_rcpf(d.x); t.y = __builtin_amdgcn_rcpf(d.y);
    f32x2 q = t * 0.5307027145f + (-0.7265760135f); q = q * t + 0.7107068705f; q = q * t + (-0.142248368f); q = q * t + 0.127414796f; q = q * t;
    const f32x2 s = (v * v) * (-0.72134752044f);
    f32x2 e; e.x = __builtin_amdgcn_exp2f(s.x); e.y = __builtin_amdgcn_exp2f(s.y);
    const f32x2 m = v * (q * e), r = v - m;
    f32x2 o; o.x = v.x < 0.f ? m.x : r.x; o.y = v.y < 0.f ? m.y : r.y; return o;
}

template <int ACT  > struct EpiBf16 {
    static constexpr bool PERM = true, AFTER_DRAIN = false; static_assert(ACT == 0 || ACT == 1, "EpiBf16: ACT is 0 (none) or 1 (gelu_pk)");
    bf16_t* O; int ldc; const float* bias; int split_cols; size_t split_stride; float scale0;
    __device__ __forceinline__ void operator()(const f32x4 (&acc)[2][2][4][2], const Unit& u, int wr, int wc, int fr, int fq) const {
        const int row0 = u.pm * BM + wr * 64 + fr; int colt = u.pn * BM; bf16_t* base = O;
        float sc = 1.f; if (split_cols) { const int t = colt / split_cols; base += (size_t)t * split_stride; colt -= t * split_cols; if (t == 0) sc = scale0; }
        const int col0 = colt + wc * 32 + 8 * fq, bcol0 = u.pn * BM + wc * 32 + 8 * fq;
        f32x4 bv[2][2];
#pragma unroll
        for (int bj = 0; bj < 2; ++bj)
#pragma unroll
            for (int n = 0; n < 2; ++n) bv[bj][n] = bias ? *(const f32x4*)(bias + bcol0 + bj * HALF + 4 * n) : (f32x4){0.f, 0.f, 0.f, 0.f};
#pragma unroll
        for (int ai = 0; ai < 2; ++ai)
#pragma unroll
            for (int m = 0; m < 4; ++m) { bf16_t* rowp = base + (size_t)(row0 + ai * HALF + m * 16) * ldc + col0;
#pragma unroll
                for (int bj = 0; bj < 2; ++bj) { f32x4 v0 = acc[ai][bj][m][0] + bv[bj][0], v1 = acc[ai][bj][m][1] + bv[bj][1];
                    if (ACT == 1) { f32x2 a = gelu_pk((f32x2){v0[0], v0[1]}), b = gelu_pk((f32x2){v0[2], v0[3]}), c = gelu_pk((f32x2){v1[0], v1[1]}), d = gelu_pk((f32x2){v1[2], v1[3]});
                        v0 = (f32x4){a.x, a.y, b.x, b.y}; v1 = (f32x4){c.x, c.y, d.x, d.y}; }
                    v0 = v0 * sc; v1 = v1 * sc; u32x4 w; w.x = cvt_pk_bf16(v0[0], v0[1]); w.y = cvt_pk_bf16(v0[2], v0[3]); w.z = cvt_pk_bf16(v1[0], v1[1]); w.w = cvt_pk_bf16(v1[2], v1[3]);
                    *(u32x4*)(rowp + bj * HALF) = w; } }
    }
};

struct PanelStats {
    unsigned* xbuf;
    unsigned* cnt;
    unsigned* tmo;
    int ntn; float eps;
    unsigned code;
    __device__ __forceinline__ bool run(const f32x4 (&v)[2][2][4][2], const Unit& u, int wr, int wc, int fr, int fq, PG8_LAS unsigned char* lds, int wid, int lane) const {
        typedef float f32x2v __attribute__((ext_vector_type(2)));
        PG8_LAS f32x2v* P = (PG8_LAS f32x2v*)lds;
        PG8_LAS f32x2v* S = (PG8_LAS f32x2v*)(lds + 8192);
        PG8_LAS unsigned* flag = (PG8_LAS unsigned*)(lds + 8192 + 2048);
#pragma unroll
        for (int ai = 0; ai < 2; ++ai)
#pragma unroll
            for (int m = 0; m < 4; ++m) {
                float s = 0.f;
#pragma unroll
                for (int bj = 0; bj < 2; ++bj)
#pragma unroll
                    for (int n = 0; n < 2; ++n) { const f32x4 x = v[ai][bj][m][n]; s += (x[0] + x[1]) + (x[2] + x[3]); }
                s += __shfl_xor(s, 16); s += __shfl_xor(s, 32);
                const float mw = s * (1.0f / 64.0f); float q = 0.f;
#pragma unroll
                for (int bj = 0; bj < 2; ++bj)
#pragma unroll
                    for (int n = 0; n < 2; ++n) { const f32x4 d = v[ai][bj][m][n] - mw; q += (d[0] * d[0] + d[1] * d[1]) + (d[2] * d[2] + d[3] * d[3]); }
                q += __shfl_xor(q, 16); q += __shfl_xor(q, 32);
                if (fq == 0) P[(ai * HALF + wr * 64 + m * 16 + fr) * 4 + wc] = (f32x2v){mw, q};
            }
        asm volatile("s_waitcnt lgkmcnt(0)" ::: "memory"); __builtin_amdgcn_s_barrier(); asm volatile("" ::: "memory");
#if defined(BROKEN_EXCHANGE_NO_WAIT)
#warning BROKEN CONTROL BUILD: the row-statistics exchange does not wait; results are wrong by design
        if (blockIdx.x >= 64) { const long long t0_ = clock64(); while (clock64() - t0_ < 60000) __builtin_amdgcn_s_sleep(8); }
#endif
        const int row = wid * 32 + (lane & 31);
        if (lane < 32) {
            const f32x2v a = P[row * 4 + 0], b = P[row * 4 + 1], c = P[row * 4 + 2], d = P[row * 4 + 3];
            const float mt = (a.x + b.x + c.x + d.x) * 0.25f;
            const float da = a.x - mt, db = b.x - mt, dc = c.x - mt, dd = d.x - mt;
            const float m2 = (a.y + b.y) + (c.y + d.y) + 64.0f * ((da * da + db * db) + (dc * dc + dd * dd));
            unsigned long long* slot = (unsigned long long*)xbuf + ((size_t)(u.pm * BM + row) * 4 + u.pn);
            __hip_atomic_store(slot, ((unsigned long long)__float_as_uint(m2) << 32) | __float_as_uint(mt), __ATOMIC_RELAXED, __HIP_MEMORY_SCOPE_AGENT);
        }
        asm volatile("s_waitcnt vmcnt(0)" ::: "memory");
        if (lane == 0) __hip_atomic_fetch_add(cnt + 64 * u.pm, 1u, __ATOMIC_RELAXED, __HIP_MEMORY_SCOPE_AGENT);
        if (wid == 0) {
            bool dead = false; const unsigned long long t0 = __builtin_amdgcn_s_memrealtime(); const unsigned want = 8u * (unsigned)ntn;
            for (;;) {
#if defined(BROKEN_EXCHANGE_NO_WAIT)
                break;
#endif
                if ((unsigned)__builtin_amdgcn_readfirstlane(__hip_atomic_load(cnt + 64 * u.pm, __ATOMIC_RELAXED, __HIP_MEMORY_SCOPE_AGENT)) >= want) break;
                if (__builtin_amdgcn_s_memrealtime() - t0 > 2000000ull) {
                    if (lane == 0) { unsigned expect = 0u; __hip_atomic_compare_exchange_strong(tmo + 1, &expect, code | (unsigned)(u.pm & 0xff), __ATOMIC_RELAXED, __ATOMIC_RELAXED, __HIP_MEMORY_SCOPE_AGENT);
                                     __hip_atomic_store(tmo, 1u, __ATOMIC_RELAXED, __HIP_MEMORY_SCOPE_AGENT); }
                    dead = true; break; }
                __builtin_amdgcn_s_sleep(2);
            }
            __builtin_amdgcn_fence(__ATOMIC_ACQUIRE, "agent");
            if (lane == 0) flag[0] = dead ? 1u : 0u;
        }
        asm volatile("s_waitcnt vmcnt(0) lgkmcnt(0)" ::: "memory"); __builtin_amdgcn_s_barrier(); asm volatile("" ::: "memory");
        const bool bad = flag[0] != 0u;
        if (lane < 32) {
            const unsigned long long* slot = (const unsigned long long*)xbuf + (size_t)(u.pm * BM + row) * 4; float mt[4], m2[4]; float ms = 0.f;
#pragma unroll
            for (int t = 0; t < 4; ++t) { if (t < ntn) { const unsigned long long w = __hip_atomic_load(slot + t, __ATOMIC_RELAXED, __HIP_MEMORY_SCOPE_AGENT); mt[t] = __uint_as_float((unsigned)w); m2[t] = __uint_as_float((unsigned)(w >> 32)); } else { mt[t] = 0.f; m2[t] = 0.f; } ms += mt[t]; }
            const float mean = ms / (float)ntn; float q = 0.f;
#pragma unroll
            for (int t = 0; t < 4; ++t) if (t < ntn) { const float dm = mt[t] - mean; q += m2[t] + 256.0f * dm * dm; }
            S[row] = (f32x2v){mean, 1.0f / sqrtf(q / (256.0f * (float)ntn) + eps)};
        }
        asm volatile("s_waitcnt lgkmcnt(0)" ::: "memory"); __builtin_amdgcn_s_barrier(); asm volatile("" ::: "memory");
        return bad;
    }
};
struct EpiLnRes {
    static constexpr bool PERM = false, AFTER_DRAIN = true;
    const float* base; float* out; int ldc; const float* bias; PanelStats st; unsigned poison;
    __device__ __forceinline__ void fused(f32x4 (&acc)[2][2][4][2], const Unit& u, int wr, int wc, int fr, int fq, PG8_LAS unsigned char* lds, int wid, int lane) const {
        typedef float f32x2v __attribute__((ext_vector_type(2)));
        const PG8_LAS f32x2v* S = (const PG8_LAS f32x2v*)(lds + 8192);
        const int col0 = u.pn * BM + wc * 32 + 4 * fq;
#pragma unroll
        for (int bj = 0; bj < 2; ++bj)
#pragma unroll
            for (int n = 0; n < 2; ++n) { const f32x4 bv = bias ? *(const f32x4*)(bias + col0 + bj * HALF + n * 16) : (f32x4){0.f, 0.f, 0.f, 0.f};
#pragma unroll
                for (int ai = 0; ai < 2; ++ai)
#pragma unroll
                    for (int m = 0; m < 4; ++m) acc[ai][bj][m][n] += bv; }
        f32x4 pre[4][2][2];
#pragma unroll
        for (int m = 0; m < 4; ++m) { const size_t off = (size_t)(u.pm * BM + wr * 64 + m * 16 + fr) * ldc + col0;
#pragma unroll
            for (int bj = 0; bj < 2; ++bj)
#pragma unroll
                for (int n = 0; n < 2; ++n) pre[m][bj][n] = *(const f32x4*)(base + off + bj * HALF + n * 16); }
        const bool bad = st.run(acc, u, wr, wc, fr, fq, lds, wid, lane) || poison != 0u;
        const float qnan = __builtin_nanf("");
#pragma unroll
        for (int ai = 0; ai < 2; ++ai)
#pragma unroll
            for (int m = 0; m < 4; ++m) { const int r = ai * HALF + wr * 64 + m * 16 + fr; const f32x2v sr = S[r]; const size_t off = (size_t)(u.pm * BM + r) * ldc + col0;
#pragma unroll
                for (int bj = 0; bj < 2; ++bj)
#pragma unroll
                    for (int n = 0; n < 2; ++n) { const f32x4 bs = ai == 0 ? pre[m][bj][n] : *(const f32x4*)(base + off + bj * HALF + n * 16); f32x4 o = bs + (acc[ai][bj][m][n] - sr.x) * sr.y;
                        if (bad) o = (f32x4){qnan, qnan, qnan, qnan}; *(f32x4*)(out + off + bj * HALF + n * 16) = o; }
                if (m & 1) asm volatile("" ::: "memory"); }
    }
};
struct EpiLnResLn {
    static constexpr bool PERM = false, AFTER_DRAIN = true;
    const float* base; float* out; bf16_t* xn; int ldc; const float* bias; PanelStats st1, st2; unsigned poison;
    __device__ __forceinline__ void fused(f32x4 (&acc)[2][2][4][2], const Unit& u, int wr, int wc, int fr, int fq, PG8_LAS unsigned char* lds, int wid, int lane) const {
        typedef float f32x2v __attribute__((ext_vector_type(2))); typedef unsigned u32x2v __attribute__((ext_vector_type(2)));
        const PG8_LAS f32x2v* S = (const PG8_LAS f32x2v*)(lds + 8192);
        const int col0 = u.pn * BM + wc * 32 + 4 * fq;
#pragma unroll
        for (int bj = 0; bj < 2; ++bj)
#pragma unroll
            for (int n = 0; n < 2; ++n) { const f32x4 bv = bias ? *(const f32x4*)(bias + col0 + bj * HALF + n * 16) : (f32x4){0.f, 0.f, 0.f, 0.f};
#pragma unroll
                for (int ai = 0; ai < 2; ++ai)
#pragma unroll
                    for (int m = 0; m < 4; ++m) acc[ai][bj][m][n] += bv; }
        bool bad = st1.run(acc, u, wr, wc, fr, fq, lds, wid, lane) || poison != 0u;
        const float qnan = __builtin_nanf("");
#pragma unroll
        for (int ai = 0; ai < 2; ++ai)
#pragma unroll
            for (int m = 0; m < 4; ++m) { const int r = ai * HALF + wr * 64 + m * 16 + fr; const f32x2v sr = S[r]; const size_t off = (size_t)(u.pm * BM + r) * ldc + col0;
#pragma unroll
                for (int bj = 0; bj < 2; ++bj)
#pragma unroll
                    for (int n = 0; n < 2; ++n) { const f32x4 bs = *(const f32x4*)(base + off + bj * HALF + n * 16); acc[ai][bj][m][n] = bs + (acc[ai][bj][m][n] - sr.x) * sr.y; }
                asm volatile("" : "+v"(acc[ai][0][m][0]), "+v"(acc[ai][0][m][1]), "+v"(acc[ai][1][m][0]), "+v"(acc[ai][1][m][1]));
                if (m & 1) asm volatile("" ::: "memory"); }
        const bool bad1 = bad;
        bad = st2.run(acc, u, wr, wc, fr, fq, lds, wid, lane) || bad;
#pragma unroll
        for (int ai = 0; ai < 2; ++ai)
#pragma unroll
            for (int m = 0; m < 4; ++m) { const int r = ai * HALF + wr * 64 + m * 16 + fr; const f32x2v sr = S[r]; const size_t off = (size_t)(u.pm * BM + r) * ldc + col0;
#pragma unroll
                for (int bj = 0; bj < 2; ++bj)
#pragma unroll
                    for (int n = 0; n < 2; ++n) { const f32x4 x1 = acc[ai][bj][m][n]; *(f32x4*)(out + off + bj * HALF + n * 16) = bad1 ? (f32x4){qnan, qnan, qnan, qnan} : x1;
                        const f32x4 o = (x1 - sr.x) * sr.y; u32x2v w; w.x = cvt_pk_bf16(o[0], o[1]); w.y = cvt_pk_bf16(o[2], o[3]);
                        if (bad) { w.x = 0x7fc07fc0u; w.y = 0x7fc07fc0u; } *(u32x2v*)(xn + off + bj * HALF + n * 16) = w; }
                asm volatile("" ::: "memory"); }
    }
};

template <class Epi, class Sched, bool ALIGN_EPI = false, bool SP2 = false>
__device__ __forceinline__ void gemm_phase(PG8_LAS unsigned char* lds, const Gemm g, const Sched& S, const Epi& E) {
    const int tid = threadIdx.x, wid = __builtin_amdgcn_readfirstlane(tid >> 6), lane = tid & 63, wr = wid >> 2, wc = wid & 3, fr = lane & 15, fq = lane >> 4;
    const int K = g.K, nt = K / BK;
    unsigned voffA[2], voffB[2];
#pragma unroll
    for (int i = 0; i < 2; ++i) { int R, C; stage_rc(tid * 16 + i * 8192, R, C); const int Rb = Epi::PERM ? ((R & ~31) + perm32(R & 31)) : R;
        voffA[i] = (unsigned)(R * K + C) * 2u; voffB[i] = (unsigned)(Rb * K + C) * 2u; }
    const size_t kstep = (size_t)(BK * 2);
    const size_t hstep = (size_t)HALF * K * 2;
    const size_t tstep = 2 * hstep;
    const unsigned ldsw = (unsigned)wid * 1024u;
    const int aoff = lds_byte(wr * 64 + fr, fq * 8), boff = lds_byte(wc * 32 + fr, fq * 8);
#define PG8_SA(b, h) (((b) * 2 + (h)) * HTB)
#define PG8_SB(b, h) ((4 + (b) * 2 + (h)) * HTB)
#define PG8_STAGE(bufoff, gbase, voff) do { _Pragma("unroll") for (int _i = 0; _i < 2; ++_i) \
        __builtin_amdgcn_global_load_lds((const unsigned*)((const char*)(gbase) + (voff)[_i]), (PG8_LAS unsigned*)(lds + (bufoff) + ldsw + _i * 8192), 16, 0, 0); } while (0)
#define PG8_LDA(dst, b, h) do { _Pragma("unroll") for (int m = 0; m < 4; ++m) _Pragma("unroll") for (int k = 0; k < 2; ++k) dst[m][k] = *(const PG8_LAS bf16x8*)(lds + PG8_SA(b, h) + aoff + m * 2048 + k * 1024); } while (0)
#define PG8_LDB(dst, b, h) do { _Pragma("unroll") for (int n = 0; n < 2; ++n) _Pragma("unroll") for (int k = 0; k < 2; ++k) dst[n][k] = *(const PG8_LAS bf16x8*)(lds + PG8_SB(b, h) + boff + n * 2048 + k * 1024); } while (0)
#define PG8_MMA(ai, bj, At, Bt) do { __builtin_amdgcn_s_setprio(1); _Pragma("unroll") for (int m = 0; m < 4; ++m) _Pragma("unroll") for (int n = 0; n < 2; ++n) _Pragma("unroll") for (int k = 0; k < 2; ++k) \
        acc[ai][bj][m][n] = __builtin_amdgcn_mfma_f32_16x16x32_bf16(Bt[n][k], At[m][k], acc[ai][bj][m][n], 0, 0, 0); __builtin_amdgcn_s_setprio(0); } while (0)
#define PG8_WAIT_V(n) asm volatile("s_waitcnt vmcnt(" #n ")" ::: "memory")
#define PG8_WAIT_L(n) asm volatile("s_waitcnt lgkmcnt(" #n ")" ::: "memory")
#define PG8_BAR __builtin_amdgcn_s_barrier()
#define PG8_SCHED __builtin_amdgcn_sched_barrier(0)
    Unit cur, nxt; int ui = 0;
    if (!S.next(0, cur)) return;
    f32x4 acc[2][2][4][2];
#pragma unroll
    for (int a = 0; a < 2; ++a)
#pragma unroll
        for (int b = 0; b < 2; ++b)
#pragma unroll
            for (int m = 0; m < 4; ++m)
#pragma unroll
                for (int n = 0; n < 2; ++n) acc[a][b][m][n] = (f32x4){0.f, 0.f, 0.f, 0.f};
    bf16x8 At[4][2], B0[2][2], B1[2][2];
    const char* cA = (const char*)g.A + (size_t)cur.pm * tstep; const char* cB = (const char*)g.Bt + (size_t)cur.pn * tstep;
    S.a_ready(cur);
    if constexpr (SP2) {
        PG8_STAGE(PG8_SB(0, 0), cB, voffB); PG8_STAGE(PG8_SB(0, 1), cB + hstep, voffB); PG8_STAGE(PG8_SA(0, 0), cA, voffA); PG8_STAGE(PG8_SA(0, 1), cA + hstep, voffA);
        if (wr == 1) PG8_BAR;
        PG8_WAIT_V(2); PG8_BAR;
        PG8_STAGE(PG8_SB(1, 0), cB + kstep, voffB); PG8_STAGE(PG8_SA(1, 0), cA + kstep, voffA); PG8_STAGE(PG8_SB(1, 1), cB + hstep + kstep, voffB);
        PG8_WAIT_V(6); PG8_BAR;
    } else {
        PG8_STAGE(PG8_SB(0, 0), cB, voffB); PG8_STAGE(PG8_SA(0, 0), cA, voffA); PG8_STAGE(PG8_SB(0, 1), cB + hstep, voffB); PG8_STAGE(PG8_SA(0, 1), cA + hstep, voffA);
        if (wr == 1) PG8_BAR;
        PG8_WAIT_V(4); PG8_BAR;
        PG8_STAGE(PG8_SB(1, 0), cB + kstep, voffB); PG8_STAGE(PG8_SA(1, 0), cA + kstep, voffA); PG8_STAGE(PG8_SB(1, 1), cB + hstep + kstep, voffB);
        PG8_WAIT_V(6); PG8_BAR;
    }
    for (;;) {
        const bool has_next = S.next(ui + 1, nxt);
        const char* nA = has_next ? (const char*)g.A + (size_t)nxt.pm * tstep : cA; const char* nB = has_next ? (const char*)g.Bt + (size_t)nxt.pn * tstep : cB;
        for (int t = 0; t < nt; t += 2) {
            const bool last = (t == nt - 2);
            const char* a1 = cA + (size_t)(t + 1) * kstep;
            const char* a2 = last ? nA : cA + (size_t)(t + 2) * kstep; const char* b2 = last ? nB : cB + (size_t)(t + 2) * kstep;
            const char* a3 = a2 + kstep; const char* b3 = b2 + kstep;
            if (last && has_next) S.a_ready(nxt);
            if constexpr (SP2) {
            PG8_LDB(B0, 0, 0); PG8_LDB(B1, 0, 1); PG8_SCHED; PG8_LDA(At, 0, 0); PG8_STAGE(PG8_SA(1, 1), a1 + hstep, voffA);
            PG8_WAIT_V(8); PG8_WAIT_L(0); PG8_BAR; PG8_MMA(0, 0, At, B0); PG8_MMA(0, 1, At, B1); PG8_BAR; PG8_SCHED;
            PG8_LDA(At, 0, 1); PG8_STAGE(PG8_SB(0, 0), b2, voffB); PG8_STAGE(PG8_SB(0, 1), b2 + hstep, voffB); PG8_STAGE(PG8_SA(0, 0), a2, voffA);
            PG8_WAIT_V(8); PG8_WAIT_L(0); PG8_BAR; PG8_MMA(1, 0, At, B0); PG8_MMA(1, 1, At, B1); PG8_BAR; PG8_SCHED;
            PG8_LDB(B0, 1, 0); PG8_LDB(B1, 1, 1); PG8_SCHED; PG8_LDA(At, 1, 0); PG8_STAGE(PG8_SA(0, 1), a2 + hstep, voffA);
            PG8_WAIT_V(8); PG8_WAIT_L(0); PG8_BAR; PG8_MMA(0, 0, At, B0); PG8_MMA(0, 1, At, B1); PG8_BAR; PG8_SCHED;
            PG8_LDA(At, 1, 1); PG8_STAGE(PG8_SB(1, 0), b3, voffB); PG8_STAGE(PG8_SB(1, 1), b3 + hstep, voffB); PG8_STAGE(PG8_SA(1, 0), a3, voffA);
            PG8_WAIT_V(8); PG8_WAIT_L(0); PG8_BAR; PG8_MMA(1, 0, At, B0); PG8_MMA(1, 1, At, B1); PG8_BAR; PG8_SCHED;
            } else {
            PG8_LDB(B0, 0, 0); PG8_SCHED; PG8_LDA(At, 0, 0); PG8_STAGE(PG8_SA(1, 1), a1 + hstep, voffA);
            PG8_WAIT_L(8); PG8_BAR; PG8_WAIT_L(0); PG8_MMA(0, 0, At, B0); PG8_BAR; PG8_SCHED;
            PG8_LDB(B1, 0, 1); PG8_STAGE(PG8_SB(0, 0), b2, voffB);
            PG8_BAR; PG8_WAIT_L(0); PG8_MMA(0, 1, At, B1); PG8_BAR;
            PG8_LDA(At, 0, 1); PG8_STAGE(PG8_SA(0, 0), a2, voffA);
            PG8_BAR; PG8_WAIT_L(0); PG8_MMA(1, 0, At, B0); PG8_BAR; PG8_SCHED;
            PG8_STAGE(PG8_SB(0, 1), b2 + hstep, voffB);
            PG8_WAIT_V(6); PG8_BAR; PG8_MMA(1, 1, At, B1); PG8_BAR;
            PG8_LDB(B0, 1, 0); PG8_SCHED; PG8_LDA(At, 1, 0); PG8_STAGE(PG8_SA(0, 1), a2 + hstep, voffA);
            PG8_WAIT_L(8); PG8_BAR; PG8_WAIT_L(0); PG8_MMA(0, 0, At, B0); PG8_BAR; PG8_SCHED;
            PG8_LDB(B1, 1, 1); PG8_STAGE(PG8_SB(1, 0), b3, voffB);
            PG8_BAR; PG8_WAIT_L(0); PG8_MMA(0, 1, At, B1); PG8_BAR;
            PG8_LDA(At, 1, 1); PG8_STAGE(PG8_SA(1, 0), a3, voffA);
            PG8_BAR; PG8_WAIT_L(0); PG8_MMA(1, 0, At, B0); PG8_BAR; PG8_SCHED;
            PG8_STAGE(PG8_SB(1, 1), b3 + hstep, voffB);
            PG8_WAIT_V(6); PG8_BAR; PG8_MMA(1, 1, At, B1); PG8_BAR;
            }
        }
        if constexpr (ALIGN_EPI) { if (wr == 0) PG8_BAR; }
        if constexpr (!Epi::AFTER_DRAIN) { E(acc, cur, wr, wc, fr, fq); S.done(cur); }
        if (!has_next) break;
#pragma unroll
        for (int a = 0; a < 2; ++a)
#pragma unroll
            for (int b = 0; b < 2; ++b)
#pragma unroll
                for (int m = 0; m < 4; ++m)
#pragma unroll
                    for (int n = 0; n < 2; ++n) acc[a][b][m][n] = (f32x4){0.f, 0.f, 0.f, 0.f};
        cur = nxt; cA = nA; cB = nB; ++ui;
        if constexpr (ALIGN_EPI) { if (wr == 1) PG8_BAR; }
    }
    PG8_WAIT_V(0);
    if constexpr (!ALIGN_EPI) { if (wr == 0) PG8_BAR; }
    PG8_BAR;
    if constexpr (Epi::AFTER_DRAIN) { E.fused(acc, cur, wr, wc, fr, fq, lds, wid, lane); S.done(cur); }
#undef PG8_SA
#undef PG8_SB
#undef PG8_STAGE
#undef PG8_LDA
#undef PG8_LDB
#undef PG8_MMA
#undef PG8_WAIT_V
#undef PG8_WAIT_L
#undef PG8_BAR
#undef PG8_SCHED
}
}
#ifndef PG8_SP2
#define PG8_SP2 true
#endif
#ifndef PG8_ALIGN
#define PG8_ALIGN true
#endif
namespace pg8 {
struct EpiF32 {
    static constexpr bool PERM = false, AFTER_DRAIN = false;
    float* O; int ldc; const float* base; float alpha;
    __device__ __forceinline__ void operator()(const f32x4 (&acc)[2][2][4][2], const Unit& u, int wr, int wc, int fr, int fq) const {
        const int col0 = u.pn * BM + wc * 32 + 4 * fq;
#pragma unroll
        for (int ai = 0; ai < 2; ++ai)
#pragma unroll
            for (int m = 0; m < 4; ++m) { const size_t off = (size_t)(u.pm * BM + ai * HALF + wr * 64 + m * 16 + fr) * ldc + col0;
#pragma unroll
                for (int bj = 0; bj < 2; ++bj)
#pragma unroll
                    for (int n = 0; n < 2; ++n) { f32x4 v = acc[ai][bj][m][n];
                        if (base) { const f32x4 bs = *(const f32x4*)(base + off + bj * HALF + n * 16); v = v + bs * alpha; }
                        *(f32x4*)(O + off + bj * HALF + n * 16) = v; } }
    }
};
}

#include <hip/hip_bf16.h>
#include <cmath>
namespace datt {
using bf16 = __hip_bfloat16;
typedef short bf16x8 __attribute__((ext_vector_type(8)));
typedef short s16x4 __attribute__((ext_vector_type(4)));
typedef float f32x16 __attribute__((ext_vector_type(16)));
typedef float f32x4 __attribute__((ext_vector_type(4)));
typedef unsigned u32x4 __attribute__((ext_vector_type(4)));
constexpr int SEQ = 4096, DM = 1024, DQK = 64, DV = 128;
constexpr int NW = 8, QBLK = 32, KVBLK = 64, QB = NW * QBLK;
constexpr int SHM_V = KVBLK * DV * 2, SHM_K = KVBLK * DQK * 2;
constexpr int NSLOT = 3;
constexpr int LDS_BYTES = NSLOT * SHM_V + NSLOT * SHM_K + NW * 64 * 4;
constexpr float THR = 8.f;
#define DKSWZ(row, colB) ((row) * 128 + ((colB) ^ (((row) & 7) << 4)))
#define DSBAR() __builtin_amdgcn_sched_barrier(0)
__device__ __forceinline__ int v_st(int k, int c) { const int kk = (k & ~0xC) | ((k & 4) << 1) | ((k & 8) >> 1); return ((kk >> 3) * 4 + (c >> 5)) * 512 + ((kk & 7) * 32 + (c & 31)) * 2; }
__device__ __forceinline__ int v_rd_base(int lane) { return ((lane & 3) << 3) | (((lane >> 2) & 3) << 6) | (((lane >> 4) & 1) << 5) | (((lane >> 5) & 1) << 8); }
constexpr int v_rd_off(int d0, int ks, int half) { return d0 * 512 + ks * 4096 + half * 2048; }
__device__ __forceinline__ int crow(int r, int hi) { return (r & 3) + 8 * (r >> 2) + 4 * hi; }
__device__ __forceinline__ unsigned cvtpk(float lo, float hi) { unsigned r; asm volatile("v_cvt_pk_bf16_f32 %0, %1, %2" : "=v"(r) : "v"(lo), "v"(hi)); return r; }
__device__ __forceinline__ bf16x8 load8(const bf16* p) { return *reinterpret_cast<const bf16x8*>(p); }
__device__ __forceinline__ void mask_tile(f32x16& p0, f32x16& p1, int dq) {
    const float NEG = -__builtin_inff();
#pragma unroll
    for (int r = 0; r < 16; ++r) { const int c = (r & 3) + 8 * (r >> 2); if (dq - c < 0) p0[r] = NEG; if (dq - c - 32 < 0) p1[r] = NEG; }
}
__device__ __forceinline__ void alibi_tile(f32x16& p0, f32x16& p1, float sl2) {
#pragma unroll
    for (int r = 0; r < 16; ++r) { const float c = (float)((r & 3) + 8 * (r >> 2)); p0[r] = __builtin_fmaf(sl2, c, p0[r]); p1[r] = __builtin_fmaf(sl2, c + 32.f, p1[r]); }
}
__device__ __forceinline__ void partialSM(f32x16& p0, f32x16& p1, float base, float& m_reg, float& alpha) {
    float pmax = p0[0];
#pragma unroll
    for (int r = 1; r < 16; ++r) pmax = fmaxf(pmax, p0[r]);
#pragma unroll
    for (int r = 0; r < 16; ++r) pmax = fmaxf(pmax, p1[r]);
    { auto rr = __builtin_amdgcn_permlane32_swap(__float_as_uint(pmax), __float_as_uint(pmax), false, false); pmax = fmaxf(__uint_as_float(rr[0]), __uint_as_float(rr[1])); }
    pmax += base;
    float mn;
    if (__builtin_expect(__all(pmax - m_reg <= THR), 1)) { mn = m_reg; alpha = 1.f; }
    else { mn = fmaxf(m_reg, pmax); alpha = __builtin_amdgcn_exp2f(m_reg - mn); m_reg = mn; }
    const float mnL = base - mn;
#pragma unroll
    for (int r = 0; r < 16; ++r) p0[r] += mnL;
#pragma unroll
    for (int r = 0; r < 16; ++r) p1[r] += mnL;
#pragma unroll
    for (int r = 0; r < 16; ++r) p0[r] = __builtin_amdgcn_exp2f(p0[r]);
}
__device__ __forceinline__ void finishSM(f32x16& p0, f32x16& p1, float alpha, float& l_reg, bf16x8& pa0, bf16x8& pa1, bf16x8& pa2, bf16x8& pa3) {
#pragma unroll
    for (int r = 0; r < 16; ++r) p1[r] = __builtin_amdgcn_exp2f(p1[r]);
    float ps = 0;
#pragma unroll
    for (int r = 0; r < 16; ++r) ps += p0[r];
#pragma unroll
    for (int r = 0; r < 16; ++r) ps += p1[r];
    { auto rr = __builtin_amdgcn_permlane32_swap(__float_as_uint(ps), __float_as_uint(ps), false, false); ps = __uint_as_float(rr[0]) + __uint_as_float(rr[1]); }
    l_reg = l_reg * alpha + ps;
#define DPK4(P, B_, OUT) do { unsigned a0 = cvtpk(P[B_+0], P[B_+1]), a1 = cvtpk(P[B_+2], P[B_+3]); unsigned b0 = cvtpk(P[B_+4], P[B_+5]), b1 = cvtpk(P[B_+6], P[B_+7]); \
        auto r0 = __builtin_amdgcn_permlane32_swap(a0, b0, false, false); auto r1 = __builtin_amdgcn_permlane32_swap(a1, b1, false, false); \
        u32x4 w = {r0[0], r1[0], r0[1], r1[1]}; OUT = *reinterpret_cast<bf16x8*>(&w); } while (0)
    DPK4(p0, 0, pa0); DPK4(p0, 8, pa1); DPK4(p1, 0, pa2); DPK4(p1, 8, pa3);
#undef DPK4
}
__device__ __forceinline__ void qkt(f32x16& p0, f32x16& p1, const char* Kslot, int r32, int hi, const bf16x8* qr) {
    p0 = f32x16{}; p1 = f32x16{};
#pragma unroll
    for (int d0 = 0; d0 < 4; ++d0) { const char* a = Kslot + DKSWZ(r32, (d0 * 16 + hi * 8) * 2);
        const bf16x8 b0 = *reinterpret_cast<const bf16x8*>(a);
        const bf16x8 b1 = *reinterpret_cast<const bf16x8*>(a + 32 * 128);
        p0 = __builtin_amdgcn_mfma_f32_32x32x16_bf16(b0, qr[d0], p0, 0, 0, 0);
        p1 = __builtin_amdgcn_mfma_f32_32x32x16_bf16(b1, qr[d0], p1, 0, 0, 0); }
}
__device__ __forceinline__ void pv_tile(f32x16* o, int vb0, bf16x8 pa0, bf16x8 pa1, bf16x8 pa2, bf16x8 pa3) {
#define DTRRD(dst, off) asm volatile("ds_read_b64_tr_b16 %0, %1 offset:%2" : "=&v"(dst) : "v"(vb0), "i"(off) : "memory")
#define DPV_D0(d0) do { s16x4 l0, l1, l2, l3, h0, h1, h2, h3; constexpr int b_ = v_rd_off(d0, 0, 0); \
        DTRRD(l0, b_); DTRRD(h0, b_ + 2048); DTRRD(l1, b_ + 4096); DTRRD(h1, b_ + 6144); DTRRD(l2, b_ + 8192); DTRRD(h2, b_ + 10240); DTRRD(l3, b_ + 12288); DTRRD(h3, b_ + 14336); \
        asm volatile("s_waitcnt lgkmcnt(0)" ::: "memory"); DSBAR(); \
        o[d0] = __builtin_amdgcn_mfma_f32_32x32x16_bf16(pa0, (bf16x8){l0[0], l0[1], l0[2], l0[3], h0[0], h0[1], h0[2], h0[3]}, o[d0], 0, 0, 0); \
        o[d0] = __builtin_amdgcn_mfma_f32_32x32x16_bf16(pa1, (bf16x8){l1[0], l1[1], l1[2], l1[3], h1[0], h1[1], h1[2], h1[3]}, o[d0], 0, 0, 0); \
        o[d0] = __builtin_amdgcn_mfma_f32_32x32x16_bf16(pa2, (bf16x8){l2[0], l2[1], l2[2], l2[3], h2[0], h2[1], h2[2], h2[3]}, o[d0], 0, 0, 0); \
        o[d0] = __builtin_amdgcn_mfma_f32_32x32x16_bf16(pa3, (bf16x8){l3[0], l3[1], l3[2], l3[3], h3[0], h3[1], h3[2], h3[3]}, o[d0], 0, 0, 0); } while (0)
    DPV_D0(0); DPV_D0(1); DPV_D0(2); DPV_D0(3);
#undef DPV_D0
#undef DTRRD
}
struct BlockRef { const bf16* Q; const bf16* K; const bf16* V; bf16* O; int P0; int jlo; float sl2; };
struct Seam { bf16x8 qr[4]; bf16x8 st_v0, st_v1, st_k0; };
#define DROWV(p, k0, rr) ((p) + (size_t)((k0) + (rr)) * DM + sc)
#define DROWK(p, k0) ((p) + (size_t)((k0) + kr) * DM + kc)
#define DVMW() asm volatile("s_waitcnt vmcnt(0)" ::: "memory")
#define DVMWN(n) asm volatile("s_waitcnt vmcnt(%0)" :: "i"(n) : "memory")
#define DSLOAD(Kp, Vp, k0) do { S.st_v0 = load8(DROWV(Vp, k0, sr)); S.st_v1 = load8(DROWV(Vp, k0, 32 + sr)); S.st_k0 = load8(DROWK(Kp, k0)); } while (0)
#define DSWRITE_K(so) do { *(bf16x8*)(K_lds + (so) * SHM_K + kws) = S.st_k0; } while (0)
#define DSWRITE_V(so) do { *(bf16x8*)(V_lds + (so) * SHM_V + vst0) = S.st_v0; *(bf16x8*)(V_lds + (so) * SHM_V + vst1) = S.st_v1; } while (0)
__device__ __forceinline__ void datt_prime(const BlockRef& cur, char* lds, Seam& S) {
    const int tid = threadIdx.x, wid = __builtin_amdgcn_readfirstlane(tid >> 6), lane = tid & 63, r32 = lane & 31, hi = lane >> 5;
    const int sr = tid >> 4, sc = (tid & 15) * 8, kr = tid >> 3, kc = (tid & 7) * 8, kws = DKSWZ(kr, kc * 2); char* K_lds = lds + NSLOT * SHM_V;
    const int kb0 = cur.jlo * KVBLK;
#pragma unroll
    for (int d0 = 0; d0 < 4; ++d0) S.qr[d0] = load8(cur.Q + (size_t)(wid * QBLK + r32) * DM + d0 * 16 + hi * 8);
    DSLOAD(cur.K, cur.V, kb0); DVMW(); DSWRITE_K(0);
    __syncthreads();
}
__device__ __forceinline__ void datt_block(const BlockRef& cur, const BlockRef& nxt, char* lds, Seam& S) {
    const int tid = threadIdx.x, wid = __builtin_amdgcn_readfirstlane(tid >> 6), lane = tid & 63, r32 = lane & 31, hi = lane >> 5;
    const int j_lo = cur.jlo, j_hi = (cur.P0 + QB - 1) / KVBLK + 1, NT = j_hi - j_lo;
    const int kbn = nxt.jlo * KVBLK;
    const int qlo = cur.P0 + wid * QBLK, qm = qlo + r32 - 4 * hi;
    const float sl2 = cur.sl2;
    char* V_lds = lds; char* K_lds = lds + NSLOT * SHM_V;
    float* ws = (float*)(lds + NSLOT * SHM_V + NSLOT * SHM_K) + wid * 64; float* li_l = ws, * al_l = ws + 32;
    float m_reg = 4.0f, l_reg = 0; f32x16 o[4] = {};
    const int sr = tid >> 4, sc = (tid & 15) * 8, vst0 = v_st(sr, sc), vst1 = v_st(32 + sr, sc), kr = tid >> 3, kc = (tid & 7) * 8, kws = DKSWZ(kr, kc * 2);
    const int vb0 = (int)(uintptr_t)V_lds + v_rd_base(lane);
    const bf16* Kh = cur.K; const bf16* Vh = cur.V;
#define DRESC(a) do { if (__any((a) < 1.f)) { if (hi == 0) al_l[r32] = (a); asm volatile("s_waitcnt lgkmcnt(0)" ::: "memory"); \
                     _Pragma("unroll") for (int d_ = 0; d_ < 4; ++d_) _Pragma("unroll") for (int r = 0; r < 16; ++r) o[d_][r] *= al_l[crow(r, hi)]; } } while (0)
#define DKBASE(t) ((j_lo + (t)) * KVBLK)
#define DBIAS(t) (sl2 * (float)(DKBASE(t) - qm))
#define DMASKT(P0_, P1_, t) do { const int kb_ = DKBASE(t); alibi_tile(P0_, P1_, sl2); if (kb_ + KVBLK - 1 > qlo) mask_tile(P0_, P1_, qm - kb_); } while (0)
#define DSEAM_K0() do { DVMWN(4); DSWRITE_K(0); DSBAR(); } while (0)
    int s_p = 2, s_c = 0, s_n = 1;
#define DROT() do { const int t_ = s_p; s_p = s_c; s_c = s_n; s_n = t_; } while (0)
    f32x16 pA0, pA1, pB0, pB1; float alA, alB; bf16x8 pa0, pa1, pa2, pa3;
    DSWRITE_V(0); DSBAR();
    if (NT > 1) DSLOAD(Kh, Vh, DKBASE(1));
    DSBAR(); qkt(pA0, pA1, K_lds, r32, hi, S.qr);
    DMASKT(pA0, pA1, 0); partialSM(pA0, pA1, DBIAS(0), m_reg, alA);
    if (NT > 1) { DVMW(); DSWRITE_V(1); DSWRITE_K(1); }
    __syncthreads();
#define DHALF_STEP(PX0, PX1, alX, PY0, PY1, alY, t) do { DROT(); \
        DSBAR(); qkt(PX0, PX1, K_lds + s_c * SHM_K, r32, hi, S.qr); \
        finishSM(PY0, PY1, alY, l_reg, pa0, pa1, pa2, pa3); DSBAR(); \
        if ((t) + 1 < NT) { DSLOAD(Kh, Vh, DKBASE((t) + 1)); DSBAR(); } \
        pv_tile(o, vb0 + s_p * SHM_V, pa0, pa1, pa2, pa3); DMASKT(PX0, PX1, (t)); partialSM(PX0, PX1, DBIAS(t), m_reg, alX); \
        if ((t) + 1 < NT) { DVMW(); DSWRITE_V(s_n); DSWRITE_K(s_n); } \
        DRESC(alX); __syncthreads(); } while (0)
    for (int t = 1; t + 1 < NT; t += 2) {
        DHALF_STEP(pB0, pB1, alB, pA0, pA1, alA, t);
        DHALF_STEP(pA0, pA1, alA, pB0, pB1, alB, t + 1);
    }
    const bool even = (NT & 1) == 0;
    if (even) { DSBAR(); qkt(pB0, pB1, K_lds + s_n * SHM_K, r32, hi, S.qr); DSBAR(); }
    DSLOAD(nxt.K, nxt.V, kbn); DSBAR();
#pragma unroll
    for (int d0 = 0; d0 < 4; ++d0) S.qr[d0] = load8(nxt.Q + (size_t)(wid * QBLK + r32) * DM + d0 * 16 + hi * 8);
    DSBAR();
    finishSM(pA0, pA1, alA, l_reg, pa0, pa1, pa2, pa3); DSBAR();
    pv_tile(o, vb0 + s_c * SHM_V, pa0, pa1, pa2, pa3);
    if (even) { DMASKT(pB0, pB1, NT - 1); partialSM(pB0, pB1, DBIAS(NT - 1), m_reg, alB); __syncthreads(); DRESC(alB);
        finishSM(pB0, pB1, alB, l_reg, pa0, pa1, pa2, pa3); DSBAR(); pv_tile(o, vb0 + s_n * SHM_V, pa0, pa1, pa2, pa3); }
    else { __syncthreads(); }
    DSBAR(); DSEAM_K0();
    if (hi == 0) li_l[r32] = l_reg; asm volatile("s_waitcnt lgkmcnt(0)" ::: "memory");
    float rli[16];
#pragma unroll
    for (int r = 0; r < 16; ++r) rli[r] = __builtin_amdgcn_rcpf(li_l[crow(r, hi)]);
    bf16* Ow = cur.O + (size_t)(wid * QBLK) * DM;
#pragma unroll
    for (int r = 0; r < 16; ++r) { const int orow = crow(r, hi);
#pragma unroll
        for (int d0 = 0; d0 < 4; ++d0) { const float v = o[d0][r] * rli[r]; const float vn = __shfl_xor(v, 1);
            if ((r32 & 1) == 0) *(unsigned*)(Ow + (size_t)orow * DM + d0 * 32 + r32) = cvtpk(v, vn); } }
    __syncthreads();
#undef DRESC
#undef DKBASE
#undef DBIAS
#undef DMASKT
#undef DSEAM_K0
#undef DHALF_STEP
#undef DROT
}
#undef DROWV
#undef DROWK
#undef DVMW
#undef DVMWN
#undef DSLOAD
#undef DSWRITE_K
#undef DSWRITE_V
struct Tensors { const bf16* Q; const bf16* K; const bf16* V; bf16* O0; bf16* O1; const unsigned* NQ; const unsigned* NK; unsigned* qhead; const unsigned short* order; };
__device__ __forceinline__ BlockRef make_ref(const Tensors& T, unsigned code) {
    const int qb = code & 15, h = (code >> 4) & 7, b = (code >> 7) & 3, c = (code >> 9) & 1, hq = 2 * h + c;
    BlockRef r; const size_t rowb = (size_t)b * SEQ;
    r.Q = T.Q + (rowb + (size_t)qb * QB) * DM + hq * DQK; r.K = T.K + rowb * DM + hq * DQK; r.V = T.V + rowb * DM + h * DV; r.O = (c ? T.O1 : T.O0) + (rowb + (size_t)qb * QB) * DM + h * DV;
    r.P0 = qb * QB; r.sl2 = __builtin_amdgcn_exp2f(-(float)(h + 1)) * 1.4426950408889634f;
    int lane_ = threadIdx.x & 63; asm volatile("" : "+v"(lane_));
    const int nt_ = 4 * qb + 4; float qn_ = 0.f;
#pragma unroll
    for (int i_ = 0; i_ < 4; ++i_) qn_ = fmaxf(qn_, __uint_as_float(T.NQ[((b * 64 + 4 * qb + i_) * 16) + hq]));
    const float kn_ = lane_ < nt_ ? __uint_as_float(T.NK[((b * 64 + lane_) * 16) + hq]) : 0.f;
    const float bound_ = sqrtf(qn_) * sqrtf(kn_) * 1.001f - r.sl2 * (float)(256 * qb - 64 * lane_ - 63) - 4.0f;
    const unsigned long long keep_ = __ballot(lane_ < nt_ && !(bound_ < -152.0f));
    int first_ = keep_ ? (int)__builtin_ctzll(keep_) : nt_ - 1; if (first_ > nt_ - 4) first_ = nt_ - 4;
    r.jlo = __builtin_amdgcn_readfirstlane(first_);
    return r;
}
__device__ __forceinline__ int draw(const Tensors& T, volatile __attribute__((address_space(3))) unsigned* qw) {
    __syncthreads();
    if (threadIdx.x == 0) *qw = __hip_atomic_fetch_add(T.qhead, 1u, __ATOMIC_RELAXED, __HIP_MEMORY_SCOPE_AGENT);
    __syncthreads();
    return (int)*qw;
}
__device__ __forceinline__ void datt_phase(char* lds, volatile __attribute__((address_space(3))) unsigned* qw, const Tensors& T) {
    int i = draw(T, qw); if (i >= 1024) return;
    BlockRef cur = make_ref(T, T.order[i]);
    Seam S;
    datt_prime(cur, lds, S);
    for (;;) {
        const int in = draw(T, qw); const bool last = in >= 1024;
        const BlockRef nxt = last ? cur : make_ref(T, T.order[in]);
        datt_block(cur, nxt, lds, S);
        if (last) break;
        cur = nxt;
    }
}
#undef DKSWZ
#undef DSBAR
}
__device__ const unsigned short datt_order[1024] = {79,95,111,127,207,223,239,255,335,351,367,383,463,479,495,511,591,607,623,639,719,735,751,767,847,863,879,895,975,991,1007,1023,78,94,110,126,206,222,238,254,334,350,366,382,462,478,494,510,590,606,622,638,718,734,750,766,846,862,878,894,974,990,1006,1022,77,93,109,125,205,221,237,253,333,349,365,381,461,477,493,509,589,605,621,637,717,733,749,765,845,861,877,893,973,989,1005,1021,76,92,108,124,204,220,236,252,332,348,364,380,460,476,492,508,588,604,620,636,716,732,748,764,844,860,876,892,972,988,1004,1020,75,91,107,123,203,219,235,251,331,347,363,379,459,475,491,507,587,603,619,635,715,731,747,763,843,859,875,891,971,987,1003,1019,74,90,106,122,202,218,234,250,330,346,362,378,458,474,490,506,586,602,618,634,714,730,746,762,842,858,874,890,970,986,1002,1018,73,89,105,121,201,217,233,249,329,345,361,377,457,473,489,505,585,601,617,633,713,729,745,761,841,857,873,889,969,985,1001,1017,56,57,58,59,60,61,62,63,72,88,104,120,184,185,186,187,188,189,190,191,200,216,232,248,312,313,314,315,316,317,318,319,328,344,360,376,440,441,442,443,444,445,446,447,456,472,488,504,568,569,570,571,572,573,574,575,584,600,616,632,696,697,698,699,700,701,702,703,712,728,744,760,824,825,826,827,828,829,830,831,840,856,872,888,952,953,954,955,956,957,958,959,968,984,1000,1016,55,71,87,103,119,183,199,215,231,247,311,327,343,359,375,439,455,471,487,503,567,583,599,615,631,695,711,727,743,759,823,839,855,871,887,951,967,983,999,1015,54,70,86,102,118,182,198,214,230,246,310,326,342,358,374,438,454,470,486,502,566,582,598,614,630,694,710,726,742,758,822,838,854,870,886,950,966,982,998,1014,53,69,85,101,117,181,197,213,229,245,309,325,341,357,373,437,453,469,485,501,565,581,597,613,629,693,709,725,741,757,821,837,853,869,885,949,965,981,997,1013,36,37,38,39,40,41,42,43,44,45,46,47,52,68,84,100,116,164,165,166,167,168,169,170,171,172,173,174,175,180,196,212,228,244,292,293,294,295,296,297,298,299,300,301,302,303,308,324,340,356,372,420,421,422,423,424,425,426,427,428,429,430,431,436,452,468,484,500,548,549,550,551,552,553,554,555,556,557,558,559,564,580,596,612,628,676,677,678,679,680,681,682,683,684,685,686,687,692,708,724,740,756,804,805,806,807,808,809,810,811,812,813,814,815,820,836,852,868,884,932,933,934,935,936,937,938,939,940,941,942,943,948,964,980,996,1012,35,51,67,83,99,115,163,179,195,211,227,243,291,307,323,339,355,371,419,435,451,467,483,499,547,563,579,595,611,627,675,691,707,723,739,755,803,819,835,851,867,883,931,947,963,979,995,1011,18,19,20,21,22,23,24,25,26,27,28,29,30,31,34,50,66,82,98,114,146,147,148,149,150,151,152,153,154,155,156,157,158,159,162,178,194,210,226,242,274,275,276,277,278,279,280,281,282,283,284,285,286,287,290,306,322,338,354,370,402,403,404,405,406,407,408,409,410,411,412,413,414,415,418,434,450,466,482,498,530,531,532,533,534,535,536,537,538,539,540,541,542,543,546,562,578,594,610,626,658,659,660,661,662,663,664,665,666,667,668,669,670,671,674,690,706,722,738,754,786,787,788,789,790,791,792,793,794,795,796,797,798,799,802,818,834,850,866,882,914,915,916,917,918,919,920,921,922,923,924,925,926,927,930,946,962,978,994,1010,1,2,3,4,5,6,7,8,9,10,11,12,13,14,15,17,33,49,65,81,97,113,129,130,131,132,133,134,135,136,137,138,139,140,141,142,143,145,161,177,193,209,225,241,257,258,259,260,261,262,263,264,265,266,267,268,269,270,271,273,289,305,321,337,353,369,385,386,387,388,389,390,391,392,393,394,395,396,397,398,399,401,417,433,449,465,481,497,513,514,515,516,517,518,519,520,521,522,523,524,525,526,527,529,545,561,577,593,609,625,641,642,643,644,645,646,647,648,649,650,651,652,653,654,655,657,673,689,705,721,737,753,769,770,771,772,773,774,775,776,777,778,779,780,781,782,783,785,801,817,833,849,865,881,897,898,899,900,901,902,903,904,905,906,907,908,909,910,911,913,929,945,961,977,993,1009,0,16,32,48,64,80,96,112,128,144,160,176,192,208,224,240,256,272,288,304,320,336,352,368,384,400,416,432,448,464,480,496,512,528,544,560,576,592,608,624,640,656,672,688,704,720,736,752,768,784,800,816,832,848,864,880,896,912,928,944,960,976,992,1008};

constexpr int NWAVES = 8;
constexpr int BATCH = 4, SEQ = 4096, D = 2048, M = BATCH * SEQ;
constexpr int AW = 1024, NIN = 5120;
constexpr float LN_EPS = 1e-5f;
constexpr float DN_ALPHA = 1.189207115002721f;
constexpr float C2 = 0.125f * 1.4426950408889634f;
constexpr float LOG2E = 1.4426950408889634f;

constexpr size_t MiB = 1u << 20;
constexpr size_t WS_CTL = 0, CTL_ZERO_BYTES = 1 * MiB;
constexpr size_t WS_WIN = 2 * MiB, WS_WOUT = 22 * MiB, WS_WQ = 30 * MiB, WS_PRM = 38 * MiB;
constexpr size_t WS_XB = 392 * MiB;
constexpr size_t WS_MIX = 40 * MiB;
constexpr size_t WS_Q = 104 * MiB, WS_K = 136 * MiB, WS_V = 168 * MiB, WS_XR = 200 * MiB, WS_XG = 232 * MiB;
constexpr size_t WS_Y1 = 104 * MiB;
constexpr size_t WS_H1 = 232 * MiB;
constexpr size_t WS_H8 = 296 * MiB;
constexpr size_t WS_PQ = 104 * MiB;
constexpr size_t WS_SU = 38 * MiB + 65536, WS_SH = 38 * MiB + 131072;
constexpr size_t WS_WG = 38 * MiB + 262144;
constexpr size_t WS_PART = 104 * MiB;
constexpr size_t WS_FFN = 40 * MiB;
constexpr size_t WS_PK = 2 * MiB;
constexpr size_t WS_U8 = 328 * MiB, WS_V8 = 360 * MiB;
constexpr size_t WS_LA = 328 * MiB, WS_LB = 392 * MiB;
constexpr size_t WS_O0 = 264 * MiB, WS_O1 = 296 * MiB;
constexpr size_t WS_E = 456 * MiB, WS_G = 464 * MiB, WS_TOTA = 472 * MiB, WS_TOTH = 473 * MiB, WS_SKH = 474 * MiB, WS_SKL = 475 * MiB, WS_END = 476 * MiB;
constexpr int CW_BAR = 4096;
constexpr int CW_NQ = 32768, CW_NK = 32768 + 4096, CW_AQ = 32768 + 8192, CW_CQ = 32768 + 8192 + 128;

constexpr int RING_OFF = 0, RING_BYTES = 131072;
constexpr int LDSCTL_OFF = RING_BYTES, MISC_OFF = LDSCTL_OFF + 320;
constexpr int LDS_BYTES = 147456;

#define GAS __attribute__((address_space(1)))
#define LAS __attribute__((address_space(3)))
typedef unsigned short bf16;
typedef unsigned v4u __attribute__((ext_vector_type(4)));
typedef float f32x4 __attribute__((ext_vector_type(4)));
typedef GAS unsigned gu32;
#define RLX_AGENT __ATOMIC_RELAXED, __HIP_MEMORY_SCOPE_AGENT
#define LDS_WAIT() asm volatile("s_waitcnt lgkmcnt(0)" ::: "memory")
#define VM_WAIT() asm volatile("s_waitcnt vmcnt(0)" ::: "memory")
__device__ __forceinline__ unsigned f2bf(float f) { unsigned u = __builtin_bit_cast(unsigned, f); return (u + 0x7fffu + ((u >> 16) & 1u)) >> 16; }
__device__ __forceinline__ unsigned pk2(float lo, float hi) { return f2bf(lo) | (f2bf(hi) << 16); }
__device__ __forceinline__ float bf2f(unsigned short u) { return __uint_as_float(((unsigned)u) << 16); }
__device__ __forceinline__ float gelu_tanh(float x) { const float u = 0.7978845608028654f * (x + 0.044715f * x * x * x); return 0.5f * x * (1.f + tanhf(u)); }

#define XB_TMO      128
#define XB_XCNT(j)  (256  + 64 * (j))
#define XB_XSUB(j)  (1280 + 64 * (j))
#define XB_XGEN(j)  (2304 + 64 * (j))
#define XB_TOP      3328
#define XB_TOPGEN   3392
#define XCD_BAR_WORDS 3456
#define XB_SPIN_CAP (1u << 18)

__device__ __forceinline__ unsigned xb_ld(unsigned* p)              { return __hip_atomic_load(p, __ATOMIC_RELAXED, __HIP_MEMORY_SCOPE_AGENT); }
__device__ __forceinline__ unsigned xb_add(unsigned* p, unsigned v) { return __hip_atomic_fetch_add(p, v, __ATOMIC_RELAXED, __HIP_MEMORY_SCOPE_AGENT); }
__device__ __forceinline__ unsigned xb_xcc_id() { return (unsigned)__builtin_amdgcn_s_getreg((3 << 11) | 20) & 0xFu; }
#define XB_SPIN(cond, bar) do { unsigned _sp = 0; while (cond) { __builtin_amdgcn_s_sleep(1); \
    if ((++_sp & 255u) == 0u) { if (xb_ld(&(bar)[XB_TMO])) break; if (_sp > XB_SPIN_CAP) { atomicAdd(&(bar)[XB_TMO], 1u); break; } } } } while (0)

struct XcdBarrier {
    unsigned* bar; unsigned x;
    volatile LAS unsigned* st;
};

__device__ __forceinline__ XcdBarrier xcd_barrier_post(unsigned* bar, volatile LAS unsigned* st) {
    XcdBarrier b; b.bar = bar; b.x = xb_xcc_id(); b.st = st;
    if (threadIdx.x == 0) (void)xb_add(&bar[XB_XCNT(b.x)], 1u);
    return b;
}
__device__ __forceinline__ void xcd_barrier_complete(unsigned* bar, unsigned x, unsigned& nloc, unsigned& nx) {
    const unsigned G = gridDim.x * gridDim.y * gridDim.z;
    unsigned sum, cnt, mine, sp = 0u;
    for (;;) {
        sum = 0u; cnt = 0u; mine = 0u;
#pragma unroll
        for (unsigned j = 0; j < 16; ++j) { const unsigned c = xb_ld(&bar[XB_XCNT(j)]); sum += c; cnt += (c > 0u) ? 1u : 0u; mine = (j == x) ? c : mine; }
        if (sum == G) break;
        __builtin_amdgcn_s_sleep(1);
        if ((++sp & 255u) == 0u) { if (xb_ld(&bar[XB_TMO])) break; if (sp > XB_SPIN_CAP) { atomicAdd(&bar[XB_TMO], 1u); break; } }
    }
    nloc = mine > 0u ? mine : 1u; nx = cnt > 0u ? cnt : 1u;
}

__device__ __forceinline__ void xcd_barrier(const XcdBarrier& b) {
    asm volatile("s_waitcnt vmcnt(0)" ::: "memory");
    __syncthreads();
    if (threadIdx.x == 0) {
        unsigned* bar = b.bar;
        __builtin_amdgcn_s_waitcnt(0);
        unsigned nloc = b.st[0], nx = b.st[1];
        if (nloc == 0u) { xcd_barrier_complete(bar, b.x, nloc, nx); b.st[0] = nloc; b.st[1] = nx; }
        const unsigned old = xb_add(&bar[XB_XSUB(b.x)], 1u);
        const unsigned gen = old / nloc;
        if (old + 1u == (gen + 1u) * nloc) {
            __builtin_amdgcn_fence(__ATOMIC_RELEASE, "agent");
            asm volatile("s_waitcnt vmcnt(0)" ::: "memory");
            const unsigned og = xb_add(&bar[XB_TOP], 1u);
            const unsigned tg = og / nx;
            if (og + 1u == (tg + 1u) * nx) xb_add(&bar[XB_TOPGEN], 1u);
            else XB_SPIN(xb_ld(&bar[XB_TOPGEN]) == tg, bar);
            __builtin_amdgcn_fence(__ATOMIC_ACQUIRE, "agent");
            xb_add(&bar[XB_XGEN(b.x)], 1u);
            asm volatile("s_waitcnt vmcnt(0)" ::: "memory");
        } else {
            XB_SPIN(xb_ld(&bar[XB_XGEN(b.x)]) == gen, bar);
            __builtin_amdgcn_fence(__ATOMIC_ACQUIRE, "agent");
            asm volatile("s_waitcnt vmcnt(0)" ::: "memory");
        }
    }
    __syncthreads();
}

struct Frame {
    LAS unsigned char* lds;
    int tid, lane, wave;
    int vcu, G;
};

__device__ __forceinline__ void p0_transpose_item(const float* W, int K, int N, bf16* WT, int row_off, LAS float* scr, int item, int lane) {
    const int nblk = N / 32, kb = item / nblk, nb = item % nblk, k0 = 64 * kb, n0 = 32 * nb;
#pragma unroll 8
    for (int i = 0; i < 32; ++i) { const int kk = 2 * i + (lane >> 5); scr[kk * 33 + (lane & 31)] = W[(size_t)(k0 + kk) * N + n0 + (lane & 31)]; }
    LDS_WAIT(); asm volatile("" ::: "memory");
    const int c = lane & 7;
#pragma unroll
    for (int j = 0; j < 4; ++j) { const int n = (lane >> 3) + 8 * j; const LAS float* s = scr + (8 * c) * 33 + n;
        v4u o; o.x = pk2(s[0 * 33], s[1 * 33]); o.y = pk2(s[2 * 33], s[3 * 33]); o.z = pk2(s[4 * 33], s[5 * 33]); o.w = pk2(s[6 * 33], s[7 * 33]);
        *(GAS v4u*)(WT + (size_t)(row_off + n0 + n) * K + k0 + 8 * c) = o; }
    LDS_WAIT(); asm volatile("" ::: "memory");
}

typedef short bf16x8 __attribute__((ext_vector_type(8)));
typedef float f32x16 __attribute__((ext_vector_type(16)));
typedef float f32x2_t __attribute__((ext_vector_type(2))); typedef __bf16 bf16x2_t __attribute__((ext_vector_type(2)));
__device__ __forceinline__ unsigned cvtpk(float lo, float hi) { f32x2_t v = {lo, hi}; bf16x2_t b = __builtin_convertvector(v, bf16x2_t); return __builtin_bit_cast(unsigned, b); }
__device__ __forceinline__ void split8(const f32x4 a, const f32x4 b, bf16x8& h, bf16x8& l) {
    v4u hh; hh.x = cvtpk(a.x, a.y); hh.y = cvtpk(a.z, a.w); hh.z = cvtpk(b.x, b.y); hh.w = cvtpk(b.z, b.w);
    v4u ll;
    ll.x = cvtpk(a.x - __uint_as_float(hh.x << 16), a.y - __uint_as_float(hh.x & 0xffff0000u));
    ll.y = cvtpk(a.z - __uint_as_float(hh.y << 16), a.w - __uint_as_float(hh.y & 0xffff0000u));
    ll.z = cvtpk(b.x - __uint_as_float(hh.z << 16), b.y - __uint_as_float(hh.z & 0xffff0000u));
    ll.w = cvtpk(b.z - __uint_as_float(hh.w << 16), b.w - __uint_as_float(hh.w & 0xffff0000u));
    h = __builtin_bit_cast(bf16x8, hh); l = __builtin_bit_cast(bf16x8, ll);
}
__device__ __forceinline__ float max3f_(float a, float b, float c) { return __builtin_fmaxf(__builtin_fmaxf(a, b), c); }
__device__ __forceinline__ float pair_max(float m) { auto rr = __builtin_amdgcn_permlane32_swap(__float_as_uint(m), __float_as_uint(m), false, false); return __builtin_fmaxf(__uint_as_float(rr[0]), __uint_as_float(rr[1])); }
__device__ __forceinline__ void route_half(const float* qp, const v4u* kh, const v4u* kl, int lane, int hi, float (&lst)[16]) {
    f32x16 sc[4];
#pragma unroll
    for (int kt = 0; kt < 4; ++kt) sc[kt] = f32x16{};
#pragma unroll 2
    for (int ds = 0; ds < 8; ++ds) { bf16x8 qh, ql; split8(*(const f32x4*)(qp + 16 * ds), *(const f32x4*)(qp + 16 * ds + 4), qh, ql);
#pragma unroll
        for (int kt = 0; kt < 4; ++kt) { const bf16x8 ah = __builtin_bit_cast(bf16x8, kh[(kt * 8 + ds) * 64 + lane]), al = __builtin_bit_cast(bf16x8, kl[(kt * 8 + ds) * 64 + lane]);
            sc[kt] = __builtin_amdgcn_mfma_f32_32x32x16_bf16(ah, qh, sc[kt], 0, 0, 0);
            sc[kt] = __builtin_amdgcn_mfma_f32_32x32x16_bf16(ah, ql, sc[kt], 0, 0, 0);
            sc[kt] = __builtin_amdgcn_mfma_f32_32x32x16_bf16(al, qh, sc[kt], 0, 0, 0); } }
#pragma unroll
    for (int kt = 0; kt < 4; ++kt)
#pragma unroll
        for (int r = 0; r < 16; ++r) { const unsigned key = (unsigned)(kt * 32 + (r & 3) + 8 * (r >> 2) + 4 * hi); sc[kt][r] = __uint_as_float((__float_as_uint(sc[kt][r]) & ~127u) | (127u - key)); }
#pragma unroll
    for (int rd = 0; rd < 16; ++rd) {
        float m = max3f_(sc[0][0], sc[0][1], sc[0][2]);
#pragma unroll
        for (int n = 3; n + 1 < 64; n += 2) m = max3f_(m, sc[n >> 4][n & 15], sc[(n + 1) >> 4][(n + 1) & 15]);
        m = __builtin_fmaxf(m, sc[3][15]);
        const float gm = pair_max(m); lst[rd] = gm;
#pragma unroll
        for (int kt = 0; kt < 4; ++kt)
#pragma unroll
            for (int r = 0; r < 16; ++r) sc[kt][r] = (__float_as_uint(sc[kt][r]) == __float_as_uint(gm)) ? -INFINITY : sc[kt][r];
    }
}
typedef float f32x2v __attribute__((ext_vector_type(2)));
__device__ __forceinline__ unsigned pk4_fp8(float a, float b, float c, float d) { int p = __builtin_amdgcn_cvt_pk_fp8_f32(a, b, 0, false); p = __builtin_amdgcn_cvt_pk_fp8_f32(c, d, p, true); return (unsigned)p; }
constexpr float U8_SCALE = 64.f;
typedef short bf16x8_l __attribute__((ext_vector_type(8)));
template <int PASS, bool CONV = false> __device__ __forceinline__ void lru_phase(const Frame& F, unsigned char* ws, const float* conv_w, const float* conv_b, const float* b_a, const float* b_x, const float* lru_lambda, const float* tab_u = nullptr, const float* tab_v = nullptr) {
    int itc = 0;
    constexpr int XS = 272;
    LAS unsigned char* xs = F.lds + RING_OFF;
    const bf16* XR = (const bf16*)(ws + WS_XR); const bf16* XG = (const bf16*)(ws + WS_XG); bf16* MIX = (bf16*)(ws + WS_MIX); const bf16* WGT = (const bf16*)(ws + WS_WG);
    float* TA = (float*)(ws + WS_TOTA); float* TH = (float*)(ws + WS_TOTH);
    const int tid = F.tid, lane = F.lane, w = F.wave, l15 = lane & 15, g = lane >> 4;
    const int hb = F.vcu & 7;
    const int nun = 2048 / 8;
    const int gi = F.vcu >> 3, gn = (F.G + 7 - hb) >> 3;
    const int chc = tid & 127, tg = tid >> 7, colc = hb * 128 + chc;
    const float cw0 = conv_w[colc], cw1 = conv_w[1024 + colc], cw2 = conv_w[2048 + colc], cw3 = conv_w[3072 + colc], cb = conv_b[colc];
    const int chn = hb * 128 + 16 * w + l15;
    LAS unsigned char* wb = F.lds + RING_OFF + 49152 + w * 8192 + lane * 16;
#pragma unroll
    for (int ks = 0; ks < 4; ++ks) { *(LAS bf16x8_l*)(wb + ks * 1024) = *(const bf16x8_l*)(WGT + ((size_t)(hb * 128 + 16 * w + l15)) * 128 + 32 * ks + 8 * g);
        *(LAS bf16x8_l*)(wb + (4 + ks) * 1024) = *(const bf16x8_l*)(WGT + ((size_t)((8 + hb) * 128 + 16 * w + l15)) * 128 + 32 * ks + 8 * g); }
    const float ba = b_a[chn], bx = b_x[chn], sp8 = 8.f * log1pf(__expf(-lru_lambda[chn]));
    unsigned short xrn[19];
#define LRU_LOAD(uu) do { const int c_ = (uu) & 63, b_ = (uu) >> 6, tok0_ = b_ * SEQ + c_ * 64; \
        int ro_ = (tok0_ + tg * 16) * AW + colc; asm volatile("" : "+v"(ro_)); \
        _Pragma("unroll") for (int r = 0; r < 19; ++r) xrn[r] = (c_ * 64 + tg * 16 + r - 3 >= 0) ? XR[ro_ + (r - 3) * AW] : (unsigned short)0; \
        } while (0)
    if (gi < nun) LRU_LOAD(gi);
    for (int uu = gi; uu < nun; uu += gn) {
        const int c = uu & 63, b = uu >> 6, tok0 = b * SEQ + c * 64;
        {
            float xv[19];
#pragma unroll
            for (int r = 0; r < 19; ++r) xv[r] = bf2f(xrn[r]);
#pragma unroll
            for (int i = 0; i < 16; ++i) { const float y = cb + cw0 * xv[i] + cw1 * xv[i + 1] + cw2 * xv[i + 2] + cw3 * xv[i + 3];
                *(LAS unsigned short*)(xs + (tg * 16 + i) * XS + chc * 2) = (unsigned short)f2bf(y); }
        }
        unsigned short xgv[16]; float ta[16], th[16];
        if (PASS == 2) {
            int go_ = (tok0 + 4 * g) * AW + chn, to_ = b * 65536 + chn; asm volatile("" : "+v"(go_), "+v"(to_));
#pragma unroll
            for (int m = 0; m < 4; ++m)
#pragma unroll
                for (int r = 0; r < 4; ++r) xgv[4 * m + r] = XG[go_ + (16 * m + r) * AW];
#pragma unroll
            for (int i = 0; i < 16; ++i) { const int c2 = 16 * g + i, cl = c2 < c ? c2 : 0; ta[i] = TA[to_ + cl * 1024]; th[i] = TH[to_ + cl * 1024]; }
        }
        __syncthreads();
        if (uu + gn < nun) LRU_LOAD(uu + gn);
        f32x4 cu_[8]; const int itcc = itc < 7 ? itc : 7;
        if (CONV) {
            if (PASS == 1) { int uo_ = (F.vcu * 64 + itcc * 8 + w) * (D / 4) + lane; asm volatile("" : "+v"(uo_));
#pragma unroll
                for (int j = 0; j < 8; ++j) cu_[j] = ((const f32x4*)tab_u)[uo_ + 64 * j]; }
            else { int vo_ = (F.vcu * 64 + (tid >> 6)) * (D / 4) + itcc * 64 + (tid & 63); asm volatile("" : "+v"(vo_));
#pragma unroll
                for (int j = 0; j < 8; ++j) cu_[j] = ((const f32x4*)tab_v)[vo_ + 8 * j * (D / 4)]; }
        }
        f32x4 ca[4], cx[4];
#pragma unroll
        for (int m = 0; m < 4; ++m) { ca[m] = (f32x4){0.f, 0.f, 0.f, 0.f}; cx[m] = (f32x4){0.f, 0.f, 0.f, 0.f};
#pragma unroll
            for (int ks = 0; ks < 4; ++ks) { const bf16x8_l A = *(const LAS bf16x8_l*)(xs + (16 * m + l15) * XS + (32 * ks + 8 * g) * 2);
                const bf16x8_l Bak = *(const LAS bf16x8_l*)(wb + ks * 1024), Bxk = *(const LAS bf16x8_l*)(wb + (4 + ks) * 1024);
                ca[m] = __builtin_amdgcn_mfma_f32_16x16x32_bf16(A, Bak, ca[m], 0, 0, 0); cx[m] = __builtin_amdgcn_mfma_f32_16x16x32_bf16(A, Bxk, cx[m], 0, 0, 0); } }
        float av[4][4], bv[4][4];
#pragma unroll
        for (int m = 0; m < 4; ++m)
#pragma unroll
            for (int r = 0; r < 4; ++r) { const int tt = 16 * m + 4 * g + r;
                const float rg = 1.f / (1.f + __expf(-(ca[m][r] + ba))), ig = 1.f / (1.f + __expf(-(cx[m][r] + bx)));
                const float a = __expf(-sp8 * rg), xcv = bf2f(*(const LAS unsigned short*)(xs + tt * XS + (16 * w + l15) * 2));
                av[m][r] = a; bv[m][r] = sqrtf(fmaxf(1.f - a * a, 0.f)) * ig * xcv; }
        float carry = 0.f, Ac = 1.f;
        if (PASS == 2) {
            float Ap = 1.f, Hp = 0.f;
#pragma unroll
            for (int i = 0; i < 16; ++i) { const bool in_ = 16 * g + i < c; const float ta_ = in_ ? ta[i] : 1.f, th_ = in_ ? th[i] : 0.f; Hp = ta_ * Hp + th_; Ap *= ta_; }
            { const float A1 = __shfl_up(Ap, 16), H1 = __shfl_up(Hp, 16); if (g >= 1) { Hp = Ap * H1 + Hp; Ap = Ap * A1; } }
            { const float A2 = __shfl_up(Ap, 32), H2 = __shfl_up(Hp, 32); if (g >= 2) { Hp = Ap * H2 + Hp; Ap = Ap * A2; } }
            carry = __shfl(Hp, 48 + l15);
        }
#pragma unroll
        for (int m = 0; m < 4; ++m) {
            float As = (av[m][0] * av[m][1]) * (av[m][2] * av[m][3]);
            float Hs = ((bv[m][0] * av[m][1] + bv[m][1]) * av[m][2] + bv[m][2]) * av[m][3] + bv[m][3];
            { const float A1 = __shfl_up(As, 16), H1 = __shfl_up(Hs, 16); if (g >= 1) { Hs = As * H1 + Hs; As = As * A1; } }
            { const float A2 = __shfl_up(As, 32), H2 = __shfl_up(Hs, 32); if (g >= 2) { Hs = As * H2 + Hs; As = As * A2; } }
            const float At = __shfl(As, 48 + l15), Ht = __shfl(Hs, 48 + l15);
            if (PASS == 2) {
                float Ae = __shfl_up(As, 16), He = __shfl_up(Hs, 16); if (g == 0) { Ae = 1.f; He = 0.f; }
                float h = Ae * carry + He;
                int mo_ = (tok0 + 16 * m + 4 * g) * D + 1024 + chn; asm volatile("" : "+v"(mo_));
#pragma unroll
                for (int r = 0; r < 4; ++r) { h = av[m][r] * h + bv[m][r];
                    MIX[mo_ + r * D] = (bf16)f2bf(h * gelu_tanh(bf2f(xgv[4 * m + r]))); }
            }
            carry = At * carry + Ht; Ac *= At;
        }
        if (PASS == 1 && g == 0) { int so_ = (b * 64 + c) * 1024 + chn; asm volatile("" : "+v"(so_)); TA[so_] = Ac; TH[so_] = carry; }
        if (CONV && PASS == 1 && itc < 8) {
            const int e = F.vcu * 64 + itc * 8 + w; float am = 0.f;
#pragma unroll
            for (int j = 0; j < 8; ++j) am = fmaxf(fmaxf(am, fmaxf(fabsf(cu_[j].x), fabsf(cu_[j].y))), fmaxf(fabsf(cu_[j].z), fabsf(cu_[j].w)));
#pragma unroll
            for (int o = 1; o < 64; o <<= 1) am = fmaxf(am, __shfl_xor(am, o));
            const float qs = am > 0.f ? 127.f / am : 0.f;
            if (lane == 0) ((float*)(ws + WS_SU))[e] = am * (1.f / 127.f);
#pragma unroll
            for (int j = 0; j < 8; ++j) { const int cc_ = (lane + 64 * j) * 4;
                const unsigned q = ((unsigned)(int)rintf(cu_[j].x * qs) & 0xffu) | (((unsigned)(int)rintf(cu_[j].y * qs) & 0xffu) << 8) | (((unsigned)(int)rintf(cu_[j].z * qs) & 0xffu) << 16) | (((unsigned)(int)rintf(cu_[j].w * qs) & 0xffu) << 24);
                *(unsigned*)(ws + WS_U8 + ((size_t)(cc_ >> 7) * 16384 + e) * 128 + (cc_ & 127)) = q; }
        }
        if (CONV && PASS == 2) {
            LAS unsigned char* tl = F.lds + RING_OFF + 32768;
            int tq_ = tid; asm volatile("" : "+v"(tq_));
            if (itc < 8) { const int lo_ = ((4 * (tq_ & 63)) >> 3) * 512 + (tq_ >> 6) * 8 + ((4 * (tq_ & 63)) & 7);
#pragma unroll
                for (int j = 0; j < 8; ++j) *(LAS unsigned*)(tl + lo_ + 64 * j) = pk4_fp8(cu_[j].x, cu_[j].y, cu_[j].z, cu_[j].w); }
            __syncthreads();
            if (itc < 8) { const int cu2 = tq_ >> 5, pc = tq_ & 31;
#pragma unroll
                for (int j = 0; j < 2; ++j)
                    *(v4u*)(ws + WS_V8 + ((size_t)(itc * 32 + cu2 + 16 * j) * 16384 + F.vcu * 64) * 8 + pc * 16) = *(const LAS v4u*)(tl + (cu2 + 16 * j) * 512 + pc * 16); }
        }
        ++itc;
        __syncthreads();
    }
#undef LRU_LOAD
}
struct Args { const float* in[23]; float* out; unsigned char* ws; int ph_lo, ph_hi; };

__global__ void __launch_bounds__(NWAVES * 64, 2) skel_fwd(Args args) {
    extern __shared__ __attribute__((aligned(16))) unsigned char lds[];
    Frame F;
    F.lds = (LAS unsigned char*)lds;
    F.tid = threadIdx.x; F.lane = F.tid & 63; F.wave = __builtin_amdgcn_readfirstlane(F.tid >> 6);
    F.G = gridDim.x; { const int bx = blockIdx.x; F.vcu = (F.G % 8 == 0) ? (bx % 8) * (F.G / 8) + bx / 8 : bx; }
    unsigned char* ws = args.ws;
    const float* x = args.in[0];
    bf16* WIN_T = (bf16*)(ws + WS_WIN); bf16* WOUT_T = (bf16*)(ws + WS_WOUT); bf16* WQ_T = (bf16*)(ws + WS_WQ);
    bf16* XB = (bf16*)(ws + WS_XB); bf16* MIX = (bf16*)(ws + WS_MIX); bf16* QB = (bf16*)(ws + WS_Q); bf16* H1 = (bf16*)(ws + WS_H1);
    float* Y1 = (float*)(ws + WS_Y1); float* PQ = (float*)(ws + WS_PQ);
    for (int u = F.tid; u < (LDS_BYTES - LDSCTL_OFF) / 4; u += NWAVES * 64) ((LAS unsigned*)(F.lds + LDSCTL_OFF))[u] = 0u;
    __syncthreads();
    XcdBarrier bar = xcd_barrier_post((unsigned*)(ws + WS_CTL) + CW_BAR, (volatile LAS unsigned*)(F.lds + MISC_OFF) + 8);
    const unsigned phmask = (unsigned)args.ph_lo;
    int slot_ = 0;
#define IN(k) (false)
#define RUN(slotbit) ((phmask >> (slotbit)) & 1u)
#define GRID_BAR() do { if (phmask == 0xffffffffu) xcd_barrier(bar); } while (0)

    if (RUN(0)) {
        if (blockIdx.x == 0 && F.wave == 0) {
            float a_ = args.in[9][F.lane] * args.in[10][F.lane], b_ = args.in[11][F.lane] * args.in[12][F.lane];
#pragma unroll
            for (int o = 1; o < 64; o <<= 1) { a_ += __shfl_xor(a_, o); b_ += __shfl_xor(b_, o); }
            if (F.lane == 0) ((float*)(ws + WS_PRM))[0] = expf(a_) - expf(b_) + 0.2f;
        }
        LAS float* scr = (LAS float*)(F.lds + RING_OFF + F.wave * 16384);
        const int gw = F.vcu * NWAVES + F.wave, NGW = F.G * NWAVES;
        constexpr int I_IN = (D / 64) * (NIN / 32), I_SQ = (D / 64) * (D / 32);
        constexpr int NITEMS = I_IN + 2 * I_SQ;
        for (int it = gw; it < NITEMS; it += NGW) {
            int r = it;
            if (r < I_IN) { p0_transpose_item(args.in[1], D, NIN, WIN_T, 0, scr, r, F.lane); continue; } r -= I_IN;
            if (r < I_SQ) { p0_transpose_item(args.in[14], D, D, WOUT_T, 0, scr, r, F.lane); continue; } r -= I_SQ;
            p0_transpose_item(args.in[17], D, D, WQ_T, 0, scr, r, F.lane);
        }
        for (int it = gw; it < 128; it += NGW) { const int mt = it >> 3;
            p0_transpose_item(args.in[mt < 8 ? 4 : 6] + (size_t)(mt & 7) * 16384, 128, 128, (bf16*)(ws + WS_WG) + (size_t)mt * 16384, 0, scr, it & 7, F.lane); }
        {
            const float* sk = args.in[18]; v4u* SKH = (v4u*)(ws + WS_SKH); v4u* SKL = (v4u*)(ws + WS_SKL);
            for (int fi = gw; fi < 512; fi += NGW) { const int ds = fi & 7, kt = (fi >> 3) & 3, hp = fi >> 5;
                const float* src = sk + ((size_t)(hp * 128 + kt * 32 + (F.lane & 31)) * 128 + 16 * ds + 8 * (F.lane >> 5));
                bf16x8 h8, l8; split8(*(const f32x4*)src, *(const f32x4*)(src + 4), h8, l8);
                SKH[fi * 64 + F.lane] = __builtin_bit_cast(v4u, h8); SKL[fi * 64 + F.lane] = __builtin_bit_cast(v4u, l8); }
        }
        for (int m = gw; m < M; m += NGW) {
            const GAS f32x4* xr = (const GAS f32x4*)(x + (size_t)m * D) + F.lane;
            GAS unsigned long long* o8 = (GAS unsigned long long*)(XB + (size_t)m * D) + F.lane;
#pragma unroll
            for (int j = 0; j < 8; ++j) { const f32x4 v = xr[64 * j]; o8[64 * j] = (unsigned long long)pk2(v.x, v.y) | ((unsigned long long)pk2(v.z, v.w) << 32); }
        }
    }
    GRID_BAR();
    if (RUN(1)) {
        pg8::Gemm g{XB, WIN_T, M, NIN, D}; pg8::StaticOrder S; S.init(M, NIN, F.G, (int)blockIdx.x);
        pg8::EpiBf16<0> E{QB, AW, nullptr, AW, (size_t)(WS_K - WS_Q) / 2, C2};
        pg8::gemm_phase<pg8::EpiBf16<0>, pg8::StaticOrder, PG8_ALIGN, PG8_SP2>(F.lds + RING_OFF, g, S, E);
    }
    GRID_BAR();
    if (RUN(2)) {
        const bool fusedconv = (F.G == 256);
#pragma unroll 1
        for (int step = 0; step < 2; ++step) {
            if (fusedconv ? (step == 0) : (((step ^ F.vcu) & 1) == 0)) {
                if (fusedconv) lru_phase<1, true>(F, ws, args.in[2], args.in[3], args.in[5], args.in[7], args.in[8], args.in[19], args.in[20]);
                else lru_phase<1, false>(F, ws, args.in[2], args.in[3], args.in[5], args.in[7], args.in[8]);
                {
                    const int gw = F.vcu * NWAVES + F.wave, NGW = F.G * NWAVES, lane = F.lane; unsigned* ctlw = (unsigned*)(ws + WS_CTL);
                    for (int it = gw; it < 2 * (M / 16); it += NGW) { const int z = it & 1, r16 = it >> 1; const bf16* src = (const bf16*)(ws + (z ? WS_K : WS_Q)) + (size_t)r16 * 16 * AW + 8 * lane;
                        float mx0 = 0.f, mx1 = 0.f;
#pragma unroll 4
                        for (int r = 0; r < 16; ++r) {
#pragma unroll
                            for (int hf = 0; hf < 2; ++hf) { const v4u q = *(const v4u*)(src + (size_t)r * AW + hf * 512); float ss = 0.f;
#pragma unroll
                                for (int e = 0; e < 4; ++e) { const float lo = __uint_as_float(q[e] << 16), hi = __uint_as_float(q[e] & 0xffff0000u); ss += lo * lo + hi * hi; }
                                ss += __builtin_bit_cast(float, __builtin_amdgcn_update_dpp(0, __builtin_bit_cast(int, ss), 0xB1, 0xf, 0xf, true)); ss += __builtin_bit_cast(float, __builtin_amdgcn_update_dpp(0, __builtin_bit_cast(int, ss), 0x4E, 0xf, 0xf, true));
                                ss += __builtin_bit_cast(float, __builtin_amdgcn_update_dpp(0, __builtin_bit_cast(int, ss), 0x141, 0xf, 0xf, true));
                                if (hf == 0) mx0 = fmaxf(mx0, ss); else mx1 = fmaxf(mx1, ss); } }
                        if ((lane & 7) == 0) { unsigned* dst = ctlw + (z ? CW_NK : CW_NQ) + (r16 >> 2) * 16 + (lane >> 3); atomicMax(dst, __float_as_uint(mx0)); atomicMax(dst + 8, __float_as_uint(mx1)); }
                    }
                }
            } else if (!fusedconv) {
                for (int item = F.vcu; item < 512; item += F.G) {
                    if (item < 256) {
                        const float* us = args.in[19]; float* SU = (float*)(ws + WS_SU);
                        f32x4 uv[8];
                        { const f32x4* ur = (const f32x4*)(us + (size_t)(item * 64 + F.wave) * D);
#pragma unroll
                          for (int j = 0; j < 8; ++j) uv[j] = ur[F.lane + 64 * j]; }
                        for (int e = item * 64 + F.wave; e < item * 64 + 64; e += NWAVES) {
                            f32x4 un[8]; { const int en = e + NWAVES < item * 64 + 64 ? e + NWAVES : e; const f32x4* ur = (const f32x4*)(us + (size_t)en * D);
#pragma unroll
                              for (int j = 0; j < 8; ++j) un[j] = ur[F.lane + 64 * j]; }
                            float am = 0.f;
#pragma unroll
                            for (int j = 0; j < 8; ++j) am = fmaxf(fmaxf(am, fmaxf(fabsf(uv[j].x), fabsf(uv[j].y))), fmaxf(fabsf(uv[j].z), fabsf(uv[j].w)));
#pragma unroll
                            for (int o = 1; o < 64; o <<= 1) am = fmaxf(am, __shfl_xor(am, o));
                            const float qs = am > 0.f ? 127.f / am : 0.f;
                            if (F.lane == 0) SU[e] = am * (1.f / 127.f);
#pragma unroll
                            for (int j = 0; j < 8; ++j) { const int c = (F.lane + 64 * j) * 4;
                                const unsigned q = ((unsigned)(int)rintf(uv[j].x * qs) & 0xffu) | (((unsigned)(int)rintf(uv[j].y * qs) & 0xffu) << 8) | (((unsigned)(int)rintf(uv[j].z * qs) & 0xffu) << 16) | (((unsigned)(int)rintf(uv[j].w * qs) & 0xffu) << 24);
                                *(unsigned*)(ws + WS_U8 + ((size_t)(c >> 7) * 16384 + e) * 128 + (c & 127)) = q; }
#pragma unroll
                            for (int j = 0; j < 8; ++j) uv[j] = un[j];
                        }
                    } else {
                        const float* vs = args.in[20]; unsigned char* V8 = ws + WS_V8; LAS unsigned char* tl = F.lds + RING_OFF;
                        f32x4 vv[8];
                        { const int t = (item - 256) * 8, e0 = (t >> 3) * 64, c0 = (t & 7) * 256;
#pragma unroll
                          for (int j = 0; j < 8; ++j) { const int idx = F.tid + 512 * j, r = idx >> 6, c = 4 * (idx & 63); vv[j] = *(const f32x4*)(vs + (size_t)(e0 + r) * D + c0 + c); } }
                        for (int t = (item - 256) * 8; t < (item - 256) * 8 + 8; ++t) { const int e0 = (t >> 3) * 64, c0 = (t & 7) * 256;
                            f32x4 vn[8]; { const int tn = t + 1 < (item - 256) * 8 + 8 ? t + 1 : t, e1 = (tn >> 3) * 64, c1 = (tn & 7) * 256;
#pragma unroll
                              for (int j = 0; j < 8; ++j) { const int idx = F.tid + 512 * j, r = idx >> 6, c = 4 * (idx & 63); vn[j] = *(const f32x4*)(vs + (size_t)(e1 + r) * D + c1 + c); } }
                            __syncthreads();
#pragma unroll
                            for (int j = 0; j < 8; ++j) { const int idx = F.tid + 512 * j, r = idx >> 6, c = 4 * (idx & 63);
                                *(LAS unsigned*)(tl + (c >> 3) * 512 + r * 8 + (c & 7)) = pk4_fp8(vv[j].x, vv[j].y, vv[j].z, vv[j].w); }
                            __syncthreads();
#pragma unroll
                            for (int j = 0; j < 2; ++j) { const int cu = (F.tid >> 5) + 16 * j, pc = F.tid & 31;
                                *(v4u*)(V8 + ((size_t)((c0 >> 3) + cu) * 16384 + e0) * 8 + pc * 16) = *(const LAS v4u*)(tl + cu * 512 + pc * 16); }
#pragma unroll
                            for (int j = 0; j < 8; ++j) vv[j] = vn[j];
                        }
                    }
                }
                __syncthreads();
            }
        }
    }
    GRID_BAR();
    if (RUN(4)) {
        static_assert(datt::LDS_BYTES <= RING_BYTES, "attention LDS vs ring");
        const datt::Tensors DT{(const datt::bf16*)QB, (const datt::bf16*)(ws + WS_K), (const datt::bf16*)(ws + WS_V), (datt::bf16*)(ws + WS_O0), (datt::bf16*)(ws + WS_O1),
                               (const unsigned*)(ws + WS_CTL) + CW_NQ, (const unsigned*)(ws + WS_CTL) + CW_NK, (unsigned*)(ws + WS_CTL) + CW_AQ, datt_order};
        datt::datt_phase((char*)lds + RING_OFF, (volatile LAS unsigned*)(F.lds + MISC_OFF) + 16, DT);
    }
    if (RUN(5)) { if (F.G == 256) lru_phase<2, true>(F, ws, args.in[2], args.in[3], args.in[5], args.in[7], args.in[8], args.in[19], args.in[20]);
        else lru_phase<2, false>(F, ws, args.in[2], args.in[3], args.in[5], args.in[7], args.in[8]); }
    GRID_BAR();
    if (RUN(6)) {
        const int gw = F.vcu * NWAVES + F.wave, NGW = F.G * NWAVES, sub = F.lane >> 4, l16 = F.lane & 15;
        const float lam = ((const float*)(ws + WS_PRM))[0];
        const bf16* O0 = (const bf16*)(ws + WS_O0); const bf16* O1 = (const bf16*)(ws + WS_O1);
        float gs[8];
#pragma unroll
        for (int e = 0; e < 8; ++e) gs[e] = args.in[13][l16 * 8 + e] * 0.8f;
        for (int it = gw; it < M * 2; it += NGW) { const int item = it * 4 + sub, tok = item >> 3, h = item & 7;
            const v4u a = *(const v4u*)(O0 + (size_t)tok * AW + h * 128 + l16 * 8), b = *(const v4u*)(O1 + (size_t)tok * AW + h * 128 + l16 * 8);
            float d[8]; float ss = 0.f;
#pragma unroll
            for (int e = 0; e < 4; ++e) { d[2 * e] = __uint_as_float(a[e] << 16) - lam * __uint_as_float(b[e] << 16); d[2 * e + 1] = __uint_as_float(a[e] & 0xffff0000u) - lam * __uint_as_float(b[e] & 0xffff0000u); ss += d[2 * e] * d[2 * e] + d[2 * e + 1] * d[2 * e + 1]; }
            ss += __builtin_bit_cast(float, __builtin_amdgcn_update_dpp(0, __builtin_bit_cast(int, ss), 0xB1, 0xf, 0xf, true)); ss += __builtin_bit_cast(float, __builtin_amdgcn_update_dpp(0, __builtin_bit_cast(int, ss), 0x4E, 0xf, 0xf, true));
            ss += __builtin_bit_cast(float, __builtin_amdgcn_update_dpp(0, __builtin_bit_cast(int, ss), 0x141, 0xf, 0xf, true)); ss += __builtin_bit_cast(float, __builtin_amdgcn_update_dpp(0, __builtin_bit_cast(int, ss), 0x140, 0xf, 0xf, true));
            const float r = rsqrtf(ss * (1.f / 128.f) + LN_EPS);
            *(v4u*)(MIX + (size_t)tok * D + h * 128 + l16 * 8) = (v4u){pk2(d[0] * r * gs[0], d[1] * r * gs[1]), pk2(d[2] * r * gs[2], d[3] * r * gs[3]), pk2(d[4] * r * gs[4], d[5] * r * gs[5]), pk2(d[6] * r * gs[6], d[7] * r * gs[7])}; }
    }
    GRID_BAR();
    if (RUN(7)) {
        pg8::Gemm g{MIX, WOUT_T, M, D, D}; pg8::StaticOrder S; S.init(M, D, F.G, (int)blockIdx.x);
        pg8::EpiBf16<0> E{(bf16*)Y1, D, nullptr, 0, 0, 1.f};
        pg8::gemm_phase<pg8::EpiBf16<0>, pg8::StaticOrder, PG8_ALIGN, PG8_SP2>(F.lds + RING_OFF, g, S, E);
    }
    GRID_BAR();
    if (RUN(8)) {
        const int gw = F.vcu * NWAVES + F.wave, NGW = F.G * NWAVES; const float* g = args.in[15]; const float* bb = args.in[16];
        for (int row = gw; row < M; row += NGW) {
            const unsigned long long* xr_ = (const unsigned long long*)(XB + (size_t)row * D); const unsigned long long* yb = (const unsigned long long*)((const bf16*)Y1 + (size_t)row * D);
            f32x4 v[8]; float s = 0.f;
#pragma unroll
            for (int j = 0; j < 8; ++j) { const unsigned long long x_ = xr_[F.lane + 64 * j]; const unsigned x0 = (unsigned)x_, x1 = (unsigned)(x_ >> 32); const f32x4 xv_ = (f32x4){__uint_as_float(x0 << 16), __uint_as_float(x0 & 0xffff0000u), __uint_as_float(x1 << 16), __uint_as_float(x1 & 0xffff0000u)};
                const unsigned long long q_ = yb[F.lane + 64 * j]; const unsigned q0 = (unsigned)q_, q1 = (unsigned)(q_ >> 32);
                v[j].x = DN_ALPHA * xv_.x + __uint_as_float(q0 << 16); v[j].y = DN_ALPHA * xv_.y + __uint_as_float(q0 & 0xffff0000u); v[j].z = DN_ALPHA * xv_.z + __uint_as_float(q1 << 16); v[j].w = DN_ALPHA * xv_.w + __uint_as_float(q1 & 0xffff0000u);
                s += (v[j].x + v[j].y) + (v[j].z + v[j].w); }
#pragma unroll
            for (int o = 1; o < 64; o <<= 1) s += __shfl_xor(s, o);
            const float mean = s * (1.f / D); float s2 = 0.f;
#pragma unroll
            for (int j = 0; j < 8; ++j) { v[j] = v[j] - mean; s2 += (v[j].x * v[j].x + v[j].y * v[j].y) + (v[j].z * v[j].z + v[j].w * v[j].w); }
#pragma unroll
            for (int o = 1; o < 64; o <<= 1) s2 += __shfl_xor(s2, o);
            const float rstd = rsqrtf(s2 * (1.f / D) + LN_EPS);
#pragma unroll
            for (int j = 0; j < 8; ++j) { const int c = (F.lane + 64 * j) * 4; const f32x4 gg = *(const f32x4*)(g + c), bv = *(const f32x4*)(bb + c);
                const f32x4 o = v[j] * rstd * gg + bv;
                *(unsigned long long*)(H1 + (size_t)row * D + c) = (unsigned long long)pk2(o.x, o.y) | ((unsigned long long)pk2(o.z, o.w) << 32);
                v[j] = o; }
            float am = 0.f;
#pragma unroll
            for (int j = 0; j < 8; ++j) am = fmaxf(fmaxf(am, fmaxf(fabsf(v[j].x), fabsf(v[j].y))), fmaxf(fabsf(v[j].z), fabsf(v[j].w)));
#pragma unroll
            for (int o = 1; o < 64; o <<= 1) am = fmaxf(am, __shfl_xor(am, o));
            const float qs = am > 0.f ? 127.f / am : 0.f;
            if (F.lane == 0) ((float*)(ws + WS_SH))[row] = am * (1.f / 127.f);
#pragma unroll
            for (int j = 0; j < 8; ++j) { const int c = (F.lane + 64 * j) * 4;
                const unsigned q = ((unsigned)(int)rintf(v[j].x * qs) & 0xffu) | (((unsigned)(int)rintf(v[j].y * qs) & 0xffu) << 8) | (((unsigned)(int)rintf(v[j].z * qs) & 0xffu) << 16) | (((unsigned)(int)rintf(v[j].w * qs) & 0xffu) << 24);
                *(unsigned*)(ws + WS_H8 + ((size_t)(c >> 7) * M + row) * 128 + (c & 127)) = q; }
        }
    }
    GRID_BAR();
    if (RUN(9)) {
        pg8::Gemm g{H1, WQ_T, M, D, D}; pg8::StaticOrder S; S.init(M, D, F.G, (int)blockIdx.x);
        pg8::EpiBf16<0> E{(bf16*)PQ, D, nullptr, 0, 0, 1.f};
        pg8::gemm_phase<pg8::EpiBf16<0>, pg8::StaticOrder, PG8_ALIGN, PG8_SP2>(F.lds + RING_OFF, g, S, E);
    }
    GRID_BAR();
    if (RUN(10)) {
        const int nh = (F.G & 7) == 0 ? 8 : 1;
        int* E = (int*)(ws + WS_E); float* G = (float*)(ws + WS_G);
        for (int h = F.vcu % nh; h < 8; h += nh) {
            __syncthreads();
            {
                int tq = F.tid; asm volatile("" : "+v"(tq));
#pragma unroll 4
                for (int j = 0; j < 16; ++j) { const int i = tq + 512 * j, p = i >> 12, hl = (i >> 11) & 1, fl = i & 2047;
                    *(LAS v4u*)(F.lds + RING_OFF + (size_t)i * 16) = ((const v4u*)(ws + WS_SKH))[(size_t)hl * 65536 + (size_t)(h * 2 + p) * 2048 + fl]; }
            }
            __syncthreads();
            const int wv = (F.vcu / nh) * NWAVES + F.wave, nwv = ((F.G + nh - 1 - F.vcu % nh) / nh) * NWAVES;
            v4u qn[8];
#define ROUTE_LOADQ() do { _Pragma("unroll") for (int ds = 0; ds < 8; ++ds) qn[ds] = *(const v4u*)(qptr + 16 * ds); } while (0)
            const bf16* qptr = (const bf16*)PQ + (size_t)(wv * 32 + (F.lane & 31)) * D + h * 256 + 8 * (F.lane >> 5);
            if (wv < M / 32) ROUTE_LOADQ();
            for (int tg = wv; tg < M / 32; tg += nwv) { int ln_ = F.lane; asm volatile("" : "+v"(ln_));
                const int tl = ln_ & 31, hi = ln_ >> 5, tok = tg * 32 + tl;
                LAS unsigned char* scr = F.lds + RING_BYTES + 1024 + F.wave * 1024 + tl * 32;
                float sa[16], sb[16];
#pragma unroll
                for (int p = 0; p < 2; ++p) {
                    f32x16 sc[4];
#pragma unroll
                    for (int kt = 0; kt < 4; ++kt) sc[kt] = f32x16{};
#pragma unroll
                    for (int ds = 0; ds < 8; ++ds) { const bf16x8 qh = __builtin_bit_cast(bf16x8, qn[ds]);
#pragma unroll
                        for (int kt = 0; kt < 4; ++kt) { const bf16x8 ah = *(const LAS bf16x8*)(F.lds + RING_OFF + ((p * 2 + 0) * 32 + kt * 8 + ds) * 1024 + F.lane * 16), al = *(const LAS bf16x8*)(F.lds + RING_OFF + ((p * 2 + 1) * 32 + kt * 8 + ds) * 1024 + F.lane * 16);
                            sc[kt] = __builtin_amdgcn_mfma_f32_32x32x16_bf16(ah, qh, sc[kt], 0, 0, 0);
                            sc[kt] = __builtin_amdgcn_mfma_f32_32x32x16_bf16(al, qh, sc[kt], 0, 0, 0); } }
                    if (p == 0) { qptr += 128; ROUTE_LOADQ(); } else if (tg + nwv < M / 32) { qptr += (size_t)nwv * 32 * D - 128; ROUTE_LOADQ(); }
#pragma unroll
                    for (int kt = 0; kt < 4; ++kt)
#pragma unroll
                        for (int r = 0; r < 16; ++r) { const unsigned key = (unsigned)(kt * 32 + (r & 3) + 8 * (r >> 2) + 4 * hi); sc[kt][r] = __uint_as_float((__float_as_uint(sc[kt][r]) & ~127u) | (127u - key)); }
#define CE_(x, y) do { const float h_ = __builtin_fmaxf(x, y), l_ = __builtin_fminf(x, y); x = h_; y = l_; } while (0)
                    CE_(sc[0][0], sc[0][1]); CE_(sc[0][2], sc[0][3]); CE_(sc[0][0], sc[0][2]); CE_(sc[0][1], sc[0][3]); CE_(sc[0][1], sc[0][2]); CE_(sc[0][4], sc[0][5]); CE_(sc[0][6], sc[0][7]); CE_(sc[0][4], sc[0][6]); CE_(sc[0][5], sc[0][7]); CE_(sc[0][5], sc[0][6]); CE_(sc[0][0], sc[0][4]); CE_(sc[0][2], sc[0][6]); CE_(sc[0][2], sc[0][4]); CE_(sc[0][1], sc[0][5]); CE_(sc[0][3], sc[0][7]); CE_(sc[0][3], sc[0][5]); CE_(sc[0][1], sc[0][2]); CE_(sc[0][3], sc[0][4]); CE_(sc[0][5], sc[0][6]); CE_(sc[0][8], sc[0][9]); CE_(sc[0][10], sc[0][11]); CE_(sc[0][8], sc[0][10]); CE_(sc[0][9], sc[0][11]); CE_(sc[0][9], sc[0][10]); CE_(sc[0][12], sc[0][13]); CE_(sc[0][14], sc[0][15]); CE_(sc[0][12], sc[0][14]); CE_(sc[0][13], sc[0][15]); CE_(sc[0][13], sc[0][14]); CE_(sc[0][8], sc[0][12]); CE_(sc[0][10], sc[0][14]); CE_(sc[0][10], sc[0][12]); CE_(sc[0][9], sc[0][13]); CE_(sc[0][11], sc[0][15]); CE_(sc[0][11], sc[0][13]); CE_(sc[0][9], sc[0][10]); CE_(sc[0][11], sc[0][12]); CE_(sc[0][13], sc[0][14]); CE_(sc[0][0], sc[0][8]); CE_(sc[0][4], sc[0][12]); CE_(sc[0][4], sc[0][8]); CE_(sc[0][2], sc[0][10]); CE_(sc[0][6], sc[0][14]); CE_(sc[0][6], sc[0][10]); CE_(sc[0][2], sc[0][4]); CE_(sc[0][6], sc[0][8]); CE_(sc[0][10], sc[0][12]); CE_(sc[0][1], sc[0][9]); CE_(sc[0][5], sc[0][13]); CE_(sc[0][5], sc[0][9]); CE_(sc[0][3], sc[0][11]); CE_(sc[0][7], sc[0][15]); CE_(sc[0][7], sc[0][11]); CE_(sc[0][3], sc[0][5]); CE_(sc[0][7], sc[0][9]); CE_(sc[0][11], sc[0][13]); CE_(sc[0][1], sc[0][2]); CE_(sc[0][3], sc[0][4]); CE_(sc[0][5], sc[0][6]); CE_(sc[0][7], sc[0][8]); CE_(sc[0][9], sc[0][10]); CE_(sc[0][11], sc[0][12]); CE_(sc[0][13], sc[0][14]);
                    CE_(sc[1][0], sc[1][1]); CE_(sc[1][2], sc[1][3]); CE_(sc[1][0], sc[1][2]); CE_(sc[1][1], sc[1][3]); CE_(sc[1][1], sc[1][2]); CE_(sc[1][4], sc[1][5]); CE_(sc[1][6], sc[1][7]); CE_(sc[1][4], sc[1][6]); CE_(sc[1][5], sc[1][7]); CE_(sc[1][5], sc[1][6]); CE_(sc[1][0], sc[1][4]); CE_(sc[1][2], sc[1][6]); CE_(sc[1][2], sc[1][4]); CE_(sc[1][1], sc[1][5]); CE_(sc[1][3], sc[1][7]); CE_(sc[1][3], sc[1][5]); CE_(sc[1][1], sc[1][2]); CE_(sc[1][3], sc[1][4]); CE_(sc[1][5], sc[1][6]); CE_(sc[1][8], sc[1][9]); CE_(sc[1][10], sc[1][11]); CE_(sc[1][8], sc[1][10]); CE_(sc[1][9], sc[1][11]); CE_(sc[1][9], sc[1][10]); CE_(sc[1][12], sc[1][13]); CE_(sc[1][14], sc[1][15]); CE_(sc[1][12], sc[1][14]); CE_(sc[1][13], sc[1][15]); CE_(sc[1][13], sc[1][14]); CE_(sc[1][8], sc[1][12]); CE_(sc[1][10], sc[1][14]); CE_(sc[1][10], sc[1][12]); CE_(sc[1][9], sc[1][13]); CE_(sc[1][11], sc[1][15]); CE_(sc[1][11], sc[1][13]); CE_(sc[1][9], sc[1][10]); CE_(sc[1][11], sc[1][12]); CE_(sc[1][13], sc[1][14]); CE_(sc[1][0], sc[1][8]); CE_(sc[1][4], sc[1][12]); CE_(sc[1][4], sc[1][8]); CE_(sc[1][2], sc[1][10]); CE_(sc[1][6], sc[1][14]); CE_(sc[1][6], sc[1][10]); CE_(sc[1][2], sc[1][4]); CE_(sc[1][6], sc[1][8]); CE_(sc[1][10], sc[1][12]); CE_(sc[1][1], sc[1][9]); CE_(sc[1][5], sc[1][13]); CE_(sc[1][5], sc[1][9]); CE_(sc[1][3], sc[1][11]); CE_(sc[1][7], sc[1][15]); CE_(sc[1][7], sc[1][11]); CE_(sc[1][3], sc[1][5]); CE_(sc[1][7], sc[1][9]); CE_(sc[1][11], sc[1][13]); CE_(sc[1][1], sc[1][2]); CE_(sc[1][3], sc[1][4]); CE_(sc[1][5], sc[1][6]); CE_(sc[1][7], sc[1][8]); CE_(sc[1][9], sc[1][10]); CE_(sc[1][11], sc[1][12]); CE_(sc[1][13], sc[1][14]);
                    CE_(sc[2][0], sc[2][1]); CE_(sc[2][2], sc[2][3]); CE_(sc[2][0], sc[2][2]); CE_(sc[2][1], sc[2][3]); CE_(sc[2][1], sc[2][2]); CE_(sc[2][4], sc[2][5]); CE_(sc[2][6], sc[2][7]); CE_(sc[2][4], sc[2][6]); CE_(sc[2][5], sc[2][7]); CE_(sc[2][5], sc[2][6]); CE_(sc[2][0], sc[2][4]); CE_(sc[2][2], sc[2][6]); CE_(sc[2][2], sc[2][4]); CE_(sc[2][1], sc[2][5]); CE_(sc[2][3], sc[2][7]); CE_(sc[2][3], sc[2][5]); CE_(sc[2][1], sc[2][2]); CE_(sc[2][3], sc[2][4]); CE_(sc[2][5], sc[2][6]); CE_(sc[2][8], sc[2][9]); CE_(sc[2][10], sc[2][11]); CE_(sc[2][8], sc[2][10]); CE_(sc[2][9], sc[2][11]); CE_(sc[2][9], sc[2][10]); CE_(sc[2][12], sc[2][13]); CE_(sc[2][14], sc[2][15]); CE_(sc[2][12], sc[2][14]); CE_(sc[2][13], sc[2][15]); CE_(sc[2][13], sc[2][14]); CE_(sc[2][8], sc[2][12]); CE_(sc[2][10], sc[2][14]); CE_(sc[2][10], sc[2][12]); CE_(sc[2][9], sc[2][13]); CE_(sc[2][11], sc[2][15]); CE_(sc[2][11], sc[2][13]); CE_(sc[2][9], sc[2][10]); CE_(sc[2][11], sc[2][12]); CE_(sc[2][13], sc[2][14]); CE_(sc[2][0], sc[2][8]); CE_(sc[2][4], sc[2][12]); CE_(sc[2][4], sc[2][8]); CE_(sc[2][2], sc[2][10]); CE_(sc[2][6], sc[2][14]); CE_(sc[2][6], sc[2][10]); CE_(sc[2][2], sc[2][4]); CE_(sc[2][6], sc[2][8]); CE_(sc[2][10], sc[2][12]); CE_(sc[2][1], sc[2][9]); CE_(sc[2][5], sc[2][13]); CE_(sc[2][5], sc[2][9]); CE_(sc[2][3], sc[2][11]); CE_(sc[2][7], sc[2][15]); CE_(sc[2][7], sc[2][11]); CE_(sc[2][3], sc[2][5]); CE_(sc[2][7], sc[2][9]); CE_(sc[2][11], sc[2][13]); CE_(sc[2][1], sc[2][2]); CE_(sc[2][3], sc[2][4]); CE_(sc[2][5], sc[2][6]); CE_(sc[2][7], sc[2][8]); CE_(sc[2][9], sc[2][10]); CE_(sc[2][11], sc[2][12]); CE_(sc[2][13], sc[2][14]);
                    CE_(sc[3][0], sc[3][1]); CE_(sc[3][2], sc[3][3]); CE_(sc[3][0], sc[3][2]); CE_(sc[3][1], sc[3][3]); CE_(sc[3][1], sc[3][2]); CE_(sc[3][4], sc[3][5]); CE_(sc[3][6], sc[3][7]); CE_(sc[3][4], sc[3][6]); CE_(sc[3][5], sc[3][7]); CE_(sc[3][5], sc[3][6]); CE_(sc[3][0], sc[3][4]); CE_(sc[3][2], sc[3][6]); CE_(sc[3][2], sc[3][4]); CE_(sc[3][1], sc[3][5]); CE_(sc[3][3], sc[3][7]); CE_(sc[3][3], sc[3][5]); CE_(sc[3][1], sc[3][2]); CE_(sc[3][3], sc[3][4]); CE_(sc[3][5], sc[3][6]); CE_(sc[3][8], sc[3][9]); CE_(sc[3][10], sc[3][11]); CE_(sc[3][8], sc[3][10]); CE_(sc[3][9], sc[3][11]); CE_(sc[3][9], sc[3][10]); CE_(sc[3][12], sc[3][13]); CE_(sc[3][14], sc[3][15]); CE_(sc[3][12], sc[3][14]); CE_(sc[3][13], sc[3][15]); CE_(sc[3][13], sc[3][14]); CE_(sc[3][8], sc[3][12]); CE_(sc[3][10], sc[3][14]); CE_(sc[3][10], sc[3][12]); CE_(sc[3][9], sc[3][13]); CE_(sc[3][11], sc[3][15]); CE_(sc[3][11], sc[3][13]); CE_(sc[3][9], sc[3][10]); CE_(sc[3][11], sc[3][12]); CE_(sc[3][13], sc[3][14]); CE_(sc[3][0], sc[3][8]); CE_(sc[3][4], sc[3][12]); CE_(sc[3][4], sc[3][8]); CE_(sc[3][2], sc[3][10]); CE_(sc[3][6], sc[3][14]); CE_(sc[3][6], sc[3][10]); CE_(sc[3][2], sc[3][4]); CE_(sc[3][6], sc[3][8]); CE_(sc[3][10], sc[3][12]); CE_(sc[3][1], sc[3][9]); CE_(sc[3][5], sc[3][13]); CE_(sc[3][5], sc[3][9]); CE_(sc[3][3], sc[3][11]); CE_(sc[3][7], sc[3][15]); CE_(sc[3][7], sc[3][11]); CE_(sc[3][3], sc[3][5]); CE_(sc[3][7], sc[3][9]); CE_(sc[3][11], sc[3][13]); CE_(sc[3][1], sc[3][2]); CE_(sc[3][3], sc[3][4]); CE_(sc[3][5], sc[3][6]); CE_(sc[3][7], sc[3][8]); CE_(sc[3][9], sc[3][10]); CE_(sc[3][11], sc[3][12]); CE_(sc[3][13], sc[3][14]);
                    sc[0][0] = __builtin_fmaxf(sc[0][0], sc[1][15]); sc[0][1] = __builtin_fmaxf(sc[0][1], sc[1][14]); sc[0][2] = __builtin_fmaxf(sc[0][2], sc[1][13]); sc[0][3] = __builtin_fmaxf(sc[0][3], sc[1][12]); sc[0][4] = __builtin_fmaxf(sc[0][4], sc[1][11]); sc[0][5] = __builtin_fmaxf(sc[0][5], sc[1][10]); sc[0][6] = __builtin_fmaxf(sc[0][6], sc[1][9]); sc[0][7] = __builtin_fmaxf(sc[0][7], sc[1][8]); sc[0][8] = __builtin_fmaxf(sc[0][8], sc[1][7]); sc[0][9] = __builtin_fmaxf(sc[0][9], sc[1][6]); sc[0][10] = __builtin_fmaxf(sc[0][10], sc[1][5]); sc[0][11] = __builtin_fmaxf(sc[0][11], sc[1][4]); sc[0][12] = __builtin_fmaxf(sc[0][12], sc[1][3]); sc[0][13] = __builtin_fmaxf(sc[0][13], sc[1][2]); sc[0][14] = __builtin_fmaxf(sc[0][14], sc[1][1]); sc[0][15] = __builtin_fmaxf(sc[0][15], sc[1][0]);
                    CE_(sc[0][0], sc[0][8]); CE_(sc[0][1], sc[0][9]); CE_(sc[0][2], sc[0][10]); CE_(sc[0][3], sc[0][11]); CE_(sc[0][4], sc[0][12]); CE_(sc[0][5], sc[0][13]); CE_(sc[0][6], sc[0][14]); CE_(sc[0][7], sc[0][15]); CE_(sc[0][0], sc[0][4]); CE_(sc[0][1], sc[0][5]); CE_(sc[0][2], sc[0][6]); CE_(sc[0][3], sc[0][7]); CE_(sc[0][8], sc[0][12]); CE_(sc[0][9], sc[0][13]); CE_(sc[0][10], sc[0][14]); CE_(sc[0][11], sc[0][15]); CE_(sc[0][0], sc[0][2]); CE_(sc[0][1], sc[0][3]); CE_(sc[0][4], sc[0][6]); CE_(sc[0][5], sc[0][7]); CE_(sc[0][8], sc[0][10]); CE_(sc[0][9], sc[0][11]); CE_(sc[0][12], sc[0][14]); CE_(sc[0][13], sc[0][15]); CE_(sc[0][0], sc[0][1]); CE_(sc[0][2], sc[0][3]); CE_(sc[0][4], sc[0][5]); CE_(sc[0][6], sc[0][7]); CE_(sc[0][8], sc[0][9]); CE_(sc[0][10], sc[0][11]); CE_(sc[0][12], sc[0][13]); CE_(sc[0][14], sc[0][15]);
                    sc[2][0] = __builtin_fmaxf(sc[2][0], sc[3][15]); sc[2][1] = __builtin_fmaxf(sc[2][1], sc[3][14]); sc[2][2] = __builtin_fmaxf(sc[2][2], sc[3][13]); sc[2][3] = __builtin_fmaxf(sc[2][3], sc[3][12]); sc[2][4] = __builtin_fmaxf(sc[2][4], sc[3][11]); sc[2][5] = __builtin_fmaxf(sc[2][5], sc[3][10]); sc[2][6] = __builtin_fmaxf(sc[2][6], sc[3][9]); sc[2][7] = __builtin_fmaxf(sc[2][7], sc[3][8]); sc[2][8] = __builtin_fmaxf(sc[2][8], sc[3][7]); sc[2][9] = __builtin_fmaxf(sc[2][9], sc[3][6]); sc[2][10] = __builtin_fmaxf(sc[2][10], sc[3][5]); sc[2][11] = __builtin_fmaxf(sc[2][11], sc[3][4]); sc[2][12] = __builtin_fmaxf(sc[2][12], sc[3][3]); sc[2][13] = __builtin_fmaxf(sc[2][13], sc[3][2]); sc[2][14] = __builtin_fmaxf(sc[2][14], sc[3][1]); sc[2][15] = __builtin_fmaxf(sc[2][15], sc[3][0]);
                    CE_(sc[2][0], sc[2][8]); CE_(sc[2][1], sc[2][9]); CE_(sc[2][2], sc[2][10]); CE_(sc[2][3], sc[2][11]); CE_(sc[2][4], sc[2][12]); CE_(sc[2][5], sc[2][13]); CE_(sc[2][6], sc[2][14]); CE_(sc[2][7], sc[2][15]); CE_(sc[2][0], sc[2][4]); CE_(sc[2][1], sc[2][5]); CE_(sc[2][2], sc[2][6]); CE_(sc[2][3], sc[2][7]); CE_(sc[2][8], sc[2][12]); CE_(sc[2][9], sc[2][13]); CE_(sc[2][10], sc[2][14]); CE_(sc[2][11], sc[2][15]); CE_(sc[2][0], sc[2][2]); CE_(sc[2][1], sc[2][3]); CE_(sc[2][4], sc[2][6]); CE_(sc[2][5], sc[2][7]); CE_(sc[2][8], sc[2][10]); CE_(sc[2][9], sc[2][11]); CE_(sc[2][12], sc[2][14]); CE_(sc[2][13], sc[2][15]); CE_(sc[2][0], sc[2][1]); CE_(sc[2][2], sc[2][3]); CE_(sc[2][4], sc[2][5]); CE_(sc[2][6], sc[2][7]); CE_(sc[2][8], sc[2][9]); CE_(sc[2][10], sc[2][11]); CE_(sc[2][12], sc[2][13]); CE_(sc[2][14], sc[2][15]);
                    sc[0][0] = __builtin_fmaxf(sc[0][0], sc[2][15]); sc[0][1] = __builtin_fmaxf(sc[0][1], sc[2][14]); sc[0][2] = __builtin_fmaxf(sc[0][2], sc[2][13]); sc[0][3] = __builtin_fmaxf(sc[0][3], sc[2][12]); sc[0][4] = __builtin_fmaxf(sc[0][4], sc[2][11]); sc[0][5] = __builtin_fmaxf(sc[0][5], sc[2][10]); sc[0][6] = __builtin_fmaxf(sc[0][6], sc[2][9]); sc[0][7] = __builtin_fmaxf(sc[0][7], sc[2][8]); sc[0][8] = __builtin_fmaxf(sc[0][8], sc[2][7]); sc[0][9] = __builtin_fmaxf(sc[0][9], sc[2][6]); sc[0][10] = __builtin_fmaxf(sc[0][10], sc[2][5]); sc[0][11] = __builtin_fmaxf(sc[0][11], sc[2][4]); sc[0][12] = __builtin_fmaxf(sc[0][12], sc[2][3]); sc[0][13] = __builtin_fmaxf(sc[0][13], sc[2][2]); sc[0][14] = __builtin_fmaxf(sc[0][14], sc[2][1]); sc[0][15] = __builtin_fmaxf(sc[0][15], sc[2][0]);
                    CE_(sc[0][0], sc[0][8]); CE_(sc[0][1], sc[0][9]); CE_(sc[0][2], sc[0][10]); CE_(sc[0][3], sc[0][11]); CE_(sc[0][4], sc[0][12]); CE_(sc[0][5], sc[0][13]); CE_(sc[0][6], sc[0][14]); CE_(sc[0][7], sc[0][15]); CE_(sc[0][0], sc[0][4]); CE_(sc[0][1], sc[0][5]); CE_(sc[0][2], sc[0][6]); CE_(sc[0][3], sc[0][7]); CE_(sc[0][8], sc[0][12]); CE_(sc[0][9], sc[0][13]); CE_(sc[0][10], sc[0][14]); CE_(sc[0][11], sc[0][15]); CE_(sc[0][0], sc[0][2]); CE_(sc[0][1], sc[0][3]); CE_(sc[0][4], sc[0][6]); CE_(sc[0][5], sc[0][7]); CE_(sc[0][8], sc[0][10]); CE_(sc[0][9], sc[0][11]); CE_(sc[0][12], sc[0][14]); CE_(sc[0][13], sc[0][15]); CE_(sc[0][0], sc[0][1]); CE_(sc[0][2], sc[0][3]); CE_(sc[0][4], sc[0][5]); CE_(sc[0][6], sc[0][7]); CE_(sc[0][8], sc[0][9]); CE_(sc[0][10], sc[0][11]); CE_(sc[0][12], sc[0][13]); CE_(sc[0][14], sc[0][15]);
                    { float la[16], lb[16];
#pragma unroll
                      for (int i = 0; i < 16; ++i) { auto rr = __builtin_amdgcn_permlane32_swap(__float_as_uint(sc[0][i]), __float_as_uint(sc[0][i]), false, false); la[i] = __uint_as_float(rr[0]); lb[i] = __uint_as_float(rr[1]); }
#pragma unroll
                      for (int i = 0; i < 16; ++i) la[i] = __builtin_fmaxf(la[i], lb[15 - i]);
                      CE_(la[0], la[8]); CE_(la[1], la[9]); CE_(la[2], la[10]); CE_(la[3], la[11]); CE_(la[4], la[12]); CE_(la[5], la[13]); CE_(la[6], la[14]); CE_(la[7], la[15]); CE_(la[0], la[4]); CE_(la[1], la[5]); CE_(la[2], la[6]); CE_(la[3], la[7]); CE_(la[8], la[12]); CE_(la[9], la[13]); CE_(la[10], la[14]); CE_(la[11], la[15]); CE_(la[0], la[2]); CE_(la[1], la[3]); CE_(la[4], la[6]); CE_(la[5], la[7]); CE_(la[8], la[10]); CE_(la[9], la[11]); CE_(la[12], la[14]); CE_(la[13], la[15]); CE_(la[0], la[1]); CE_(la[2], la[3]); CE_(la[4], la[5]); CE_(la[6], la[7]); CE_(la[8], la[9]); CE_(la[10], la[11]); CE_(la[12], la[13]); CE_(la[14], la[15]);
#pragma unroll
                      for (int i = 0; i < 16; ++i) { if (p == 0) sa[i] = la[i]; else sb[i] = la[i]; } }
#undef CE_
                }
                { unsigned w[4];
    #pragma unroll
                  for (int q = 0; q < 4; ++q) { w[q] = 0u;
    #pragma unroll
                      for (int e = 0; e < 4; ++e) { const unsigned ka = 127u - (__float_as_uint(sa[4 * q + e]) & 127u), kb = 127u - (__float_as_uint(sb[4 * q + e]) & 127u); w[q] |= (hi ? kb : ka) << (8 * e); } }
                  *(LAS v4u*)(scr + 16 * hi) = (v4u){w[0], w[1], w[2], w[3]}; }
                float cd[25];
    #define CV_(i, j) __uint_as_float((__float_as_uint(sa[i] + sb[j]) & ~255u) | (255u - (unsigned)(16 * (i) + (j))))
                cd[0] = hi ? CV_(0, 1) : CV_(0, 0);
                cd[1] = hi ? CV_(0, 3) : CV_(0, 2);
                cd[2] = hi ? CV_(0, 5) : CV_(0, 4);
                cd[3] = hi ? CV_(0, 7) : CV_(0, 6);
                cd[4] = hi ? CV_(0, 9) : CV_(0, 8);
                cd[5] = hi ? CV_(0, 11) : CV_(0, 10);
                cd[6] = hi ? CV_(0, 13) : CV_(0, 12);
                cd[7] = hi ? CV_(0, 15) : CV_(0, 14);
                cd[8] = hi ? CV_(1, 1) : CV_(1, 0);
                cd[9] = hi ? CV_(1, 3) : CV_(1, 2);
                cd[10] = hi ? CV_(1, 5) : CV_(1, 4);
                cd[11] = hi ? CV_(1, 7) : CV_(1, 6);
                cd[12] = hi ? CV_(2, 1) : CV_(2, 0);
                cd[13] = hi ? CV_(2, 3) : CV_(2, 2);
                cd[14] = hi ? CV_(3, 0) : CV_(2, 4);
                cd[15] = hi ? CV_(3, 2) : CV_(3, 1);
                cd[16] = hi ? CV_(4, 0) : CV_(3, 3);
                cd[17] = hi ? CV_(4, 2) : CV_(4, 1);
                cd[18] = hi ? CV_(5, 1) : CV_(5, 0);
                cd[19] = hi ? CV_(6, 1) : CV_(6, 0);
                cd[20] = hi ? CV_(7, 1) : CV_(7, 0);
                cd[21] = hi ? CV_(9, 0) : CV_(8, 0);
                cd[22] = hi ? CV_(11, 0) : CV_(10, 0);
                cd[23] = hi ? CV_(13, 0) : CV_(12, 0);
                cd[24] = hi ? CV_(15, 0) : CV_(14, 0);
    #undef CV_
                float top[16];
    #pragma unroll
                for (int rd = 0; rd < 16; ++rd) {
                    float m = cd[0];
    #pragma unroll
                    for (int n = 1; n + 1 < 25; n += 2) m = max3f_(m, cd[n], cd[n + 1]);
                    const float gm = pair_max(m); top[rd] = gm;
    #pragma unroll
                    for (int n = 0; n < 25; ++n) cd[n] = (__float_as_uint(cd[n]) == __float_as_uint(gm)) ? -INFINITY : cd[n];
                }
                float ex[16], sum = 0.f;
    #pragma unroll
                for (int r = 0; r < 16; ++r) { ex[r] = __builtin_amdgcn_exp2f((top[r] - top[0]) * LOG2E); sum += ex[r]; }
                const float inv = 1.f / sum;
                asm volatile("s_waitcnt lgkmcnt(0)" ::: "memory");
                int eo[8]; float go[8];
    #pragma unroll
                for (int rr = 0; rr < 8; ++rr) { float t0 = top[rr], t1 = top[rr + 8], e0 = ex[rr], e1 = ex[rr + 8]; asm volatile("" : "+v"(t0), "+v"(t1), "+v"(e0), "+v"(e1));
                    const unsigned f = 255u - (__float_as_uint(hi ? t1 : t0) & 255u);
                    const int ia = scr[f >> 4], ib = scr[16 + (f & 15)]; eo[rr] = ia * 128 + ib; go[rr] = (hi ? e1 : e0) * inv; }
                int* ep = E + (size_t)tok * 128 + h * 16 + 8 * hi; float* gp = G + (size_t)tok * 128 + h * 16 + 8 * hi;
                *(v4u*)ep = (v4u){(unsigned)eo[0], (unsigned)eo[1], (unsigned)eo[2], (unsigned)eo[3]}; *(v4u*)(ep + 4) = (v4u){(unsigned)eo[4], (unsigned)eo[5], (unsigned)eo[6], (unsigned)eo[7]};
                *(f32x4*)gp = (f32x4){go[0], go[1], go[2], go[3]}; *(f32x4*)(gp + 4) = (f32x4){go[4], go[5], go[6], go[7]};
                asm volatile("s_waitcnt lgkmcnt(0)" ::: "memory");
            }
        }
#undef ROUTE_LOADQ
    }
    GRID_BAR();
    if (RUN(11)) {
        const int nlab = F.G < 8 ? F.G : 8, label = (int)blockIdx.x % nlab, nblk = (F.G - label + nlab - 1) / nlab, wx = ((int)blockIdx.x / nlab) * NWAVES + F.wave, nwx = nblk * NWAVES;
        const int lane = F.lane, rr = lane >> 3, cc = lane & 7;
        const int* E = (const int*)(ws + WS_E);
        for (int sl = label; sl < 16; sl += nlab) {
            const unsigned char* Us = ws + WS_U8 + (size_t)sl * 16384 * 128 + 16 * cc;
            const unsigned char* Hs = ws + WS_H8 + (size_t)sl * M * 128 + 16 * cc;
            for (int item = wx; item < M / 8; item += nwx) { const int tok = item * 8 + rr;
                const v4u hq = *(const v4u*)(Hs + (size_t)tok * 128);
                const v4u* ep = (const v4u*)(E + (size_t)tok * 128);
                int res[16];
#pragma unroll
                for (int i = 0; i < 16; ++i) res[i] = 0;
#pragma unroll
                for (int i = 0; i < 16; ++i) {
                    const v4u e0 = ep[2 * i], e1 = ep[2 * i + 1];
#pragma unroll
                    for (int j = 0; j < 8; ++j) { const unsigned e = j < 4 ? e0[j & 3] : e1[j & 3];
                        const v4u a = *(const v4u*)(Us + (size_t)e * 128);
                        int d = __builtin_amdgcn_sdot4((int)a.x, (int)hq.x, 0, false); d = __builtin_amdgcn_sdot4((int)a.y, (int)hq.y, d, false); d = __builtin_amdgcn_sdot4((int)a.z, (int)hq.z, d, false); d = __builtin_amdgcn_sdot4((int)a.w, (int)hq.w, d, false);
                        d += __builtin_amdgcn_update_dpp(0, d, 0xB1, 0xf, 0xf, true); d += __builtin_amdgcn_update_dpp(0, d, 0x4E, 0xf, 0xf, true); d += __builtin_amdgcn_update_dpp(0, d, 0x141, 0xf, 0xf, true);
                        res[i] = (cc == j) ? d : res[i]; } }
                v4u* po = (v4u*)((short*)(ws + WS_PART) + (size_t)sl * M * 128 + (size_t)tok * 128 + cc * 16);
                unsigned pw[8];
#pragma unroll
                for (int q = 0; q < 8; ++q) pw[q] = ((unsigned)((res[2 * q] + 32) >> 6) & 0xffffu) | ((unsigned)((res[2 * q + 1] + 32) >> 6) << 16);
                po[0] = (v4u){pw[0], pw[1], pw[2], pw[3]}; po[1] = (v4u){pw[4], pw[5], pw[6], pw[7]};
            }
        }
    }
    GRID_BAR();
    if (RUN(12)) {
        const short* P = (const short*)(ws + WS_PART); const int* E = (const int*)(ws + WS_E); const float* G = (const float*)(ws + WS_G); unsigned* PK = (unsigned*)(ws + WS_PK);
        const float* SU = (const float*)(ws + WS_SU); const float* SH = (const float*)(ws + WS_SH);
        for (int idx = F.vcu * 512 + F.tid; idx < M * 128; idx += F.G * 512) { const int tok = idx >> 7, k = idx & 127; const size_t pi = (size_t)tok * 128 + (k & 7) * 16 + (k >> 3); int hsum = 0;
#pragma unroll
            for (int sl = 0; sl < 16; ++sl) hsum += (int)P[(size_t)sl * M * 128 + pi];
            const int e = E[idx];
            const float w = G[idx] * gelu_tanh((float)hsum * 64.f * SU[e] * SH[tok]);
            PK[(size_t)(tok >> 6) * 8192 + (k >> 2) * 256 + (tok & 63) * 4 + (k & 3)] = (unsigned)e | (f2bf(w) << 16); }
    }
    GRID_BAR();
    if (RUN(13)) {
        const unsigned* PK = (const unsigned*)(ws + WS_PK); bf16* FFN = (bf16*)(ws + WS_FFN);
        for (int c = F.vcu; c < 256; c += F.G) {
            __syncthreads();
            { int tq = F.tid; asm volatile("" : "+v"(tq)); const v4u* src = (const v4u*)(ws + WS_V8 + (size_t)c * 131072) + tq;
#pragma unroll 4
              for (int j = 0; j < 16; ++j) *(LAS v4u*)(F.lds + RING_OFF + (tq + 512 * j) * 16) = src[512 * j]; }
            __syncthreads();
            for (int tb = F.wave; tb < M / 64; tb += NWAVES) { int ln_ = F.lane; asm volatile("" : "+v"(ln_));
                const v4u* pk = (const v4u*)(PK + (size_t)tb * 8192) + ln_;
                f32x2v av[4];
#pragma unroll
                for (int i = 0; i < 4; ++i) av[i] = (f32x2v){0.f, 0.f};
                v4u pb[32];
#pragma unroll
                for (int kq = 0; kq < 32; ++kq) pb[kq] = pk[kq * 64];
#pragma unroll
                for (int kq = 0; kq < 32; ++kq) { const v4u p4 = pb[kq];
#pragma unroll
                    for (int j = 0; j < 4; ++j) { const unsigned p = p4[j]; const float w = __uint_as_float(p & 0xffff0000u); const f32x2v ww = (f32x2v){w, w};
                        const unsigned long long d = *(const LAS unsigned long long*)(F.lds + RING_OFF + ((p & 0xffffu) << 3));
                        const int d0 = (int)(unsigned)d, d1 = (int)(unsigned)(d >> 32);
                        av[0] = av[0] + __builtin_amdgcn_cvt_pk_f32_fp8(d0, false) * ww; av[1] = av[1] + __builtin_amdgcn_cvt_pk_f32_fp8(d0, true) * ww;
                        av[2] = av[2] + __builtin_amdgcn_cvt_pk_f32_fp8(d1, false) * ww; av[3] = av[3] + __builtin_amdgcn_cvt_pk_f32_fp8(d1, true) * ww; } }
                *(v4u*)(FFN + (size_t)(tb * 64 + ln_) * D + 8 * c) = (v4u){pk2(av[0].x, av[0].y), pk2(av[1].x, av[1].y), pk2(av[2].x, av[2].y), pk2(av[3].x, av[3].y)};
            }
        }
        __syncthreads();
    }
    GRID_BAR();
    if (RUN(14)) {
        const int gw = F.vcu * NWAVES + F.wave, NGW = F.G * NWAVES, lane = F.lane; const float* g2 = args.in[21]; const float* b2 = args.in[22]; float* out = args.out; const bf16* FFN = (const bf16*)(ws + WS_FFN);
        for (int row = gw; row < M; row += NGW) {
            f32x4 v[8]; float sm = 0.f;
#pragma unroll
            for (int j = 0; j < 8; ++j) { const int c = (lane + 64 * j) * 4; const unsigned long long hq = *(const unsigned long long*)(H1 + (size_t)row * D + c), fq = *(const unsigned long long*)(FFN + (size_t)row * D + c);
                const unsigned h0 = (unsigned)hq, h1_ = (unsigned)(hq >> 32), f0 = (unsigned)fq, f1 = (unsigned)(fq >> 32);
                v[j].x = DN_ALPHA * __uint_as_float(h0 << 16) + __uint_as_float(f0 << 16); v[j].y = DN_ALPHA * __uint_as_float(h0 & 0xffff0000u) + __uint_as_float(f0 & 0xffff0000u);
                v[j].z = DN_ALPHA * __uint_as_float(h1_ << 16) + __uint_as_float(f1 << 16); v[j].w = DN_ALPHA * __uint_as_float(h1_ & 0xffff0000u) + __uint_as_float(f1 & 0xffff0000u);
                sm += (v[j].x + v[j].y) + (v[j].z + v[j].w); }
#pragma unroll
            for (int o = 1; o < 64; o <<= 1) sm += __shfl_xor(sm, o);
            const float mean = sm * (1.f / D); float s2 = 0.f;
#pragma unroll
            for (int j = 0; j < 8; ++j) { v[j] = v[j] - mean; s2 += (v[j].x * v[j].x + v[j].y * v[j].y) + (v[j].z * v[j].z + v[j].w * v[j].w); }
#pragma unroll
            for (int o = 1; o < 64; o <<= 1) s2 += __shfl_xor(s2, o);
            const float rstd = rsqrtf(s2 * (1.f / D) + LN_EPS);
#pragma unroll
            for (int j = 0; j < 8; ++j) { const int c = (lane + 64 * j) * 4; *(f32x4*)(out + (size_t)row * D + c) = v[j] * rstd * *(const f32x4*)(g2 + c) + *(const f32x4*)(b2 + c); }
        }
    }
#undef IN
#undef RUN
#undef GRID_BAR
}

extern "C" void kernel_launch(void* const* d_in, const int* in_sizes, int n_in, void* d_out, int out_size, void* d_ws, size_t ws_size, hipStream_t stream) {
    static int grid = 0;
    if (grid == 0) {
        if (n_in != 23 || in_sizes[0] != M * D || out_size != M * D || ws_size < WS_END) { fprintf(stderr, "kernel_launch: unexpected shapes n_in %d in0 %d out %d ws %zu\n", n_in, n_in > 0 ? in_sizes[0] : -1, out_size, ws_size); grid = -1; return; }
        int dev = 0, cus = 0;
        if (hipGetDevice(&dev) != hipSuccess || hipDeviceGetAttribute(&cus, hipDeviceAttributeMultiprocessorCount, dev) != hipSuccess) { grid = -1; return; }
        if (hipFuncSetAttribute((const void*)skel_fwd, hipFuncAttributeMaxDynamicSharedMemorySize, LDS_BYTES) != hipSuccess) { grid = -1; return; }
        grid = cus;
    }
    if (grid < 0) return;
    (void)hipMemsetAsync((char*)d_ws + WS_CTL, 0, CTL_ZERO_BYTES, stream);
    Args a{};
    for (int i = 0; i < 23; ++i) a.in[i] = (const float*)d_in[i];
    a.out = (float*)d_out; a.ws = (unsigned char*)d_ws;
    unsigned char* ws = (unsigned char*)d_ws;
    const float* const* in = (const float* const*)d_in;
    float* prm = (float*)(ws + WS_PRM);
    bf16 *Q = (bf16*)(ws + WS_Q), *K = (bf16*)(ws + WS_K), *V = (bf16*)(ws + WS_V), *XR = (bf16*)(ws + WS_XR), *XG = (bf16*)(ws + WS_XG), *MIX = (bf16*)(ws + WS_MIX), *H1 = (bf16*)(ws + WS_H1);
    float *LA = (float*)(ws + WS_LA), *LB = (float*)(ws + WS_LB), *Y1 = (float*)(ws + WS_Y1), *PQ = (float*)(ws + WS_PQ), *G = (float*)(ws + WS_G); int* E = (int*)(ws + WS_E);
#ifndef MK_MULTI
    a.ph_lo = -1; a.ph_hi = 0; hipLaunchKernelGGL(skel_fwd, dim3(grid), dim3(NWAVES * 64), LDS_BYTES, stream, a);
#else
    for (int sl = 0; sl < 15; ++sl) { a.ph_lo = 1 << sl; a.ph_hi = 0; hipLaunchKernelGGL(skel_fwd, dim3(grid), dim3(NWAVES * 64), LDS_BYTES, stream, a); }
#endif
}
```

```cpp
#include <hip/hip_runtime.h>
#include <cstdio>
#include <cstdint>
namespace pg8 {
#define PG8_LAS __attribute__((address_space(3)))
typedef unsigned short bf16_t;
typedef short bf16x8 __attribute__((ext_vector_type(8)));
typedef float f32x4 __attribute__((ext_vector_type(4)));
typedef unsigned u32x4 __attribute__((ext_vector_type(4)));
constexpr int BM = 256, BK = 64, HALF = 128, HTB = HALF * BK * 2  , STAGE_BYTES = 8 * HTB, NXCD = 8, WGM = 8;

__host__ __device__ __forceinline__ int lds_byte(int r, int c) { const int st = (r >> 4) * 2 + (c >> 5), rr = r & 15, cc = c & 31, ob = rr * 64 + cc * 2; return st * 1024 + (ob ^ (((ob >> 9) & 1) << 5)); }
__host__ __device__ __forceinline__ void stage_rc(int b, int& R, int& C) { const int st = b / 1024, sb = b % 1024, swz = sb ^ (((sb >> 9) & 1) << 5); R = (st >> 1) * 16 + swz / 64; C = (st & 1) * 32 + (swz % 64) / 2; }
__host__ __device__ __forceinline__ int perm32(int rho) { const int n = rho >> 4, i = rho & 15; return 8 * (i >> 2) + 4 * n + (i & 3); }

struct Unit { int pm, pn; };
struct Gemm { const bf16_t* A; const bf16_t* Bt; int M, N, K; };

struct StaticOrder {
    int nM, nN, nwg, G, c;
    __host__ __device__ void init(int M, int N, int G_, int c_) { nM = M / BM; nN = N / BM; nwg = nM * nN; G = G_; c = c_; }
    __host__ __device__ bool next(int i, Unit& u) const {
        const long L = (long)i * G + c; if (L >= nwg) return false;
        int wgid = (int)L; { const int q = nwg / NXCD, r = nwg % NXCD, xcd = wgid % NXCD, off = wgid / NXCD; wgid = (xcd < r ? xcd * (q + 1) : r * (q + 1) + (xcd - r) * q) + off; }
        const int nig = WGM * nN, gid = wgid / nig, fm = gid * WGM, gsz = (nM - fm) < WGM ? (nM - fm) : WGM;
        u.pm = fm + ((wgid % nig) % gsz); u.pn = (wgid % nig) / gsz; return true;
    }
    __device__ __forceinline__ void a_ready(const Unit&) const {}
    __device__ __forceinline__ void done(const Unit&) const {}
};

__device__ __forceinline__ unsigned cvt_pk_bf16(float lo, float hi) { unsigned r; asm volatile("v_cvt_pk_bf16_f32 %0, %1, %2" : "=v"(r) : "v"(lo), "v"(hi)); return r; }
typedef float f32x2 __attribute__((ext_vector_type(2)));
__device__ __forceinline__ f32x2 gelu_pk(f32x2 v) {
    const f32x2 av = __builtin_elementwise_abs(v), d = av * 0.2316418882f + 1.0f;
    f32x2 t; t.x = __builtin_amdgcn_rcpf(d.x); t.y = __builtin_amdgcn_rcpf(d.y);
    f32x2 q = t * 0.5307027145f + (-0.7265760135f); q = q * t + 0.7107068705f; q = q * t + (-0.142248368f); q = q * t + 0.127414796f; q = q * t;
    const f32x2 s = (v * v) * (-0.72134752044f);
    f32x2 e; e.x = __builtin_amdgcn_exp2f(s.x); e.y = __builtin_amdgcn_exp2f(s.y);
    const f32x2 m = v * (q * e), r = v - m;
    f32x2 o; o.x = v.x < 0.f ? m.x : r.x; o.y = v.y < 0.f ? m.y : r.y; return o;
}

template <int ACT  > struct EpiBf16 {
    static constexpr bool PERM = true, AFTER_DRAIN = false; static_assert(ACT == 0 || ACT == 1, "EpiBf16: ACT is 0 (none) or 1 (gelu_pk)");
    bf16_t* O; int ldc; const float* bias; int split_cols; size_t split_stride; float scale0;
    __device__ __forceinline__ void operator()(const f32x4 (&acc)[2][2][4][2], const Unit& u, int wr, int wc, int fr, int fq) const {
        const int row0 = u.pm * BM + wr * 64 + fr; int colt = u.pn * BM; bf16_t* base = O;
        float sc = 1.f; if (split_cols) { const int t = colt / split_cols; base += (size_t)t * split_stride; colt -= t * split_cols; if (t == 0) sc = scale0; }
        const int col0 = colt + wc * 32 + 8 * fq, bcol0 = u.pn * BM + wc * 32 + 8 * fq;
        f32x4 bv[2][2];
#pragma unroll
        for (int bj = 0; bj < 2; ++bj)
#pragma unroll
            for (int n = 0; n < 2; ++n) bv[bj][n] = bias ? *(const f32x4*)(bias + bcol0 + bj * HALF + 4 * n) : (f32x4){0.f, 0.f, 0.f, 0.f};
#pragma unroll
        for (int ai = 0; ai < 2; ++ai)
#pragma unroll
            for (int m = 0; m < 4; ++m) { bf16_t* rowp = base + (size_t)(row0 + ai * HALF + m * 16) * ldc + col0;
#pragma unroll
                for (int bj = 0; bj < 2; ++bj) { f32x4 v0 = acc[ai][bj][m][0] + bv[bj][0], v1 = acc[ai][bj][m][1] + bv[bj][1];
                    if (ACT == 1) { f32x2 a = gelu_pk((f32x2){v0[0], v0[1]}), b = gelu_pk((f32x2){v0[2], v0[3]}), c = gelu_pk((f32x2){v1[0], v1[1]}), d = gelu_pk((f32x2){v1[2], v1[3]});
                        v0 = (f32x4){a.x, a.y, b.x, b.y}; v1 = (f32x4){c.x, c.y, d.x, d.y}; }
                    v0 = v0 * sc; v1 = v1 * sc; u32x4 w; w.x = cvt_pk_bf16(v0[0], v0[1]); w.y = cvt_pk_bf16(v0[2], v0[3]); w.z = cvt_pk_bf16(v1[0], v1[1]); w.w = cvt_pk_bf16(v1[2], v1[3]);
                    *(u32x4*)(rowp + bj * HALF) = w; } }
    }
};

struct PanelStats {
    unsigned* xbuf;
    unsigned* cnt;
    unsigned* tmo;
    int ntn; float eps;
    unsigned code;
    __device__ __forceinline__ bool run(const f32x4 (&v)[2][2][4][2], const Unit& u, int wr, int wc, int fr, int fq, PG8_LAS unsigned char* lds, int wid, int lane) const {
        typedef float f32x2v __attribute__((ext_vector_type(2)));
        PG8_LAS f32x2v* P = (PG8_LAS f32x2v*)lds;
        PG8_LAS f32x2v* S = (PG8_LAS f32x2v*)(lds + 8192);
        PG8_LAS unsigned* flag = (PG8_LAS unsigned*)(lds + 8192 + 2048);
#pragma unroll
        for (int ai = 0; ai < 2; ++ai)
#pragma unroll
            for (int m = 0; m < 4; ++m) {
                float s = 0.f;
#pragma unroll
                for (int bj = 0; bj < 2; ++bj)
#pragma unroll
                    for (int n = 0; n < 2; ++n) { const f32x4 x = v[ai][bj][m][n]; s += (x[0] + x[1]) + (x[2] + x[3]); }
                s += __shfl_xor(s, 16); s += __shfl_xor(s, 32);
                const float mw = s * (1.0f / 64.0f); float q = 0.f;
#pragma unroll
                for (int bj = 0; bj < 2; ++bj)
#pragma unroll
                    for (int n = 0; n < 2; ++n) { const f32x4 d = v[ai][bj][m][n] - mw; q += (d[0] * d[0] + d[1] * d[1]) + (d[2] * d[2] + d[3] * d[3]); }
                q += __shfl_xor(q, 16); q += __shfl_xor(q, 32);
                if (fq == 0) P[(ai * HALF + wr * 64 + m * 16 + fr) * 4 + wc] = (f32x2v){mw, q};
            }
        asm volatile("s_waitcnt lgkmcnt(0)" ::: "memory"); __builtin_amdgcn_s_barrier(); asm volatile("" ::: "memory");
#if defined(BROKEN_EXCHANGE_NO_WAIT)
#warning BROKEN CONTROL BUILD: the row-statistics exchange does not wait; results are wrong by design
        if (blockIdx.x >= 64) { const long long t0_ = clock64(); while (clock64() - t0_ < 60000) __builtin_amdgcn_s_sleep(8); }
#endif
        const int row = wid * 32 + (lane & 31);
        if (lane < 32) {
            const f32x2v a = P[row * 4 + 0], b = P[row * 4 + 1], c = P[row * 4 + 2], d = P[row * 4 + 3];
            const float mt = (a.x + b.x + c.x + d.x) * 0.25f;
            const float da = a.x - mt, db = b.x - mt, dc = c.x - mt, dd = d.x - mt;
            const float m2 = (a.y + b.y) + (c.y + d.y) + 64.0f * ((da * da + db * db) + (dc * dc + dd * dd));
            unsigned long long* slot = (unsigned long long*)xbuf + ((size_t)(u.pm * BM + row) * 4 + u.pn);
            __hip_atomic_store(slot, ((unsigned long long)__float_as_uint(m2) << 32) | __float_as_uint(mt), __ATOMIC_RELAXED, __HIP_MEMORY_SCOPE_AGENT);
        }
        asm volatile("s_waitcnt vmcnt(0)" ::: "memory");
        if (lane == 0) __hip_atomic_fetch_add(cnt + 64 * u.pm, 1u, __ATOMIC_RELAXED, __HIP_MEMORY_SCOPE_AGENT);
        if (wid == 0) {
            bool dead = false; const unsigned long long t0 = __builtin_amdgcn_s_memrealtime(); const unsigned want = 8u * (unsigned)ntn;
            for (;;) {
#if defined(BROKEN_EXCHANGE_NO_WAIT)
                break;
#endif
                if ((unsigned)__builtin_amdgcn_readfirstlane(__hip_atomic_load(cnt + 64 * u.pm, __ATOMIC_RELAXED, __HIP_MEMORY_SCOPE_AGENT)) >= want) break;
                if (__builtin_amdgcn_s_memrealtime() - t0 > 2000000ull) {
                    if (lane == 0) { unsigned expect = 0u; __hip_atomic_compare_exchange_strong(tmo + 1, &expect, code | (unsigned)(u.pm & 0xff), __ATOMIC_RELAXED, __ATOMIC_RELAXED, __HIP_MEMORY_SCOPE_AGENT);
                                     __hip_atomic_store(tmo, 1u, __ATOMIC_RELAXED, __HIP_MEMORY_SCOPE_AGENT); }
                    dead = true; break; }
                __builtin_amdgcn_s_sleep(2);
            }
            __builtin_amdgcn_fence(__ATOMIC_ACQUIRE, "agent");
            if (lane == 0) flag[0] = dead ? 1u : 0u;
        }
        asm volatile("s_waitcnt vmcnt(0) lgkmcnt(0)" ::: "memory"); __builtin_amdgcn_s_barrier(); asm volatile("" ::: "memory");
        const bool bad = flag[0] != 0u;
        if (lane < 32) {
            const unsigned long long* slot = (const unsigned long long*)xbuf + (size_t)(u.pm * BM + row) * 4; float mt[4], m2[4]; float ms = 0.f;
#pragma unroll
            for (int t = 0; t < 4; ++t) { if (t < ntn) { const unsigned long long w = __hip_atomic_load(slot + t, __ATOMIC_RELAXED, __HIP_MEMORY_SCOPE_AGENT); mt[t] = __uint_as_float((unsigned)w); m2[t] = __uint_as_float((unsigned)(w >> 32)); } else { mt[t] = 0.f; m2[t] = 0.f; } ms += mt[t]; }
            const float mean = ms / (float)ntn; float q = 0.f;
#pragma unroll
            for (int t = 0; t < 4; ++t) if (t < ntn) { const float dm = mt[t] - mean; q += m2[t] + 256.0f * dm * dm; }
            S[row] = (f32x2v){mean, 1.0f / sqrtf(q / (256.0f * (float)ntn) + eps)};
        }
        asm volatile("s_waitcnt lgkmcnt(0)" ::: "memory"); __builtin_amdgcn_s_barrier(); asm volatile("" ::: "memory");
        return bad;
    }
};
struct EpiLnRes {
    static constexpr bool PERM = false, AFTER_DRAIN = true;
    const float* base; float* out; int ldc; const float* bias; PanelStats st; unsigned poison;
    __device__ __forceinline__ void fused(f32x4 (&acc)[2][2][4][2], const Unit& u, int wr, int wc, int fr, int fq, PG8_LAS unsigned char* lds, int wid, int lane) const {
        typedef float f32x2v __attribute__((ext_vector_type(2)));
        const PG8_LAS f32x2v* S = (const PG8_LAS f32x2v*)(lds + 8192);
        const int col0 = u.pn * BM + wc * 32 + 4 * fq;
#pragma unroll
        for (int bj = 0; bj < 2; ++bj)
#pragma unroll
            for (int n = 0; n < 2; ++n) { const f32x4 bv = bias ? *(const f32x4*)(bias + col0 + bj * HALF + n * 16) : (f32x4){0.f, 0.f, 0.f, 0.f};
#pragma unroll
                for (int ai = 0; ai < 2; ++ai)
#pragma unroll
                    for (int m = 0; m < 4; ++m) acc[ai][bj][m][n] += bv; }
        f32x4 pre[4][2][2];
#pragma unroll
        for (int m = 0; m < 4; ++m) { const size_t off = (size_t)(u.pm * BM + wr * 64 + m * 16 + fr) * ldc + col0;
#pragma unroll
            for (int bj = 0; bj < 2; ++bj)
#pragma unroll
                for (int n = 0; n < 2; ++n) pre[m][bj][n] = *(const f32x4*)(base + off + bj * HALF + n * 16); }
        const bool bad = st.run(acc, u, wr, wc, fr, fq, lds, wid, lane) || poison != 0u;
        const float qnan = __builtin_nanf("");
#pragma unroll
        for (int ai = 0; ai < 2; ++ai)
#pragma unroll
            for (int m = 0; m < 4; ++m) { const int r = ai * HALF + wr * 64 + m * 16 + fr; const f32x2v sr = S[r]; const size_t off = (size_t)(u.pm * BM + r) * ldc + col0;
#pragma unroll
                for (int bj = 0; bj < 2; ++bj)
#pragma unroll
                    for (int n = 0; n < 2; ++n) { const f32x4 bs = ai == 0 ? pre[m][bj][n] : *(const f32x4*)(base + off + bj * HALF + n * 16); f32x4 o = bs + (acc[ai][bj][m][n] - sr.x) * sr.y;
                        if (bad) o = (f32x4){qnan, qnan, qnan, qnan}; *(f32x4*)(out + off + bj * HALF + n * 16) = o; }
                if (m & 1) asm volatile("" ::: "memory"); }
    }
};
struct EpiLnResLn {
    static constexpr bool PERM = false, AFTER_DRAIN = true;
    const float* base; float* out; bf16_t* xn; int ldc; const float* bias; PanelStats st1, st2; unsigned poison;
    __device__ __forceinline__ void fused(f32x4 (&acc)[2][2][4][2], const Unit& u, int wr, int wc, int fr, int fq, PG8_LAS unsigned char* lds, int wid, int lane) const {
        typedef float f32x2v __attribute__((ext_vector_type(2))); typedef unsigned u32x2v __attribute__((ext_vector_type(2)));
        const PG8_LAS f32x2v* S = (const PG8_LAS f32x2v*)(lds + 8192);
        const int col0 = u.pn * BM + wc * 32 + 4 * fq;
#pragma unroll
        for (int bj = 0; bj < 2; ++bj)
#pragma unroll
            for (int n = 0; n < 2; ++n) { const f32x4 bv = bias ? *(const f32x4*)(bias + col0 + bj * HALF + n * 16) : (f32x4){0.f, 0.f, 0.f, 0.f};
#pragma unroll
                for (int ai = 0; ai < 2; ++ai)
#pragma unroll
                    for (int m = 0; m < 4; ++m) acc[ai][bj][m][n] += bv; }
        bool bad = st1.run(acc, u, wr, wc, fr, fq, lds, wid, lane) || poison != 0u;
        const float qnan = __builtin_nanf("");
#pragma unroll
        for (int ai = 0; ai < 2; ++ai)
#pragma unroll
            for (int m = 0; m < 4; ++m) { const int r = ai * HALF + wr * 64 + m * 16 + fr; const f32x2v sr = S[r]; const size_t off = (size_t)(u.pm * BM + r) * ldc + col0;
#pragma unroll
                for (int bj = 0; bj < 2; ++bj)
#pragma unroll
                    for (int n = 0; n < 2; ++n) { const f32x4 bs = *(const f32x4*)(base + off + bj * HALF + n * 16); acc[ai][bj][m][n] = bs + (acc[ai][bj][m][n] - sr.x) * sr.y; }
                asm volatile("" : "+v"(acc[ai][0][m][0]), "+v"(acc[ai][0][m][1]), "+v"(acc[ai][1][m][0]), "+v"(acc[ai][1][m][1]));
                if (m & 1) asm volatile("" ::: "memory"); }
        const bool bad1 = bad;
        bad = st2.run(acc, u, wr, wc, fr, fq, lds, wid, lane) || bad;
#pragma unroll
        for (int ai = 0; ai < 2; ++ai)
#pragma unroll
            for (int m = 0; m < 4; ++m) { const int r = ai * HALF + wr * 64 + m * 16 + fr; const f32x2v sr = S[r]; const size_t off = (size_t)(u.pm * BM + r) * ldc + col0;
#pragma unroll
                for (int bj = 0; bj < 2; ++bj)
#pragma unroll
                    for (int n = 0; n < 2; ++n) { const f32x4 x1 = acc[ai][bj][m][n]; *(f32x4*)(out + off + bj * HALF + n * 16) = bad1 ? (f32x4){qnan, qnan, qnan, qnan} : x1;
                        const f32x4 o = (x1 - sr.x) * sr.y; u32x2v w; w.x = cvt_pk_bf16(o[0], o[1]); w.y = cvt_pk_bf16(o[2], o[3]);
                        if (bad) { w.x = 0x7fc07fc0u; w.y = 0x7fc07fc0u; } *(u32x2v*)(xn + off + bj * HALF + n * 16) = w; }
                asm volatile("" ::: "memory"); }
    }
};

template <class Epi, class Sched, bool ALIGN_EPI = false, bool SP2 = false>
__device__ __forceinline__ void gemm_phase(PG8_LAS unsigned char* lds, const Gemm g, const Sched& S, const Epi& E) {
    const int tid = threadIdx.x, wid = __builtin_amdgcn_readfirstlane(tid >> 6), lane = tid & 63, wr = wid >> 2, wc = wid & 3, fr = lane & 15, fq = lane >> 4;
    const int K = g.K, nt = K / BK;
    unsigned voffA[2], voffB[2];
#pragma unroll
    for (int i = 0; i < 2; ++i) { int R, C; stage_rc(tid * 16 + i * 8192, R, C); const int Rb = Epi::PERM ? ((R & ~31) + perm32(R & 31)) : R;
        voffA[i] = (unsigned)(R * K + C) * 2u; voffB[i] = (unsigned)(Rb * K + C) * 2u; }
    const size_t kstep = (size_t)(BK * 2);
    const size_t hstep = (size_t)HALF * K * 2;
    const size_t tstep = 2 * hstep;
    const unsigned ldsw = (unsigned)wid * 1024u;
    const int aoff = lds_byte(wr * 64 + fr, fq * 8), boff = lds_byte(wc * 32 + fr, fq * 8);
#define PG8_SA(b, h) (((b) * 2 + (h)) * HTB)
#define PG8_SB(b, h) ((4 + (b) * 2 + (h)) * HTB)
#define PG8_STAGE(bufoff, gbase, voff) do { _Pragma("unroll") for (int _i = 0; _i < 2; ++_i) \
        __builtin_amdgcn_global_load_lds((const unsigned*)((const char*)(gbase) + (voff)[_i]), (PG8_LAS unsigned*)(lds + (bufoff) + ldsw + _i * 8192), 16, 0, 0); } while (0)
#define PG8_LDA(dst, b, h) do { _Pragma("unroll") for (int m = 0; m < 4; ++m) _Pragma("unroll") for (int k = 0; k < 2; ++k) dst[m][k] = *(const PG8_LAS bf16x8*)(lds + PG8_SA(b, h) + aoff + m * 2048 + k * 1024); } while (0)
#define PG8_LDB(dst, b, h) do { _Pragma("unroll") for (int n = 0; n < 2; ++n) _Pragma("unroll") for (int k = 0; k < 2; ++k) dst[n][k] = *(const PG8_LAS bf16x8*)(lds + PG8_SB(b, h) + boff + n * 2048 + k * 1024); } while (0)
#define PG8_MMA(ai, bj, At, Bt) do { __builtin_amdgcn_s_setprio(1); _Pragma("unroll") for (int m = 0; m < 4; ++m) _Pragma("unroll") for (int n = 0; n < 2; ++n) _Pragma("unroll") for (int k = 0; k < 2; ++k) \
        acc[ai][bj][m][n] = __builtin_amdgcn_mfma_f32_16x16x32_bf16(Bt[n][k], At[m][k], acc[ai][bj][m][n], 0, 0, 0); __builtin_amdgcn_s_setprio(0); } while (0)
#define PG8_WAIT_V(n) asm volatile("s_waitcnt vmcnt(" #n ")" ::: "memory")
#define PG8_WAIT_L(n) asm volatile("s_waitcnt lgkmcnt(" #n ")" ::: "memory")
#define PG8_BAR __builtin_amdgcn_s_barrier()
#define PG8_SCHED __builtin_amdgcn_sched_barrier(0)
    Unit cur, nxt; int ui = 0;
    if (!S.next(0, cur)) return;
    f32x4 acc[2][2][4][2];
#pragma unroll
    for (int a = 0; a < 2; ++a)
#pragma unroll
        for (int b = 0; b < 2; ++b)
#pragma unroll
            for (int m = 0; m < 4; ++m)
#pragma unroll
                for (int n = 0; n < 2; ++n) acc[a][b][m][n] = (f32x4){0.f, 0.f, 0.f, 0.f};
    bf16x8 At[4][2], B0[2][2], B1[2][2];
    const char* cA = (const char*)g.A + (size_t)cur.pm * tstep; const char* cB = (const char*)g.Bt + (size_t)cur.pn * tstep;
    S.a_ready(cur);
    if constexpr (SP2) {
        PG8_STAGE(PG8_SB(0, 0), cB, voffB); PG8_STAGE(PG8_SB(0, 1), cB + hstep, voffB); PG8_STAGE(PG8_SA(0, 0), cA, voffA); PG8_STAGE(PG8_SA(0, 1), cA + hstep, voffA);
        if (wr == 1) PG8_BAR;
        PG8_WAIT_V(2); PG8_BAR;
        PG8_STAGE(PG8_SB(1, 0), cB + kstep, voffB); PG8_STAGE(PG8_SA(1, 0), cA + kstep, voffA); PG8_STAGE(PG8_SB(1, 1), cB + hstep + kstep, voffB);
        PG8_WAIT_V(6); PG8_BAR;
    } else {
        PG8_STAGE(PG8_SB(0, 0), cB, voffB); PG8_STAGE(PG8_SA(0, 0), cA, voffA); PG8_STAGE(PG8_SB(0, 1), cB + hstep, voffB); PG8_STAGE(PG8_SA(0, 1), cA + hstep, voffA);
        if (wr == 1) PG8_BAR;
        PG8_WAIT_V(4); PG8_BAR;
        PG8_STAGE(PG8_SB(1, 0), cB + kstep, voffB); PG8_STAGE(PG8_SA(1, 0), cA + kstep, voffA); PG8_STAGE(PG8_SB(1, 1), cB + hstep + kstep, voffB);
        PG8_WAIT_V(6); PG8_BAR;
    }
    for (;;) {
        const bool has_next = S.next(ui + 1, nxt);
        const char* nA = has_next ? (const char*)g.A + (size_t)nxt.pm * tstep : cA; const char* nB = has_next ? (const char*)g.Bt + (size_t)nxt.pn * tstep : cB;
        for (int t = 0; t < nt; t += 2) {
            const bool last = (t == nt - 2);
            const char* a1 = cA + (size_t)(t + 1) * kstep;
            const char* a2 = last ? nA : cA + (size_t)(t + 2) * kstep; const char* b2 = last ? nB : cB + (size_t)(t + 2) * kstep;
            const char* a3 = a2 + kstep; const char* b3 = b2 + kstep;
            if (last && has_next) S.a_ready(nxt);
            if constexpr (SP2) {
            PG8_LDB(B0, 0, 0); PG8_LDB(B1, 0, 1); PG8_SCHED; PG8_LDA(At, 0, 0); PG8_STAGE(PG8_SA(1, 1), a1 + hstep, voffA);
            PG8_WAIT_V(8); PG8_WAIT_L(0); PG8_BAR; PG8_MMA(0, 0, At, B0); PG8_MMA(0, 1, At, B1); PG8_BAR; PG8_SCHED;
            PG8_LDA(At, 0, 1); PG8_STAGE(PG8_SB(0, 0), b2, voffB); PG8_STAGE(PG8_SB(0, 1), b2 + hstep, voffB); PG8_STAGE(PG8_SA(0, 0), a2, voffA);
            PG8_WAIT_V(8); PG8_WAIT_L(0); PG8_BAR; PG8_MMA(1, 0, At, B0); PG8_MMA(1, 1, At, B1); PG8_BAR; PG8_SCHED;
            PG8_LDB(B0, 1, 0); PG8_LDB(B1, 1, 1); PG8_SCHED; PG8_LDA(At, 1, 0); PG8_STAGE(PG8_SA(0, 1), a2 + hstep, voffA);
            PG8_WAIT_V(8); PG8_WAIT_L(0); PG8_BAR; PG8_MMA(0, 0, At, B0); PG8_MMA(0, 1, At, B1); PG8_BAR; PG8_SCHED;
            PG8_LDA(At, 1, 1); PG8_STAGE(PG8_SB(1, 0), b3, voffB); PG8_STAGE(PG8_SB(1, 1), b3 + hstep, voffB); PG8_STAGE(PG8_SA(1, 0), a3, voffA);
            PG8_WAIT_V(8); PG8_WAIT_L(0); PG8_BAR; PG8_MMA(1, 0, At, B0); PG8_MMA(1, 1, At, B1); PG8_BAR; PG8_SCHED;
            } else {
            PG8_LDB(B0, 0, 0); PG8_SCHED; PG8_LDA(At, 0, 0); PG8_STAGE(PG8_SA(1, 1), a1 + hstep, voffA);
            PG8_WAIT_L(8); PG8_BAR; PG8_WAIT_L(0); PG8_MMA(0, 0, At, B0); PG8_BAR; PG8_SCHED;
            PG8_LDB(B1, 0, 1); PG8_STAGE(PG8_SB(0, 0), b2, voffB);
            PG8_BAR; PG8_WAIT_L(0); PG8_MMA(0, 1, At, B1); PG8_BAR;
            PG8_LDA(At, 0, 1); PG8_STAGE(PG8_SA(0, 0), a2, voffA);
            PG8_BAR; PG8_WAIT_L(0); PG8_MMA(1, 0, At, B0); PG8_BAR; PG8_SCHED;
            PG8_STAGE(PG8_SB(0, 1), b2 + hstep, voffB);
            PG8_WAIT_V(6); PG8_BAR; PG8_MMA(1, 1, At, B1); PG8_BAR;
            PG8_LDB(B0, 1, 0); PG8_SCHED; PG8_LDA(At, 1, 0); PG8_STAGE(PG8_SA(0, 1), a2 + hstep, voffA);
            PG8_WAIT_L(8); PG8_BAR; PG8_WAIT_L(0); PG8_MMA(0, 0, At, B0); PG8_BAR; PG8_SCHED;
            PG8_LDB(B1, 1, 1); PG8_STAGE(PG8_SB(1, 0), b3, voffB);
            PG8_BAR; PG8_WAIT_L(0); PG8_MMA(0, 1, At, B1); PG8_BAR;
            PG8_LDA(At, 1, 1); PG8_STAGE(PG8_SA(1, 0), a3, voffA);
            PG8_BAR; PG8_WAIT_L(0); PG8_MMA(1, 0, At, B0); PG8_BAR; PG8_SCHED;
            PG8_STAGE(PG8_SB(1, 1), b3 + hstep, voffB);
            PG8_WAIT_V(6); PG8_BAR; PG8_MMA(1, 1, At, B1); PG8_BAR;
            }
        }
        if constexpr (ALIGN_EPI) { if (wr == 0) PG8_BAR; }
        if constexpr (!Epi::AFTER_DRAIN) { E(acc, cur, wr, wc, fr, fq); S.done(cur); }
        if (!has_next) break;
#pragma unroll
        for (int a = 0; a < 2; ++a)
#pragma unroll
            for (int b = 0; b < 2; ++b)
#pragma unroll
                for (int m = 0; m < 4; ++m)
#pragma unroll
                    for (int n = 0; n < 2; ++n) acc[a][b][m][n] = (f32x4){0.f, 0.f, 0.f, 0.f};
        cur = nxt; cA = nA; cB = nB; ++ui;
        if constexpr (ALIGN_EPI) { if (wr == 1) PG8_BAR; }
    }
    PG8_WAIT_V(0);
    if constexpr (!ALIGN_EPI) { if (wr == 0) PG8_BAR; }
    PG8_BAR;
    if constexpr (Epi::AFTER_DRAIN) { E.fused(acc, cur, wr, wc, fr, fq, lds, wid, lane); S.done(cur); }
#undef PG8_SA
#undef PG8_SB
#undef PG8_STAGE
#undef PG8_LDA
#undef PG8_LDB
#undef PG8_MMA
#undef PG8_WAIT_V
#undef PG8_WAIT_L
#undef PG8_BAR
#undef PG8_SCHED
}
}
#ifndef PG8_SP2
#define PG8_SP2 true
#endif
#ifndef PG8_ALIGN
#define PG8_ALIGN true
#endif

#include <hip/hip_bf16.h>
#include <cmath>
namespace datt {
using bf16 = __hip_bfloat16;
typedef short bf16x8 __attribute__((ext_vector_type(8)));
typedef short s16x4 __attribute__((ext_vector_type(4)));
typedef float f32x16 __attribute__((ext_vector_type(16)));
typedef float f32x4 __attribute__((ext_vector_type(4)));
typedef unsigned u32x4 __attribute__((ext_vector_type(4)));
constexpr int SEQ = 4096, DM = 1024, DQK = 64, DV = 128;
constexpr int NW = 8, QBLK = 32, KVBLK = 64, QB = NW * QBLK;
constexpr int SHM_V = KVBLK * DV * 2, SHM_K = KVBLK * DQK * 2;
constexpr int NSLOT = 3;
constexpr int LDS_BYTES = NSLOT * SHM_V + NSLOT * SHM_K + NW * 64 * 4;
constexpr float THR = 8.f;
#define DKSWZ(row, colB) ((row) * 128 + ((colB) ^ (((row) & 7) << 4)))
#define DSBAR() __builtin_amdgcn_sched_barrier(0)
__device__ __forceinline__ int v_st(int k, int c) { const int kk = (k & ~0xC) | ((k & 4) << 1) | ((k & 8) >> 1); return ((kk >> 3) * 4 + (c >> 5)) * 512 + ((kk & 7) * 32 + (c & 31)) * 2; }
__device__ __forceinline__ int v_rd_base(int lane) { return ((lane & 3) << 3) | (((lane >> 2) & 3) << 6) | (((lane >> 4) & 1) << 5) | (((lane >> 5) & 1) << 8); }
constexpr int v_rd_off(int d0, int ks, int half) { return d0 * 512 + ks * 4096 + half * 2048; }
__device__ __forceinline__ int crow(int r, int hi) { return (r & 3) + 8 * (r >> 2) + 4 * hi; }
__device__ __forceinline__ unsigned cvtpk(float lo, float hi) { unsigned r; asm volatile("v_cvt_pk_bf16_f32 %0, %1, %2" : "=v"(r) : "v"(lo), "v"(hi)); return r; }
__device__ __forceinline__ bf16x8 load8(const bf16* p) { return *reinterpret_cast<const bf16x8*>(p); }
__device__ __forceinline__ void mask_tile(f32x16& p0, f32x16& p1, int dq) {
    const float NEG = -__builtin_inff();
#pragma unroll
    for (int r = 0; r < 16; ++r) { const int c = (r & 3) + 8 * (r >> 2); if (dq - c < 0) p0[r] = NEG; if (dq - c - 32 < 0) p1[r] = NEG; }
}
__device__ __forceinline__ void alibi_tile(f32x16& p0, f32x16& p1, float sl2) {
#pragma unroll
    for (int r = 0; r < 16; ++r) { const float c = (float)((r & 3) + 8 * (r >> 2)); p0[r] = __builtin_fmaf(sl2, c, p0[r]); p1[r] = __builtin_fmaf(sl2, c + 32.f, p1[r]); }
}
__device__ __forceinline__ void partialSM(f32x16& p0, f32x16& p1, float base, float& m_reg, float& alpha) {
    float pmax = p0[0];
#pragma unroll
    for (int r = 1; r < 16; ++r) pmax = fmaxf(pmax, p0[r]);
#pragma unroll
    for (int r = 0; r < 16; ++r) pmax = fmaxf(pmax, p1[r]);
    { auto rr = __builtin_amdgcn_permlane32_swap(__float_as_uint(pmax), __float_as_uint(pmax), false, false); pmax = fmaxf(__uint_as_float(rr[0]), __uint_as_float(rr[1])); }
    pmax += base;
    float mn;
    if (__builtin_expect(__all(pmax - m_reg <= THR), 1)) { mn = m_reg; alpha = 1.f; }
    else { mn = fmaxf(m_reg, pmax); alpha = __builtin_amdgcn_exp2f(m_reg - mn); m_reg = mn; }
    const float mnL = base - mn;
#pragma unroll
    for (int r = 0; r < 16; ++r) p0[r] += mnL;
#pragma unroll
    for (int r = 0; r < 16; ++r) p1[r] += mnL;
#pragma unroll
    for (int r = 0; r < 16; ++r) p0[r] = __builtin_amdgcn_exp2f(p0[r]);
}
__device__ __forceinline__ void finishSM(f32x16& p0, f32x16& p1, float alpha, float& l_reg, bf16x8& pa0, bf16x8& pa1, bf16x8& pa2, bf16x8& pa3) {
#pragma unroll
    for (int r = 0; r < 16; ++r) p1[r] = __builtin_amdgcn_exp2f(p1[r]);
    float ps = 0;
#pragma unroll
    for (int r = 0; r < 16; ++r) ps += p0[r];
#pragma unroll
    for (int r = 0; r < 16; ++r) ps += p1[r];
    { auto rr = __builtin_amdgcn_permlane32_swap(__float_as_uint(ps), __float_as_uint(ps), false, false); ps = __uint_as_float(rr[0]) + __uint_as_float(rr[1]); }
    l_reg = l_reg * alpha + ps;
#define DPK4(P, B_, OUT) do { unsigned a0 = cvtpk(P[B_+0], P[B_+1]), a1 = cvtpk(P[B_+2], P[B_+3]); unsigned b0 = cvtpk(P[B_+4], P[B_+5]), b1 = cvtpk(P[B_+6], P[B_+7]); \
        auto r0 = __builtin_amdgcn_permlane32_swap(a0, b0, false, false); auto r1 = __builtin_amdgcn_permlane32_swap(a1, b1, false, false); \
        u32x4 w = {r0[0], r1[0], r0[1], r1[1]}; OUT = *reinterpret_cast<bf16x8*>(&w); } while (0)
    DPK4(p0, 0, pa0); DPK4(p0, 8, pa1); DPK4(p1, 0, pa2); DPK4(p1, 8, pa3);
#undef DPK4
}
__device__ __forceinline__ void qkt(f32x16& p0, f32x16& p1, const char* Kslot, int r32, int hi, const bf16x8* qr) {
    p0 = f32x16{}; p1 = f32x16{};
#pragma unroll
    for (int d0 = 0; d0 < 4; ++d0) { const char* a = Kslot + DKSWZ(r32, (d0 * 16 + hi * 8) * 2);
        const bf16x8 b0 = *reinterpret_cast<const bf16x8*>(a);
        const bf16x8 b1 = *reinterpret_cast<const bf16x8*>(a + 32 * 128);
        p0 = __builtin_amdgcn_mfma_f32_32x32x16_bf16(b0, qr[d0], p0, 0, 0, 0);
        p1 = __builtin_amdgcn_mfma_f32_32x32x16_bf16(b1, qr[d0], p1, 0, 0, 0); }
}
__device__ __forceinline__ void pv_tile(f32x16* o, int vb0, bf16x8 pa0, bf16x8 pa1, bf16x8 pa2, bf16x8 pa3) {
#define DTRRD(dst, off) asm volatile("ds_read_b64_tr_b16 %0, %1 offset:%2" : "=&v"(dst) : "v"(vb0), "i"(off) : "memory")
#define DPV_D0(d0) do { s16x4 l0, l1, l2, l3, h0, h1, h2, h3; constexpr int b_ = v_rd_off(d0, 0, 0); \
        DTRRD(l0, b_); DTRRD(h0, b_ + 2048); DTRRD(l1, b_ + 4096); DTRRD(h1, b_ + 6144); DTRRD(l2, b_ + 8192); DTRRD(h2, b_ + 10240); DTRRD(l3, b_ + 12288); DTRRD(h3, b_ + 14336); \
        asm volatile("s_waitcnt lgkmcnt(0)" ::: "memory"); DSBAR(); \
        o[d0] = __builtin_amdgcn_mfma_f32_32x32x16_bf16(pa0, (bf16x8){l0[0], l0[1], l0[2], l0[3], h0[0], h0[1], h0[2], h0[3]}, o[d0], 0, 0, 0); \
        o[d0] = __builtin_amdgcn_mfma_f32_32x32x16_bf16(pa1, (bf16x8){l1[0], l1[1], l1[2], l1[3], h1[0], h1[1], h1[2], h1[3]}, o[d0], 0, 0, 0); \
        o[d0] = __builtin_amdgcn_mfma_f32_32x32x16_bf16(pa2, (bf16x8){l2[0], l2[1], l2[2], l2[3], h2[0], h2[1], h2[2], h2[3]}, o[d0], 0, 0, 0); \
        o[d0] = __builtin_amdgcn_mfma_f32_32x32x16_bf16(pa3, (bf16x8){l3[0], l3[1], l3[2], l3[3], h3[0], h3[1], h3[2], h3[3]}, o[d0], 0, 0, 0); } while (0)
    DPV_D0(0); DPV_D0(1); DPV_D0(2); DPV_D0(3);
#undef DPV_D0
#undef DTRRD
}
struct BlockRef { const bf16* Q; const bf16* K; const bf16* V; bf16* O; int P0; int jlo; float sl2; };
struct Seam { bf16x8 qr[4]; bf16x8 st_v0, st_v1, st_k0; };
#define DROWV(p, k0, rr) ((p) + (size_t)((k0) + (rr)) * DM + sc)
#define DROWK(p, k0) ((p) + (size_t)((k0) + kr) * DM + kc)
#define DVMW() asm volatile("s_waitcnt vmcnt(0)" ::: "memory")
#define DVMWN(n) asm volatile("s_waitcnt vmcnt(%0)" :: "i"(n) : "memory")
#define DSLOAD(Kp, Vp, k0) do { S.st_v0 = load8(DROWV(Vp, k0, sr)); S.st_v1 = load8(DROWV(Vp, k0, 32 + sr)); S.st_k0 = load8(DROWK(Kp, k0)); } while (0)
#define DSWRITE_K(so) do { *(bf16x8*)(K_lds + (so) * SHM_K + kws) = S.st_k0; } while (0)
#define DSWRITE_V(so) do { *(bf16x8*)(V_lds + (so) * SHM_V + vst0) = S.st_v0; *(bf16x8*)(V_lds + (so) * SHM_V + vst1) = S.st_v1; } while (0)
__device__ __forceinline__ void datt_prime(const BlockRef& cur, char* lds, Seam& S) {
    const int tid = threadIdx.x, wid = __builtin_amdgcn_readfirstlane(tid >> 6), lane = tid & 63, r32 = lane & 31, hi = lane >> 5;
    const int sr = tid >> 4, sc = (tid & 15) * 8, kr = tid >> 3, kc = (tid & 7) * 8, kws = DKSWZ(kr, kc * 2); char* K_lds = lds + NSLOT * SHM_V;
    const int kb0 = cur.jlo * KVBLK;
#pragma unroll
    for (int d0 = 0; d0 < 4; ++d0) S.qr[d0] = load8(cur.Q + (size_t)(wid * QBLK + r32) * DM + d0 * 16 + hi * 8);
    DSLOAD(cur.K, cur.V, kb0); DVMW(); DSWRITE_K(0);
    __syncthreads();
}
__device__ __forceinline__ void datt_block(const BlockRef& cur, const BlockRef& nxt, char* lds, Seam& S) {
    const int tid = threadIdx.x, wid = __builtin_amdgcn_readfirstlane(tid >> 6), lane = tid & 63, r32 = lane & 31, hi = lane >> 5;
    const int j_lo = cur.jlo, j_hi = (cur.P0 + QB - 1) / KVBLK + 1, NT = j_hi - j_lo;
    const int kbn = nxt.jlo * KVBLK;
    const int qlo = cur.P0 + wid * QBLK, qm = qlo + r32 - 4 * hi;
    const float sl2 = cur.sl2;
    char* V_lds = lds; char* K_lds = lds + NSLOT * SHM_V;
    float* ws = (float*)(lds + NSLOT * SHM_V + NSLOT * SHM_K) + wid * 64; float* li_l = ws, * al_l = ws + 32;
    float m_reg = 4.0f, l_reg = 0; f32x16 o[4] = {};
    const int sr = tid >> 4, sc = (tid & 15) * 8, vst0 = v_st(sr, sc), vst1 = v_st(32 + sr, sc), kr = tid >> 3, kc = (tid & 7) * 8, kws = DKSWZ(kr, kc * 2);
    const int vb0 = (int)(uintptr_t)V_lds + v_rd_base(lane);
    const bf16* Kh = cur.K; const bf16* Vh = cur.V;
#define DRESC(a) do { if (__any((a) < 1.f)) { if (hi == 0) al_l[r32] = (a); asm volatile("s_waitcnt lgkmcnt(0)" ::: "memory"); \
                     _Pragma("unroll") for (int d_ = 0; d_ < 4; ++d_) _Pragma("unroll") for (int r = 0; r < 16; ++r) o[d_][r] *= al_l[crow(r, hi)]; } } while (0)
#define DKBASE(t) ((j_lo + (t)) * KVBLK)
#define DBIAS(t) (sl2 * (float)(DKBASE(t) - qm))
#define DMASKT(P0_, P1_, t) do { const int kb_ = DKBASE(t); alibi_tile(P0_, P1_, sl2); if (kb_ + KVBLK - 1 > qlo) mask_tile(P0_, P1_, qm - kb_); } while (0)
#define DSEAM_K0() do { DVMWN(4); DSWRITE_K(0); DSBAR(); } while (0)
    int s_p = 2, s_c = 0, s_n = 1;
#define DROT() do { const int t_ = s_p; s_p = s_c; s_c = s_n; s_n = t_; } while (0)
    f32x16 pA0, pA1, pB0, pB1; float alA, alB; bf16x8 pa0, pa1, pa2, pa3;
    DSWRITE_V(0); DSBAR();
    if (NT > 1) DSLOAD(Kh, Vh, DKBASE(1));
    DSBAR(); qkt(pA0, pA1, K_lds, r32, hi, S.qr);
    DMASKT(pA0, pA1, 0); partialSM(pA0, pA1, DBIAS(0), m_reg, alA);
    if (NT > 1) { DVMW(); DSWRITE_V(1); DSWRITE_K(1); }
    __syncthreads();
#define DHALF_STEP(PX0, PX1, alX, PY0, PY1, alY, t) do { DROT(); \
        DSBAR(); qkt(PX0, PX1, K_lds + s_c * SHM_K, r32, hi, S.qr); \
        finishSM(PY0, PY1, alY, l_reg, pa0, pa1, pa2, pa3); DSBAR(); \
        if ((t) + 1 < NT) { DSLOAD(Kh, Vh, DKBASE((t) + 1)); DSBAR(); } \
        pv_tile(o, vb0 + s_p * SHM_V, pa0, pa1, pa2, pa3); DMASKT(PX0, PX1, (t)); partialSM(PX0, PX1, DBIAS(t), m_reg, alX); \
        if ((t) + 1 < NT) { DVMW(); DSWRITE_V(s_n); DSWRITE_K(s_n); } \
        DRESC(alX); __syncthreads(); } while (0)
    for (int t = 1; t + 1 < NT; t += 2) {
        DHALF_STEP(pB0, pB1, alB, pA0, pA1, alA, t);
        DHALF_STEP(pA0, pA1, alA, pB0, pB1, alB, t + 1);
    }
    const bool even = (NT & 1) == 0;
    if (even) { DSBAR(); qkt(pB0, pB1, K_lds + s_n * SHM_K, r32, hi, S.qr); DSBAR(); }
    DSLOAD(nxt.K, nxt.V, kbn); DSBAR();
#pragma unroll
    for (int d0 = 0; d0 < 4; ++d0) S.qr[d0] = load8(nxt.Q + (size_t)(wid * QBLK + r32) * DM + d0 * 16 + hi * 8);
    DSBAR();
    finishSM(pA0, pA1, alA, l_reg, pa0, pa1, pa2, pa3); DSBAR();
    pv_tile(o, vb0 + s_c * SHM_V, pa0, pa1, pa2, pa3);
    if (even) { DMASKT(pB0, pB1, NT - 1); partialSM(pB0, pB1, DBIAS(NT - 1), m_reg, alB); __syncthreads(); DRESC(alB);
        finishSM(pB0, pB1, alB, l_reg, pa0, pa1, pa2, pa3); DSBAR(); pv_tile(o, vb0 + s_n * SHM_V, pa0, pa1, pa2, pa3); }
    else { __syncthreads(); }
    DSBAR(); DSEAM_K0();
    if (hi == 0) li_l[r32] = l_reg; asm volatile("s_waitcnt lgkmcnt(0)" ::: "memory");
    float rli[16];
#pragma unroll
    for (int r = 0; r < 16; ++r) rli[r] = __builtin_amdgcn_rcpf(li_l[crow(r, hi)]);
    bf16* Ow = cur.O + (size_t)(wid * QBLK) * DM;
#pragma unroll
    for (int r = 0; r < 16; ++r) { const int orow = crow(r, hi);
#pragma unroll
        for (int d0 = 0; d0 < 4; ++d0) { const float v = o[d0][r] * rli[r]; const float vn = __shfl_xor(v, 1);
            if ((r32 & 1) == 0) *(unsigned*)(Ow + (size_t)orow * DM + d0 * 32 + r32) = cvtpk(v, vn); } }
    __syncthreads();
#undef DRESC
#undef DKBASE
#undef DBIAS
#undef DMASKT
#undef DSEAM_K0
#undef DHALF_STEP
#undef DROT
}
#undef DROWV
#undef DROWK
#undef DVMW
#undef DVMWN
#undef DSLOAD
#undef DSWRITE_K
#undef DSWRITE_V
struct Tensors { const bf16* Q; const bf16* K; const bf16* V; bf16* O0; bf16* O1; const unsigned* NQ; const unsigned* NK; unsigned* qhead; const unsigned short* order; };
__device__ __forceinline__ BlockRef make_ref(const Tensors& T, unsigned code) {
    const int qb = code & 15, h = (code >> 4) & 7, b = (code >> 7) & 3, c = (code >> 9) & 1, hq = 2 * h + c;
    BlockRef r; const size_t rowb = (size_t)b * SEQ;
    r.Q = T.Q + (rowb + (size_t)qb * QB) * DM + hq * DQK; r.K = T.K + rowb * DM + hq * DQK; r.V = T.V + rowb * DM + h * DV; r.O = (c ? T.O1 : T.O0) + (rowb + (size_t)qb * QB) * DM + h * DV;
    r.P0 = qb * QB; r.sl2 = __builtin_amdgcn_exp2f(-(float)(h + 1)) * 1.4426950408889634f;
    int lane_ = threadIdx.x & 63; asm volatile("" : "+v"(lane_));
    const int nt_ = 4 * qb + 4; float qn_ = 0.f;
#pragma unroll
    for (int i_ = 0; i_ < 4; ++i_) qn_ = fmaxf(qn_, __uint_as_float(T.NQ[((b * 64 + 4 * qb + i_) * 16) + hq]));
    const float kn_ = lane_ < nt_ ? __uint_as_float(T.NK[((b * 64 + lane_) * 16) + hq]) : 0.f;
    const float bound_ = sqrtf(qn_) * sqrtf(kn_) * 1.001f - r.sl2 * (float)(256 * qb - 64 * lane_ - 63) - 4.0f;
    const unsigned long long keep_ = __ballot(lane_ < nt_ && !(bound_ < -152.0f));
    int first_ = keep_ ? (int)__builtin_ctzll(keep_) : nt_ - 1; if (first_ > nt_ - 4) first_ = nt_ - 4;
    r.jlo = __builtin_amdgcn_readfirstlane(first_);
    return r;
}
__device__ __forceinline__ int draw(const Tensors& T, volatile __attribute__((address_space(3))) unsigned* qw) {
    __syncthreads();
    if (threadIdx.x == 0) *qw = __hip_atomic_fetch_add(T.qhead, 1u, __ATOMIC_RELAXED, __HIP_MEMORY_SCOPE_AGENT);
    __syncthreads();
    return (int)*qw;
}
__device__ __forceinline__ void datt_phase(char* lds, volatile __attribute__((address_space(3))) unsigned* qw, const Tensors& T) {
    int i = draw(T, qw); if (i >= 1024) return;
    BlockRef cur = make_ref(T, T.order[i]);
    Seam S;
    datt_prime(cur, lds, S);
    for (;;) {
        const int in = draw(T, qw); const bool last = in >= 1024;
        const BlockRef nxt = last ? cur : make_ref(T, T.order[in]);
        datt_block(cur, nxt, lds, S);
        if (last) break;
        cur = nxt;
    }
}
#undef DKSWZ
#undef DSBAR
}
__device__ const unsigned short datt_order[1024] = {79,95,111,127,207,223,239,255,335,351,367,383,463,479,495,511,591,607,623,639,719,735,751,767,847,863,879,895,975,991,1007,1023,78,94,110,126,206,222,238,254,334,350,366,382,462,478,494,510,590,606,622,638,718,734,750,766,846,862,878,894,974,990,1006,1022,77,93,109,125,205,221,237,253,333,349,365,381,461,477,493,509,589,605,621,637,717,733,749,765,845,861,877,893,973,989,1005,1021,76,92,108,124,204,220,236,252,332,348,364,380,460,476,492,508,588,604,620,636,716,732,748,764,844,860,876,892,972,988,1004,1020,75,91,107,123,203,219,235,251,331,347,363,379,459,475,491,507,587,603,619,635,715,731,747,763,843,859,875,891,971,987,1003,1019,74,90,106,122,202,218,234,250,330,346,362,378,458,474,490,506,586,602,618,634,714,730,746,762,842,858,874,890,970,986,1002,1018,73,89,105,121,201,217,233,249,329,345,361,377,457,473,489,505,585,601,617,633,713,729,745,761,841,857,873,889,969,985,1001,1017,56,57,58,59,60,61,62,63,72,88,104,120,184,185,186,187,188,189,190,191,200,216,232,248,312,313,314,315,316,317,318,319,328,344,360,376,440,441,442,443,444,445,446,447,456,472,488,504,568,569,570,571,572,573,574,575,584,600,616,632,696,697,698,699,700,701,702,703,712,728,744,760,824,825,826,827,828,829,830,831,840,856,872,888,952,953,954,955,956,957,958,959,968,984,1000,1016,55,71,87,103,119,183,199,215,231,247,311,327,343,359,375,439,455,471,487,503,567,583,599,615,631,695,711,727,743,759,823,839,855,871,887,951,967,983,999,1015,54,70,86,102,118,182,198,214,230,246,310,326,342,358,374,438,454,470,486,502,566,582,598,614,630,694,710,726,742,758,822,838,854,870,886,950,966,982,998,1014,53,69,85,101,117,181,197,213,229,245,309,325,341,357,373,437,453,469,485,501,565,581,597,613,629,693,709,725,741,757,821,837,853,869,885,949,965,981,997,1013,36,37,38,39,40,41,42,43,44,45,46,47,52,68,84,100,116,164,165,166,167,168,169,170,171,172,173,174,175,180,196,212,228,244,292,293,294,295,296,297,298,299,300,301,302,303,308,324,340,356,372,420,421,422,423,424,425,426,427,428,429,430,431,436,452,468,484,500,548,549,550,551,552,553,554,555,556,557,558,559,564,580,596,612,628,676,677,678,679,680,681,682,683,684,685,686,687,692,708,724,740,756,804,805,806,807,808,809,810,811,812,813,814,815,820,836,852,868,884,932,933,934,935,936,937,938,939,940,941,942,943,948,964,980,996,1012,35,51,67,83,99,115,163,179,195,211,227,243,291,307,323,339,355,371,419,435,451,467,483,499,547,563,579,595,611,627,675,691,707,723,739,755,803,819,835,851,867,883,931,947,963,979,995,1011,18,19,20,21,22,23,24,25,26,27,28,29,30,31,34,50,66,82,98,114,146,147,148,149,150,151,152,153,154,155,156,157,158,159,162,178,194,210,226,242,274,275,276,277,278,279,280,281,282,283,284,285,286,287,290,306,322,338,354,370,402,403,404,405,406,407,408,409,410,411,412,413,414,415,418,434,450,466,482,498,530,531,532,533,534,535,536,537,538,539,540,541,542,543,546,562,578,594,610,626,658,659,660,661,662,663,664,665,666,667,668,669,670,671,674,690,706,722,738,754,786,787,788,789,790,791,792,793,794,795,796,797,798,799,802,818,834,850,866,882,914,915,916,917,918,919,920,921,922,923,924,925,926,927,930,946,962,978,994,1010,1,2,3,4,5,6,7,8,9,10,11,12,13,14,15,17,33,49,65,81,97,113,129,130,131,132,133,134,135,136,137,138,139,140,141,142,143,145,161,177,193,209,225,241,257,258,259,260,261,262,263,264,265,266,267,268,269,270,271,273,289,305,321,337,353,369,385,386,387,388,389,390,391,392,393,394,395,396,397,398,399,401,417,433,449,465,481,497,513,514,515,516,517,518,519,520,521,522,523,524,525,526,527,529,545,561,577,593,609,625,641,642,643,644,645,646,647,648,649,650,651,652,653,654,655,657,673,689,705,721,737,753,769,770,771,772,773,774,775,776,777,778,779,780,781,782,783,785,801,817,833,849,865,881,897,898,899,900,901,902,903,904,905,906,907,908,909,910,911,913,929,945,961,977,993,1009,0,16,32,48,64,80,96,112,128,144,160,176,192,208,224,240,256,272,288,304,320,336,352,368,384,400,416,432,448,464,480,496,512,528,544,560,576,592,608,624,640,656,672,688,704,720,736,752,768,784,800,816,832,848,864,880,896,912,928,944,960,976,992,1008};

constexpr int NWAVES = 8;
constexpr int BATCH = 4, SEQ = 4096, D = 2048, M = BATCH * SEQ;
constexpr int AW = 1024, NIN = 5120;
constexpr float LN_EPS = 1e-5f;
constexpr float DN_ALPHA = 1.189207115002721f;
constexpr float C2 = 0.125f * 1.4426950408889634f;
constexpr float LOG2E = 1.4426950408889634f;

constexpr size_t MiB = 1u << 20;
constexpr size_t WS_CTL = 0, CTL_ZERO_BYTES = 1 * MiB;
constexpr size_t WS_WIN = 2 * MiB, WS_WOUT = 22 * MiB, WS_WQ = 30 * MiB, WS_PRM = 38 * MiB;
constexpr size_t WS_XB = 392 * MiB;
constexpr size_t WS_MIX = 40 * MiB;
constexpr size_t WS_Q = 104 * MiB, WS_K = 136 * MiB, WS_V = 168 * MiB, WS_XR = 200 * MiB, WS_XG = 232 * MiB;
constexpr size_t WS_Y1 = 104 * MiB;
constexpr size_t WS_H1 = 232 * MiB;
constexpr size_t WS_H8 = 296 * MiB;
constexpr size_t WS_PQ = 104 * MiB;
constexpr size_t WS_SU = 38 * MiB + 65536, WS_SH = 38 * MiB + 131072;
constexpr size_t WS_WG = 38 * MiB + 262144;
constexpr size_t WS_PART = 104 * MiB;
constexpr size_t WS_FFN = 40 * MiB;
constexpr size_t WS_PK = 2 * MiB;
constexpr size_t WS_U8 = 328 * MiB, WS_V8 = 360 * MiB;
constexpr size_t WS_O0 = 264 * MiB, WS_O1 = 296 * MiB;
constexpr size_t WS_E = 456 * MiB, WS_G = 464 * MiB, WS_TOTA = 472 * MiB, WS_TOTH = 473 * MiB, WS_SKH = 474 * MiB, WS_SKL = 475 * MiB, WS_END = 476 * MiB;
constexpr int CW_BAR = 4096;
constexpr int CW_NQ = 32768, CW_NK = 32768 + 4096, CW_AQ = 32768 + 8192, CW_CQ = 32768 + 8192 + 128;

constexpr int RING_OFF = 0, RING_BYTES = 131072;
constexpr int LDSCTL_OFF = RING_BYTES, MISC_OFF = LDSCTL_OFF + 320;
constexpr int LDS_BYTES = 147456;

#define GAS __attribute__((address_space(1)))
#define LAS __attribute__((address_space(3)))
typedef unsigned short bf16;
typedef unsigned v4u __attribute__((ext_vector_type(4)));
typedef float f32x4 __attribute__((ext_vector_type(4)));
typedef GAS unsigned gu32;
#define RLX_AGENT __ATOMIC_RELAXED, __HIP_MEMORY_SCOPE_AGENT
#define LDS_WAIT() asm volatile("s_waitcnt lgkmcnt(0)" ::: "memory")
#define VM_WAIT() asm volatile("s_waitcnt vmcnt(0)" ::: "memory")
__device__ __forceinline__ unsigned f2bf(float f) { unsigned u = __builtin_bit_cast(unsigned, f); return (u + 0x7fffu + ((u >> 16) & 1u)) >> 16; }
__device__ __forceinline__ unsigned pk2(float lo, float hi) { return f2bf(lo) | (f2bf(hi) << 16); }
__device__ __forceinline__ float bf2f(unsigned short u) { return __uint_as_float(((unsigned)u) << 16); }
__device__ __forceinline__ float gelu_tanh(float x) { const float u = 0.7978845608028654f * (x + 0.044715f * x * x * x); return 0.5f * x * (1.f + tanhf(u)); }

#define XB_TMO      128
#define XB_XCNT(j)  (256  + 64 * (j))
#define XB_XSUB(j)  (1280 + 64 * (j))
#define XB_XGEN(j)  (2304 + 64 * (j))
#define XB_TOP      3328
#define XB_TOPGEN   3392
#define XCD_BAR_WORDS 3456
#define XB_SPIN_CAP (1u << 18)

__device__ __forceinline__ unsigned xb_ld(unsigned* p)              { return __hip_atomic_load(p, __ATOMIC_RELAXED, __HIP_MEMORY_SCOPE_AGENT); }
__device__ __forceinline__ unsigned xb_add(unsigned* p, unsigned v) { return __hip_atomic_fetch_add(p, v, __ATOMIC_RELAXED, __HIP_MEMORY_SCOPE_AGENT); }
__device__ __forceinline__ unsigned xb_xcc_id() { return (unsigned)__builtin_amdgcn_s_getreg((3 << 11) | 20) & 0xFu; }
#define XB_SPIN(cond, bar) do { unsigned _sp = 0; while (cond) { __builtin_amdgcn_s_sleep(1); \
    if ((++_sp & 255u) == 0u) { if (xb_ld(&(bar)[XB_TMO])) break; if (_sp > XB_SPIN_CAP) { atomicAdd(&(bar)[XB_TMO], 1u); break; } } } } while (0)

struct XcdBarrier {
    unsigned* bar; unsigned x;
    volatile LAS unsigned* st;
};

__device__ __forceinline__ XcdBarrier xcd_barrier_post(unsigned* bar, volatile LAS unsigned* st) {
    XcdBarrier b; b.bar = bar; b.x = xb_xcc_id(); b.st = st;
    if (threadIdx.x == 0) (void)xb_add(&bar[XB_XCNT(b.x)], 1u);
    return b;
}
__device__ __forceinline__ void xcd_barrier_complete(unsigned* bar, unsigned x, unsigned& nloc, unsigned& nx) {
    const unsigned G = gridDim.x * gridDim.y * gridDim.z;
    unsigned sum, cnt, mine, sp = 0u;
    for (;;) {
        sum = 0u; cnt = 0u; mine = 0u;
#pragma unroll
        for (unsigned j = 0; j < 16; ++j) { const unsigned c = xb_ld(&bar[XB_XCNT(j)]); sum += c; cnt += (c > 0u) ? 1u : 0u; mine = (j == x) ? c : mine; }
        if (sum == G) break;
        __builtin_amdgcn_s_sleep(1);
        if ((++sp & 255u) == 0u) { if (xb_ld(&bar[XB_TMO])) break; if (sp > XB_SPIN_CAP) { atomicAdd(&bar[XB_TMO], 1u); break; } }
    }
    nloc = mine > 0u ? mine : 1u; nx = cnt > 0u ? cnt : 1u;
}

__device__ __forceinline__ void xcd_barrier(const XcdBarrier& b) {
    asm volatile("s_waitcnt vmcnt(0)" ::: "memory");
    __syncthreads();
    if (threadIdx.x == 0) {
        unsigned* bar = b.bar;
        __builtin_amdgcn_s_waitcnt(0);
        unsigned nloc = b.st[0], nx = b.st[1];
        if (nloc == 0u) { xcd_barrier_complete(bar, b.x, nloc, nx); b.st[0] = nloc; b.st[1] = nx; }
        const unsigned old = xb_add(&bar[XB_XSUB(b.x)], 1u);
        const unsigned gen = old / nloc;
        if (old + 1u == (gen + 1u) * nloc) {
            __builtin_amdgcn_fence(__ATOMIC_RELEASE, "agent");
            asm volatile("s_waitcnt vmcnt(0)" ::: "memory");
            const unsigned og = xb_add(&bar[XB_TOP], 1u);
            const unsigned tg = og / nx;
            if (og + 1u == (tg + 1u) * nx) xb_add(&bar[XB_TOPGEN], 1u);
            else XB_SPIN(xb_ld(&bar[XB_TOPGEN]) == tg, bar);
            __builtin_amdgcn_fence(__ATOMIC_ACQUIRE, "agent");
            xb_add(&bar[XB_XGEN(b.x)], 1u);
            asm volatile("s_waitcnt vmcnt(0)" ::: "memory");
        } else {
            XB_SPIN(xb_ld(&bar[XB_XGEN(b.x)]) == gen, bar);
            __builtin_amdgcn_fence(__ATOMIC_ACQUIRE, "agent");
            asm volatile("s_waitcnt vmcnt(0)" ::: "memory");
        }
    }
    __syncthreads();
}

struct Frame {
    LAS unsigned char* lds;
    int tid, lane, wave;
    int vcu, G;
};

__device__ __forceinline__ void p0_transpose_item(const float* W, int K, int N, bf16* WT, int row_off, LAS float* scr, int item, int lane) {
    const int nblk = N / 32, kb = item / nblk, nb = item % nblk, k0 = 64 * kb, n0 = 32 * nb;
#pragma unroll 8
    for (int i = 0; i < 32; ++i) { const int kk = 2 * i + (lane >> 5); scr[kk * 33 + (lane & 31)] = W[(size_t)(k0 + kk) * N + n0 + (lane & 31)]; }
    LDS_WAIT(); asm volatile("" ::: "memory");
    const int c = lane & 7;
#pragma unroll
    for (int j = 0; j < 4; ++j) { const int n = (lane >> 3) + 8 * j; const LAS float* s = scr + (8 * c) * 33 + n;
        v4u o; o.x = pk2(s[0 * 33], s[1 * 33]); o.y = pk2(s[2 * 33], s[3 * 33]); o.z = pk2(s[4 * 33], s[5 * 33]); o.w = pk2(s[6 * 33], s[7 * 33]);
        *(GAS v4u*)(WT + (size_t)(row_off + n0 + n) * K + k0 + 8 * c) = o; }
    LDS_WAIT(); asm volatile("" ::: "memory");
}

typedef short bf16x8 __attribute__((ext_vector_type(8)));
typedef float f32x16 __attribute__((ext_vector_type(16)));
typedef float f32x2_t __attribute__((ext_vector_type(2))); typedef __bf16 bf16x2_t __attribute__((ext_vector_type(2)));
__device__ __forceinline__ unsigned cvtpk(float lo, float hi) { f32x2_t v = {lo, hi}; bf16x2_t b = __builtin_convertvector(v, bf16x2_t); return __builtin_bit_cast(unsigned, b); }
__device__ __forceinline__ void split8(const f32x4 a, const f32x4 b, bf16x8& h, bf16x8& l) {
    v4u hh; hh.x = cvtpk(a.x, a.y); hh.y = cvtpk(a.z, a.w); hh.z = cvtpk(b.x, b.y); hh.w = cvtpk(b.z, b.w);
    v4u ll;
    ll.x = cvtpk(a.x - __uint_as_float(hh.x << 16), a.y - __uint_as_float(hh.x & 0xffff0000u));
    ll.y = cvtpk(a.z - __uint_as_float(hh.y << 16), a.w - __uint_as_float(hh.y & 0xffff0000u));
    ll.z = cvtpk(b.x - __uint_as_float(hh.z << 16), b.y - __uint_as_float(hh.z & 0xffff0000u));
    ll.w = cvtpk(b.z - __uint_as_float(hh.w << 16), b.w - __uint_as_float(hh.w & 0xffff0000u));
    h = __builtin_bit_cast(bf16x8, hh); l = __builtin_bit_cast(bf16x8, ll);
}
__device__ __forceinline__ float max3f_(float a, float b, float c) { return __builtin_fmaxf(__builtin_fmaxf(a, b), c); }
__device__ __forceinline__ float pair_max(float m) { auto rr = __builtin_amdgcn_permlane32_swap(__float_as_uint(m), __float_as_uint(m), false, false); return __builtin_fmaxf(__uint_as_float(rr[0]), __uint_as_float(rr[1])); }
typedef float f32x2v __attribute__((ext_vector_type(2)));
__device__ __forceinline__ unsigned pk4_fp8(float a, float b, float c, float d) { int p = __builtin_amdgcn_cvt_pk_fp8_f32(a, b, 0, false); p = __builtin_amdgcn_cvt_pk_fp8_f32(c, d, p, true); return (unsigned)p; }
constexpr float U8_SCALE = 64.f;
typedef short bf16x8_l __attribute__((ext_vector_type(8)));
template <int PASS, bool CONV = false> __device__ __forceinline__ void lru_phase(const Frame& F, unsigned char* ws, const float* conv_w, const float* conv_b, const float* b_a, const float* b_x, const float* lru_lambda, const float* tab_u = nullptr, const float* tab_v = nullptr) {
    int itc = 0;
    constexpr int XS = 272;
    LAS unsigned char* xs = F.lds + RING_OFF;
    const bf16* XR = (const bf16*)(ws + WS_XR); const bf16* XG = (const bf16*)(ws + WS_XG); bf16* MIX = (bf16*)(ws + WS_MIX); const bf16* WGT = (const bf16*)(ws + WS_WG);
    float* TA = (float*)(ws + WS_TOTA); float* TH = (float*)(ws + WS_TOTH);
    const int tid = F.tid, lane = F.lane, w = F.wave, l15 = lane & 15, g = lane >> 4;
    const int hb = F.vcu & 7;
    const int nun = 2048 / 8;
    const int gi = F.vcu >> 3, gn = (F.G + 7 - hb) >> 3;
    const int chc = tid & 127, tg = tid >> 7, colc = hb * 128 + chc;
    const float cw0 = conv_w[colc], cw1 = conv_w[1024 + colc], cw2 = conv_w[2048 + colc], cw3 = conv_w[3072 + colc], cb = conv_b[colc];
    const int chn = hb * 128 + 16 * w + l15;
    LAS unsigned char* wb = F.lds + RING_OFF + 49152 + w * 8192 + lane * 16;
#pragma unroll
    for (int ks = 0; ks < 4; ++ks) { *(LAS bf16x8_l*)(wb + ks * 1024) = *(const bf16x8_l*)(WGT + ((size_t)(hb * 128 + 16 * w + l15)) * 128 + 32 * ks + 8 * g);
        *(LAS bf16x8_l*)(wb + (4 + ks) * 1024) = *(const bf16x8_l*)(WGT + ((size_t)((8 + hb) * 128 + 16 * w + l15)) * 128 + 32 * ks + 8 * g); }
    const float ba = b_a[chn], bx = b_x[chn], sp8 = 8.f * log1pf(__expf(-lru_lambda[chn]));
    unsigned short xrn[19];
#define LRU_LOAD(uu) do { const int c_ = (uu) & 63, b_ = (uu) >> 6, tok0_ = b_ * SEQ + c_ * 64; \
        int ro_ = (tok0_ + tg * 16) * AW + colc; asm volatile("" : "+v"(ro_)); \
        _Pragma("unroll") for (int r = 0; r < 19; ++r) xrn[r] = (c_ * 64 + tg * 16 + r - 3 >= 0) ? XR[ro_ + (r - 3) * AW] : (unsigned short)0; \
        } while (0)
    if (gi < nun) LRU_LOAD(gi);
    for (int uu = gi; uu < nun; uu += gn) {
        const int c = uu & 63, b = uu >> 6, tok0 = b * SEQ + c * 64;
        {
            float xv[19];
#pragma unroll
            for (int r = 0; r < 19; ++r) xv[r] = bf2f(xrn[r]);
#pragma unroll
            for (int i = 0; i < 16; ++i) { const float y = cb + cw0 * xv[i] + cw1 * xv[i + 1] + cw2 * xv[i + 2] + cw3 * xv[i + 3];
                *(LAS unsigned short*)(xs + (tg * 16 + i) * XS + chc * 2) = (unsigned short)f2bf(y); }
        }
        unsigned short xgv[16]; float ta[16], th[16];
        if (PASS == 2) {
            int go_ = (tok0 + 4 * g) * AW + chn, to_ = b * 65536 + chn; asm volatile("" : "+v"(go_), "+v"(to_));
#pragma unroll
            for (int m = 0; m < 4; ++m)
#pragma unroll
                for (int r = 0; r < 4; ++r) xgv[4 * m + r] = XG[go_ + (16 * m + r) * AW];
#pragma unroll
            for (int i = 0; i < 16; ++i) { const int c2 = 16 * g + i, cl = c2 < c ? c2 : 0; ta[i] = TA[to_ + cl * 1024]; th[i] = TH[to_ + cl * 1024]; }
        }
        __syncthreads();
        if (uu + gn < nun) LRU_LOAD(uu + gn);
        f32x4 cu_[8]; const int itcc = itc < 7 ? itc : 7;
        if (CONV) {
            if (PASS == 1) { int uo_ = (F.vcu * 64 + itcc * 8 + w) * (D / 4) + lane; asm volatile("" : "+v"(uo_));
#pragma unroll
                for (int j = 0; j < 8; ++j) cu_[j] = ((const f32x4*)tab_u)[uo_ + 64 * j]; }
            else { int vo_ = (F.vcu * 64 + (tid >> 6)) * (D / 4) + itcc * 64 + (tid & 63); asm volatile("" : "+v"(vo_));
#pragma unroll
                for (int j = 0; j < 8; ++j) cu_[j] = ((const f32x4*)tab_v)[vo_ + 8 * j * (D / 4)]; }
        }
        f32x4 ca[4], cx[4];
#pragma unroll
        for (int m = 0; m < 4; ++m) { ca[m] = (f32x4){0.f, 0.f, 0.f, 0.f}; cx[m] = (f32x4){0.f, 0.f, 0.f, 0.f};
#pragma unroll
            for (int ks = 0; ks < 4; ++ks) { const bf16x8_l A = *(const LAS bf16x8_l*)(xs + (16 * m + l15) * XS + (32 * ks + 8 * g) * 2);
                const bf16x8_l Bak = *(const LAS bf16x8_l*)(wb + ks * 1024), Bxk = *(const LAS bf16x8_l*)(wb + (4 + ks) * 1024);
                ca[m] = __builtin_amdgcn_mfma_f32_16x16x32_bf16(A, Bak, ca[m], 0, 0, 0); cx[m] = __builtin_amdgcn_mfma_f32_16x16x32_bf16(A, Bxk, cx[m], 0, 0, 0); } }
        float av[4][4], bv[4][4];
#pragma unroll
        for (int m = 0; m < 4; ++m)
#pragma unroll
            for (int r = 0; r < 4; ++r) { const int tt = 16 * m + 4 * g + r;
                const float rg = 1.f / (1.f + __expf(-(ca[m][r] + ba))), ig = 1.f / (1.f + __expf(-(cx[m][r] + bx)));
                const float a = __expf(-sp8 * rg), xcv = bf2f(*(const LAS unsigned short*)(xs + tt * XS + (16 * w + l15) * 2));
                av[m][r] = a; bv[m][r] = sqrtf(fmaxf(1.f - a * a, 0.f)) * ig * xcv; }
        float carry = 0.f, Ac = 1.f;
        if (PASS == 2) {
            float Ap = 1.f, Hp = 0.f;
#pragma unroll
            for (int i = 0; i < 16; ++i) { const bool in_ = 16 * g + i < c; const float ta_ = in_ ? ta[i] : 1.f, th_ = in_ ? th[i] : 0.f; Hp = ta_ * Hp + th_; Ap *= ta_; }
            { const float A1 = __shfl_up(Ap, 16), H1 = __shfl_up(Hp, 16); if (g >= 1) { Hp = Ap * H1 + Hp; Ap = Ap * A1; } }
            { const float A2 = __shfl_up(Ap, 32), H2 = __shfl_up(Hp, 32); if (g >= 2) { Hp = Ap * H2 + Hp; Ap = Ap * A2; } }
            carry = __shfl(Hp, 48 + l15);
        }
#pragma unroll
        for (int m = 0; m < 4; ++m) {
            float As = (av[m][0] * av[m][1]) * (av[m][2] * av[m][3]);
            float Hs = ((bv[m][0] * av[m][1] + bv[m][1]) * av[m][2] + bv[m][2]) * av[m][3] + bv[m][3];
            { const float A1 = __shfl_up(As, 16), H1 = __shfl_up(Hs, 16); if (g >= 1) { Hs = As * H1 + Hs; As = As * A1; } }
            { const float A2 = __shfl_up(As, 32), H2 = __shfl_up(Hs, 32); if (g >= 2) { Hs = As * H2 + Hs; As = As * A2; } }
            const float At = __shfl(As, 48 + l15), Ht = __shfl(Hs, 48 + l15);
            if (PASS == 2) {
                float Ae = __shfl_up(As, 16), He = __shfl_up(Hs, 16); if (g == 0) { Ae = 1.f; He = 0.f; }
                float h = Ae * carry + He;
                int mo_ = (tok0 + 16 * m + 4 * g) * D + 1024 + chn; asm volatile("" : "+v"(mo_));
#pragma unroll
                for (int r = 0; r < 4; ++r) { h = av[m][r] * h + bv[m][r];
                    MIX[mo_ + r * D] = (bf16)f2bf(h * gelu_tanh(bf2f(xgv[4 * m + r]))); }
            }
            carry = At * carry + Ht; Ac *= At;
        }
        if (PASS == 1 && g == 0) { int so_ = (b * 64 + c) * 1024 + chn; asm volatile("" : "+v"(so_)); TA[so_] = Ac; TH[so_] = carry; }
        if (CONV && PASS == 1 && itc < 8) {
            const int e = F.vcu * 64 + itc * 8 + w; float am = 0.f;
#pragma unroll
            for (int j = 0; j < 8; ++j) am = fmaxf(fmaxf(am, fmaxf(fabsf(cu_[j].x), fabsf(cu_[j].y))), fmaxf(fabsf(cu_[j].z), fabsf(cu_[j].w)));
#pragma unroll
            for (int o = 1; o < 64; o <<= 1) am = fmaxf(am, __shfl_xor(am, o));
            const float qs = am > 0.f ? 127.f / am : 0.f;
            if (lane == 0) ((float*)(ws + WS_SU))[e] = am * (1.f / 127.f);
#pragma unroll
            for (int j = 0; j < 8; ++j) { const int cc_ = (lane + 64 * j) * 4;
                const unsigned q = ((unsigned)(int)rintf(cu_[j].x * qs) & 0xffu) | (((unsigned)(int)rintf(cu_[j].y * qs) & 0xffu) << 8) | (((unsigned)(int)rintf(cu_[j].z * qs) & 0xffu) << 16) | (((unsigned)(int)rintf(cu_[j].w * qs) & 0xffu) << 24);
                *(unsigned*)(ws + WS_U8 + ((size_t)(cc_ >> 7) * 16384 + e) * 128 + (cc_ & 127)) = q; }
        }
        if (CONV && PASS == 2) {
            LAS unsigned char* tl = F.lds + RING_OFF + 32768;
            int tq_ = tid; asm volatile("" : "+v"(tq_));
            if (itc < 8) { const int lo_ = ((4 * (tq_ & 63)) >> 3) * 512 + (tq_ >> 6) * 8 + ((4 * (tq_ & 63)) & 7);
#pragma unroll
                for (int j = 0; j < 8; ++j) *(LAS unsigned*)(tl + lo_ + 64 * j) = pk4_fp8(cu_[j].x, cu_[j].y, cu_[j].z, cu_[j].w); }
            __syncthreads();
            if (itc < 8) { const int cu2 = tq_ >> 5, pc = tq_ & 31;
#pragma unroll
                for (int j = 0; j < 2; ++j)
                    *(v4u*)(ws + WS_V8 + ((size_t)(itc * 32 + cu2 + 16 * j) * 16384 + F.vcu * 64) * 8 + pc * 16) = *(const LAS v4u*)(tl + (cu2 + 16 * j) * 512 + pc * 16); }
        }
        ++itc;
        __syncthreads();
    }
#undef LRU_LOAD
}
struct Args { const float* in[23]; float* out; unsigned char* ws; int ph_lo, ph_hi; };

__global__ void __launch_bounds__(NWAVES * 64, 2) skel_fwd(Args args) {
    extern __shared__ __attribute__((aligned(16))) unsigned char lds[];
    Frame F;
    F.lds = (LAS unsigned char*)lds;
    F.tid = threadIdx.x; F.lane = F.tid & 63; F.wave = __builtin_amdgcn_readfirstlane(F.tid >> 6);
    F.G = gridDim.x; { const int bx = blockIdx.x; F.vcu = (F.G % 8 == 0) ? (bx % 8) * (F.G / 8) + bx / 8 : bx; }
    unsigned char* ws = args.ws;
    const float* x = args.in[0];
    bf16* WIN_T = (bf16*)(ws + WS_WIN); bf16* WOUT_T = (bf16*)(ws + WS_WOUT); bf16* WQ_T = (bf16*)(ws + WS_WQ);
    bf16* XB = (bf16*)(ws + WS_XB); bf16* MIX = (bf16*)(ws + WS_MIX); bf16* QB = (bf16*)(ws + WS_Q); bf16* H1 = (bf16*)(ws + WS_H1);
    float* Y1 = (float*)(ws + WS_Y1); float* PQ = (float*)(ws + WS_PQ);
    for (int u = F.tid; u < (LDS_BYTES - LDSCTL_OFF) / 4; u += NWAVES * 64) ((LAS unsigned*)(F.lds + LDSCTL_OFF))[u] = 0u;
    __syncthreads();
    XcdBarrier bar = xcd_barrier_post((unsigned*)(ws + WS_CTL) + CW_BAR, (volatile LAS unsigned*)(F.lds + MISC_OFF) + 8);
    const unsigned phmask = (unsigned)args.ph_lo;
    int slot_ = 0;
#define IN(k) (false)
#define RUN(slotbit) ((phmask >> (slotbit)) & 1u)
#define GRID_BAR() do { if (phmask == 0xffffffffu) xcd_barrier(bar); } while (0)

    if (RUN(0)) {
        if (blockIdx.x == 0 && F.wave == 0) {
            float a_ = args.in[9][F.lane] * args.in[10][F.lane], b_ = args.in[11][F.lane] * args.in[12][F.lane];
#pragma unroll
            for (int o = 1; o < 64; o <<= 1) { a_ += __shfl_xor(a_, o); b_ += __shfl_xor(b_, o); }
            if (F.lane == 0) ((float*)(ws + WS_PRM))[0] = expf(a_) - expf(b_) + 0.2f;
        }
        LAS float* scr = (LAS float*)(F.lds + RING_OFF + F.wave * 16384);
        const int gw = F.vcu * NWAVES + F.wave, NGW = F.G * NWAVES;
        constexpr int I_IN = (D / 64) * (NIN / 32), I_SQ = (D / 64) * (D / 32);
        constexpr int NITEMS = I_IN + 2 * I_SQ;
        for (int it = gw; it < NITEMS; it += NGW) {
            int r = it;
            if (r < I_IN) { p0_transpose_item(args.in[1], D, NIN, WIN_T, 0, scr, r, F.lane); continue; } r -= I_IN;
            if (r < I_SQ) { p0_transpose_item(args.in[14], D, D, WOUT_T, 0, scr, r, F.lane); continue; } r -= I_SQ;
            p0_transpose_item(args.in[17], D, D, WQ_T, 0, scr, r, F.lane);
        }
        for (int it = gw; it < 128; it += NGW) { const int mt = it >> 3;
            p0_transpose_item(args.in[mt < 8 ? 4 : 6] + (size_t)(mt & 7) * 16384, 128, 128, (bf16*)(ws + WS_WG) + (size_t)mt * 16384, 0, scr, it & 7, F.lane); }
        {
            const float* sk = args.in[18]; v4u* SKH = (v4u*)(ws + WS_SKH); v4u* SKL = (v4u*)(ws + WS_SKL);
            for (int fi = gw; fi < 512; fi += NGW) { const int ds = fi & 7, kt = (fi >> 3) & 3, hp = fi >> 5;
                const float* src = sk + ((size_t)(hp * 128 + kt * 32 + (F.lane & 31)) * 128 + 16 * ds + 8 * (F.lane >> 5));
                bf16x8 h8, l8; split8(*(const f32x4*)src, *(const f32x4*)(src + 4), h8, l8);
                SKH[fi * 64 + F.lane] = __builtin_bit_cast(v4u, h8); SKL[fi * 64 + F.lane] = __builtin_bit_cast(v4u, l8); }
        }
        for (int m = gw; m < M; m += NGW) {
            const GAS f32x4* xr = (const GAS f32x4*)(x + (size_t)m * D) + F.lane;
            GAS unsigned long long* o8 = (GAS unsigned long long*)(XB + (size_t)m * D) + F.lane;
#pragma unroll
            for (int j = 0; j < 8; ++j) { const f32x4 v = xr[64 * j]; o8[64 * j] = (unsigned long long)pk2(v.x, v.y) | ((unsigned long long)pk2(v.z, v.w) << 32); }
        }
    }
    GRID_BAR();
    if (RUN(1)) {
        pg8::Gemm g{XB, WIN_T, M, NIN, D}; pg8::StaticOrder S; S.init(M, NIN, F.G, (int)blockIdx.x);
        pg8::EpiBf16<0> E{QB, AW, nullptr, AW, (size_t)(WS_K - WS_Q) / 2, C2};
        pg8::gemm_phase<pg8::EpiBf16<0>, pg8::StaticOrder, PG8_ALIGN, PG8_SP2>(F.lds + RING_OFF, g, S, E);
    }
    GRID_BAR();
    if (RUN(2)) {
        const bool fusedconv = (F.G == 256);
#pragma unroll 1
        for (int step = 0; step < 2; ++step) {
            if (fusedconv ? (step == 0) : (((step ^ F.vcu) & 1) == 0)) {
                if (fusedconv) lru_phase<1, true>(F, ws, args.in[2], args.in[3], args.in[5], args.in[7], args.in[8], args.in[19], args.in[20]);
                else lru_phase<1, false>(F, ws, args.in[2], args.in[3], args.in[5], args.in[7], args.in[8]);
                {
                    const int gw = F.vcu * NWAVES + F.wave, NGW = F.G * NWAVES, lane = F.lane; unsigned* ctlw = (unsigned*)(ws + WS_CTL);
                    for (int it = gw; it < 2 * (M / 16); it += NGW) { const int z = it & 1, r16 = it >> 1; const bf16* src = (const bf16*)(ws + (z ? WS_K : WS_Q)) + (size_t)r16 * 16 * AW + 8 * lane;
                        float mx0 = 0.f, mx1 = 0.f;
#pragma unroll 4
                        for (int r = 0; r < 16; ++r) {
#pragma unroll
                            for (int hf = 0; hf < 2; ++hf) { const v4u q = *(const v4u*)(src + (size_t)r * AW + hf * 512); float ss = 0.f;
#pragma unroll
                                for (int e = 0; e < 4; ++e) { const float lo = __uint_as_float(q[e] << 16), hi = __uint_as_float(q[e] & 0xffff0000u); ss += lo * lo + hi * hi; }
                                ss += __builtin_bit_cast(float, __builtin_amdgcn_update_dpp(0, __builtin_bit_cast(int, ss), 0xB1, 0xf, 0xf, true)); ss += __builtin_bit_cast(float, __builtin_amdgcn_update_dpp(0, __builtin_bit_cast(int, ss), 0x4E, 0xf, 0xf, true));
                                ss += __builtin_bit_cast(float, __builtin_amdgcn_update_dpp(0, __builtin_bit_cast(int, ss), 0x141, 0xf, 0xf, true));
                                if (hf == 0) mx0 = fmaxf(mx0, ss); else mx1 = fmaxf(mx1, ss); } }
                        if ((lane & 7) == 0) { unsigned* dst = ctlw + (z ? CW_NK : CW_NQ) + (r16 >> 2) * 16 + (lane >> 3); atomicMax(dst, __float_as_uint(mx0)); atomicMax(dst + 8, __float_as_uint(mx1)); }
                    }
                }
            } else if (!fusedconv) {
                for (int item = F.vcu; item < 512; item += F.G) {
                    if (item < 256) {
                        const float* us = args.in[19]; float* SU = (float*)(ws + WS_SU);
                        f32x4 uv[8];
                        { const f32x4* ur = (const f32x4*)(us + (size_t)(item * 64 + F.wave) * D);
#pragma unroll
                          for (int j = 0; j < 8; ++j) uv[j] = ur[F.lane + 64 * j]; }
                        for (int e = item * 64 + F.wave; e < item * 64 + 64; e += NWAVES) {
                            f32x4 un[8]; { const int en = e + NWAVES < item * 64 + 64 ? e + NWAVES : e; const f32x4* ur = (const f32x4*)(us + (size_t)en * D);
#pragma unroll
                              for (int j = 0; j < 8; ++j) un[j] = ur[F.lane + 64 * j]; }
                            float am = 0.f;
#pragma unroll
                            for (int j = 0; j < 8; ++j) am = fmaxf(fmaxf(am, fmaxf(fabsf(uv[j].x), fabsf(uv[j].y))), fmaxf(fabsf(uv[j].z), fabsf(uv[j].w)));
#pragma unroll
                            for (int o = 1; o < 64; o <<= 1) am = fmaxf(am, __shfl_xor(am, o));
                            const float qs = am > 0.f ? 127.f / am : 0.f;
                            if (F.lane == 0) SU[e] = am * (1.f / 127.f);
#pragma unroll
                            for (int j = 0; j < 8; ++j) { const int c = (F.lane + 64 * j) * 4;
                                const unsigned q = ((unsigned)(int)rintf(uv[j].x * qs) & 0xffu) | (((unsigned)(int)rintf(uv[j].y * qs) & 0xffu) << 8) | (((unsigned)(int)rintf(uv[j].z * qs) & 0xffu) << 16) | (((unsigned)(int)rintf(uv[j].w * qs) & 0xffu) << 24);
                                *(unsigned*)(ws + WS_U8 + ((size_t)(c >> 7) * 16384 + e) * 128 + (c & 127)) = q; }
#pragma unroll
                            for (int j = 0; j < 8; ++j) uv[j] = un[j];
                        }
                    } else {
                        const float* vs = args.in[20]; unsigned char* V8 = ws + WS_V8; LAS unsigned char* tl = F.lds + RING_OFF;
                        f32x4 vv[8];
                        { const int t = (item - 256) * 8, e0 = (t >> 3) * 64, c0 = (t & 7) * 256;
#pragma unroll
                          for (int j = 0; j < 8; ++j) { const int idx = F.tid + 512 * j, r = idx >> 6, c = 4 * (idx & 63); vv[j] = *(const f32x4*)(vs + (size_t)(e0 + r) * D + c0 + c); } }
                        for (int t = (item - 256) * 8; t < (item - 256) * 8 + 8; ++t) { const int e0 = (t >> 3) * 64, c0 = (t & 7) * 256;
                            f32x4 vn[8]; { const int tn = t + 1 < (item - 256) * 8 + 8 ? t + 1 : t, e1 = (tn >> 3) * 64, c1 = (tn & 7) * 256;
#pragma unroll
                              for (int j = 0; j < 8; ++j) { const int idx = F.tid + 512 * j, r = idx >> 6, c = 4 * (idx & 63); vn[j] = *(const f32x4*)(vs + (size_t)(e1 + r) * D + c1 + c); } }
                            __syncthreads();
#pragma unroll
                            for (int j = 0; j < 8; ++j) { const int idx = F.tid + 512 * j, r = idx >> 6, c = 4 * (idx & 63);
                                *(LAS unsigned*)(tl + (c >> 3) * 512 + r * 8 + (c & 7)) = pk4_fp8(vv[j].x, vv[j].y, vv[j].z, vv[j].w); }
                            __syncthreads();
#pragma unroll
                            for (int j = 0; j < 2; ++j) { const int cu = (F.tid >> 5) + 16 * j, pc = F.tid & 31;
                                *(v4u*)(V8 + ((size_t)((c0 >> 3) + cu) * 16384 + e0) * 8 + pc * 16) = *(const LAS v4u*)(tl + cu * 512 + pc * 16); }
#pragma unroll
                            for (int j = 0; j < 8; ++j) vv[j] = vn[j];
                        }
                    }
                }
                __syncthreads();
            }
        }
    }
    GRID_BAR();
    if (RUN(4)) {
        static_assert(datt::LDS_BYTES <= RING_BYTES, "attention LDS vs ring");
        const datt::Tensors DT{(const datt::bf16*)QB, (const datt::bf16*)(ws + WS_K), (const datt::bf16*)(ws + WS_V), (datt::bf16*)(ws + WS_O0), (datt::bf16*)(ws + WS_O1),
                               (const unsigned*)(ws + WS_CTL) + CW_NQ, (const unsigned*)(ws + WS_CTL) + CW_NK, (unsigned*)(ws + WS_CTL) + CW_AQ, datt_order};
        datt::datt_phase((char*)lds + RING_OFF, (volatile LAS unsigned*)(F.lds + MISC_OFF) + 16, DT);
    }
    if (RUN(5)) { if (F.G == 256) lru_phase<2, true>(F, ws, args.in[2], args.in[3], args.in[5], args.in[7], args.in[8], args.in[19], args.in[20]);
        else lru_phase<2, false>(F, ws, args.in[2], args.in[3], args.in[5], args.in[7], args.in[8]); }
    GRID_BAR();
    if (RUN(6)) {
        const int gw = F.vcu * NWAVES + F.wave, NGW = F.G * NWAVES, sub = F.lane >> 4, l16 = F.lane & 15;
        const float lam = ((const float*)(ws + WS_PRM))[0];
        const bf16* O0 = (const bf16*)(ws + WS_O0); const bf16* O1 = (const bf16*)(ws + WS_O1);
        float gs[8];
#pragma unroll
        for (int e = 0; e < 8; ++e) gs[e] = args.in[13][l16 * 8 + e] * 0.8f;
        for (int it = gw; it < M * 2; it += NGW) { const int item = it * 4 + sub, tok = item >> 3, h = item & 7;
            const v4u a = *(const v4u*)(O0 + (size_t)tok * AW + h * 128 + l16 * 8), b = *(const v4u*)(O1 + (size_t)tok * AW + h * 128 + l16 * 8);
            float d[8]; float ss = 0.f;
#pragma unroll
            for (int e = 0; e < 4; ++e) { d[2 * e] = __uint_as_float(a[e] << 16) - lam * __uint_as_float(b[e] << 16); d[2 * e + 1] = __uint_as_float(a[e] & 0xffff0000u) - lam * __uint_as_float(b[e] & 0xffff0000u); ss += d[2 * e] * d[2 * e] + d[2 * e + 1] * d[2 * e + 1]; }
            ss += __builtin_bit_cast(float, __builtin_amdgcn_update_dpp(0, __builtin_bit_cast(int, ss), 0xB1, 0xf, 0xf, true)); ss += __builtin_bit_cast(float, __builtin_amdgcn_update_dpp(0, __builtin_bit_cast(int, ss), 0x4E, 0xf, 0xf, true));
            ss += __builtin_bit_cast(float, __builtin_amdgcn_update_dpp(0, __builtin_bit_cast(int, ss), 0x141, 0xf, 0xf, true)); ss += __builtin_bit_cast(float, __builtin_amdgcn_update_dpp(0, __builtin_bit_cast(int, ss), 0x140, 0xf, 0xf, true));
            const float r = rsqrtf(ss * (1.f / 128.f) + LN_EPS);
            *(v4u*)(MIX + (size_t)tok * D + h * 128 + l16 * 8) = (v4u){pk2(d[0] * r * gs[0], d[1] * r * gs[1]), pk2(d[2] * r * gs[2], d[3] * r * gs[3]), pk2(d[4] * r * gs[4], d[5] * r * gs[5]), pk2(d[6] * r * gs[6], d[7] * r * gs[7])}; }
    }
    GRID_BAR();
    if (RUN(7)) {
        pg8::Gemm g{MIX, WOUT_T, M, D, D}; pg8::StaticOrder S; S.init(M, D, F.G, (int)blockIdx.x);
        pg8::EpiBf16<0> E{(bf16*)Y1, D, nullptr, 0, 0, 1.f};
        pg8::gemm_phase<pg8::EpiBf16<0>, pg8::StaticOrder, PG8_ALIGN, PG8_SP2>(F.lds + RING_OFF, g, S, E);
    }
    GRID_BAR();
    if (RUN(8)) {
        const int gw = F.vcu * NWAVES + F.wave, NGW = F.G * NWAVES; const float* g = args.in[15]; const float* bb = args.in[16];
        for (int row = gw; row < M; row += NGW) {
            const unsigned long long* xr_ = (const unsigned long long*)(XB + (size_t)row * D); const unsigned long long* yb = (const unsigned long long*)((const bf16*)Y1 + (size_t)row * D);
            f32x4 v[8]; float s = 0.f;
#pragma unroll
            for (int j = 0; j < 8; ++j) { const unsigned long long x_ = xr_[F.lane + 64 * j]; const unsigned x0 = (unsigned)x_, x1 = (unsigned)(x_ >> 32); const f32x4 xv_ = (f32x4){__uint_as_float(x0 << 16), __uint_as_float(x0 & 0xffff0000u), __uint_as_float(x1 << 16), __uint_as_float(x1 & 0xffff0000u)};
                const unsigned long long q_ = yb[F.lane + 64 * j]; const unsigned q0 = (unsigned)q_, q1 = (unsigned)(q_ >> 32);
                v[j].x = DN_ALPHA * xv_.x + __uint_as_float(q0 << 16); v[j].y = DN_ALPHA * xv_.y + __uint_as_float(q0 & 0xffff0000u); v[j].z = DN_ALPHA * xv_.z + __uint_as_float(q1 << 16); v[j].w = DN_ALPHA * xv_.w + __uint_as_float(q1 & 0xffff0000u);
                s += (v[j].x + v[j].y) + (v[j].z + v[j].w); }
#pragma unroll
            for (int o = 1; o < 64; o <<= 1) s += __shfl_xor(s, o);
            const float mean = s * (1.f / D); float s2 = 0.f;
#pragma unroll
            for (int j = 0; j < 8; ++j) { v[j] = v[j] - mean; s2 += (v[j].x * v[j].x + v[j].y * v[j].y) + (v[j].z * v[j].z + v[j].w * v[j].w); }
#pragma unroll
            for (int o = 1; o < 64; o <<= 1) s2 += __shfl_xor(s2, o);
            const float rstd = rsqrtf(s2 * (1.f / D) + LN_EPS);
#pragma unroll
            for (int j = 0; j < 8; ++j) { const int c = (F.lane + 64 * j) * 4; const f32x4 gg = *(const f32x4*)(g + c), bv = *(const f32x4*)(bb + c);
                const f32x4 o = v[j] * rstd * gg + bv;
                *(unsigned long long*)(H1 + (size_t)row * D + c) = (unsigned long long)pk2(o.x, o.y) | ((unsigned long long)pk2(o.z, o.w) << 32);
                v[j] = o; }
            float am = 0.f;
#pragma unroll
            for (int j = 0; j < 8; ++j) am = fmaxf(fmaxf(am, fmaxf(fabsf(v[j].x), fabsf(v[j].y))), fmaxf(fabsf(v[j].z), fabsf(v[j].w)));
#pragma unroll
            for (int o = 1; o < 64; o <<= 1) am = fmaxf(am, __shfl_xor(am, o));
            const float qs = am > 0.f ? 127.f / am : 0.f;
            if (F.lane == 0) ((float*)(ws + WS_SH))[row] = am * (1.f / 127.f);
#pragma unroll
            for (int j = 0; j < 8; ++j) { const int c = (F.lane + 64 * j) * 4;
                const unsigned q = ((unsigned)(int)rintf(v[j].x * qs) & 0xffu) | (((unsigned)(int)rintf(v[j].y * qs) & 0xffu) << 8) | (((unsigned)(int)rintf(v[j].z * qs) & 0xffu) << 16) | (((unsigned)(int)rintf(v[j].w * qs) & 0xffu) << 24);
                *(unsigned*)(ws + WS_H8 + ((size_t)(c >> 7) * M + row) * 128 + (c & 127)) = q; }
        }
    }
    GRID_BAR();
    if (RUN(9)) {
        pg8::Gemm g{H1, WQ_T, M, D, D}; pg8::StaticOrder S; S.init(M, D, F.G, (int)blockIdx.x);
        pg8::EpiBf16<0> E{(bf16*)PQ, D, nullptr, 0, 0, 1.f};
        pg8::gemm_phase<pg8::EpiBf16<0>, pg8::StaticOrder, PG8_ALIGN, PG8_SP2>(F.lds + RING_OFF, g, S, E);
    }
    GRID_BAR();
    if (RUN(10)) {
        const int nh = (F.G & 7) == 0 ? 8 : 1;
        int* E = (int*)(ws + WS_E); float* G = (float*)(ws + WS_G);
        for (int h = F.vcu % nh; h < 8; h += nh) {
            __syncthreads();
            {
                int tq = F.tid; asm volatile("" : "+v"(tq));
#pragma unroll 4
                for (int j = 0; j < 16; ++j) { const int i = tq + 512 * j, p = i >> 12, hl = (i >> 11) & 1, fl = i & 2047;
                    *(LAS v4u*)(F.lds + RING_OFF + (size_t)i * 16) = ((const v4u*)(ws + WS_SKH))[(size_t)hl * 65536 + (size_t)(h * 2 + p) * 2048 + fl]; }
            }
            __syncthreads();
            const int wv = (F.vcu / nh) * NWAVES + F.wave, nwv = ((F.G + nh - 1 - F.vcu % nh) / nh) * NWAVES;
            v4u qn[8];
#define ROUTE_LOADQ() do { _Pragma("unroll") for (int ds = 0; ds < 8; ++ds) qn[ds] = *(const v4u*)(qptr + 16 * ds); } while (0)
            const bf16* qptr = (const bf16*)PQ + (size_t)(wv * 32 + (F.lane & 31)) * D + h * 256 + 8 * (F.lane >> 5);
            if (wv < M / 32) ROUTE_LOADQ();
            for (int tg = wv; tg < M / 32; tg += nwv) { int ln_ = F.lane; asm volatile("" : "+v"(ln_));
                const int tl = ln_ & 31, hi = ln_ >> 5, tok = tg * 32 + tl;
                LAS unsigned char* scr = F.lds + RING_BYTES + 1024 + F.wave * 1024 + tl * 32;
                float sa[16], sb[16];
#pragma unroll
                for (int p = 0; p < 2; ++p) {
                    f32x16 sc[4];
#pragma unroll
                    for (int kt = 0; kt < 4; ++kt) sc[kt] = f32x16{};
#pragma unroll
                    for (int ds = 0; ds < 8; ++ds) { const bf16x8 qh = __builtin_bit_cast(bf16x8, qn[ds]);
#pragma unroll
                        for (int kt = 0; kt < 4; ++kt) { const bf16x8 ah = *(const LAS bf16x8*)(F.lds + RING_OFF + ((p * 2 + 0) * 32 + kt * 8 + ds) * 1024 + F.lane * 16), al = *(const LAS bf16x8*)(F.lds + RING_OFF + ((p * 2 + 1) * 32 + kt * 8 + ds) * 1024 + F.lane * 16);
                            sc[kt] = __builtin_amdgcn_mfma_f32_32x32x16_bf16(ah, qh, sc[kt], 0, 0, 0);
                            sc[kt] = __builtin_amdgcn_mfma_f32_32x32x16_bf16(al, qh, sc[kt], 0, 0, 0); } }
                    if (p == 0) { qptr += 128; ROUTE_LOADQ(); } else if (tg + nwv < M / 32) { qptr += (size_t)nwv * 32 * D - 128; ROUTE_LOADQ(); }
#pragma unroll
                    for (int kt = 0; kt < 4; ++kt)
#pragma unroll
                        for (int r = 0; r < 16; ++r) { const unsigned key = (unsigned)(kt * 32 + (r & 3) + 8 * (r >> 2) + 4 * hi); sc[kt][r] = __uint_as_float((__float_as_uint(sc[kt][r]) & ~127u) | (127u - key)); }
#define CE_(x, y) do { const float h_ = __builtin_fmaxf(x, y), l_ = __builtin_fminf(x, y); x = h_; y = l_; } while (0)
                    CE_(sc[0][0], sc[0][1]); CE_(sc[0][2], sc[0][3]); CE_(sc[0][0], sc[0][2]); CE_(sc[0][1], sc[0][3]); CE_(sc[0][1], sc[0][2]); CE_(sc[0][4], sc[0][5]); CE_(sc[0][6], sc[0][7]); CE_(sc[0][4], sc[0][6]); CE_(sc[0][5], sc[0][7]); CE_(sc[0][5], sc[0][6]); CE_(sc[0][0], sc[0][4]); CE_(sc[0][2], sc[0][6]); CE_(sc[0][2], sc[0][4]); CE_(sc[0][1], sc[0][5]); CE_(sc[0][3], sc[0][7]); CE_(sc[0][3], sc[0][5]); CE_(sc[0][1], sc[0][2]); CE_(sc[0][3], sc[0][4]); CE_(sc[0][5], sc[0][6]); CE_(sc[0][8], sc[0][9]); CE_(sc[0][10], sc[0][11]); CE_(sc[0][8], sc[0][10]); CE_(sc[0][9], sc[0][11]); CE_(sc[0][9], sc[0][10]); CE_(sc[0][12], sc[0][13]); CE_(sc[0][14], sc[0][15]); CE_(sc[0][12], sc[0][14]); CE_(sc[0][13], sc[0][15]); CE_(sc[0][13], sc[0][14]); CE_(sc[0][8], sc[0][12]); CE_(sc[0][10], sc[0][14]); CE_(sc[0][10], sc[0][12]); CE_(sc[0][9], sc[0][13]); CE_(sc[0][11], sc[0][15]); CE_(sc[0][11], sc[0][13]); CE_(sc[0][9], sc[0][10]); CE_(sc[0][11], sc[0][12]); CE_(sc[0][13], sc[0][14]); CE_(sc[0][0], sc[0][8]); CE_(sc[0][4], sc[0][12]); CE_(sc[0][4], sc[0][8]); CE_(sc[0][2], sc[0][10]); CE_(sc[0][6], sc[0][14]); CE_(sc[0][6], sc[0][10]); CE_(sc[0][2], sc[0][4]); CE_(sc[0][6], sc[0][8]); CE_(sc[0][10], sc[0][12]); CE_(sc[0][1], sc[0][9]); CE_(sc[0][5], sc[0][13]); CE_(sc[0][5], sc[0][9]); CE_(sc[0][3], sc[0][11]); CE_(sc[0][7], sc[0][15]); CE_(sc[0][7], sc[0][11]); CE_(sc[0][3], sc[0][5]); CE_(sc[0][7], sc[0][9]); CE_(sc[0][11], sc[0][13]); CE_(sc[0][1], sc[0][2]); CE_(sc[0][3], sc[0][4]); CE_(sc[0][5], sc[0][6]); CE_(sc[0][7], sc[0][8]); CE_(sc[0][9], sc[0][10]); CE_(sc[0][11], sc[0][12]); CE_(sc[0][13], sc[0][14]);
                    CE_(sc[1][0], sc[1][1]); CE_(sc[1][2], sc[1][3]); CE_(sc[1][0], sc[1][2]); CE_(sc[1][1], sc[1][3]); CE_(sc[1][1], sc[1][2]); CE_(sc[1][4], sc[1][5]); CE_(sc[1][6], sc[1][7]); CE_(sc[1][4], sc[1][6]); CE_(sc[1][5], sc[1][7]); CE_(sc[1][5], sc[1][6]); CE_(sc[1][0], sc[1][4]); CE_(sc[1][2], sc[1][6]); CE_(sc[1][2], sc[1][4]); CE_(sc[1][1], sc[1][5]); CE_(sc[1][3], sc[1][7]); CE_(sc[1][3], sc[1][5]); CE_(sc[1][1], sc[1][2]); CE_(sc[1][3], sc[1][4]); CE_(sc[1][5], sc[1][6]); CE_(sc[1][8], sc[1][9]); CE_(sc[1][10], sc[1][11]); CE_(sc[1][8], sc[1][10]); CE_(sc[1][9], sc[1][11]); CE_(sc[1][9], sc[1][10]); CE_(sc[1][12], sc[1][13]); CE_(sc[1][14], sc[1][15]); CE_(sc[1][12], sc[1][14]); CE_(sc[1][13], sc[1][15]); CE_(sc[1][13], sc[1][14]); CE_(sc[1][8], sc[1][12]); CE_(sc[1][10], sc[1][14]); CE_(sc[1][10], sc[1][12]); CE_(sc[1][9], sc[1][13]); CE_(sc[1][11], sc[1][15]); CE_(sc[1][11], sc[1][13]); CE_(sc[1][9], sc[1][10]); CE_(sc[1][11], sc[1][12]); CE_(sc[1][13], sc[1][14]); CE_(sc[1][0], sc[1][8]); CE_(sc[1][4], sc[1][12]); CE_(sc[1][4], sc[1][8]); CE_(sc[1][2], sc[1][10]); CE_(sc[1][6], sc[1][14]); CE_(sc[1][6], sc[1][10]); CE_(sc[1][2], sc[1][4]); CE_(sc[1][6], sc[1][8]); CE_(sc[1][10], sc[1][12]); CE_(sc[1][1], sc[1][9]); CE_(sc[1][5], sc[1][13]); CE_(sc[1][5], sc[1][9]); CE_(sc[1][3], sc[1][11]); CE_(sc[1][7], sc[1][15]); CE_(sc[1][7], sc[1][11]); CE_(sc[1][3], sc[1][5]); CE_(sc[1][7], sc[1][9]); CE_(sc[1][11], sc[1][13]); CE_(sc[1][1], sc[1][2]); CE_(sc[1][3], sc[1][4]); CE_(sc[1][5], sc[1][6]); CE_(sc[1][7], sc[1][8]); CE_(sc[1][9], sc[1][10]); CE_(sc[1][11], sc[1][12]); CE_(sc[1][13], sc[1][14]);
                    CE_(sc[2][0], sc[2][1]); CE_(sc[2][2], sc[2][3]); CE_(sc[2][0], sc[2][2]); CE_(sc[2][1], sc[2][3]); CE_(sc[2][1], sc[2][2]); CE_(sc[2][4], sc[2][5]); CE_(sc[2][6], sc[2][7]); CE_(sc[2][4], sc[2][6]); CE_(sc[2][5], sc[2][7]); CE_(sc[2][5], sc[2][6]); CE_(sc[2][0], sc[2][4]); CE_(sc[2][2], sc[2][6]); CE_(sc[2][2], sc[2][4]); CE_(sc[2][1], sc[2][5]); CE_(sc[2][3], sc[2][7]); CE_(sc[2][3], sc[2][5]); CE_(sc[2][1], sc[2][2]); CE_(sc[2][3], sc[2][4]); CE_(sc[2][5], sc[2][6]); CE_(sc[2][8], sc[2][9]); CE_(sc[2][10], sc[2][11]); CE_(sc[2][8], sc[2][10]); CE_(sc[2][9], sc[2][11]); CE_(sc[2][9], sc[2][10]); CE_(sc[2][12], sc[2][13]); CE_(sc[2][14], sc[2][15]); CE_(sc[2][12], sc[2][14]); CE_(sc[2][13], sc[2][15]); CE_(sc[2][13], sc[2][14]); CE_(sc[2][8], sc[2][12]); CE_(sc[2][10], sc[2][14]); CE_(sc[2][10], sc[2][12]); CE_(sc[2][9], sc[2][13]); CE_(sc[2][11], sc[2][15]); CE_(sc[2][11], sc[2][13]); CE_(sc[2][9], sc[2][10]); CE_(sc[2][11], sc[2][12]); CE_(sc[2][13], sc[2][14]); CE_(sc[2][0], sc[2][8]); CE_(sc[2][4], sc[2][12]); CE_(sc[2][4], sc[2][8]); CE_(sc[2][2], sc[2][10]); CE_(sc[2][6], sc[2][14]); CE_(sc[2][6], sc[2][10]); CE_(sc[2][2], sc[2][4]); CE_(sc[2][6], sc[2][8]); CE_(sc[2][10], sc[2][12]); CE_(sc[2][1], sc[2][9]); CE_(sc[2][5], sc[2][13]); CE_(sc[2][5], sc[2][9]); CE_(sc[2][3], sc[2][11]); CE_(sc[2][7], sc[2][15]); CE_(sc[2][7], sc[2][11]); CE_(sc[2][3], sc[2][5]); CE_(sc[2][7], sc[2][9]); CE_(sc[2][11], sc[2][13]); CE_(sc[2][1], sc[2][2]); CE_(sc[2][3], sc[2][4]); CE_(sc[2][5], sc[2][6]); CE_(sc[2][7], sc[2][8]); CE_(sc[2][9], sc[2][10]); CE_(sc[2][11], sc[2][12]); CE_(sc[2][13], sc[2][14]);
                    CE_(sc[3][0], sc[3][1]); CE_(sc[3][2], sc[3][3]); CE_(sc[3][0], sc[3][2]); CE_(sc[3][1], sc[3][3]); CE_(sc[3][1], sc[3][2]); CE_(sc[3][4], sc[3][5]); CE_(sc[3][6], sc[3][7]); CE_(sc[3][4], sc[3][6]); CE_(sc[3][5], sc[3][7]); CE_(sc[3][5], sc[3][6]); CE_(sc[3][0], sc[3][4]); CE_(sc[3][2], sc[3][6]); CE_(sc[3][2], sc[3][4]); CE_(sc[3][1], sc[3][5]); CE_(sc[3][3], sc[3][7]); CE_(sc[3][3], sc[3][5]); CE_(sc[3][1], sc[3][2]); CE_(sc[3][3], sc[3][4]); CE_(sc[3][5], sc[3][6]); CE_(sc[3][8], sc[3][9]); CE_(sc[3][10], sc[3][11]); CE_(sc[3][8], sc[3][10]); CE_(sc[3][9], sc[3][11]); CE_(sc[3][9], sc[3][10]); CE_(sc[3][12], sc[3][13]); CE_(sc[3][14], sc[3][15]); CE_(sc[3][12], sc[3][14]); CE_(sc[3][13], sc[3][15]); CE_(sc[3][13], sc[3][14]); CE_(sc[3][8], sc[3][12]); CE_(sc[3][10], sc[3][14]); CE_(sc[3][10], sc[3][12]); CE_(sc[3][9], sc[3][13]); CE_(sc[3][11], sc[3][15]); CE_(sc[3][11], sc[3][13]); CE_(sc[3][9], sc[3][10]); CE_(sc[3][11], sc[3][12]); CE_(sc[3][13], sc[3][14]); CE_(sc[3][0], sc[3][8]); CE_(sc[3][4], sc[3][12]); CE_(sc[3][4], sc[3][8]); CE_(sc[3][2], sc[3][10]); CE_(sc[3][6], sc[3][14]); CE_(sc[3][6], sc[3][10]); CE_(sc[3][2], sc[3][4]); CE_(sc[3][6], sc[3][8]); CE_(sc[3][10], sc[3][12]); CE_(sc[3][1], sc[3][9]); CE_(sc[3][5], sc[3][13]); CE_(sc[3][5], sc[3][9]); CE_(sc[3][3], sc[3][11]); CE_(sc[3][7], sc[3][15]); CE_(sc[3][7], sc[3][11]); CE_(sc[3][3], sc[3][5]); CE_(sc[3][7], sc[3][9]); CE_(sc[3][11], sc[3][13]); CE_(sc[3][1], sc[3][2]); CE_(sc[3][3], sc[3][4]); CE_(sc[3][5], sc[3][6]); CE_(sc[3][7], sc[3][8]); CE_(sc[3][9], sc[3][10]); CE_(sc[3][11], sc[3][12]); CE_(sc[3][13], sc[3][14]);
                    sc[0][0] = __builtin_fmaxf(sc[0][0], sc[1][15]); sc[0][1] = __builtin_fmaxf(sc[0][1], sc[1][14]); sc[0][2] = __builtin_fmaxf(sc[0][2], sc[1][13]); sc[0][3] = __builtin_fmaxf(sc[0][3], sc[1][12]); sc[0][4] = __builtin_fmaxf(sc[0][4], sc[1][11]); sc[0][5] = __builtin_fmaxf(sc[0][5], sc[1][10]); sc[0][6] = __builtin_fmaxf(sc[0][6], sc[1][9]); sc[0][7] = __builtin_fmaxf(sc[0][7], sc[1][8]); sc[0][8] = __builtin_fmaxf(sc[0][8], sc[1][7]); sc[0][9] = __builtin_fmaxf(sc[0][9], sc[1][6]); sc[0][10] = __builtin_fmaxf(sc[0][10], sc[1][5]); sc[0][11] = __builtin_fmaxf(sc[0][11], sc[1][4]); sc[0][12] = __builtin_fmaxf(sc[0][12], sc[1][3]); sc[0][13] = __builtin_fmaxf(sc[0][13], sc[1][2]); sc[0][14] = __builtin_fmaxf(sc[0][14], sc[1][1]); sc[0][15] = __builtin_fmaxf(sc[0][15], sc[1][0]);
                    CE_(sc[0][0], sc[0][8]); CE_(sc[0][1], sc[0][9]); CE_(sc[0][2], sc[0][10]); CE_(sc[0][3], sc[0][11]); CE_(sc[0][4], sc[0][12]); CE_(sc[0][5], sc[0][13]); CE_(sc[0][6], sc[0][14]); CE_(sc[0][7], sc[0][15]); CE_(sc[0][0], sc[0][4]); CE_(sc[0][1], sc[0][5]); CE_(sc[0][2], sc[0][6]); CE_(sc[0][3], sc[0][7]); CE_(sc[0][8], sc[0][12]); CE_(sc[0][9], sc[0][13]); CE_(sc[0][10], sc[0][14]); CE_(sc[0][11], sc[0][15]); CE_(sc[0][0], sc[0][2]); CE_(sc[0][1], sc[0][3]); CE_(sc[0][4], sc[0][6]); CE_(sc[0][5], sc[0][7]); CE_(sc[0][8], sc[0][10]); CE_(sc[0][9], sc[0][11]); CE_(sc[0][12], sc[0][14]); CE_(sc[0][13], sc[0][15]); CE_(sc[0][0], sc[0][1]); CE_(sc[0][2], sc[0][3]); CE_(sc[0][4], sc[0][5]); CE_(sc[0][6], sc[0][7]); CE_(sc[0][8], sc[0][9]); CE_(sc[0][10], sc[0][11]); CE_(sc[0][12], sc[0][13]); CE_(sc[0][14], sc[0][15]);
                    sc[2][0] = __builtin_fmaxf(sc[2][0], sc[3][15]); sc[2][1] = __builtin_fmaxf(sc[2][1], sc[3][14]); sc[2][2] = __builtin_fmaxf(sc[2][2], sc[3][13]); sc[2][3] = __builtin_fmaxf(sc[2][3], sc[3][12]); sc[2][4] = __builtin_fmaxf(sc[2][4], sc[3][11]); sc[2][5] = __builtin_fmaxf(sc[2][5], sc[3][10]); sc[2][6] = __builtin_fmaxf(sc[2][6], sc[3][9]); sc[2][7] = __builtin_fmaxf(sc[2][7], sc[3][8]); sc[2][8] = __builtin_fmaxf(sc[2][8], sc[3][7]); sc[2][9] = __builtin_fmaxf(sc[2][9], sc[3][6]); sc[2][10] = __builtin_fmaxf(sc[2][10], sc[3][5]); sc[2][11] = __builtin_fmaxf(sc[2][11], sc[3][4]); sc[2][12] = __builtin_fmaxf(sc[2][12], sc[3][3]); sc[2][13] = __builtin_fmaxf(sc[2][13], sc[3][2]); sc[2][14] = __builtin_fmaxf(sc[2][14], sc[3][1]); sc[2][15] = __builtin_fmaxf(sc[2][15], sc[3][0]);
                    CE_(sc[2][0], sc[2][8]); CE_(sc[2][1], sc[2][9]); CE_(sc[2][2], sc[2][10]); CE_(sc[2][3], sc[2][11]); CE_(sc[2][4], sc[2][12]); CE_(sc[2][5], sc[2][13]); CE_(sc[2][6], sc[2][14]); CE_(sc[2][7], sc[2][15]); CE_(sc[2][0], sc[2][4]); CE_(sc[2][1], sc[2][5]); CE_(sc[2][2], sc[2][6]); CE_(sc[2][3], sc[2][7]); CE_(sc[2][8], sc[2][12]); CE_(sc[2][9], sc[2][13]); CE_(sc[2][10], sc[2][14]); CE_(sc[2][11], sc[2][15]); CE_(sc[2][0], sc[2][2]); CE_(sc[2][1], sc[2][3]); CE_(sc[2][4], sc[2][6]); CE_(sc[2][5], sc[2][7]); CE_(sc[2][8], sc[2][10]); CE_(sc[2][9], sc[2][11]); CE_(sc[2][12], sc[2][14]); CE_(sc[2][13], sc[2][15]); CE_(sc[2][0], sc[2][1]); CE_(sc[2][2], sc[2][3]); CE_(sc[2][4], sc[2][5]); CE_(sc[2][6], sc[2][7]); CE_(sc[2][8], sc[2][9]); CE_(sc[2][10], sc[2][11]); CE_(sc[2][12], sc[2][13]); CE_(sc[2][14], sc[2][15]);
                    sc[0][0] = __builtin_fmaxf(sc[0][0], sc[2][15]); sc[0][1] = __builtin_fmaxf(sc[0][1], sc[2][14]); sc[0][2] = __builtin_fmaxf(sc[0][2], sc[2][13]); sc[0][3] = __builtin_fmaxf(sc[0][3], sc[2][12]); sc[0][4] = __builtin_fmaxf(sc[0][4], sc[2][11]); sc[0][5] = __builtin_fmaxf(sc[0][5], sc[2][10]); sc[0][6] = __builtin_fmaxf(sc[0][6], sc[2][9]); sc[0][7] = __builtin_fmaxf(sc[0][7], sc[2][8]); sc[0][8] = __builtin_fmaxf(sc[0][8], sc[2][7]); sc[0][9] = __builtin_fmaxf(sc[0][9], sc[2][6]); sc[0][10] = __builtin_fmaxf(sc[0][10], sc[2][5]); sc[0][11] = __builtin_fmaxf(sc[0][11], sc[2][4]); sc[0][12] = __builtin_fmaxf(sc[0][12], sc[2][3]); sc[0][13] = __builtin_fmaxf(sc[0][13], sc[2][2]); sc[0][14] = __builtin_fmaxf(sc[0][14], sc[2][1]); sc[0][15] = __builtin_fmaxf(sc[0][15], sc[2][0]);
                    CE_(sc[0][0], sc[0][8]); CE_(sc[0][1], sc[0][9]); CE_(sc[0][2], sc[0][10]); CE_(sc[0][3], sc[0][11]); CE_(sc[0][4], sc[0][12]); CE_(sc[0][5], sc[0][13]); CE_(sc[0][6], sc[0][14]); CE_(sc[0][7], sc[0][15]); CE_(sc[0][0], sc[0][4]); CE_(sc[0][1], sc[0][5]); CE_(sc[0][2], sc[0][6]); CE_(sc[0][3], sc[0][7]); CE_(sc[0][8], sc[0][12]); CE_(sc[0][9], sc[0][13]); CE_(sc[0][10], sc[0][14]); CE_(sc[0][11], sc[0][15]); CE_(sc[0][0], sc[0][2]); CE_(sc[0][1], sc[0][3]); CE_(sc[0][4], sc[0][6]); CE_(sc[0][5], sc[0][7]); CE_(sc[0][8], sc[0][10]); CE_(sc[0][9], sc[0][11]); CE_(sc[0][12], sc[0][14]); CE_(sc[0][13], sc[0][15]); CE_(sc[0][0], sc[0][1]); CE_(sc[0][2], sc[0][3]); CE_(sc[0][4], sc[0][5]); CE_(sc[0][6], sc[0][7]); CE_(sc[0][8], sc[0][9]); CE_(sc[0][10], sc[0][11]); CE_(sc[0][12], sc[0][13]); CE_(sc[0][14], sc[0][15]);
                    { float la[16], lb[16];
#pragma unroll
                      for (int i = 0; i < 16; ++i) { auto rr = __builtin_amdgcn_permlane32_swap(__float_as_uint(sc[0][i]), __float_as_uint(sc[0][i]), false, false); la[i] = __uint_as_float(rr[0]); lb[i] = __uint_as_float(rr[1]); }
#pragma unroll
                      for (int i = 0; i < 16; ++i) la[i] = __builtin_fmaxf(la[i], lb[15 - i]);
                      CE_(la[0], la[8]); CE_(la[1], la[9]); CE_(la[2], la[10]); CE_(la[3], la[11]); CE_(la[4], la[12]); CE_(la[5], la[13]); CE_(la[6], la[14]); CE_(la[7], la[15]); CE_(la[0], la[4]); CE_(la[1], la[5]); CE_(la[2], la[6]); CE_(la[3], la[7]); CE_(la[8], la[12]); CE_(la[9], la[13]); CE_(la[10], la[14]); CE_(la[11], la[15]); CE_(la[0], la[2]); CE_(la[1], la[3]); CE_(la[4], la[6]); CE_(la[5], la[7]); CE_(la[8], la[10]); CE_(la[9], la[11]); CE_(la[12], la[14]); CE_(la[13], la[15]); CE_(la[0], la[1]); CE_(la[2], la[3]); CE_(la[4], la[5]); CE_(la[6], la[7]); CE_(la[8], la[9]); CE_(la[10], la[11]); CE_(la[12], la[13]); CE_(la[14], la[15]);
#pragma unroll
                      for (int i = 0; i < 16; ++i) { if (p == 0) sa[i] = la[i]; else sb[i] = la[i]; } }
#undef CE_
                }
                { unsigned w[4];
    #pragma unroll
                  for (int q = 0; q < 4; ++q) { w[q] = 0u;
    #pragma unroll
                      for (int e = 0; e < 4; ++e) { const unsigned ka = 127u - (__float_as_uint(sa[4 * q + e]) & 127u), kb = 127u - (__float_as_uint(sb[4 * q + e]) & 127u); w[q] |= (hi ? kb : ka) << (8 * e); } }
                  *(LAS v4u*)(scr + 16 * hi) = (v4u){w[0], w[1], w[2], w[3]}; }
                float cd[25];
    #define CV_(i, j) __uint_as_float((__float_as_uint(sa[i] + sb[j]) & ~255u) | (255u - (unsigned)(16 * (i) + (j))))
                cd[0] = hi ? CV_(0, 1) : CV_(0, 0);
                cd[1] = hi ? CV_(0, 3) : CV_(0, 2);
                cd[2] = hi ? CV_(0, 5) : CV_(0, 4);
                cd[3] = hi ? CV_(0, 7) : CV_(0, 6);
                cd[4] = hi ? CV_(0, 9) : CV_(0, 8);
                cd[5] = hi ? CV_(0, 11) : CV_(0, 10);
                cd[6] = hi ? CV_(0, 13) : CV_(0, 12);
                cd[7] = hi ? CV_(0, 15) : CV_(0, 14);
                cd[8] = hi ? CV_(1, 1) : CV_(1, 0);
                cd[9] = hi ? CV_(1, 3) : CV_(1, 2);
                cd[10] = hi ? CV_(1, 5) : CV_(1, 4);
                cd[11] = hi ? CV_(1, 7) : CV_(1, 6);
                cd[12] = hi ? CV_(2, 1) : CV_(2, 0);
                cd[13] = hi ? CV_(2, 3) : CV_(2, 2);
                cd[14] = hi ? CV_(3, 0) : CV_(2, 4);
                cd[15] = hi ? CV_(3, 2) : CV_(3, 1);
                cd[16] = hi ? CV_(4, 0) : CV_(3, 3);
                cd[17] = hi ? CV_(4, 2) : CV_(4, 1);
                cd[18] = hi ? CV_(5, 1) : CV_(5, 0);
                cd[19] = hi ? CV_(6, 1) : CV_(6, 0);
                cd[20] = hi ? CV_(7, 1) : CV_(7, 0);
                cd[21] = hi ? CV_(9, 0) : CV_(8, 0);
                cd[22] = hi ? CV_(11, 0) : CV_(10, 0);
                cd[23] = hi ? CV_(13, 0) : CV_(12, 0);
                cd[24] = hi ? CV_(15, 0) : CV_(14, 0);
    #undef CV_
                float top[16];
    #pragma unroll
                for (int rd = 0; rd < 16; ++rd) {
                    float m = cd[0];
    #pragma unroll
                    for (int n = 1; n + 1 < 25; n += 2) m = max3f_(m, cd[n], cd[n + 1]);
                    const float gm = pair_max(m); top[rd] = gm;
    #pragma unroll
                    for (int n = 0; n < 25; ++n) cd[n] = (__float_as_uint(cd[n]) == __float_as_uint(gm)) ? -INFINITY : cd[n];
                }
                float ex[16], sum = 0.f;
    #pragma unroll
                for (int r = 0; r < 16; ++r) { ex[r] = __builtin_amdgcn_exp2f((top[r] - top[0]) * LOG2E); sum += ex[r]; }
                const float inv = 1.f / sum;
                asm volatile("s_waitcnt lgkmcnt(0)" ::: "memory");
                int eo[8]; float go[8];
    #pragma unroll
                for (int rr = 0; rr < 8; ++rr) { float t0 = top[rr], t1 = top[rr + 8], e0 = ex[rr], e1 = ex[rr + 8]; asm volatile("" : "+v"(t0), "+v"(t1), "+v"(e0), "+v"(e1));
                    const unsigned f = 255u - (__float_as_uint(hi ? t1 : t0) & 255u);
                    const int ia = scr[f >> 4], ib = scr[16 + (f & 15)]; eo[rr] = ia * 128 + ib; go[rr] = (hi ? e1 : e0) * inv; }
                int* ep = E + (size_t)tok * 128 + h * 16 + 8 * hi; float* gp = G + (size_t)tok * 128 + h * 16 + 8 * hi;
                *(v4u*)ep = (v4u){(unsigned)eo[0], (unsigned)eo[1], (unsigned)eo[2], (unsigned)eo[3]}; *(v4u*)(ep + 4) = (v4u){(unsigned)eo[4], (unsigned)eo[5], (unsigned)eo[6], (unsigned)eo[7]};
                *(f32x4*)gp = (f32x4){go[0], go[1], go[2], go[3]}; *(f32x4*)(gp + 4) = (f32x4){go[4], go[5], go[6], go[7]};
                asm volatile("s_waitcnt lgkmcnt(0)" ::: "memory");
            }
        }
#undef ROUTE_LOADQ
    }
    GRID_BAR();
    if (RUN(11)) {
        const int nlab = F.G < 8 ? F.G : 8, label = (int)blockIdx.x % nlab, nblk = (F.G - label + nlab - 1) / nlab, wx = ((int)blockIdx.x / nlab) * NWAVES + F.wave, nwx = nblk * NWAVES;
        const int lane = F.lane, rr = lane >> 3, cc = lane & 7;
        const int* E = (const int*)(ws + WS_E);
        for (int sl = label; sl < 16; sl += nlab) {
            const unsigned char* Us = ws + WS_U8 + (size_t)sl * 16384 * 128 + 16 * cc;
            const unsigned char* Hs = ws + WS_H8 + (size_t)sl * M * 128 + 16 * cc;
            LAS unsigned* itq = (LAS unsigned*)(F.lds + MISC_OFF) + 19;
            __syncthreads(); if (F.tid == 0) *itq = 0u; __syncthreads();
            for (;;) { int n_ = 0; if (F.lane == 0) n_ = (int)__hip_atomic_fetch_add(itq, 1u, __ATOMIC_RELAXED, __HIP_MEMORY_SCOPE_WORKGROUP); n_ = __builtin_amdgcn_readfirstlane(n_);
                const int item = ((int)blockIdx.x / nlab) * NWAVES + (n_ & 7) + nwx * (n_ >> 3); if (item >= M / 8) break;
                const int tok = item * 8 + rr;
                const v4u hq = *(const v4u*)(Hs + (size_t)tok * 128);
                const v4u* ep = (const v4u*)(E + (size_t)tok * 128);
                int res[16];
#pragma unroll
                for (int i = 0; i < 16; ++i) res[i] = 0;
#pragma unroll
                for (int i = 0; i < 16; ++i) {
                    const v4u e0 = ep[2 * i], e1 = ep[2 * i + 1];
#pragma unroll
                    for (int j = 0; j < 8; ++j) { const unsigned e = j < 4 ? e0[j & 3] : e1[j & 3];
                        const v4u a = *(const v4u*)(Us + (size_t)e * 128);
                        int d = __builtin_amdgcn_sdot4((int)a.x, (int)hq.x, 0, false); d = __builtin_amdgcn_sdot4((int)a.y, (int)hq.y, d, false); d = __builtin_amdgcn_sdot4((int)a.z, (int)hq.z, d, false); d = __builtin_amdgcn_sdot4((int)a.w, (int)hq.w, d, false);
                        d += __builtin_amdgcn_update_dpp(0, d, 0xB1, 0xf, 0xf, true); d += __builtin_amdgcn_update_dpp(0, d, 0x4E, 0xf, 0xf, true); d += __builtin_amdgcn_update_dpp(0, d, 0x141, 0xf, 0xf, true);
                        res[i] = (cc == j) ? d : res[i]; } }
                v4u* po = (v4u*)((short*)(ws + WS_PART) + (size_t)sl * M * 128 + (size_t)tok * 128 + cc * 16);
                unsigned pw[8];
#pragma unroll
                for (int q = 0; q < 8; ++q) pw[q] = ((unsigned)((res[2 * q] + 32) >> 6) & 0xffffu) | ((unsigned)((res[2 * q + 1] + 32) >> 6) << 16);
                po[0] = (v4u){pw[0], pw[1], pw[2], pw[3]}; po[1] = (v4u){pw[4], pw[5], pw[6], pw[7]};
            }
        }
    }
    GRID_BAR();
    if (RUN(12)) {
        const short* P = (const short*)(ws + WS_PART); const int* E = (const int*)(ws + WS_E); const float* G = (const float*)(ws + WS_G); unsigned* PK = (unsigned*)(ws + WS_PK);
        const float* SU = (const float*)(ws + WS_SU); const float* SH = (const float*)(ws + WS_SH);
        for (int idx = F.vcu * 512 + F.tid; idx < M * 128; idx += F.G * 512) { const int tok = idx >> 7, k = idx & 127; const size_t pi = (size_t)tok * 128 + (k & 7) * 16 + (k >> 3); int hsum = 0;
#pragma unroll
            for (int sl = 0; sl < 16; ++sl) hsum += (int)P[(size_t)sl * M * 128 + pi];
            const int e = E[idx];
            const float w = G[idx] * gelu_tanh((float)hsum * 64.f * SU[e] * SH[tok]);
            const unsigned wb_ = __float_as_uint(w), lo_ = (unsigned)e << 3, mg_ = wb_ & 0x7fffffffu;
            PK[(size_t)(tok >> 6) * 8192 + (k >> 2) * 256 + (tok & 63) * 4 + (k & 3)] = lo_ | (mg_ < 0x00800000u ? 0u : ((wb_ & 0x80000000u) | ((mg_ - lo_ + 0x10000u) & 0x7ffe0000u))); }
    }
    GRID_BAR();
    if (RUN(13)) {
        const unsigned* PK = (const unsigned*)(ws + WS_PK); bf16* FFN = (bf16*)(ws + WS_FFN);
        const unsigned lbase = (unsigned)(uintptr_t)(F.lds + RING_OFF);
        for (int c = F.vcu; c < 256; c += F.G) {
            __syncthreads();
            { int tq = F.tid; asm volatile("" : "+v"(tq)); const v4u* src = (const v4u*)(ws + WS_V8 + (size_t)c * 131072) + tq;
#pragma unroll 4
              for (int j = 0; j < 16; ++j) *(LAS v4u*)(F.lds + RING_OFF + (tq + 512 * j) * 16) = src[512 * j]; }
            LAS unsigned* tbq = (LAS unsigned*)(F.lds + MISC_OFF) + 18;
            if (F.tid == 0) *tbq = 0u;
            __syncthreads();
            for (;;) { int tb = 0; if (F.lane == 0) tb = (int)__hip_atomic_fetch_add(tbq, 1u, __ATOMIC_RELAXED, __HIP_MEMORY_SCOPE_WORKGROUP); tb = __builtin_amdgcn_readfirstlane(tb); if (tb >= M / 64) break;
                int ln_ = F.lane; asm volatile("" : "+v"(ln_));
                const v4u* pk = (const v4u*)(PK + (size_t)tb * 8192) + ln_;
                f32x2v av[4];
#pragma unroll
                for (int i = 0; i < 4; ++i) av[i] = (f32x2v){0.f, 0.f};
                v4u pb[32];
#pragma unroll
                for (int kq = 0; kq < 32; ++kq) pb[kq] = pk[kq * 64];
                unsigned long long dq[8];
#pragma unroll
                for (int j = 0; j < 8; ++j) { const unsigned ad = (pb[j >> 2][j & 3] & 0x1fff8u) | lbase; asm volatile("ds_read_b64 %0, %1" : "=v"(dq[j]) : "v"(ad)); }
#pragma unroll
                for (int j = 0; j < 128; ++j) { const int s_ = j & 7; unsigned long long d = dq[s_];
                    if (j <= 120) asm volatile("s_waitcnt lgkmcnt(7)" : "+v"(d));
                    else if (j == 121) asm volatile("s_waitcnt lgkmcnt(6)" : "+v"(d));
                    else if (j == 122) asm volatile("s_waitcnt lgkmcnt(5)" : "+v"(d));
                    else if (j == 123) asm volatile("s_waitcnt lgkmcnt(4)" : "+v"(d));
                    else if (j == 124) asm volatile("s_waitcnt lgkmcnt(3)" : "+v"(d));
                    else if (j == 125) asm volatile("s_waitcnt lgkmcnt(2)" : "+v"(d));
                    else if (j == 126) asm volatile("s_waitcnt lgkmcnt(1)" : "+v"(d));
                    else asm volatile("s_waitcnt lgkmcnt(0)" : "+v"(d));
                    if (j + 8 < 128) { const unsigned ad = (pb[(j + 8) >> 2][(j + 8) & 3] & 0x1fff8u) | lbase; asm volatile("ds_read_b64 %0, %1" : "=v"(dq[s_]) : "v"(ad)); }
                    const float w = __uint_as_float(pb[j >> 2][j & 3]); const f32x2v ww = (f32x2v){w, w};
                    const int d0 = (int)(unsigned)d, d1 = (int)(unsigned)(d >> 32);
                    av[0] = av[0] + __builtin_amdgcn_cvt_pk_f32_fp8(d0, false) * ww; av[1] = av[1] + __builtin_amdgcn_cvt_pk_f32_fp8(d0, true) * ww;
                    av[2] = av[2] + __builtin_amdgcn_cvt_pk_f32_fp8(d1, false) * ww; av[3] = av[3] + __builtin_amdgcn_cvt_pk_f32_fp8(d1, true) * ww; }
                *(v4u*)(FFN + (size_t)(tb * 64 + ln_) * D + 8 * c) = (v4u){pk2(av[0].x, av[0].y), pk2(av[1].x, av[1].y), pk2(av[2].x, av[2].y), pk2(av[3].x, av[3].y)};
            }
        }
        __syncthreads();
    }
    GRID_BAR();
    if (RUN(14)) {
        const int gw = F.vcu * NWAVES + F.wave, NGW = F.G * NWAVES, lane = F.lane; const float* g2 = args.in[21]; const float* b2 = args.in[22]; float* out = args.out; const bf16* FFN = (const bf16*)(ws + WS_FFN);
        for (int row = gw; row < M; row += NGW) {
            f32x4 v[8]; float sm = 0.f;
#pragma unroll
            for (int j = 0; j < 8; ++j) { const int c = (lane + 64 * j) * 4; const unsigned long long hq = *(const unsigned long long*)(H1 + (size_t)row * D + c), fq = *(const unsigned long long*)(FFN + (size_t)row * D + c);
                const unsigned h0 = (unsigned)hq, h1_ = (unsigned)(hq >> 32), f0 = (unsigned)fq, f1 = (unsigned)(fq >> 32);
                v[j].x = DN_ALPHA * __uint_as_float(h0 << 16) + __uint_as_float(f0 << 16); v[j].y = DN_ALPHA * __uint_as_float(h0 & 0xffff0000u) + __uint_as_float(f0 & 0xffff0000u);
                v[j].z = DN_ALPHA * __uint_as_float(h1_ << 16) + __uint_as_float(f1 << 16); v[j].w = DN_ALPHA * __uint_as_float(h1_ & 0xffff0000u) + __uint_as_float(f1 & 0xffff0000u);
                sm += (v[j].x + v[j].y) + (v[j].z + v[j].w); }
#pragma unroll
            for (int o = 1; o < 64; o <<= 1) sm += __shfl_xor(sm, o);
            const float mean = sm * (1.f / D); float s2 = 0.f;
#pragma unroll
            for (int j = 0; j < 8; ++j) { v[j] = v[j] - mean; s2 += (v[j].x * v[j].x + v[j].y * v[j].y) + (v[j].z * v[j].z + v[j].w * v[j].w); }
#pragma unroll
            for (int o = 1; o < 64; o <<= 1) s2 += __shfl_xor(s2, o);
            const float rstd = rsqrtf(s2 * (1.f / D) + LN_EPS);
#pragma unroll
            for (int j = 0; j < 8; ++j) { const int c = (lane + 64 * j) * 4; *(f32x4*)(out + (size_t)row * D + c) = v[j] * rstd * *(const f32x4*)(g2 + c) + *(const f32x4*)(b2 + c); }
        }
    }
#undef IN
#undef RUN
#undef GRID_BAR
}

extern "C" void kernel_launch(void* const* d_in, const int* in_sizes, int n_in, void* d_out, int out_size, void* d_ws, size_t ws_size, hipStream_t stream) {
    static int grid = 0;
    if (grid == 0) {
        if (n_in != 23 || in_sizes[0] != M * D || out_size != M * D || ws_size < WS_END) { fprintf(stderr, "kernel_launch: unexpected shapes n_in %d in0 %d out %d ws %zu\n", n_in, n_in > 0 ? in_sizes[0] : -1, out_size, ws_size); grid = -1; return; }
        int dev = 0, cus = 0;
        if (hipGetDevice(&dev) != hipSuccess || hipDeviceGetAttribute(&cus, hipDeviceAttributeMultiprocessorCount, dev) != hipSuccess) { grid = -1; return; }
        if (hipFuncSetAttribute((const void*)skel_fwd, hipFuncAttributeMaxDynamicSharedMemorySize, LDS_BYTES) != hipSuccess) { grid = -1; return; }
        int per_cu = 0;
        if (hipOccupancyMaxActiveBlocksPerMultiprocessor(&per_cu, (const void*)skel_fwd, NWAVES * 64, LDS_BYTES) != hipSuccess || per_cu < 1) { fprintf(stderr, "kernel_launch: occupancy query reports %d workgroups per CU\n", per_cu); (void)hipGetLastError(); }
        grid = cus;
    }
    if (grid < 0) return;
    (void)hipMemsetAsync((char*)d_ws + WS_CTL, 0, CTL_ZERO_BYTES, stream);
    Args a{};
    for (int i = 0; i < 23; ++i) a.in[i] = (const float*)d_in[i];
    a.out = (float*)d_out; a.ws = (unsigned char*)d_ws;
    a.ph_lo = -1; a.ph_hi = 0;
    hipLaunchKernelGGL(skel_fwd, dim3(grid), dim3(NWAVES * 64), LDS_BYTES, stream, a);
}
```

```cpp
#include <hip/hip_runtime.h>
#include <cstdio>
#include <cstdint>
namespace pg8 {
#define PG8_LAS __attribute__((address_space(3)))
typedef unsigned short bf16_t;
typedef short bf16x8 __attribute__((ext_vector_type(8)));
typedef float f32x4 __attribute__((ext_vector_type(4)));
typedef unsigned u32x4 __attribute__((ext_vector_type(4)));
constexpr int BM = 256, BK = 64, HALF = 128, HTB = HALF * BK * 2  , STAGE_BYTES = 8 * HTB, NXCD = 8, WGM = 8;

__host__ __device__ __forceinline__ int lds_byte(int r, int c) { const int st = (r >> 4) * 2 + (c >> 5), rr = r & 15, cc = c & 31, ob = rr * 64 + cc * 2; return st * 1024 + (ob ^ (((ob >> 9) & 1) << 5)); }
__host__ __device__ __forceinline__ void stage_rc(int b, int& R, int& C) { const int st = b / 1024, sb = b % 1024, swz = sb ^ (((sb >> 9) & 1) << 5); R = (st >> 1) * 16 + swz / 64; C = (st & 1) * 32 + (swz % 64) / 2; }
__host__ __device__ __forceinline__ int perm32(int rho) { const int n = rho >> 4, i = rho & 15; return 8 * (i >> 2) + 4 * n + (i & 3); }

struct Unit { int pm, pn; };
struct Gemm { const bf16_t* A; const bf16_t* Bt; int M, N, K; };

struct StaticOrder {
    int nM, nN, nwg, G, c;
    __host__ __device__ void init(int M, int N, int G_, int c_) { nM = M / BM; nN = N / BM; nwg = nM * nN; G = G_; c = c_; }
    __host__ __device__ bool next(int i, Unit& u) const {
        const long L = (long)i * G + c; if (L >= nwg) return false;
        int wgid = (int)L; { const int q = nwg / NXCD, r = nwg % NXCD, xcd = wgid % NXCD, off = wgid / NXCD; wgid = (xcd < r ? xcd * (q + 1) : r * (q + 1) + (xcd - r) * q) + off; }
        const int nig = WGM * nN, gid = wgid / nig, fm = gid * WGM, gsz = (nM - fm) < WGM ? (nM - fm) : WGM;
        u.pm = fm + ((wgid % nig) % gsz); u.pn = (wgid % nig) / gsz; return true;
    }
    __device__ __forceinline__ void a_ready(const Unit&) const {}
    __device__ __forceinline__ void done(const Unit&) const {}
};

__device__ __forceinline__ unsigned cvt_pk_bf16(float lo, float hi) { unsigned r; asm volatile("v_cvt_pk_bf16_f32 %0, %1, %2" : "=v"(r) : "v"(lo), "v"(hi)); return r; }
typedef float f32x2 __attribute__((ext_vector_type(2)));
__device__ __forceinline__ f32x2 gelu_pk(f32x2 v) {
    const f32x2 av = __builtin_elementwise_abs(v), d = av * 0.2316418882f + 1.0f;
    f32x2 t; t.x = __builtin_amdgcn_rcpf(d.x); t.y = __builtin_amdgcn_rcpf(d.y);
    f32x2 q = t * 0.5307027145f + (-0.7265760135f); q = q * t + 0.7107068705f; q = q * t + (-0.142248368f); q = q * t + 0.127414796f; q = q * t;
    const f32x2 s = (v * v) * (-0.72134752044f);
    f32x2 e; e.x = __builtin_amdgcn_exp2f(s.x); e.y = __builtin_amdgcn_exp2f(s.y);
    const f32x2 m = v * (q * e), r = v - m;
    f32x2 o; o.x = v.x < 0.f ? m.x : r.x; o.y = v.y < 0.f ? m.y : r.y; return o;
}

template <int ACT  > struct EpiBf16 {
    static constexpr bool PERM = true, AFTER_DRAIN = false; static_assert(ACT == 0 || ACT == 1, "EpiBf16: ACT is 0 (none) or 1 (gelu_pk)");
    bf16_t* O; int ldc; const float* bias; int split_cols; size_t split_stride; float scale0;
    __device__ __forceinline__ void operator()(const f32x4 (&acc)[2][2][4][2], const Unit& u, int wr, int wc, int fr, int fq) const {
        const int row0 = u.pm * BM + wr * 64 + fr; int colt = u.pn * BM; bf16_t* base = O;
        float sc = 1.f; if (split_cols) { const int t = colt / split_cols; base += (size_t)t * split_stride; colt -= t * split_cols; if (t == 0) sc = scale0; }
        const int col0 = colt + wc * 32 + 8 * fq, bcol0 = u.pn * BM + wc * 32 + 8 * fq;
        f32x4 bv[2][2];
#pragma unroll
        for (int bj = 0; bj < 2; ++bj)
#pragma unroll
            for (int n = 0; n < 2; ++n) bv[bj][n] = bias ? *(const f32x4*)(bias + bcol0 + bj * HALF + 4 * n) : (f32x4){0.f, 0.f, 0.f, 0.f};
#pragma unroll
        for (int ai = 0; ai < 2; ++ai)
#pragma unroll
            for (int m = 0; m < 4; ++m) { bf16_t* rowp = base + (size_t)(row0 + ai * HALF + m * 16) * ldc + col0;
#pragma unroll
                for (int bj = 0; bj < 2; ++bj) { f32x4 v0 = acc[ai][bj][m][0] + bv[bj][0], v1 = acc[ai][bj][m][1] + bv[bj][1];
                    if (ACT == 1) { f32x2 a = gelu_pk((f32x2){v0[0], v0[1]}), b = gelu_pk((f32x2){v0[2], v0[3]}), c = gelu_pk((f32x2){v1[0], v1[1]}), d = gelu_pk((f32x2){v1[2], v1[3]});
                        v0 = (f32x4){a.x, a.y, b.x, b.y}; v1 = (f32x4){c.x, c.y, d.x, d.y}; }
                    v0 = v0 * sc; v1 = v1 * sc; u32x4 w; w.x = cvt_pk_bf16(v0[0], v0[1]); w.y = cvt_pk_bf16(v0[2], v0[3]); w.z = cvt_pk_bf16(v1[0], v1[1]); w.w = cvt_pk_bf16(v1[2], v1[3]);
                    *(u32x4*)(rowp + bj * HALF) = w; } }
    }
};

struct PanelStats {
    unsigned* xbuf;
    unsigned* cnt;
    unsigned* tmo;
    int ntn; float eps;
    unsigned code;
    __device__ __forceinline__ bool run(const f32x4 (&v)[2][2][4][2], const Unit& u, int wr, int wc, int fr, int fq, PG8_LAS unsigned char* lds, int wid, int lane) const {
        typedef float f32x2v __attribute__((ext_vector_type(2)));
        PG8_LAS f32x2v* P = (PG8_LAS f32x2v*)lds;
        PG8_LAS f32x2v* S = (PG8_LAS f32x2v*)(lds + 8192);
        PG8_LAS unsigned* flag = (PG8_LAS unsigned*)(lds + 8192 + 2048);
#pragma unroll
        for (int ai = 0; ai < 2; ++ai)
#pragma unroll
            for (int m = 0; m < 4; ++m) {
                float s = 0.f;
#pragma unroll
                for (int bj = 0; bj < 2; ++bj)
#pragma unroll
                    for (int n = 0; n < 2; ++n) { const f32x4 x = v[ai][bj][m][n]; s += (x[0] + x[1]) + (x[2] + x[3]); }
                s += __shfl_xor(s, 16); s += __shfl_xor(s, 32);
                const float mw = s * (1.0f / 64.0f); float q = 0.f;
#pragma unroll
                for (int bj = 0; bj < 2; ++bj)
#pragma unroll
                    for (int n = 0; n < 2; ++n) { const f32x4 d = v[ai][bj][m][n] - mw; q += (d[0] * d[0] + d[1] * d[1]) + (d[2] * d[2] + d[3] * d[3]); }
                q += __shfl_xor(q, 16); q += __shfl_xor(q, 32);
                if (fq == 0) P[(ai * HALF + wr * 64 + m * 16 + fr) * 4 + wc] = (f32x2v){mw, q};
            }
        asm volatile("s_waitcnt lgkmcnt(0)" ::: "memory"); __builtin_amdgcn_s_barrier(); asm volatile("" ::: "memory");
#if defined(BROKEN_EXCHANGE_NO_WAIT)
#warning BROKEN CONTROL BUILD: the row-statistics exchange does not wait; results are wrong by design
        if (blockIdx.x >= 64) { const long long t0_ = clock64(); while (clock64() - t0_ < 60000) __builtin_amdgcn_s_sleep(8); }
#endif
        const int row = wid * 32 + (lane & 31);
        if (lane < 32) {
            const f32x2v a = P[row * 4 + 0], b = P[row * 4 + 1], c = P[row * 4 + 2], d = P[row * 4 + 3];
            const float mt = (a.x + b.x + c.x + d.x) * 0.25f;
            const float da = a.x - mt, db = b.x - mt, dc = c.x - mt, dd = d.x - mt;
            const float m2 = (a.y + b.y) + (c.y + d.y) + 64.0f * ((da * da + db * db) + (dc * dc + dd * dd));
            unsigned long long* slot = (unsigned long long*)xbuf + ((size_t)(u.pm * BM + row) * 4 + u.pn);
            __hip_atomic_store(slot, ((unsigned long long)__float_as_uint(m2) << 32) | __float_as_uint(mt), __ATOMIC_RELAXED, __HIP_MEMORY_SCOPE_AGENT);
        }
        asm volatile("s_waitcnt vmcnt(0)" ::: "memory");
        if (lane == 0) __hip_atomic_fetch_add(cnt + 64 * u.pm, 1u, __ATOMIC_RELAXED, __HIP_MEMORY_SCOPE_AGENT);
        if (wid == 0) {
            bool dead = false; const unsigned long long t0 = __builtin_amdgcn_s_memrealtime(); const unsigned want = 8u * (unsigned)ntn;
            for (;;) {
#if defined(BROKEN_EXCHANGE_NO_WAIT)
                break;
#endif
                if ((unsigned)__builtin_amdgcn_readfirstlane(__hip_atomic_load(cnt + 64 * u.pm, __ATOMIC_RELAXED, __HIP_MEMORY_SCOPE_AGENT)) >= want) break;
                if (__builtin_amdgcn_s_memrealtime() - t0 > 2000000ull) {
                    if (lane == 0) { unsigned expect = 0u; __hip_atomic_compare_exchange_strong(tmo + 1, &expect, code | (unsigned)(u.pm & 0xff), __ATOMIC_RELAXED, __ATOMIC_RELAXED, __HIP_MEMORY_SCOPE_AGENT);
                                     __hip_atomic_store(tmo, 1u, __ATOMIC_RELAXED, __HIP_MEMORY_SCOPE_AGENT); }
                    dead = true; break; }
                __builtin_amdgcn_s_sleep(2);
            }
            __builtin_amdgcn_fence(__ATOMIC_ACQUIRE, "agent");
            if (lane == 0) flag[0] = dead ? 1u : 0u;
        }
        asm volatile("s_waitcnt vmcnt(0) lgkmcnt(0)" ::: "memory"); __builtin_amdgcn_s_barrier(); asm volatile("" ::: "memory");
        const bool bad = flag[0] != 0u;
        if (lane < 32) {
            const unsigned long long* slot = (const unsigned long long*)xbuf + (size_t)(u.pm * BM + row) * 4; float mt[4], m2[4]; float ms = 0.f;
#pragma unroll
            for (int t = 0; t < 4; ++t) { if (t < ntn) { const unsigned long long w = __hip_atomic_load(slot + t, __ATOMIC_RELAXED, __HIP_MEMORY_SCOPE_AGENT); mt[t] = __uint_as_float((unsigned)w); m2[t] = __uint_as_float((unsigned)(w >> 32)); } else { mt[t] = 0.f; m2[t] = 0.f; } ms += mt[t]; }
            const float mean = ms / (float)ntn; float q = 0.f;
#pragma unroll
            for (int t = 0; t < 4; ++t) if (t < ntn) { const float dm = mt[t] - mean; q += m2[t] + 256.0f * dm * dm; }
            S[row] = (f32x2v){mean, 1.0f / sqrtf(q / (256.0f * (float)ntn) + eps)};
        }
        asm volatile("s_waitcnt lgkmcnt(0)" ::: "memory"); __builtin_amdgcn_s_barrier(); asm volatile("" ::: "memory");
        return bad;
    }
};
struct EpiLnRes {
    static constexpr bool PERM = false, AFTER_DRAIN = true;
    const float* base; float* out; int ldc; const float* bias; PanelStats st; unsigned poison;
    __device__ __forceinline__ void fused(f32x4 (&acc)[2][2][4][2], const Unit& u, int wr, int wc, int fr, int fq, PG8_LAS unsigned char* lds, int wid, int lane) const {
        typedef float f32x2v __attribute__((ext_vector_type(2)));
        const PG8_LAS f32x2v* S = (const PG8_LAS f32x2v*)(lds + 8192);
        const int col0 = u.pn * BM + wc * 32 + 4 * fq;
#pragma unroll
        for (int bj = 0; bj < 2; ++bj)
#pragma unroll
            for (int n = 0; n < 2; ++n) { const f32x4 bv = bias ? *(const f32x4*)(bias + col0 + bj * HALF + n * 16) : (f32x4){0.f, 0.f, 0.f, 0.f};
#pragma unroll
                for (int ai = 0; ai < 2; ++ai)
#pragma unroll
                    for (int m = 0; m < 4; ++m) acc[ai][bj][m][n] += bv; }
        f32x4 pre[4][2][2];
#pragma unroll
        for (int m = 0; m < 4; ++m) { const size_t off = (size_t)(u.pm * BM + wr * 64 + m * 16 + fr) * ldc + col0;
#pragma unroll
            for (int bj = 0; bj < 2; ++bj)
#pragma unroll
                for (int n = 0; n < 2; ++n) pre[m][bj][n] = *(const f32x4*)(base + off + bj * HALF + n * 16); }
        const bool bad = st.run(acc, u, wr, wc, fr, fq, lds, wid, lane) || poison != 0u;
        const float qnan = __builtin_nanf("");
#pragma unroll
        for (int ai = 0; ai < 2; ++ai)
#pragma unroll
            for (int m = 0; m < 4; ++m) { const int r = ai * HALF + wr * 64 + m * 16 + fr; const f32x2v sr = S[r]; const size_t off = (size_t)(u.pm * BM + r) * ldc + col0;
#pragma unroll
                for (int bj = 0; bj < 2; ++bj)
#pragma unroll
                    for (int n = 0; n < 2; ++n) { const f32x4 bs = ai == 0 ? pre[m][bj][n] : *(const f32x4*)(base + off + bj * HALF + n * 16); f32x4 o = bs + (acc[ai][bj][m][n] - sr.x) * sr.y;
                        if (bad) o = (f32x4){qnan, qnan, qnan, qnan}; *(f32x4*)(out + off + bj * HALF + n * 16) = o; }
                if (m & 1) asm volatile("" ::: "memory"); }
    }
};
struct EpiLnResLn {
    static constexpr bool PERM = false, AFTER_DRAIN = true;
    const float* base; float* out; bf16_t* xn; int ldc; const float* bias; PanelStats st1, st2; unsigned poison;
    __device__ __forceinline__ void fused(f32x4 (&acc)[2][2][4][2], const Unit& u, int wr, int wc, int fr, int fq, PG8_LAS unsigned char* lds, int wid, int lane) const {
        typedef float f32x2v __attribute__((ext_vector_type(2))); typedef unsigned u32x2v __attribute__((ext_vector_type(2)));
        const PG8_LAS f32x2v* S = (const PG8_LAS f32x2v*)(lds + 8192);
        const int col0 = u.pn * BM + wc * 32 + 4 * fq;
#pragma unroll
        for (int bj = 0; bj < 2; ++bj)
#pragma unroll
            for (int n = 0; n < 2; ++n) { const f32x4 bv = bias ? *(const f32x4*)(bias + col0 + bj * HALF + n * 16) : (f32x4){0.f, 0.f, 0.f, 0.f};
#pragma unroll
                for (int ai = 0; ai < 2; ++ai)
#pragma unroll
                    for (int m = 0; m < 4; ++m) acc[ai][bj][m][n] += bv; }
        bool bad = st1.run(acc, u, wr, wc, fr, fq, lds, wid, lane) || poison != 0u;
        const float qnan = __builtin_nanf("");
#pragma unroll
        for (int ai = 0; ai < 2; ++ai)
#pragma unroll
            for (int m = 0; m < 4; ++m) { const int r = ai * HALF + wr * 64 + m * 16 + fr; const f32x2v sr = S[r]; const size_t off = (size_t)(u.pm * BM + r) * ldc + col0;
#pragma unroll
                for (int bj = 0; bj < 2; ++bj)
#pragma unroll
                    for (int n = 0; n < 2; ++n) { const f32x4 bs = *(const f32x4*)(base + off + bj * HALF + n * 16); acc[ai][bj][m][n] = bs + (acc[ai][bj][m][n] - sr.x) * sr.y; }
                asm volatile("" : "+v"(acc[ai][0][m][0]), "+v"(acc[ai][0][m][1]), "+v"(acc[ai][1][m][0]), "+v"(acc[ai][1][m][1]));
                if (m & 1) asm volatile("" ::: "memory"); }
        const bool bad1 = bad;
        bad = st2.run(acc, u, wr, wc, fr, fq, lds, wid, lane) || bad;
#pragma unroll
        for (int ai = 0; ai < 2; ++ai)
#pragma unroll
            for (int m = 0; m < 4; ++m) { const int r = ai * HALF + wr * 64 + m * 16 + fr; const f32x2v sr = S[r]; const size_t off = (size_t)(u.pm * BM + r) * ldc + col0;
#pragma unroll
                for (int bj = 0; bj < 2; ++bj)
#pragma unroll
                    for (int n = 0; n < 2; ++n) { const f32x4 x1 = acc[ai][bj][m][n]; *(f32x4*)(out + off + bj * HALF + n * 16) = bad1 ? (f32x4){qnan, qnan, qnan, qnan} : x1;
                        const f32x4 o = (x1 - sr.x) * sr.y; u32x2v w; w.x = cvt_pk_bf16(o[0], o[1]); w.y = cvt_pk_bf16(o[2], o[3]);
                        if (bad) { w.x = 0x7fc07fc0u; w.y = 0x7fc07fc0u; } *(u32x2v*)(xn + off + bj * HALF + n * 16) = w; }
                asm volatile("" ::: "memory"); }
    }
};

template <class Epi, class Sched, bool ALIGN_EPI = false, bool SP2 = false>
__device__ __forceinline__ void gemm_phase(PG8_LAS unsigned char* lds, const Gemm g, const Sched& S, const Epi& E) {
    const int tid = threadIdx.x, wid = __builtin_amdgcn_readfirstlane(tid >> 6), lane = tid & 63, wr = wid >> 2, wc = wid & 3, fr = lane & 15, fq = lane >> 4;
    const int K = g.K, nt = K / BK;
    unsigned voffA[2], voffB[2];
#pragma unroll
    for (int i = 0; i < 2; ++i) { int R, C; stage_rc(tid * 16 + i * 8192, R, C); const int Rb = Epi::PERM ? ((R & ~31) + perm32(R & 31)) : R;
        voffA[i] = (unsigned)(R * K + C) * 2u; voffB[i] = (unsigned)(Rb * K + C) * 2u; }
    const size_t kstep = (size_t)(BK * 2);
    const size_t hstep = (size_t)HALF * K * 2;
    const size_t tstep = 2 * hstep;
    const unsigned ldsw = (unsigned)wid * 1024u;
    const int aoff = lds_byte(wr * 64 + fr, fq * 8), boff = lds_byte(wc * 32 + fr, fq * 8);
#define PG8_SA(b, h) (((b) * 2 + (h)) * HTB)
#define PG8_SB(b, h) ((4 + (b) * 2 + (h)) * HTB)
#define PG8_STAGE(bufoff, gbase, voff) do { _Pragma("unroll") for (int _i = 0; _i < 2; ++_i) \
        __builtin_amdgcn_global_load_lds((const unsigned*)((const char*)(gbase) + (voff)[_i]), (PG8_LAS unsigned*)(lds + (bufoff) + ldsw + _i * 8192), 16, 0, 0); } while (0)
#define PG8_LDA(dst, b, h) do { _Pragma("unroll") for (int m = 0; m < 4; ++m) _Pragma("unroll") for (int k = 0; k < 2; ++k) dst[m][k] = *(const PG8_LAS bf16x8*)(lds + PG8_SA(b, h) + aoff + m * 2048 + k * 1024); } while (0)
#define PG8_LDB(dst, b, h) do { _Pragma("unroll") for (int n = 0; n < 2; ++n) _Pragma("unroll") for (int k = 0; k < 2; ++k) dst[n][k] = *(const PG8_LAS bf16x8*)(lds + PG8_SB(b, h) + boff + n * 2048 + k * 1024); } while (0)
#define PG8_MMA(ai, bj, At, Bt) do { __builtin_amdgcn_s_setprio(1); _Pragma("unroll") for (int m = 0; m < 4; ++m) _Pragma("unroll") for (int n = 0; n < 2; ++n) _Pragma("unroll") for (int k = 0; k < 2; ++k) \
        acc[ai][bj][m][n] = __builtin_amdgcn_mfma_f32_16x16x32_bf16(Bt[n][k], At[m][k], acc[ai][bj][m][n], 0, 0, 0); __builtin_amdgcn_s_setprio(0); } while (0)
#define PG8_WAIT_V(n) asm volatile("s_waitcnt vmcnt(" #n ")" ::: "memory")
#define PG8_WAIT_L(n) asm volatile("s_waitcnt lgkmcnt(" #n ")" ::: "memory")
#define PG8_BAR __builtin_amdgcn_s_barrier()
#define PG8_SCHED __builtin_amdgcn_sched_barrier(0)
    Unit cur, nxt; int ui = 0;
    if (!S.next(0, cur)) return;
    f32x4 acc[2][2][4][2];
#pragma unroll
    for (int a = 0; a < 2; ++a)
#pragma unroll
        for (int b = 0; b < 2; ++b)
#pragma unroll
            for (int m = 0; m < 4; ++m)
#pragma unroll
                for (int n = 0; n < 2; ++n) acc[a][b][m][n] = (f32x4){0.f, 0.f, 0.f, 0.f};
    bf16x8 At[4][2], B0[2][2], B1[2][2];
    const char* cA = (const char*)g.A + (size_t)cur.pm * tstep; const char* cB = (const char*)g.Bt + (size_t)cur.pn * tstep;
    S.a_ready(cur);
    if constexpr (SP2) {
        PG8_STAGE(PG8_SB(0, 0), cB, voffB); PG8_STAGE(PG8_SB(0, 1), cB + hstep, voffB); PG8_STAGE(PG8_SA(0, 0), cA, voffA); PG8_STAGE(PG8_SA(0, 1), cA + hstep, voffA);
        if (wr == 1) PG8_BAR;
        PG8_WAIT_V(2); PG8_BAR;
        PG8_STAGE(PG8_SB(1, 0), cB + kstep, voffB); PG8_STAGE(PG8_SA(1, 0), cA + kstep, voffA); PG8_STAGE(PG8_SB(1, 1), cB + hstep + kstep, voffB);
        PG8_WAIT_V(6); PG8_BAR;
    } else {
        PG8_STAGE(PG8_SB(0, 0), cB, voffB); PG8_STAGE(PG8_SA(0, 0), cA, voffA); PG8_STAGE(PG8_SB(0, 1), cB + hstep, voffB); PG8_STAGE(PG8_SA(0, 1), cA + hstep, voffA);
        if (wr == 1) PG8_BAR;
        PG8_WAIT_V(4); PG8_BAR;
        PG8_STAGE(PG8_SB(1, 0), cB + kstep, voffB); PG8_STAGE(PG8_SA(1, 0), cA + kstep, voffA); PG8_STAGE(PG8_SB(1, 1), cB + hstep + kstep, voffB);
        PG8_WAIT_V(6); PG8_BAR;
    }
    for (;;) {
        const bool has_next = S.next(ui + 1, nxt);
        const char* nA = has_next ? (const char*)g.A + (size_t)nxt.pm * tstep : cA; const char* nB = has_next ? (const char*)g.Bt + (size_t)nxt.pn * tstep : cB;
        for (int t = 0; t < nt; t += 2) {
            const bool last = (t == nt - 2);
            const char* a1 = cA + (size_t)(t + 1) * kstep;
            const char* a2 = last ? nA : cA + (size_t)(t + 2) * kstep; const char* b2 = last ? nB : cB + (size_t)(t + 2) * kstep;
            const char* a3 = a2 + kstep; const char* b3 = b2 + kstep;
            if (last && has_next) S.a_ready(nxt);
            if constexpr (SP2) {
            PG8_LDB(B0, 0, 0); PG8_LDB(B1, 0, 1); PG8_SCHED; PG8_LDA(At, 0, 0); PG8_STAGE(PG8_SA(1, 1), a1 + hstep, voffA);
            PG8_WAIT_V(8); PG8_WAIT_L(0); PG8_BAR; PG8_MMA(0, 0, At, B0); PG8_MMA(0, 1, At, B1); PG8_BAR; PG8_SCHED;
            PG8_LDA(At, 0, 1); PG8_STAGE(PG8_SB(0, 0), b2, voffB); PG8_STAGE(PG8_SB(0, 1), b2 + hstep, voffB); PG8_STAGE(PG8_SA(0, 0), a2, voffA);
            PG8_WAIT_V(8); PG8_WAIT_L(0); PG8_BAR; PG8_MMA(1, 0, At, B0); PG8_MMA(1, 1, At, B1); PG8_BAR; PG8_SCHED;
            PG8_LDB(B0, 1, 0); PG8_LDB(B1, 1, 1); PG8_SCHED; PG8_LDA(At, 1, 0); PG8_STAGE(PG8_SA(0, 1), a2 + hstep, voffA);
            PG8_WAIT_V(8); PG8_WAIT_L(0); PG8_BAR; PG8_MMA(0, 0, At, B0); PG8_MMA(0, 1, At, B1); PG8_BAR; PG8_SCHED;
            PG8_LDA(At, 1, 1); PG8_STAGE(PG8_SB(1, 0), b3, voffB); PG8_STAGE(PG8_SB(1, 1), b3 + hstep, voffB); PG8_STAGE(PG8_SA(1, 0), a3, voffA);
            PG8_WAIT_V(8); PG8_WAIT_L(0); PG8_BAR; PG8_MMA(1, 0, At, B0); PG8_MMA(1, 1, At, B1); PG8_BAR; PG8_SCHED;
            } else {
            PG8_LDB(B0, 0, 0); PG8_SCHED; PG8_LDA(At, 0, 0); PG8_STAGE(PG8_SA(1, 1), a1 + hstep, voffA);
            PG8_WAIT_L(8); PG8_BAR; PG8_WAIT_L(0); PG8_MMA(0, 0, At, B0); PG8_BAR; PG8_SCHED;
            PG8_LDB(B1, 0, 1); PG8_STAGE(PG8_SB(0, 0), b2, voffB);
            PG8_BAR; PG8_WAIT_L(0); PG8_MMA(0, 1, At, B1); PG8_BAR;
            PG8_LDA(At, 0, 1); PG8_STAGE(PG8_SA(0, 0), a2, voffA);
            PG8_BAR; PG8_WAIT_L(0); PG8_MMA(1, 0, At, B0); PG8_BAR; PG8_SCHED;
            PG8_STAGE(PG8_SB(0, 1), b2 + hstep, voffB);
            PG8_WAIT_V(6); PG8_BAR; PG8_MMA(1, 1, At, B1); PG8_BAR;
            PG8_LDB(B0, 1, 0); PG8_SCHED; PG8_LDA(At, 1, 0); PG8_STAGE(PG8_SA(0, 1), a2 + hstep, voffA);
            PG8_WAIT_L(8); PG8_BAR; PG8_WAIT_L(0); PG8_MMA(0, 0, At, B0); PG8_BAR; PG8_SCHED;
            PG8_LDB(B1, 1, 1); PG8_STAGE(PG8_SB(1, 0), b3, voffB);
            PG8_BAR; PG8_WAIT_L(0); PG8_MMA(0, 1, At, B1); PG8_BAR;
            PG8_LDA(At, 1, 1); PG8_STAGE(PG8_SA(1, 0), a3, voffA);
            PG8_BAR; PG8_WAIT_L(0); PG8_MMA(1, 0, At, B0); PG8_BAR; PG8_SCHED;
            PG8_STAGE(PG8_SB(1, 1), b3 + hstep, voffB);
            PG8_WAIT_V(6); PG8_BAR; PG8_MMA(1, 1, At, B1); PG8_BAR;
            }
        }
        if constexpr (ALIGN_EPI) { if (wr == 0) PG8_BAR; }
        if constexpr (!Epi::AFTER_DRAIN) { E(acc, cur, wr, wc, fr, fq); S.done(cur); }
        if (!has_next) break;
#pragma unroll
        for (int a = 0; a < 2; ++a)
#pragma unroll
            for (int b = 0; b < 2; ++b)
#pragma unroll
                for (int m = 0; m < 4; ++m)
#pragma unroll
                    for (int n = 0; n < 2; ++n) acc[a][b][m][n] = (f32x4){0.f, 0.f, 0.f, 0.f};
        cur = nxt; cA = nA; cB = nB; ++ui;
        if constexpr (ALIGN_EPI) { if (wr == 1) PG8_BAR; }
    }
    PG8_WAIT_V(0);
    if constexpr (!ALIGN_EPI) { if (wr == 0) PG8_BAR; }
    PG8_BAR;
    if constexpr (Epi::AFTER_DRAIN) { E.fused(acc, cur, wr, wc, fr, fq, lds, wid, lane); S.done(cur); }
#undef PG8_SA
#undef PG8_SB
#undef PG8_STAGE
#undef PG8_LDA
#undef PG8_LDB
#undef PG8_MMA
#undef PG8_WAIT_V
#undef PG8_WAIT_L
#undef PG8_BAR
#undef PG8_SCHED
}
}
#ifndef PG8_SP2
#define PG8_SP2 true
#endif
#ifndef PG8_ALIGN
#define PG8_ALIGN true
#endif

#include <hip/hip_bf16.h>
#include <cmath>
namespace datt {
using bf16 = __hip_bfloat16;
typedef short bf16x8 __attribute__((ext_vector_type(8)));
typedef short s16x4 __attribute__((ext_vector_type(4)));
typedef float f32x16 __attribute__((ext_vector_type(16)));
typedef float f32x4 __attribute__((ext_vector_type(4)));
typedef unsigned u32x4 __attribute__((ext_vector_type(4)));
constexpr int SEQ = 4096, DM = 1024, DQK = 64, DV = 128;
constexpr int NW = 8, QBLK = 32, KVBLK = 64, QB = NW * QBLK;
constexpr int SHM_V = KVBLK * DV * 2, SHM_K = KVBLK * DQK * 2;
constexpr int NSLOT = 3;
constexpr int LDS_BYTES = NSLOT * SHM_V + NSLOT * SHM_K + NW * 64 * 4;
constexpr float THR = 8.f;
#define DKSWZ(row, colB) ((row) * 128 + ((colB) ^ (((row) & 7) << 4)))
#define DSBAR() __builtin_amdgcn_sched_barrier(0)
__device__ __forceinline__ int v_st(int k, int c) { const int kk = (k & ~0xC) | ((k & 4) << 1) | ((k & 8) >> 1); return ((kk >> 3) * 4 + (c >> 5)) * 512 + ((kk & 7) * 32 + (c & 31)) * 2; }
__device__ __forceinline__ int v_rd_base(int lane) { return ((lane & 3) << 3) | (((lane >> 2) & 3) << 6) | (((lane >> 4) & 1) << 5) | (((lane >> 5) & 1) << 8); }
constexpr int v_rd_off(int d0, int ks, int half) { return d0 * 512 + ks * 4096 + half * 2048; }
__device__ __forceinline__ int crow(int r, int hi) { return (r & 3) + 8 * (r >> 2) + 4 * hi; }
__device__ __forceinline__ unsigned cvtpk(float lo, float hi) { unsigned r; asm volatile("v_cvt_pk_bf16_f32 %0, %1, %2" : "=v"(r) : "v"(lo), "v"(hi)); return r; }
__device__ __forceinline__ bf16x8 load8(const bf16* p) { return *reinterpret_cast<const bf16x8*>(p); }
__device__ __forceinline__ void mask_tile(f32x16& p0, f32x16& p1, int dq) {
    const float NEG = -__builtin_inff();
#pragma unroll
    for (int r = 0; r < 16; ++r) { const int c = (r & 3) + 8 * (r >> 2); if (dq - c < 0) p0[r] = NEG; if (dq - c - 32 < 0) p1[r] = NEG; }
}
__device__ __forceinline__ void alibi_tile(f32x16& p0, f32x16& p1, float sl2) {
#pragma unroll
    for (int r = 0; r < 16; ++r) { const float c = (float)((r & 3) + 8 * (r >> 2)); p0[r] = __builtin_fmaf(sl2, c, p0[r]); p1[r] = __builtin_fmaf(sl2, c + 32.f, p1[r]); }
}
__device__ __forceinline__ void partialSM(f32x16& p0, f32x16& p1, float base, float& m_reg, float& alpha) {
    float pmax = p0[0];
#pragma unroll
    for (int r = 1; r < 16; ++r) pmax = fmaxf(pmax, p0[r]);
#pragma unroll
    for (int r = 0; r < 16; ++r) pmax = fmaxf(pmax, p1[r]);
    { auto rr = __builtin_amdgcn_permlane32_swap(__float_as_uint(pmax), __float_as_uint(pmax), false, false); pmax = fmaxf(__uint_as_float(rr[0]), __uint_as_float(rr[1])); }
    pmax += base;
    float mn;
    if (__builtin_expect(__all(pmax - m_reg <= THR), 1)) { mn = m_reg; alpha = 1.f; }
    else { mn = fmaxf(m_reg, pmax); alpha = __builtin_amdgcn_exp2f(m_reg - mn); m_reg = mn; }
    const float mnL = base - mn;
#pragma unroll
    for (int r = 0; r < 16; ++r) p0[r] += mnL;
#pragma unroll
    for (int r = 0; r < 16; ++r) p1[r] += mnL;
#pragma unroll
    for (int r = 0; r < 16; ++r) p0[r] = __builtin_amdgcn_exp2f(p0[r]);
}
__device__ __forceinline__ void finishSM(f32x16& p0, f32x16& p1, float alpha, float& l_reg, bf16x8& pa0, bf16x8& pa1, bf16x8& pa2, bf16x8& pa3) {
#pragma unroll
    for (int r = 0; r < 16; ++r) p1[r] = __builtin_amdgcn_exp2f(p1[r]);
    float ps = 0;
#pragma unroll
    for (int r = 0; r < 16; ++r) ps += p0[r];
#pragma unroll
    for (int r = 0; r < 16; ++r) ps += p1[r];
    { auto rr = __builtin_amdgcn_permlane32_swap(__float_as_uint(ps), __float_as_uint(ps), false, false); ps = __uint_as_float(rr[0]) + __uint_as_float(rr[1]); }
    l_reg = l_reg * alpha + ps;
#define DPK4(P, B_, OUT) do { unsigned a0 = cvtpk(P[B_+0], P[B_+1]), a1 = cvtpk(P[B_+2], P[B_+3]); unsigned b0 = cvtpk(P[B_+4], P[B_+5]), b1 = cvtpk(P[B_+6], P[B_+7]); \
        auto r0 = __builtin_amdgcn_permlane32_swap(a0, b0, false, false); auto r1 = __builtin_amdgcn_permlane32_swap(a1, b1, false, false); \
        u32x4 w = {r0[0], r1[0], r0[1], r1[1]}; OUT = *reinterpret_cast<bf16x8*>(&w); } while (0)
    DPK4(p0, 0, pa0); DPK4(p0, 8, pa1); DPK4(p1, 0, pa2); DPK4(p1, 8, pa3);
#undef DPK4
}
__device__ __forceinline__ void qkt(f32x16& p0, f32x16& p1, const char* Kslot, int r32, int hi, const bf16x8* qr) {
    p0 = f32x16{}; p1 = f32x16{};
#pragma unroll
    for (int d0 = 0; d0 < 4; ++d0) { const char* a = Kslot + DKSWZ(r32, (d0 * 16 + hi * 8) * 2);
        const bf16x8 b0 = *reinterpret_cast<const bf16x8*>(a);
        const bf16x8 b1 = *reinterpret_cast<const bf16x8*>(a + 32 * 128);
        p0 = __builtin_amdgcn_mfma_f32_32x32x16_bf16(b0, qr[d0], p0, 0, 0, 0);
        p1 = __builtin_amdgcn_mfma_f32_32x32x16_bf16(b1, qr[d0], p1, 0, 0, 0); }
}
__device__ __forceinline__ void pv_tile(f32x16* o, int vb0, bf16x8 pa0, bf16x8 pa1, bf16x8 pa2, bf16x8 pa3) {
#define DTRRD(dst, off) asm volatile("ds_read_b64_tr_b16 %0, %1 offset:%2" : "=&v"(dst) : "v"(vb0), "i"(off) : "memory")
#define DPV_D0(d0) do { s16x4 l0, l1, l2, l3, h0, h1, h2, h3; constexpr int b_ = v_rd_off(d0, 0, 0); \
        DTRRD(l0, b_); DTRRD(h0, b_ + 2048); DTRRD(l1, b_ + 4096); DTRRD(h1, b_ + 6144); DTRRD(l2, b_ + 8192); DTRRD(h2, b_ + 10240); DTRRD(l3, b_ + 12288); DTRRD(h3, b_ + 14336); \
        asm volatile("s_waitcnt lgkmcnt(0)" ::: "memory"); DSBAR(); \
        o[d0] = __builtin_amdgcn_mfma_f32_32x32x16_bf16(pa0, (bf16x8){l0[0], l0[1], l0[2], l0[3], h0[0], h0[1], h0[2], h0[3]}, o[d0], 0, 0, 0); \
        o[d0] = __builtin_amdgcn_mfma_f32_32x32x16_bf16(pa1, (bf16x8){l1[0], l1[1], l1[2], l1[3], h1[0], h1[1], h1[2], h1[3]}, o[d0], 0, 0, 0); \
        o[d0] = __builtin_amdgcn_mfma_f32_32x32x16_bf16(pa2, (bf16x8){l2[0], l2[1], l2[2], l2[3], h2[0], h2[1], h2[2], h2[3]}, o[d0], 0, 0, 0); \
        o[d0] = __builtin_amdgcn_mfma_f32_32x32x16_bf16(pa3, (bf16x8){l3[0], l3[1], l3[2], l3[3], h3[0], h3[1], h3[2], h3[3]}, o[d0], 0, 0, 0); } while (0)
    DPV_D0(0); DPV_D0(1); DPV_D0(2); DPV_D0(3);
#undef DPV_D0
#undef DTRRD
}
struct BlockRef { const bf16* Q; const bf16* K; const bf16* V; bf16* O; int P0; int jlo; float sl2; };
struct Seam { bf16x8 qr[4]; bf16x8 st_v0, st_v1, st_k0; };
#define DROWV(p, k0, rr) ((p) + (size_t)((k0) + (rr)) * DM + sc)
#define DROWK(p, k0) ((p) + (size_t)((k0) + kr) * DM + kc)
#define DVMW() asm volatile("s_waitcnt vmcnt(0)" ::: "memory")
#define DVMWN(n) asm volatile("s_waitcnt vmcnt(%0)" :: "i"(n) : "memory")
#define DSLOAD(Kp, Vp, k0) do { S.st_v0 = load8(DROWV(Vp, k0, sr)); S.st_v1 = load8(DROWV(Vp, k0, 32 + sr)); S.st_k0 = load8(DROWK(Kp, k0)); } while (0)
#define DSWRITE_K(so) do { *(bf16x8*)(K_lds + (so) * SHM_K + kws) = S.st_k0; } while (0)
#define DSWRITE_V(so) do { *(bf16x8*)(V_lds + (so) * SHM_V + vst0) = S.st_v0; *(bf16x8*)(V_lds + (so) * SHM_V + vst1) = S.st_v1; } while (0)
__device__ __forceinline__ void datt_prime(const BlockRef& cur, char* lds, Seam& S) {
    const int tid = threadIdx.x, wid = __builtin_amdgcn_readfirstlane(tid >> 6), lane = tid & 63, r32 = lane & 31, hi = lane >> 5;
    const int sr = tid >> 4, sc = (tid & 15) * 8, kr = tid >> 3, kc = (tid & 7) * 8, kws = DKSWZ(kr, kc * 2); char* K_lds = lds + NSLOT * SHM_V;
    const int kb0 = cur.jlo * KVBLK;
#pragma unroll
    for (int d0 = 0; d0 < 4; ++d0) S.qr[d0] = load8(cur.Q + (size_t)(wid * QBLK + r32) * DM + d0 * 16 + hi * 8);
    DSLOAD(cur.K, cur.V, kb0); DVMW(); DSWRITE_K(0);
    __syncthreads();
}
__device__ __forceinline__ void datt_block(const BlockRef& cur, const BlockRef& nxt, char* lds, Seam& S) {
    const int tid = threadIdx.x, wid = __builtin_amdgcn_readfirstlane(tid >> 6), lane = tid & 63, r32 = lane & 31, hi = lane >> 5;
    const int j_lo = cur.jlo, j_hi = (cur.P0 + QB - 1) / KVBLK + 1, NT = j_hi - j_lo;
    const int kbn = nxt.jlo * KVBLK;
    const int qlo = cur.P0 + wid * QBLK, qm = qlo + r32 - 4 * hi;
    const float sl2 = cur.sl2;
    char* V_lds = lds; char* K_lds = lds + NSLOT * SHM_V;
    float* ws = (float*)(lds + NSLOT * SHM_V + NSLOT * SHM_K) + wid * 64; float* li_l = ws, * al_l = ws + 32;
    float m_reg = 4.0f, l_reg = 0; f32x16 o[4] = {};
    const int sr = tid >> 4, sc = (tid & 15) * 8, vst0 = v_st(sr, sc), vst1 = v_st(32 + sr, sc), kr = tid >> 3, kc = (tid & 7) * 8, kws = DKSWZ(kr, kc * 2);
    const int vb0 = (int)(uintptr_t)V_lds + v_rd_base(lane);
    const bf16* Kh = cur.K; const bf16* Vh = cur.V;
#define DRESC(a) do { if (__any((a) < 1.f)) { if (hi == 0) al_l[r32] = (a); asm volatile("s_waitcnt lgkmcnt(0)" ::: "memory"); \
                     _Pragma("unroll") for (int d_ = 0; d_ < 4; ++d_) _Pragma("unroll") for (int r = 0; r < 16; ++r) o[d_][r] *= al_l[crow(r, hi)]; } } while (0)
#define DKBASE(t) ((j_lo + (t)) * KVBLK)
#define DBIAS(t) (sl2 * (float)(DKBASE(t) - qm))
#define DMASKT(P0_, P1_, t) do { const int kb_ = DKBASE(t); alibi_tile(P0_, P1_, sl2); if (kb_ + KVBLK - 1 > qlo) mask_tile(P0_, P1_, qm - kb_); } while (0)
#define DSEAM_K0() do { DVMWN(4); DSWRITE_K(0); DSBAR(); } while (0)
    int s_p = 2, s_c = 0, s_n = 1;
#define DROT() do { const int t_ = s_p; s_p = s_c; s_c = s_n; s_n = t_; } while (0)
    f32x16 pA0, pA1, pB0, pB1; float alA, alB; bf16x8 pa0, pa1, pa2, pa3;
    DSWRITE_V(0); DSBAR();
    if (NT > 1) DSLOAD(Kh, Vh, DKBASE(1));
    DSBAR(); qkt(pA0, pA1, K_lds, r32, hi, S.qr);
    DMASKT(pA0, pA1, 0); partialSM(pA0, pA1, DBIAS(0), m_reg, alA);
    if (NT > 1) { DVMW(); DSWRITE_V(1); DSWRITE_K(1); }
    __syncthreads();
#define DHALF_STEP(PX0, PX1, alX, PY0, PY1, alY, t) do { DROT(); \
        DSBAR(); qkt(PX0, PX1, K_lds + s_c * SHM_K, r32, hi, S.qr); \
        finishSM(PY0, PY1, alY, l_reg, pa0, pa1, pa2, pa3); DSBAR(); \
        if ((t) + 1 < NT) { DSLOAD(Kh, Vh, DKBASE((t) + 1)); DSBAR(); } \
        pv_tile(o, vb0 + s_p * SHM_V, pa0, pa1, pa2, pa3); DMASKT(PX0, PX1, (t)); partialSM(PX0, PX1, DBIAS(t), m_reg, alX); \
        if ((t) + 1 < NT) { DVMW(); DSWRITE_V(s_n); DSWRITE_K(s_n); } \
        DRESC(alX); __syncthreads(); } while (0)
    for (int t = 1; t + 1 < NT; t += 2) {
        DHALF_STEP(pB0, pB1, alB, pA0, pA1, alA, t);
        DHALF_STEP(pA0, pA1, alA, pB0, pB1, alB, t + 1);
    }
    const bool even = (NT & 1) == 0;
    if (even) { DSBAR(); qkt(pB0, pB1, K_lds + s_n * SHM_K, r32, hi, S.qr); DSBAR(); }
    DSLOAD(nxt.K, nxt.V, kbn); DSBAR();
#pragma unroll
    for (int d0 = 0; d0 < 4; ++d0) S.qr[d0] = load8(nxt.Q + (size_t)(wid * QBLK + r32) * DM + d0 * 16 + hi * 8);
    DSBAR();
    finishSM(pA0, pA1, alA, l_reg, pa0, pa1, pa2, pa3); DSBAR();
    pv_tile(o, vb0 + s_c * SHM_V, pa0, pa1, pa2, pa3);
    if (even) { DMASKT(pB0, pB1, NT - 1); partialSM(pB0, pB1, DBIAS(NT - 1), m_reg, alB); __syncthreads(); DRESC(alB);
        finishSM(pB0, pB1, alB, l_reg, pa0, pa1, pa2, pa3); DSBAR(); pv_tile(o, vb0 + s_n * SHM_V, pa0, pa1, pa2, pa3); }
    else { __syncthreads(); }
    DSBAR(); DSEAM_K0();
    if (hi == 0) li_l[r32] = l_reg; asm volatile("s_waitcnt lgkmcnt(0)" ::: "memory");
    float rli[16];
#pragma unroll
    for (int r = 0; r < 16; ++r) rli[r] = __builtin_amdgcn_rcpf(li_l[crow(r, hi)]);
    bf16* Ow = cur.O + (size_t)(wid * QBLK) * DM;
#pragma unroll
    for (int r = 0; r < 16; ++r) { const int orow = crow(r, hi);
#pragma unroll
        for (int d0 = 0; d0 < 4; ++d0) { const float v = o[d0][r] * rli[r]; const float vn = __shfl_xor(v, 1);
            if ((r32 & 1) == 0) *(unsigned*)(Ow + (size_t)orow * DM + d0 * 32 + r32) = cvtpk(v, vn); } }
    __syncthreads();
#undef DRESC
#undef DKBASE
#undef DBIAS
#undef DMASKT
#undef DSEAM_K0
#undef DHALF_STEP
#undef DROT
}
#undef DROWV
#undef DROWK
#undef DVMW
#undef DVMWN
#undef DSLOAD
#undef DSWRITE_K
#undef DSWRITE_V
struct Tensors { const bf16* Q; const bf16* K; const bf16* V; bf16* O0; bf16* O1; const unsigned* NQ; const unsigned* NK; unsigned* qhead; const unsigned short* order; };
__device__ __forceinline__ BlockRef make_ref(const Tensors& T, unsigned code) {
    const int qb = code & 15, h = (code >> 4) & 7, b = (code >> 7) & 3, c = (code >> 9) & 1, hq = 2 * h + c;
    BlockRef r; const size_t rowb = (size_t)b * SEQ;
    r.Q = T.Q + (rowb + (size_t)qb * QB) * DM + hq * DQK; r.K = T.K + rowb * DM + hq * DQK; r.V = T.V + rowb * DM + h * DV; r.O = (c ? T.O1 : T.O0) + (rowb + (size_t)qb * QB) * DM + h * DV;
    r.P0 = qb * QB; r.sl2 = __builtin_amdgcn_exp2f(-(float)(h + 1)) * 1.4426950408889634f;
    int lane_ = threadIdx.x & 63; asm volatile("" : "+v"(lane_));
    const int nt_ = 4 * qb + 4; float qn_ = 0.f;
#pragma unroll
    for (int i_ = 0; i_ < 4; ++i_) qn_ = fmaxf(qn_, __uint_as_float(T.NQ[((b * 64 + 4 * qb + i_) * 16) + hq]));
    const float kn_ = lane_ < nt_ ? __uint_as_float(T.NK[((b * 64 + lane_) * 16) + hq]) : 0.f;
    const float bound_ = sqrtf(qn_) * sqrtf(kn_) * 1.001f - r.sl2 * (float)(256 * qb - 64 * lane_ - 63) - 4.0f;
    const unsigned long long keep_ = __ballot(lane_ < nt_ && !(bound_ < -152.0f));
    int first_ = keep_ ? (int)__builtin_ctzll(keep_) : nt_ - 1; if (first_ > nt_ - 4) first_ = nt_ - 4;
    r.jlo = __builtin_amdgcn_readfirstlane(first_);
    return r;
}
__device__ __forceinline__ int draw(const Tensors& T, volatile __attribute__((address_space(3))) unsigned* qw) {
    __syncthreads();
    if (threadIdx.x == 0) *qw = __hip_atomic_fetch_add(T.qhead, 1u, __ATOMIC_RELAXED, __HIP_MEMORY_SCOPE_AGENT);
    __syncthreads();
    return (int)*qw;
}
__device__ __forceinline__ void datt_phase(char* lds, volatile __attribute__((address_space(3))) unsigned* qw, const Tensors& T) {
    int i = draw(T, qw); if (i >= 1024) return;
    BlockRef cur = make_ref(T, T.order[i]);
    Seam S;
    datt_prime(cur, lds, S);
    for (;;) {
        const int in = draw(T, qw); const bool last = in >= 1024;
        const BlockRef nxt = last ? cur : make_ref(T, T.order[in]);
        datt_block(cur, nxt, lds, S);
        if (last) break;
        cur = nxt;
    }
}
#undef DKSWZ
#undef DSBAR
}
__device__ const unsigned short datt_order[1024] = {79,95,111,127,207,223,239,255,335,351,367,383,463,479,495,511,591,607,623,639,719,735,751,767,847,863,879,895,975,991,1007,1023,78,94,110,126,206,222,238,254,334,350,366,382,462,478,494,510,590,606,622,638,718,734,750,766,846,862,878,894,974,990,1006,1022,77,93,109,125,205,221,237,253,333,349,365,381,461,477,493,509,589,605,621,637,717,733,749,765,845,861,877,893,973,989,1005,1021,76,92,108,124,204,220,236,252,332,348,364,380,460,476,492,508,588,604,620,636,716,732,748,764,844,860,876,892,972,988,1004,1020,75,91,107,123,203,219,235,251,331,347,363,379,459,475,491,507,587,603,619,635,715,731,747,763,843,859,875,891,971,987,1003,1019,74,90,106,122,202,218,234,250,330,346,362,378,458,474,490,506,586,602,618,634,714,730,746,762,842,858,874,890,970,986,1002,1018,73,89,105,121,201,217,233,249,329,345,361,377,457,473,489,505,585,601,617,633,713,729,745,761,841,857,873,889,969,985,1001,1017,56,57,58,59,60,61,62,63,72,88,104,120,184,185,186,187,188,189,190,191,200,216,232,248,312,313,314,315,316,317,318,319,328,344,360,376,440,441,442,443,444,445,446,447,456,472,488,504,568,569,570,571,572,573,574,575,584,600,616,632,696,697,698,699,700,701,702,703,712,728,744,760,824,825,826,827,828,829,830,831,840,856,872,888,952,953,954,955,956,957,958,959,968,984,1000,1016,55,71,87,103,119,183,199,215,231,247,311,327,343,359,375,439,455,471,487,503,567,583,599,615,631,695,711,727,743,759,823,839,855,871,887,951,967,983,999,1015,54,70,86,102,118,182,198,214,230,246,310,326,342,358,374,438,454,470,486,502,566,582,598,614,630,694,710,726,742,758,822,838,854,870,886,950,966,982,998,1014,53,69,85,101,117,181,197,213,229,245,309,325,341,357,373,437,453,469,485,501,565,581,597,613,629,693,709,725,741,757,821,837,853,869,885,949,965,981,997,1013,36,37,38,39,40,41,42,43,44,45,46,47,52,68,84,100,116,164,165,166,167,168,169,170,171,172,173,174,175,180,196,212,228,244,292,293,294,295,296,297,298,299,300,301,302,303,308,324,340,356,372,420,421,422,423,424,425,426,427,428,429,430,431,436,452,468,484,500,548,549,550,551,552,553,554,555,556,557,558,559,564,580,596,612,628,676,677,678,679,680,681,682,683,684,685,686,687,692,708,724,740,756,804,805,806,807,808,809,810,811,812,813,814,815,820,836,852,868,884,932,933,934,935,936,937,938,939,940,941,942,943,948,964,980,996,1012,35,51,67,83,99,115,163,179,195,211,227,243,291,307,323,339,355,371,419,435,451,467,483,499,547,563,579,595,611,627,675,691,707,723,739,755,803,819,835,851,867,883,931,947,963,979,995,1011,18,19,20,21,22,23,24,25,26,27,28,29,30,31,34,50,66,82,98,114,146,147,148,149,150,151,152,153,154,155,156,157,158,159,162,178,194,210,226,242,274,275,276,277,278,279,280,281,282,283,284,285,286,287,290,306,322,338,354,370,402,403,404,405,406,407,408,409,410,411,412,413,414,415,418,434,450,466,482,498,530,531,532,533,534,535,536,537,538,539,540,541,542,543,546,562,578,594,610,626,658,659,660,661,662,663,664,665,666,667,668,669,670,671,674,690,706,722,738,754,786,787,788,789,790,791,792,793,794,795,796,797,798,799,802,818,834,850,866,882,914,915,916,917,918,919,920,921,922,923,924,925,926,927,930,946,962,978,994,1010,1,2,3,4,5,6,7,8,9,10,11,12,13,14,15,17,33,49,65,81,97,113,129,130,131,132,133,134,135,136,137,138,139,140,141,142,143,145,161,177,193,209,225,241,257,258,259,260,261,262,263,264,265,266,267,268,269,270,271,273,289,305,321,337,353,369,385,386,387,388,389,390,391,392,393,394,395,396,397,398,399,401,417,433,449,465,481,497,513,514,515,516,517,518,519,520,521,522,523,524,525,526,527,529,545,561,577,593,609,625,641,642,643,644,645,646,647,648,649,650,651,652,653,654,655,657,673,689,705,721,737,753,769,770,771,772,773,774,775,776,777,778,779,780,781,782,783,785,801,817,833,849,865,881,897,898,899,900,901,902,903,904,905,906,907,908,909,910,911,913,929,945,961,977,993,1009,0,16,32,48,64,80,96,112,128,144,160,176,192,208,224,240,256,272,288,304,320,336,352,368,384,400,416,432,448,464,480,496,512,528,544,560,576,592,608,624,640,656,672,688,704,720,736,752,768,784,800,816,832,848,864,880,896,912,928,944,960,976,992,1008};

constexpr int NWAVES = 8;
constexpr int BATCH = 4, SEQ = 4096, D = 2048, M = BATCH * SEQ;
constexpr int AW = 1024, NIN = 5120;
constexpr float LN_EPS = 1e-5f;
constexpr float DN_ALPHA = 1.189207115002721f;
constexpr float C2 = 0.125f * 1.4426950408889634f;
constexpr float LOG2E = 1.4426950408889634f;

constexpr size_t MiB = 1u << 20;
constexpr size_t WS_CTL = 0, CTL_ZERO_BYTES = 1 * MiB;
constexpr size_t WS_WIN = 2 * MiB, WS_WOUT = 22 * MiB, WS_WQ = 30 * MiB, WS_PRM = 38 * MiB;
constexpr size_t WS_XB = 392 * MiB;
constexpr size_t WS_MIX = 40 * MiB;
constexpr size_t WS_Q = 104 * MiB, WS_K = 136 * MiB, WS_V = 168 * MiB, WS_XR = 200 * MiB, WS_XG = 232 * MiB;
constexpr size_t WS_Y1 = 104 * MiB;
constexpr size_t WS_H1 = 232 * MiB;
constexpr size_t WS_H8 = 296 * MiB;
constexpr size_t WS_PQ = 104 * MiB;
constexpr size_t WS_SU = 38 * MiB + 65536, WS_SH = 38 * MiB + 131072;
constexpr size_t WS_WG = 38 * MiB + 262144;
constexpr size_t WS_PART = 104 * MiB;
constexpr size_t WS_FFN = 40 * MiB;
constexpr size_t WS_PK = 2 * MiB;
constexpr size_t WS_U8 = 328 * MiB, WS_V8 = 360 * MiB;
constexpr size_t WS_O0 = 264 * MiB, WS_O1 = 296 * MiB;
constexpr size_t WS_E = 456 * MiB, WS_G = 464 * MiB, WS_TOTA = 472 * MiB, WS_TOTH = 473 * MiB, WS_SKH = 474 * MiB, WS_SKL = 475 * MiB, WS_END = 476 * MiB;
constexpr int CW_BAR = 4096;
constexpr int CW_NQ = 32768, CW_NK = 32768 + 4096, CW_AQ = 32768 + 8192, CW_CQ = 32768 + 8192 + 128;

constexpr int RING_OFF = 0, RING_BYTES = 131072;
constexpr int LDSCTL_OFF = RING_BYTES, MISC_OFF = LDSCTL_OFF + 320;
constexpr int LDS_BYTES = 147456;

#define GAS __attribute__((address_space(1)))
#define LAS __attribute__((address_space(3)))
typedef unsigned short bf16;
typedef unsigned v4u __attribute__((ext_vector_type(4)));
typedef float f32x4 __attribute__((ext_vector_type(4)));
typedef GAS unsigned gu32;
#define RLX_AGENT __ATOMIC_RELAXED, __HIP_MEMORY_SCOPE_AGENT
#define LDS_WAIT() asm volatile("s_waitcnt lgkmcnt(0)" ::: "memory")
#define VM_WAIT() asm volatile("s_waitcnt vmcnt(0)" ::: "memory")
__device__ __forceinline__ unsigned pk2(float lo, float hi) { unsigned r; asm("v_cvt_pk_bf16_f32 %0, %1, %2" : "=v"(r) : "v"(lo), "v"(hi)); return r; }
__device__ __forceinline__ unsigned f2bf(float f) { return pk2(f, 0.f) & 0xffffu; }
__device__ __forceinline__ float bf2f(unsigned short u) { return __uint_as_float(((unsigned)u) << 16); }
__device__ __forceinline__ float wave_sum(float x) {
    x += __builtin_bit_cast(float, __builtin_amdgcn_update_dpp(0, __builtin_bit_cast(int, x), 0xB1, 0xf, 0xf, true)); x += __builtin_bit_cast(float, __builtin_amdgcn_update_dpp(0, __builtin_bit_cast(int, x), 0x4E, 0xf, 0xf, true));
    x += __builtin_bit_cast(float, __builtin_amdgcn_update_dpp(0, __builtin_bit_cast(int, x), 0x141, 0xf, 0xf, true)); x += __builtin_bit_cast(float, __builtin_amdgcn_update_dpp(0, __builtin_bit_cast(int, x), 0x140, 0xf, 0xf, true));
    const int xi = __builtin_bit_cast(int, x);
    return (__builtin_bit_cast(float, __builtin_amdgcn_readlane(xi, 0)) + __builtin_bit_cast(float, __builtin_amdgcn_readlane(xi, 16))) + (__builtin_bit_cast(float, __builtin_amdgcn_readlane(xi, 32)) + __builtin_bit_cast(float, __builtin_amdgcn_readlane(xi, 48)));
}
__device__ __forceinline__ float wave_max_nonneg(float x) {
    x = fmaxf(x, __builtin_bit_cast(float, __builtin_amdgcn_update_dpp(0, __builtin_bit_cast(int, x), 0xB1, 0xf, 0xf, true))); x = fmaxf(x, __builtin_bit_cast(float, __builtin_amdgcn_update_dpp(0, __builtin_bit_cast(int, x), 0x4E, 0xf, 0xf, true)));
    x = fmaxf(x, __builtin_bit_cast(float, __builtin_amdgcn_update_dpp(0, __builtin_bit_cast(int, x), 0x141, 0xf, 0xf, true))); x = fmaxf(x, __builtin_bit_cast(float, __builtin_amdgcn_update_dpp(0, __builtin_bit_cast(int, x), 0x140, 0xf, 0xf, true)));
    const int xi = __builtin_bit_cast(int, x);
    return fmaxf(fmaxf(__builtin_bit_cast(float, __builtin_amdgcn_readlane(xi, 0)), __builtin_bit_cast(float, __builtin_amdgcn_readlane(xi, 16))), fmaxf(__builtin_bit_cast(float, __builtin_amdgcn_readlane(xi, 32)), __builtin_bit_cast(float, __builtin_amdgcn_readlane(xi, 48))));
}
__device__ __forceinline__ float gelu_tanh(float x) { const float u2 = -2.302208198f * (x + 0.044715f * x * x * x); return x * __builtin_amdgcn_rcpf(1.f + __builtin_amdgcn_exp2f(u2)); }

#define XB_TMO      128
#define XB_XCNT(j)  (256  + 64 * (j))
#define XB_XSUB(j)  (1280 + 64 * (j))
#define XB_XGEN(j)  (2304 + 64 * (j))
#define XB_TOP      3328
#define XB_TOPGEN   3392
#define XCD_BAR_WORDS 3456
#define XB_SPIN_CAP (1u << 18)

__device__ __forceinline__ unsigned xb_ld(unsigned* p)              { return __hip_atomic_load(p, __ATOMIC_RELAXED, __HIP_MEMORY_SCOPE_AGENT); }
__device__ __forceinline__ unsigned xb_add(unsigned* p, unsigned v) { return __hip_atomic_fetch_add(p, v, __ATOMIC_RELAXED, __HIP_MEMORY_SCOPE_AGENT); }
__device__ __forceinline__ unsigned xb_xcc_id() { return (unsigned)__builtin_amdgcn_s_getreg((3 << 11) | 20) & 0xFu; }
#define XB_SPIN(cond, bar) do { unsigned _sp = 0; while (cond) { __builtin_amdgcn_s_sleep(1); \
    if ((++_sp & 255u) == 0u) { if (xb_ld(&(bar)[XB_TMO])) break; if (_sp > XB_SPIN_CAP) { atomicAdd(&(bar)[XB_TMO], 1u); break; } } } } while (0)

struct XcdBarrier {
    unsigned* bar; unsigned x;
    volatile LAS unsigned* st;
};

__device__ __forceinline__ XcdBarrier xcd_barrier_post(unsigned* bar, volatile LAS unsigned* st) {
    XcdBarrier b; b.bar = bar; b.x = xb_xcc_id(); b.st = st;
    if (threadIdx.x == 0) (void)xb_add(&bar[XB_XCNT(b.x)], 1u);
    return b;
}
__device__ __forceinline__ void xcd_barrier_complete(unsigned* bar, unsigned x, unsigned& nloc, unsigned& nx) {
    const unsigned G = gridDim.x * gridDim.y * gridDim.z;
    unsigned sum, cnt, mine, sp = 0u;
    for (;;) {
        sum = 0u; cnt = 0u; mine = 0u;
#pragma unroll
        for (unsigned j = 0; j < 16; ++j) { const unsigned c = xb_ld(&bar[XB_XCNT(j)]); sum += c; cnt += (c > 0u) ? 1u : 0u; mine = (j == x) ? c : mine; }
        if (sum == G) break;
        __builtin_amdgcn_s_sleep(1);
        if ((++sp & 255u) == 0u) { if (xb_ld(&bar[XB_TMO])) break; if (sp > XB_SPIN_CAP) { atomicAdd(&bar[XB_TMO], 1u); break; } }
    }
    nloc = mine > 0u ? mine : 1u; nx = cnt > 0u ? cnt : 1u;
}

__device__ __forceinline__ void xcd_barrier(const XcdBarrier& b) {
    asm volatile("s_waitcnt vmcnt(0)" ::: "memory");
    __syncthreads();
    if (threadIdx.x == 0) {
        unsigned* bar = b.bar;
        __builtin_amdgcn_s_waitcnt(0);
        unsigned nloc = b.st[0], nx = b.st[1];
        if (nloc == 0u) { xcd_barrier_complete(bar, b.x, nloc, nx); b.st[0] = nloc; b.st[1] = nx; }
        const unsigned old = xb_add(&bar[XB_XSUB(b.x)], 1u);
        const unsigned gen = old / nloc;
        if (old + 1u == (gen + 1u) * nloc) {
            __builtin_amdgcn_fence(__ATOMIC_RELEASE, "agent");
            asm volatile("s_waitcnt vmcnt(0)" ::: "memory");
            const unsigned og = xb_add(&bar[XB_TOP], 1u);
            const unsigned tg = og / nx;
            if (og + 1u == (tg + 1u) * nx) xb_add(&bar[XB_TOPGEN], 1u);
            else XB_SPIN(xb_ld(&bar[XB_TOPGEN]) == tg, bar);
            __builtin_amdgcn_fence(__ATOMIC_ACQUIRE, "agent");
            xb_add(&bar[XB_XGEN(b.x)], 1u);
            asm volatile("s_waitcnt vmcnt(0)" ::: "memory");
        } else {
            XB_SPIN(xb_ld(&bar[XB_XGEN(b.x)]) == gen, bar);
            __builtin_amdgcn_fence(__ATOMIC_ACQUIRE, "agent");
            asm volatile("s_waitcnt vmcnt(0)" ::: "memory");
        }
    }
    __syncthreads();
}

struct Frame {
    LAS unsigned char* lds;
    int tid, lane, wave;
    int vcu, G;
};

__device__ __forceinline__ void p0_transpose_item(const float* W, int K, int N, bf16* WT, int row_off, LAS float* scr, int item, int lane) {
    const int nblk = N / 32, kb = item / nblk, nb = item % nblk, k0 = 64 * kb, n0 = 32 * nb;
    float wv_[32];
    { const unsigned wb_ = (unsigned)((k0 + (lane >> 5)) * N + n0 + (lane & 31)) * 4u;
#pragma unroll
      for (int i = 0; i < 32; ++i) wv_[i] = __builtin_nontemporal_load((const float*)((const unsigned char*)W + (wb_ + (unsigned)(2 * i * N * 4)))); }
#pragma unroll
    for (int i = 0; i < 32; ++i) { const int kk = 2 * i + (lane >> 5); scr[kk * 33 + (lane & 31)] = wv_[i]; }
    LDS_WAIT(); asm volatile("" ::: "memory");
    const int c = lane & 7;
#pragma unroll
    for (int j = 0; j < 4; ++j) { const int n = (lane >> 3) + 8 * j; const LAS float* s = scr + (8 * c) * 33 + n;
        v4u o; o.x = pk2(s[0 * 33], s[1 * 33]); o.y = pk2(s[2 * 33], s[3 * 33]); o.z = pk2(s[4 * 33], s[5 * 33]); o.w = pk2(s[6 * 33], s[7 * 33]);
        *(GAS v4u*)(WT + (size_t)(row_off + n0 + n) * K + k0 + 8 * c) = o; }
    LDS_WAIT(); asm volatile("" ::: "memory");
}

typedef short bf16x8 __attribute__((ext_vector_type(8)));
typedef float f32x16 __attribute__((ext_vector_type(16)));
typedef float f32x2_t __attribute__((ext_vector_type(2))); typedef __bf16 bf16x2_t __attribute__((ext_vector_type(2)));
__device__ __forceinline__ unsigned cvtpk(float lo, float hi) { f32x2_t v = {lo, hi}; bf16x2_t b = __builtin_convertvector(v, bf16x2_t); return __builtin_bit_cast(unsigned, b); }
__device__ __forceinline__ void split8(const f32x4 a, const f32x4 b, bf16x8& h, bf16x8& l) {
    v4u hh; hh.x = cvtpk(a.x, a.y); hh.y = cvtpk(a.z, a.w); hh.z = cvtpk(b.x, b.y); hh.w = cvtpk(b.z, b.w);
    v4u ll;
    ll.x = cvtpk(a.x - __uint_as_float(hh.x << 16), a.y - __uint_as_float(hh.x & 0xffff0000u));
    ll.y = cvtpk(a.z - __uint_as_float(hh.y << 16), a.w - __uint_as_float(hh.y & 0xffff0000u));
    ll.z = cvtpk(b.x - __uint_as_float(hh.z << 16), b.y - __uint_as_float(hh.z & 0xffff0000u));
    ll.w = cvtpk(b.z - __uint_as_float(hh.w << 16), b.w - __uint_as_float(hh.w & 0xffff0000u));
    h = __builtin_bit_cast(bf16x8, hh); l = __builtin_bit_cast(bf16x8, ll);
}
__device__ __forceinline__ float max3f_(float a, float b, float c) { return __builtin_fmaxf(__builtin_fmaxf(a, b), c); }
__device__ __forceinline__ float pair_max(float m) { auto rr = __builtin_amdgcn_permlane32_swap(__float_as_uint(m), __float_as_uint(m), false, false); return __builtin_fmaxf(__uint_as_float(rr[0]), __uint_as_float(rr[1])); }
typedef float f32x2v __attribute__((ext_vector_type(2)));
__device__ __forceinline__ unsigned pk4_fp8(float a, float b, float c, float d) { int p = __builtin_amdgcn_cvt_pk_fp8_f32(a, b, 0, false); p = __builtin_amdgcn_cvt_pk_fp8_f32(c, d, p, true); return (unsigned)p; }
constexpr float U8_SCALE = 64.f;
typedef short bf16x8_l __attribute__((ext_vector_type(8)));
template <int PASS, bool CONV = false> __device__ __forceinline__ void lru_phase(const Frame& F, unsigned char* ws, const float* conv_w, const float* conv_b, const float* b_a, const float* b_x, const float* lru_lambda, const float* tab_u = nullptr, const float* tab_v = nullptr) {
    int itc = 0;
    constexpr int XS = 272;
    LAS unsigned char* xs = F.lds + RING_OFF;
    const bf16* XR = (const bf16*)(ws + WS_XR); const bf16* XG = (const bf16*)(ws + WS_XG); bf16* MIX = (bf16*)(ws + WS_MIX); const bf16* WGT = (const bf16*)(ws + WS_WG);
    float* TA = (float*)(ws + WS_TOTA); float* TH = (float*)(ws + WS_TOTH);
    const int tid = F.tid, lane = F.lane, w = F.wave, l15 = lane & 15, g = lane >> 4;
    const int hb = F.vcu & 7;
    const int nun = 2048 / 8;
    const int gi = F.vcu >> 3, gn = (F.G + 7 - hb) >> 3;
    const int chc = tid & 127, tg = tid >> 7, colc = hb * 128 + chc;
    const float cw0 = conv_w[colc], cw1 = conv_w[1024 + colc], cw2 = conv_w[2048 + colc], cw3 = conv_w[3072 + colc], cb = conv_b[colc];
    const int chn = hb * 128 + 16 * w + l15;
    LAS unsigned char* wb = F.lds + RING_OFF + 49152 + w * 8192 + lane * 16;
#pragma unroll
    for (int ks = 0; ks < 4; ++ks) { *(LAS bf16x8_l*)(wb + ks * 1024) = *(const bf16x8_l*)(WGT + ((size_t)(hb * 128 + 16 * w + l15)) * 128 + 32 * ks + 8 * g);
        *(LAS bf16x8_l*)(wb + (4 + ks) * 1024) = *(const bf16x8_l*)(WGT + ((size_t)((8 + hb) * 128 + 16 * w + l15)) * 128 + 32 * ks + 8 * g); }
    const float ba = b_a[chn], bx = b_x[chn], sp8 = 8.f * log1pf(__expf(-lru_lambda[chn]));
    unsigned short xrn[19];
#define LRU_LOAD(uu) do { const int c_ = (uu) & 63, b_ = (uu) >> 6, tok0_ = b_ * SEQ + c_ * 64; \
        unsigned ro_ = (unsigned)((tok0_ + tg * 16) * AW + colc) * 2u; asm volatile("" : "+v"(ro_)); \
        _Pragma("unroll") for (int r = 0; r < 19; ++r) xrn[r] = (c_ * 64 + tg * 16 + r - 3 >= 0) ? *(const unsigned short*)((const unsigned char*)(XR - 3 * AW) + (ro_ + (unsigned)(r * AW * 2))) : (unsigned short)0; \
        } while (0)
    if (gi < nun) LRU_LOAD(gi);
    for (int uu = gi; uu < nun; uu += gn) {
        const int c = uu & 63, b = uu >> 6, tok0 = b * SEQ + c * 64;
        {
            float xv[19];
#pragma unroll
            for (int r = 0; r < 19; ++r) xv[r] = bf2f(xrn[r]);
#pragma unroll
            for (int i = 0; i < 16; ++i) { const float y = cb + cw0 * xv[i] + cw1 * xv[i + 1] + cw2 * xv[i + 2] + cw3 * xv[i + 3];
                *(LAS unsigned short*)(xs + (tg * 16 + i) * XS + chc * 2) = (unsigned short)f2bf(y); }
        }
        unsigned short xgv[16]; float ta[16], th[16];
        if (PASS == 2) {
            int go_ = (tok0 + 4 * g) * AW + chn, to_ = b * 65536 + chn; asm volatile("" : "+v"(go_), "+v"(to_));
#pragma unroll
            for (int m = 0; m < 4; ++m)
#pragma unroll
                for (int r = 0; r < 4; ++r) xgv[4 * m + r] = *(const unsigned short*)((const unsigned char*)XG + ((unsigned)go_ * 2u + (unsigned)((16 * m + r) * AW * 2)));
#pragma unroll
            for (int i = 0; i < 16; ++i) { const int c2 = 16 * g + i, cl = c2 < c ? c2 : 0; const unsigned tb_ = (unsigned)(to_ + cl * 1024) * 4u; ta[i] = *(const float*)((const unsigned char*)TA + tb_); th[i] = *(const float*)((const unsigned char*)TH + tb_); }
        }
        __syncthreads();
        if (uu + gn < nun) LRU_LOAD(uu + gn);
        f32x4 cu_[8]; const int itcc = itc < 7 ? itc : 7;
        if (CONV) {
            if (PASS == 1) { int uo_ = (F.vcu * 64 + itcc * 8 + w) * (D / 4) + lane; asm volatile("" : "+v"(uo_));
#pragma unroll
                for (int j = 0; j < 8; ++j) cu_[j] = ((const f32x4*)tab_u)[uo_ + 64 * j]; }
            else { int vo_ = (F.vcu * 64 + (tid >> 6)) * (D / 4) + itcc * 64 + (tid & 63); asm volatile("" : "+v"(vo_));
#pragma unroll
                for (int j = 0; j < 8; ++j) cu_[j] = __builtin_nontemporal_load((const f32x4*)tab_v + (vo_ + 8 * j * (D / 4))); }
        }
        f32x4 ca[4], cx[4];
#pragma unroll
        for (int m = 0; m < 4; ++m) { ca[m] = (f32x4){0.f, 0.f, 0.f, 0.f}; cx[m] = (f32x4){0.f, 0.f, 0.f, 0.f};
#pragma unroll
            for (int ks = 0; ks < 4; ++ks) { const bf16x8_l A = *(const LAS bf16x8_l*)(xs + (16 * m + l15) * XS + (32 * ks + 8 * g) * 2);
                const bf16x8_l Bak = *(const LAS bf16x8_l*)(wb + ks * 1024), Bxk = *(const LAS bf16x8_l*)(wb + (4 + ks) * 1024);
                ca[m] = __builtin_amdgcn_mfma_f32_16x16x32_bf16(A, Bak, ca[m], 0, 0, 0); cx[m] = __builtin_amdgcn_mfma_f32_16x16x32_bf16(A, Bxk, cx[m], 0, 0, 0); } }
        float av[4][4], bv[4][4];
#pragma unroll
        for (int m = 0; m < 4; ++m)
#pragma unroll
            for (int r = 0; r < 4; ++r) { const int tt = 16 * m + 4 * g + r;
                const float rg = __builtin_amdgcn_rcpf(1.f + __builtin_amdgcn_exp2f(-1.4426950408889634f * (ca[m][r] + ba))), ig = __builtin_amdgcn_rcpf(1.f + __builtin_amdgcn_exp2f(-1.4426950408889634f * (cx[m][r] + bx)));
                const float a = __builtin_amdgcn_exp2f(-1.4426950408889634f * sp8 * rg), xcv = bf2f(*(const LAS unsigned short*)(xs + tt * XS + (16 * w + l15) * 2));
                av[m][r] = a; bv[m][r] = __builtin_amdgcn_sqrtf(fmaxf(1.f - a * a, 0.f)) * ig * xcv; }
        float carry = 0.f, Ac = 1.f;
        if (PASS == 2) {
            float Ap = 1.f, Hp = 0.f;
#pragma unroll
            for (int i = 0; i < 16; ++i) { const bool in_ = 16 * g + i < c; const float ta_ = in_ ? ta[i] : 1.f, th_ = in_ ? th[i] : 0.f; Hp = ta_ * Hp + th_; Ap *= ta_; }
            { const float A1 = __shfl_up(Ap, 16), H1 = __shfl_up(Hp, 16); if (g >= 1) { Hp = Ap * H1 + Hp; Ap = Ap * A1; } }
            { const float A2 = __shfl_up(Ap, 32), H2 = __shfl_up(Hp, 32); if (g >= 2) { Hp = Ap * H2 + Hp; Ap = Ap * A2; } }
            carry = __shfl(Hp, 48 + l15);
        }
#pragma unroll
        for (int m = 0; m < 4; ++m) {
            float As = (av[m][0] * av[m][1]) * (av[m][2] * av[m][3]);
            float Hs = ((bv[m][0] * av[m][1] + bv[m][1]) * av[m][2] + bv[m][2]) * av[m][3] + bv[m][3];
            { const float A1 = __shfl_up(As, 16), H1 = __shfl_up(Hs, 16); if (g >= 1) { Hs = As * H1 + Hs; As = As * A1; } }
            { const float A2 = __shfl_up(As, 32), H2 = __shfl_up(Hs, 32); if (g >= 2) { Hs = As * H2 + Hs; As = As * A2; } }
            const float At = __shfl(As, 48 + l15), Ht = __shfl(Hs, 48 + l15);
            if (PASS == 2) {
                float Ae = __shfl_up(As, 16), He = __shfl_up(Hs, 16); if (g == 0) { Ae = 1.f; He = 0.f; }
                float h = Ae * carry + He;
                int mo_ = (tok0 + 16 * m + 4 * g) * D + 1024 + chn; asm volatile("" : "+v"(mo_));
#pragma unroll
                for (int r = 0; r < 4; ++r) { h = av[m][r] * h + bv[m][r];
                    *(unsigned short*)((unsigned char*)MIX + ((unsigned)mo_ * 2u + (unsigned)(r * D * 2))) = (unsigned short)f2bf(h * gelu_tanh(bf2f(xgv[4 * m + r]))); }
            }
            carry = At * carry + Ht; Ac *= At;
        }
        if (PASS == 1 && g == 0) { int so_ = (b * 64 + c) * 1024 + chn; asm volatile("" : "+v"(so_)); TA[so_] = Ac; TH[so_] = carry; }
        if (CONV && PASS == 1 && itc < 8) {
            const int e = F.vcu * 64 + itc * 8 + w; float am = 0.f;
#pragma unroll
            for (int j = 0; j < 8; ++j) am = fmaxf(fmaxf(am, fmaxf(fabsf(cu_[j].x), fabsf(cu_[j].y))), fmaxf(fabsf(cu_[j].z), fabsf(cu_[j].w)));
            am = wave_max_nonneg(am);
            const float qs = am > 0.f ? 127.f / am : 0.f;
            if (lane == 0) ((float*)(ws + WS_SU))[e] = am * (1.f / 127.f);
#pragma unroll
            for (int j = 0; j < 8; ++j) { const int cc_ = (lane + 64 * j) * 4;
                const unsigned q = ((unsigned)(int)rintf(cu_[j].x * qs) & 0xffu) | (((unsigned)(int)rintf(cu_[j].y * qs) & 0xffu) << 8) | (((unsigned)(int)rintf(cu_[j].z * qs) & 0xffu) << 16) | (((unsigned)(int)rintf(cu_[j].w * qs) & 0xffu) << 24);
                *(unsigned*)(ws + WS_U8 + ((size_t)(cc_ >> 7) * 16384 + e) * 128 + (cc_ & 127)) = q; }
        }
        if (CONV && PASS == 2) {
            LAS unsigned char* tl = F.lds + RING_OFF + 32768;
            int tq_ = tid; asm volatile("" : "+v"(tq_));
            if (itc < 8) { const int lo_ = ((4 * (tq_ & 63)) >> 3) * 512 + (tq_ >> 6) * 8 + ((4 * (tq_ & 63)) & 7);
#pragma unroll
                for (int j = 0; j < 8; ++j) *(LAS unsigned*)(tl + lo_ + 64 * j) = pk4_fp8(cu_[j].x, cu_[j].y, cu_[j].z, cu_[j].w); }
            __syncthreads();
            if (itc < 8) { const int cu2 = tq_ >> 5, pc = tq_ & 31;
#pragma unroll
                for (int j = 0; j < 2; ++j)
                    *(v4u*)(ws + WS_V8 + ((size_t)(itc * 32 + cu2 + 16 * j) * 16384 + F.vcu * 64) * 8 + pc * 16) = *(const LAS v4u*)(tl + (cu2 + 16 * j) * 512 + pc * 16); }
        }
        ++itc;
        __syncthreads();
    }
#undef LRU_LOAD
}
struct Args { const float* in[23]; float* out; unsigned char* ws; int ph_lo, ph_hi; };

__global__ void __launch_bounds__(NWAVES * 64, 2) skel_fwd(Args args) {
    extern __shared__ __attribute__((aligned(16))) unsigned char lds[];
    Frame F;
    F.lds = (LAS unsigned char*)lds;
    F.tid = threadIdx.x; F.lane = F.tid & 63; F.wave = __builtin_amdgcn_readfirstlane(F.tid >> 6);
    F.G = gridDim.x; { const int bx = blockIdx.x; F.vcu = (F.G % 8 == 0) ? (bx % 8) * (F.G / 8) + bx / 8 : bx; }
    unsigned char* ws = args.ws;
    const float* x = args.in[0];
    bf16* WIN_T = (bf16*)(ws + WS_WIN); bf16* WOUT_T = (bf16*)(ws + WS_WOUT); bf16* WQ_T = (bf16*)(ws + WS_WQ);
    bf16* XB = (bf16*)(ws + WS_XB); bf16* MIX = (bf16*)(ws + WS_MIX); bf16* QB = (bf16*)(ws + WS_Q); bf16* H1 = (bf16*)(ws + WS_H1);
    float* Y1 = (float*)(ws + WS_Y1); float* PQ = (float*)(ws + WS_PQ);
    for (int u = F.tid; u < (LDS_BYTES - LDSCTL_OFF) / 4; u += NWAVES * 64) ((LAS unsigned*)(F.lds + LDSCTL_OFF))[u] = 0u;
    __syncthreads();
    XcdBarrier bar = xcd_barrier_post((unsigned*)(ws + WS_CTL) + CW_BAR, (volatile LAS unsigned*)(F.lds + MISC_OFF) + 8);
    const unsigned phmask = (unsigned)args.ph_lo;
    int slot_ = 0;
#define IN(k) (false)
#define RUN(slotbit) ((phmask >> (slotbit)) & 1u)
#define GRID_BAR() do { if (phmask == 0xffffffffu) xcd_barrier(bar); } while (0)

    if (RUN(0)) {
        if (blockIdx.x == 0 && F.wave == 0) {
            float a_ = args.in[9][F.lane] * args.in[10][F.lane], b_ = args.in[11][F.lane] * args.in[12][F.lane];
#pragma unroll
            for (int o = 1; o < 64; o <<= 1) { a_ += __shfl_xor(a_, o); b_ += __shfl_xor(b_, o); }
            if (F.lane == 0) ((float*)(ws + WS_PRM))[0] = expf(a_) - expf(b_) + 0.2f;
        }
        LAS float* scr = (LAS float*)(F.lds + RING_OFF + F.wave * 16384);
        const int gw = F.vcu * NWAVES + F.wave, NGW = F.G * NWAVES;
        constexpr int I_IN = (D / 64) * (NIN / 32), I_SQ = (D / 64) * (D / 32);
        constexpr int NITEMS = I_IN + 2 * I_SQ;
#pragma unroll 1
        for (int st_ = 0; st_ < 2; ++st_) {
        if (((st_ ^ F.wave) & 1) == 0) {
        for (int it = gw; it < I_IN; it += NGW) p0_transpose_item(args.in[1], D, NIN, WIN_T, 0, scr, it, F.lane);
        (void)I_SQ; (void)NITEMS;
        for (int it = gw; it < 128; it += NGW) { const int mt = it >> 3;
            p0_transpose_item(args.in[mt < 8 ? 4 : 6] + (size_t)(mt & 7) * 16384, 128, 128, (bf16*)(ws + WS_WG) + (size_t)mt * 16384, 0, scr, it & 7, F.lane); }
        {
            const float* sk = args.in[18]; v4u* SKH = (v4u*)(ws + WS_SKH); v4u* SKL = (v4u*)(ws + WS_SKL);
            for (int fi = gw; fi < 512; fi += NGW) { const int ds = fi & 7, kt = (fi >> 3) & 3, hp = fi >> 5;
                const float* src = sk + ((size_t)(hp * 128 + kt * 32 + (F.lane & 31)) * 128 + 16 * ds + 8 * (F.lane >> 5));
                bf16x8 h8, l8; split8(*(const f32x4*)src, *(const f32x4*)(src + 4), h8, l8);
                SKH[fi * 64 + F.lane] = __builtin_bit_cast(v4u, h8); SKL[fi * 64 + F.lane] = __builtin_bit_cast(v4u, l8); }
        }
        } else {
        {
            f32x4 xv_[8];
            { const GAS f32x4* xr = (const GAS f32x4*)(x + (size_t)(gw < M ? gw : M - 1) * D) + F.lane;
#pragma unroll
              for (int j = 0; j < 8; ++j) xv_[j] = __builtin_nontemporal_load(xr + 64 * j); }
            for (int m = gw; m < M; m += NGW) {
                f32x4 xc_[8];
#pragma unroll
                for (int j = 0; j < 8; ++j) xc_[j] = xv_[j];
                { const int mn = m + NGW < M ? m + NGW : m; const GAS f32x4* xr = (const GAS f32x4*)(x + (size_t)mn * D) + F.lane;
#pragma unroll
                  for (int j = 0; j < 8; ++j) xv_[j] = __builtin_nontemporal_load(xr + 64 * j); }
                GAS unsigned long long* o8 = (GAS unsigned long long*)(XB + (size_t)m * D) + F.lane;
#pragma unroll
                for (int j = 0; j < 8; ++j) { const f32x4 v = xc_[j]; o8[64 * j] = (unsigned long long)pk2(v.x, v.y) | ((unsigned long long)pk2(v.z, v.w) << 32); }
            }
        }
        }
        }
    }
    GRID_BAR();
    if (RUN(1)) {
        pg8::Gemm g{XB, WIN_T, M, NIN, D}; pg8::StaticOrder S; S.init(M, NIN, F.G, (int)blockIdx.x);
        pg8::EpiBf16<0> E{QB, AW, nullptr, AW, (size_t)(WS_K - WS_Q) / 2, C2};
        pg8::gemm_phase<pg8::EpiBf16<0>, pg8::StaticOrder, PG8_ALIGN, PG8_SP2>(F.lds + RING_OFF, g, S, E);
    }
    GRID_BAR();
    if (RUN(2)) {
        const bool fusedconv = (F.G == 256);
#pragma unroll 1
        for (int step = 0; step < 2; ++step) {
            if (fusedconv ? (step == 0) : (((step ^ F.vcu) & 1) == 0)) {
#pragma unroll 1
                for (int jb_ = 0; jb_ < 2; ++jb_) {
                if (((jb_ ^ F.vcu) & 1) == 0) {
                if (fusedconv) lru_phase<1, false>(F, ws, args.in[2], args.in[3], args.in[5], args.in[7], args.in[8]);
                else lru_phase<1, false>(F, ws, args.in[2], args.in[3], args.in[5], args.in[7], args.in[8]);
                } else {
                    const int gw = F.vcu * NWAVES + F.wave, NGW = F.G * NWAVES, lane = F.lane; unsigned* ctlw = (unsigned*)(ws + WS_CTL);
                    for (int it = gw; it < 2 * (M / 16); it += NGW) { const int z = it & 1, r16 = it >> 1; const bf16* src = (const bf16*)(ws + (z ? WS_K : WS_Q)) + (size_t)r16 * 16 * AW + 8 * lane;
                        float mx0 = 0.f, mx1 = 0.f;
#pragma unroll
                        for (int r = 0; r < 16; ++r) {
#pragma unroll
                            for (int hf = 0; hf < 2; ++hf) { const v4u q = *(const v4u*)(src + (size_t)r * AW + hf * 512); float ss = 0.f;
#pragma unroll
                                for (int e = 0; e < 4; ++e) { const float lo = __uint_as_float(q[e] << 16), hi = __uint_as_float(q[e] & 0xffff0000u); ss += lo * lo + hi * hi; }
                                ss += __builtin_bit_cast(float, __builtin_amdgcn_update_dpp(0, __builtin_bit_cast(int, ss), 0xB1, 0xf, 0xf, true)); ss += __builtin_bit_cast(float, __builtin_amdgcn_update_dpp(0, __builtin_bit_cast(int, ss), 0x4E, 0xf, 0xf, true));
                                ss += __builtin_bit_cast(float, __builtin_amdgcn_update_dpp(0, __builtin_bit_cast(int, ss), 0x141, 0xf, 0xf, true));
                                if (hf == 0) mx0 = fmaxf(mx0, ss); else mx1 = fmaxf(mx1, ss); } }
                        if ((lane & 7) == 0) { unsigned* dst = ctlw + (z ? CW_NK : CW_NQ) + (r16 >> 2) * 16 + (lane >> 3); atomicMax(dst, __float_as_uint(mx0)); atomicMax(dst + 8, __float_as_uint(mx1)); }
                    }
                }
                }
            } else if (!fusedconv) {
                for (int item = F.vcu; item < 512; item += F.G) {
                    if (item < 256) {
                        const float* us = args.in[19]; float* SU = (float*)(ws + WS_SU);
                        f32x4 uv[8];
                        { const f32x4* ur = (const f32x4*)(us + (size_t)(item * 64 + F.wave) * D);
#pragma unroll
                          for (int j = 0; j < 8; ++j) uv[j] = ur[F.lane + 64 * j]; }
                        for (int e = item * 64 + F.wave; e < item * 64 + 64; e += NWAVES) {
                            f32x4 un[8]; { const int en = e + NWAVES < item * 64 + 64 ? e + NWAVES : e; const f32x4* ur = (const f32x4*)(us + (size_t)en * D);
#pragma unroll
                              for (int j = 0; j < 8; ++j) un[j] = ur[F.lane + 64 * j]; }
                            float am = 0.f;
#pragma unroll
                            for (int j = 0; j < 8; ++j) am = fmaxf(fmaxf(am, fmaxf(fabsf(uv[j].x), fabsf(uv[j].y))), fmaxf(fabsf(uv[j].z), fabsf(uv[j].w)));
#pragma unroll
                            for (int o = 1; o < 64; o <<= 1) am = fmaxf(am, __shfl_xor(am, o));
                            const float qs = am > 0.f ? 127.f / am : 0.f;
                            if (F.lane == 0) SU[e] = am * (1.f / 127.f);
#pragma unroll
                            for (int j = 0; j < 8; ++j) { const int c = (F.lane + 64 * j) * 4;
                                const unsigned q = ((unsigned)(int)rintf(uv[j].x * qs) & 0xffu) | (((unsigned)(int)rintf(uv[j].y * qs) & 0xffu) << 8) | (((unsigned)(int)rintf(uv[j].z * qs) & 0xffu) << 16) | (((unsigned)(int)rintf(uv[j].w * qs) & 0xffu) << 24);
                                *(unsigned*)(ws + WS_U8 + ((size_t)(c >> 7) * 16384 + e) * 128 + (c & 127)) = q; }
#pragma unroll
                            for (int j = 0; j < 8; ++j) uv[j] = un[j];
                        }
                    } else {
                        const float* vs = args.in[20]; unsigned char* V8 = ws + WS_V8; LAS unsigned char* tl = F.lds + RING_OFF;
                        f32x4 vv[8];
                        { const int t = (item - 256) * 8, e0 = (t >> 3) * 64, c0 = (t & 7) * 256;
#pragma unroll
                          for (int j = 0; j < 8; ++j) { const int idx = F.tid + 512 * j, r = idx >> 6, c = 4 * (idx & 63); vv[j] = *(const f32x4*)(vs + (size_t)(e0 + r) * D + c0 + c); } }
                        for (int t = (item - 256) * 8; t < (item - 256) * 8 + 8; ++t) { const int e0 = (t >> 3) * 64, c0 = (t & 7) * 256;
                            f32x4 vn[8]; { const int tn = t + 1 < (item - 256) * 8 + 8 ? t + 1 : t, e1 = (tn >> 3) * 64, c1 = (tn & 7) * 256;
#pragma unroll
                              for (int j = 0; j < 8; ++j) { const int idx = F.tid + 512 * j, r = idx >> 6, c = 4 * (idx & 63); vn[j] = *(const f32x4*)(vs + (size_t)(e1 + r) * D + c1 + c); } }
                            __syncthreads();
#pragma unroll
                            for (int j = 0; j < 8; ++j) { const int idx = F.tid + 512 * j, r = idx >> 6, c = 4 * (idx & 63);
                                *(LAS unsigned*)(tl + (c >> 3) * 512 + r * 8 + (c & 7)) = pk4_fp8(vv[j].x, vv[j].y, vv[j].z, vv[j].w); }
                            __syncthreads();
#pragma unroll
                            for (int j = 0; j < 2; ++j) { const int cu = (F.tid >> 5) + 16 * j, pc = F.tid & 31;
                                *(v4u*)(V8 + ((size_t)((c0 >> 3) + cu) * 16384 + e0) * 8 + pc * 16) = *(const LAS v4u*)(tl + cu * 512 + pc * 16); }
#pragma unroll
                            for (int j = 0; j < 8; ++j) vv[j] = vn[j];
                        }
                    }
                }
                __syncthreads();
            }
        }
    }
    GRID_BAR();
    if (RUN(4)) {
        static_assert(datt::LDS_BYTES <= RING_BYTES, "attention LDS vs ring");
        const datt::Tensors DT{(const datt::bf16*)QB, (const datt::bf16*)(ws + WS_K), (const datt::bf16*)(ws + WS_V), (datt::bf16*)(ws + WS_O0), (datt::bf16*)(ws + WS_O1),
                               (const unsigned*)(ws + WS_CTL) + CW_NQ, (const unsigned*)(ws + WS_CTL) + CW_NK, (unsigned*)(ws + WS_CTL) + CW_AQ, datt_order};
        datt::datt_phase((char*)lds + RING_OFF, (volatile LAS unsigned*)(F.lds + MISC_OFF) + 16, DT);
    }
    if (RUN(5)) { if (F.G == 256) lru_phase<2, true>(F, ws, args.in[2], args.in[3], args.in[5], args.in[7], args.in[8], args.in[19], args.in[20]);
        else lru_phase<2, false>(F, ws, args.in[2], args.in[3], args.in[5], args.in[7], args.in[8]); }
    GRID_BAR();
    if (RUN(6)) {
        const int gw = F.vcu * NWAVES + F.wave, NGW = F.G * NWAVES, sub = F.lane >> 4, l16 = F.lane & 15;
        const float lam = ((const float*)(ws + WS_PRM))[0];
        const bf16* O0 = (const bf16*)(ws + WS_O0); const bf16* O1 = (const bf16*)(ws + WS_O1);
        float gs[8];
#pragma unroll
        for (int e = 0; e < 8; ++e) gs[e] = args.in[13][l16 * 8 + e] * 0.8f;
        LAS float* scr6 = (LAS float*)(F.lds + RING_OFF + F.wave * 16384);
#pragma unroll 1
        for (int st_ = 0; st_ < 2; ++st_) {
        if (((st_ ^ F.wave) & 1) != 0) { for (int it = gw; it < (D / 64) * (D / 32); it += NGW) p0_transpose_item(args.in[14], D, D, WOUT_T, 0, scr6, it, F.lane); }
        else {
        for (int it = gw; it < M * 2; it += NGW) { const int item = it * 4 + sub, tok = item >> 3, h = item & 7;
            const v4u a = __builtin_nontemporal_load((const v4u*)(O0 + (size_t)tok * AW + h * 128 + l16 * 8)), b = __builtin_nontemporal_load((const v4u*)(O1 + (size_t)tok * AW + h * 128 + l16 * 8));
            float d[8]; float ss = 0.f;
#pragma unroll
            for (int e = 0; e < 4; ++e) { d[2 * e] = __uint_as_float(a[e] << 16) - lam * __uint_as_float(b[e] << 16); d[2 * e + 1] = __uint_as_float(a[e] & 0xffff0000u) - lam * __uint_as_float(b[e] & 0xffff0000u); ss += d[2 * e] * d[2 * e] + d[2 * e + 1] * d[2 * e + 1]; }
            ss += __builtin_bit_cast(float, __builtin_amdgcn_update_dpp(0, __builtin_bit_cast(int, ss), 0xB1, 0xf, 0xf, true)); ss += __builtin_bit_cast(float, __builtin_amdgcn_update_dpp(0, __builtin_bit_cast(int, ss), 0x4E, 0xf, 0xf, true));
            ss += __builtin_bit_cast(float, __builtin_amdgcn_update_dpp(0, __builtin_bit_cast(int, ss), 0x141, 0xf, 0xf, true)); ss += __builtin_bit_cast(float, __builtin_amdgcn_update_dpp(0, __builtin_bit_cast(int, ss), 0x140, 0xf, 0xf, true));
            const float r = rsqrtf(ss * (1.f / 128.f) + LN_EPS);
            *(v4u*)(MIX + (size_t)tok * D + h * 128 + l16 * 8) = (v4u){pk2(d[0] * r * gs[0], d[1] * r * gs[1]), pk2(d[2] * r * gs[2], d[3] * r * gs[3]), pk2(d[4] * r * gs[4], d[5] * r * gs[5]), pk2(d[6] * r * gs[6], d[7] * r * gs[7])}; }
        }
        }
    }
    GRID_BAR();
    if (RUN(7)) {
        pg8::Gemm g{MIX, WOUT_T, M, D, D}; pg8::StaticOrder S; S.init(M, D, F.G, (int)blockIdx.x);
        pg8::EpiBf16<0> E{(bf16*)Y1, D, nullptr, 0, 0, 1.f};
        pg8::gemm_phase<pg8::EpiBf16<0>, pg8::StaticOrder, PG8_ALIGN, PG8_SP2>(F.lds + RING_OFF, g, S, E);
    }
    GRID_BAR();
    if (RUN(8)) {
        const int gw = F.vcu * NWAVES + F.wave, NGW = F.G * NWAVES; const float* g = args.in[15]; const float* bb = args.in[16];
        LAS float* scr8 = (LAS float*)(F.lds + RING_OFF + F.wave * 16384);
#pragma unroll 1
        for (int st_ = 0; st_ < 2; ++st_) {
        if (((st_ ^ F.wave) & 1) != 0) { for (int it = gw; it < (D / 64) * (D / 32); it += NGW) p0_transpose_item(args.in[17], D, D, WQ_T, 0, scr8, it, F.lane); }
        else {
        unsigned long long xq[8], yq[8];
        { int l_ = F.lane; asm volatile("" : "+v"(l_)); const int r0 = gw < M ? gw : M - 1; const unsigned long long* xr_ = (const unsigned long long*)(XB + (size_t)r0 * D) + l_; const unsigned long long* yb = (const unsigned long long*)((const bf16*)Y1 + (size_t)r0 * D) + l_;
#pragma unroll
          for (int j = 0; j < 8; ++j) { xq[j] = __builtin_nontemporal_load(xr_ + 64 * j); yq[j] = __builtin_nontemporal_load(yb + 64 * j); } }
        for (int row = gw; row < M; row += NGW) {
            f32x4 v[8]; float s = 0.f;
#pragma unroll
            for (int j = 0; j < 8; ++j) { const unsigned long long x_ = xq[j]; const unsigned x0 = (unsigned)x_, x1 = (unsigned)(x_ >> 32); const f32x4 xv_ = (f32x4){__uint_as_float(x0 << 16), __uint_as_float(x0 & 0xffff0000u), __uint_as_float(x1 << 16), __uint_as_float(x1 & 0xffff0000u)};
                const unsigned long long q_ = yq[j]; const unsigned q0 = (unsigned)q_, q1 = (unsigned)(q_ >> 32);
                v[j].x = DN_ALPHA * xv_.x + __uint_as_float(q0 << 16); v[j].y = DN_ALPHA * xv_.y + __uint_as_float(q0 & 0xffff0000u); v[j].z = DN_ALPHA * xv_.z + __uint_as_float(q1 << 16); v[j].w = DN_ALPHA * xv_.w + __uint_as_float(q1 & 0xffff0000u);
                s += (v[j].x + v[j].y) + (v[j].z + v[j].w); }
            { int l_ = F.lane; asm volatile("" : "+v"(l_)); const int rn = row + NGW < M ? row + NGW : row; const unsigned long long* xr_ = (const unsigned long long*)(XB + (size_t)rn * D) + l_; const unsigned long long* yb = (const unsigned long long*)((const bf16*)Y1 + (size_t)rn * D) + l_;
#pragma unroll
              for (int j = 0; j < 8; ++j) { xq[j] = __builtin_nontemporal_load(xr_ + 64 * j); yq[j] = __builtin_nontemporal_load(yb + 64 * j); } }
            s = wave_sum(s);
            const float mean = s * (1.f / D); float s2 = 0.f;
#pragma unroll
            for (int j = 0; j < 8; ++j) { v[j] = v[j] - mean; s2 += (v[j].x * v[j].x + v[j].y * v[j].y) + (v[j].z * v[j].z + v[j].w * v[j].w); }
            s2 = wave_sum(s2);
            const float rstd = rsqrtf(s2 * (1.f / D) + LN_EPS);
#pragma unroll
            for (int j = 0; j < 8; ++j) { const int c = (F.lane + 64 * j) * 4; const f32x4 gg = *(const f32x4*)(g + c), bv = *(const f32x4*)(bb + c);
                const f32x4 o = v[j] * rstd * gg + bv;
                *(unsigned long long*)(H1 + (size_t)row * D + c) = (unsigned long long)pk2(o.x, o.y) | ((unsigned long long)pk2(o.z, o.w) << 32);
                v[j] = o; }
            float am = 0.f;
#pragma unroll
            for (int j = 0; j < 8; ++j) am = fmaxf(fmaxf(am, fmaxf(fabsf(v[j].x), fabsf(v[j].y))), fmaxf(fabsf(v[j].z), fabsf(v[j].w)));
            am = wave_max_nonneg(am);
            const float qs = am > 0.f ? 127.f / am : 0.f;
            if (F.lane == 0) ((float*)(ws + WS_SH))[row] = am * (1.f / 127.f);
#pragma unroll
            for (int j = 0; j < 8; ++j) { const int c = (F.lane + 64 * j) * 4;
                const unsigned q = ((unsigned)(int)rintf(v[j].x * qs) & 0xffu) | (((unsigned)(int)rintf(v[j].y * qs) & 0xffu) << 8) | (((unsigned)(int)rintf(v[j].z * qs) & 0xffu) << 16) | (((unsigned)(int)rintf(v[j].w * qs) & 0xffu) << 24);
                *(unsigned*)(ws + WS_H8 + ((size_t)(c >> 7) * M + row) * 128 + (c & 127)) = q; }
        }
        }
        }
    }
    GRID_BAR();
    if (RUN(9)) {
        pg8::Gemm g{H1, WQ_T, M, D, D}; pg8::StaticOrder S; S.init(M, D, F.G, (int)blockIdx.x);
        pg8::EpiBf16<0> E{(bf16*)PQ, D, nullptr, 0, 0, 1.f};
        pg8::gemm_phase<pg8::EpiBf16<0>, pg8::StaticOrder, PG8_ALIGN, PG8_SP2>(F.lds + RING_OFF, g, S, E);
    }
    GRID_BAR();
    if (RUN(10)) {
        const int nh = (F.G & 7) == 0 ? 8 : 1;
        int* E = (int*)(ws + WS_E); float* G = (float*)(ws + WS_G);
        for (int h = F.vcu % nh; h < 8; h += nh) {
            __syncthreads();
            {
                int tq = F.tid; asm volatile("" : "+v"(tq));
#pragma unroll 4
                for (int j = 0; j < 16; ++j) { const int i = tq + 512 * j, p = i >> 12, hl = (i >> 11) & 1, fl = i & 2047;
                    *(LAS v4u*)(F.lds + RING_OFF + (size_t)i * 16) = ((const v4u*)(ws + WS_SKH))[(size_t)hl * 65536 + (size_t)(h * 2 + p) * 2048 + fl]; }
            }
            __syncthreads();
#pragma unroll 1
            for (int st_ = 0; st_ < 2; ++st_) {
            if (((st_ ^ (F.wave >> 2)) & 1) == 0) {
            const int wv = (F.vcu / nh) * NWAVES + F.wave, nwv = ((F.G + nh - 1 - F.vcu % nh) / nh) * NWAVES;
            v4u qn[8];
#define ROUTE_LOADQ() do { _Pragma("unroll") for (int ds = 0; ds < 8; ++ds) qn[ds] = *(const v4u*)(qptr + 16 * ds); } while (0)
            const bf16* qptr = (const bf16*)PQ + (size_t)(wv * 32 + (F.lane & 31)) * D + h * 256 + 8 * (F.lane >> 5);
            if (wv < M / 32) ROUTE_LOADQ();
            for (int tg = wv; tg < M / 32; tg += nwv) { int ln_ = F.lane; asm volatile("" : "+v"(ln_));
                const int tl = ln_ & 31, hi = ln_ >> 5, tok = tg * 32 + tl;
                LAS unsigned char* scr = F.lds + RING_BYTES + 1024 + F.wave * 1024 + tl * 32;
                float sa[16], sb[16];
#pragma unroll
                for (int p = 0; p < 2; ++p) {
                    f32x16 sc[4];
#pragma unroll
                    for (int kt = 0; kt < 4; ++kt) sc[kt] = f32x16{};
#pragma unroll
                    for (int ds = 0; ds < 8; ++ds) { const bf16x8 qh = __builtin_bit_cast(bf16x8, qn[ds]);
#pragma unroll
                        for (int kt = 0; kt < 4; ++kt) { const bf16x8 ah = *(const LAS bf16x8*)(F.lds + RING_OFF + ((p * 2 + 0) * 32 + kt * 8 + ds) * 1024 + F.lane * 16), al = *(const LAS bf16x8*)(F.lds + RING_OFF + ((p * 2 + 1) * 32 + kt * 8 + ds) * 1024 + F.lane * 16);
                            sc[kt] = __builtin_amdgcn_mfma_f32_32x32x16_bf16(ah, qh, sc[kt], 0, 0, 0);
                            sc[kt] = __builtin_amdgcn_mfma_f32_32x32x16_bf16(al, qh, sc[kt], 0, 0, 0); } }
                    if (p == 0) { qptr += 128; ROUTE_LOADQ(); } else if (tg + nwv < M / 32) { qptr += (size_t)nwv * 32 * D - 128; ROUTE_LOADQ(); }
#pragma unroll
                    for (int kt = 0; kt < 4; ++kt)
#pragma unroll
                        for (int r = 0; r < 16; ++r) { const unsigned key = (unsigned)(kt * 32 + (r & 3) + 8 * (r >> 2) + 4 * hi); sc[kt][r] = __uint_as_float((__float_as_uint(sc[kt][r]) & ~127u) | (127u - key)); }
#define CE_(x, y) do { const float h_ = __builtin_fmaxf(x, y), l_ = __builtin_fminf(x, y); x = h_; y = l_; } while (0)
                    CE_(sc[0][0], sc[0][1]); CE_(sc[0][2], sc[0][3]); CE_(sc[0][0], sc[0][2]); CE_(sc[0][1], sc[0][3]); CE_(sc[0][1], sc[0][2]); CE_(sc[0][4], sc[0][5]); CE_(sc[0][6], sc[0][7]); CE_(sc[0][4], sc[0][6]); CE_(sc[0][5], sc[0][7]); CE_(sc[0][5], sc[0][6]); CE_(sc[0][0], sc[0][4]); CE_(sc[0][2], sc[0][6]); CE_(sc[0][2], sc[0][4]); CE_(sc[0][1], sc[0][5]); CE_(sc[0][3], sc[0][7]); CE_(sc[0][3], sc[0][5]); CE_(sc[0][1], sc[0][2]); CE_(sc[0][3], sc[0][4]); CE_(sc[0][5], sc[0][6]); CE_(sc[0][8], sc[0][9]); CE_(sc[0][10], sc[0][11]); CE_(sc[0][8], sc[0][10]); CE_(sc[0][9], sc[0][11]); CE_(sc[0][9], sc[0][10]); CE_(sc[0][12], sc[0][13]); CE_(sc[0][14], sc[0][15]); CE_(sc[0][12], sc[0][14]); CE_(sc[0][13], sc[0][15]); CE_(sc[0][13], sc[0][14]); CE_(sc[0][8], sc[0][12]); CE_(sc[0][10], sc[0][14]); CE_(sc[0][10], sc[0][12]); CE_(sc[0][9], sc[0][13]); CE_(sc[0][11], sc[0][15]); CE_(sc[0][11], sc[0][13]); CE_(sc[0][9], sc[0][10]); CE_(sc[0][11], sc[0][12]); CE_(sc[0][13], sc[0][14]); CE_(sc[0][0], sc[0][8]); CE_(sc[0][4], sc[0][12]); CE_(sc[0][4], sc[0][8]); CE_(sc[0][2], sc[0][10]); CE_(sc[0][6], sc[0][14]); CE_(sc[0][6], sc[0][10]); CE_(sc[0][2], sc[0][4]); CE_(sc[0][6], sc[0][8]); CE_(sc[0][10], sc[0][12]); CE_(sc[0][1], sc[0][9]); CE_(sc[0][5], sc[0][13]); CE_(sc[0][5], sc[0][9]); CE_(sc[0][3], sc[0][11]); CE_(sc[0][7], sc[0][15]); CE_(sc[0][7], sc[0][11]); CE_(sc[0][3], sc[0][5]); CE_(sc[0][7], sc[0][9]); CE_(sc[0][11], sc[0][13]); CE_(sc[0][1], sc[0][2]); CE_(sc[0][3], sc[0][4]); CE_(sc[0][5], sc[0][6]); CE_(sc[0][7], sc[0][8]); CE_(sc[0][9], sc[0][10]); CE_(sc[0][11], sc[0][12]); CE_(sc[0][13], sc[0][14]);
                    CE_(sc[1][0], sc[1][1]); CE_(sc[1][2], sc[1][3]); CE_(sc[1][0], sc[1][2]); CE_(sc[1][1], sc[1][3]); CE_(sc[1][1], sc[1][2]); CE_(sc[1][4], sc[1][5]); CE_(sc[1][6], sc[1][7]); CE_(sc[1][4], sc[1][6]); CE_(sc[1][5], sc[1][7]); CE_(sc[1][5], sc[1][6]); CE_(sc[1][0], sc[1][4]); CE_(sc[1][2], sc[1][6]); CE_(sc[1][2], sc[1][4]); CE_(sc[1][1], sc[1][5]); CE_(sc[1][3], sc[1][7]); CE_(sc[1][3], sc[1][5]); CE_(sc[1][1], sc[1][2]); CE_(sc[1][3], sc[1][4]); CE_(sc[1][5], sc[1][6]); CE_(sc[1][8], sc[1][9]); CE_(sc[1][10], sc[1][11]); CE_(sc[1][8], sc[1][10]); CE_(sc[1][9], sc[1][11]); CE_(sc[1][9], sc[1][10]); CE_(sc[1][12], sc[1][13]); CE_(sc[1][14], sc[1][15]); CE_(sc[1][12], sc[1][14]); CE_(sc[1][13], sc[1][15]); CE_(sc[1][13], sc[1][14]); CE_(sc[1][8], sc[1][12]); CE_(sc[1][10], sc[1][14]); CE_(sc[1][10], sc[1][12]); CE_(sc[1][9], sc[1][13]); CE_(sc[1][11], sc[1][15]); CE_(sc[1][11], sc[1][13]); CE_(sc[1][9], sc[1][10]); CE_(sc[1][11], sc[1][12]); CE_(sc[1][13], sc[1][14]); CE_(sc[1][0], sc[1][8]); CE_(sc[1][4], sc[1][12]); CE_(sc[1][4], sc[1][8]); CE_(sc[1][2], sc[1][10]); CE_(sc[1][6], sc[1][14]); CE_(sc[1][6], sc[1][10]); CE_(sc[1][2], sc[1][4]); CE_(sc[1][6], sc[1][8]); CE_(sc[1][10], sc[1][12]); CE_(sc[1][1], sc[1][9]); CE_(sc[1][5], sc[1][13]); CE_(sc[1][5], sc[1][9]); CE_(sc[1][3], sc[1][11]); CE_(sc[1][7], sc[1][15]); CE_(sc[1][7], sc[1][11]); CE_(sc[1][3], sc[1][5]); CE_(sc[1][7], sc[1][9]); CE_(sc[1][11], sc[1][13]); CE_(sc[1][1], sc[1][2]); CE_(sc[1][3], sc[1][4]); CE_(sc[1][5], sc[1][6]); CE_(sc[1][7], sc[1][8]); CE_(sc[1][9], sc[1][10]); CE_(sc[1][11], sc[1][12]); CE_(sc[1][13], sc[1][14]);
                    CE_(sc[2][0], sc[2][1]); CE_(sc[2][2], sc[2][3]); CE_(sc[2][0], sc[2][2]); CE_(sc[2][1], sc[2][3]); CE_(sc[2][1], sc[2][2]); CE_(sc[2][4], sc[2][5]); CE_(sc[2][6], sc[2][7]); CE_(sc[2][4], sc[2][6]); CE_(sc[2][5], sc[2][7]); CE_(sc[2][5], sc[2][6]); CE_(sc[2][0], sc[2][4]); CE_(sc[2][2], sc[2][6]); CE_(sc[2][2], sc[2][4]); CE_(sc[2][1], sc[2][5]); CE_(sc[2][3], sc[2][7]); CE_(sc[2][3], sc[2][5]); CE_(sc[2][1], sc[2][2]); CE_(sc[2][3], sc[2][4]); CE_(sc[2][5], sc[2][6]); CE_(sc[2][8], sc[2][9]); CE_(sc[2][10], sc[2][11]); CE_(sc[2][8], sc[2][10]); CE_(sc[2][9], sc[2][11]); CE_(sc[2][9], sc[2][10]); CE_(sc[2][12], sc[2][13]); CE_(sc[2][14], sc[2][15]); CE_(sc[2][12], sc[2][14]); CE_(sc[2][13], sc[2][15]); CE_(sc[2][13], sc[2][14]); CE_(sc[2][8], sc[2][12]); CE_(sc[2][10], sc[2][14]); CE_(sc[2][10], sc[2][12]); CE_(sc[2][9], sc[2][13]); CE_(sc[2][11], sc[2][15]); CE_(sc[2][11], sc[2][13]); CE_(sc[2][9], sc[2][10]); CE_(sc[2][11], sc[2][12]); CE_(sc[2][13], sc[2][14]); CE_(sc[2][0], sc[2][8]); CE_(sc[2][4], sc[2][12]); CE_(sc[2][4], sc[2][8]); CE_(sc[2][2], sc[2][10]); CE_(sc[2][6], sc[2][14]); CE_(sc[2][6], sc[2][10]); CE_(sc[2][2], sc[2][4]); CE_(sc[2][6], sc[2][8]); CE_(sc[2][10], sc[2][12]); CE_(sc[2][1], sc[2][9]); CE_(sc[2][5], sc[2][13]); CE_(sc[2][5], sc[2][9]); CE_(sc[2][3], sc[2][11]); CE_(sc[2][7], sc[2][15]); CE_(sc[2][7], sc[2][11]); CE_(sc[2][3], sc[2][5]); CE_(sc[2][7], sc[2][9]); CE_(sc[2][11], sc[2][13]); CE_(sc[2][1], sc[2][2]); CE_(sc[2][3], sc[2][4]); CE_(sc[2][5], sc[2][6]); CE_(sc[2][7], sc[2][8]); CE_(sc[2][9], sc[2][10]); CE_(sc[2][11], sc[2][12]); CE_(sc[2][13], sc[2][14]);
                    CE_(sc[3][0], sc[3][1]); CE_(sc[3][2], sc[3][3]); CE_(sc[3][0], sc[3][2]); CE_(sc[3][1], sc[3][3]); CE_(sc[3][1], sc[3][2]); CE_(sc[3][4], sc[3][5]); CE_(sc[3][6], sc[3][7]); CE_(sc[3][4], sc[3][6]); CE_(sc[3][5], sc[3][7]); CE_(sc[3][5], sc[3][6]); CE_(sc[3][0], sc[3][4]); CE_(sc[3][2], sc[3][6]); CE_(sc[3][2], sc[3][4]); CE_(sc[3][1], sc[3][5]); CE_(sc[3][3], sc[3][7]); CE_(sc[3][3], sc[3][5]); CE_(sc[3][1], sc[3][2]); CE_(sc[3][3], sc[3][4]); CE_(sc[3][5], sc[3][6]); CE_(sc[3][8], sc[3][9]); CE_(sc[3][10], sc[3][11]); CE_(sc[3][8], sc[3][10]); CE_(sc[3][9], sc[3][11]); CE_(sc[3][9], sc[3][10]); CE_(sc[3][12], sc[3][13]); CE_(sc[3][14], sc[3][15]); CE_(sc[3][12], sc[3][14]); CE_(sc[3][13], sc[3][15]); CE_(sc[3][13], sc[3][14]); CE_(sc[3][8], sc[3][12]); CE_(sc[3][10], sc[3][14]); CE_(sc[3][10], sc[3][12]); CE_(sc[3][9], sc[3][13]); CE_(sc[3][11], sc[3][15]); CE_(sc[3][11], sc[3][13]); CE_(sc[3][9], sc[3][10]); CE_(sc[3][11], sc[3][12]); CE_(sc[3][13], sc[3][14]); CE_(sc[3][0], sc[3][8]); CE_(sc[3][4], sc[3][12]); CE_(sc[3][4], sc[3][8]); CE_(sc[3][2], sc[3][10]); CE_(sc[3][6], sc[3][14]); CE_(sc[3][6], sc[3][10]); CE_(sc[3][2], sc[3][4]); CE_(sc[3][6], sc[3][8]); CE_(sc[3][10], sc[3][12]); CE_(sc[3][1], sc[3][9]); CE_(sc[3][5], sc[3][13]); CE_(sc[3][5], sc[3][9]); CE_(sc[3][3], sc[3][11]); CE_(sc[3][7], sc[3][15]); CE_(sc[3][7], sc[3][11]); CE_(sc[3][3], sc[3][5]); CE_(sc[3][7], sc[3][9]); CE_(sc[3][11], sc[3][13]); CE_(sc[3][1], sc[3][2]); CE_(sc[3][3], sc[3][4]); CE_(sc[3][5], sc[3][6]); CE_(sc[3][7], sc[3][8]); CE_(sc[3][9], sc[3][10]); CE_(sc[3][11], sc[3][12]); CE_(sc[3][13], sc[3][14]);
                    sc[0][0] = __builtin_fmaxf(sc[0][0], sc[1][15]); sc[0][1] = __builtin_fmaxf(sc[0][1], sc[1][14]); sc[0][2] = __builtin_fmaxf(sc[0][2], sc[1][13]); sc[0][3] = __builtin_fmaxf(sc[0][3], sc[1][12]); sc[0][4] = __builtin_fmaxf(sc[0][4], sc[1][11]); sc[0][5] = __builtin_fmaxf(sc[0][5], sc[1][10]); sc[0][6] = __builtin_fmaxf(sc[0][6], sc[1][9]); sc[0][7] = __builtin_fmaxf(sc[0][7], sc[1][8]); sc[0][8] = __builtin_fmaxf(sc[0][8], sc[1][7]); sc[0][9] = __builtin_fmaxf(sc[0][9], sc[1][6]); sc[0][10] = __builtin_fmaxf(sc[0][10], sc[1][5]); sc[0][11] = __builtin_fmaxf(sc[0][11], sc[1][4]); sc[0][12] = __builtin_fmaxf(sc[0][12], sc[1][3]); sc[0][13] = __builtin_fmaxf(sc[0][13], sc[1][2]); sc[0][14] = __builtin_fmaxf(sc[0][14], sc[1][1]); sc[0][15] = __builtin_fmaxf(sc[0][15], sc[1][0]);
                    CE_(sc[0][0], sc[0][8]); CE_(sc[0][1], sc[0][9]); CE_(sc[0][2], sc[0][10]); CE_(sc[0][3], sc[0][11]); CE_(sc[0][4], sc[0][12]); CE_(sc[0][5], sc[0][13]); CE_(sc[0][6], sc[0][14]); CE_(sc[0][7], sc[0][15]); CE_(sc[0][0], sc[0][4]); CE_(sc[0][1], sc[0][5]); CE_(sc[0][2], sc[0][6]); CE_(sc[0][3], sc[0][7]); CE_(sc[0][8], sc[0][12]); CE_(sc[0][9], sc[0][13]); CE_(sc[0][10], sc[0][14]); CE_(sc[0][11], sc[0][15]); CE_(sc[0][0], sc[0][2]); CE_(sc[0][1], sc[0][3]); CE_(sc[0][4], sc[0][6]); CE_(sc[0][5], sc[0][7]); CE_(sc[0][8], sc[0][10]); CE_(sc[0][9], sc[0][11]); CE_(sc[0][12], sc[0][14]); CE_(sc[0][13], sc[0][15]); CE_(sc[0][0], sc[0][1]); CE_(sc[0][2], sc[0][3]); CE_(sc[0][4], sc[0][5]); CE_(sc[0][6], sc[0][7]); CE_(sc[0][8], sc[0][9]); CE_(sc[0][10], sc[0][11]); CE_(sc[0][12], sc[0][13]); CE_(sc[0][14], sc[0][15]);
                    sc[2][0] = __builtin_fmaxf(sc[2][0], sc[3][15]); sc[2][1] = __builtin_fmaxf(sc[2][1], sc[3][14]); sc[2][2] = __builtin_fmaxf(sc[2][2], sc[3][13]); sc[2][3] = __builtin_fmaxf(sc[2][3], sc[3][12]); sc[2][4] = __builtin_fmaxf(sc[2][4], sc[3][11]); sc[2][5] = __builtin_fmaxf(sc[2][5], sc[3][10]); sc[2][6] = __builtin_fmaxf(sc[2][6], sc[3][9]); sc[2][7] = __builtin_fmaxf(sc[2][7], sc[3][8]); sc[2][8] = __builtin_fmaxf(sc[2][8], sc[3][7]); sc[2][9] = __builtin_fmaxf(sc[2][9], sc[3][6]); sc[2][10] = __builtin_fmaxf(sc[2][10], sc[3][5]); sc[2][11] = __builtin_fmaxf(sc[2][11], sc[3][4]); sc[2][12] = __builtin_fmaxf(sc[2][12], sc[3][3]); sc[2][13] = __builtin_fmaxf(sc[2][13], sc[3][2]); sc[2][14] = __builtin_fmaxf(sc[2][14], sc[3][1]); sc[2][15] = __builtin_fmaxf(sc[2][15], sc[3][0]);
                    CE_(sc[2][0], sc[2][8]); CE_(sc[2][1], sc[2][9]); CE_(sc[2][2], sc[2][10]); CE_(sc[2][3], sc[2][11]); CE_(sc[2][4], sc[2][12]); CE_(sc[2][5], sc[2][13]); CE_(sc[2][6], sc[2][14]); CE_(sc[2][7], sc[2][15]); CE_(sc[2][0], sc[2][4]); CE_(sc[2][1], sc[2][5]); CE_(sc[2][2], sc[2][6]); CE_(sc[2][3], sc[2][7]); CE_(sc[2][8], sc[2][12]); CE_(sc[2][9], sc[2][13]); CE_(sc[2][10], sc[2][14]); CE_(sc[2][11], sc[2][15]); CE_(sc[2][0], sc[2][2]); CE_(sc[2][1], sc[2][3]); CE_(sc[2][4], sc[2][6]); CE_(sc[2][5], sc[2][7]); CE_(sc[2][8], sc[2][10]); CE_(sc[2][9], sc[2][11]); CE_(sc[2][12], sc[2][14]); CE_(sc[2][13], sc[2][15]); CE_(sc[2][0], sc[2][1]); CE_(sc[2][2], sc[2][3]); CE_(sc[2][4], sc[2][5]); CE_(sc[2][6], sc[2][7]); CE_(sc[2][8], sc[2][9]); CE_(sc[2][10], sc[2][11]); CE_(sc[2][12], sc[2][13]); CE_(sc[2][14], sc[2][15]);
                    sc[0][0] = __builtin_fmaxf(sc[0][0], sc[2][15]); sc[0][1] = __builtin_fmaxf(sc[0][1], sc[2][14]); sc[0][2] = __builtin_fmaxf(sc[0][2], sc[2][13]); sc[0][3] = __builtin_fmaxf(sc[0][3], sc[2][12]); sc[0][4] = __builtin_fmaxf(sc[0][4], sc[2][11]); sc[0][5] = __builtin_fmaxf(sc[0][5], sc[2][10]); sc[0][6] = __builtin_fmaxf(sc[0][6], sc[2][9]); sc[0][7] = __builtin_fmaxf(sc[0][7], sc[2][8]); sc[0][8] = __builtin_fmaxf(sc[0][8], sc[2][7]); sc[0][9] = __builtin_fmaxf(sc[0][9], sc[2][6]); sc[0][10] = __builtin_fmaxf(sc[0][10], sc[2][5]); sc[0][11] = __builtin_fmaxf(sc[0][11], sc[2][4]); sc[0][12] = __builtin_fmaxf(sc[0][12], sc[2][3]); sc[0][13] = __builtin_fmaxf(sc[0][13], sc[2][2]); sc[0][14] = __builtin_fmaxf(sc[0][14], sc[2][1]); sc[0][15] = __builtin_fmaxf(sc[0][15], sc[2][0]);
                    CE_(sc[0][0], sc[0][8]); CE_(sc[0][1], sc[0][9]); CE_(sc[0][2], sc[0][10]); CE_(sc[0][3], sc[0][11]); CE_(sc[0][4], sc[0][12]); CE_(sc[0][5], sc[0][13]); CE_(sc[0][6], sc[0][14]); CE_(sc[0][7], sc[0][15]); CE_(sc[0][0], sc[0][4]); CE_(sc[0][1], sc[0][5]); CE_(sc[0][2], sc[0][6]); CE_(sc[0][3], sc[0][7]); CE_(sc[0][8], sc[0][12]); CE_(sc[0][9], sc[0][13]); CE_(sc[0][10], sc[0][14]); CE_(sc[0][11], sc[0][15]); CE_(sc[0][0], sc[0][2]); CE_(sc[0][1], sc[0][3]); CE_(sc[0][4], sc[0][6]); CE_(sc[0][5], sc[0][7]); CE_(sc[0][8], sc[0][10]); CE_(sc[0][9], sc[0][11]); CE_(sc[0][12], sc[0][14]); CE_(sc[0][13], sc[0][15]); CE_(sc[0][0], sc[0][1]); CE_(sc[0][2], sc[0][3]); CE_(sc[0][4], sc[0][5]); CE_(sc[0][6], sc[0][7]); CE_(sc[0][8], sc[0][9]); CE_(sc[0][10], sc[0][11]); CE_(sc[0][12], sc[0][13]); CE_(sc[0][14], sc[0][15]);
                    { float la[16], lb[16];
#pragma unroll
                      for (int i = 0; i < 16; ++i) { auto rr = __builtin_amdgcn_permlane32_swap(__float_as_uint(sc[0][i]), __float_as_uint(sc[0][i]), false, false); la[i] = __uint_as_float(rr[0]); lb[i] = __uint_as_float(rr[1]); }
#pragma unroll
                      for (int i = 0; i < 16; ++i) la[i] = __builtin_fmaxf(la[i], lb[15 - i]);
                      CE_(la[0], la[8]); CE_(la[1], la[9]); CE_(la[2], la[10]); CE_(la[3], la[11]); CE_(la[4], la[12]); CE_(la[5], la[13]); CE_(la[6], la[14]); CE_(la[7], la[15]); CE_(la[0], la[4]); CE_(la[1], la[5]); CE_(la[2], la[6]); CE_(la[3], la[7]); CE_(la[8], la[12]); CE_(la[9], la[13]); CE_(la[10], la[14]); CE_(la[11], la[15]); CE_(la[0], la[2]); CE_(la[1], la[3]); CE_(la[4], la[6]); CE_(la[5], la[7]); CE_(la[8], la[10]); CE_(la[9], la[11]); CE_(la[12], la[14]); CE_(la[13], la[15]); CE_(la[0], la[1]); CE_(la[2], la[3]); CE_(la[4], la[5]); CE_(la[6], la[7]); CE_(la[8], la[9]); CE_(la[10], la[11]); CE_(la[12], la[13]); CE_(la[14], la[15]);
#pragma unroll
                      for (int i = 0; i < 16; ++i) { if (p == 0) sa[i] = la[i]; else sb[i] = la[i]; } }
#undef CE_
                }
                { unsigned w[4];
    #pragma unroll
                  for (int q = 0; q < 4; ++q) { w[q] = 0u;
    #pragma unroll
                      for (int e = 0; e < 4; ++e) { const unsigned ka = 127u - (__float_as_uint(sa[4 * q + e]) & 127u), kb = 127u - (__float_as_uint(sb[4 * q + e]) & 127u); w[q] |= (hi ? kb : ka) << (8 * e); } }
                  *(LAS v4u*)(scr + 16 * hi) = (v4u){w[0], w[1], w[2], w[3]}; }
                float cd[25];
    #define CV_(i, j) __uint_as_float((__float_as_uint(sa[i] + sb[j]) & ~255u) | (255u - (unsigned)(16 * (i) + (j))))
                cd[0] = hi ? CV_(0, 1) : CV_(0, 0);
                cd[1] = hi ? CV_(0, 3) : CV_(0, 2);
                cd[2] = hi ? CV_(0, 5) : CV_(0, 4);
                cd[3] = hi ? CV_(0, 7) : CV_(0, 6);
                cd[4] = hi ? CV_(0, 9) : CV_(0, 8);
                cd[5] = hi ? CV_(0, 11) : CV_(0, 10);
                cd[6] = hi ? CV_(0, 13) : CV_(0, 12);
                cd[7] = hi ? CV_(0, 15) : CV_(0, 14);
                cd[8] = hi ? CV_(1, 1) : CV_(1, 0);
                cd[9] = hi ? CV_(1, 3) : CV_(1, 2);
                cd[10] = hi ? CV_(1, 5) : CV_(1, 4);
                cd[11] = hi ? CV_(1, 7) : CV_(1, 6);
                cd[12] = hi ? CV_(2, 1) : CV_(2, 0);
                cd[13] = hi ? CV_(2, 3) : CV_(2, 2);
                cd[14] = hi ? CV_(3, 0) : CV_(2, 4);
                cd[15] = hi ? CV_(3, 2) : CV_(3, 1);
                cd[16] = hi ? CV_(4, 0) : CV_(3, 3);
                cd[17] = hi ? CV_(4, 2) : CV_(4, 1);
                cd[18] = hi ? CV_(5, 1) : CV_(5, 0);
                cd[19] = hi ? CV_(6, 1) : CV_(6, 0);
                cd[20] = hi ? CV_(7, 1) : CV_(7, 0);
                cd[21] = hi ? CV_(9, 0) : CV_(8, 0);
                cd[22] = hi ? CV_(11, 0) : CV_(10, 0);
                cd[23] = hi ? CV_(13, 0) : CV_(12, 0);
                cd[24] = hi ? CV_(15, 0) : CV_(14, 0);
    #undef CV_
                float top[16];
    #pragma unroll
                for (int rd = 0; rd < 16; ++rd) {
                    float m = cd[0];
    #pragma unroll
                    for (int n = 1; n + 1 < 25; n += 2) m = max3f_(m, cd[n], cd[n + 1]);
                    const float gm = pair_max(m); top[rd] = gm;
    #pragma unroll
                    for (int n = 0; n < 25; ++n) cd[n] = (__float_as_uint(cd[n]) == __float_as_uint(gm)) ? -INFINITY : cd[n];
                }
                float ex[16], sum = 0.f;
    #pragma unroll
                for (int r = 0; r < 16; ++r) { ex[r] = __builtin_amdgcn_exp2f((top[r] - top[0]) * LOG2E); sum += ex[r]; }
                const float inv = 1.f / sum;
                asm volatile("s_waitcnt lgkmcnt(0)" ::: "memory");
                int eo[8]; float go[8];
    #pragma unroll
                for (int rr = 0; rr < 8; ++rr) { float t0 = top[rr], t1 = top[rr + 8], e0 = ex[rr], e1 = ex[rr + 8]; asm volatile("" : "+v"(t0), "+v"(t1), "+v"(e0), "+v"(e1));
                    const unsigned f = 255u - (__float_as_uint(hi ? t1 : t0) & 255u);
                    const int ia = scr[f >> 4], ib = scr[16 + (f & 15)]; eo[rr] = ia * 128 + ib; go[rr] = (hi ? e1 : e0) * inv; }
                int* ep = E + (size_t)tok * 128 + h * 16 + 8 * hi; float* gp = G + (size_t)tok * 128 + h * 16 + 8 * hi;
                *(v4u*)ep = (v4u){(unsigned)eo[0], (unsigned)eo[1], (unsigned)eo[2], (unsigned)eo[3]}; *(v4u*)(ep + 4) = (v4u){(unsigned)eo[4], (unsigned)eo[5], (unsigned)eo[6], (unsigned)eo[7]};
                *(f32x4*)gp = (f32x4){go[0], go[1], go[2], go[3]}; *(f32x4*)(gp + 4) = (f32x4){go[4], go[5], go[6], go[7]};
                asm volatile("s_waitcnt lgkmcnt(0)" ::: "memory");
            }
            } else if (h == F.vcu % nh) {
            {
                const int gwu = F.vcu * NWAVES + F.wave, NGWu = F.G * NWAVES; const float* us = args.in[19]; float* SU = (float*)(ws + WS_SU);
                f32x4 uv[8];
                { int l_ = F.lane; asm volatile("" : "+v"(l_)); const f32x4* ur = (const f32x4*)(us + (size_t)(gwu < 16384 ? gwu : 16383) * D) + l_;
#pragma unroll
                  for (int j = 0; j < 8; ++j) uv[j] = __builtin_nontemporal_load(ur + 64 * j); }
                for (int e = gwu; e < 16384; e += NGWu) {
                    int l_ = F.lane; asm volatile("" : "+v"(l_));
                    f32x4 un[8]; { const int en = e + NGWu < 16384 ? e + NGWu : e; const f32x4* ur = (const f32x4*)(us + (size_t)en * D) + l_;
#pragma unroll
                      for (int j = 0; j < 8; ++j) un[j] = __builtin_nontemporal_load(ur + 64 * j); }
                    float am = 0.f;
#pragma unroll
                    for (int j = 0; j < 8; ++j) am = fmaxf(fmaxf(am, fmaxf(fabsf(uv[j].x), fabsf(uv[j].y))), fmaxf(fabsf(uv[j].z), fabsf(uv[j].w)));
                    am = wave_max_nonneg(am);
                    const float qs = am > 0.f ? 127.f / am : 0.f;
                    if (l_ == 0) SU[e] = am * (1.f / 127.f);
#pragma unroll
                    for (int j = 0; j < 8; ++j) { const int c = (l_ + 64 * j) * 4;
                        const unsigned q = ((unsigned)(int)rintf(uv[j].x * qs) & 0xffu) | (((unsigned)(int)rintf(uv[j].y * qs) & 0xffu) << 8) | (((unsigned)(int)rintf(uv[j].z * qs) & 0xffu) << 16) | (((unsigned)(int)rintf(uv[j].w * qs) & 0xffu) << 24);
                        *(unsigned*)(ws + WS_U8 + ((size_t)(c >> 7) * 16384 + e) * 128 + (c & 127)) = q; }
#pragma unroll
                    for (int j = 0; j < 8; ++j) uv[j] = un[j];
                }
            }
            }
            }
        }
#undef ROUTE_LOADQ
    }
    GRID_BAR();
    if (RUN(11)) {
        const int nlab = F.G < 8 ? F.G : 8, label = (int)blockIdx.x % nlab, nblk = (F.G - label + nlab - 1) / nlab, wx = ((int)blockIdx.x / nlab) * NWAVES + F.wave, nwx = nblk * NWAVES;
        const int lane = F.lane, rr = lane >> 3, cc = lane & 7;
        const int* E = (const int*)(ws + WS_E);
        for (int sl = label; sl < 16; sl += nlab) {
            const unsigned char* Us = ws + WS_U8 + (size_t)sl * 16384 * 128 + 16 * cc;
            const __amdgpu_buffer_rsrc_t urs = __builtin_amdgcn_make_buffer_rsrc((void*)(ws + WS_U8 + (size_t)sl * 16384 * 128), 0, 16384 * 128, 0x00020000);
            const unsigned char* Hs = ws + WS_H8 + (size_t)sl * M * 128 + 16 * cc;
            LAS unsigned* itq = (LAS unsigned*)(F.lds + MISC_OFF) + 19;
            LAS unsigned char* ib = F.lds + RING_OFF + F.wave * 4224;
            __syncthreads(); if (F.tid == 0) *itq = 0u; __syncthreads();
            const int ibase = ((int)blockIdx.x / nlab) * NWAVES;
            int n_ = 0; if (F.lane == 0) n_ = (int)__hip_atomic_fetch_add(itq, 1u, __ATOMIC_RELAXED, __HIP_MEMORY_SCOPE_WORKGROUP); n_ = __builtin_amdgcn_readfirstlane(n_);
            int item = ibase + (n_ & 7) + nwx * (n_ >> 3);
            if (item < M / 8) {
                v4u idr[4]; v4u hq;
                { int ln_ = lane; asm volatile("" : "+v"(ln_)); const v4u* es = (const v4u*)(E + (size_t)item * 1024) + ln_;
#pragma unroll
                  for (int q = 0; q < 4; ++q) idr[q] = es[64 * q];
                  hq = *(const v4u*)(Hs + (size_t)(item * 8 + (ln_ >> 3)) * 128); }
                for (;;) {
                    int ln_ = lane; asm volatile("" : "+v"(ln_));
                    const int rr_ = ln_ >> 3, cc_ = ln_ & 7;
#pragma unroll
                    for (int q = 0; q < 4; ++q) *(LAS v4u*)(ib + (2 * q + (ln_ >> 5)) * 528 + (ln_ & 31) * 16) = idr[q];
                    int n1 = 0; if (F.lane == 0) n1 = (int)__hip_atomic_fetch_add(itq, 1u, __ATOMIC_RELAXED, __HIP_MEMORY_SCOPE_WORKGROUP); n1 = __builtin_amdgcn_readfirstlane(n1);
                    const int item1 = ibase + (n1 & 7) + nwx * (n1 >> 3); const bool more = item1 < M / 8; const int itn = more ? item1 : item;
                    const v4u hc = hq;
                    { const v4u* es = (const v4u*)(E + (size_t)itn * 1024) + ln_;
#pragma unroll
                      for (int q = 0; q < 4; ++q) idr[q] = es[64 * q];
                      hq = *(const v4u*)(Hs + (size_t)(itn * 8 + rr_) * 128); }
                    const int tok = item * 8 + rr_;
                    const LAS unsigned char* ir = ib + rr_ * 528;
                    int res[16];
#pragma unroll
                    for (int i = 0; i < 16; ++i) res[i] = 0;
#pragma unroll
                    for (int i = 0; i < 16; ++i) {
                        const v4u e0 = *(const LAS v4u*)(ir + 32 * i), e1 = *(const LAS v4u*)(ir + 32 * i + 16);
#pragma unroll
                        for (int j = 0; j < 8; ++j) { const unsigned e = j < 4 ? e0[j & 3] : e1[j & 3];
                            v4u a; if (j & 1) a = __builtin_amdgcn_raw_buffer_load_b128(urs, (int)(e * 128u + 16u * (unsigned)cc_), 0, 16); else a = *(const v4u*)(Us + (size_t)e * 128);
                            int d = __builtin_amdgcn_sdot4((int)a.x, (int)hc.x, 0, false); d = __builtin_amdgcn_sdot4((int)a.y, (int)hc.y, d, false); d = __builtin_amdgcn_sdot4((int)a.z, (int)hc.z, d, false); d = __builtin_amdgcn_sdot4((int)a.w, (int)hc.w, d, false);
                            d += __builtin_amdgcn_update_dpp(0, d, 0xB1, 0xf, 0xf, true); d += __builtin_amdgcn_update_dpp(0, d, 0x4E, 0xf, 0xf, true); d += __builtin_amdgcn_update_dpp(0, d, 0x141, 0xf, 0xf, true);
                            res[i] = (cc_ == j) ? d : res[i]; } }
                    v4u* po = (v4u*)((short*)(ws + WS_PART) + (size_t)sl * M * 128 + (size_t)tok * 128 + cc_ * 16);
                    unsigned pw[8];
#pragma unroll
                    for (int q = 0; q < 8; ++q) pw[q] = ((unsigned)((res[2 * q] + 32) >> 6) & 0xffffu) | ((unsigned)((res[2 * q + 1] + 32) >> 6) << 16);
                    po[0] = (v4u){pw[0], pw[1], pw[2], pw[3]}; po[1] = (v4u){pw[4], pw[5], pw[6], pw[7]};
                    if (!more) break;
                    item = item1;
                }
            }
        }
    }
    GRID_BAR();
    if (RUN(12)) {
        const short* P = (const short*)(ws + WS_PART); const int* E = (const int*)(ws + WS_E); const float* G = (const float*)(ws + WS_G); unsigned* PK = (unsigned*)(ws + WS_PK);
        const float* SU = (const float*)(ws + WS_SU); const float* SH = (const float*)(ws + WS_SH);
        for (int t = F.vcu * 512 + F.tid; t < M * 16; t += F.G * 512) { const int tok = t >> 4, sub = t & 15, cc = sub >> 1, half = sub & 1;
            int hs[8];
#pragma unroll
            for (int j = 0; j < 8; ++j) hs[j] = 0;
#pragma unroll
            for (int sl = 0; sl < 16; ++sl) { const v4u p = __builtin_nontemporal_load((const v4u*)(P + (size_t)sl * M * 128 + (size_t)tok * 128 + sub * 8));
#pragma unroll
                for (int q = 0; q < 4; ++q) { hs[2 * q] += (int)(short)(p[q] & 0xffffu); hs[2 * q + 1] += (int)p[q] >> 16; } }
            const float sh = SH[tok] * 64.f;
#pragma unroll
            for (int j = 0; j < 8; ++j) { const int k = 64 * half + 8 * j + cc, idx = tok * 128 + k;
                const int e = E[idx];
                const float w = G[idx] * gelu_tanh((float)hs[j] * SU[e] * sh);
                const unsigned wb_ = __float_as_uint(w), lo_ = (unsigned)e << 3, mg_ = wb_ & 0x7fffffffu;
                PK[(size_t)(tok >> 6) * 8192 + (k >> 2) * 256 + (tok & 63) * 4 + (k & 3)] = lo_ | (mg_ < 0x00800000u ? 0u : ((wb_ & 0x80000000u) | ((mg_ - lo_ + 0x10000u) & 0x7ffe0000u))); }
        }
    }
    GRID_BAR();
    if (RUN(13)) {
        const unsigned* PK = (const unsigned*)(ws + WS_PK); bf16* FFN = (bf16*)(ws + WS_FFN);
        const unsigned lbase = (unsigned)(uintptr_t)(F.lds + RING_OFF);
        for (int c = F.vcu; c < 256; c += F.G) {
            __syncthreads();
            { int tq = F.tid; asm volatile("" : "+v"(tq)); const v4u* src = (const v4u*)(ws + WS_V8 + (size_t)c * 131072) + tq;
#pragma unroll 4
              for (int j = 0; j < 16; ++j) *(LAS v4u*)(F.lds + RING_OFF + (tq + 512 * j) * 16) = __builtin_nontemporal_load(src + 512 * j); }
            LAS unsigned* tbq = (LAS unsigned*)(F.lds + MISC_OFF) + 18;
            if (F.tid == 0) *tbq = 0u;
            __syncthreads();
            for (;;) { int tb = 0; if (F.lane == 0) tb = (int)__hip_atomic_fetch_add(tbq, 1u, __ATOMIC_RELAXED, __HIP_MEMORY_SCOPE_WORKGROUP); tb = __builtin_amdgcn_readfirstlane(tb); if (tb >= M / 64) break;
                int ln_ = F.lane; asm volatile("" : "+v"(ln_));
                const v4u* pk = (const v4u*)(PK + (size_t)tb * 8192) + ln_;
                f32x2v av[4];
#pragma unroll
                for (int i = 0; i < 4; ++i) av[i] = (f32x2v){0.f, 0.f};
                v4u pb[32];
#pragma unroll
                for (int kq = 0; kq < 32; ++kq) pb[kq] = pk[kq * 64];
                unsigned long long dq[8];
#pragma unroll
                for (int j = 0; j < 8; ++j) { const unsigned ad = (pb[j >> 2][j & 3] & 0x1fff8u) | lbase; asm volatile("ds_read_b64 %0, %1" : "=v"(dq[j]) : "v"(ad)); }
#pragma unroll
                for (int j = 0; j < 128; ++j) { const int s_ = j & 7; unsigned long long d = dq[s_];
                    if (j <= 120) asm volatile("s_waitcnt lgkmcnt(7)" : "+v"(d));
                    else if (j == 121) asm volatile("s_waitcnt lgkmcnt(6)" : "+v"(d));
                    else if (j == 122) asm volatile("s_waitcnt lgkmcnt(5)" : "+v"(d));
                    else if (j == 123) asm volatile("s_waitcnt lgkmcnt(4)" : "+v"(d));
                    else if (j == 124) asm volatile("s_waitcnt lgkmcnt(3)" : "+v"(d));
                    else if (j == 125) asm volatile("s_waitcnt lgkmcnt(2)" : "+v"(d));
                    else if (j == 126) asm volatile("s_waitcnt lgkmcnt(1)" : "+v"(d));
                    else asm volatile("s_waitcnt lgkmcnt(0)" : "+v"(d));
                    if (j + 8 < 128) { const unsigned ad = (pb[(j + 8) >> 2][(j + 8) & 3] & 0x1fff8u) | lbase; asm volatile("ds_read_b64 %0, %1" : "=v"(dq[s_]) : "v"(ad)); }
                    const float w = __uint_as_float(pb[j >> 2][j & 3]); const f32x2v ww = (f32x2v){w, w};
                    const int d0 = (int)(unsigned)d, d1 = (int)(unsigned)(d >> 32);
                    av[0] = av[0] + __builtin_amdgcn_cvt_pk_f32_fp8(d0, false) * ww; av[1] = av[1] + __builtin_amdgcn_cvt_pk_f32_fp8(d0, true) * ww;
                    av[2] = av[2] + __builtin_amdgcn_cvt_pk_f32_fp8(d1, false) * ww; av[3] = av[3] + __builtin_amdgcn_cvt_pk_f32_fp8(d1, true) * ww; }
                *(v4u*)(FFN + (size_t)(tb * 64 + ln_) * D + 8 * c) = (v4u){pk2(av[0].x, av[0].y), pk2(av[1].x, av[1].y), pk2(av[2].x, av[2].y), pk2(av[3].x, av[3].y)};
            }
        }
        __syncthreads();
    }
    GRID_BAR();
    if (RUN(14)) {
        const int gw = F.vcu * NWAVES + F.wave, NGW = F.G * NWAVES, lane = F.lane; const float* g2 = args.in[21]; const float* b2 = args.in[22]; float* out = args.out; const bf16* FFN = (const bf16*)(ws + WS_FFN);
        unsigned long long hq_[8], fq_[8];
        { int l_ = lane; asm volatile("" : "+v"(l_)); const int r0 = gw < M ? gw : M - 1; const unsigned long long* hp = (const unsigned long long*)(H1 + (size_t)r0 * D) + l_; const unsigned long long* fp = (const unsigned long long*)(FFN + (size_t)r0 * D) + l_;
#pragma unroll
          for (int j = 0; j < 8; ++j) { hq_[j] = __builtin_nontemporal_load(hp + 64 * j); fq_[j] = __builtin_nontemporal_load(fp + 64 * j); } }
        for (int row = gw; row < M; row += NGW) {
            f32x4 v[8]; float sm = 0.f;
#pragma unroll
            for (int j = 0; j < 8; ++j) { const unsigned long long hq = hq_[j], fq = fq_[j];
                const unsigned h0 = (unsigned)hq, h1_ = (unsigned)(hq >> 32), f0 = (unsigned)fq, f1 = (unsigned)(fq >> 32);
                v[j].x = DN_ALPHA * __uint_as_float(h0 << 16) + __uint_as_float(f0 << 16); v[j].y = DN_ALPHA * __uint_as_float(h0 & 0xffff0000u) + __uint_as_float(f0 & 0xffff0000u);
                v[j].z = DN_ALPHA * __uint_as_float(h1_ << 16) + __uint_as_float(f1 << 16); v[j].w = DN_ALPHA * __uint_as_float(h1_ & 0xffff0000u) + __uint_as_float(f1 & 0xffff0000u);
                sm += (v[j].x + v[j].y) + (v[j].z + v[j].w); }
            { int l_ = lane; asm volatile("" : "+v"(l_)); const int rn = row + NGW < M ? row + NGW : row; const unsigned long long* hp = (const unsigned long long*)(H1 + (size_t)rn * D) + l_; const unsigned long long* fp = (const unsigned long long*)(FFN + (size_t)rn * D) + l_;
#pragma unroll
              for (int j = 0; j < 8; ++j) { hq_[j] = __builtin_nontemporal_load(hp + 64 * j); fq_[j] = __builtin_nontemporal_load(fp + 64 * j); } }
            sm = wave_sum(sm);
            const float mean = sm * (1.f / D); float s2 = 0.f;
#pragma unroll
            for (int j = 0; j < 8; ++j) { v[j] = v[j] - mean; s2 += (v[j].x * v[j].x + v[j].y * v[j].y) + (v[j].z * v[j].z + v[j].w * v[j].w); }
            s2 = wave_sum(s2);
            const float rstd = rsqrtf(s2 * (1.f / D) + LN_EPS);
#pragma unroll
            for (int j = 0; j < 8; ++j) { const int c = (lane + 64 * j) * 4; *(f32x4*)(out + (size_t)row * D + c) = v[j] * rstd * *(const f32x4*)(g2 + c) + *(const f32x4*)(b2 + c); }
        }
    }
#undef IN
#undef RUN
#undef GRID_BAR
}

extern "C" void kernel_launch(void* const* d_in, const int* in_sizes, int n_in, void* d_out, int out_size, void* d_ws, size_t ws_size, hipStream_t stream) {
    static int grid = 0;
    if (grid == 0) {
        if (n_in != 23 || in_sizes[0] != M * D || out_size != M * D || ws_size < WS_END) { fprintf(stderr, "kernel_launch: unexpected shapes n_in %d in0 %d out %d ws %zu\n", n_in, n_in > 0 ? in_sizes[0] : -1, out_size, ws_size); grid = -1; return; }
        int dev = 0, cus = 0;
        if (hipGetDevice(&dev) != hipSuccess || hipDeviceGetAttribute(&cus, hipDeviceAttributeMultiprocessorCount, dev) != hipSuccess) { grid = -1; return; }
        if (hipFuncSetAttribute((const void*)skel_fwd, hipFuncAttributeMaxDynamicSharedMemorySize, LDS_BYTES) != hipSuccess) { grid = -1; return; }
        int per_cu = 0;
        if (hipOccupancyMaxActiveBlocksPerMultiprocessor(&per_cu, (const void*)skel_fwd, NWAVES * 64, LDS_BYTES) != hipSuccess || per_cu < 1) { fprintf(stderr, "kernel_launch: occupancy query reports %d workgroups per CU\n", per_cu); (void)hipGetLastError(); }
        grid = cus;
    }
    if (grid < 0) return;
    (void)hipMemsetAsync((char*)d_ws + WS_CTL, 0, CTL_ZERO_BYTES, stream);
    Args a{};
    for (int i = 0; i < 23; ++i) a.in[i] = (const float*)d_in[i];
    a.out = (float*)d_out; a.ws = (unsigned char*)d_ws;
    a.ph_lo = -1; a.ph_hi = 0;
    hipLaunchKernelGGL(skel_fwd, dim3(grid), dim3(NWAVES * 64), LDS_BYTES, stream, a);
}
```
